# Optimizing an MI355X kernel written in HIP

```python
import math
import jax, jax.numpy as jnp
from jax import lax
import numpy as np

D_MODEL = 1024
BATCH = 8
SEQ = 4096
DEPTH = 2

HEAD_DIM = 64
ROPE_THETA = 10000.0
LN_EPS = 1e-5
DEEPNORM_ALPHA = (2.0 * DEPTH) ** 0.25
DEEPNORM_BETA = (8.0 * DEPTH) ** -0.25
N_EVEN_LAYERS = (DEPTH + 1) // 2
N_ODD_LAYERS = DEPTH // 2

NSA_HEADS = D_MODEL // 128
NSA_KV_GROUPS = 2
NSA_HEADS_PER_GROUP = NSA_HEADS // NSA_KV_GROUPS
NSA_WIDTH = NSA_HEADS * HEAD_DIM
NSA_KV_WIDTH = NSA_KV_GROUPS * HEAD_DIM
CMP_BLOCK = 32
CMP_STRIDE = 16
CMP_HIDDEN = 2 * HEAD_DIM
SEL_BLOCK = 64
SEL_TOPN = 8
WINDOW = 256
NSA_QCHUNK = 128
NSA_IN_WIDTH = NSA_WIDTH + 6 * NSA_KV_WIDTH + 3 * NSA_HEADS

S5_WIDTH = D_MODEL - NSA_WIDTH
S5_GROUP_CH = 16
S5_GROUPS = S5_WIDTH // S5_GROUP_CH
S5_STATE = 64

EVEN_IN_WIDTH = NSA_IN_WIDTH + S5_WIDTH

MOBA_HEADS = D_MODEL // HEAD_DIM
MOBA_BLOCK = 256
MOBA_TOPK = 3
MOBA_QCHUNK = 64

MOE_GROUPS = 4
MOE_EXPERTS_PER_GROUP = 8
MOE_N_EXPERTS = MOE_GROUPS * MOE_EXPERTS_PER_GROUP
MOE_TOP_IN_GROUP = 2
MOE_FF = 128

kernel_name = 'hybrid_nsa_s5_moba_hmoe_deepnorm'


def layer_norm(x, g, b):
    xf = x.astype(jnp.float32)
    mu = jnp.mean(xf, -1, keepdims=True)
    var = jnp.mean(jnp.square(xf - mu), -1, keepdims=True)
    return ((xf - mu) * lax.rsqrt(var + LN_EPS) * g + b).astype(x.dtype)


def rope_tables(seq):
    inv = 1.0 / (ROPE_THETA ** (jnp.arange(0, HEAD_DIM, 2, dtype=jnp.float32) / HEAD_DIM))
    ang = jnp.arange(seq, dtype=jnp.float32)[:, None] * inv[None, :]
    return jnp.cos(ang), jnp.sin(ang)


def apply_rope(x, cos, sin):
    x1, x2 = jnp.split(x, 2, axis=-1)
    c = cos[:, None, :]
    s = sin[:, None, :]
    return jnp.concatenate([x1 * c - x2 * s, x1 * s + x2 * c], -1).astype(x.dtype)


def masked_softmax(s, mask):
    s = jnp.where(mask, s.astype(jnp.float32), -jnp.inf)
    m = jnp.max(s, -1, keepdims=True)
    m = jnp.where(jnp.isfinite(m), m, 0.0)
    p = jnp.where(mask, jnp.exp(s - m), 0.0)
    return p / jnp.maximum(jnp.sum(p, -1, keepdims=True), 1e-30)


def nsa_mixer(xp, cos, sin, pe_k, pe_v, k_w1, k_w2, v_w1, v_w2):
    B, S, _ = xp.shape
    G, Z, dh = NSA_KV_GROUPS, NSA_HEADS_PER_GROUP, HEAD_DIM
    cuts = [int(v) for v in np.cumsum([NSA_WIDTH] + [NSA_KV_WIDTH] * 6)]
    q, kc, vc, ks, vs, kw, vw, gl = jnp.split(xp, cuts, axis=-1)
    q = apply_rope(q.reshape(B, S, NSA_HEADS, dh), cos, sin)
    q = q.reshape(B, S, G, Z, dh).transpose(0, 2, 3, 1, 4)
    kc, ks, kw = [apply_rope(t.reshape(B, S, G, dh), cos, sin) for t in (kc, ks, kw)]
    vc, vs, vw = [t.reshape(B, S, G, dh) for t in (vc, vs, vw)]
    gates = jax.nn.sigmoid(gl.astype(jnp.float32)).reshape(B, S, G, Z, 3).transpose(0, 2, 3, 1, 4)

    n_cmp = (S - CMP_BLOCK) // CMP_STRIDE + 1
    starts = jnp.arange(n_cmp) * CMP_STRIDE
    idx = starts[:, None] + jnp.arange(CMP_BLOCK)[None, :]

    def compress(t, pe, w1, w2):
        blk = t[:, idx] + pe[None, None, :, None, :]
        blk = blk.transpose(0, 3, 1, 2, 4).reshape(B, G, n_cmp, CMP_BLOCK * dh)
        return jax.nn.gelu(blk @ w1) @ w2

    k_cmp = compress(kc, pe_k, k_w1, k_w2)
    v_cmp = compress(vc, pe_v, v_w1, v_w2)
    cmp_end = starts + CMP_BLOCK - 1

    nbs = S // SEL_BLOCK
    n_sel = min(SEL_TOPN, nbs)
    bstart = jnp.arange(nbs) * SEL_BLOCK
    ovl = jnp.clip(jnp.minimum(starts[:, None] + CMP_BLOCK, bstart[None, :] + SEL_BLOCK)
                   - jnp.maximum(starts[:, None], bstart[None, :]), 0, CMP_BLOCK)
    cmp_to_sel = ovl.astype(jnp.float32) / CMP_BLOCK
    ks_blk = ks.reshape(B, nbs, SEL_BLOCK, G, dh).transpose(0, 3, 1, 2, 4)
    vs_blk = vs.reshape(B, nbs, SEL_BLOCK, G, dh).transpose(0, 3, 1, 2, 4)
    kw_pad = jnp.pad(kw.transpose(0, 2, 1, 3), ((0, 0), (0, 0), (WINDOW, 0), (0, 0)))
    vw_pad = jnp.pad(vw.transpose(0, 2, 1, 3), ((0, 0), (0, 0), (WINDOW, 0), (0, 0)))
    bi = jnp.arange(B)[:, None, None, None]
    gi = jnp.arange(G)[None, :, None, None]
    scale = dh ** -0.5
    QC = NSA_QCHUNK

    def chunk(c):
        t0 = c * QC
        qpos = t0 + jnp.arange(QC)
        qc = lax.dynamic_slice_in_dim(q, t0, QC, axis=3)
        s_c = jnp.einsum('bgzqd,bgnd->bgzqn', qc, k_cmp) * scale
        p_c = masked_softmax(s_c, cmp_end[None, :] <= qpos[:, None])
        o_c = jnp.einsum('bgzqn,bgnd->bgzqd', p_c.astype(v_cmp.dtype), v_cmp)
        imp = jnp.einsum('bgzqn,nj->bgqj', p_c, cmp_to_sel)
        qblk = qpos // SEL_BLOCK
        j = jnp.arange(nbs)
        forced = (j[None, :] == 0) | (j[None, :] == qblk[:, None]) | (j[None, :] == qblk[:, None] - 1)
        future = j[None, :] > qblk[:, None]
        score = jnp.where(future, -1.0, jnp.where(forced, 1e3, imp))
        top_s, sel = lax.top_k(score, n_sel)
        valid = top_s >= 0.0
        k_sel = ks_blk[bi, gi, sel]
        v_sel = vs_blk[bi, gi, sel]
        kpos = sel[..., None] * SEL_BLOCK + jnp.arange(SEL_BLOCK)
        m_s = valid[..., None] & (kpos <= qpos[None, None, :, None, None])
        s_s = jnp.einsum('bgzqd,bgqnkd->bgzqnk', qc, k_sel) * scale
        p_s = masked_softmax(s_s.reshape(B, G, Z, QC, n_sel * SEL_BLOCK),
                             m_s.reshape(B, G, 1, QC, n_sel * SEL_BLOCK))
        o_s = jnp.einsum('bgzqk,bgqkd->bgzqd', p_s.astype(v_sel.dtype),
                         v_sel.reshape(B, G, QC, n_sel * SEL_BLOCK, dh))
        k_w = lax.dynamic_slice_in_dim(kw_pad, t0, QC + WINDOW, axis=2)
        v_w = lax.dynamic_slice_in_dim(vw_pad, t0, QC + WINDOW, axis=2)
        kposw = t0 - WINDOW + jnp.arange(QC + WINDOW)
        diff = qpos[:, None] - kposw[None, :]
        m_w = (diff >= 0) & (diff < WINDOW) & (kposw[None, :] >= 0)
        s_w = jnp.einsum('bgzqd,bgkd->bgzqk', qc, k_w) * scale
        p_w = masked_softmax(s_w, m_w)
        o_w = jnp.einsum('bgzqk,bgkd->bgzqd', p_w.astype(v_w.dtype), v_w)
        g = lax.dynamic_slice_in_dim(gates, t0, QC, axis=3)
        o = g[..., 0:1] * o_c + g[..., 1:2] * o_s + g[..., 2:3] * o_w
        return o.astype(xp.dtype)

    outs = lax.map(chunk, jnp.arange(S // QC))
    return outs.transpose(1, 0, 4, 2, 3, 5).reshape(B, S, NSA_WIDTH)


def ssm_combine(e1, e2):
    a1r, a1i, b1r, b1i = e1
    a2r, a2i, b2r, b2i = e2
    return (a2r * a1r - a2i * a1i,
            a2r * a1i + a2i * a1r,
            a2r * b1r - a2i * b1i + b2r,
            a2r * b1i + a2i * b1r + b2i)


def s5_mixer(u, lam_re, lam_im, log_step, b_re, b_im, c_re, c_im, d_skip, glu_w, glu_b):
    B, S, _ = u.shape
    f32 = jnp.float32
    uf = u.astype(f32)
    ug = uf.reshape(B, S, S5_GROUPS, S5_GROUP_CH)
    step = jnp.exp(log_step.astype(f32))[:, None]
    lr = lam_re.astype(f32)
    li = lam_im.astype(f32)
    mag = jnp.exp(lr * step)
    ar = mag * jnp.cos(li * step)
    ai = mag * jnp.sin(li * step)
    den = lr * lr + li * li
    fr = ((ar - 1.0) * lr + ai * li) / den
    fi = (ai * lr - (ar - 1.0) * li) / den
    br = b_re.astype(f32)
    bim = b_im.astype(f32)
    bbar_r = fr[..., None] * br - fi[..., None] * bim
    bbar_i = fr[..., None] * bim + fi[..., None] * br
    bu_r = jnp.einsum('bsgc,gpc->bsgp', ug, bbar_r)
    bu_i = jnp.einsum('bsgc,gpc->bsgp', ug, bbar_i)
    a_r = jnp.broadcast_to(ar[None, None], (1, S, S5_GROUPS, S5_STATE))
    a_i = jnp.broadcast_to(ai[None, None], (1, S, S5_GROUPS, S5_STATE))
    _, _, xr, xi = lax.associative_scan(ssm_combine, (a_r, a_i, bu_r, bu_i), axis=1)
    y = (jnp.einsum('bsgp,gcp->bsgc', xr, c_re.astype(f32))
         - jnp.einsum('bsgp,gcp->bsgc', xi, c_im.astype(f32)))
    y = y.reshape(B, S, S5_WIDTH) + d_skip.astype(f32) * uf
    g = jax.nn.gelu(y)
    out = g * jax.nn.sigmoid(g @ glu_w.astype(f32) + glu_b.astype(f32))
    return out.astype(u.dtype)


def moba_mixer(xp, cos, sin):
    B, S, _ = xp.shape
    H, dh = MOBA_HEADS, HEAD_DIM
    q, k, v = jnp.split(xp, 3, axis=-1)
    q = apply_rope(q.reshape(B, S, H, dh), cos, sin).transpose(0, 2, 1, 3)
    k = apply_rope(k.reshape(B, S, H, dh), cos, sin).transpose(0, 2, 1, 3)
    v = v.reshape(B, S, H, dh).transpose(0, 2, 1, 3)
    nb = -(-S // MOBA_BLOCK)
    pad = nb * MOBA_BLOCK - S
    k = jnp.pad(k, ((0, 0), (0, 0), (0, pad), (0, 0)))
    v = jnp.pad(v, ((0, 0), (0, 0), (0, pad), (0, 0)))
    k_blk = k.reshape(B, H, nb, MOBA_BLOCK, dh)
    v_blk = v.reshape(B, H, nb, MOBA_BLOCK, dh)
    k_mean = jnp.mean(k_blk.astype(jnp.float32), axis=3)
    top = min(MOBA_TOPK, max(nb - 1, 1))
    bi = jnp.arange(B)[:, None, None, None]
    hi = jnp.arange(H)[None, :, None, None]
    scale = dh ** -0.5
    QC = MOBA_QCHUNK

    def chunk(c):
        t0 = c * QC
        qpos = t0 + jnp.arange(QC)
        qc = lax.dynamic_slice_in_dim(q, t0, QC, axis=2)
        own = t0 // MOBA_BLOCK
        gs = jnp.einsum('bhqd,bhnd->bhqn', qc.astype(jnp.float32), k_mean)
        past = jnp.arange(nb) < own
        gs = jnp.where(past, gs, -jnp.inf)
        top_s, sel = lax.top_k(gs, top)
        valid = jnp.isfinite(top_s)
        k_sel = k_blk[bi, hi, sel]
        v_sel = v_blk[bi, hi, sel]
        s_sel = jnp.einsum('bhqd,bhqnkd->bhqnk', qc, k_sel) * scale
        s_sel = s_sel.reshape(B, H, QC, top * MOBA_BLOCK)
        m_sel = jnp.broadcast_to(valid[..., None], (B, H, QC, top, MOBA_BLOCK)).reshape(B, H, QC, top * MOBA_BLOCK)
        k_own = lax.dynamic_slice_in_dim(k, own * MOBA_BLOCK, MOBA_BLOCK, axis=2)
        v_own = lax.dynamic_slice_in_dim(v, own * MOBA_BLOCK, MOBA_BLOCK, axis=2)
        kpos_own = own * MOBA_BLOCK + jnp.arange(MOBA_BLOCK)
        m_own = jnp.broadcast_to(kpos_own[None, :] <= qpos[:, None], (B, H, QC, MOBA_BLOCK))
        s_own = jnp.einsum('bhqd,bhkd->bhqk', qc, k_own) * scale
        p = masked_softmax(jnp.concatenate([s_own, s_sel], -1), jnp.concatenate([m_own, m_sel], -1))
        p = p.astype(v.dtype)
        o = (jnp.einsum('bhqk,bhkd->bhqd', p[..., :MOBA_BLOCK], v_own)
             + jnp.einsum('bhqnk,bhqnkd->bhqd', p[..., MOBA_BLOCK:].reshape(B, H, QC, top, MOBA_BLOCK), v_sel))
        return o

    outs = lax.map(chunk, jnp.arange(S // QC))
    return outs.transpose(1, 0, 3, 2, 4).reshape(B, S, H * dh)


def hier_moe(x, w_coarse, b_coarse, w_fine, b_fine, w_gate, w_up, w_down):
    B, S, D = x.shape
    t = x.reshape(B * S, D)
    T = t.shape[0]
    pc = jax.nn.softmax((t @ w_coarse + b_coarse).astype(jnp.float32), axis=-1)
    gv, gidx = lax.top_k(pc, 1)
    lf = (jnp.einsum('td,gde->tge', t, w_fine) + b_fine).astype(jnp.float32)
    lf_sel = jnp.take_along_axis(lf, gidx[:, :, None], axis=1)[:, 0]
    pf = jax.nn.softmax(lf_sel, axis=-1)
    fv, fidx = lax.top_k(pf, MOE_TOP_IN_GROUP)
    fv = fv / jnp.sum(fv, -1, keepdims=True)
    w = gv * fv
    eid = gidx * MOE_EXPERTS_PER_GROUP + fidx
    gates = jnp.sum(jax.nn.one_hot(eid, MOE_N_EXPERTS, dtype=jnp.float32) * w[..., None], axis=1)
    gates = gates.reshape(T, MOE_GROUPS, MOE_EXPERTS_PER_GROUP).astype(t.dtype)
    y = jnp.zeros_like(t)
    for g in range(MOE_GROUPS):
        hg = jnp.einsum('td,edf->tef', t, w_gate[g])
        hu = jnp.einsum('td,edf->tef', t, w_up[g])
        h = jax.nn.silu(hg) * hu * gates[:, g, :, None]
        y = y + jnp.einsum('tef,efd->td', h, w_down[g])
    return y.reshape(B, S, D)


def setup_inputs(seed: int = 0) -> dict:
    key = jax.random.key(seed)
    ks = jax.random.split(key, 40)
    f32 = jnp.float32
    NE, NO, L = N_EVEN_LAYERS, N_ODD_LAYERS, DEPTH

    def nrm(i, shape, scale):
        return jax.random.normal(ks[i], shape, f32) * scale

    d = D_MODEL
    return {
        'x': nrm(0, (BATCH, SEQ, d), 1.0),
        'ev_w_in': nrm(1, (NE, d, EVEN_IN_WIDTH), d ** -0.5),
        'nsa_pe_k': nrm(2, (NE, CMP_BLOCK, HEAD_DIM), 0.02),
        'nsa_pe_v': nrm(3, (NE, CMP_BLOCK, HEAD_DIM), 0.02),
        'nsa_cmp_k_w1': nrm(4, (NE, CMP_BLOCK * HEAD_DIM, CMP_HIDDEN), (CMP_BLOCK * HEAD_DIM) ** -0.5),
        'nsa_cmp_k_w2': nrm(5, (NE, CMP_HIDDEN, HEAD_DIM), CMP_HIDDEN ** -0.5),
        'nsa_cmp_v_w1': nrm(6, (NE, CMP_BLOCK * HEAD_DIM, CMP_HIDDEN), (CMP_BLOCK * HEAD_DIM) ** -0.5),
        'nsa_cmp_v_w2': nrm(7, (NE, CMP_HIDDEN, HEAD_DIM), CMP_HIDDEN ** -0.5),
        's5_lambda_re': -0.5 + nrm(8, (NE, S5_GROUPS, S5_STATE), 0.01),
        's5_lambda_im': math.pi * jnp.arange(S5_STATE, dtype=f32) + nrm(9, (NE, S5_GROUPS, S5_STATE), 0.01),
        's5_log_step': jax.random.uniform(ks[10], (NE, S5_GROUPS), f32, math.log(1e-3), math.log(1e-1)),
        's5_b_re': nrm(11, (NE, S5_GROUPS, S5_STATE, S5_GROUP_CH), (2 * S5_GROUP_CH) ** -0.5),
        's5_b_im': nrm(12, (NE, S5_GROUPS, S5_STATE, S5_GROUP_CH), (2 * S5_GROUP_CH) ** -0.5),
        's5_c_re': nrm(13, (NE, S5_GROUPS, S5_GROUP_CH, S5_STATE), S5_STATE ** -0.5),
        's5_c_im': nrm(14, (NE, S5_GROUPS, S5_GROUP_CH, S5_STATE), S5_STATE ** -0.5),
        's5_d': nrm(15, (NE, S5_WIDTH), 1.0),
        's5_glu_w': nrm(16, (NE, S5_WIDTH, S5_WIDTH), S5_WIDTH ** -0.5),
        's5_glu_b': nrm(17, (NE, S5_WIDTH), 0.01),
        'ev_w_out': nrm(18, (NE, d, d), DEEPNORM_BETA * d ** -0.5),
        'od_w_in': nrm(19, (NO, d, 3 * d), d ** -0.5),
        'od_w_out': nrm(20, (NO, d, d), DEEPNORM_BETA * d ** -0.5),
        'ln_mix_g': 1.0 + nrm(21, (L, d), 0.01),
        'ln_mix_b': nrm(22, (L, d), 0.01),
        'ln_ffn_g': 1.0 + nrm(23, (L, d), 0.01),
        'ln_ffn_b': nrm(24, (L, d), 0.01),
        'moe_w_coarse': nrm(25, (L, d, MOE_GROUPS), d ** -0.5),
        'moe_b_coarse': nrm(26, (L, MOE_GROUPS), 0.01),
        'moe_w_fine': nrm(27, (L, MOE_GROUPS, d, MOE_EXPERTS_PER_GROUP), d ** -0.5),
        'moe_b_fine': nrm(28, (L, MOE_GROUPS, MOE_EXPERTS_PER_GROUP), 0.01),
        'moe_w_gate': nrm(29, (L, MOE_GROUPS, MOE_EXPERTS_PER_GROUP, d, MOE_FF), d ** -0.5),
        'moe_w_up': nrm(30, (L, MOE_GROUPS, MOE_EXPERTS_PER_GROUP, d, MOE_FF), d ** -0.5),
        'moe_w_down': nrm(31, (L, MOE_GROUPS, MOE_EXPERTS_PER_GROUP, MOE_FF, d), DEEPNORM_BETA * MOE_FF ** -0.5),
    }


def reference(x, ev_w_in, nsa_pe_k, nsa_pe_v, nsa_cmp_k_w1, nsa_cmp_k_w2, nsa_cmp_v_w1, nsa_cmp_v_w2,
              s5_lambda_re, s5_lambda_im, s5_log_step, s5_b_re, s5_b_im, s5_c_re, s5_c_im, s5_d,
              s5_glu_w, s5_glu_b, ev_w_out, od_w_in, od_w_out,
              ln_mix_g, ln_mix_b, ln_ffn_g, ln_ffn_b,
              moe_w_coarse, moe_b_coarse, moe_w_fine, moe_b_fine, moe_w_gate, moe_w_up, moe_w_down):
    S = x.shape[1]
    cos, sin = rope_tables(S)
    for layer in range(DEPTH):
        if layer % 2 == 0:
            e = layer // 2
            xp = x @ ev_w_in[e]
            o_nsa = nsa_mixer(xp[..., :NSA_IN_WIDTH], cos, sin, nsa_pe_k[e], nsa_pe_v[e],
                              nsa_cmp_k_w1[e], nsa_cmp_k_w2[e], nsa_cmp_v_w1[e], nsa_cmp_v_w2[e])
            o_s5 = s5_mixer(xp[..., NSA_IN_WIDTH:], s5_lambda_re[e], s5_lambda_im[e], s5_log_step[e],
                            s5_b_re[e], s5_b_im[e], s5_c_re[e], s5_c_im[e], s5_d[e], s5_glu_w[e], s5_glu_b[e])
            mix = jnp.concatenate([o_nsa, o_s5], axis=-1) @ ev_w_out[e]
        else:
            o = layer // 2
            mix = moba_mixer(x @ od_w_in[o], cos, sin) @ od_w_out[o]
        x = layer_norm(DEEPNORM_ALPHA * x + mix, ln_mix_g[layer], ln_mix_b[layer])
        ffn = hier_moe(x, moe_w_coarse[layer], moe_b_coarse[layer], moe_w_fine[layer], moe_b_fine[layer],
                       moe_w_gate[layer], moe_w_up[layer], moe_w_down[layer])
        x = layer_norm(DEEPNORM_ALPHA * x + ffn, ln_ffn_g[layer], ln_ffn_b[layer])
    return x
```

```cpp
#include <hip/hip_runtime.h>
#include <hip/hip_cooperative_groups.h>
#include <cstdio>
#include <cstdint>
namespace cg = cooperative_groups;

typedef unsigned short bf16_t;
typedef short bf16x8 __attribute__((ext_vector_type(8)));
typedef float f32x4 __attribute__((ext_vector_type(4)));
typedef unsigned u32x4 __attribute__((ext_vector_type(4)));
typedef unsigned u32x2 __attribute__((ext_vector_type(2)));
#define DI __device__ __forceinline__

constexpr int NB = 8, SEQ = 4096, DM = 1024, NT = NB * SEQ;
constexpr float ALPHA = 1.41421356237f;
constexpr float LN_EPS = 1e-5f;
constexpr int NIN0 = 1920;
constexpr int NPH = 19;
#ifndef MK_ONE_LAUNCH
#define MK_ONE_LAUNCH 0
#endif

constexpr size_t MiB = 1u << 20;
constexpr size_t WS_CTL = 0;
constexpr size_t WS_ROPE = 1 * MiB;
constexpr size_t WS_WIN0 = 2 * MiB;
constexpr size_t WS_WOUT0 = 6 * MiB;
constexpr size_t WS_WIN1 = 8 * MiB;
constexpr size_t WS_WOUT1 = 14 * MiB;
constexpr size_t WS_WGLU = 16 * MiB;
constexpr size_t WS_WCK1 = 16 * MiB + 512 * 1024;
constexpr size_t WS_WCV1 = 17 * MiB;
constexpr size_t WS_WCK2 = 17 * MiB + 512 * 1024;
constexpr size_t WS_WCV2 = WS_WCK2 + 16384;
constexpr size_t WS_CBIAS = WS_WCV2 + 16384;
constexpr size_t WS_S5AL = WS_CBIAS + 4096;
constexpr size_t WS_BTE = 18 * MiB;
constexpr size_t WS_BTY = 22 * MiB;
constexpr size_t WS_WGU = 42 * MiB;
constexpr size_t WS_WDN = 74 * MiB;
constexpr size_t WS_LIST = 90 * MiB;
constexpr size_t WS_WGT = 94 * MiB;
constexpr size_t WS_KMEAN = 94 * MiB + 512 * 1024;
constexpr size_t WS_KCMP = 95 * MiB;
constexpr size_t WS_VCMP = 95 * MiB + 512 * 1024;
constexpr size_t WS_ACTB = 96 * MiB;
constexpr size_t WS_MIX = 160 * MiB;
constexpr size_t WS_XP = 224 * MiB;
constexpr size_t WS_END = 416 * MiB;
constexpr size_t XP_Q0 = WS_XP;
constexpr size_t XP_KC = WS_XP + 32 * MiB;
constexpr size_t KVSZ = 8 * MiB;
constexpr size_t XP_GATES = WS_XP + 80 * MiB;
constexpr size_t XP_AEXT = WS_XP + 84 * MiB;
constexpr size_t XP_G5 = WS_XP + 124 * MiB;
constexpr size_t XP_YB = WS_XP;
constexpr size_t XP_H = WS_XP + 128 * MiB;
constexpr size_t XP_Q1 = WS_XP;

struct Params {
    const float* in[32];
    float* out;
    unsigned char* ws;
    int ph_lo, ph_hi;
};

DI bf16_t f2bf(float f) { unsigned u = __float_as_uint(f); return (bf16_t)((u + 0x7fffu + ((u >> 16) & 1u)) >> 16); }
DI float bf2f(bf16_t h) { return __uint_as_float(((unsigned)h) << 16); }
DI unsigned pk2(float lo, float hi) { return (unsigned)f2bf(lo) | ((unsigned)f2bf(hi) << 16); }
DI float wave_sum(float v) {
#pragma unroll
    for (int o = 32; o > 0; o >>= 1) v += __shfl_xor(v, o);
    return v;
}
DI float wave_max(float v) {
#pragma unroll
    for (int o = 32; o > 0; o >>= 1) v = fmaxf(v, __shfl_xor(v, o));
    return v;
}
DI float sigmoidf_(float x) { return 1.f / (1.f + __expf(-x)); }
DI float gelu_tanh(float x) { const float z = 0.7978845608028654f * (x + 0.044715f * x * x * x); return x * sigmoidf_(2.f * z); }

constexpr int GLD = 72;
constexpr int GEMM_LDS = 2 * 128 * GLD * 2;
template <class RowPtr, class Epi>
DI void gemm128(RowPtr rowptr, const bf16_t* __restrict__ Bt, int ldb, int K, unsigned char* smem, Epi epi) {
    bf16_t* sA = (bf16_t*)smem;
    bf16_t* sB = sA + 128 * GLD;
    const int tid = threadIdx.x, lane = tid & 63, wave = tid >> 6, wr = wave >> 1, wc = wave & 1;
    const bf16_t* ap[4];
    const bf16_t* bp[4];
#pragma unroll
    for (int i = 0; i < 4; ++i) {
        const int c = tid + 256 * i, r = c >> 3, cc = c & 7;
        ap[i] = rowptr(r) + cc * 8;
        bp[i] = Bt + (size_t)r * ldb + cc * 8;
    }
    u32x4 ra[4], rb[4];
#pragma unroll
    for (int i = 0; i < 4; ++i) { ra[i] = *(const u32x4*)(ap[i]); rb[i] = *(const u32x4*)(bp[i]); }
    f32x4 acc[4][4];
#pragma unroll
    for (int m = 0; m < 4; ++m)
#pragma unroll
        for (int n = 0; n < 4; ++n) acc[m][n] = (f32x4){0.f, 0.f, 0.f, 0.f};
    const int nk = K >> 6;
    for (int kt = 0; kt < nk; ++kt) {
#pragma unroll
        for (int i = 0; i < 4; ++i) {
            const int c = tid + 256 * i, r = c >> 3, cc = c & 7;
            *(u32x4*)(sA + r * GLD + cc * 8) = ra[i];
            *(u32x4*)(sB + r * GLD + cc * 8) = rb[i];
        }
        __syncthreads();
        if (kt + 1 < nk) {
#pragma unroll
            for (int i = 0; i < 4; ++i) { ra[i] = *(const u32x4*)(ap[i] + (kt + 1) * 64); rb[i] = *(const u32x4*)(bp[i] + (kt + 1) * 64); }
        }
#pragma unroll
        for (int ks = 0; ks < 2; ++ks) {
            bf16x8 af[4], bfr[4];
#pragma unroll
            for (int m = 0; m < 4; ++m) af[m] = *(const bf16x8*)(sA + (wr * 64 + m * 16 + (lane & 15)) * GLD + ks * 32 + (lane >> 4) * 8);
#pragma unroll
            for (int n = 0; n < 4; ++n) bfr[n] = *(const bf16x8*)(sB + (wc * 64 + n * 16 + (lane & 15)) * GLD + ks * 32 + (lane >> 4) * 8);
#pragma unroll
            for (int m = 0; m < 4; ++m)
#pragma unroll
                for (int n = 0; n < 4; ++n) acc[m][n] = __builtin_amdgcn_mfma_f32_16x16x32_bf16(af[m], bfr[n], acc[m][n], 0, 0, 0);
        }
        __syncthreads();
    }
    epi(acc, wr, wc, lane);
}

DI int rowmap(int kind, int n) {
    if (kind == 1) return n < 1304 ? n : n + 104;
    if (kind == 2) return ((n >> 5) << 6) + (n & 31);
    if (kind == 3) return ((n >> 5) << 6) + 32 + (n & 31);
    return n;
}
DI void tr_tile(const float* __restrict__ src, int K, int N, bf16_t* __restrict__ dst, int kind, int kt, int nt, float* s) {
    const int tid = threadIdx.x, k0 = kt * 64, n0 = nt * 64;
    {
        const int nn = tid & 63, kq = tid >> 6, n = n0 + nn;
#pragma unroll
        for (int i = 0; i < 16; ++i) { const int kk = kq + 4 * i; s[kk * 65 + nn] = (n < N) ? src[(size_t)(k0 + kk) * N + n] : 0.f; }
    }
    __syncthreads();
    {
        const int rn = tid >> 2, kseg = (tid & 3) * 16, n = n0 + rn;
        if (n < N) {
            unsigned w[8];
#pragma unroll
            for (int i = 0; i < 8; ++i) w[i] = pk2(s[(kseg + 2 * i) * 65 + rn], s[(kseg + 2 * i + 1) * 65 + rn]);
            bf16_t* d = dst + (size_t)rowmap(kind, n) * K + k0 + kseg;
            *(uint4*)d = make_uint4(w[0], w[1], w[2], w[3]);
            *(uint4*)(d + 8) = make_uint4(w[4], w[5], w[6], w[7]);
        }
    }
    __syncthreads();
}
struct CF { float re, im; };
DI CF cmul(CF a, CF b) { return {a.re * b.re - a.im * b.im, a.re * b.im + a.im * b.re}; }
DI CF s5_apow(const Params& P, int g, int p, float tau) {
    const float step = expf(P.in[10][g]);
    const float lr = P.in[8][g * 64 + p], li = P.in[9][g * 64 + p];
    const float mag = expf(lr * step * tau);
    float sn, cs; sincosf(li * step * tau, &sn, &cs);
    return {mag * cs, mag * sn};
}
DI CF s5_f(const Params& P, int g, int p) {
    const CF a = s5_apow(P, g, p, 1.f);
    const float lr = P.in[8][g * 64 + p], li = P.in[9][g * 64 + p];
    const float den = lr * lr + li * li;
    return {((a.re - 1.f) * lr + a.im * li) / den, (a.im * lr - (a.re - 1.f) * li) / den};
}
DI void phase0(const Params& P, unsigned char* smem) {
    const int tid = threadIdx.x;
    unsigned char* ws = P.ws;
    float* sf = (float*)smem;
    constexpr int N_TR0 = 16 * 29, N_TR1 = 256, N_TR2 = 16 * 48, N_TR3 = 256, N_TR4 = 64, N_TR5 = 64, N_TR6 = 64, N_TR7 = 2, N_TR8 = 2;
    constexpr int N_TRG = 64 * 32, N_TRU = 64 * 32, N_TRD = 64 * 32;
    constexpr int N_X = NT * DM / 8192, N_ROPE = 512, N_CB = 16, N_AL = 8, N_BTE = 256, N_BTYM = 32 * 63, N_BTYQ = 4096, N_ZP = 13;
    constexpr int TOTAL = N_TR0 + N_TR1 + N_TR2 + N_TR3 + N_TR4 + N_TR5 + N_TR6 + N_TR7 + N_TR8 + N_TRG + N_TRU + N_TRD + N_X + N_ROPE + N_CB + N_AL + N_BTE + N_BTYM + N_BTYQ + N_ZP;
    for (int it0 = blockIdx.x; it0 < TOTAL; it0 += gridDim.x) {
        int it = it0;
        if (it < N_TR0) { tr_tile(P.in[1], 1024, 1816, (bf16_t*)(ws + WS_WIN0), 1, it / 29, it % 29, sf); continue; } it -= N_TR0;
        if (it < N_TR1) { tr_tile(P.in[18], 1024, 1024, (bf16_t*)(ws + WS_WOUT0), 0, it / 16, it % 16, sf); continue; } it -= N_TR1;
        if (it < N_TR2) { tr_tile(P.in[19], 1024, 3072, (bf16_t*)(ws + WS_WIN1), 0, it / 48, it % 48, sf); continue; } it -= N_TR2;
        if (it < N_TR3) { tr_tile(P.in[20], 1024, 1024, (bf16_t*)(ws + WS_WOUT1), 0, it / 16, it % 16, sf); continue; } it -= N_TR3;
        if (it < N_TR4) { tr_tile(P.in[16], 512, 512, (bf16_t*)(ws + WS_WGLU), 0, it / 8, it % 8, sf); continue; } it -= N_TR4;
        if (it < N_TR5) { tr_tile(P.in[4], 2048, 128, (bf16_t*)(ws + WS_WCK1), 0, it / 2, it % 2, sf); continue; } it -= N_TR5;
        if (it < N_TR6) { tr_tile(P.in[6], 2048, 128, (bf16_t*)(ws + WS_WCV1), 0, it / 2, it % 2, sf); continue; } it -= N_TR6;
        if (it < N_TR7) { tr_tile(P.in[5], 128, 64, (bf16_t*)(ws + WS_WCK2), 0, it, 0, sf); continue; } it -= N_TR7;
        if (it < N_TR8) { tr_tile(P.in[7], 128, 64, (bf16_t*)(ws + WS_WCV2), 0, it, 0, sf); continue; } it -= N_TR8;
        if (it < N_TRG) { const int mat = it >> 5, r = it & 31; tr_tile(P.in[29] + (size_t)mat * 1024 * 128, 1024, 128, (bf16_t*)(ws + WS_WGU) + (size_t)mat * 256 * 1024, 2, r >> 1, r & 1, sf); continue; } it -= N_TRG;
        if (it < N_TRU) { const int mat = it >> 5, r = it & 31; tr_tile(P.in[30] + (size_t)mat * 1024 * 128, 1024, 128, (bf16_t*)(ws + WS_WGU) + (size_t)mat * 256 * 1024, 3, r >> 1, r & 1, sf); continue; } it -= N_TRU;
        if (it < N_TRD) { const int mat = it >> 5, r = it & 31; tr_tile(P.in[31] + (size_t)mat * 128 * 1024, 128, 1024, (bf16_t*)(ws + WS_WDN) + (size_t)mat * 1024 * 128, 0, r >> 4, r & 15, sf); continue; } it -= N_TRD;
        if (it < N_X) {
            const float* x = P.in[0]; bf16_t* xb = (bf16_t*)(ws + WS_ACTB);
#pragma unroll
            for (int i = 0; i < 4; ++i) {
                const size_t idx = (size_t)it * 8192 + i * 2048 + tid * 8;
                const float4 a = *(const float4*)(x + idx), b = *(const float4*)(x + idx + 4);
                *(uint4*)(xb + idx) = make_uint4(pk2(a.x, a.y), pk2(a.z, a.w), pk2(b.x, b.y), pk2(b.z, b.w));
            }
            continue;
        } it -= N_X;
        if (it < N_ROPE) {
            const int e = it * 256 + tid, pos = e >> 5, i = e & 31;
            const float inv = 1.0f / powf(10000.0f, (float)(2 * i) / 64.0f);
            const float ang = (float)pos * inv;
            ((float*)(ws + WS_ROPE))[e] = (float)cos((double)ang);
            ((float*)(ws + WS_ROPE))[4096 * 32 + e] = (float)sin((double)ang);
            continue;
        } it -= N_ROPE;
        if (it < N_CB) {
            const int kv = it >> 3, j0 = (it & 7) * 16, j = j0 + (tid & 15), sl = tid >> 4;
            const float* pe = P.in[kv ? 3 : 2]; const float* w1 = P.in[kv ? 6 : 4];
            float a = 0.f;
            for (int i = sl * 128; i < sl * 128 + 128; ++i) a += pe[i] * w1[(size_t)i * 128 + j];
            sf[tid] = a; __syncthreads();
            if (tid < 16) { float t = 0.f; for (int q = 0; q < 16; ++q) t += sf[q * 16 + tid]; ((float*)(ws + WS_CBIAS))[kv * 128 + j0 + tid] = t; }
            __syncthreads();
            continue;
        } it -= N_CB;
        if (it < N_AL) {
            const int e = it * 256 + tid, g = e >> 6, p = e & 63;
            const CF a = s5_apow(P, g, p, 32.f);
            ((float*)(ws + WS_S5AL))[e * 2] = a.re; ((float*)(ws + WS_S5AL))[e * 2 + 1] = a.im;
            continue;
        } it -= N_AL;
        if (it < N_BTE) {
            const int e = it * 256 + tid, g = e >> 11, p = (e >> 5) & 63, r = e & 31;
            const CF w = cmul(s5_apow(P, g, p, (float)(31 - r)), s5_f(P, g, p));
            bf16_t* d = (bf16_t*)(ws + WS_BTE) + (size_t)g * 128 * 512;
#pragma unroll
            for (int c = 0; c < 16; ++c) {
                const CF bb = {P.in[11][(g * 64 + p) * 16 + c], P.in[12][(g * 64 + p) * 16 + c]};
                const CF v = cmul(w, bb);
                d[(size_t)p * 512 + r * 16 + c] = f2bf(v.re);
                d[(size_t)(64 + p) * 512 + r * 16 + c] = f2bf(v.im);
            }
            continue;
        } it -= N_BTE;
        if (it < N_BTYM) {
            const int g = it / 63, dd = it % 63 - 31, ch = tid >> 4, c = tid & 15;
            float val = 0.f;
            if (dd >= 0) {
                for (int p = 0; p < 64; ++p) {
                    const CF bb = {P.in[11][(g * 64 + p) * 16 + c], P.in[12][(g * 64 + p) * 16 + c]};
                    const CF cc = {P.in[13][(g * 16 + ch) * 64 + p], P.in[14][(g * 16 + ch) * 64 + p]};
                    const CF v = cmul(cc, cmul(s5_apow(P, g, p, (float)dd), cmul(s5_f(P, g, p), bb)));
                    val += v.re;
                }
            }
            bf16_t* d = (bf16_t*)(ws + WS_BTY) + (size_t)g * 512 * 640;
            const bf16_t hv = f2bf(val);
            for (int r = 0; r < 32; ++r) { const int s = r + dd; if (s >= 0 && s < 32) d[(size_t)(s * 16 + ch) * 640 + r * 16 + c] = hv; }
            continue;
        } it -= N_BTYM;
        if (it < N_BTYQ) {
            const int e = it * 256 + tid, g = e >> 15, s = (e >> 10) & 31, ch = (e >> 6) & 15, p = e & 63;
            const CF cc = {P.in[13][(g * 16 + ch) * 64 + p], P.in[14][(g * 16 + ch) * 64 + p]};
            const CF w = cmul(cc, s5_apow(P, g, p, (float)(s + 1)));
            bf16_t* d = (bf16_t*)(ws + WS_BTY) + ((size_t)g * 512 + s * 16 + ch) * 640 + 512;
            d[p] = f2bf(w.re); d[64 + p] = f2bf(-w.im);
            continue;
        } it -= N_BTYQ;
        {
            uint4* d = (uint4*)((bf16_t*)(ws + WS_WIN0) + (size_t)(1304 + it * 8) * 1024);
#pragma unroll
            for (int i = 0; i < 4; ++i) d[i * 256 + tid] = make_uint4(0, 0, 0, 0);
        }
    }
}

DI void phase_inproj0(const Params& P, unsigned char* smem) {
    unsigned char* ws = P.ws;
    const bf16_t* A = (const bf16_t*)(ws + WS_ACTB);
    const float* cosT = (const float*)(ws + WS_ROPE);
    const float* sinT = cosT + 4096 * 32;
    constexpr int NTN = NIN0 / 128;
    for (int it = blockIdx.x; it < (NT / 128) * NTN; it += gridDim.x) {
        const int mt = it / NTN, nt = it % NTN, m0 = mt * 128;
        auto rowptr = [=](int r) { return A + (size_t)(m0 + r) * 1024; };
        auto epi = [=](f32x4 (&acc)[4][4], int wr, int wc, int lane) {
            const int u64 = nt * 2 + wc, fr = lane & 15, fq = lane >> 4;
#pragma unroll
            for (int m = 0; m < 4; ++m)
#pragma unroll
                for (int j = 0; j < 4; ++j) {
                    const int t = m0 + wr * 64 + m * 16 + fq * 4 + j, s = t & 4095, b = t >> 12;
                    if (u64 < 20) {
                        const bool isq = u64 < 8;
                        const int which = (u64 - 8) >> 1, g = (u64 - 8) & 1;
                        const bool rope = isq || ((which & 1) == 0);
                        bf16_t* dst = isq ? (bf16_t*)(ws + XP_Q0) + (size_t)t * 512 + u64 * 64
                                          : (bf16_t*)(ws + XP_KC + (size_t)which * KVSZ) + ((size_t)(b * 2 + g) * 4096 + s) * 64;
#pragma unroll
                        for (int n = 0; n < 2; ++n) {
                            const int i = n * 16 + fr;
                            float x1 = acc[m][n][j], x2 = acc[m][n + 2][j];
                            if (rope) { const float c = cosT[s * 32 + i], sn = sinT[s * 32 + i]; const float o1 = x1 * c - x2 * sn, o2 = x1 * sn + x2 * c; x1 = o1; x2 = o2; }
                            dst[i] = f2bf(x1); dst[i + 32] = f2bf(x2);
                        }
                    } else if (u64 == 20) {
#pragma unroll
                        for (int n = 0; n < 2; ++n) { const int c = n * 16 + fr; if (c < 24) ((float*)(ws + XP_GATES))[(size_t)t * 24 + c] = sigmoidf_(acc[m][n][j]); }
                    } else if (u64 >= 22) {
#pragma unroll
                        for (int n = 0; n < 4; ++n) {
                            const int g5 = (u64 - 22) * 4 + n;
                            ((bf16_t*)(ws + XP_AEXT))[((size_t)g5 * 1024 + (t >> 5)) * 640 + (t & 31) * 16 + fr] = f2bf(acc[m][n][j]);
                        }
                    }
                }
        };
        gemm128(rowptr, (const bf16_t*)(ws + WS_WIN0) + (size_t)nt * 128 * 1024, 1024, 1024, smem, epi);
    }
}

DI void phase_cmp_s5e(const Params& P, unsigned char* smem) {
    unsigned char* ws = P.ws;
    const int tid = threadIdx.x, lane = tid & 63, wave = tid >> 6;
    for (int it = blockIdx.x; it < 64 + 256; it += gridDim.x) {
        if (it < 64) {
            const int kv = it >> 5, bg = (it >> 1) & 15, mt = it & 1;
            const bf16_t* src = (const bf16_t*)(ws + XP_KC + (size_t)kv * KVSZ) + (size_t)bg * 4096 * 64;
            const float* cb = (const float*)(ws + WS_CBIAS) + kv * 128;
            bf16_t* sH = (bf16_t*)smem;
            auto rowptr = [=](int r) { int rr = mt * 128 + r; rr = rr > 254 ? 254 : rr; return src + (size_t)rr * 1024; };
            auto epi = [=](f32x4 (&acc)[4][4], int wr, int wc, int ln) {
                const int fr = ln & 15, fq = ln >> 4;
#pragma unroll
                for (int m = 0; m < 4; ++m)
#pragma unroll
                    for (int n = 0; n < 4; ++n)
#pragma unroll
                        for (int j = 0; j < 4; ++j) {
                            const int r = wr * 64 + m * 16 + fq * 4 + j, c = wc * 64 + n * 16 + fr;
                            sH[r * 136 + c] = f2bf(gelu_tanh(acc[m][n][j] + cb[c]));
                        }
            };
            gemm128(rowptr, (const bf16_t*)(ws + (kv ? WS_WCV1 : WS_WCK1)), 2048, 2048, smem, epi);
            __syncthreads();
            const bf16_t* W2 = (const bf16_t*)(ws + (kv ? WS_WCV2 : WS_WCK2));
            f32x4 a2[2][4];
#pragma unroll
            for (int m = 0; m < 2; ++m)
#pragma unroll
                for (int n = 0; n < 4; ++n) a2[m][n] = (f32x4){0.f, 0.f, 0.f, 0.f};
#pragma unroll
            for (int ks = 0; ks < 4; ++ks) {
                bf16x8 af[2], bfr[4];
#pragma unroll
                for (int m = 0; m < 2; ++m) af[m] = *(const bf16x8*)(sH + (wave * 32 + m * 16 + (lane & 15)) * 136 + ks * 32 + (lane >> 4) * 8);
#pragma unroll
                for (int n = 0; n < 4; ++n) bfr[n] = *(const bf16x8*)(W2 + (n * 16 + (lane & 15)) * 128 + ks * 32 + (lane >> 4) * 8);
#pragma unroll
                for (int m = 0; m < 2; ++m)
#pragma unroll
                    for (int n = 0; n < 4; ++n) a2[m][n] = __builtin_amdgcn_mfma_f32_16x16x32_bf16(af[m], bfr[n], a2[m][n], 0, 0, 0);
            }
            bf16_t* dst = (bf16_t*)(ws + (kv ? WS_VCMP : WS_KCMP)) + (size_t)bg * 256 * 64;
#pragma unroll
            for (int m = 0; m < 2; ++m)
#pragma unroll
                for (int n = 0; n < 4; ++n)
#pragma unroll
                    for (int j = 0; j < 4; ++j) {
                        const int row = mt * 128 + wave * 32 + m * 16 + (lane >> 4) * 4 + j, col = n * 16 + (lane & 15);
                        dst[row * 64 + col] = row < 255 ? f2bf(a2[m][n][j]) : (bf16_t)0;
                    }
            __syncthreads();
        } else {
            const int it2 = it - 64, g = it2 >> 3, b = it2 & 7;
            bf16_t* aext = (bf16_t*)(ws + XP_AEXT) + ((size_t)g * 1024 + b * 128) * 640;
            float* sE = (float*)smem;
            auto rowptr = [=](int r) { return (const bf16_t*)aext + (size_t)r * 640; };
            auto epi = [=](f32x4 (&acc)[4][4], int wr, int wc, int ln) {
                const int fr = ln & 15, fq = ln >> 4;
#pragma unroll
                for (int m = 0; m < 4; ++m)
#pragma unroll
                    for (int n = 0; n < 4; ++n)
#pragma unroll
                        for (int j = 0; j < 4; ++j) sE[(wr * 64 + m * 16 + fq * 4 + j) * 129 + wc * 64 + n * 16 + fr] = acc[m][n][j];
            };
            gemm128(rowptr, (const bf16_t*)(ws + WS_BTE) + (size_t)g * 128 * 512, 512, 512, smem, epi);
            __syncthreads();
            if (tid < 64) {
                const float ar = ((const float*)(ws + WS_S5AL))[(g * 64 + tid) * 2], ai = ((const float*)(ws + WS_S5AL))[(g * 64 + tid) * 2 + 1];
                float xr = 0.f, xi = 0.f;
                for (int c = 0; c < 128; ++c) {
                    aext[(size_t)c * 640 + 512 + tid] = f2bf(xr);
                    aext[(size_t)c * 640 + 576 + tid] = f2bf(xi);
                    const float er = sE[c * 129 + tid], ei = sE[c * 129 + 64 + tid];
                    const float nr = ar * xr - ai * xi + er, ni = ar * xi + ai * xr + ei;
                    xr = nr; xi = ni;
                }
            }
            __syncthreads();
        }
    }
}

template <int NH>
DI void dot_rows(const bf16_t* __restrict__ krow, const float* qf  , float (&out)[NH]) {
#pragma unroll
    for (int h = 0; h < NH; ++h) out[h] = 0.f;
#pragma unroll
    for (int c = 0; c < 8; ++c) {
        const uint4 kk = *(const uint4*)(krow + c * 8);
        float kf[8];
        kf[0] = __uint_as_float(kk.x << 16); kf[1] = __uint_as_float(kk.x & 0xffff0000u);
        kf[2] = __uint_as_float(kk.y << 16); kf[3] = __uint_as_float(kk.y & 0xffff0000u);
        kf[4] = __uint_as_float(kk.z << 16); kf[5] = __uint_as_float(kk.z & 0xffff0000u);
        kf[6] = __uint_as_float(kk.w << 16); kf[7] = __uint_as_float(kk.w & 0xffff0000u);
#pragma unroll
        for (int h = 0; h < NH; ++h) {
            const float4 q0 = *(const float4*)(qf + h * 64 + c * 8), q1 = *(const float4*)(qf + h * 64 + c * 8 + 4);
            out[h] += kf[0] * q0.x + kf[1] * q0.y + kf[2] * q0.z + kf[3] * q0.w + kf[4] * q1.x + kf[5] * q1.y + kf[6] * q1.z + kf[7] * q1.w;
        }
    }
}

constexpr int NSA_WLDS = 4 * 64 * 4 + 512 * 4 * 4 + 256 * 4 + 64 * 4;
DI void nsa_item(const Params& P, unsigned char* wl, int bgs) {
    unsigned char* ws = P.ws;
    const int lane = threadIdx.x & 63;
    float* qf = (float*)wl;
    float* pb = qf + 256;
    float* pn = pb + 2048;
    float* scs = pn + 256;
    const int s = bgs & 4095, g = (bgs >> 12) & 1, b = bgs >> 13, bg = b * 2 + g, t = b * 4096 + s;
    const bf16_t* Q = (const bf16_t*)(ws + XP_Q0) + (size_t)t * 512 + g * 256;
#pragma unroll
    for (int h = 0; h < 4; ++h) qf[h * 64 + lane] = bf2f(Q[h * 64 + lane]) * 0.125f;
    __builtin_amdgcn_wave_barrier();
    const float NEG = -INFINITY;
    float oc[4] = {0.f, 0.f, 0.f, 0.f}, osel[4] = {0.f, 0.f, 0.f, 0.f}, ow[4] = {0.f, 0.f, 0.f, 0.f};
    const int nc = s >= 31 ? ((s - 31) >> 4) + 1 : 0;
    {
        const bf16_t* KC = (const bf16_t*)(ws + WS_KCMP) + (size_t)bg * 256 * 64;
        const bf16_t* VC = (const bf16_t*)(ws + WS_VCMP) + (size_t)bg * 256 * 64;
        float sc[4][4];
#pragma unroll
        for (int bt = 0; bt < 4; ++bt) {
            const int n = bt * 64 + lane;
            float d[4] = {NEG, NEG, NEG, NEG};
            if (bt * 64 < nc) { float dd[4]; dot_rows<4>(KC + (size_t)n * 64, qf, dd); if (n < nc) { d[0] = dd[0]; d[1] = dd[1]; d[2] = dd[2]; d[3] = dd[3]; } }
#pragma unroll
            for (int h = 0; h < 4; ++h) sc[h][bt] = d[h];
        }
        float psum[4] = {0.f, 0.f, 0.f, 0.f};
#pragma unroll
        for (int h = 0; h < 4; ++h) {
            float m = wave_max(fmaxf(fmaxf(sc[h][0], sc[h][1]), fmaxf(sc[h][2], sc[h][3])));
            if (m == NEG) m = 0.f;
            float e[4], l = 0.f;
#pragma unroll
            for (int bt = 0; bt < 4; ++bt) { e[bt] = (sc[h][bt] == NEG) ? 0.f : __expf(sc[h][bt] - m); l += e[bt]; }
            l = wave_sum(l);
            const float inv = 1.f / fmaxf(l, 1e-30f);
#pragma unroll
            for (int bt = 0; bt < 4; ++bt) { const float p = e[bt] * inv; pb[(bt * 64 + lane) * 4 + h] = p; psum[bt] += p; }
        }
#pragma unroll
        for (int bt = 0; bt < 4; ++bt) pn[bt * 64 + lane] = psum[bt];
        __builtin_amdgcn_wave_barrier();
        for (int n = 0; n < nc; ++n) {
            const float v = bf2f(VC[(size_t)n * 64 + lane]);
            const float4 p = *(const float4*)(pb + n * 4);
            oc[0] += p.x * v; oc[1] += p.y * v; oc[2] += p.z * v; oc[3] += p.w * v;
        }
    }
    const int qblk = s >> 6;
    unsigned long long selmask;
    {
        const int j = lane;
        float imp = pn[4 * j] + pn[4 * j + 1] + pn[4 * j + 2];
        if (4 * j + 3 < 255) imp += 0.5f * pn[4 * j + 3];
        if (j > 0) imp += 0.5f * pn[4 * j - 1];
        float score = (j > qblk) ? -1.f : ((j == 0 || j == qblk || j == qblk - 1) ? 1e3f : imp);
        scs[j] = score;
        __builtin_amdgcn_wave_barrier();
        int rank = 0;
        for (int jj = 0; jj < 64; ++jj) { const float o = scs[jj]; rank += (o > score || (o == score && jj < j)) ? 1 : 0; }
        selmask = __ballot(rank < 8 && score >= 0.f);
    }
    __builtin_amdgcn_wave_barrier();
    {
        const bf16_t* KS = (const bf16_t*)(ws + XP_KC + 2 * KVSZ) + (size_t)bg * 4096 * 64;
        const bf16_t* VS = (const bf16_t*)(ws + XP_KC + 3 * KVSZ) + (size_t)bg * 4096 * 64;
        float sc[4][8];
        unsigned long long mm = selmask;
#pragma unroll
        for (int i = 0; i < 8; ++i) {
            float d[4] = {NEG, NEG, NEG, NEG};
            if (mm) {
                const int j = __builtin_ctzll(mm); mm &= mm - 1;
                const int key = j * 64 + lane;
                float dd[4]; dot_rows<4>(KS + (size_t)key * 64, qf, dd);
                if (key <= s) { d[0] = dd[0]; d[1] = dd[1]; d[2] = dd[2]; d[3] = dd[3]; }
            }
#pragma unroll
            for (int h = 0; h < 4; ++h) sc[h][i] = d[h];
        }
#pragma unroll
        for (int h = 0; h < 4; ++h) {
            float m = sc[h][0];
#pragma unroll
            for (int i = 1; i < 8; ++i) m = fmaxf(m, sc[h][i]);
            m = wave_max(m);
            if (m == NEG) m = 0.f;
            float e[8], l = 0.f;
#pragma unroll
            for (int i = 0; i < 8; ++i) { e[i] = (sc[h][i] == NEG) ? 0.f : __expf(sc[h][i] - m); l += e[i]; }
            l = wave_sum(l);
            const float inv = 1.f / fmaxf(l, 1e-30f);
#pragma unroll
            for (int i = 0; i < 8; ++i) pb[(i * 64 + lane) * 4 + h] = e[i] * inv;
        }
        __builtin_amdgcn_wave_barrier();
        mm = selmask;
        for (int i = 0; mm; ++i) {
            const int j = __builtin_ctzll(mm); mm &= mm - 1;
            for (int kk = 0; kk < 64; ++kk) {
                const float v = bf2f(VS[(size_t)(j * 64 + kk) * 64 + lane]);
                const float4 p = *(const float4*)(pb + (i * 64 + kk) * 4);
                osel[0] += p.x * v; osel[1] += p.y * v; osel[2] += p.z * v; osel[3] += p.w * v;
            }
        }
    }
    __builtin_amdgcn_wave_barrier();
    {
        const bf16_t* KW = (const bf16_t*)(ws + XP_KC + 4 * KVSZ) + (size_t)bg * 4096 * 64;
        const bf16_t* VW = (const bf16_t*)(ws + XP_KC + 5 * KVSZ) + (size_t)bg * 4096 * 64;
        float sc[4][4];
#pragma unroll
        for (int bt = 0; bt < 4; ++bt) {
            const int key = s - 255 + bt * 64 + lane;
            float d[4] = {NEG, NEG, NEG, NEG};
            if (s - 255 + bt * 64 + 63 >= 0) {
                const int kc = key < 0 ? 0 : key;
                float dd[4]; dot_rows<4>(KW + (size_t)kc * 64, qf, dd);
                if (key >= 0) { d[0] = dd[0]; d[1] = dd[1]; d[2] = dd[2]; d[3] = dd[3]; }
            }
#pragma unroll
            for (int h = 0; h < 4; ++h) sc[h][bt] = d[h];
        }
#pragma unroll
        for (int h = 0; h < 4; ++h) {
            float m = wave_max(fmaxf(fmaxf(sc[h][0], sc[h][1]), fmaxf(sc[h][2], sc[h][3])));
            if (m == NEG) m = 0.f;
            float e[4], l = 0.f;
#pragma unroll
            for (int bt = 0; bt < 4; ++bt) { e[bt] = (sc[h][bt] == NEG) ? 0.f : __expf(sc[h][bt] - m); l += e[bt]; }
            l = wave_sum(l);
            const float inv = 1.f / fmaxf(l, 1e-30f);
#pragma unroll
            for (int bt = 0; bt < 4; ++bt) pb[(bt * 64 + lane) * 4 + h] = e[bt] * inv;
        }
        __builtin_amdgcn_wave_barrier();
        const int k0 = s - 255 < 0 ? 0 : s - 255;
        for (int key = k0; key <= s; ++key) {
            const float v = bf2f(VW[(size_t)key * 64 + lane]);
            const float4 p = *(const float4*)(pb + (key - (s - 255)) * 4);
            ow[0] += p.x * v; ow[1] += p.y * v; ow[2] += p.z * v; ow[3] += p.w * v;
        }
    }
    __builtin_amdgcn_wave_barrier();
    const float* gt = (const float*)(ws + XP_GATES) + (size_t)t * 24 + g * 12;
    bf16_t* o = (bf16_t*)(ws + WS_MIX) + (size_t)t * 1024 + g * 256;
#pragma unroll
    for (int h = 0; h < 4; ++h) o[h * 64 + lane] = f2bf(gt[h * 3] * oc[h] + gt[h * 3 + 1] * osel[h] + gt[h * 3 + 2] * ow[h]);
}

DI void phase_s5y(const Params& P, unsigned char* smem) {
    unsigned char* ws = P.ws;
    constexpr int N_S5Y = 32 * 8 * 4;
    for (int it = blockIdx.x; it < N_S5Y; it += gridDim.x) {
        const int g = it >> 5, mt = (it >> 2) & 7, nt = it & 3;
        const bf16_t* aext = (const bf16_t*)(ws + XP_AEXT) + (size_t)g * 1024 * 640;
        const float* dsk = P.in[15];
        auto rowptr = [=](int r) { return aext + (size_t)(mt * 128 + r) * 640; };
        auto epi = [=](f32x4 (&acc)[4][4], int wr, int wc, int ln) {
            const int fr = ln & 15, fq = ln >> 4;
#pragma unroll
            for (int m = 0; m < 4; ++m) {
#pragma unroll
                for (int n = 0; n < 4; ++n)
#pragma unroll
                    for (int j = 0; j < 4; ++j) {
                        const int cr = mt * 128 + wr * 64 + m * 16 + fq * 4 + j, sp = nt * 8 + wc * 4 + n, t = cr * 32 + sp, chan = g * 16 + fr;
                        const float u = bf2f(aext[(size_t)cr * 640 + sp * 16 + fr]);
                        ((bf16_t*)(ws + XP_G5))[(size_t)t * 512 + chan] = f2bf(gelu_tanh(acc[m][n][j] + dsk[chan] * u));
                    }
                asm volatile("" ::: "memory");
            }
        };
        gemm128(rowptr, (const bf16_t*)(ws + WS_BTY) + ((size_t)g * 512 + nt * 128) * 640, 640, 640, smem, epi);
    }
}
DI void phase_nsa(const Params& P, unsigned char* smem) {
    const int wave = threadIdx.x >> 6;
    constexpr int N_NSA = NB * 2 * SEQ / 4;
    for (int it = blockIdx.x; it < N_NSA; it += gridDim.x) nsa_item(P, smem + wave * NSA_WLDS, it * 4 + wave);
}

DI void phase_glu(const Params& P, unsigned char* smem) {
    unsigned char* ws = P.ws;
    const bf16_t* G5 = (const bf16_t*)(ws + XP_G5);
    const float* gb = P.in[17];
    for (int it = blockIdx.x; it < (NT / 128) * 4; it += gridDim.x) {
        const int mt = it >> 2, nt = it & 3, m0 = mt * 128;
        auto rowptr = [=](int r) { return G5 + (size_t)(m0 + r) * 512; };
        auto epi = [=](f32x4 (&acc)[4][4], int wr, int wc, int ln) {
            const int fr = ln & 15, fq = ln >> 4;
#pragma unroll
            for (int m = 0; m < 4; ++m) {
#pragma unroll
                for (int n = 0; n < 4; ++n)
#pragma unroll
                    for (int j = 0; j < 4; ++j) {
                        const int row = m0 + wr * 64 + m * 16 + fq * 4 + j, col = nt * 128 + wc * 64 + n * 16 + fr;
                        const float gv = bf2f(G5[(size_t)row * 512 + col]);
                        ((bf16_t*)(ws + WS_MIX))[(size_t)row * 1024 + 512 + col] = f2bf(gv * sigmoidf_(acc[m][n][j] + gb[col]));
                    }
                asm volatile("" ::: "memory");
            }
        };
        gemm128(rowptr, (const bf16_t*)(ws + WS_WGLU) + (size_t)nt * 128 * 512, 512, 512, smem, epi);
    }
}

DI void phase_outproj(const Params& P, unsigned char* smem, const float* xres, size_t wt_off) {
    unsigned char* ws = P.ws;
    const bf16_t* A = (const bf16_t*)(ws + WS_MIX);
    float* out = P.out;
    for (int it = blockIdx.x; it < (NT / 128) * 8; it += gridDim.x) {
        const int mt = it >> 3, nt = it & 7, m0 = mt * 128;
        auto rowptr = [=](int r) { return A + (size_t)(m0 + r) * 1024; };
        auto epi = [=](f32x4 (&acc)[4][4], int wr, int wc, int ln) {
            const int fr = ln & 15, fq = ln >> 4;
#pragma unroll
            for (int m = 0; m < 4; ++m) {
#pragma unroll
                for (int n = 0; n < 4; ++n)
#pragma unroll
                    for (int j = 0; j < 4; ++j) {
                        const size_t idx = (size_t)(m0 + wr * 64 + m * 16 + fq * 4 + j) * 1024 + nt * 128 + wc * 64 + n * 16 + fr;
                        out[idx] = ALPHA * xres[idx] + acc[m][n][j];
                    }
                asm volatile("" ::: "memory");
            }
        };
        gemm128(rowptr, (const bf16_t*)(ws + wt_off) + (size_t)nt * 128 * 1024, 1024, 1024, smem, epi);
    }
}

DI void ln_row(float (&v)[16], const float* __restrict__ g, const float* __restrict__ bta, int lane) {
    float s = 0.f;
#pragma unroll
    for (int i = 0; i < 16; ++i) s += v[i];
    const float mu = wave_sum(s) * (1.f / 1024.f);
    float q = 0.f;
#pragma unroll
    for (int i = 0; i < 16; ++i) { v[i] -= mu; q += v[i] * v[i]; }
    const float rstd = rsqrtf(wave_sum(q) * (1.f / 1024.f) + LN_EPS);
#pragma unroll
    for (int j = 0; j < 4; ++j) {
        const float4 gg = *(const float4*)(g + 4 * lane + 256 * j), bb = *(const float4*)(bta + 4 * lane + 256 * j);
        v[4 * j + 0] = v[4 * j + 0] * rstd * gg.x + bb.x; v[4 * j + 1] = v[4 * j + 1] * rstd * gg.y + bb.y;
        v[4 * j + 2] = v[4 * j + 2] * rstd * gg.z + bb.z; v[4 * j + 3] = v[4 * j + 3] * rstd * gg.w + bb.w;
    }
}

DI void phase_ln_router(const Params& P, int layer) {
    unsigned char* ws = P.ws;
    const int lane = threadIdx.x & 63, wave = threadIdx.x >> 6;
    const float* g = P.in[21] + layer * 1024; const float* bta = P.in[22] + layer * 1024;
    const float* wc = P.in[25] + (size_t)layer * 1024 * 4; const float* bc = P.in[26] + layer * 4;
    const float* wf = P.in[27] + (size_t)layer * 4 * 1024 * 8; const float* bfn = P.in[28] + layer * 32;
    int* cnt = (int*)(ws + WS_CTL) + layer * 32;
    int* list = (int*)(ws + WS_LIST);
    float* wgt = (float*)(ws + WS_WGT);
    bf16_t* xb = (bf16_t*)(ws + WS_ACTB);
    for (int it = blockIdx.x; it < NT / 4; it += gridDim.x) {
        const int t = it * 4 + wave;
        float* row = P.out + (size_t)t * 1024;
        float v[16];
#pragma unroll
        for (int j = 0; j < 4; ++j) { const float4 a = *(const float4*)(row + 4 * lane + 256 * j); v[4 * j] = a.x; v[4 * j + 1] = a.y; v[4 * j + 2] = a.z; v[4 * j + 3] = a.w; }
        ln_row(v, g, bta, lane);
#pragma unroll
        for (int j = 0; j < 4; ++j) {
            *(float4*)(row + 4 * lane + 256 * j) = make_float4(v[4 * j], v[4 * j + 1], v[4 * j + 2], v[4 * j + 3]);
            *(uint2*)(xb + (size_t)t * 1024 + 4 * lane + 256 * j) = make_uint2(pk2(v[4 * j], v[4 * j + 1]), pk2(v[4 * j + 2], v[4 * j + 3]));
        }
        float lc[4] = {0.f, 0.f, 0.f, 0.f};
#pragma unroll
        for (int j = 0; j < 4; ++j)
#pragma unroll
            for (int i = 0; i < 4; ++i) {
                const float4 w = *(const float4*)(wc + (size_t)(4 * lane + 256 * j + i) * 4);
                const float x = v[4 * j + i];
                lc[0] += x * w.x; lc[1] += x * w.y; lc[2] += x * w.z; lc[3] += x * w.w;
            }
#pragma unroll
        for (int c = 0; c < 4; ++c) lc[c] = wave_sum(lc[c]) + bc[c];
        int gi = 0; float lm = lc[0];
#pragma unroll
        for (int c = 1; c < 4; ++c) if (lc[c] > lm) { lm = lc[c]; gi = c; }
        float den = 0.f;
#pragma unroll
        for (int c = 0; c < 4; ++c) den += expf(lc[c] - lm);
        const float gv = 1.f / den;
        float lf[8] = {0.f, 0.f, 0.f, 0.f, 0.f, 0.f, 0.f, 0.f};
        const float* wfg = wf + (size_t)gi * 1024 * 8;
#pragma unroll
        for (int j = 0; j < 4; ++j)
#pragma unroll
            for (int i = 0; i < 4; ++i) {
                const float4 w0 = *(const float4*)(wfg + (size_t)(4 * lane + 256 * j + i) * 8), w1 = *(const float4*)(wfg + (size_t)(4 * lane + 256 * j + i) * 8 + 4);
                const float x = v[4 * j + i];
                lf[0] += x * w0.x; lf[1] += x * w0.y; lf[2] += x * w0.z; lf[3] += x * w0.w;
                lf[4] += x * w1.x; lf[5] += x * w1.y; lf[6] += x * w1.z; lf[7] += x * w1.w;
            }
#pragma unroll
        for (int e = 0; e < 8; ++e) lf[e] = wave_sum(lf[e]) + bfn[gi * 8 + e];
        int e1 = 0; float l1 = lf[0];
#pragma unroll
        for (int e = 1; e < 8; ++e) if (lf[e] > l1) { l1 = lf[e]; e1 = e; }
        int e2 = -1; float l2 = -INFINITY;
#pragma unroll
        for (int e = 0; e < 8; ++e) if (e != e1 && lf[e] > l2) { l2 = lf[e]; e2 = e; }
        const float r = expf(l2 - l1);
        const float w1 = gv / (1.f + r), w2 = gv * r / (1.f + r);
        if (lane == 0) {
            const int ea = gi * 8 + e1, eb = gi * 8 + e2;
            const int pa = atomicAdd(&cnt[ea], 1); list[ea * 32768 + pa] = t * 2;     wgt[t * 2] = w1;
            const int pb = atomicAdd(&cnt[eb], 1); list[eb * 32768 + pb] = t * 2 + 1; wgt[t * 2 + 1] = w2;
        }
    }
}

DI bool moe_tile(const int* cnt, int tile, int& e, int& mt, int& off, int& ce) {
    int acc_t = 0, acc_r = 0;
    for (int i = 0; i < 32; ++i) {
        const int c = cnt[i], nt = (c + 127) >> 7;
        if (tile < acc_t + nt) { e = i; mt = tile - acc_t; off = acc_r; ce = c; return true; }
        acc_t += nt; acc_r += c;
    }
    return false;
}
DI int moe_ntiles(const int* cnt) { int a = 0; for (int i = 0; i < 32; ++i) a += (cnt[i] + 127) >> 7; return a; }

DI void phase_moe_gu(const Params& P, unsigned char* smem, int layer) {
    unsigned char* ws = P.ws;
    const int* cnt = (const int*)(ws + WS_CTL) + layer * 32;
    const int* list = (const int*)(ws + WS_LIST);
    const float* wgt = (const float*)(ws + WS_WGT);
    const bf16_t* xb = (const bf16_t*)(ws + WS_ACTB);
    bf16_t* H = (bf16_t*)(ws + XP_H);
    const int ntile = moe_ntiles(cnt);
    for (int it = blockIdx.x; it < ntile * 2; it += gridDim.x) {
        int e, mt, off, ce; moe_tile(cnt, it >> 1, e, mt, off, ce);
        const int nt = it & 1;
        const int* le = list + e * 32768;
        auto rowptr = [=](int r) { int pos = mt * 128 + r; pos = pos < ce ? pos : 0; return xb + (size_t)(le[pos] >> 1) * 1024; };
        auto epi = [=](f32x4 (&acc)[4][4], int wr, int wc, int ln) {
            const int fr = ln & 15, fq = ln >> 4;
#pragma unroll
            for (int m = 0; m < 4; ++m)
#pragma unroll
                for (int j = 0; j < 4; ++j) {
                    const int pos = mt * 128 + wr * 64 + m * 16 + fq * 4 + j;
                    if (pos < ce) {
                        const float w = wgt[le[pos]];
#pragma unroll
                        for (int n = 0; n < 2; ++n) {
                            const float gte = acc[m][n][j], up = acc[m][n + 2][j];
                            H[(size_t)(off + pos) * 128 + (nt * 2 + wc) * 32 + n * 16 + fr] = f2bf(gte * sigmoidf_(gte) * up * w);
                        }
                    }
                }
        };
        gemm128(rowptr, (const bf16_t*)(ws + WS_WGU) + ((size_t)(layer * 32 + e) * 256 + nt * 128) * 1024, 1024, 1024, smem, epi);
    }
}
DI void phase_moe_down(const Params& P, unsigned char* smem, int layer) {
    unsigned char* ws = P.ws;
    const int* cnt = (const int*)(ws + WS_CTL) + layer * 32;
    const int* list = (const int*)(ws + WS_LIST);
    const bf16_t* H = (const bf16_t*)(ws + XP_H);
    bf16_t* YB = (bf16_t*)(ws + XP_YB);
    const int ntile = moe_ntiles(cnt);
    for (int it = blockIdx.x; it < ntile * 8; it += gridDim.x) {
        int e, mt, off, ce; moe_tile(cnt, it >> 3, e, mt, off, ce);
        const int nt = it & 7;
        const int* le = list + e * 32768;
        auto rowptr = [=](int r) { int pos = mt * 128 + r; pos = pos < ce ? pos : 0; return H + (size_t)(off + pos) * 128; };
        auto epi = [=](f32x4 (&acc)[4][4], int wr, int wc, int ln) {
            const int fr = ln & 15, fq = ln >> 4;
#pragma unroll
            for (int m = 0; m < 4; ++m)
#pragma unroll
                for (int j = 0; j < 4; ++j) {
                    const int pos = mt * 128 + wr * 64 + m * 16 + fq * 4 + j;
                    if (pos < ce) {
                        bf16_t* dst = YB + (size_t)le[pos] * 1024 + nt * 128 + wc * 64 + fr;
#pragma unroll
                        for (int n = 0; n < 4; ++n) dst[n * 16] = f2bf(acc[m][n][j]);
                    }
                }
        };
        gemm128(rowptr, (const bf16_t*)(ws + WS_WDN) + ((size_t)(layer * 32 + e) * 1024 + nt * 128) * 128, 128, 128, smem, epi);
    }
}
DI void phase_ln_ffn(const Params& P, int layer) {
    unsigned char* ws = P.ws;
    const int lane = threadIdx.x & 63, wave = threadIdx.x >> 6;
    const float* g = P.in[23] + layer * 1024; const float* bta = P.in[24] + layer * 1024;
    const bf16_t* YB = (const bf16_t*)(ws + XP_YB);
    bf16_t* xb = (bf16_t*)(ws + WS_ACTB);
    for (int it = blockIdx.x; it < NT / 4; it += gridDim.x) {
        const int t = it * 4 + wave;
        float* row = P.out + (size_t)t * 1024;
        float v[16];
#pragma unroll
        for (int j = 0; j < 4; ++j) {
            const float4 a = *(const float4*)(row + 4 * lane + 256 * j);
            const uint2 y0 = *(const uint2*)(YB + (size_t)(2 * t) * 1024 + 4 * lane + 256 * j), y1 = *(const uint2*)(YB + (size_t)(2 * t + 1) * 1024 + 4 * lane + 256 * j);
            v[4 * j + 0] = ALPHA * a.x + (__uint_as_float(y0.x << 16) + __uint_as_float(y1.x << 16));
            v[4 * j + 1] = ALPHA * a.y + (__uint_as_float(y0.x & 0xffff0000u) + __uint_as_float(y1.x & 0xffff0000u));
            v[4 * j + 2] = ALPHA * a.z + (__uint_as_float(y0.y << 16) + __uint_as_float(y1.y << 16));
            v[4 * j + 3] = ALPHA * a.w + (__uint_as_float(y0.y & 0xffff0000u) + __uint_as_float(y1.y & 0xffff0000u));
        }
        ln_row(v, g, bta, lane);
#pragma unroll
        for (int j = 0; j < 4; ++j) {
            *(float4*)(row + 4 * lane + 256 * j) = make_float4(v[4 * j], v[4 * j + 1], v[4 * j + 2], v[4 * j + 3]);
            if (layer == 0) *(uint2*)(xb + (size_t)t * 1024 + 4 * lane + 256 * j) = make_uint2(pk2(v[4 * j], v[4 * j + 1]), pk2(v[4 * j + 2], v[4 * j + 3]));
        }
    }
}

DI void phase_inproj1(const Params& P, unsigned char* smem) {
    unsigned char* ws = P.ws;
    const bf16_t* A = (const bf16_t*)(ws + WS_ACTB);
    const float* cosT = (const float*)(ws + WS_ROPE);
    const float* sinT = cosT + 4096 * 32;
    for (int it = blockIdx.x; it < (NT / 128) * 24; it += gridDim.x) {
        const int mt = it / 24, nt = it % 24, m0 = mt * 128;
        auto rowptr = [=](int r) { return A + (size_t)(m0 + r) * 1024; };
        auto epi = [=](f32x4 (&acc)[4][4], int wr, int wc, int lane) {
            const int u64 = nt * 2 + wc, kind = u64 >> 4, head = u64 & 15, fr = lane & 15, fq = lane >> 4;
#pragma unroll
            for (int m = 0; m < 4; ++m)
#pragma unroll
                for (int j = 0; j < 4; ++j) {
                    const int t = m0 + wr * 64 + m * 16 + fq * 4 + j, s = t & 4095, b = t >> 12;
                    bf16_t* dst = (bf16_t*)(ws + XP_Q1 + (size_t)kind * 64 * MiB) + ((size_t)(b * 16 + head) * 4096 + s) * 64;
#pragma unroll
                    for (int n = 0; n < 2; ++n) {
                        const int i = n * 16 + fr;
                        float x1 = acc[m][n][j], x2 = acc[m][n + 2][j];
                        if (kind < 2) { const float c = cosT[s * 32 + i], sn = sinT[s * 32 + i]; const float o1 = x1 * c - x2 * sn, o2 = x1 * sn + x2 * c; x1 = o1; x2 = o2; }
                        dst[i] = f2bf(x1); dst[i + 32] = f2bf(x2);
                    }
                }
        };
        gemm128(rowptr, (const bf16_t*)(ws + WS_WIN1) + (size_t)nt * 128 * 1024, 1024, 1024, smem, epi);
    }
}
DI void phase_kmean(const Params& P) {
    unsigned char* ws = P.ws;
    const bf16_t* K1 = (const bf16_t*)(ws + XP_Q1 + 64 * MiB);
    float* km = (float*)(ws + WS_KMEAN);
    for (int it = blockIdx.x; it < 512; it += gridDim.x) {
        const int e = it * 256 + threadIdx.x, d = e & 63, n = (e >> 6) & 15, bh = e >> 10;
        const bf16_t* src = K1 + ((size_t)bh * 4096 + n * 256) * 64 + d;
        float a = 0.f;
        for (int i = 0; i < 256; ++i) a += bf2f(src[(size_t)i * 64]);
        km[e] = a * (1.f / 256.f);
    }
}
constexpr int MOBA_WLDS = 64 * 4 + 1024 * 4;
DI void moba_item(const Params& P, unsigned char* wl, int bhs) {
    unsigned char* ws = P.ws;
    const int lane = threadIdx.x & 63;
    float* qf = (float*)wl;
    float* pb = qf + 64;
    const int s = bhs & 4095, bh = bhs >> 12, b = bh >> 4, h = bh & 15, t = b * 4096 + s;
    const bf16_t* Q = (const bf16_t*)(ws + XP_Q1) + ((size_t)bh * 4096 + s) * 64;
    const bf16_t* K = (const bf16_t*)(ws + XP_Q1 + 64 * MiB) + (size_t)bh * 4096 * 64;
    const bf16_t* V = (const bf16_t*)(ws + XP_Q1 + 128 * MiB) + (size_t)bh * 4096 * 64;
    const float* km = (const float*)(ws + WS_KMEAN) + (size_t)bh * 16 * 64;
    qf[lane] = bf2f(Q[lane]);
    __builtin_amdgcn_wave_barrier();
    const int own = s >> 8;
    const float NEG = -INFINITY;
    float gs = NEG;
    if (lane < own) { float a = 0.f; for (int d = 0; d < 64; ++d) a += qf[d] * km[lane * 64 + d]; gs = a; }
    int rank = 0;
#pragma unroll
    for (int n = 0; n < 16; ++n) { const float o = __shfl(gs, n); rank += (o > gs || (o == gs && n < lane)) ? 1 : 0; }
    unsigned long long selm = __ballot(lane < own && rank < 3);
    int blk[4]; int nblk = 1; blk[0] = own; blk[1] = 0; blk[2] = 0; blk[3] = 0;
#pragma unroll
    for (int i = 1; i < 4; ++i) if (selm) { blk[i] = __builtin_ctzll(selm); selm &= selm - 1; nblk = i + 1; }
    float sc[16];
#pragma unroll
    for (int i = 0; i < 4; ++i)
#pragma unroll
        for (int bt = 0; bt < 4; ++bt) {
            float d = NEG;
            const int key = blk[i] * 256 + bt * 64 + lane;
            if (i < nblk && (i > 0 || blk[0] * 256 + bt * 64 <= s)) {
                float dd[1]; dot_rows<1>(K + (size_t)key * 64, qf, dd);
                if (i > 0 || key <= s) d = dd[0] * 0.125f;
            }
            sc[i * 4 + bt] = d;
        }
    float m = sc[0];
#pragma unroll
    for (int i = 1; i < 16; ++i) m = fmaxf(m, sc[i]);
    m = wave_max(m);
    float l = 0.f;
#pragma unroll
    for (int i = 0; i < 16; ++i) { sc[i] = (sc[i] == NEG) ? 0.f : __expf(sc[i] - m); l += sc[i]; }
    l = wave_sum(l);
    const float inv = 1.f / fmaxf(l, 1e-30f);
#pragma unroll
    for (int i = 0; i < 16; ++i) pb[i * 64 + lane] = sc[i] * inv;
    __builtin_amdgcn_wave_barrier();
    float o = 0.f;
#pragma unroll
    for (int i = 0; i < 4; ++i) {
        if (i < nblk) {
            const int kend = (i == 0) ? (s - own * 256 + 1) : 256;
            const bf16_t* vb = V + (size_t)blk[i] * 256 * 64 + lane;
            for (int kk = 0; kk < kend; ++kk) o += pb[i * 256 + kk] * bf2f(vb[(size_t)kk * 64]);
        }
    }
    __builtin_amdgcn_wave_barrier();
    ((bf16_t*)(ws + WS_MIX))[(size_t)t * 1024 + h * 64 + lane] = f2bf(o);
}
DI void phase_moba(const Params& P, unsigned char* smem) {
    const int wave = threadIdx.x >> 6;
    for (int it = blockIdx.x; it < NB * 16 * SEQ / 4; it += gridDim.x) moba_item(P, smem + wave * MOBA_WLDS, it * 4 + wave);
}

constexpr int SMEM_BYTES = 128 * 129 * 4;
DI void run_phase(const Params& P, unsigned char* smem, int ph) {
    switch (ph) {
        case 0: phase0(P, smem); break;
        case 1: phase_inproj0(P, smem); break;
        case 2: phase_cmp_s5e(P, smem); break;
        case 3: phase_s5y(P, smem); break;
        case 4: phase_nsa(P, smem); break;
        case 5: phase_glu(P, smem); break;
        case 6: phase_outproj(P, smem, P.in[0], WS_WOUT0); break;
        case 7: phase_ln_router(P, 0); break;
        case 8: phase_moe_gu(P, smem, 0); break;
        case 9: phase_moe_down(P, smem, 0); break;
        case 10: phase_ln_ffn(P, 0); break;
        case 11: phase_inproj1(P, smem); break;
        case 12: phase_kmean(P); break;
        case 13: phase_moba(P, smem); break;
        case 14: phase_outproj(P, smem, P.out, WS_WOUT1); break;
        case 15: phase_ln_router(P, 1); break;
        case 16: phase_moe_gu(P, smem, 1); break;
        case 17: phase_moe_down(P, smem, 1); break;
        case 18: phase_ln_ffn(P, 1); break;
    }
}
template <int PH> __global__ void __launch_bounds__(256, (PH == 4 || PH == 5) ? 1 : 2) phase_kernel(Params P) {
    __shared__ __attribute__((aligned(16))) unsigned char smem[SMEM_BYTES];
    run_phase(P, smem, PH);
}
template <int PH> static void launch_phase(const Params& p, int grid, hipStream_t stream) { hipLaunchKernelGGL(phase_kernel<PH>, dim3(grid), dim3(256), 0, stream, p); }

#if MK_ONE_LAUNCH
__global__ void __launch_bounds__(256, 2) mega(Params P) {
    __shared__ __attribute__((aligned(16))) unsigned char smem[SMEM_BYTES];
    cg::grid_group grid = cg::this_grid();
    for (int ph = P.ph_lo; ph < P.ph_hi; ++ph) {
        run_phase(P, smem, ph);
        if (ph + 1 < P.ph_hi) grid.sync();
    }
}
#endif

extern "C" void kernel_launch(void* const* d_in, const int* in_sizes, int n_in, void* d_out, int out_size, void* d_ws, size_t ws_size, hipStream_t stream) {
    static int grid = 0;
    if (grid == 0) {
        if (n_in != 32 || out_size != NT * DM || ws_size < WS_END) { fprintf(stderr, "kernel_launch: unexpected shapes (n_in %d, out %d, ws %zu)\n", n_in, out_size, ws_size); grid = -1; return; }
        int dev = 0, cus = 0, per_cu = 0;
        (void)hipGetDevice(&dev);
        (void)hipDeviceGetAttribute(&cus, hipDeviceAttributeMultiprocessorCount, dev);
#if MK_ONE_LAUNCH
        (void)hipOccupancyMaxActiveBlocksPerMultiprocessor(&per_cu, mega, 256, 0);
#else
        per_cu = 2;
#endif
        if (per_cu < 1) per_cu = 1;
        if (per_cu > 2) per_cu = 2;
        grid = cus * per_cu;
    }
    if (grid < 0) return;
    (void)hipMemsetAsync((char*)d_ws + WS_CTL, 0, 4096, stream);
    Params p{};
    for (int i = 0; i < 32; ++i) p.in[i] = (const float*)d_in[i];
    p.out = (float*)d_out; p.ws = (unsigned char*)d_ws;
#if MK_ONE_LAUNCH
    p.ph_lo = 0; p.ph_hi = NPH;
    void* args[] = {&p};
    hipError_t e = hipLaunchCooperativeKernel((void*)mega, dim3(grid), dim3(256), args, 0, stream);
    if (e != hipSuccess) fprintf(stderr, "cooperative launch failed: %s (grid %d)\n", hipGetErrorString(e), grid);
#else
    p.ph_lo = 0; p.ph_hi = 1;
    launch_phase<0>(p, grid, stream); launch_phase<1>(p, grid, stream); launch_phase<2>(p, grid, stream); launch_phase<3>(p, grid, stream);
    launch_phase<4>(p, grid, stream); launch_phase<5>(p, grid, stream); launch_phase<6>(p, grid, stream); launch_phase<7>(p, grid, stream);
    launch_phase<8>(p, grid, stream); launch_phase<9>(p, grid, stream); launch_phase<10>(p, grid, stream); launch_phase<11>(p, grid, stream);
    launch_phase<12>(p, grid, stream); launch_phase<13>(p, grid, stream); launch_phase<14>(p, grid, stream); launch_phase<15>(p, grid, stream);
    launch_phase<16>(p, grid, stream); launch_phase<17>(p, grid, stream); launch_phase<18>(p, grid, stream);
#endif
}
```

```cpp
#include <hip/hip_runtime.h>
#include <hip/hip_cooperative_groups.h>
#include <cstdio>
#include <cstdint>
namespace cg = cooperative_groups;

typedef unsigned short bf16_t;
typedef short bf16x8 __attribute__((ext_vector_type(8)));
typedef float f32x4 __attribute__((ext_vector_type(4)));
typedef unsigned u32x4 __attribute__((ext_vector_type(4)));
typedef unsigned u32x2 __attribute__((ext_vector_type(2)));
#define DI __device__ __forceinline__
#define LAS __attribute__((address_space(3)))
typedef float f32x16 __attribute__((ext_vector_type(16)));
typedef float f32x8 __attribute__((ext_vector_type(8)));
typedef __bf16 bf16x8v __attribute__((ext_vector_type(8)));
typedef __bf16 bf16x4v __attribute__((ext_vector_type(4)));
#define MFMA32(a, b, c) __builtin_amdgcn_mfma_f32_32x32x16_bf16((a), (b), (c), 0, 0, 0)

constexpr int NB = 8, SEQ = 4096, DM = 1024, NT = NB * SEQ;
constexpr float ALPHA = 1.41421356237f;
constexpr float LN_EPS = 1e-5f;
constexpr int NIN0 = 1920;
constexpr int NPH = 21;

constexpr size_t MiB = 1u << 20;
constexpr size_t WS_CTL = 0;
constexpr size_t WS_ROPE = 1 * MiB;
constexpr size_t WS_WIN0 = 2 * MiB;
constexpr size_t WS_WOUT0 = 6 * MiB;
constexpr size_t WS_WIN1 = 8 * MiB;
constexpr size_t WS_WOUT1 = 14 * MiB;
constexpr size_t WS_WGLU = 16 * MiB;
constexpr size_t WS_WCK1 = 16 * MiB + 512 * 1024;
constexpr size_t WS_WCV1 = 17 * MiB;
constexpr size_t WS_WCK2 = 17 * MiB + 512 * 1024;
constexpr size_t WS_WCV2 = WS_WCK2 + 16384;
constexpr size_t WS_CBIAS = WS_WCV2 + 16384;
constexpr size_t WS_S5AL = WS_CBIAS + 4096;
constexpr size_t WS_RTRW = 17 * MiB + 640 * 1024;
constexpr size_t WS_BTE = 18 * MiB;
constexpr size_t WS_BTY = 22 * MiB;
constexpr size_t WS_WGU = 42 * MiB;
constexpr size_t WS_WDN = 74 * MiB;
constexpr size_t WS_KMP = 90 * MiB;
constexpr size_t WS_WGT = 94 * MiB;
constexpr size_t WS_KMEAN = 94 * MiB + 512 * 1024;
constexpr size_t WS_KCMP = 95 * MiB;
constexpr size_t WS_VCMP = 95 * MiB + 512 * 1024;
constexpr size_t WS_ACTB = 96 * MiB;
constexpr size_t WS_MIX = 160 * MiB;
constexpr size_t WS_XP = 224 * MiB;
constexpr size_t WS_LIST2 = 416 * MiB;
constexpr size_t WS_SELM = 92 * MiB;
constexpr size_t WS_MCNT = 93 * MiB;
constexpr size_t WS_MLIST = WS_LIST2;
constexpr size_t WS_PO2 = 424 * MiB;
constexpr size_t WS_PML = 488 * MiB;
constexpr size_t WS_END = 504 * MiB;
constexpr size_t XP_Q0 = WS_XP;
constexpr size_t XP_KC = WS_XP + 32 * MiB;
constexpr size_t KVSZ = 8 * MiB;
constexpr size_t XP_GATES = WS_XP + 80 * MiB;
constexpr size_t XP_AEXT = WS_XP + 84 * MiB;
constexpr size_t XP_G5 = WS_XP + 124 * MiB;
constexpr size_t XP_YB = WS_XP;
constexpr size_t XP_H = WS_XP + 128 * MiB;
constexpr size_t XP_Q1 = WS_XP;

struct Params {
    const float* in[32];
    float* out;
    unsigned char* ws;
    int ph_lo, ph_hi;
};

DI bf16_t f2bf(float f) { unsigned u = __float_as_uint(f); return (bf16_t)((u + 0x7fffu + ((u >> 16) & 1u)) >> 16); }
DI float bf2f(bf16_t h) { return __uint_as_float(((unsigned)h) << 16); }
DI unsigned pk2(float lo, float hi) { return (unsigned)f2bf(lo) | ((unsigned)f2bf(hi) << 16); }
DI bf16x8 cvt8(f32x8 v) { return __builtin_bit_cast(bf16x8, __builtin_convertvector(v, bf16x8v)); }
DI u32x2 cvt4(f32x4 v) { return __builtin_bit_cast(u32x2, __builtin_convertvector(v, bf16x4v)); }
DI size_t kp_off(int key, int d) { return ((size_t)((key >> 5) * 4 + (d >> 4)) * 32 + (key & 31)) * 16 + (d & 15); }
DI int vp_pos(int ko) { return 8 * ((ko >> 2) & 1) + 4 * (ko >> 3) + (ko & 3); }
DI size_t vp_off(int key, int d) { return ((size_t)(key >> 4) * 64 + d) * 16 + vp_pos(key & 15); }
DI bf16_t ld_bf(const bf16_t* p) { return *p; }
DI f32x4 bf4_to_f(u32x2 w) { return (f32x4){__uint_as_float(w.x << 16), __uint_as_float(w.x & 0xffff0000u), __uint_as_float(w.y << 16), __uint_as_float(w.y & 0xffff0000u)}; }
template <int CTRL> DI float dpp_f(float v) { return __builtin_bit_cast(float, __builtin_amdgcn_update_dpp(0, __builtin_bit_cast(int, v), CTRL, 0xF, 0xF, true)); }
DI float wave_sum(float v) {
    v += dpp_f<0xB1>(v);
    v += dpp_f<0x4E>(v);
    v += dpp_f<0x141>(v);
    v += dpp_f<0x140>(v);
    { const auto s = __builtin_amdgcn_permlane16_swap(__float_as_uint(v), __float_as_uint(v), false, false); v = __uint_as_float(s[0]) + __uint_as_float(s[1]); }
    { const auto s = __builtin_amdgcn_permlane32_swap(__float_as_uint(v), __float_as_uint(v), false, false); v = __uint_as_float(s[0]) + __uint_as_float(s[1]); }
    return v;
}
DI float wave_max(float v) {
#pragma unroll
    for (int o = 32; o > 0; o >>= 1) v = fmaxf(v, __shfl_xor(v, o));
    return v;
}
DI float sigmoidf_(float x) { return __builtin_amdgcn_rcpf(1.f + __expf(-x)); }
DI float gelu_tanh(float x) { const float z = 0.7978845608028654f * (x + 0.044715f * x * x * x); return x * sigmoidf_(2.f * z); }

constexpr int GEMM_LDS = 65536;
template <bool TRANS = true, class RowPtr, class Epi>
DI void gemm128(RowPtr rowptr, const bf16_t* __restrict__ Bt, int ldb, int K, unsigned char* smem, Epi epi, int kskip_lo = 0, int kskip_hi = 0) {
    LAS unsigned char* lds = (LAS unsigned char*)smem;
    const int tid = threadIdx.x, lane = tid & 63, wave = tid >> 6, wr = wave >> 1, wc = wave & 1, fr = lane & 15, fq = lane >> 4;
    const int schunk = ((tid & 7) ^ ((tid >> 4) & 7)) * 8;
    const bf16_t* ga[4];
#pragma unroll
    for (int i = 0; i < 4; ++i) ga[i] = rowptr(i * 32 + (tid >> 3)) + schunk;
    const bf16_t* gb = Bt + (size_t)(tid >> 3) * ldb + schunk;
    const size_t gbs = (size_t)32 * ldb;
    auto stage = [&](int kt, int s) {
#pragma unroll
        for (int i = 0; i < 4; ++i) {
            __builtin_amdgcn_global_load_lds((const unsigned*)(ga[i] + kt * 64), (LAS unsigned*)(lds + s * 32768 + (i * 256 + tid) * 16), 16, 0, 0);
            __builtin_amdgcn_global_load_lds((const unsigned*)(gb + i * gbs + kt * 64), (LAS unsigned*)(lds + s * 32768 + 16384 + (i * 256 + tid) * 16), 16, 0, 0);
        }
    };
    f32x4 acc[4][4];
#pragma unroll
    for (int m = 0; m < 4; ++m)
#pragma unroll
        for (int n = 0; n < 4; ++n) acc[m][n] = (f32x4){0.f, 0.f, 0.f, 0.f};
    const int nskip = kskip_hi - kskip_lo, nk = (K >> 6) - nskip;
    const int swz = (fr >> 1) & 7;
    const int aoff = (wr * 64 + fr) * 128, boff = 16384 + (wc * 64 + fr) * 128;
    stage(kskip_lo == 0 ? nskip : 0, 0);
#pragma unroll 1
    for (int kt = 0; kt < nk; ++kt) {
        asm volatile("s_waitcnt vmcnt(0)" ::: "memory");
        __syncthreads();
        if (kt + 1 < nk) stage(kt + 1 < kskip_lo ? kt + 1 : kt + 1 + nskip, (kt + 1) & 1);
        const LAS unsigned char* cur = lds + (kt & 1) * 32768;
#pragma unroll
        for (int ks = 0; ks < 2; ++ks) {
            bf16x8 af[4], bfr[4];
            const int co = ((ks * 4 + fq) ^ swz) * 16;
#pragma unroll
            for (int m = 0; m < 4; ++m) af[m] = *(const LAS bf16x8*)(cur + aoff + m * 2048 + co);
#pragma unroll
            for (int n = 0; n < 4; ++n) bfr[n] = *(const LAS bf16x8*)(cur + boff + n * 2048 + co);
#pragma unroll
            for (int m = 0; m < 4; ++m)
#pragma unroll
                for (int n = 0; n < 4; ++n) acc[m][n] = TRANS ? __builtin_amdgcn_mfma_f32_16x16x32_bf16(bfr[n], af[m], acc[m][n], 0, 0, 0) : __builtin_amdgcn_mfma_f32_16x16x32_bf16(af[m], bfr[n], acc[m][n], 0, 0, 0);
        }
    }
    __syncthreads();
    epi(acc, wr, wc, lane);
}

DI int vblock() { const int G = gridDim.x; return (G & 7) == 0 ? (int)(blockIdx.x & 7) * (G >> 3) + (int)(blockIdx.x >> 3) : (int)blockIdx.x; }
DI void tile_mn(int it, int nN, int& mt, int& nt) { const int per = 8 * nN, grp = it / per, idx = it - grp * per; nt = idx >> 3; mt = grp * 8 + (idx & 7); }

DI int rope_pos(int l) { return (l & ~63) + ((2 * ((l & 31) >> 4) + ((l >> 5) & 1)) << 4) + (l & 15); }
DI int rowmap(int kind, int n) {
    if (kind == 1) {
        if (n < 512 || (n >= 512 && n < 640) || (n >= 768 && n < 896) || (n >= 1024 && n < 1152)) return rope_pos(n);
        return n < 1304 ? n : n + 104;
    }
    if (kind == 4) return n < 2048 ? rope_pos(n) : n;
    if (kind == 2) return ((n >> 5) << 6) + (n & 31);
    if (kind == 3) return ((n >> 5) << 6) + 32 + (n & 31);
    return n;
}
DI void tr_tile(const float* __restrict__ src, int K, int N, bf16_t* __restrict__ dst, int kind, int kt, int nt, float* s) {
    const int tid = threadIdx.x, k0 = kt * 64, n0 = nt * 64;
    {
        const int nn = tid & 63, kq = tid >> 6, n = n0 + nn;
#pragma unroll
        for (int i = 0; i < 16; ++i) { const int kk = kq + 4 * i; s[kk * 65 + nn] = (n < N) ? __builtin_nontemporal_load(src + (size_t)(k0 + kk) * N + n) : 0.f; }
    }
    __syncthreads();
    {
        const int rn = tid >> 2, kseg = (tid & 3) * 16, n = n0 + rn;
        if (n < N) {
            unsigned w[8];
#pragma unroll
            for (int i = 0; i < 8; ++i) w[i] = pk2(s[(kseg + 2 * i) * 65 + rn], s[(kseg + 2 * i + 1) * 65 + rn]);
            bf16_t* d = dst + (size_t)rowmap(kind, n) * K + k0 + kseg;
            *(uint4*)d = make_uint4(w[0], w[1], w[2], w[3]);
            *(uint4*)(d + 8) = make_uint4(w[4], w[5], w[6], w[7]);
        }
    }
    __syncthreads();
}
struct CF { float re, im; };
DI CF cmul(CF a, CF b) { return {a.re * b.re - a.im * b.im, a.re * b.im + a.im * b.re}; }
DI CF s5_apow(const Params& P, int g, int p, float tau) {
    const float step = expf(P.in[10][g]);
    const float lr = P.in[8][g * 64 + p], li = P.in[9][g * 64 + p];
    const float mag = expf(lr * step * tau);
    float sn, cs; sincosf(li * step * tau, &sn, &cs);
    return {mag * cs, mag * sn};
}
DI CF s5_f(const Params& P, int g, int p) {
    const CF a = s5_apow(P, g, p, 1.f);
    const float lr = P.in[8][g * 64 + p], li = P.in[9][g * 64 + p];
    const float den = lr * lr + li * li;
    return {((a.re - 1.f) * lr + a.im * li) / den, (a.im * lr - (a.re - 1.f) * li) / den};
}
DI void phase0(const Params& P, unsigned char* smem) {
    const int tid = threadIdx.x;
    unsigned char* ws = P.ws;
    float* sf = (float*)smem;
    constexpr int N_TR0 = 16 * 29, N_TR1 = 256, N_TR2 = 16 * 48, N_TR3 = 256, N_TR4 = 64, N_TR5 = 64, N_TR6 = 64, N_TR7 = 2, N_TR8 = 2;
    constexpr int N_TRG = 64 * 32, N_TRU = 64 * 32, N_TRD = 64 * 32;
    constexpr int N_X = NT * DM / 8192, N_ROPE = 512, N_CB = 16, N_AL = 8, N_BTE = 256, N_BTYM = 32 * 63, N_BTYQ = 4096, N_ZP = 13;
    constexpr int N_RW = 2 * 36864 / 256;
    constexpr int TOTAL = N_RW + N_TR0 + N_TR1 + N_TR4 + N_TR5 + N_TR6 + N_TR7 + N_TR8 + N_X + N_ROPE + N_CB + N_AL + N_BTE + N_BTYM + N_BTYQ + N_ZP;
    for (int it0 = blockIdx.x; it0 < TOTAL; it0 += gridDim.x) {
        int it = it0;
        if (it < N_RW) {
            const int e = it * 256 + tid, layer = e / 36864, r = e % 36864;
            float* dst = (float*)(ws + WS_RTRW) + (size_t)layer * 36864;
            if (r < 4096) { const int o = r & 3, l = (r >> 2) & 63, jk = r >> 8, d = 4 * l + 256 * (jk >> 2) + (jk & 3); dst[r] = P.in[25][((size_t)layer * 1024 + d) * 4 + o]; }
            else { const int q = r - 4096, o = q & 3, l = (q >> 2) & 63, hf = (q >> 8) & 1, jk = (q >> 9) & 15, g = q >> 13, d = 4 * l + 256 * (jk >> 2) + (jk & 3);
                   dst[r] = P.in[27][(((size_t)layer * 4 + g) * 1024 + d) * 8 + hf * 4 + o]; }
            continue;
        } it -= N_RW;
        if (it < N_TR0) { tr_tile(P.in[1], 1024, 1816, (bf16_t*)(ws + WS_WIN0), 1, it / 29, it % 29, sf); continue; } it -= N_TR0;
        if (it < N_TR1) { tr_tile(P.in[18], 1024, 1024, (bf16_t*)(ws + WS_WOUT0), 0, it / 16, it % 16, sf); continue; } it -= N_TR1;
        if (it < N_TR4) { tr_tile(P.in[16], 512, 512, (bf16_t*)(ws + WS_WGLU), 0, it / 8, it % 8, sf); continue; } it -= N_TR4;
        if (it < N_TR5) { tr_tile(P.in[4], 2048, 128, (bf16_t*)(ws + WS_WCK1), 0, it / 2, it % 2, sf); continue; } it -= N_TR5;
        if (it < N_TR6) { tr_tile(P.in[6], 2048, 128, (bf16_t*)(ws + WS_WCV1), 0, it / 2, it % 2, sf); continue; } it -= N_TR6;
        if (it < N_TR7) { tr_tile(P.in[5], 128, 64, (bf16_t*)(ws + WS_WCK2), 0, it, 0, sf); continue; } it -= N_TR7;
        if (it < N_TR8) { tr_tile(P.in[7], 128, 64, (bf16_t*)(ws + WS_WCV2), 0, it, 0, sf); continue; } it -= N_TR8;
        if (it < N_X) {
            const float* x = P.in[0]; bf16_t* xb = (bf16_t*)(ws + WS_ACTB);
#pragma unroll
            for (int i = 0; i < 4; ++i) {
                const size_t idx = (size_t)it * 8192 + i * 2048 + tid * 8;
                const f32x4 a = __builtin_nontemporal_load((const f32x4*)(x + idx)), b = __builtin_nontemporal_load((const f32x4*)(x + idx + 4));
                *(uint4*)(xb + idx) = make_uint4(pk2(a.x, a.y), pk2(a.z, a.w), pk2(b.x, b.y), pk2(b.z, b.w));
            }
            continue;
        } it -= N_X;
        if (it < N_ROPE) {
            const int e = it * 256 + tid, pos = e >> 5, i = e & 31;
            const float inv = 1.0f / powf(10000.0f, (float)(2 * i) / 64.0f);
            const float ang = (float)pos * inv;
            ((float*)(ws + WS_ROPE))[e] = (float)cos((double)ang);
            ((float*)(ws + WS_ROPE))[4096 * 32 + e] = (float)sin((double)ang);
            continue;
        } it -= N_ROPE;
        if (it < N_CB) {
            const int kv = it >> 3, j0 = (it & 7) * 16, j = j0 + (tid & 15), sl = tid >> 4;
            const float* pe = P.in[kv ? 3 : 2]; const float* w1 = P.in[kv ? 6 : 4];
            float a = 0.f;
            for (int i = sl * 128; i < sl * 128 + 128; ++i) a += pe[i] * w1[(size_t)i * 128 + j];
            sf[tid] = a; __syncthreads();
            if (tid < 16) { float t = 0.f; for (int q = 0; q < 16; ++q) t += sf[q * 16 + tid]; ((float*)(ws + WS_CBIAS))[kv * 128 + j0 + tid] = t; }
            __syncthreads();
            continue;
        } it -= N_CB;
        if (it < N_AL) {
            const int e = it * 256 + tid, g = e >> 6, p = e & 63;
            const CF a = s5_apow(P, g, p, 32.f);
            ((float*)(ws + WS_S5AL))[e * 2] = a.re; ((float*)(ws + WS_S5AL))[e * 2 + 1] = a.im;
            continue;
        } it -= N_AL;
        if (it < N_BTE) {
            const int e = it * 256 + tid, g = e >> 11, p = (e >> 5) & 63, r = e & 31;
            const CF w = cmul(s5_apow(P, g, p, (float)(31 - r)), s5_f(P, g, p));
            bf16_t* d = (bf16_t*)(ws + WS_BTE) + (size_t)g * 128 * 512;
#pragma unroll
            for (int c = 0; c < 16; ++c) {
                const CF bb = {P.in[11][(g * 64 + p) * 16 + c], P.in[12][(g * 64 + p) * 16 + c]};
                const CF v = cmul(w, bb);
                d[(size_t)p * 512 + r * 16 + c] = f2bf(v.re);
                d[(size_t)(64 + p) * 512 + r * 16 + c] = f2bf(v.im);
            }
            continue;
        } it -= N_BTE;
        if (it < N_BTYM) {
            const int g = it / 63, dd = it % 63 - 31, ch = tid >> 4, c = tid & 15;
            float val = 0.f;
            if (dd >= 0) {
                float* sw = sf; float* sb = sf + 128; float* sc = sf + 128 + 2048;
                if (tid < 64) { const CF w = cmul(s5_apow(P, g, tid, (float)dd), s5_f(P, g, tid)); sw[2 * tid] = w.re; sw[2 * tid + 1] = w.im; }
#pragma unroll
                for (int i = 0; i < 4; ++i) {
                    const int e = tid + 256 * i;
                    sb[2 * e] = P.in[11][(size_t)g * 1024 + e]; sb[2 * e + 1] = P.in[12][(size_t)g * 1024 + e];
                    sc[2 * e] = P.in[13][(size_t)g * 1024 + e]; sc[2 * e + 1] = P.in[14][(size_t)g * 1024 + e];
                }
                __syncthreads();
#pragma unroll 8
                for (int p = 0; p < 64; ++p) {
                    const CF bb = {sb[2 * (p * 16 + c)], sb[2 * (p * 16 + c) + 1]};
                    const CF cc = {sc[2 * (ch * 64 + p)], sc[2 * (ch * 64 + p) + 1]};
                    const CF w = {sw[2 * p], sw[2 * p + 1]};
                    val += cmul(cc, cmul(w, bb)).re;
                }
                __syncthreads();
            }
            bf16_t* d = (bf16_t*)(ws + WS_BTY) + (size_t)g * 512 * 640;
            const bf16_t hv = f2bf(val);
            for (int r = 0; r < 32; ++r) { const int s = r + dd; if (s >= 0 && s < 32) d[(size_t)(s * 16 + ch) * 640 + r * 16 + c] = hv; }
            continue;
        } it -= N_BTYM;
        if (it < N_BTYQ) {
            const int e = it * 256 + tid, g = e >> 15, s = (e >> 10) & 31, ch = (e >> 6) & 15, p = e & 63;
            const CF cc = {P.in[13][(g * 16 + ch) * 64 + p], P.in[14][(g * 16 + ch) * 64 + p]};
            const CF w = cmul(cc, s5_apow(P, g, p, (float)(s + 1)));
            bf16_t* d = (bf16_t*)(ws + WS_BTY) + ((size_t)g * 512 + s * 16 + ch) * 640 + 512;
            d[p] = f2bf(w.re); d[64 + p] = f2bf(-w.im);
            continue;
        } it -= N_BTYQ;
        {
            uint4* d = (uint4*)((bf16_t*)(ws + WS_WIN0) + (size_t)(1304 + it * 8) * 1024);
#pragma unroll
            for (int i = 0; i < 4; ++i) d[i * 256 + tid] = make_uint4(0, 0, 0, 0);
        }
    }
}

DI void phase_inproj0(const Params& P, unsigned char* smem) {
    unsigned char* ws = P.ws;
    const bf16_t* A = (const bf16_t*)(ws + WS_ACTB);
    const float* cosT = (const float*)(ws + WS_ROPE);
    const float* sinT = cosT + 4096 * 32;
    constexpr int NTN = NIN0 / 128;
    for (int it = vblock(); it < (NT / 128) * NTN; it += gridDim.x) {
        int mt, nt; tile_mn(it, NTN, mt, nt);
        const int m0 = mt * 128;
        auto rowptr = [=](int r) { return A + (size_t)(m0 + r) * 1024; };
        const bf16_t* Bt = (const bf16_t*)(ws + WS_WIN0) + (size_t)nt * 128 * 1024;
        if (nt == 7 || nt == 9) {
            auto epi = [=](f32x4 (&acc)[4][4], int wr, int wc, int lane) {
                const int fr = lane & 15, fq = lane >> 4, which = nt == 7 ? 3 : 5, g = wc;
#pragma unroll
                for (int m = 0; m < 4; ++m) {
                    const int t = m0 + wr * 64 + m * 16 + fq * 4, s = t & 4095, b = t >> 12;
                    bf16_t* dst = (bf16_t*)(ws + XP_KC + (size_t)which * KVSZ) + (size_t)(b * 2 + g) * 4096 * 64;
#pragma unroll
                    for (int n = 0; n < 4; ++n) *(u32x2*)(dst + vp_off(s, n * 16 + fr)) = cvt4(acc[m][n]);
                }
            };
            gemm128<false>(rowptr, Bt, 1024, 1024, smem, epi);
            continue;
        }
        auto epi = [=](f32x4 (&acc)[4][4], int wr, int wc, int lane) {
            const int u64 = nt * 2 + wc, fr = lane & 15, fq = lane >> 4;
#pragma unroll
            for (int m = 0; m < 4; ++m) {
                const int t = m0 + wr * 64 + m * 16 + fr, s = t & 4095, b = t >> 12;
                if (u64 < 20) {
                    const bool isq = u64 < 8;
                    const int which = (u64 - 8) >> 1, g = (u64 - 8) & 1;
                    if (isq || ((which & 1) == 0)) {
#pragma unroll
                        for (int n2 = 0; n2 < 2; ++n2) {
                            const int i = n2 * 16 + fq * 4;
                            const f32x4 c = *(const f32x4*)(cosT + s * 32 + i), sn = *(const f32x4*)(sinT + s * 32 + i);
                            const f32x4 x1 = acc[m][2 * n2], x2 = acc[m][2 * n2 + 1];
                            const u32x2 o1 = cvt4(x1 * c - x2 * sn), o2 = cvt4(x1 * sn + x2 * c);
                            if (isq) { bf16_t* dst = (bf16_t*)(ws + XP_Q0) + (size_t)t * 512 + u64 * 64; *(u32x2*)(dst + i) = o1; *(u32x2*)(dst + i + 32) = o2; }
                            else {
                                bf16_t* dst = (bf16_t*)(ws + XP_KC + (size_t)which * KVSZ) + (size_t)(b * 2 + g) * 4096 * 64;
                                if (which == 0) { *(u32x2*)(dst + (size_t)s * 64 + i) = o1; *(u32x2*)(dst + (size_t)s * 64 + i + 32) = o2; }
                                else { *(u32x2*)(dst + kp_off(s, i)) = o1; *(u32x2*)(dst + kp_off(s, i + 32)) = o2; }
                            }
                        }
                    } else {
                        bf16_t* dst = (bf16_t*)(ws + XP_KC + (size_t)which * KVSZ) + ((size_t)(b * 2 + g) * 4096 + s) * 64;
#pragma unroll
                        for (int n = 0; n < 4; ++n) *(u32x2*)(dst + n * 16 + fq * 4) = cvt4(acc[m][n]);
                    }
                } else if (u64 == 20) {
#pragma unroll
                    for (int n = 0; n < 2; ++n) {
                        const int c0 = n * 16 + fq * 4;
                        if (c0 < 24) { f32x4 o; o.x = sigmoidf_(acc[m][n].x); o.y = sigmoidf_(acc[m][n].y); o.z = sigmoidf_(acc[m][n].z); o.w = sigmoidf_(acc[m][n].w); *(f32x4*)((float*)(ws + XP_GATES) + (size_t)t * 24 + c0) = o; }
                    }
                } else if (u64 >= 22) {
#pragma unroll
                    for (int n = 0; n < 4; ++n) {
                        const int g5 = (u64 - 22) * 4 + n;
                        *(u32x2*)((bf16_t*)(ws + XP_AEXT) + ((size_t)g5 * 1024 + (t >> 5)) * 640 + (t & 31) * 16 + fq * 4) = cvt4(acc[m][n]);
                    }
                }
            }
        };
        gemm128(rowptr, Bt, 1024, 1024, smem, epi);
    }
}

constexpr int N_LATE = 16 * 48 + 256 + 3 * 64 * 32;
DI void late_weights(const Params& P, unsigned char* smem, int it) {
    unsigned char* ws = P.ws;
    float* sf = (float*)smem;
    constexpr int N_TR2 = 16 * 48, N_TR3 = 256, N_TRG = 64 * 32, N_TRU = 64 * 32;
    if (it < N_TR2) { tr_tile(P.in[19], 1024, 3072, (bf16_t*)(ws + WS_WIN1), 4, it / 48, it % 48, sf); return; } it -= N_TR2;
    if (it < N_TR3) { tr_tile(P.in[20], 1024, 1024, (bf16_t*)(ws + WS_WOUT1), 0, it / 16, it % 16, sf); return; } it -= N_TR3;
    if (it < N_TRG) { const int mat = it >> 5, r = it & 31; tr_tile(P.in[29] + (size_t)mat * 1024 * 128, 1024, 128, (bf16_t*)(ws + WS_WGU) + (size_t)mat * 256 * 1024, 2, r >> 1, r & 1, sf); return; } it -= N_TRG;
    if (it < N_TRU) { const int mat = it >> 5, r = it & 31; tr_tile(P.in[30] + (size_t)mat * 1024 * 128, 1024, 128, (bf16_t*)(ws + WS_WGU) + (size_t)mat * 256 * 1024, 3, r >> 1, r & 1, sf); return; } it -= N_TRU;
    { const int mat = it >> 5, r = it & 31; tr_tile(P.in[31] + (size_t)mat * 128 * 1024, 128, 1024, (bf16_t*)(ws + WS_WDN) + (size_t)mat * 1024 * 128, 0, r >> 4, r & 15, sf); }
}

DI void phase_cmp_s5e(const Params& P, unsigned char* smem) {
    unsigned char* ws = P.ws;
    const int tid = threadIdx.x, lane = tid & 63, wave = tid >> 6;
    for (int it = blockIdx.x; it < 64 + 256 + N_LATE; it += gridDim.x) {
        if (it >= 64 + 256) { late_weights(P, smem, it - 320); continue; }
        if (it < 64) {
            const int kv = it >> 5, bg = (it >> 1) & 15, mt = it & 1;
            const bf16_t* src = (const bf16_t*)(ws + XP_KC + (size_t)kv * KVSZ) + (size_t)bg * 4096 * 64;
            const float* cb = (const float*)(ws + WS_CBIAS) + kv * 128;
            bf16_t* sH = (bf16_t*)smem;
            auto rowptr = [=](int r) { int rr = mt * 128 + r; rr = rr > 254 ? 254 : rr; return src + (size_t)rr * 1024; };
            auto epi = [=](f32x4 (&acc)[4][4], int wr, int wc, int ln) {
                const int fr = ln & 15, fq = ln >> 4;
#pragma unroll
                for (int m = 0; m < 4; ++m)
#pragma unroll
                    for (int n = 0; n < 4; ++n)
#pragma unroll
                        for (int j = 0; j < 4; ++j) {
                            const int r = wr * 64 + m * 16 + fr, c = wc * 64 + n * 16 + fq * 4 + j;
                            sH[r * 136 + c] = f2bf(gelu_tanh(acc[m][n][j] + cb[c]));
                        }
            };
            gemm128(rowptr, (const bf16_t*)(ws + (kv ? WS_WCV1 : WS_WCK1)), 2048, 2048, smem, epi);
            __syncthreads();
            const bf16_t* W2 = (const bf16_t*)(ws + (kv ? WS_WCV2 : WS_WCK2));
            f32x4 a2[2][4];
#pragma unroll
            for (int m = 0; m < 2; ++m)
#pragma unroll
                for (int n = 0; n < 4; ++n) a2[m][n] = (f32x4){0.f, 0.f, 0.f, 0.f};
#pragma unroll
            for (int ks = 0; ks < 4; ++ks) {
                bf16x8 af[2], bfr[4];
#pragma unroll
                for (int m = 0; m < 2; ++m) af[m] = *(const bf16x8*)(sH + (wave * 32 + m * 16 + (lane & 15)) * 136 + ks * 32 + (lane >> 4) * 8);
#pragma unroll
                for (int n = 0; n < 4; ++n) bfr[n] = *(const bf16x8*)(W2 + (n * 16 + (lane & 15)) * 128 + ks * 32 + (lane >> 4) * 8);
#pragma unroll
                for (int m = 0; m < 2; ++m)
#pragma unroll
                    for (int n = 0; n < 4; ++n) a2[m][n] = __builtin_amdgcn_mfma_f32_16x16x32_bf16(af[m], bfr[n], a2[m][n], 0, 0, 0);
            }
            bf16_t* dst = (bf16_t*)(ws + (kv ? WS_VCMP : WS_KCMP)) + (size_t)bg * 256 * 64;
#pragma unroll
            for (int m = 0; m < 2; ++m)
#pragma unroll
                for (int n = 0; n < 4; ++n)
#pragma unroll
                    for (int j = 0; j < 4; ++j) {
                        const int row = mt * 128 + wave * 32 + m * 16 + (lane >> 4) * 4 + j, col = n * 16 + (lane & 15);
                        dst[kv ? vp_off(row, col) : kp_off(row, col)] = row < 255 ? f2bf(a2[m][n][j]) : (bf16_t)0;
                    }
            __syncthreads();
        } else {
            const int it2 = it - 64, g = it2 >> 3, b = it2 & 7;
            bf16_t* aext = (bf16_t*)(ws + XP_AEXT) + ((size_t)g * 1024 + b * 128) * 640;
            float* sE = (float*)smem;
            auto rowptr = [=](int r) { return (const bf16_t*)aext + (size_t)r * 640; };
            auto epi = [=](f32x4 (&acc)[4][4], int wr, int wc, int ln) {
                const int fr = ln & 15, fq = ln >> 4;
#pragma unroll
                for (int m = 0; m < 4; ++m)
#pragma unroll
                    for (int n = 0; n < 4; ++n)
#pragma unroll
                        for (int j = 0; j < 4; ++j) sE[(wr * 64 + m * 16 + fr) * 129 + wc * 64 + n * 16 + fq * 4 + j] = acc[m][n][j];
            };
            gemm128(rowptr, (const bf16_t*)(ws + WS_BTE) + (size_t)g * 128 * 512, 512, 512, smem, epi);
            __syncthreads();
            if (tid < 64) {
                const float ar = ((const float*)(ws + WS_S5AL))[(g * 64 + tid) * 2], ai = ((const float*)(ws + WS_S5AL))[(g * 64 + tid) * 2 + 1];
                float xr = 0.f, xi = 0.f;
                for (int c = 0; c < 128; ++c) {
                    aext[(size_t)c * 640 + 512 + tid] = f2bf(xr);
                    aext[(size_t)c * 640 + 576 + tid] = f2bf(xi);
                    const float er = sE[c * 129 + tid], ei = sE[c * 129 + 64 + tid];
                    const float nr = ar * xr - ai * xi + er, ni = ar * xi + ai * xr + ei;
                    xr = nr; xi = ni;
                }
            }
            __syncthreads();
        }
    }
}

DI void phase_s5y(const Params& P, unsigned char* smem) {
    unsigned char* ws = P.ws;
    constexpr int N_S5Y = 32 * 8 * 4;
    for (int it = vblock(); it < N_S5Y; it += gridDim.x) {
        const int g = it >> 5, mt = (it >> 2) & 7, nt = it & 3;
        const bf16_t* aext = (const bf16_t*)(ws + XP_AEXT) + (size_t)g * 1024 * 640;
        const float* dsk = P.in[15];
        auto rowptr = [=](int r) { return aext + (size_t)(mt * 128 + r) * 640; };
        auto epi = [=](f32x4 (&acc)[4][4], int wr, int wc, int ln) {
            const int fr = ln & 15, fq = ln >> 4;
            const f32x4 dk = *(const f32x4*)(dsk + g * 16 + fq * 4);
#pragma unroll
            for (int m = 0; m < 4; ++m) {
                const int cr = mt * 128 + wr * 64 + m * 16 + fr;
#pragma unroll
                for (int n = 0; n < 4; ++n) {
                    const int sp = nt * 8 + wc * 4 + n, t = cr * 32 + sp;
                    const f32x4 u = bf4_to_f(*(const u32x2*)(aext + (size_t)cr * 640 + sp * 16 + fq * 4));
                    const f32x4 y = acc[m][n] + dk * u;
                    *(u32x2*)((bf16_t*)(ws + XP_G5) + (size_t)t * 512 + g * 16 + fq * 4) = cvt4((f32x4){gelu_tanh(y.x), gelu_tanh(y.y), gelu_tanh(y.z), gelu_tanh(y.w)});
                }
            }
        };
        gemm128(rowptr, (const bf16_t*)(ws + WS_BTY) + ((size_t)g * 512 + nt * 128) * 640, 640, 640, smem, epi, 2 * nt + 2, 8);
    }
}
struct FA { f32x16 o0, o1; float m, l; };
DI void fa_init(FA& st) {
#pragma unroll
    for (int i = 0; i < 16; ++i) { st.o0[i] = 0.f; st.o1[i] = 0.f; }
    st.m = -1e30f; st.l = 0.f;
}
constexpr float FA_THR = 8.f;
template <int MODE, class Valid>
DI void fa_tile(FA& st, const bf16x8 (&qf)[4], const LAS bf16_t* Kt, const LAS bf16_t* Vt, int r, int h, float c, bool rowok, Valid valid) {
    const LAS bf16_t* kb = Kt + r * 16 + 8 * h;
    const LAS bf16_t* vb = Vt + r * 16 + 8 * h;
    bf16x8 kf[4], vf[4];
#pragma unroll
    for (int ks = 0; ks < 4; ++ks) kf[ks] = *(const LAS bf16x8*)(kb + ks * 512);
#pragma unroll
    for (int sub = 0; sub < 2; ++sub) {
        f32x16 acc;
#pragma unroll
        for (int i = 0; i < 16; ++i) acc[i] = 0.f;
#pragma unroll
        for (int ks = 0; ks < 4; ++ks) acc = MFMA32(kf[ks], qf[ks], acc);
#pragma unroll
        for (int s2 = 0; s2 < 2; ++s2) { vf[2 * s2] = *(const LAS bf16x8*)(vb + ((sub * 2 + s2) * 64) * 16); vf[2 * s2 + 1] = *(const LAS bf16x8*)(vb + ((sub * 2 + s2) * 64 + 32) * 16); }
        if (sub == 0) {
#pragma unroll
            for (int ks = 0; ks < 4; ++ks) kf[ks] = *(const LAS bf16x8*)(kb + (4 + ks) * 512);
        }
        __builtin_amdgcn_sched_barrier(0);
        float mx = -INFINITY;
#pragma unroll
        for (int i = 0; i < 16; ++i) {
            if (MODE == 2) { const int koff = sub * 32 + (i & 3) + 8 * (i >> 2) + 4 * h; acc[i] = valid(koff) ? acc[i] : -INFINITY; }
            mx = fmaxf(mx, acc[i]);
        }
        {
            const auto sw = __builtin_amdgcn_permlane32_swap(__float_as_uint(mx), __float_as_uint(mx), false, false);
            mx = fmaxf(__uint_as_float(sw[0]), __uint_as_float(sw[1]));
        }
        const float cand = mx * c;
        const bool upd = cand > st.m + FA_THR;
        if (__ballot(upd)) {
            const float mn = upd ? cand : st.m, alpha = __builtin_amdgcn_exp2f(st.m - mn);
            st.m = mn; st.l *= alpha;
#pragma unroll
            for (int i = 0; i < 16; ++i) { st.o0[i] *= alpha; st.o1[i] *= alpha; }
        }
        const float nb = (MODE == 1 && !rowok) ? -INFINITY : -st.m;
        float ps0 = 0.f, ps1 = 0.f;
#pragma unroll
        for (int i = 0; i < 16; i += 2) {
            acc[i] = __builtin_amdgcn_exp2f(__builtin_fmaf(acc[i], c, nb));
            acc[i + 1] = __builtin_amdgcn_exp2f(__builtin_fmaf(acc[i + 1], c, nb));
            ps0 += acc[i]; ps1 += acc[i + 1];
        }
        st.l += ps0 + ps1;
#pragma unroll
        for (int s2 = 0; s2 < 2; ++s2) {
            const bf16x8 pk = cvt8((f32x8){acc[8 * s2], acc[8 * s2 + 1], acc[8 * s2 + 2], acc[8 * s2 + 3], acc[8 * s2 + 4], acc[8 * s2 + 5], acc[8 * s2 + 6], acc[8 * s2 + 7]});
            st.o0 = MFMA32(vf[2 * s2], pk, st.o0);
            st.o1 = MFMA32(vf[2 * s2 + 1], pk, st.o1);
        }
    }
}
DI void fa_issue(const bf16_t* gK, const bf16_t* gV, LAS unsigned char* buf, int tid) {
    __builtin_amdgcn_global_load_lds((const unsigned*)(gK + tid * 8), (LAS unsigned*)(buf + tid * 16), 16, 0, 0);
    __builtin_amdgcn_global_load_lds((const unsigned*)(gK + (tid + 256) * 8), (LAS unsigned*)(buf + (tid + 256) * 16), 16, 0, 0);
    __builtin_amdgcn_global_load_lds((const unsigned*)(gV + tid * 8), (LAS unsigned*)(buf + 8192 + tid * 16), 16, 0, 0);
    __builtin_amdgcn_global_load_lds((const unsigned*)(gV + (tid + 256) * 8), (LAS unsigned*)(buf + 8192 + (tid + 256) * 16), 16, 0, 0);
}
DI void fa_wait(int j, int n) {
    const int rem = n - 1 - j;
    if (rem >= 2) asm volatile("s_waitcnt vmcnt(8)" ::: "memory");
    else if (rem == 1) asm volatile("s_waitcnt vmcnt(4)" ::: "memory");
    else asm volatile("s_waitcnt vmcnt(0)" ::: "memory");
    __builtin_amdgcn_s_barrier();
    asm volatile("" ::: "memory");
}

constexpr int NSA_LDS_IMP = 65536;
constexpr int NSA_LDS_SCS = NSA_LDS_IMP + 8192;
constexpr int NSA_LDS_MSK = NSA_LDS_SCS + 1024;
DI void phase_nsa(const Params& P, unsigned char* smem) {
    unsigned char* ws = P.ws;
    const int tid = threadIdx.x, lane = tid & 63, wave = tid >> 6, r = lane & 31, h = lane >> 5;
    const float c = 0.125f * 1.4426950408889634f;
    LAS unsigned char* lds = (LAS unsigned char*)smem;
    float* impw = (float*)(smem + NSA_LDS_IMP) + wave * 512;
    float* scs = (float*)(smem + NSA_LDS_SCS) + wave * 64;
    unsigned long long* mskw = (unsigned long long*)(smem + NSA_LDS_MSK) + wave * 8;
    for (int it = blockIdx.x; it < 2048; it += gridDim.x) {
        const int qt = 127 - (it >> 4), bg = it & 15, b = bg >> 1, g = bg & 1, t0 = qt * 32, qblk = t0 >> 6;
        const int ql = r >> 2, z = r & 3, s = t0 + wave * 8 + ql, t = b * 4096 + s;
        const bf16_t* Qg = (const bf16_t*)(ws + XP_Q0) + (size_t)t * 512 + (g * 4 + z) * 64;
        bf16x8 qf[4];
#pragma unroll
        for (int ks = 0; ks < 4; ++ks) qf[ks] = *(const bf16x8*)(Qg + ks * 16 + 8 * h);
        const float* gt = (const float*)(ws + XP_GATES) + (size_t)t * 24 + (g * 4 + z) * 3;
        const float g_c = gt[0], g_s = gt[1], g_w = gt[2];
        const bf16_t* Kc = (const bf16_t*)(ws + WS_KCMP) + (size_t)bg * 256 * 64;
        const bf16_t* Vc = (const bf16_t*)(ws + WS_VCMP) + (size_t)bg * 256 * 64;
        const bf16_t* Ks = (const bf16_t*)(ws + XP_KC + 2 * KVSZ) + (size_t)bg * 4096 * 64;
        const bf16_t* Vs = (const bf16_t*)(ws + XP_KC + 3 * KVSZ) + (size_t)bg * 4096 * 64;
        const bf16_t* Kw = (const bf16_t*)(ws + XP_KC + 4 * KVSZ) + (size_t)bg * 4096 * 64;
        const bf16_t* Vw = (const bf16_t*)(ws + XP_KC + 5 * KVSZ) + (size_t)bg * 4096 * 64;
        const int nct = ((t0 >> 4) + 1 + 63) >> 6;
        const int w0 = (t0 - 255) < 0 ? 0 : (t0 - 255) >> 6;
        const int e1 = nct, e2 = 2 * nct, e3 = e2 + qblk + 1, e4 = e3 + (qblk - w0 + 1);
        const int nc = s >= 31 ? ((s - 31) >> 4) + 1 : 0;
        const int s_lo = t0 + wave * 8, s_hi = s_lo + 7, nc_min = s_lo >= 31 ? ((s_lo - 31) >> 4) + 1 : 0;
        for (int i = lane; i < 512; i += 64) impw[i] = 0.f;
        auto tile_ptrs = [&](int i, const bf16_t*& gk, const bf16_t*& gv) {
            if (i < e1) { gk = Kc + (size_t)i * 4096; gv = Vc + (size_t)i * 4096; }
            else if (i < e2) { gk = Kc + (size_t)(i - e1) * 4096; gv = Vc + (size_t)(i - e1) * 4096; }
            else if (i < e3) { gk = Ks + (size_t)(i - e2) * 4096; gv = Vs + (size_t)(i - e2) * 4096; }
            else { gk = Kw + (size_t)(w0 + i - e3) * 4096; gv = Vw + (size_t)(w0 + i - e3) * 4096; }
        };
        FA st; fa_init(st);
        f32x16 out0, out1;
#pragma unroll
        for (int i = 0; i < 16; ++i) { out0[i] = 0.f; out1[i] = 0.f; }
        float m_c = -1e30f, il_c = 0.f;
        unsigned long long mymask = 0ull;
        asm volatile("s_waitcnt vmcnt(0)" ::: "memory");
        __builtin_amdgcn_s_barrier();
#pragma unroll
        for (int i = 0; i < 3; ++i) if (i < e4) { const bf16_t *gk, *gv; tile_ptrs(i, gk, gv); fa_issue(gk, gv, lds + i * 16384, tid); }
        for (int i = 0; i < e4; ++i) {
            fa_wait(i, e4);
            if (i + 3 < e4) { const bf16_t *gk, *gv; tile_ptrs(i + 3, gk, gv); fa_issue(gk, gv, lds + ((i + 3) & 3) * 16384, tid); }
            const LAS bf16_t* cur = (const LAS bf16_t*)(lds + (i & 3) * 16384);
            if (i < e1) {
                const int nb = i * 64;
                { if (nb + 63 < nc_min) fa_tile<0>(st, qf, cur, cur + 4096, r, h, c, true, [=](int) { return true; }); else fa_tile<2>(st, qf, cur, cur + 4096, r, h, c, true, [=](int koff) { return nb + koff < nc; }); }
                if (i == e1 - 1) {
                    const float l = st.l + __shfl_xor(st.l, 32);
                    il_c = 1.f / fmaxf(l, 1e-30f); m_c = st.m;
                    const float f = g_c * il_c;
#pragma unroll
                    for (int k = 0; k < 16; ++k) { out0[k] = st.o0[k] * f; out1[k] = st.o1[k] * f; }
                    fa_init(st);
                }
            } else if (i < e2) {
                const int nb = (i - e1) * 64;
#pragma unroll
                for (int sub = 0; sub < 2; ++sub) {
                    f32x16 acc;
#pragma unroll
                    for (int k = 0; k < 16; ++k) acc[k] = 0.f;
#pragma unroll
                    for (int ks = 0; ks < 4; ++ks) acc = MFMA32(*(const LAS bf16x8*)(cur + ((sub * 4 + ks) * 32 + r) * 16 + 8 * h), qf[ks], acc);
#pragma unroll
                    for (int q4 = 0; q4 < 4; ++q4) {
                        float p[4];
#pragma unroll
                        for (int k = 0; k < 4; ++k) {
                            const int n = nb + sub * 32 + 8 * q4 + 4 * h + k;
                            p[k] = (n < nc) ? __builtin_amdgcn_exp2f(acc[4 * q4 + k] * c - m_c) * il_c : 0.f;
                        }
                        float a = (p[0] + p[1]) + (p[2] + 0.5f * p[3]), cn = 0.5f * p[3];
                        a += __shfl_xor(a, 1); a += __shfl_xor(a, 2);
                        cn += __shfl_xor(cn, 1); cn += __shfl_xor(cn, 2);
                        const int jb = ((nb + sub * 32) >> 2) + 2 * q4 + h;
                        if (z == 0) { atomicAdd(&impw[ql * 64 + jb], a); if (jb + 1 < 64) atomicAdd(&impw[ql * 64 + jb + 1], cn); }
                    }
                }
                if (i == e2 - 1) {
                    __builtin_amdgcn_wave_barrier();
#pragma unroll 1
                    for (int qq = 0; qq < 8; ++qq) {
                        const int j = lane;
                        const float imp = impw[qq * 64 + j];
                        const float score = (j > qblk) ? -1.f : ((j == 0 || j == qblk || j == qblk - 1) ? 1e3f : imp);
                        scs[j] = score;
                        __builtin_amdgcn_wave_barrier();
                        int rank = 0;
#pragma unroll 8
                        for (int jj = 0; jj < 64; ++jj) { const float o = scs[jj]; rank += (o > score || (o == score && jj < j)) ? 1 : 0; }
                        const unsigned long long mk = __ballot(rank < 8 && score >= 0.f);
                        if (lane == 0) mskw[qq] = mk;
                        __builtin_amdgcn_wave_barrier();
                    }
                    mymask = mskw[ql];
                }
            } else if (i < e3) {
                const int j = i - e2;
                const bool sel = (mymask >> j) & 1ull;
                if (__ballot(sel)) {
                    if (j < qblk) fa_tile<1>(st, qf, cur, cur + 4096, r, h, c, sel, [=](int) { return true; });
                    else { const int kb = j * 64; fa_tile<2>(st, qf, cur, cur + 4096, r, h, c, true, [=](int koff) { return sel && (kb + koff <= s); }); }
                }
                if (i == e3 - 1) {
                    const float l = st.l + __shfl_xor(st.l, 32);
                    const float f = g_s / fmaxf(l, 1e-30f);
#pragma unroll
                    for (int k = 0; k < 16; ++k) { out0[k] += st.o0[k] * f; out1[k] += st.o1[k] * f; }
                    fa_init(st);
                }
            } else {
                const int kb = (w0 + i - e3) * 64;
                { if (kb >= s_hi - 255 && kb + 63 <= s_lo) fa_tile<0>(st, qf, cur, cur + 4096, r, h, c, true, [=](int) { return true; }); else fa_tile<2>(st, qf, cur, cur + 4096, r, h, c, true, [=](int koff) { const int key = kb + koff; return key <= s && key >= s - 255; }); }
            }
        }
        {
            const float l = st.l + __shfl_xor(st.l, 32);
            const float f = g_w / fmaxf(l, 1e-30f);
#pragma unroll
            for (int k = 0; k < 16; ++k) { out0[k] += st.o0[k] * f; out1[k] += st.o1[k] * f; }
        }
        bf16_t* o = (bf16_t*)(ws + WS_MIX) + (size_t)t * 1024 + (g * 4 + z) * 64;
#pragma unroll
        for (int g4 = 0; g4 < 4; ++g4) {
            *(u32x2*)(o + 8 * g4 + 4 * h) = cvt4((f32x4){out0[4 * g4], out0[4 * g4 + 1], out0[4 * g4 + 2], out0[4 * g4 + 3]});
            *(u32x2*)(o + 32 + 8 * g4 + 4 * h) = cvt4((f32x4){out1[4 * g4], out1[4 * g4 + 1], out1[4 * g4 + 2], out1[4 * g4 + 3]});
        }
    }
}

DI void phase_glu(const Params& P, unsigned char* smem) {
    unsigned char* ws = P.ws;
    const bf16_t* G5 = (const bf16_t*)(ws + XP_G5);
    const float* gb = P.in[17];
    for (int it = vblock(); it < (NT / 128) * 4; it += gridDim.x) {
        int mt, nt; tile_mn(it, 4, mt, nt);
        const int m0 = mt * 128;
        auto rowptr = [=](int r) { return G5 + (size_t)(m0 + r) * 512; };
        auto epi = [=](f32x4 (&acc)[4][4], int wr, int wc, int ln) {
            const int fr = ln & 15, fq = ln >> 4;
#pragma unroll
            for (int m = 0; m < 4; ++m) {
                const int row = m0 + wr * 64 + m * 16 + fr;
#pragma unroll
                for (int n = 0; n < 4; ++n) {
                    const int col = nt * 128 + wc * 64 + n * 16 + fq * 4;
                    const f32x4 gv = bf4_to_f(*(const u32x2*)(G5 + (size_t)row * 512 + col)), bb = *(const f32x4*)(gb + col), z = acc[m][n] + bb;
                    *(u32x2*)((bf16_t*)(ws + WS_MIX) + (size_t)row * 1024 + 512 + col) = cvt4((f32x4){gv.x * sigmoidf_(z.x), gv.y * sigmoidf_(z.y), gv.z * sigmoidf_(z.z), gv.w * sigmoidf_(z.w)});
                }
            }
        };
        gemm128(rowptr, (const bf16_t*)(ws + WS_WGLU) + (size_t)nt * 128 * 512, 512, 512, smem, epi);
    }
}

DI void phase_outproj(const Params& P, unsigned char* smem, const float* xres, size_t wt_off) {
    unsigned char* ws = P.ws;
    const bf16_t* A = (const bf16_t*)(ws + WS_MIX);
    float* out = P.out;
    for (int it = vblock(); it < (NT / 128) * 8; it += gridDim.x) {
        int mt, nt; tile_mn(it, 8, mt, nt);
        const int m0 = mt * 128;
        auto rowptr = [=](int r) { return A + (size_t)(m0 + r) * 1024; };
        auto epi = [=](f32x4 (&acc)[4][4], int wr, int wc, int ln) {
            const int fr = ln & 15, fq = ln >> 4;
#pragma unroll
            for (int m = 0; m < 4; ++m) {
                const size_t base = (size_t)(m0 + wr * 64 + m * 16 + fr) * 1024 + nt * 128 + wc * 64 + fq * 4;
                f32x4 xr[4];
#pragma unroll
                for (int n = 0; n < 4; ++n) xr[n] = __builtin_nontemporal_load((const f32x4*)(xres + base + n * 16));
#pragma unroll
                for (int n = 0; n < 4; ++n) *(f32x4*)(out + base + n * 16) = xr[n] * ALPHA + acc[m][n];
            }
        };
        gemm128(rowptr, (const bf16_t*)(ws + wt_off) + (size_t)nt * 128 * 1024, 1024, 1024, smem, epi);
    }
}

DI void ln_row(float (&v)[16], const float* __restrict__ g, const float* __restrict__ bta, int lane) {
    float s = 0.f;
#pragma unroll
    for (int i = 0; i < 16; ++i) s += v[i];
    const float mu = wave_sum(s) * (1.f / 1024.f);
    float q = 0.f;
#pragma unroll
    for (int i = 0; i < 16; ++i) { v[i] -= mu; q += v[i] * v[i]; }
    const float rstd = rsqrtf(wave_sum(q) * (1.f / 1024.f) + LN_EPS);
#pragma unroll
    for (int j = 0; j < 4; ++j) {
        const float4 gg = *(const float4*)(g + 4 * lane + 256 * j), bb = *(const float4*)(bta + 4 * lane + 256 * j);
        v[4 * j + 0] = v[4 * j + 0] * rstd * gg.x + bb.x; v[4 * j + 1] = v[4 * j + 1] * rstd * gg.y + bb.y;
        v[4 * j + 2] = v[4 * j + 2] * rstd * gg.z + bb.z; v[4 * j + 3] = v[4 * j + 3] * rstd * gg.w + bb.w;
    }
}

DI void phase_ln_router(const Params& P, int layer) {
    unsigned char* ws = P.ws;
    const int lane = threadIdx.x & 63, wave = threadIdx.x >> 6;
    const float* g = P.in[21] + layer * 1024; const float* bta = P.in[22] + layer * 1024;
    const float* wc = (const float*)(ws + WS_RTRW) + (size_t)layer * 36864; const float* bc = P.in[26] + layer * 4;
    const float* wf = wc + 4096; const float* bfn = P.in[28] + layer * 32;
    int* cnt = (int*)(ws + WS_CTL) + layer * 2048;
    int* list = (int*)(ws + WS_LIST2);
    float* wgt = (float*)(ws + WS_WGT);
    bf16_t* xb = (bf16_t*)(ws + WS_ACTB);
    for (int task = blockIdx.x * 4 + wave; task < NT / 16; task += gridDim.x * 4) {
        int my_e = 0; float my_w = 0.f;
        f32x4 wcr[16];
#pragma unroll
        for (int q = 0; q < 16; ++q) wcr[q] = *(const f32x4*)(wc + (q * 64 + lane) * 4);
        f32x4 nx[4];
#pragma unroll
        for (int j = 0; j < 4; ++j) nx[j] = __builtin_nontemporal_load((const f32x4*)(P.out + (size_t)(task * 16) * 1024 + 4 * lane + 256 * j));
#pragma unroll 1
        for (int i = 0; i < 16; ++i) {
            const int t = task * 16 + i;
            float v[16];
#pragma unroll
            for (int j = 0; j < 4; ++j) { v[4 * j] = nx[j].x; v[4 * j + 1] = nx[j].y; v[4 * j + 2] = nx[j].z; v[4 * j + 3] = nx[j].w; }
            if (i + 1 < 16) {
#pragma unroll
                for (int j = 0; j < 4; ++j) nx[j] = __builtin_nontemporal_load((const f32x4*)(P.out + (size_t)(t + 1) * 1024 + 4 * lane + 256 * j));
            }
            ln_row(v, g, bta, lane);
#pragma unroll
            for (int j = 0; j < 4; ++j) {
                *(u32x2*)(xb + (size_t)t * 1024 + 4 * lane + 256 * j) = cvt4((f32x4){v[4 * j], v[4 * j + 1], v[4 * j + 2], v[4 * j + 3]});
            }
            float lc[4] = {0.f, 0.f, 0.f, 0.f};
#pragma unroll
            for (int j = 0; j < 4; ++j)
#pragma unroll
                for (int k = 0; k < 4; ++k) {
                    const f32x4 w = wcr[j * 4 + k];
                    const float x = v[4 * j + k];
                    lc[0] += x * w.x; lc[1] += x * w.y; lc[2] += x * w.z; lc[3] += x * w.w;
                }
#pragma unroll
            for (int c = 0; c < 4; ++c) lc[c] = wave_sum(lc[c]) + bc[c];
            int gi = 0; float lm = lc[0];
#pragma unroll
            for (int c = 1; c < 4; ++c) if (lc[c] > lm) { lm = lc[c]; gi = c; }
            gi = __builtin_amdgcn_readfirstlane(gi);
            float den = 0.f;
#pragma unroll
            for (int c = 0; c < 4; ++c) den += expf(lc[c] - lm);
            const float gv = 1.f / den;
            float lf[8] = {0.f, 0.f, 0.f, 0.f, 0.f, 0.f, 0.f, 0.f};
            const float* wfg = wf + (size_t)gi * 8192;
#pragma unroll
            for (int j = 0; j < 4; ++j)
#pragma unroll
                for (int k = 0; k < 4; ++k) {
                    const f32x4 w0 = *(const f32x4*)(wfg + (((j * 4 + k) * 2 + 0) * 64 + lane) * 4), w1 = *(const f32x4*)(wfg + (((j * 4 + k) * 2 + 1) * 64 + lane) * 4);
                    const float x = v[4 * j + k];
                    lf[0] += x * w0.x; lf[1] += x * w0.y; lf[2] += x * w0.z; lf[3] += x * w0.w;
                    lf[4] += x * w1.x; lf[5] += x * w1.y; lf[6] += x * w1.z; lf[7] += x * w1.w;
                }
#pragma unroll
            for (int e = 0; e < 8; ++e) lf[e] = wave_sum(lf[e]) + bfn[gi * 8 + e];
            int e1 = 0; float l1 = lf[0];
#pragma unroll
            for (int e = 1; e < 8; ++e) if (lf[e] > l1) { l1 = lf[e]; e1 = e; }
            int e2 = 0; float l2 = -INFINITY;
#pragma unroll
            for (int e = 0; e < 8; ++e) if (e != e1 && lf[e] > l2) { l2 = lf[e]; e2 = e; }
            const float r = expf(l2 - l1);
            if (lane == i) { my_e = gi * 8 + e1; my_w = gv / (1.f + r); }
            if (lane == 16 + i) { my_e = gi * 8 + e2; my_w = gv * r / (1.f + r); }
        }
        if (lane < 32) {
            const int t = task * 16 + (lane & 15), k = lane >> 4, slot = (task & 63) * 32 + my_e;
            const int pos = atomicAdd(&cnt[slot], 1);
            list[(slot << 10) + pos] = t * 2 + k;
            wgt[t * 2 + k] = my_w;
        }
    }
}

constexpr int MOE_LDS_TAB = 65536;
constexpr int MOE_LDS_ROW = 65536 + 8448;
DI void moe_tables(const int* cnt, unsigned char* smem) {
    int* tab = (int*)(smem + MOE_LDS_TAB);
    if (threadIdx.x < 32) { const int e = threadIdx.x; int run = 0; for (int s = 0; s < 64; ++s) { tab[e * 65 + s] = run; run += cnt[s * 32 + e]; } tab[e * 65 + 64] = run; }
    __syncthreads();
}
DI bool moe_tile(const int* tab, int tile, int& e, int& mt, int& off, int& ce) {
    int acc_t = 0, acc_r = 0;
    for (int i = 0; i < 32; ++i) {
        const int c = tab[i * 65 + 64], nt = (c + 127) >> 7;
        if (tile < acc_t + nt) { e = i; mt = tile - acc_t; off = acc_r; ce = c; return true; }
        acc_t += nt; acc_r += c;
    }
    return false;
}
DI int moe_ntiles(const int* tab) { int a = 0; for (int i = 0; i < 32; ++i) a += (tab[i * 65 + 64] + 127) >> 7; return a; }
DI void moe_rows(const int* tab, const int* list, int e, int mt, int ce, int* rowidx) {
    if (threadIdx.x < 128) {
        const int pos = mt * 128 + threadIdx.x;
        int idx = -1;
        if (pos < ce) {
            int lo = 0, hi = 64;
            while (hi - lo > 1) { const int mid = (lo + hi) >> 1; if (tab[e * 65 + mid] <= pos) lo = mid; else hi = mid; }
            idx = list[((lo * 32 + e) << 10) + pos - tab[e * 65 + lo]];
        }
        rowidx[threadIdx.x] = idx;
    }
    __syncthreads();
}

DI void phase_moe_gu(const Params& P, unsigned char* smem, int layer) {
    unsigned char* ws = P.ws;
    const int* cnt = (const int*)(ws + WS_CTL) + layer * 2048;
    const int* list = (const int*)(ws + WS_LIST2);
    const float* wgt = (const float*)(ws + WS_WGT);
    const bf16_t* xb = (const bf16_t*)(ws + WS_ACTB);
    bf16_t* H = (bf16_t*)(ws + XP_H);
    const int* tab = (const int*)(smem + MOE_LDS_TAB);
    int* rowidx = (int*)(smem + MOE_LDS_ROW);
    moe_tables(cnt, smem);
    const int ntile = moe_ntiles(tab);
    for (int it = vblock(); it < ntile * 2; it += gridDim.x) {
        int e, mt, off, ce; moe_tile(tab, it >> 1, e, mt, off, ce);
        const int nt = it & 1;
        moe_rows(tab, list, e, mt, ce, rowidx);
        auto rowptr = [=](int r) { int idx = rowidx[r]; idx = idx < 0 ? rowidx[0] : idx; return xb + (size_t)(idx >> 1) * 1024; };
        auto epi = [=](f32x4 (&acc)[4][4], int wr, int wc, int ln) {
            const int fr = ln & 15, fq = ln >> 4;
#pragma unroll
            for (int m = 0; m < 4; ++m) {
                const int rl = wr * 64 + m * 16 + fr, idx = rowidx[rl];
                if (idx >= 0) {
                    const float w = wgt[idx];
#pragma unroll
                    for (int n = 0; n < 2; ++n) {
                        const f32x4 gte = acc[m][n], up = acc[m][n + 2];
                        *(u32x2*)(H + (size_t)(off + mt * 128 + rl) * 128 + (nt * 2 + wc) * 32 + n * 16 + fq * 4) =
                            cvt4((f32x4){gte.x * sigmoidf_(gte.x) * up.x * w, gte.y * sigmoidf_(gte.y) * up.y * w, gte.z * sigmoidf_(gte.z) * up.z * w, gte.w * sigmoidf_(gte.w) * up.w * w});
                    }
                }
            }
        };
        gemm128(rowptr, (const bf16_t*)(ws + WS_WGU) + ((size_t)(layer * 32 + e) * 256 + nt * 128) * 1024, 1024, 1024, smem, epi);
        __syncthreads();
    }
}
DI void phase_moe_down(const Params& P, unsigned char* smem, int layer) {
    unsigned char* ws = P.ws;
    const int* cnt = (const int*)(ws + WS_CTL) + layer * 2048;
    const int* list = (const int*)(ws + WS_LIST2);
    const bf16_t* H = (const bf16_t*)(ws + XP_H);
    bf16_t* YB = (bf16_t*)(ws + XP_YB);
    const int* tab = (const int*)(smem + MOE_LDS_TAB);
    int* rowidx = (int*)(smem + MOE_LDS_ROW);
    moe_tables(cnt, smem);
    const int ntile = moe_ntiles(tab);
    for (int it = vblock(); it < ntile * 8; it += gridDim.x) {
        int e, mt, off, ce; moe_tile(tab, it >> 3, e, mt, off, ce);
        const int nt = it & 7;
        moe_rows(tab, list, e, mt, ce, rowidx);
        auto rowptr = [=](int r) { int pos = mt * 128 + r; pos = pos < ce ? pos : 0; return H + (size_t)(off + pos) * 128; };
        auto epi = [=](f32x4 (&acc)[4][4], int wr, int wc, int ln) {
            const int fr = ln & 15, fq = ln >> 4;
#pragma unroll
            for (int m = 0; m < 4; ++m) {
                const int idx = rowidx[wr * 64 + m * 16 + fr];
                if (idx >= 0) {
                    bf16_t* dst = YB + (size_t)idx * 1024 + nt * 128 + wc * 64 + fq * 4;
#pragma unroll
                    for (int n = 0; n < 4; ++n) *(u32x2*)(dst + n * 16) = cvt4(acc[m][n]);
                }
            }
        };
        gemm128(rowptr, (const bf16_t*)(ws + WS_WDN) + ((size_t)(layer * 32 + e) * 1024 + nt * 128) * 128, 128, 128, smem, epi);
        __syncthreads();
    }
}
DI void phase_ln_ffn(const Params& P, int layer) {
    unsigned char* ws = P.ws;
    const int lane = threadIdx.x & 63, wave = threadIdx.x >> 6;
    const float* g = P.in[23] + layer * 1024; const float* bta = P.in[24] + layer * 1024;
    const bf16_t* YB = (const bf16_t*)(ws + XP_YB);
    bf16_t* xb = (bf16_t*)(ws + WS_ACTB);
    for (int task = blockIdx.x * 4 + wave; task < NT / 16; task += gridDim.x * 4) {
        u32x2 nxm[4], ny0[4], ny1[4];
        auto fetch = [&](int t) {
#pragma unroll
            for (int j = 0; j < 4; ++j) {
                nxm[j] = __builtin_nontemporal_load((const u32x2*)(xb + (size_t)t * 1024 + 4 * lane + 256 * j));
                ny0[j] = __builtin_nontemporal_load((const u32x2*)(YB + (size_t)(2 * t) * 1024 + 4 * lane + 256 * j));
                ny1[j] = __builtin_nontemporal_load((const u32x2*)(YB + (size_t)(2 * t + 1) * 1024 + 4 * lane + 256 * j));
            }
        };
        fetch(task * 16);
#pragma unroll 1
        for (int i = 0; i < 16; ++i) {
            const int t = task * 16 + i;
            float v[16];
#pragma unroll
            for (int j = 0; j < 4; ++j) {
                const f32x4 a = bf4_to_f(nxm[j]), y0 = bf4_to_f(ny0[j]), y1 = bf4_to_f(ny1[j]);
                v[4 * j + 0] = ALPHA * a.x + (y0.x + y1.x); v[4 * j + 1] = ALPHA * a.y + (y0.y + y1.y);
                v[4 * j + 2] = ALPHA * a.z + (y0.z + y1.z); v[4 * j + 3] = ALPHA * a.w + (y0.w + y1.w);
            }
            if (i + 1 < 16) fetch(t + 1);
            ln_row(v, g, bta, lane);
            float* row = P.out + (size_t)t * 1024;
#pragma unroll
            for (int j = 0; j < 4; ++j) {
                __builtin_nontemporal_store((f32x4){v[4 * j], v[4 * j + 1], v[4 * j + 2], v[4 * j + 3]}, (f32x4*)(row + 4 * lane + 256 * j));
                if (layer == 0) *(u32x2*)(xb + (size_t)t * 1024 + 4 * lane + 256 * j) = cvt4((f32x4){v[4 * j], v[4 * j + 1], v[4 * j + 2], v[4 * j + 3]});
            }
        }
    }
}

DI void phase_inproj1(const Params& P, unsigned char* smem) {
    unsigned char* ws = P.ws;
    const bf16_t* A = (const bf16_t*)(ws + WS_ACTB);
    const float* cosT = (const float*)(ws + WS_ROPE);
    const float* sinT = cosT + 4096 * 32;
    for (int it = vblock(); it < (NT / 128) * 24; it += gridDim.x) {
        int mt, nt; tile_mn(it, 24, mt, nt);
        const int m0 = mt * 128;
        auto rowptr = [=](int r) { return A + (size_t)(m0 + r) * 1024; };
        const bf16_t* Bt = (const bf16_t*)(ws + WS_WIN1) + (size_t)nt * 128 * 1024;
        if (nt >= 16) {
            auto epi = [=](f32x4 (&acc)[4][4], int wr, int wc, int lane) {
                const int head = (nt * 2 + wc) & 15, fr = lane & 15, fq = lane >> 4;
#pragma unroll
                for (int m = 0; m < 4; ++m) {
                    const int t = m0 + wr * 64 + m * 16 + fq * 4, s = t & 4095, b = t >> 12;
                    bf16_t* base = (bf16_t*)(ws + XP_Q1 + (size_t)2 * 64 * MiB) + (size_t)(b * 16 + head) * 4096 * 64;
#pragma unroll
                    for (int n = 0; n < 4; ++n) *(u32x2*)(base + vp_off(s, n * 16 + fr)) = cvt4(acc[m][n]);
                }
            };
            gemm128<false>(rowptr, Bt, 1024, 1024, smem, epi);
            continue;
        }
        auto epi = [=](f32x4 (&acc)[4][4], int wr, int wc, int lane) {
            const int u64 = nt * 2 + wc, kind = u64 >> 4, head = u64 & 15, fr = lane & 15, fq = lane >> 4;
            f32x4 cs[2][2];
#pragma unroll
            for (int n2 = 0; n2 < 2; ++n2) { cs[n2][0] = (f32x4){0.f, 0.f, 0.f, 0.f}; cs[n2][1] = cs[n2][0]; }
#pragma unroll
            for (int m = 0; m < 4; ++m) {
                const int t = m0 + wr * 64 + m * 16 + fr, s = t & 4095, b = t >> 12;
                bf16_t* base = (bf16_t*)(ws + XP_Q1 + (size_t)kind * 64 * MiB) + (size_t)(b * 16 + head) * 4096 * 64;
#pragma unroll
                for (int n2 = 0; n2 < 2; ++n2) {
                    const int i = n2 * 16 + fq * 4;
                    const f32x4 c = *(const f32x4*)(cosT + s * 32 + i), sn = *(const f32x4*)(sinT + s * 32 + i);
                    const f32x4 x1 = acc[m][2 * n2], x2 = acc[m][2 * n2 + 1];
                    const f32x4 r1 = x1 * c - x2 * sn, r2 = x1 * sn + x2 * c;
                    const u32x2 o1 = cvt4(r1), o2 = cvt4(r2);
                    if (kind == 0) { *(u32x2*)(base + (size_t)s * 64 + i) = o1; *(u32x2*)(base + (size_t)s * 64 + i + 32) = o2; }
                    else { *(u32x2*)(base + kp_off(s, i)) = o1; *(u32x2*)(base + kp_off(s, i + 32)) = o2; cs[n2][0] += r1; cs[n2][1] += r2; }
                }
            }
            if (kind == 1) {
                const int t0 = m0 + wr * 64, bh = (t0 >> 12) * 16 + head, seg = (t0 & 4095) >> 6;
                float* dst = (float*)(ws + WS_KMP) + ((size_t)bh * 64 + seg) * 64;
#pragma unroll
                for (int n2 = 0; n2 < 2; ++n2)
#pragma unroll
                    for (int hf = 0; hf < 2; ++hf) {
                        f32x4 v = cs[n2][hf];
#pragma unroll
                        for (int k = 0; k < 4; ++k) { float x = v[k]; x += dpp_f<0xB1>(x); x += dpp_f<0x4E>(x); x += dpp_f<0x141>(x); x += dpp_f<0x140>(x); v[k] = x; }
                        if (fr == 0) *(f32x4*)(dst + n2 * 16 + fq * 4 + hf * 32) = v;
                    }
            }
        };
        gemm128(rowptr, Bt, 1024, 1024, smem, epi);
    }
}
DI void moba_kmeans_slab(const Params& P, bf16_t* kml, int bh, int tid) {
    const float* kp = (const float*)(P.ws + WS_KMP) + (size_t)bh * 64 * 64;
    for (int e = tid; e < 2048; e += 256) {
        const int d = e & 63, n = e >> 6;
        float a = 0.f;
        if (n < 16) a = ((kp[(4 * n) * 64 + d] + kp[(4 * n + 1) * 64 + d]) + (kp[(4 * n + 2) * 64 + d] + kp[(4 * n + 3) * 64 + d])) * (1.f / 256.f);
        kml[((d >> 4) * 32 + n) * 16 + (d & 15)] = f2bf(a);
    }
}
DI unsigned moba_gate_rows(const bf16_t* km, const bf16x8 (&qf)[4], int own, int r, int h) {
    f32x16 g;
#pragma unroll
    for (int i = 0; i < 16; ++i) g[i] = 0.f;
#pragma unroll
    for (int ks = 0; ks < 4; ++ks) g = MFMA32(*(const bf16x8*)(km + (ks * 32 + r) * 16 + 8 * h), qf[ks], g);
    float mine[8], oth[8];
#pragma unroll
    for (int i = 0; i < 8; ++i) { const int n = (i & 3) + 8 * (i >> 2) + 4 * h; mine[i] = n < own ? g[i] : -INFINITY; oth[i] = __shfl_xor(mine[i], 32); }
    unsigned selmask = 0;
#pragma unroll
    for (int i = 0; i < 8; ++i) {
        const int n = (i & 3) + 8 * (i >> 2) + 4 * h;
        int rank = 0;
#pragma unroll
        for (int k = 0; k < 8; ++k) {
            const int nk = (k & 3) + 8 * (k >> 2) + 4 * h, no = (k & 3) + 8 * (k >> 2) + 4 * (1 - h);
            rank += (mine[k] > mine[i] || (mine[k] == mine[i] && nk < n)) ? 1 : 0;
            rank += (oth[k] > mine[i] || (oth[k] == mine[i] && no < n)) ? 1 : 0;
        }
        if (n < own && rank < 3) selmask |= 1u << n;
    }
    return selmask | __shfl_xor(selmask, 32);
}
DI void phase_moba_gate(const Params& P, unsigned char* smem) {
    unsigned char* ws = P.ws;
    const int tid = threadIdx.x, lane = tid & 63, wave = tid >> 6, r = lane & 31, h = lane >> 5;
    bf16_t* kml = (bf16_t*)smem;
    unsigned short* smask = (unsigned short*)(smem + 4096);
    unsigned short* selm = (unsigned short*)(ws + WS_SELM);
    unsigned short* mcnt = (unsigned short*)(ws + WS_MCNT);
    unsigned char* mlist = ws + WS_MLIST;
    int km_bh = -1;
    for (int it = blockIdx.x; it < 2048; it += gridDim.x) {
        const int bh = it & 127, qb = it >> 7;
        if (bh != km_bh) { km_bh = bh; __syncthreads(); moba_kmeans_slab(P, kml, bh, tid); }
        __syncthreads();
#pragma unroll 1
        for (int g2 = 0; g2 < 2; ++g2) {
            const int rl = wave * 64 + g2 * 32 + r, q = qb * 256 + rl;
            const bf16_t* Qg = (const bf16_t*)(ws + XP_Q1) + ((size_t)bh * 4096 + q) * 64;
            bf16x8 qf[4];
#pragma unroll
            for (int ks = 0; ks < 4; ++ks) qf[ks] = *(const bf16x8*)(Qg + ks * 16 + 8 * h);
            const unsigned sm = qb > 0 ? moba_gate_rows(kml, qf, qb, r, h) : 0u;
            if (h == 0) { selm[(size_t)bh * 4096 + q] = (unsigned short)sm; smask[rl] = (unsigned short)sm; }
        }
        __syncthreads();
        for (int n = wave; n < qb; n += 4) {
            unsigned char* lp = mlist + ((size_t)(bh * 16 + qb) * 16 + n) * 256;
            int base = 0;
#pragma unroll
            for (int c4 = 0; c4 < 4; ++c4) {
                const int row = c4 * 64 + lane;
                const bool bit = (smask[row] >> n) & 1;
                const unsigned long long bal = __ballot(bit);
                if (bit) lp[base + __builtin_popcountll(bal & ((1ull << lane) - 1ull))] = (unsigned char)row;
                base += __builtin_popcountll(bal);
            }
            if (lane == 0) mcnt[(bh * 16 + qb) * 16 + n] = (unsigned short)base;
        }
    }
}
DI bf16_t* moba_po(const Params& P, int slot) { return (bf16_t*)(P.ws + (slot == 0 ? WS_MIX : slot == 1 ? WS_ACTB : WS_PO2)); }
DI void phase_moba_kv(const Params& P, unsigned char* smem) {
    unsigned char* ws = P.ws;
    const int tid = threadIdx.x, lane = tid & 63, wave = tid >> 6, r = lane & 31, h = lane >> 5;
    const float c = 0.125f * 1.4426950408889634f;
    LAS unsigned char* lds = (LAS unsigned char*)smem;
    const unsigned short* selm = (const unsigned short*)(ws + WS_SELM);
    const unsigned short* mcnt = (const unsigned short*)(ws + WS_MCNT);
    const unsigned char* mlist = ws + WS_MLIST;
    float* pml = (float*)(ws + WS_PML);
    const bool bal = (gridDim.x == 512);
    const int nit = bal ? ((blockIdx.x >> 7) == 3 ? 3 : 4) : (1920 + (int)gridDim.x - 1 - (int)blockIdx.x) / (int)gridDim.x;
    for (int iti = 0; iti < nit; ++iti) {
        int bh, n;
        if (bal) { const int gq = blockIdx.x >> 7; bh = blockIdx.x & 127; const int tab = gq == 0 ? 0x0DA90 : gq == 1 ? 0x0CB61 : gq == 2 ? 0x0E852 : 0x00743; n = (tab >> (4 * iti)) & 15; }
        else { const int it = blockIdx.x + iti * gridDim.x; n = it >> 7; bh = it & 127; }
        const bf16_t* Kg = (const bf16_t*)(ws + XP_Q1 + 64 * MiB) + (size_t)bh * 4096 * 64 + (size_t)n * 4 * 4096;
        const bf16_t* Vg = (const bf16_t*)(ws + XP_Q1 + 128 * MiB) + (size_t)bh * 4096 * 64 + (size_t)n * 4 * 4096;
        asm volatile("s_waitcnt vmcnt(0)" ::: "memory");
        __builtin_amdgcn_s_barrier();
#pragma unroll
        for (int j = 0; j < 4; ++j) fa_issue(Kg + (size_t)j * 4096, Vg + (size_t)j * 4096, lds + j * 16384, tid);
        const int cntv = (lane < 16 && lane > n) ? (int)mcnt[(bh * 16 + lane) * 16 + n] : 0;
        asm volatile("s_waitcnt vmcnt(0)" ::: "memory");
        __builtin_amdgcn_s_barrier();
        asm volatile("" ::: "memory");
        int prefv = 0, total = 0;
#pragma unroll 1
        for (int qb = 0; qb < 16; ++qb) { if (lane == qb) prefv = total; total += __builtin_amdgcn_readlane(cntv, qb); }
#pragma unroll 1
        for (int v0 = wave * 32; v0 < total; v0 += 128) {
            const int v = v0 + r;
            const bool valid = v < total;
            const int vv = valid ? v : v0;
            int qb = n + 1;
#pragma unroll 1
            for (int l = n + 2; l < 16; ++l) if (vv >= __builtin_amdgcn_readlane(prefv, l)) qb = l;
            const int idx = vv - __shfl(prefv, qb);
            const int q = qb * 256 + (int)mlist[((size_t)(bh * 16 + qb) * 16 + n) * 256 + idx];
            const bf16_t* Qg = (const bf16_t*)(ws + XP_Q1) + ((size_t)bh * 4096 + q) * 64;
            bf16x8 qf[4];
#pragma unroll
            for (int ks = 0; ks < 4; ++ks) qf[ks] = *(const bf16x8*)(Qg + ks * 16 + 8 * h);
            FA st; fa_init(st);
#pragma unroll 1
            for (int j = 0; j < 4; ++j) {
                const LAS bf16_t* cur = (const LAS bf16_t*)(lds + j * 16384);
                fa_tile<0>(st, qf, cur, cur + 4096, r, h, c, true, [=](int) { return true; });
            }
            const float l = st.l + __shfl_xor(st.l, 32);
            const float inv = 1.f / fmaxf(l, 1e-30f);
            if (valid) {
                const int slot = __builtin_popcount((unsigned)selm[(size_t)bh * 4096 + q] & ((1u << n) - 1u));
                bf16_t* o = moba_po(P, slot) + ((size_t)(bh >> 4) * 4096 + q) * 1024 + (bh & 15) * 64;
#pragma unroll
                for (int g4 = 0; g4 < 4; ++g4) {
                    *(u32x2*)(o + 8 * g4 + 4 * h) = cvt4((f32x4){st.o0[4 * g4] * inv, st.o0[4 * g4 + 1] * inv, st.o0[4 * g4 + 2] * inv, st.o0[4 * g4 + 3] * inv});
                    *(u32x2*)(o + 32 + 8 * g4 + 4 * h) = cvt4((f32x4){st.o1[4 * g4] * inv, st.o1[4 * g4 + 1] * inv, st.o1[4 * g4 + 2] * inv, st.o1[4 * g4 + 3] * inv});
                }
                if (h == 0) { float* pm = pml + (((size_t)bh * 4096 + q) * 3 + slot) * 2; pm[0] = st.m; pm[1] = l; }
            }
        }
    }
}
DI void phase_moba_own(const Params& P, unsigned char* smem) {
    unsigned char* ws = P.ws;
    const int tid = threadIdx.x, lane = tid & 63, wave = tid >> 6, r = lane & 31, h = lane >> 5;
    const float c = 0.125f * 1.4426950408889634f;
    LAS unsigned char* lds = (LAS unsigned char*)smem;
    const unsigned short* selm = (const unsigned short*)(ws + WS_SELM);
    const float* pml = (const float*)(ws + WS_PML);
    for (int it = blockIdx.x; it < 2048; it += gridDim.x) {
        const int own = 15 - (it >> 7), bh = it & 127, t0 = own * 256;
        const bf16_t* Kg = (const bf16_t*)(ws + XP_Q1 + 64 * MiB) + (size_t)bh * 4096 * 64 + (size_t)own * 4 * 4096;
        const bf16_t* Vg = (const bf16_t*)(ws + XP_Q1 + 128 * MiB) + (size_t)bh * 4096 * 64 + (size_t)own * 4 * 4096;
        asm volatile("s_waitcnt vmcnt(0)" ::: "memory");
        __builtin_amdgcn_s_barrier();
#pragma unroll
        for (int j = 0; j < 4; ++j) fa_issue(Kg + (size_t)j * 4096, Vg + (size_t)j * 4096, lds + j * 16384, tid);
        asm volatile("s_waitcnt vmcnt(0)" ::: "memory");
        __builtin_amdgcn_s_barrier();
        asm volatile("" ::: "memory");
#pragma unroll 1
        for (int g2 = 0; g2 < 2; ++g2) {
            const int row0 = t0 + g2 * 128 + wave * 32, q = row0 + r;
            const bf16_t* Qg = (const bf16_t*)(ws + XP_Q1) + ((size_t)bh * 4096 + q) * 64;
            bf16x8 qf[4];
#pragma unroll
            for (int ks = 0; ks < 4; ++ks) qf[ks] = *(const bf16x8*)(Qg + ks * 16 + 8 * h);
            const int nsel = __builtin_popcount((unsigned)selm[(size_t)bh * 4096 + q]);
            const size_t orow = ((size_t)(bh >> 4) * 4096 + q) * 1024 + (bh & 15) * 64;
            const float* pm = pml + ((size_t)bh * 4096 + q) * 6;
            float mi[3], li[3];
            u32x2 pa[3][8];
#pragma unroll
            for (int i = 0; i < 3; ++i) {
                mi[i] = i < nsel ? pm[2 * i] : -INFINITY; li[i] = i < nsel ? pm[2 * i + 1] : 0.f;
                const bf16_t* po = moba_po(P, i) + orow;
#pragma unroll
                for (int g4 = 0; g4 < 4; ++g4) {
                    pa[i][2 * g4] = i < nsel ? *(const u32x2*)(po + 8 * g4 + 4 * h) : (u32x2){0u, 0u};
                    pa[i][2 * g4 + 1] = i < nsel ? *(const u32x2*)(po + 32 + 8 * g4 + 4 * h) : (u32x2){0u, 0u};
                }
            }
            FA st; fa_init(st);
            const int jmax = (row0 + 31 - t0) >> 6;
#pragma unroll 1
            for (int j = 0; j <= jmax; ++j) {
                const LAS bf16_t* cur = (const LAS bf16_t*)(lds + j * 16384);
                const int kbase = t0 + j * 64;
                if (kbase + 63 <= row0) fa_tile<0>(st, qf, cur, cur + 4096, r, h, c, true, [=](int) { return true; });
                else fa_tile<2>(st, qf, cur, cur + 4096, r, h, c, true, [=](int koff) { return kbase + koff <= q; });
            }
            const float l_own = st.l + __shfl_xor(st.l, 32);
            const float M = fmaxf(fmaxf(st.m, mi[0]), fmaxf(mi[1], mi[2]));
            const float wo = __builtin_amdgcn_exp2f(st.m - M);
            float L = l_own * wo;
#pragma unroll
            for (int k = 0; k < 16; ++k) { st.o0[k] *= wo; st.o1[k] *= wo; }
#pragma unroll
            for (int i = 0; i < 3; ++i) {
                const float wi = li[i] * __builtin_amdgcn_exp2f(mi[i] - M);
                L += wi;
#pragma unroll
                for (int g4 = 0; g4 < 4; ++g4) {
                    const f32x4 a = bf4_to_f(pa[i][2 * g4]), b2 = bf4_to_f(pa[i][2 * g4 + 1]);
                    st.o0[4 * g4] += wi * a.x; st.o0[4 * g4 + 1] += wi * a.y; st.o0[4 * g4 + 2] += wi * a.z; st.o0[4 * g4 + 3] += wi * a.w;
                    st.o1[4 * g4] += wi * b2.x; st.o1[4 * g4 + 1] += wi * b2.y; st.o1[4 * g4 + 2] += wi * b2.z; st.o1[4 * g4 + 3] += wi * b2.w;
                }
            }
            const float inv = 1.f / fmaxf(L, 1e-30f);
            bf16_t* o = (bf16_t*)(ws + WS_MIX) + orow;
#pragma unroll
            for (int g4 = 0; g4 < 4; ++g4) {
                *(u32x2*)(o + 8 * g4 + 4 * h) = cvt4((f32x4){st.o0[4 * g4] * inv, st.o0[4 * g4 + 1] * inv, st.o0[4 * g4 + 2] * inv, st.o0[4 * g4 + 3] * inv});
                *(u32x2*)(o + 32 + 8 * g4 + 4 * h) = cvt4((f32x4){st.o1[4 * g4] * inv, st.o1[4 * g4 + 1] * inv, st.o1[4 * g4 + 2] * inv, st.o1[4 * g4 + 3] * inv});
            }
        }
    }
}

constexpr int SMEM_BYTES = 65536 + 8192 + 1024 + 512;
static_assert(SMEM_BYTES >= 128 * 129 * 4 && SMEM_BYTES >= MOE_LDS_ROW + 512 && SMEM_BYTES >= NSA_LDS_MSK + 256, "LDS map");
constexpr int SMEM_OLD = 128 * 129 * 4;
typedef __attribute__((address_space(1))) unsigned gu32;
#define XB_TMO      128
#define XB_XCNT(j)  (256  + 64 * (j))
#define XB_XSUB(j)  (1280 + 64 * (j))
#define XB_XGEN(j)  (2304 + 64 * (j))
#define XB_TOP      3328
#define XB_TOPGEN   3392
#define XCD_BAR_WORDS 3456
#define XB_SPIN_CAP (1u << 18)

__device__ __forceinline__ unsigned xb_ld(unsigned* p)              { return __hip_atomic_load(p, __ATOMIC_RELAXED, __HIP_MEMORY_SCOPE_AGENT); }
__device__ __forceinline__ unsigned xb_add(unsigned* p, unsigned v) { return __hip_atomic_fetch_add(p, v, __ATOMIC_RELAXED, __HIP_MEMORY_SCOPE_AGENT); }
__device__ __forceinline__ unsigned xb_xcc_id() { return (unsigned)__builtin_amdgcn_s_getreg((3 << 11) | 20) & 0xFu; }
#define XB_SPIN(cond, bar) do { unsigned _sp = 0; while (cond) { __builtin_amdgcn_s_sleep(1); \
    if ((++_sp & 255u) == 0u) { if (xb_ld(&(bar)[XB_TMO])) break; if (_sp > XB_SPIN_CAP) { atomicAdd(&(bar)[XB_TMO], 1u); break; } } } } while (0)

struct XcdBarrier {
    unsigned* bar; unsigned x;
    volatile LAS unsigned* st;
};

__device__ __forceinline__ XcdBarrier xcd_barrier_post(unsigned* bar, volatile LAS unsigned* st) {
    XcdBarrier b; b.bar = bar; b.x = xb_xcc_id(); b.st = st;
    if (threadIdx.x == 0) (void)xb_add(&bar[XB_XCNT(b.x)], 1u);
    return b;
}
__device__ __forceinline__ void xcd_barrier_complete(unsigned* bar, unsigned x, unsigned& nloc, unsigned& nx) {
    const unsigned G = gridDim.x * gridDim.y * gridDim.z;
    unsigned sum, cnt, mine, sp = 0u;
    for (;;) {
        sum = 0u; cnt = 0u; mine = 0u;
#pragma unroll
        for (unsigned j = 0; j < 16; ++j) { const unsigned c = xb_ld(&bar[XB_XCNT(j)]); sum += c; cnt += (c > 0u) ? 1u : 0u; mine = (j == x) ? c : mine; }
        if (sum == G) break;
        __builtin_amdgcn_s_sleep(1);
        if ((++sp & 255u) == 0u) { if (xb_ld(&bar[XB_TMO])) break; if (sp > XB_SPIN_CAP) { atomicAdd(&bar[XB_TMO], 1u); break; } }
    }
    nloc = mine > 0u ? mine : 1u; nx = cnt > 0u ? cnt : 1u;
}

__device__ __forceinline__ void xcd_barrier(const XcdBarrier& b) {
    asm volatile("s_waitcnt vmcnt(0)" ::: "memory");
    __syncthreads();
    if (threadIdx.x == 0) {
        unsigned* bar = b.bar;
        __builtin_amdgcn_s_waitcnt(0);
        unsigned nloc = b.st[0], nx = b.st[1];
        if (nloc == 0u) { xcd_barrier_complete(bar, b.x, nloc, nx); b.st[0] = nloc; b.st[1] = nx; }
        const unsigned old = xb_add(&bar[XB_XSUB(b.x)], 1u);
        const unsigned gen = old / nloc;
        if (old + 1u == (gen + 1u) * nloc) {
            __builtin_amdgcn_fence(__ATOMIC_RELEASE, "agent");
            asm volatile("s_waitcnt vmcnt(0)" ::: "memory");
            const unsigned og = xb_add(&bar[XB_TOP], 1u);
            const unsigned tg = og / nx;
            if (og + 1u == (tg + 1u) * nx) xb_add(&bar[XB_TOPGEN], 1u);
            else XB_SPIN(xb_ld(&bar[XB_TOPGEN]) == tg, bar);
            __builtin_amdgcn_fence(__ATOMIC_ACQUIRE, "agent");
            xb_add(&bar[XB_XGEN(b.x)], 1u);
            asm volatile("s_waitcnt vmcnt(0)" ::: "memory");
        } else {
            XB_SPIN(xb_ld(&bar[XB_XGEN(b.x)]) == gen, bar);
            __builtin_amdgcn_fence(__ATOMIC_ACQUIRE, "agent");
            asm volatile("s_waitcnt vmcnt(0)" ::: "memory");
        }
    }
    __syncthreads();
}

constexpr size_t CTL_BAR = 16384;
constexpr size_t CTL_BYTES = 32768;

#define PHASE(k, call) if (P.ph_lo <= (k) && (k) < P.ph_hi) { call; if ((k) + 1 < P.ph_hi) xcd_barrier(xb); }
__global__ void __launch_bounds__(256, 2) mega(Params P) {
    __shared__ __attribute__((aligned(16))) unsigned char smem[SMEM_BYTES + 16];
    unsigned* xbst = (unsigned*)(smem + SMEM_BYTES);
    cg::grid_group grid = cg::this_grid();
    if (threadIdx.x < 4) xbst[threadIdx.x] = 0u;
    __syncthreads();
    if (P.ph_lo < 0) grid.sync();
    XcdBarrier xb = xcd_barrier_post((unsigned*)(P.ws + WS_CTL + CTL_BAR), (volatile LAS unsigned*)xbst);
    PHASE(0, phase0(P, smem))
    PHASE(1, phase_inproj0(P, smem))
    PHASE(2, phase_cmp_s5e(P, smem))
    PHASE(3, phase_s5y(P, smem); phase_nsa(P, smem))
    PHASE(5, phase_glu(P, smem))
    PHASE(6, phase_outproj(P, smem, P.in[0], WS_WOUT0))
    PHASE(7, phase_ln_router(P, 0))
    PHASE(8, phase_moe_gu(P, smem, 0))
    PHASE(9, phase_moe_down(P, smem, 0))
    PHASE(10, phase_ln_ffn(P, 0))
    PHASE(11, phase_inproj1(P, smem))
    PHASE(12, phase_moba_gate(P, smem))
    PHASE(13, phase_moba_kv(P, smem))
    PHASE(14, phase_moba_own(P, smem))
    PHASE(15, phase_outproj(P, smem, P.out, WS_WOUT1))
    PHASE(16, phase_ln_router(P, 1))
    PHASE(17, phase_moe_gu(P, smem, 1))
    PHASE(18, phase_moe_down(P, smem, 1))
    PHASE(20, phase_ln_ffn(P, 1))
}

extern "C" void kernel_launch(void* const* d_in, const int* in_sizes, int n_in, void* d_out, int out_size, void* d_ws, size_t ws_size, hipStream_t stream) {
    static int grid = 0;
    if (grid == 0) {
        if (n_in != 32 || out_size != NT * DM || ws_size < WS_END) { fprintf(stderr, "kernel_launch: unexpected shapes (n_in %d, out %d, ws %zu)\n", n_in, out_size, ws_size); grid = -1; return; }
        int dev = 0, cus = 0, per_cu = 0;
        (void)hipGetDevice(&dev);
        (void)hipDeviceGetAttribute(&cus, hipDeviceAttributeMultiprocessorCount, dev);
        (void)hipOccupancyMaxActiveBlocksPerMultiprocessor(&per_cu, mega, 256, 0);
        if (per_cu < 1) per_cu = 1;
        if (per_cu > 2) per_cu = 2;
        grid = cus * per_cu;
    }
    if (grid < 0) return;
    (void)hipMemsetAsync((char*)d_ws + WS_CTL, 0, CTL_BYTES, stream);
    Params p{};
    for (int i = 0; i < 32; ++i) p.in[i] = (const float*)d_in[i];
    p.out = (float*)d_out; p.ws = (unsigned char*)d_ws;
    p.ph_lo = 0; p.ph_hi = NPH;
    void* args[] = {&p};
    hipError_t e = hipLaunchCooperativeKernel((void*)mega, dim3(grid), dim3(256), args, 0, stream);
    if (e != hipSuccess) fprintf(stderr, "cooperative launch failed: %s (grid %d)\n", hipGetErrorString(e), grid);
}
```

```cpp
#include <hip/hip_runtime.h>
#include <hip/hip_cooperative_groups.h>
#include <cstdio>
#include <cstdint>
namespace cg = cooperative_groups;

typedef unsigned short bf16_t;
typedef short bf16x8 __attribute__((ext_vector_type(8)));
typedef float f32x4 __attribute__((ext_vector_type(4)));
typedef unsigned u32x4 __attribute__((ext_vector_type(4)));
typedef unsigned u32x2 __attribute__((ext_vector_type(2)));
#define DI __device__ __forceinline__
#define LAS __attribute__((address_space(3)))
typedef float f32x16 __attribute__((ext_vector_type(16)));
typedef float f32x8 __attribute__((ext_vector_type(8)));
typedef __bf16 bf16x8v __attribute__((ext_vector_type(8)));
typedef __bf16 bf16x4v __attribute__((ext_vector_type(4)));
#define MFMA32(a, b, c) __builtin_amdgcn_mfma_f32_32x32x16_bf16((a), (b), (c), 0, 0, 0)

constexpr int NB = 8, SEQ = 4096, DM = 1024, NT = NB * SEQ;
constexpr float ALPHA = 1.41421356237f;
constexpr float LN_EPS = 1e-5f;
constexpr int NIN0 = 1920;
constexpr int NPH = 21;

constexpr size_t MiB = 1u << 20;
constexpr size_t WS_CTL = 0;
constexpr size_t WS_ROPE = 1 * MiB;
constexpr size_t WS_WIN0 = 2 * MiB;
constexpr size_t WS_WOUT0 = 6 * MiB;
constexpr size_t WS_WIN1 = 8 * MiB;
constexpr size_t WS_WOUT1 = 14 * MiB;
constexpr size_t WS_WGLU = 16 * MiB;
constexpr size_t WS_WCK1 = 16 * MiB + 512 * 1024;
constexpr size_t WS_WCV1 = 17 * MiB;
constexpr size_t WS_WCK2 = 17 * MiB + 512 * 1024;
constexpr size_t WS_WCV2 = WS_WCK2 + 16384;
constexpr size_t WS_CBIAS = WS_WCV2 + 16384;
constexpr size_t WS_S5AL = WS_CBIAS + 4096;
constexpr size_t WS_RTRW = 17 * MiB + 640 * 1024;
constexpr size_t WS_BTE = 18 * MiB;
constexpr size_t WS_BTY = 22 * MiB;
constexpr size_t WS_WGU = 42 * MiB;
constexpr size_t WS_WDN = 74 * MiB;
constexpr size_t WS_KMP = 90 * MiB;
constexpr size_t WS_WGT = 94 * MiB;
constexpr size_t WS_KMEAN = 94 * MiB + 512 * 1024;
constexpr size_t WS_KCMP = 95 * MiB;
constexpr size_t WS_VCMP = 95 * MiB + 512 * 1024;
constexpr size_t WS_ACTB = 96 * MiB;
constexpr size_t WS_MIX = 160 * MiB;
constexpr size_t WS_XP = 224 * MiB;
constexpr size_t WS_LIST2 = 416 * MiB;
constexpr size_t WS_SELM = 92 * MiB;
constexpr size_t WS_MCNT = 93 * MiB;
constexpr size_t WS_MLIST = WS_LIST2;
constexpr size_t WS_PO2 = 424 * MiB;
constexpr size_t WS_PML = 488 * MiB;
constexpr size_t WS_END = 504 * MiB;
constexpr size_t XP_Q0 = WS_XP;
constexpr size_t XP_KC = WS_XP + 32 * MiB;
constexpr size_t KVSZ = 8 * MiB;
constexpr size_t XP_GATES = WS_XP + 80 * MiB;
constexpr size_t XP_AEXT = WS_XP + 84 * MiB;
constexpr size_t XP_G5 = WS_XP + 124 * MiB;
constexpr size_t XP_YB = WS_XP;
constexpr size_t XP_H = WS_XP + 128 * MiB;
constexpr size_t XP_Q1 = WS_XP;

struct Params {
    const float* in[32];
    float* out;
    unsigned char* ws;
    int ph_lo, ph_hi;
};

DI bf16_t f2bf(float f) { unsigned u = __float_as_uint(f); return (bf16_t)((u + 0x7fffu + ((u >> 16) & 1u)) >> 16); }
DI float bf2f(bf16_t h) { return __uint_as_float(((unsigned)h) << 16); }
DI unsigned pk2(float lo, float hi) { return (unsigned)f2bf(lo) | ((unsigned)f2bf(hi) << 16); }
DI bf16x8 cvt8(f32x8 v) { return __builtin_bit_cast(bf16x8, __builtin_convertvector(v, bf16x8v)); }
DI u32x2 cvt4(f32x4 v) { return __builtin_bit_cast(u32x2, __builtin_convertvector(v, bf16x4v)); }
DI size_t kp_off(int key, int d) { return ((size_t)((key >> 5) * 4 + (d >> 4)) * 32 + (key & 31)) * 16 + (d & 15); }
DI int vp_pos(int ko) { return 8 * ((ko >> 2) & 1) + 4 * (ko >> 3) + (ko & 3); }
DI size_t vp_off(int key, int d) { return ((size_t)(key >> 4) * 64 + d) * 16 + vp_pos(key & 15); }
DI bf16_t ld_bf(const bf16_t* p) { return *p; }
DI f32x4 bf4_to_f(u32x2 w) { return (f32x4){__uint_as_float(w.x << 16), __uint_as_float(w.x & 0xffff0000u), __uint_as_float(w.y << 16), __uint_as_float(w.y & 0xffff0000u)}; }
template <int CTRL> DI float dpp_f(float v) { return __builtin_bit_cast(float, __builtin_amdgcn_update_dpp(0, __builtin_bit_cast(int, v), CTRL, 0xF, 0xF, true)); }
DI float wave_sum(float v) {
    v += dpp_f<0xB1>(v);
    v += dpp_f<0x4E>(v);
    v += dpp_f<0x141>(v);
    v += dpp_f<0x140>(v);
    { const auto s = __builtin_amdgcn_permlane16_swap(__float_as_uint(v), __float_as_uint(v), false, false); v = __uint_as_float(s[0]) + __uint_as_float(s[1]); }
    { const auto s = __builtin_amdgcn_permlane32_swap(__float_as_uint(v), __float_as_uint(v), false, false); v = __uint_as_float(s[0]) + __uint_as_float(s[1]); }
    return v;
}
DI float wave_max(float v) {
#pragma unroll
    for (int o = 32; o > 0; o >>= 1) v = fmaxf(v, __shfl_xor(v, o));
    return v;
}
DI float sigmoidf_(float x) { return __builtin_amdgcn_rcpf(1.f + __expf(-x)); }
DI float gelu_tanh(float x) { const float z = 0.7978845608028654f * (x + 0.044715f * x * x * x); return x * sigmoidf_(2.f * z); }

constexpr int GEMM_LDS = 65536;
template <bool TRANS = true, class RowPtr, class Epi>
DI void gemm128(RowPtr rowptr, const bf16_t* __restrict__ Bt, int ldb, int K, unsigned char* smem, Epi epi, int kskip_lo = 0, int kskip_hi = 0) {
    LAS unsigned char* lds = (LAS unsigned char*)smem;
    const int tid = threadIdx.x, lane = tid & 63, wave = tid >> 6, wr = wave >> 1, wc = wave & 1, fr = lane & 15, fq = lane >> 4;
    const int schunk = ((tid & 7) ^ ((tid >> 4) & 7)) * 8;
    const bf16_t* ga[4];
#pragma unroll
    for (int i = 0; i < 4; ++i) ga[i] = rowptr(i * 32 + (tid >> 3)) + schunk;
    const bf16_t* gb = Bt + (size_t)(tid >> 3) * ldb + schunk;
    const size_t gbs = (size_t)32 * ldb;
    auto stage = [&](int kt, int s) {
#pragma unroll
        for (int i = 0; i < 4; ++i) {
            __builtin_amdgcn_global_load_lds((const unsigned*)(ga[i] + kt * 64), (LAS unsigned*)(lds + s * 32768 + (i * 256 + tid) * 16), 16, 0, 0);
            __builtin_amdgcn_global_load_lds((const unsigned*)(gb + i * gbs + kt * 64), (LAS unsigned*)(lds + s * 32768 + 16384 + (i * 256 + tid) * 16), 16, 0, 0);
        }
    };
    f32x4 acc[4][4];
#pragma unroll
    for (int m = 0; m < 4; ++m)
#pragma unroll
        for (int n = 0; n < 4; ++n) acc[m][n] = (f32x4){0.f, 0.f, 0.f, 0.f};
    const int nskip = kskip_hi - kskip_lo, nk = (K >> 6) - nskip;
    const int swz = (fr >> 1) & 7;
    const int aoff = (wr * 64 + fr) * 128, boff = 16384 + (wc * 64 + fr) * 128;
    stage(kskip_lo == 0 ? nskip : 0, 0);
#pragma unroll 1
    for (int kt = 0; kt < nk; ++kt) {
        asm volatile("s_waitcnt vmcnt(0)" ::: "memory");
        __syncthreads();
        if (kt + 1 < nk) stage(kt + 1 < kskip_lo ? kt + 1 : kt + 1 + nskip, (kt + 1) & 1);
        const LAS unsigned char* cur = lds + (kt & 1) * 32768;
#pragma unroll
        for (int ks = 0; ks < 2; ++ks) {
            bf16x8 af[4], bfr[4];
            const int co = ((ks * 4 + fq) ^ swz) * 16;
#pragma unroll
            for (int m = 0; m < 4; ++m) af[m] = *(const LAS bf16x8*)(cur + aoff + m * 2048 + co);
#pragma unroll
            for (int n = 0; n < 4; ++n) bfr[n] = *(const LAS bf16x8*)(cur + boff + n * 2048 + co);
#pragma unroll
            for (int m = 0; m < 4; ++m)
#pragma unroll
                for (int n = 0; n < 4; ++n) acc[m][n] = TRANS ? __builtin_amdgcn_mfma_f32_16x16x32_bf16(bfr[n], af[m], acc[m][n], 0, 0, 0) : __builtin_amdgcn_mfma_f32_16x16x32_bf16(af[m], bfr[n], acc[m][n], 0, 0, 0);
        }
    }
    __syncthreads();
    epi(acc, wr, wc, lane);
}

DI int vblock() { const int G = gridDim.x; return (G & 7) == 0 ? (int)(blockIdx.x & 7) * (G >> 3) + (int)(blockIdx.x >> 3) : (int)blockIdx.x; }
DI void tile_mn(int it, int nN, int& mt, int& nt) { const int per = 8 * nN, grp = it / per, idx = it - grp * per; nt = idx >> 3; mt = grp * 8 + (idx & 7); }

DI int rope_pos(int l) { return (l & ~63) + ((2 * ((l & 31) >> 4) + ((l >> 5) & 1)) << 4) + (l & 15); }
DI int rowmap(int kind, int n) {
    if (kind == 1) {
        if (n < 512 || (n >= 512 && n < 640) || (n >= 768 && n < 896) || (n >= 1024 && n < 1152)) return rope_pos(n);
        return n < 1304 ? n : n + 104;
    }
    if (kind == 4) return n < 2048 ? rope_pos(n) : n;
    if (kind == 2) return ((n >> 5) << 6) + (n & 31);
    if (kind == 3) return ((n >> 5) << 6) + 32 + (n & 31);
    return n;
}
DI void tr_tile(const float* __restrict__ src, int K, int N, bf16_t* __restrict__ dst, int kind, int kt, int nt, float* s) {
    const int tid = threadIdx.x, k0 = kt * 64, n0 = nt * 64;
    {
        const int nn = tid & 63, kq = tid >> 6, n = n0 + nn;
#pragma unroll
        for (int i = 0; i < 16; ++i) { const int kk = kq + 4 * i; s[kk * 65 + nn] = (n < N) ? src[(size_t)(k0 + kk) * N + n] : 0.f; }
    }
    __syncthreads();
    {
        const int rn = tid >> 2, kseg = (tid & 3) * 16, n = n0 + rn;
        if (n < N) {
            unsigned w[8];
#pragma unroll
            for (int i = 0; i < 8; ++i) w[i] = pk2(s[(kseg + 2 * i) * 65 + rn], s[(kseg + 2 * i + 1) * 65 + rn]);
            bf16_t* d = dst + (size_t)rowmap(kind, n) * K + k0 + kseg;
            *(uint4*)d = make_uint4(w[0], w[1], w[2], w[3]);
            *(uint4*)(d + 8) = make_uint4(w[4], w[5], w[6], w[7]);
        }
    }
    __syncthreads();
}
struct CF { float re, im; };
DI CF cmul(CF a, CF b) { return {a.re * b.re - a.im * b.im, a.re * b.im + a.im * b.re}; }
DI CF s5_apow(const Params& P, int g, int p, float tau) {
    const float step = expf(P.in[10][g]);
    const float lr = P.in[8][g * 64 + p], li = P.in[9][g * 64 + p];
    const float mag = expf(lr * step * tau);
    float sn, cs; sincosf(li * step * tau, &sn, &cs);
    return {mag * cs, mag * sn};
}
DI CF s5_f(const Params& P, int g, int p) {
    const CF a = s5_apow(P, g, p, 1.f);
    const float lr = P.in[8][g * 64 + p], li = P.in[9][g * 64 + p];
    const float den = lr * lr + li * li;
    return {((a.re - 1.f) * lr + a.im * li) / den, (a.im * lr - (a.re - 1.f) * li) / den};
}
DI void phase0(const Params& P, unsigned char* smem) {
    const int tid = threadIdx.x;
    unsigned char* ws = P.ws;
    float* sf = (float*)smem;
    constexpr int N_TR0 = 16 * 29, N_TR1 = 256, N_TR2 = 16 * 48, N_TR3 = 256, N_TR4 = 64, N_TR5 = 64, N_TR6 = 64, N_TR7 = 2, N_TR8 = 2;
    constexpr int N_TRG = 64 * 32, N_TRU = 64 * 32, N_TRD = 64 * 32;
    constexpr int N_X = NT * DM / 8192, N_ROPE = 512, N_CB = 16, N_AL = 8, N_BTE = 256, N_BTYM = 32 * 63, N_BTYQ = 4096, N_ZP = 13;
    constexpr int N_RW = 2 * 36864 / 256;
    constexpr int TOTAL = N_RW + N_TR0 + N_TR1 + N_TR4 + N_TR5 + N_TR6 + N_TR7 + N_TR8 + N_X + N_ROPE + N_CB + N_AL + N_BTE + N_BTYM + N_BTYQ + N_ZP;
    for (int it0 = blockIdx.x; it0 < TOTAL; it0 += gridDim.x) {
        int it = it0;
        if (it < N_RW) {
            const int e = it * 256 + tid, layer = e / 36864, r = e % 36864;
            float* dst = (float*)(ws + WS_RTRW) + (size_t)layer * 36864;
            if (r < 4096) { const int o = r & 3, l = (r >> 2) & 63, jk = r >> 8, d = 4 * l + 256 * (jk >> 2) + (jk & 3); dst[r] = P.in[25][((size_t)layer * 1024 + d) * 4 + o]; }
            else { const int q = r - 4096, o = q & 3, l = (q >> 2) & 63, hf = (q >> 8) & 1, jk = (q >> 9) & 15, g = q >> 13, d = 4 * l + 256 * (jk >> 2) + (jk & 3);
                   dst[r] = P.in[27][(((size_t)layer * 4 + g) * 1024 + d) * 8 + hf * 4 + o]; }
            continue;
        } it -= N_RW;
        if (it < N_TR0) { tr_tile(P.in[1], 1024, 1816, (bf16_t*)(ws + WS_WIN0), 1, it / 29, it % 29, sf); continue; } it -= N_TR0;
        if (it < N_TR1) { tr_tile(P.in[18], 1024, 1024, (bf16_t*)(ws + WS_WOUT0), 0, it / 16, it % 16, sf); continue; } it -= N_TR1;
        if (it < N_TR4) { tr_tile(P.in[16], 512, 512, (bf16_t*)(ws + WS_WGLU), 0, it / 8, it % 8, sf); continue; } it -= N_TR4;
        if (it < N_TR5) { tr_tile(P.in[4], 2048, 128, (bf16_t*)(ws + WS_WCK1), 0, it / 2, it % 2, sf); continue; } it -= N_TR5;
        if (it < N_TR6) { tr_tile(P.in[6], 2048, 128, (bf16_t*)(ws + WS_WCV1), 0, it / 2, it % 2, sf); continue; } it -= N_TR6;
        if (it < N_TR7) { tr_tile(P.in[5], 128, 64, (bf16_t*)(ws + WS_WCK2), 0, it, 0, sf); continue; } it -= N_TR7;
        if (it < N_TR8) { tr_tile(P.in[7], 128, 64, (bf16_t*)(ws + WS_WCV2), 0, it, 0, sf); continue; } it -= N_TR8;
        if (it < N_X) {
            const float* x = P.in[0]; bf16_t* xb = (bf16_t*)(ws + WS_ACTB);
#pragma unroll
            for (int i = 0; i < 4; ++i) {
                const size_t idx = (size_t)it * 8192 + i * 2048 + tid * 8;
                const f32x4 a = __builtin_nontemporal_load((const f32x4*)(x + idx)), b = __builtin_nontemporal_load((const f32x4*)(x + idx + 4));
                *(uint4*)(xb + idx) = make_uint4(pk2(a.x, a.y), pk2(a.z, a.w), pk2(b.x, b.y), pk2(b.z, b.w));
            }
            continue;
        } it -= N_X;
        if (it < N_ROPE) {
            const int e = it * 256 + tid, pos = e >> 5, i = e & 31;
            const float inv = 1.0f / powf(10000.0f, (float)(2 * i) / 64.0f);
            const float ang = (float)pos * inv;
            ((float*)(ws + WS_ROPE))[e] = (float)cos((double)ang);
            ((float*)(ws + WS_ROPE))[4096 * 32 + e] = (float)sin((double)ang);
            continue;
        } it -= N_ROPE;
        if (it < N_CB) {
            const int kv = it >> 3, j0 = (it & 7) * 16, j = j0 + (tid & 15), sl = tid >> 4;
            const float* pe = P.in[kv ? 3 : 2]; const float* w1 = P.in[kv ? 6 : 4];
            float a = 0.f;
            for (int i = sl * 128; i < sl * 128 + 128; ++i) a += pe[i] * w1[(size_t)i * 128 + j];
            sf[tid] = a; __syncthreads();
            if (tid < 16) { float t = 0.f; for (int q = 0; q < 16; ++q) t += sf[q * 16 + tid]; ((float*)(ws + WS_CBIAS))[kv * 128 + j0 + tid] = t; }
            __syncthreads();
            continue;
        } it -= N_CB;
        if (it < N_AL) {
            const int e = it * 256 + tid, g = e >> 6, p = e & 63;
            const CF a = s5_apow(P, g, p, 32.f);
            ((float*)(ws + WS_S5AL))[e * 2] = a.re; ((float*)(ws + WS_S5AL))[e * 2 + 1] = a.im;
            continue;
        } it -= N_AL;
        if (it < N_BTE) {
            const int e = it * 256 + tid, g = e >> 11, p = (e >> 5) & 63, r = e & 31;
            const CF w = cmul(s5_apow(P, g, p, (float)(31 - r)), s5_f(P, g, p));
            bf16_t* d = (bf16_t*)(ws + WS_BTE) + (size_t)g * 128 * 512;
#pragma unroll
            for (int c = 0; c < 16; ++c) {
                const CF bb = {P.in[11][(g * 64 + p) * 16 + c], P.in[12][(g * 64 + p) * 16 + c]};
                const CF v = cmul(w, bb);
                d[(size_t)p * 512 + r * 16 + c] = f2bf(v.re);
                d[(size_t)(64 + p) * 512 + r * 16 + c] = f2bf(v.im);
            }
            continue;
        } it -= N_BTE;
        if (it < N_BTYM) {
            const int g = it / 63, dd = it % 63 - 31, ch = tid >> 4, c = tid & 15;
            float val = 0.f;
            if (dd >= 0) {
                float* sw = sf; float* sb = sf + 128; float* sc = sf + 128 + 2048;
                if (tid < 64) { const CF w = cmul(s5_apow(P, g, tid, (float)dd), s5_f(P, g, tid)); sw[2 * tid] = w.re; sw[2 * tid + 1] = w.im; }
#pragma unroll
                for (int i = 0; i < 4; ++i) {
                    const int e = tid + 256 * i;
                    sb[2 * e] = P.in[11][(size_t)g * 1024 + e]; sb[2 * e + 1] = P.in[12][(size_t)g * 1024 + e];
                    sc[2 * e] = P.in[13][(size_t)g * 1024 + e]; sc[2 * e + 1] = P.in[14][(size_t)g * 1024 + e];
                }
                __syncthreads();
#pragma unroll 8
                for (int p = 0; p < 64; ++p) {
                    const CF bb = {sb[2 * (p * 16 + c)], sb[2 * (p * 16 + c) + 1]};
                    const CF cc = {sc[2 * (ch * 64 + p)], sc[2 * (ch * 64 + p) + 1]};
                    const CF w = {sw[2 * p], sw[2 * p + 1]};
                    val += cmul(cc, cmul(w, bb)).re;
                }
                __syncthreads();
            }
            bf16_t* d = (bf16_t*)(ws + WS_BTY) + (size_t)g * 512 * 640;
            const bf16_t hv = f2bf(val);
            for (int r = 0; r < 32; ++r) { const int s = r + dd; if (s >= 0 && s < 32) d[(size_t)(s * 16 + ch) * 640 + r * 16 + c] = hv; }
            continue;
        } it -= N_BTYM;
        if (it < N_BTYQ) {
            const int e = it * 256 + tid, g = e >> 15, s = (e >> 10) & 31, ch = (e >> 6) & 15, p = e & 63;
            const CF cc = {P.in[13][(g * 16 + ch) * 64 + p], P.in[14][(g * 16 + ch) * 64 + p]};
            const CF w = cmul(cc, s5_apow(P, g, p, (float)(s + 1)));
            bf16_t* d = (bf16_t*)(ws + WS_BTY) + ((size_t)g * 512 + s * 16 + ch) * 640 + 512;
            d[p] = f2bf(w.re); d[64 + p] = f2bf(-w.im);
            continue;
        } it -= N_BTYQ;
        {
            uint4* d = (uint4*)((bf16_t*)(ws + WS_WIN0) + (size_t)(1304 + it * 8) * 1024);
#pragma unroll
            for (int i = 0; i < 4; ++i) d[i * 256 + tid] = make_uint4(0, 0, 0, 0);
        }
    }
}

DI void phase_inproj0(const Params& P, unsigned char* smem) {
    unsigned char* ws = P.ws;
    const bf16_t* A = (const bf16_t*)(ws + WS_ACTB);
    const float* cosT = (const float*)(ws + WS_ROPE);
    const float* sinT = cosT + 4096 * 32;
    constexpr int NTN = NIN0 / 128;
    for (int it = vblock(); it < (NT / 128) * NTN; it += gridDim.x) {
        int mt, nt; tile_mn(it, NTN, mt, nt);
        const int m0 = mt * 128;
        auto rowptr = [=](int r) { return A + (size_t)(m0 + r) * 1024; };
        const bf16_t* Bt = (const bf16_t*)(ws + WS_WIN0) + (size_t)nt * 128 * 1024;
        if (nt == 7 || nt == 9) {
            auto epi = [=](f32x4 (&acc)[4][4], int wr, int wc, int lane) {
                const int fr = lane & 15, fq = lane >> 4, which = nt == 7 ? 3 : 5, g = wc;
#pragma unroll
                for (int m = 0; m < 4; ++m) {
                    const int t = m0 + wr * 64 + m * 16 + fq * 4, s = t & 4095, b = t >> 12;
                    bf16_t* dst = (bf16_t*)(ws + XP_KC + (size_t)which * KVSZ) + (size_t)(b * 2 + g) * 4096 * 64;
#pragma unroll
                    for (int n = 0; n < 4; ++n) *(u32x2*)(dst + vp_off(s, n * 16 + fr)) = cvt4(acc[m][n]);
                }
            };
            gemm128<false>(rowptr, Bt, 1024, 1024, smem, epi);
            continue;
        }
        auto epi = [=](f32x4 (&acc)[4][4], int wr, int wc, int lane) {
            const int u64 = nt * 2 + wc, fr = lane & 15, fq = lane >> 4;
#pragma unroll
            for (int m = 0; m < 4; ++m) {
                const int t = m0 + wr * 64 + m * 16 + fr, s = t & 4095, b = t >> 12;
                if (u64 < 20) {
                    const bool isq = u64 < 8;
                    const int which = (u64 - 8) >> 1, g = (u64 - 8) & 1;
                    if (isq || ((which & 1) == 0)) {
#pragma unroll
                        for (int n2 = 0; n2 < 2; ++n2) {
                            const int i = n2 * 16 + fq * 4;
                            const f32x4 c = *(const f32x4*)(cosT + s * 32 + i), sn = *(const f32x4*)(sinT + s * 32 + i);
                            const f32x4 x1 = acc[m][2 * n2], x2 = acc[m][2 * n2 + 1];
                            const u32x2 o1 = cvt4(x1 * c - x2 * sn), o2 = cvt4(x1 * sn + x2 * c);
                            if (isq) { bf16_t* dst = (bf16_t*)(ws + XP_Q0) + (size_t)t * 512 + u64 * 64; *(u32x2*)(dst + i) = o1; *(u32x2*)(dst + i + 32) = o2; }
                            else {
                                bf16_t* dst = (bf16_t*)(ws + XP_KC + (size_t)which * KVSZ) + (size_t)(b * 2 + g) * 4096 * 64;
                                if (which == 0) { *(u32x2*)(dst + (size_t)s * 64 + i) = o1; *(u32x2*)(dst + (size_t)s * 64 + i + 32) = o2; }
                                else { *(u32x2*)(dst + kp_off(s, i)) = o1; *(u32x2*)(dst + kp_off(s, i + 32)) = o2; }
                            }
                        }
                    } else {
                        bf16_t* dst = (bf16_t*)(ws + XP_KC + (size_t)which * KVSZ) + ((size_t)(b * 2 + g) * 4096 + s) * 64;
#pragma unroll
                        for (int n = 0; n < 4; ++n) *(u32x2*)(dst + n * 16 + fq * 4) = cvt4(acc[m][n]);
                    }
                } else if (u64 == 20) {
#pragma unroll
                    for (int n = 0; n < 2; ++n) {
                        const int c0 = n * 16 + fq * 4;
                        if (c0 < 24) { f32x4 o; o.x = sigmoidf_(acc[m][n].x); o.y = sigmoidf_(acc[m][n].y); o.z = sigmoidf_(acc[m][n].z); o.w = sigmoidf_(acc[m][n].w); *(f32x4*)((float*)(ws + XP_GATES) + (size_t)t * 24 + c0) = o; }
                    }
                } else if (u64 >= 22) {
#pragma unroll
                    for (int n = 0; n < 4; ++n) {
                        const int g5 = (u64 - 22) * 4 + n;
                        *(u32x2*)((bf16_t*)(ws + XP_AEXT) + ((size_t)g5 * 1024 + (t >> 5)) * 640 + (t & 31) * 16 + fq * 4) = cvt4(acc[m][n]);
                    }
                }
            }
        };
        gemm128(rowptr, Bt, 1024, 1024, smem, epi);
    }
}

constexpr int N_LATE = 16 * 48 + 256 + 3 * 64 * 32;
DI void late_weights(const Params& P, unsigned char* smem, int it) {
    unsigned char* ws = P.ws;
    float* sf = (float*)smem;
    constexpr int N_TR2 = 16 * 48, N_TR3 = 256, N_TRG = 64 * 32, N_TRU = 64 * 32;
    if (it < N_TR2) { tr_tile(P.in[19], 1024, 3072, (bf16_t*)(ws + WS_WIN1), 4, it / 48, it % 48, sf); return; } it -= N_TR2;
    if (it < N_TR3) { tr_tile(P.in[20], 1024, 1024, (bf16_t*)(ws + WS_WOUT1), 0, it / 16, it % 16, sf); return; } it -= N_TR3;
    if (it < N_TRG) { const int mat = it >> 5, r = it & 31; tr_tile(P.in[29] + (size_t)mat * 1024 * 128, 1024, 128, (bf16_t*)(ws + WS_WGU) + (size_t)mat * 256 * 1024, 2, r >> 1, r & 1, sf); return; } it -= N_TRG;
    if (it < N_TRU) { const int mat = it >> 5, r = it & 31; tr_tile(P.in[30] + (size_t)mat * 1024 * 128, 1024, 128, (bf16_t*)(ws + WS_WGU) + (size_t)mat * 256 * 1024, 3, r >> 1, r & 1, sf); return; } it -= N_TRU;
    { const int mat = it >> 5, r = it & 31; tr_tile(P.in[31] + (size_t)mat * 128 * 1024, 128, 1024, (bf16_t*)(ws + WS_WDN) + (size_t)mat * 1024 * 128, 0, r >> 4, r & 15, sf); }
}

DI void s5y_tile(const Params& P, unsigned char* smem, int g, int mt, int nt);
DI void phase_cmp_s5e(const Params& P, unsigned char* smem) {
    unsigned char* ws = P.ws;
    const int tid = threadIdx.x, lane = tid & 63, wave = tid >> 6;
    for (int it = blockIdx.x; it < 64 + 256 + N_LATE; it += gridDim.x) {
        if (it >= 64 + 256) { late_weights(P, smem, it - 320); continue; }
        if (it < 64) {
            const int kv = it >> 5, bg = (it >> 1) & 15, mt = it & 1;
            const bf16_t* src = (const bf16_t*)(ws + XP_KC + (size_t)kv * KVSZ) + (size_t)bg * 4096 * 64;
            const float* cb = (const float*)(ws + WS_CBIAS) + kv * 128;
            bf16_t* sH = (bf16_t*)smem;
            auto rowptr = [=](int r) { int rr = mt * 128 + r; rr = rr > 254 ? 254 : rr; return src + (size_t)rr * 1024; };
            auto epi = [=](f32x4 (&acc)[4][4], int wr, int wc, int ln) {
                const int fr = ln & 15, fq = ln >> 4;
#pragma unroll
                for (int m = 0; m < 4; ++m)
#pragma unroll
                    for (int n = 0; n < 4; ++n)
#pragma unroll
                        for (int j = 0; j < 4; ++j) {
                            const int r = wr * 64 + m * 16 + fr, c = wc * 64 + n * 16 + fq * 4 + j;
                            sH[r * 136 + c] = f2bf(gelu_tanh(acc[m][n][j] + cb[c]));
                        }
            };
            gemm128(rowptr, (const bf16_t*)(ws + (kv ? WS_WCV1 : WS_WCK1)), 2048, 2048, smem, epi);
            __syncthreads();
            const bf16_t* W2 = (const bf16_t*)(ws + (kv ? WS_WCV2 : WS_WCK2));
            f32x4 a2[2][4];
#pragma unroll
            for (int m = 0; m < 2; ++m)
#pragma unroll
                for (int n = 0; n < 4; ++n) a2[m][n] = (f32x4){0.f, 0.f, 0.f, 0.f};
#pragma unroll
            for (int ks = 0; ks < 4; ++ks) {
                bf16x8 af[2], bfr[4];
#pragma unroll
                for (int m = 0; m < 2; ++m) af[m] = *(const bf16x8*)(sH + (wave * 32 + m * 16 + (lane & 15)) * 136 + ks * 32 + (lane >> 4) * 8);
#pragma unroll
                for (int n = 0; n < 4; ++n) bfr[n] = *(const bf16x8*)(W2 + (n * 16 + (lane & 15)) * 128 + ks * 32 + (lane >> 4) * 8);
#pragma unroll
                for (int m = 0; m < 2; ++m)
#pragma unroll
                    for (int n = 0; n < 4; ++n) a2[m][n] = __builtin_amdgcn_mfma_f32_16x16x32_bf16(af[m], bfr[n], a2[m][n], 0, 0, 0);
            }
            bf16_t* dst = (bf16_t*)(ws + (kv ? WS_VCMP : WS_KCMP)) + (size_t)bg * 256 * 64;
#pragma unroll
            for (int m = 0; m < 2; ++m)
#pragma unroll
                for (int n = 0; n < 4; ++n)
#pragma unroll
                    for (int j = 0; j < 4; ++j) {
                        const int row = mt * 128 + wave * 32 + m * 16 + (lane >> 4) * 4 + j, col = n * 16 + (lane & 15);
                        dst[kv ? vp_off(row, col) : kp_off(row, col)] = row < 255 ? f2bf(a2[m][n][j]) : (bf16_t)0;
                    }
            __syncthreads();
        } else {
            const int it2 = it - 64, g = it2 >> 3, b = it2 & 7;
            bf16_t* aext = (bf16_t*)(ws + XP_AEXT) + ((size_t)g * 1024 + b * 128) * 640;
            float* sE = (float*)smem;
            auto rowptr = [=](int r) { return (const bf16_t*)aext + (size_t)r * 640; };
            auto epi = [=](f32x4 (&acc)[4][4], int wr, int wc, int ln) {
                const int fr = ln & 15, fq = ln >> 4;
#pragma unroll
                for (int m = 0; m < 4; ++m)
#pragma unroll
                    for (int n = 0; n < 4; ++n)
#pragma unroll
                        for (int j = 0; j < 4; ++j) sE[(wr * 64 + m * 16 + fr) * 129 + wc * 64 + n * 16 + fq * 4 + j] = acc[m][n][j];
            };
            gemm128(rowptr, (const bf16_t*)(ws + WS_BTE) + (size_t)g * 128 * 512, 512, 512, smem, epi);
            __syncthreads();
            if (tid < 64) {
                const float ar = ((const float*)(ws + WS_S5AL))[(g * 64 + tid) * 2], ai = ((const float*)(ws + WS_S5AL))[(g * 64 + tid) * 2 + 1];
                float xr = 0.f, xi = 0.f;
                for (int c = 0; c < 128; ++c) {
                    aext[(size_t)c * 640 + 512 + tid] = f2bf(xr);
                    aext[(size_t)c * 640 + 576 + tid] = f2bf(xi);
                    const float er = sE[c * 129 + tid], ei = sE[c * 129 + 64 + tid];
                    const float nr = ar * xr - ai * xi + er, ni = ar * xi + ai * xr + ei;
                    xr = nr; xi = ni;
                }
            }
            asm volatile("s_waitcnt vmcnt(0)" ::: "memory");
            __syncthreads();
#pragma unroll 1
            for (int nt = 0; nt < 4; ++nt) s5y_tile(P, smem, g, b, nt);
        }
    }
}

DI void s5y_tile(const Params& P, unsigned char* smem, int g, int mt, int nt) {
    unsigned char* ws = P.ws;
    const bf16_t* aext = (const bf16_t*)(ws + XP_AEXT) + (size_t)g * 1024 * 640;
    const float* dsk = P.in[15];
    auto rowptr = [=](int r) { return aext + (size_t)(mt * 128 + r) * 640; };
    auto epi = [=](f32x4 (&acc)[4][4], int wr, int wc, int ln) {
        const int fr = ln & 15, fq = ln >> 4;
        const f32x4 dk = *(const f32x4*)(dsk + g * 16 + fq * 4);
#pragma unroll
        for (int m = 0; m < 4; ++m) {
            const int cr = mt * 128 + wr * 64 + m * 16 + fr;
#pragma unroll
            for (int n = 0; n < 4; ++n) {
                const int sp = nt * 8 + wc * 4 + n, t = cr * 32 + sp;
                const f32x4 u = bf4_to_f(*(const u32x2*)(aext + (size_t)cr * 640 + sp * 16 + fq * 4));
                const f32x4 y = acc[m][n] + dk * u;
                *(u32x2*)((bf16_t*)(ws + XP_G5) + (size_t)t * 512 + g * 16 + fq * 4) = cvt4((f32x4){gelu_tanh(y.x), gelu_tanh(y.y), gelu_tanh(y.z), gelu_tanh(y.w)});
            }
        }
    };
    gemm128(rowptr, (const bf16_t*)(ws + WS_BTY) + ((size_t)g * 512 + nt * 128) * 640, 640, 640, smem, epi, 2 * nt + 2, 8);
}
struct FA { f32x16 o0, o1; float m, l; };
DI void fa_init(FA& st) {
#pragma unroll
    for (int i = 0; i < 16; ++i) { st.o0[i] = 0.f; st.o1[i] = 0.f; }
    st.m = -1e30f; st.l = 0.f;
}
constexpr float FA_THR = 8.f;
template <int MODE, class Valid>
DI void fa_tile(FA& st, const bf16x8 (&qf)[4], const LAS bf16_t* Kt, const LAS bf16_t* Vt, int r, int h, float c, bool rowok, Valid valid) {
    const LAS bf16_t* kb = Kt + r * 16 + 8 * h;
    const LAS bf16_t* vb = Vt + r * 16 + 8 * h;
    bf16x8 kf[4], vf[4];
#pragma unroll
    for (int ks = 0; ks < 4; ++ks) kf[ks] = *(const LAS bf16x8*)(kb + ks * 512);
#pragma unroll
    for (int sub = 0; sub < 2; ++sub) {
        f32x16 acc;
#pragma unroll
        for (int i = 0; i < 16; ++i) acc[i] = 0.f;
#pragma unroll
        for (int ks = 0; ks < 4; ++ks) acc = MFMA32(kf[ks], qf[ks], acc);
#pragma unroll
        for (int s2 = 0; s2 < 2; ++s2) { vf[2 * s2] = *(const LAS bf16x8*)(vb + ((sub * 2 + s2) * 64) * 16); vf[2 * s2 + 1] = *(const LAS bf16x8*)(vb + ((sub * 2 + s2) * 64 + 32) * 16); }
        if (sub == 0) {
#pragma unroll
            for (int ks = 0; ks < 4; ++ks) kf[ks] = *(const LAS bf16x8*)(kb + (4 + ks) * 512);
        }
        __builtin_amdgcn_sched_barrier(0);
        float mx = -INFINITY;
#pragma unroll
        for (int i = 0; i < 16; ++i) {
            if (MODE == 2) { const int koff = sub * 32 + (i & 3) + 8 * (i >> 2) + 4 * h; acc[i] = valid(koff) ? acc[i] : -INFINITY; }
            mx = fmaxf(mx, acc[i]);
        }
        {
            const auto sw = __builtin_amdgcn_permlane32_swap(__float_as_uint(mx), __float_as_uint(mx), false, false);
            mx = fmaxf(__uint_as_float(sw[0]), __uint_as_float(sw[1]));
        }
        const float cand = mx * c;
        const bool upd = cand > st.m + FA_THR;
        if (__ballot(upd)) {
            const float mn = upd ? cand : st.m, alpha = __builtin_amdgcn_exp2f(st.m - mn);
            st.m = mn; st.l *= alpha;
#pragma unroll
            for (int i = 0; i < 16; ++i) { st.o0[i] *= alpha; st.o1[i] *= alpha; }
        }
        const float nb = (MODE == 1 && !rowok) ? -INFINITY : -st.m;
        float ps0 = 0.f, ps1 = 0.f;
#pragma unroll
        for (int i = 0; i < 16; i += 2) {
            acc[i] = __builtin_amdgcn_exp2f(__builtin_fmaf(acc[i], c, nb));
            acc[i + 1] = __builtin_amdgcn_exp2f(__builtin_fmaf(acc[i + 1], c, nb));
            ps0 += acc[i]; ps1 += acc[i + 1];
        }
        st.l += ps0 + ps1;
#pragma unroll
        for (int s2 = 0; s2 < 2; ++s2) {
            const bf16x8 pk = cvt8((f32x8){acc[8 * s2], acc[8 * s2 + 1], acc[8 * s2 + 2], acc[8 * s2 + 3], acc[8 * s2 + 4], acc[8 * s2 + 5], acc[8 * s2 + 6], acc[8 * s2 + 7]});
            st.o0 = MFMA32(vf[2 * s2], pk, st.o0);
            st.o1 = MFMA32(vf[2 * s2 + 1], pk, st.o1);
        }
    }
}
DI void fa_issue(const bf16_t* gK, const bf16_t* gV, LAS unsigned char* buf, int tid) {
    __builtin_amdgcn_global_load_lds((const unsigned*)(gK + tid * 8), (LAS unsigned*)(buf + tid * 16), 16, 0, 0);
    __builtin_amdgcn_global_load_lds((const unsigned*)(gK + (tid + 256) * 8), (LAS unsigned*)(buf + (tid + 256) * 16), 16, 0, 0);
    __builtin_amdgcn_global_load_lds((const unsigned*)(gV + tid * 8), (LAS unsigned*)(buf + 8192 + tid * 16), 16, 0, 0);
    __builtin_amdgcn_global_load_lds((const unsigned*)(gV + (tid + 256) * 8), (LAS unsigned*)(buf + 8192 + (tid + 256) * 16), 16, 0, 0);
}
DI void fa_wait(int j, int n) {
    const int rem = n - 1 - j;
    if (rem >= 2) asm volatile("s_waitcnt vmcnt(8)" ::: "memory");
    else if (rem == 1) asm volatile("s_waitcnt vmcnt(4)" ::: "memory");
    else asm volatile("s_waitcnt vmcnt(0)" ::: "memory");
    __builtin_amdgcn_s_barrier();
    asm volatile("" ::: "memory");
}

constexpr int NSA_LDS_IMP = 65536;
constexpr int NSA_LDS_SCS = NSA_LDS_IMP + 8192;
constexpr int NSA_LDS_MSK = NSA_LDS_SCS + 1024;
DI void phase_nsa(const Params& P, unsigned char* smem) {
    unsigned char* ws = P.ws;
    const int tid = threadIdx.x, lane = tid & 63, wave = tid >> 6, r = lane & 31, h = lane >> 5;
    const float c = 0.125f * 1.4426950408889634f;
    LAS unsigned char* lds = (LAS unsigned char*)smem;
    float* impw = (float*)(smem + NSA_LDS_IMP) + wave * 512;
    float* scs = (float*)(smem + NSA_LDS_SCS) + wave * 64;
    unsigned long long* mskw = (unsigned long long*)(smem + NSA_LDS_MSK) + wave * 8;
    for (int it = blockIdx.x; it < 2048; it += gridDim.x) {
        const int qt = 127 - (it >> 4), bg = it & 15, b = bg >> 1, g = bg & 1, t0 = qt * 32, qblk = t0 >> 6;
        const int ql = r >> 2, z = r & 3, s = t0 + wave * 8 + ql, t = b * 4096 + s;
        const bf16_t* Qg = (const bf16_t*)(ws + XP_Q0) + (size_t)t * 512 + (g * 4 + z) * 64;
        bf16x8 qf[4];
#pragma unroll
        for (int ks = 0; ks < 4; ++ks) qf[ks] = *(const bf16x8*)(Qg + ks * 16 + 8 * h);
        const float* gt = (const float*)(ws + XP_GATES) + (size_t)t * 24 + (g * 4 + z) * 3;
        const float g_c = gt[0], g_s = gt[1], g_w = gt[2];
        const bf16_t* Kc = (const bf16_t*)(ws + WS_KCMP) + (size_t)bg * 256 * 64;
        const bf16_t* Vc = (const bf16_t*)(ws + WS_VCMP) + (size_t)bg * 256 * 64;
        const bf16_t* Ks = (const bf16_t*)(ws + XP_KC + 2 * KVSZ) + (size_t)bg * 4096 * 64;
        const bf16_t* Vs = (const bf16_t*)(ws + XP_KC + 3 * KVSZ) + (size_t)bg * 4096 * 64;
        const bf16_t* Kw = (const bf16_t*)(ws + XP_KC + 4 * KVSZ) + (size_t)bg * 4096 * 64;
        const bf16_t* Vw = (const bf16_t*)(ws + XP_KC + 5 * KVSZ) + (size_t)bg * 4096 * 64;
        const int nct = ((t0 >> 4) + 1 + 63) >> 6;
        const int w0 = (t0 - 255) < 0 ? 0 : (t0 - 255) >> 6;
        const int e1 = nct, e2 = 2 * nct, e3 = e2 + qblk + 1, e4 = e3 + (qblk - w0 + 1);
        const int nc = s >= 31 ? ((s - 31) >> 4) + 1 : 0;
        const int s_lo = t0 + wave * 8, s_hi = s_lo + 7, nc_min = s_lo >= 31 ? ((s_lo - 31) >> 4) + 1 : 0;
        for (int i = lane; i < 512; i += 64) impw[i] = 0.f;
        auto tile_ptrs = [&](int i, const bf16_t*& gk, const bf16_t*& gv) {
            if (i < e1) { gk = Kc + (size_t)i * 4096; gv = Vc + (size_t)i * 4096; }
            else if (i < e2) { gk = Kc + (size_t)(i - e1) * 4096; gv = Vc + (size_t)(i - e1) * 4096; }
            else if (i < e3) { gk = Ks + (size_t)(i - e2) * 4096; gv = Vs + (size_t)(i - e2) * 4096; }
            else { gk = Kw + (size_t)(w0 + i - e3) * 4096; gv = Vw + (size_t)(w0 + i - e3) * 4096; }
        };
        FA st; fa_init(st);
        f32x16 out0, out1;
#pragma unroll
        for (int i = 0; i < 16; ++i) { out0[i] = 0.f; out1[i] = 0.f; }
        float m_c = -1e30f, il_c = 0.f;
        unsigned long long mymask = 0ull;
        asm volatile("s_waitcnt vmcnt(0)" ::: "memory");
        __builtin_amdgcn_s_barrier();
#pragma unroll
        for (int i = 0; i < 3; ++i) if (i < e4) { const bf16_t *gk, *gv; tile_ptrs(i, gk, gv); fa_issue(gk, gv, lds + i * 16384, tid); }
        for (int i = 0; i < e4; ++i) {
            fa_wait(i, e4);
            if (i + 3 < e4) { const bf16_t *gk, *gv; tile_ptrs(i + 3, gk, gv); fa_issue(gk, gv, lds + ((i + 3) & 3) * 16384, tid); }
            const LAS bf16_t* cur = (const LAS bf16_t*)(lds + (i & 3) * 16384);
            if (i < e1) {
                const int nb = i * 64;
                { if (nb + 63 < nc_min) fa_tile<0>(st, qf, cur, cur + 4096, r, h, c, true, [=](int) { return true; }); else fa_tile<2>(st, qf, cur, cur + 4096, r, h, c, true, [=](int koff) { return nb + koff < nc; }); }
                if (i == e1 - 1) {
                    const float l = st.l + __shfl_xor(st.l, 32);
                    il_c = 1.f / fmaxf(l, 1e-30f); m_c = st.m;
                    const float f = g_c * il_c;
#pragma unroll
                    for (int k = 0; k < 16; ++k) { out0[k] = st.o0[k] * f; out1[k] = st.o1[k] * f; }
                    fa_init(st);
                }
            } else if (i < e2) {
                const int nb = (i - e1) * 64;
#pragma unroll
                for (int sub = 0; sub < 2; ++sub) {
                    f32x16 acc;
#pragma unroll
                    for (int k = 0; k < 16; ++k) acc[k] = 0.f;
#pragma unroll
                    for (int ks = 0; ks < 4; ++ks) acc = MFMA32(*(const LAS bf16x8*)(cur + ((sub * 4 + ks) * 32 + r) * 16 + 8 * h), qf[ks], acc);
#pragma unroll
                    for (int q4 = 0; q4 < 4; ++q4) {
                        float p[4];
#pragma unroll
                        for (int k = 0; k < 4; ++k) {
                            const int n = nb + sub * 32 + 8 * q4 + 4 * h + k;
                            p[k] = (n < nc) ? __builtin_amdgcn_exp2f(acc[4 * q4 + k] * c - m_c) * il_c : 0.f;
                        }
                        float a = (p[0] + p[1]) + (p[2] + 0.5f * p[3]), cn = 0.5f * p[3];
                        a += __shfl_xor(a, 1); a += __shfl_xor(a, 2);
                        cn += __shfl_xor(cn, 1); cn += __shfl_xor(cn, 2);
                        const int jb = ((nb + sub * 32) >> 2) + 2 * q4 + h;
                        if (z == 0) { atomicAdd(&impw[ql * 64 + jb], a); if (jb + 1 < 64) atomicAdd(&impw[ql * 64 + jb + 1], cn); }
                    }
                }
                if (i == e2 - 1) {
                    __builtin_amdgcn_wave_barrier();
#pragma unroll 1
                    for (int qq = 0; qq < 8; ++qq) {
                        const int j = lane;
                        const float imp = impw[qq * 64 + j];
                        const float score = (j > qblk) ? -1.f : ((j == 0 || j == qblk || j == qblk - 1) ? 1e3f : imp);
                        scs[j] = score;
                        __builtin_amdgcn_wave_barrier();
                        int rank = 0;
#pragma unroll 8
                        for (int jj = 0; jj < 64; ++jj) { const float o = scs[jj]; rank += (o > score || (o == score && jj < j)) ? 1 : 0; }
                        const unsigned long long mk = __ballot(rank < 8 && score >= 0.f);
                        if (lane == 0) mskw[qq] = mk;
                        __builtin_amdgcn_wave_barrier();
                    }
                    mymask = mskw[ql];
                }
            } else if (i < e3) {
                const int j = i - e2;
                const bool sel = (mymask >> j) & 1ull;
                if (__ballot(sel)) {
                    if (j < qblk) fa_tile<1>(st, qf, cur, cur + 4096, r, h, c, sel, [=](int) { return true; });
                    else { const int kb = j * 64; fa_tile<2>(st, qf, cur, cur + 4096, r, h, c, true, [=](int koff) { return sel && (kb + koff <= s); }); }
                }
                if (i == e3 - 1) {
                    const float l = st.l + __shfl_xor(st.l, 32);
                    const float f = g_s / fmaxf(l, 1e-30f);
#pragma unroll
                    for (int k = 0; k < 16; ++k) { out0[k] += st.o0[k] * f; out1[k] += st.o1[k] * f; }
                    fa_init(st);
                }
            } else {
                const int kb = (w0 + i - e3) * 64;
                { if (kb >= s_hi - 255 && kb + 63 <= s_lo) fa_tile<0>(st, qf, cur, cur + 4096, r, h, c, true, [=](int) { return true; }); else fa_tile<2>(st, qf, cur, cur + 4096, r, h, c, true, [=](int koff) { const int key = kb + koff; return key <= s && key >= s - 255; }); }
            }
        }
        {
            const float l = st.l + __shfl_xor(st.l, 32);
            const float f = g_w / fmaxf(l, 1e-30f);
#pragma unroll
            for (int k = 0; k < 16; ++k) { out0[k] += st.o0[k] * f; out1[k] += st.o1[k] * f; }
        }
        bf16_t* o = (bf16_t*)(ws + WS_MIX) + (size_t)t * 1024 + (g * 4 + z) * 64;
#pragma unroll
        for (int g4 = 0; g4 < 4; ++g4) {
            *(u32x2*)(o + 8 * g4 + 4 * h) = cvt4((f32x4){out0[4 * g4], out0[4 * g4 + 1], out0[4 * g4 + 2], out0[4 * g4 + 3]});
            *(u32x2*)(o + 32 + 8 * g4 + 4 * h) = cvt4((f32x4){out1[4 * g4], out1[4 * g4 + 1], out1[4 * g4 + 2], out1[4 * g4 + 3]});
        }
    }
}

DI void phase_glu(const Params& P, unsigned char* smem) {
    unsigned char* ws = P.ws;
    const bf16_t* G5 = (const bf16_t*)(ws + XP_G5);
    const float* gb = P.in[17];
    for (int it = vblock(); it < (NT / 128) * 4; it += gridDim.x) {
        int mt, nt; tile_mn(it, 4, mt, nt);
        const int m0 = mt * 128;
        auto rowptr = [=](int r) { return G5 + (size_t)(m0 + r) * 512; };
        auto epi = [=](f32x4 (&acc)[4][4], int wr, int wc, int ln) {
            const int fr = ln & 15, fq = ln >> 4;
#pragma unroll
            for (int m = 0; m < 4; ++m) {
                const int row = m0 + wr * 64 + m * 16 + fr;
#pragma unroll
                for (int n = 0; n < 4; ++n) {
                    const int col = nt * 128 + wc * 64 + n * 16 + fq * 4;
                    const f32x4 gv = bf4_to_f(*(const u32x2*)(G5 + (size_t)row * 512 + col)), bb = *(const f32x4*)(gb + col), z = acc[m][n] + bb;
                    *(u32x2*)((bf16_t*)(ws + WS_MIX) + (size_t)row * 1024 + 512 + col) = cvt4((f32x4){gv.x * sigmoidf_(z.x), gv.y * sigmoidf_(z.y), gv.z * sigmoidf_(z.z), gv.w * sigmoidf_(z.w)});
                }
            }
        };
        gemm128(rowptr, (const bf16_t*)(ws + WS_WGLU) + (size_t)nt * 128 * 512, 512, 512, smem, epi);
    }
}

DI void phase_outproj(const Params& P, unsigned char* smem, const float* xres, size_t wt_off) {
    unsigned char* ws = P.ws;
    const bf16_t* A = (const bf16_t*)(ws + WS_MIX);
    float* out = P.out;
    for (int it = vblock(); it < (NT / 128) * 8; it += gridDim.x) {
        int mt, nt; tile_mn(it, 8, mt, nt);
        const int m0 = mt * 128;
        auto rowptr = [=](int r) { return A + (size_t)(m0 + r) * 1024; };
        auto epi = [=](f32x4 (&acc)[4][4], int wr, int wc, int ln) {
            const int fr = ln & 15, fq = ln >> 4;
#pragma unroll
            for (int m = 0; m < 4; ++m) {
                const size_t base = (size_t)(m0 + wr * 64 + m * 16 + fr) * 1024 + nt * 128 + wc * 64 + fq * 4;
                f32x4 xr[4];
#pragma unroll
                for (int n = 0; n < 4; ++n) xr[n] = *(const f32x4*)(xres + base + n * 16);
#pragma unroll
                for (int n = 0; n < 4; ++n) *(f32x4*)(out + base + n * 16) = xr[n] * ALPHA + acc[m][n];
            }
        };
        gemm128(rowptr, (const bf16_t*)(ws + wt_off) + (size_t)nt * 128 * 1024, 1024, 1024, smem, epi);
    }
}

DI void ln_row(float (&v)[16], const float* __restrict__ g, const float* __restrict__ bta, int lane) {
    float s = 0.f;
#pragma unroll
    for (int i = 0; i < 16; ++i) s += v[i];
    const float mu = wave_sum(s) * (1.f / 1024.f);
    float q = 0.f;
#pragma unroll
    for (int i = 0; i < 16; ++i) { v[i] -= mu; q += v[i] * v[i]; }
    const float rstd = rsqrtf(wave_sum(q) * (1.f / 1024.f) + LN_EPS);
#pragma unroll
    for (int j = 0; j < 4; ++j) {
        const float4 gg = *(const float4*)(g + 4 * lane + 256 * j), bb = *(const float4*)(bta + 4 * lane + 256 * j);
        v[4 * j + 0] = v[4 * j + 0] * rstd * gg.x + bb.x; v[4 * j + 1] = v[4 * j + 1] * rstd * gg.y + bb.y;
        v[4 * j + 2] = v[4 * j + 2] * rstd * gg.z + bb.z; v[4 * j + 3] = v[4 * j + 3] * rstd * gg.w + bb.w;
    }
}

DI void phase_ln_router(const Params& P, int layer) {
    unsigned char* ws = P.ws;
    const int lane = threadIdx.x & 63, wave = threadIdx.x >> 6;
    const float* g = P.in[21] + layer * 1024; const float* bta = P.in[22] + layer * 1024;
    const float* wc = (const float*)(ws + WS_RTRW) + (size_t)layer * 36864; const float* bc = P.in[26] + layer * 4;
    const float* wf = wc + 4096; const float* bfn = P.in[28] + layer * 32;
    int* cnt = (int*)(ws + WS_CTL) + layer * 2048;
    int* list = (int*)(ws + WS_LIST2);
    float* wgt = (float*)(ws + WS_WGT);
    bf16_t* xb = (bf16_t*)(ws + WS_ACTB);
    for (int task = blockIdx.x * 4 + wave; task < NT / 16; task += gridDim.x * 4) {
        int my_e = 0; float my_w = 0.f;
        f32x4 wcr[16];
#pragma unroll
        for (int q = 0; q < 16; ++q) wcr[q] = *(const f32x4*)(wc + (q * 64 + lane) * 4);
        f32x4 nx[4];
#pragma unroll
        for (int j = 0; j < 4; ++j) nx[j] = __builtin_nontemporal_load((const f32x4*)(P.out + (size_t)(task * 16) * 1024 + 4 * lane + 256 * j));
#pragma unroll 1
        for (int i = 0; i < 16; ++i) {
            const int t = task * 16 + i;
            float v[16];
#pragma unroll
            for (int j = 0; j < 4; ++j) { v[4 * j] = nx[j].x; v[4 * j + 1] = nx[j].y; v[4 * j + 2] = nx[j].z; v[4 * j + 3] = nx[j].w; }
            if (i + 1 < 16) {
#pragma unroll
                for (int j = 0; j < 4; ++j) nx[j] = __builtin_nontemporal_load((const f32x4*)(P.out + (size_t)(t + 1) * 1024 + 4 * lane + 256 * j));
            }
            ln_row(v, g, bta, lane);
#pragma unroll
            for (int j = 0; j < 4; ++j) {
                *(u32x2*)(xb + (size_t)t * 1024 + 4 * lane + 256 * j) = cvt4((f32x4){v[4 * j], v[4 * j + 1], v[4 * j + 2], v[4 * j + 3]});
            }
            float lc[4] = {0.f, 0.f, 0.f, 0.f};
#pragma unroll
            for (int j = 0; j < 4; ++j)
#pragma unroll
                for (int k = 0; k < 4; ++k) {
                    const f32x4 w = wcr[j * 4 + k];
                    const float x = v[4 * j + k];
                    lc[0] += x * w.x; lc[1] += x * w.y; lc[2] += x * w.z; lc[3] += x * w.w;
                }
#pragma unroll
            for (int c = 0; c < 4; ++c) lc[c] = wave_sum(lc[c]) + bc[c];
            int gi = 0; float lm = lc[0];
#pragma unroll
            for (int c = 1; c < 4; ++c) if (lc[c] > lm) { lm = lc[c]; gi = c; }
            gi = __builtin_amdgcn_readfirstlane(gi);
            float den = 0.f;
#pragma unroll
            for (int c = 0; c < 4; ++c) den += expf(lc[c] - lm);
            const float gv = 1.f / den;
            float lf[8] = {0.f, 0.f, 0.f, 0.f, 0.f, 0.f, 0.f, 0.f};
            const float* wfg = wf + (size_t)gi * 8192;
#pragma unroll
            for (int j = 0; j < 4; ++j)
#pragma unroll
                for (int k = 0; k < 4; ++k) {
                    const f32x4 w0 = *(const f32x4*)(wfg + (((j * 4 + k) * 2 + 0) * 64 + lane) * 4), w1 = *(const f32x4*)(wfg + (((j * 4 + k) * 2 + 1) * 64 + lane) * 4);
                    const float x = v[4 * j + k];
                    lf[0] += x * w0.x; lf[1] += x * w0.y; lf[2] += x * w0.z; lf[3] += x * w0.w;
                    lf[4] += x * w1.x; lf[5] += x * w1.y; lf[6] += x * w1.z; lf[7] += x * w1.w;
                }
#pragma unroll
            for (int e = 0; e < 8; ++e) lf[e] = wave_sum(lf[e]) + bfn[gi * 8 + e];
            int e1 = 0; float l1 = lf[0];
#pragma unroll
            for (int e = 1; e < 8; ++e) if (lf[e] > l1) { l1 = lf[e]; e1 = e; }
            int e2 = 0; float l2 = -INFINITY;
#pragma unroll
            for (int e = 0; e < 8; ++e) if (e != e1 && lf[e] > l2) { l2 = lf[e]; e2 = e; }
            const float r = expf(l2 - l1);
            if (lane == i) { my_e = gi * 8 + e1; my_w = gv / (1.f + r); }
            if (lane == 16 + i) { my_e = gi * 8 + e2; my_w = gv * r / (1.f + r); }
        }
        if (lane < 32) {
            const int t = task * 16 + (lane & 15), k = lane >> 4, slot = (task & 63) * 32 + my_e;
            const int pos = atomicAdd(&cnt[slot], 1);
            list[(slot << 10) + pos] = t * 2 + k;
            wgt[t * 2 + k] = my_w;
        }
    }
}

constexpr int MOE_LDS_TAB = 65536;
constexpr int MOE_LDS_ROW = 65536 + 8448;
DI void moe_tables(const int* cnt, unsigned char* smem) {
    int* tab = (int*)(smem + MOE_LDS_TAB);
    if (threadIdx.x < 32) { const int e = threadIdx.x; int run = 0; for (int s = 0; s < 64; ++s) { tab[e * 65 + s] = run; run += cnt[s * 32 + e]; } tab[e * 65 + 64] = run; }
    __syncthreads();
}
DI bool moe_tile(const int* tab, int tile, int& e, int& mt, int& off, int& ce) {
    int acc_t = 0, acc_r = 0;
    for (int i = 0; i < 32; ++i) {
        const int c = tab[i * 65 + 64], nt = (c + 127) >> 7;
        if (tile < acc_t + nt) { e = i; mt = tile - acc_t; off = acc_r; ce = c; return true; }
        acc_t += nt; acc_r += c;
    }
    return false;
}
DI int moe_ntiles(const int* tab) { int a = 0; for (int i = 0; i < 32; ++i) a += (tab[i * 65 + 64] + 127) >> 7; return a; }
DI void moe_rows(const int* tab, const int* list, int e, int mt, int ce, int* rowidx) {
    if (threadIdx.x < 128) {
        const int pos = mt * 128 + threadIdx.x;
        int idx = -1;
        if (pos < ce) {
            int lo = 0, hi = 64;
            while (hi - lo > 1) { const int mid = (lo + hi) >> 1; if (tab[e * 65 + mid] <= pos) lo = mid; else hi = mid; }
            idx = list[((lo * 32 + e) << 10) + pos - tab[e * 65 + lo]];
        }
        rowidx[threadIdx.x] = idx;
    }
    __syncthreads();
}

DI void phase_moe_gu(const Params& P, unsigned char* smem, int layer) {
    unsigned char* ws = P.ws;
    const int* cnt = (const int*)(ws + WS_CTL) + layer * 2048;
    const int* list = (const int*)(ws + WS_LIST2);
    const float* wgt = (const float*)(ws + WS_WGT);
    const bf16_t* xb = (const bf16_t*)(ws + WS_ACTB);
    bf16_t* H = (bf16_t*)(ws + XP_H);
    const int* tab = (const int*)(smem + MOE_LDS_TAB);
    int* rowidx = (int*)(smem + MOE_LDS_ROW);
    moe_tables(cnt, smem);
    const int ntile = moe_ntiles(tab);
    for (int it = vblock(); it < ntile * 2; it += gridDim.x) {
        int e, mt, off, ce; moe_tile(tab, it >> 1, e, mt, off, ce);
        const int nt = it & 1;
        moe_rows(tab, list, e, mt, ce, rowidx);
        auto rowptr = [=](int r) { int idx = rowidx[r]; idx = idx < 0 ? rowidx[0] : idx; return xb + (size_t)(idx >> 1) * 1024; };
        auto epi = [=](f32x4 (&acc)[4][4], int wr, int wc, int ln) {
            const int fr = ln & 15, fq = ln >> 4;
#pragma unroll
            for (int m = 0; m < 4; ++m) {
                const int rl = wr * 64 + m * 16 + fr, idx = rowidx[rl];
                if (idx >= 0) {
                    const float w = wgt[idx];
#pragma unroll
                    for (int n = 0; n < 2; ++n) {
                        const f32x4 gte = acc[m][n], up = acc[m][n + 2];
                        *(u32x2*)(H + (size_t)(off + mt * 128 + rl) * 128 + (nt * 2 + wc) * 32 + n * 16 + fq * 4) =
                            cvt4((f32x4){gte.x * sigmoidf_(gte.x) * up.x * w, gte.y * sigmoidf_(gte.y) * up.y * w, gte.z * sigmoidf_(gte.z) * up.z * w, gte.w * sigmoidf_(gte.w) * up.w * w});
                    }
                }
            }
        };
        gemm128(rowptr, (const bf16_t*)(ws + WS_WGU) + ((size_t)(layer * 32 + e) * 256 + nt * 128) * 1024, 1024, 1024, smem, epi);
        __syncthreads();
    }
}
DI void phase_moe_down(const Params& P, unsigned char* smem, int layer) {
    unsigned char* ws = P.ws;
    const int* cnt = (const int*)(ws + WS_CTL) + layer * 2048;
    const int* list = (const int*)(ws + WS_LIST2);
    const bf16_t* H = (const bf16_t*)(ws + XP_H);
    bf16_t* YB = (bf16_t*)(ws + XP_YB);
    const int* tab = (const int*)(smem + MOE_LDS_TAB);
    int* rowidx = (int*)(smem + MOE_LDS_ROW);
    moe_tables(cnt, smem);
    const int ntile = moe_ntiles(tab);
    for (int it = vblock(); it < ntile * 8; it += gridDim.x) {
        int e, mt, off, ce; moe_tile(tab, it >> 3, e, mt, off, ce);
        const int nt = it & 7;
        moe_rows(tab, list, e, mt, ce, rowidx);
        auto rowptr = [=](int r) { int pos = mt * 128 + r; pos = pos < ce ? pos : 0; return H + (size_t)(off + pos) * 128; };
        auto epi = [=](f32x4 (&acc)[4][4], int wr, int wc, int ln) {
            const int fr = ln & 15, fq = ln >> 4;
#pragma unroll
            for (int m = 0; m < 4; ++m) {
                const int idx = rowidx[wr * 64 + m * 16 + fr];
                if (idx >= 0) {
                    bf16_t* dst = YB + (size_t)idx * 1024 + nt * 128 + wc * 64 + fq * 4;
#pragma unroll
                    for (int n = 0; n < 4; ++n) *(u32x2*)(dst + n * 16) = cvt4(acc[m][n]);
                }
            }
        };
        gemm128(rowptr, (const bf16_t*)(ws + WS_WDN) + ((size_t)(layer * 32 + e) * 1024 + nt * 128) * 128, 128, 128, smem, epi);
        __syncthreads();
    }
}
DI void phase_ln_ffn(const Params& P, int layer) {
    unsigned char* ws = P.ws;
    const int lane = threadIdx.x & 63, wave = threadIdx.x >> 6;
    const float* g = P.in[23] + layer * 1024; const float* bta = P.in[24] + layer * 1024;
    const bf16_t* YB = (const bf16_t*)(ws + XP_YB);
    bf16_t* xb = (bf16_t*)(ws + WS_ACTB);
    for (int task = blockIdx.x * 4 + wave; task < NT / 16; task += gridDim.x * 4) {
        u32x2 nxm[4], ny0[4], ny1[4];
        auto fetch = [&](int t) {
#pragma unroll
            for (int j = 0; j < 4; ++j) {
                nxm[j] = __builtin_nontemporal_load((const u32x2*)(xb + (size_t)t * 1024 + 4 * lane + 256 * j));
                ny0[j] = __builtin_nontemporal_load((const u32x2*)(YB + (size_t)(2 * t) * 1024 + 4 * lane + 256 * j));
                ny1[j] = __builtin_nontemporal_load((const u32x2*)(YB + (size_t)(2 * t + 1) * 1024 + 4 * lane + 256 * j));
            }
        };
        fetch(task * 16);
#pragma unroll 1
        for (int i = 0; i < 16; ++i) {
            const int t = task * 16 + i;
            float v[16];
#pragma unroll
            for (int j = 0; j < 4; ++j) {
                const f32x4 a = bf4_to_f(nxm[j]), y0 = bf4_to_f(ny0[j]), y1 = bf4_to_f(ny1[j]);
                v[4 * j + 0] = ALPHA * a.x + (y0.x + y1.x); v[4 * j + 1] = ALPHA * a.y + (y0.y + y1.y);
                v[4 * j + 2] = ALPHA * a.z + (y0.z + y1.z); v[4 * j + 3] = ALPHA * a.w + (y0.w + y1.w);
            }
            if (i + 1 < 16) fetch(t + 1);
            ln_row(v, g, bta, lane);
            float* row = P.out + (size_t)t * 1024;
#pragma unroll
            for (int j = 0; j < 4; ++j) {
                *(f32x4*)(row + 4 * lane + 256 * j) = (f32x4){v[4 * j], v[4 * j + 1], v[4 * j + 2], v[4 * j + 3]};
                if (layer == 0) *(u32x2*)(xb + (size_t)t * 1024 + 4 * lane + 256 * j) = cvt4((f32x4){v[4 * j], v[4 * j + 1], v[4 * j + 2], v[4 * j + 3]});
            }
        }
    }
}

DI void phase_inproj1(const Params& P, unsigned char* smem) {
    unsigned char* ws = P.ws;
    const bf16_t* A = (const bf16_t*)(ws + WS_ACTB);
    const float* cosT = (const float*)(ws + WS_ROPE);
    const float* sinT = cosT + 4096 * 32;
    for (int it = vblock(); it < (NT / 128) * 24; it += gridDim.x) {
        int mt, nt; tile_mn(it, 24, mt, nt);
        const int m0 = mt * 128;
        auto rowptr = [=](int r) { return A + (size_t)(m0 + r) * 1024; };
        const bf16_t* Bt = (const bf16_t*)(ws + WS_WIN1) + (size_t)nt * 128 * 1024;
        if (nt >= 16) {
            auto epi = [=](f32x4 (&acc)[4][4], int wr, int wc, int lane) {
                const int head = (nt * 2 + wc) & 15, fr = lane & 15, fq = lane >> 4;
#pragma unroll
                for (int m = 0; m < 4; ++m) {
                    const int t = m0 + wr * 64 + m * 16 + fq * 4, s = t & 4095, b = t >> 12;
                    bf16_t* base = (bf16_t*)(ws + XP_Q1 + (size_t)2 * 64 * MiB) + (size_t)(b * 16 + head) * 4096 * 64;
#pragma unroll
                    for (int n = 0; n < 4; ++n) *(u32x2*)(base + vp_off(s, n * 16 + fr)) = cvt4(acc[m][n]);
                }
            };
            gemm128<false>(rowptr, Bt, 1024, 1024, smem, epi);
            continue;
        }
        auto epi = [=](f32x4 (&acc)[4][4], int wr, int wc, int lane) {
            const int u64 = nt * 2 + wc, kind = u64 >> 4, head = u64 & 15, fr = lane & 15, fq = lane >> 4;
            f32x4 cs[2][2];
#pragma unroll
            for (int n2 = 0; n2 < 2; ++n2) { cs[n2][0] = (f32x4){0.f, 0.f, 0.f, 0.f}; cs[n2][1] = cs[n2][0]; }
#pragma unroll
            for (int m = 0; m < 4; ++m) {
                const int t = m0 + wr * 64 + m * 16 + fr, s = t & 4095, b = t >> 12;
                bf16_t* base = (bf16_t*)(ws + XP_Q1 + (size_t)kind * 64 * MiB) + (size_t)(b * 16 + head) * 4096 * 64;
#pragma unroll
                for (int n2 = 0; n2 < 2; ++n2) {
                    const int i = n2 * 16 + fq * 4;
                    const f32x4 c = *(const f32x4*)(cosT + s * 32 + i), sn = *(const f32x4*)(sinT + s * 32 + i);
                    const f32x4 x1 = acc[m][2 * n2], x2 = acc[m][2 * n2 + 1];
                    const f32x4 r1 = x1 * c - x2 * sn, r2 = x1 * sn + x2 * c;
                    const u32x2 o1 = cvt4(r1), o2 = cvt4(r2);
                    if (kind == 0) { *(u32x2*)(base + (size_t)s * 64 + i) = o1; *(u32x2*)(base + (size_t)s * 64 + i + 32) = o2; }
                    else { *(u32x2*)(base + kp_off(s, i)) = o1; *(u32x2*)(base + kp_off(s, i + 32)) = o2; cs[n2][0] += r1; cs[n2][1] += r2; }
                }
            }
            if (kind == 1) {
                const int t0 = m0 + wr * 64, bh = (t0 >> 12) * 16 + head, seg = (t0 & 4095) >> 6;
                float* dst = (float*)(ws + WS_KMP) + ((size_t)bh * 64 + seg) * 64;
#pragma unroll
                for (int n2 = 0; n2 < 2; ++n2)
#pragma unroll
                    for (int hf = 0; hf < 2; ++hf) {
                        f32x4 v = cs[n2][hf];
#pragma unroll
                        for (int k = 0; k < 4; ++k) { float x = v[k]; x += dpp_f<0xB1>(x); x += dpp_f<0x4E>(x); x += dpp_f<0x141>(x); x += dpp_f<0x140>(x); v[k] = x; }
                        if (fr == 0) *(f32x4*)(dst + n2 * 16 + fq * 4 + hf * 32) = v;
                    }
            }
        };
        gemm128(rowptr, Bt, 1024, 1024, smem, epi);
    }
}
DI void moba_kmeans_slab(const Params& P, bf16_t* kml, int bh, int tid) {
    const float* kp = (const float*)(P.ws + WS_KMP) + (size_t)bh * 64 * 64;
    for (int e = tid; e < 2048; e += 256) {
        const int d = e & 63, n = e >> 6;
        float a = 0.f;
        if (n < 16) a = ((kp[(4 * n) * 64 + d] + kp[(4 * n + 1) * 64 + d]) + (kp[(4 * n + 2) * 64 + d] + kp[(4 * n + 3) * 64 + d])) * (1.f / 256.f);
        kml[((d >> 4) * 32 + n) * 16 + (d & 15)] = f2bf(a);
    }
}
DI unsigned moba_gate_rows(const bf16_t* km, const bf16x8 (&qf)[4], int own, int r, int h) {
    f32x16 g;
#pragma unroll
    for (int i = 0; i < 16; ++i) g[i] = 0.f;
#pragma unroll
    for (int ks = 0; ks < 4; ++ks) g = MFMA32(*(const bf16x8*)(km + (ks * 32 + r) * 16 + 8 * h), qf[ks], g);
    float mine[8], oth[8];
#pragma unroll
    for (int i = 0; i < 8; ++i) { const int n = (i & 3) + 8 * (i >> 2) + 4 * h; mine[i] = n < own ? g[i] : -INFINITY; oth[i] = __shfl_xor(mine[i], 32); }
    unsigned selmask = 0;
#pragma unroll
    for (int i = 0; i < 8; ++i) {
        const int n = (i & 3) + 8 * (i >> 2) + 4 * h;
        int rank = 0;
#pragma unroll
        for (int k = 0; k < 8; ++k) {
            const int nk = (k & 3) + 8 * (k >> 2) + 4 * h, no = (k & 3) + 8 * (k >> 2) + 4 * (1 - h);
            rank += (mine[k] > mine[i] || (mine[k] == mine[i] && nk < n)) ? 1 : 0;
            rank += (oth[k] > mine[i] || (oth[k] == mine[i] && no < n)) ? 1 : 0;
        }
        if (n < own && rank < 3) selmask |= 1u << n;
    }
    return selmask | __shfl_xor(selmask, 32);
}
DI void phase_moba_gate(const Params& P, unsigned char* smem) {
    unsigned char* ws = P.ws;
    const int tid = threadIdx.x, lane = tid & 63, wave = tid >> 6, r = lane & 31, h = lane >> 5;
    bf16_t* kml = (bf16_t*)smem;
    unsigned short* smask = (unsigned short*)(smem + 4096);
    unsigned short* selm = (unsigned short*)(ws + WS_SELM);
    unsigned short* mcnt = (unsigned short*)(ws + WS_MCNT);
    unsigned char* mlist = ws + WS_MLIST;
    int km_bh = -1;
    for (int it = blockIdx.x; it < 2048; it += gridDim.x) {
        const int bh = it & 127, qb = it >> 7;
        if (bh != km_bh) { km_bh = bh; __syncthreads(); moba_kmeans_slab(P, kml, bh, tid); }
        __syncthreads();
#pragma unroll 1
        for (int g2 = 0; g2 < 2; ++g2) {
            const int rl = wave * 64 + g2 * 32 + r, q = qb * 256 + rl;
            const bf16_t* Qg = (const bf16_t*)(ws + XP_Q1) + ((size_t)bh * 4096 + q) * 64;
            bf16x8 qf[4];
#pragma unroll
            for (int ks = 0; ks < 4; ++ks) qf[ks] = *(const bf16x8*)(Qg + ks * 16 + 8 * h);
            const unsigned sm = qb > 0 ? moba_gate_rows(kml, qf, qb, r, h) : 0u;
            if (h == 0) { selm[(size_t)bh * 4096 + q] = (unsigned short)sm; smask[rl] = (unsigned short)sm; }
        }
        __syncthreads();
        for (int n = wave; n < qb; n += 4) {
            unsigned char* lp = mlist + ((size_t)(bh * 16 + qb) * 16 + n) * 256;
            int base = 0;
#pragma unroll
            for (int c4 = 0; c4 < 4; ++c4) {
                const int row = c4 * 64 + lane;
                const bool bit = (smask[row] >> n) & 1;
                const unsigned long long bal = __ballot(bit);
                if (bit) lp[base + __builtin_popcountll(bal & ((1ull << lane) - 1ull))] = (unsigned char)row;
                base += __builtin_popcountll(bal);
            }
            if (lane == 0) mcnt[(bh * 16 + qb) * 16 + n] = (unsigned short)base;
        }
    }
}
DI bf16_t* moba_po(const Params& P, int slot) { return (bf16_t*)(P.ws + (slot == 0 ? WS_MIX : slot == 1 ? WS_ACTB : WS_PO2)); }
DI void phase_moba_kv(const Params& P, unsigned char* smem) {
    unsigned char* ws = P.ws;
    const int tid = threadIdx.x, lane = tid & 63, wave = tid >> 6, r = lane & 31, h = lane >> 5;
    const float c = 0.125f * 1.4426950408889634f;
    LAS unsigned char* lds = (LAS unsigned char*)smem;
    const unsigned short* selm = (const unsigned short*)(ws + WS_SELM);
    const unsigned short* mcnt = (const unsigned short*)(ws + WS_MCNT);
    const unsigned char* mlist = ws + WS_MLIST;
    float* pml = (float*)(ws + WS_PML);
    const bool bal = (gridDim.x == 512);
    const int nit = bal ? ((blockIdx.x >> 7) == 3 ? 3 : 4) : (1920 + (int)gridDim.x - 1 - (int)blockIdx.x) / (int)gridDim.x;
    for (int iti = 0; iti < nit; ++iti) {
        int bh, n;
        if (bal) { const int gq = blockIdx.x >> 7; bh = blockIdx.x & 127; const int tab = gq == 0 ? 0x0DA90 : gq == 1 ? 0x0CB61 : gq == 2 ? 0x0E852 : 0x00743; n = (tab >> (4 * iti)) & 15; }
        else { const int it = blockIdx.x + iti * gridDim.x; n = it >> 7; bh = it & 127; }
        const bf16_t* Kg = (const bf16_t*)(ws + XP_Q1 + 64 * MiB) + (size_t)bh * 4096 * 64 + (size_t)n * 4 * 4096;
        const bf16_t* Vg = (const bf16_t*)(ws + XP_Q1 + 128 * MiB) + (size_t)bh * 4096 * 64 + (size_t)n * 4 * 4096;
        asm volatile("s_waitcnt vmcnt(0)" ::: "memory");
        __builtin_amdgcn_s_barrier();
#pragma unroll
        for (int j = 0; j < 4; ++j) fa_issue(Kg + (size_t)j * 4096, Vg + (size_t)j * 4096, lds + j * 16384, tid);
        const int cntv = (lane < 16 && lane > n) ? (int)mcnt[(bh * 16 + lane) * 16 + n] : 0;
        asm volatile("s_waitcnt vmcnt(0)" ::: "memory");
        __builtin_amdgcn_s_barrier();
        asm volatile("" ::: "memory");
        int prefv = 0, total = 0;
#pragma unroll 1
        for (int qb = 0; qb < 16; ++qb) { if (lane == qb) prefv = total; total += __builtin_amdgcn_readlane(cntv, qb); }
#pragma unroll 1
        for (int v0 = wave * 32; v0 < total; v0 += 128) {
            const int v = v0 + r;
            const bool valid = v < total;
            const int vv = valid ? v : v0;
            int qb = n + 1;
#pragma unroll 1
            for (int l = n + 2; l < 16; ++l) if (vv >= __builtin_amdgcn_readlane(prefv, l)) qb = l;
            const int idx = vv - __shfl(prefv, qb);
            const int q = qb * 256 + (int)mlist[((size_t)(bh * 16 + qb) * 16 + n) * 256 + idx];
            const bf16_t* Qg = (const bf16_t*)(ws + XP_Q1) + ((size_t)bh * 4096 + q) * 64;
            bf16x8 qf[4];
#pragma unroll
            for (int ks = 0; ks < 4; ++ks) qf[ks] = *(const bf16x8*)(Qg + ks * 16 + 8 * h);
            FA st; fa_init(st);
#pragma unroll 1
            for (int j = 0; j < 4; ++j) {
                const LAS bf16_t* cur = (const LAS bf16_t*)(lds + j * 16384);
                fa_tile<0>(st, qf, cur, cur + 4096, r, h, c, true, [=](int) { return true; });
            }
            const float l = st.l + __shfl_xor(st.l, 32);
            const float inv = 1.f / fmaxf(l, 1e-30f);
            if (valid) {
                const int slot = __builtin_popcount((unsigned)selm[(size_t)bh * 4096 + q] & ((1u << n) - 1u));
                bf16_t* o = moba_po(P, slot) + ((size_t)(bh >> 4) * 4096 + q) * 1024 + (bh & 15) * 64;
#pragma unroll
                for (int g4 = 0; g4 < 4; ++g4) {
                    *(u32x2*)(o + 8 * g4 + 4 * h) = cvt4((f32x4){st.o0[4 * g4] * inv, st.o0[4 * g4 + 1] * inv, st.o0[4 * g4 + 2] * inv, st.o0[4 * g4 + 3] * inv});
                    *(u32x2*)(o + 32 + 8 * g4 + 4 * h) = cvt4((f32x4){st.o1[4 * g4] * inv, st.o1[4 * g4 + 1] * inv, st.o1[4 * g4 + 2] * inv, st.o1[4 * g4 + 3] * inv});
                }
                if (h == 0) { float* pm = pml + (((size_t)bh * 4096 + q) * 3 + slot) * 2; pm[0] = st.m; pm[1] = l; }
            }
        }
    }
}
DI void phase_moba_own(const Params& P, unsigned char* smem) {
    unsigned char* ws = P.ws;
    const int tid = threadIdx.x, lane = tid & 63, wave = tid >> 6, r = lane & 31, h = lane >> 5;
    const float c = 0.125f * 1.4426950408889634f;
    LAS unsigned char* lds = (LAS unsigned char*)smem;
    const unsigned short* selm = (const unsigned short*)(ws + WS_SELM);
    const float* pml = (const float*)(ws + WS_PML);
    for (int it = blockIdx.x; it < 2048; it += gridDim.x) {
        const int own = 15 - (it >> 7), bh = it & 127, t0 = own * 256;
        const bf16_t* Kg = (const bf16_t*)(ws + XP_Q1 + 64 * MiB) + (size_t)bh * 4096 * 64 + (size_t)own * 4 * 4096;
        const bf16_t* Vg = (const bf16_t*)(ws + XP_Q1 + 128 * MiB) + (size_t)bh * 4096 * 64 + (size_t)own * 4 * 4096;
        asm volatile("s_waitcnt vmcnt(0)" ::: "memory");
        __builtin_amdgcn_s_barrier();
#pragma unroll
        for (int j = 0; j < 4; ++j) fa_issue(Kg + (size_t)j * 4096, Vg + (size_t)j * 4096, lds + j * 16384, tid);
        asm volatile("s_waitcnt vmcnt(0)" ::: "memory");
        __builtin_amdgcn_s_barrier();
        asm volatile("" ::: "memory");
#pragma unroll 1
        for (int g2 = 0; g2 < 2; ++g2) {
            const int row0 = t0 + g2 * 128 + wave * 32, q = row0 + r;
            const bf16_t* Qg = (const bf16_t*)(ws + XP_Q1) + ((size_t)bh * 4096 + q) * 64;
            bf16x8 qf[4];
#pragma unroll
            for (int ks = 0; ks < 4; ++ks) qf[ks] = *(const bf16x8*)(Qg + ks * 16 + 8 * h);
            const int nsel = __builtin_popcount((unsigned)selm[(size_t)bh * 4096 + q]);
            const size_t orow = ((size_t)(bh >> 4) * 4096 + q) * 1024 + (bh & 15) * 64;
            const float* pm = pml + ((size_t)bh * 4096 + q) * 6;
            float mi[3], li[3];
            u32x2 pa[3][8];
#pragma unroll
            for (int i = 0; i < 3; ++i) {
                mi[i] = i < nsel ? pm[2 * i] : -INFINITY; li[i] = i < nsel ? pm[2 * i + 1] : 0.f;
                const bf16_t* po = moba_po(P, i) + orow;
#pragma unroll
                for (int g4 = 0; g4 < 4; ++g4) {
                    pa[i][2 * g4] = i < nsel ? *(const u32x2*)(po + 8 * g4 + 4 * h) : (u32x2){0u, 0u};
                    pa[i][2 * g4 + 1] = i < nsel ? *(const u32x2*)(po + 32 + 8 * g4 + 4 * h) : (u32x2){0u, 0u};
                }
            }
            FA st; fa_init(st);
            const int jmax = (row0 + 31 - t0) >> 6;
#pragma unroll 1
            for (int j = 0; j <= jmax; ++j) {
                const LAS bf16_t* cur = (const LAS bf16_t*)(lds + j * 16384);
                const int kbase = t0 + j * 64;
                if (kbase + 63 <= row0) fa_tile<0>(st, qf, cur, cur + 4096, r, h, c, true, [=](int) { return true; });
                else fa_tile<2>(st, qf, cur, cur + 4096, r, h, c, true, [=](int koff) { return kbase + koff <= q; });
            }
            const float l_own = st.l + __shfl_xor(st.l, 32);
            const float M = fmaxf(fmaxf(st.m, mi[0]), fmaxf(mi[1], mi[2]));
            const float wo = __builtin_amdgcn_exp2f(st.m - M);
            float L = l_own * wo;
#pragma unroll
            for (int k = 0; k < 16; ++k) { st.o0[k] *= wo; st.o1[k] *= wo; }
#pragma unroll
            for (int i = 0; i < 3; ++i) {
                const float wi = li[i] * __builtin_amdgcn_exp2f(mi[i] - M);
                L += wi;
#pragma unroll
                for (int g4 = 0; g4 < 4; ++g4) {
                    const f32x4 a = bf4_to_f(pa[i][2 * g4]), b2 = bf4_to_f(pa[i][2 * g4 + 1]);
                    st.o0[4 * g4] += wi * a.x; st.o0[4 * g4 + 1] += wi * a.y; st.o0[4 * g4 + 2] += wi * a.z; st.o0[4 * g4 + 3] += wi * a.w;
                    st.o1[4 * g4] += wi * b2.x; st.o1[4 * g4 + 1] += wi * b2.y; st.o1[4 * g4 + 2] += wi * b2.z; st.o1[4 * g4 + 3] += wi * b2.w;
                }
            }
            const float inv = 1.f / fmaxf(L, 1e-30f);
            bf16_t* o = (bf16_t*)(ws + WS_MIX) + orow;
#pragma unroll
            for (int g4 = 0; g4 < 4; ++g4) {
                *(u32x2*)(o + 8 * g4 + 4 * h) = cvt4((f32x4){st.o0[4 * g4] * inv, st.o0[4 * g4 + 1] * inv, st.o0[4 * g4 + 2] * inv, st.o0[4 * g4 + 3] * inv});
                *(u32x2*)(o + 32 + 8 * g4 + 4 * h) = cvt4((f32x4){st.o1[4 * g4] * inv, st.o1[4 * g4 + 1] * inv, st.o1[4 * g4 + 2] * inv, st.o1[4 * g4 + 3] * inv});
            }
        }
    }
}

constexpr int SMEM_BYTES = 65536 + 8192 + 1024 + 512;
static_assert(SMEM_BYTES >= 128 * 129 * 4 && SMEM_BYTES >= MOE_LDS_ROW + 512 && SMEM_BYTES >= NSA_LDS_MSK + 256, "LDS map");
constexpr int SMEM_OLD = 128 * 129 * 4;
typedef __attribute__((address_space(1))) unsigned gu32;
#define XB_TMO      128
#define XB_XCNT(j)  (256  + 64 * (j))
#define XB_XSUB(j)  (1280 + 64 * (j))
#define XB_XGEN(j)  (2304 + 64 * (j))
#define XB_TOP      3328
#define XB_TOPGEN   3392
#define XCD_BAR_WORDS 3456
#define XB_SPIN_CAP (1u << 18)

__device__ __forceinline__ unsigned xb_ld(unsigned* p)              { return __hip_atomic_load(p, __ATOMIC_RELAXED, __HIP_MEMORY_SCOPE_AGENT); }
__device__ __forceinline__ unsigned xb_add(unsigned* p, unsigned v) { return __hip_atomic_fetch_add(p, v, __ATOMIC_RELAXED, __HIP_MEMORY_SCOPE_AGENT); }
__device__ __forceinline__ unsigned xb_xcc_id() { return (unsigned)__builtin_amdgcn_s_getreg((3 << 11) | 20) & 0xFu; }
#define XB_SPIN(cond, bar) do { unsigned _sp = 0; while (cond) { __builtin_amdgcn_s_sleep(1); \
    if ((++_sp & 255u) == 0u) { if (xb_ld(&(bar)[XB_TMO])) break; if (_sp > XB_SPIN_CAP) { atomicAdd(&(bar)[XB_TMO], 1u); break; } } } } while (0)

struct XcdBarrier {
    unsigned* bar; unsigned x;
    volatile LAS unsigned* st;
};

__device__ __forceinline__ XcdBarrier xcd_barrier_post(unsigned* bar, volatile LAS unsigned* st) {
    XcdBarrier b; b.bar = bar; b.x = xb_xcc_id(); b.st = st;
    if (threadIdx.x == 0) (void)xb_add(&bar[XB_XCNT(b.x)], 1u);
    return b;
}
__device__ __forceinline__ void xcd_barrier_complete(unsigned* bar, unsigned x, unsigned& nloc, unsigned& nx) {
    const unsigned G = gridDim.x * gridDim.y * gridDim.z;
    unsigned sum, cnt, mine, sp = 0u;
    for (;;) {
        sum = 0u; cnt = 0u; mine = 0u;
#pragma unroll
        for (unsigned j = 0; j < 16; ++j) { const unsigned c = xb_ld(&bar[XB_XCNT(j)]); sum += c; cnt += (c > 0u) ? 1u : 0u; mine = (j == x) ? c : mine; }
        if (sum == G) break;
        __builtin_amdgcn_s_sleep(1);
        if ((++sp & 255u) == 0u) { if (xb_ld(&bar[XB_TMO])) break; if (sp > XB_SPIN_CAP) { atomicAdd(&bar[XB_TMO], 1u); break; } }
    }
    nloc = mine > 0u ? mine : 1u; nx = cnt > 0u ? cnt : 1u;
}

__device__ __forceinline__ void xcd_barrier(const XcdBarrier& b) {
    asm volatile("s_waitcnt vmcnt(0)" ::: "memory");
    __syncthreads();
    if (threadIdx.x == 0) {
        unsigned* bar = b.bar;
        __builtin_amdgcn_s_waitcnt(0);
        unsigned nloc = b.st[0], nx = b.st[1];
        if (nloc == 0u) { xcd_barrier_complete(bar, b.x, nloc, nx); b.st[0] = nloc; b.st[1] = nx; }
        const unsigned old = xb_add(&bar[XB_XSUB(b.x)], 1u);
        const unsigned gen = old / nloc;
        if (old + 1u == (gen + 1u) * nloc) {
            __builtin_amdgcn_fence(__ATOMIC_RELEASE, "agent");
            asm volatile("s_waitcnt vmcnt(0)" ::: "memory");
            const unsigned og = xb_add(&bar[XB_TOP], 1u);
            const unsigned tg = og / nx;
            if (og + 1u == (tg + 1u) * nx) xb_add(&bar[XB_TOPGEN], 1u);
            else XB_SPIN(xb_ld(&bar[XB_TOPGEN]) == tg, bar);
            __builtin_amdgcn_fence(__ATOMIC_ACQUIRE, "agent");
            xb_add(&bar[XB_XGEN(b.x)], 1u);
            asm volatile("s_waitcnt vmcnt(0)" ::: "memory");
        } else {
            XB_SPIN(xb_ld(&bar[XB_XGEN(b.x)]) == gen, bar);
            __builtin_amdgcn_fence(__ATOMIC_ACQUIRE, "agent");
            asm volatile("s_waitcnt vmcnt(0)" ::: "memory");
        }
    }
    __syncthreads();
}

constexpr size_t CTL_BAR = 16384;
constexpr size_t CTL_BYTES = 32768;

#define PHASE(k, call) if (P.ph_lo <= (k) && (k) < P.ph_hi) { call; if ((k) + 1 < P.ph_hi) xcd_barrier(xb); }
__global__ void __launch_bounds__(256, 2) mega(Params P) {
    __shared__ __attribute__((aligned(16))) unsigned char smem[SMEM_BYTES + 16];
    unsigned* xbst = (unsigned*)(smem + SMEM_BYTES);
    cg::grid_group grid = cg::this_grid();
    if (threadIdx.x < 4) xbst[threadIdx.x] = 0u;
    __syncthreads();
    if (P.ph_lo < 0) grid.sync();
    XcdBarrier xb = xcd_barrier_post((unsigned*)(P.ws + WS_CTL + CTL_BAR), (volatile LAS unsigned*)xbst);
    PHASE(0, phase0(P, smem))
    PHASE(1, phase_inproj0(P, smem))
    PHASE(2, phase_cmp_s5e(P, smem))
    PHASE(3, phase_glu(P, smem); phase_nsa(P, smem))
    PHASE(6, phase_outproj(P, smem, P.in[0], WS_WOUT0))
    PHASE(7, phase_ln_router(P, 0))
    PHASE(8, phase_moe_gu(P, smem, 0))
    PHASE(9, phase_moe_down(P, smem, 0))
    PHASE(10, phase_ln_ffn(P, 0))
    PHASE(11, phase_inproj1(P, smem))
    PHASE(12, phase_moba_gate(P, smem))
    PHASE(13, phase_moba_kv(P, smem))
    PHASE(14, phase_moba_own(P, smem))
    PHASE(15, phase_outproj(P, smem, P.out, WS_WOUT1))
    PHASE(16, phase_ln_router(P, 1))
    PHASE(17, phase_moe_gu(P, smem, 1))
    PHASE(18, phase_moe_down(P, smem, 1))
    PHASE(20, phase_ln_ffn(P, 1))
}

extern "C" void kernel_launch(void* const* d_in, const int* in_sizes, int n_in, void* d_out, int out_size, void* d_ws, size_t ws_size, hipStream_t stream) {
    static int grid = 0;
    if (grid == 0) {
        if (n_in != 32 || out_size != NT * DM || ws_size < WS_END) { fprintf(stderr, "kernel_launch: unexpected shapes (n_in %d, out %d, ws %zu)\n", n_in, out_size, ws_size); grid = -1; return; }
        int dev = 0, cus = 0, per_cu = 0;
        (void)hipGetDevice(&dev);
        (void)hipDeviceGetAttribute(&cus, hipDeviceAttributeMultiprocessorCount, dev);
        (void)hipOccupancyMaxActiveBlocksPerMultiprocessor(&per_cu, mega, 256, 0);
        if (per_cu < 1) per_cu = 1;
        if (per_cu > 2) per_cu = 2;
        grid = cus * per_cu;
    }
    if (grid < 0) return;
    (void)hipMemsetAsync((char*)d_ws + WS_CTL, 0, CTL_BYTES, stream);
    Params p{};
    for (int i = 0; i < 32; ++i) p.in[i] = (const float*)d_in[i];
    p.out = (float*)d_out; p.ws = (unsigned char*)d_ws;
    p.ph_lo = 0; p.ph_hi = NPH;
    void* args[] = {&p};
    hipError_t e = hipLaunchCooperativeKernel((void*)mega, dim3(grid), dim3(256), args, 0, stream);
    if (e != hipSuccess) fprintf(stderr, "cooperative launch failed: %s (grid %d)\n", hipGetErrorString(e), grid);
}
```

```cpp
#include <hip/hip_runtime.h>
#include <hip/hip_cooperative_groups.h>
#include <cstdio>
#include <cstdint>
namespace cg = cooperative_groups;

typedef unsigned short bf16_t;
typedef short bf16x8 __attribute__((ext_vector_type(8)));
typedef float f32x4 __attribute__((ext_vector_type(4)));
typedef unsigned u32x4 __attribute__((ext_vector_type(4)));
typedef unsigned u32x2 __attribute__((ext_vector_type(2)));
#define DI __device__ __forceinline__
#define LAS __attribute__((address_space(3)))
typedef float f32x16 __attribute__((ext_vector_type(16)));
typedef float f32x8 __attribute__((ext_vector_type(8)));
typedef __bf16 bf16x8v __attribute__((ext_vector_type(8)));
typedef __bf16 bf16x4v __attribute__((ext_vector_type(4)));
#define MFMA32(a, b, c) __builtin_amdgcn_mfma_f32_32x32x16_bf16((a), (b), (c), 0, 0, 0)

constexpr int NB = 8, SEQ = 4096, DM = 1024, NT = NB * SEQ;
constexpr float ALPHA = 1.41421356237f;
constexpr float LN_EPS = 1e-5f;
constexpr int NIN0 = 1920;
constexpr int NPH = 21;

constexpr size_t MiB = 1u << 20;
constexpr size_t WS_CTL = 0;
constexpr size_t WS_ROPE = 1 * MiB;
constexpr size_t WS_WIN0 = 2 * MiB;
constexpr size_t WS_WOUT0 = 6 * MiB;
constexpr size_t WS_WIN1 = 8 * MiB;
constexpr size_t WS_WOUT1 = 14 * MiB;
constexpr size_t WS_WGLU = 16 * MiB;
constexpr size_t WS_WCK1 = 16 * MiB + 512 * 1024;
constexpr size_t WS_WCV1 = 17 * MiB;
constexpr size_t WS_WCK2 = 17 * MiB + 512 * 1024;
constexpr size_t WS_WCV2 = WS_WCK2 + 16384;
constexpr size_t WS_CBIAS = WS_WCV2 + 16384;
constexpr size_t WS_S5AL = WS_CBIAS + 4096;
constexpr size_t WS_RTRW = 17 * MiB + 640 * 1024;
constexpr size_t WS_BTE = 18 * MiB;
constexpr size_t WS_BTY = 22 * MiB;
constexpr size_t WS_WGU = 42 * MiB;
constexpr size_t WS_WDN = 74 * MiB;
constexpr size_t WS_KMP = 90 * MiB;
constexpr size_t WS_WGT = 94 * MiB;
constexpr size_t WS_KMEAN = 94 * MiB + 512 * 1024;
constexpr size_t WS_KCMP = 95 * MiB;
constexpr size_t WS_VCMP = 95 * MiB + 512 * 1024;
constexpr size_t WS_ACTB = 96 * MiB;
constexpr size_t WS_MIX = 160 * MiB;
constexpr size_t WS_XP = 224 * MiB;
constexpr size_t WS_LIST2 = 416 * MiB;
constexpr size_t WS_SELM = 92 * MiB;
constexpr size_t WS_MCNT = 93 * MiB;
constexpr size_t WS_MLIST = WS_LIST2;
constexpr size_t WS_PO2 = 424 * MiB;
constexpr size_t WS_PML = 488 * MiB;
constexpr size_t WS_END = 504 * MiB;
constexpr size_t XP_Q0 = WS_XP;
constexpr size_t XP_KC = WS_XP + 32 * MiB;
constexpr size_t KVSZ = 8 * MiB;
constexpr size_t XP_GATES = WS_XP + 80 * MiB;
constexpr size_t XP_AEXT = WS_XP + 84 * MiB;
constexpr size_t XP_G5 = WS_XP + 124 * MiB;
constexpr size_t XP_YB = WS_XP;
constexpr size_t XP_H = WS_XP + 128 * MiB;
constexpr size_t XP_Q1 = WS_XP;

struct Params {
    const float* in[32];
    float* out;
    unsigned char* ws;
    int ph_lo, ph_hi;
};

DI bf16_t f2bf(float f) { unsigned u = __float_as_uint(f); return (bf16_t)((u + 0x7fffu + ((u >> 16) & 1u)) >> 16); }
DI float bf2f(bf16_t h) { return __uint_as_float(((unsigned)h) << 16); }
DI unsigned pk2(float lo, float hi) { return (unsigned)f2bf(lo) | ((unsigned)f2bf(hi) << 16); }
DI bf16x8 cvt8(f32x8 v) { return __builtin_bit_cast(bf16x8, __builtin_convertvector(v, bf16x8v)); }
DI u32x2 cvt4(f32x4 v) { return __builtin_bit_cast(u32x2, __builtin_convertvector(v, bf16x4v)); }
DI size_t kp_off(int key, int d) { return ((size_t)((key >> 5) * 4 + (d >> 4)) * 32 + (key & 31)) * 16 + (d & 15); }
DI int vp_pos(int ko) { return 8 * ((ko >> 2) & 1) + 4 * (ko >> 3) + (ko & 3); }
DI size_t vp_off(int key, int d) { return ((size_t)(key >> 4) * 64 + d) * 16 + vp_pos(key & 15); }
DI bf16_t ld_bf(const bf16_t* p) { return *p; }
DI f32x4 bf4_to_f(u32x2 w) { return (f32x4){__uint_as_float(w.x << 16), __uint_as_float(w.x & 0xffff0000u), __uint_as_float(w.y << 16), __uint_as_float(w.y & 0xffff0000u)}; }
template <int CTRL> DI float dpp_f(float v) { return __builtin_bit_cast(float, __builtin_amdgcn_update_dpp(0, __builtin_bit_cast(int, v), CTRL, 0xF, 0xF, true)); }
DI float wave_sum(float v) {
    v += dpp_f<0xB1>(v);
    v += dpp_f<0x4E>(v);
    v += dpp_f<0x141>(v);
    v += dpp_f<0x140>(v);
    { const auto s = __builtin_amdgcn_permlane16_swap(__float_as_uint(v), __float_as_uint(v), false, false); v = __uint_as_float(s[0]) + __uint_as_float(s[1]); }
    { const auto s = __builtin_amdgcn_permlane32_swap(__float_as_uint(v), __float_as_uint(v), false, false); v = __uint_as_float(s[0]) + __uint_as_float(s[1]); }
    return v;
}
DI float wave_max(float v) {
#pragma unroll
    for (int o = 32; o > 0; o >>= 1) v = fmaxf(v, __shfl_xor(v, o));
    return v;
}
DI float sigmoidf_(float x) { return __builtin_amdgcn_rcpf(1.f + __expf(-x)); }
DI float gelu_tanh(float x) { const float z = 0.7978845608028654f * (x + 0.044715f * x * x * x); return x * sigmoidf_(2.f * z); }

constexpr int GEMM_LDS = 65536;
template <bool TRANS = true, class RowPtr, class Epi>
DI void gemm128(RowPtr rowptr, const bf16_t* __restrict__ Bt, int ldb, int K, unsigned char* smem, Epi epi, int kskip_lo = 0, int kskip_hi = 0) {
    LAS unsigned char* lds = (LAS unsigned char*)smem;
    const int tid = threadIdx.x, lane = tid & 63, wave = tid >> 6, wr = wave >> 1, wc = wave & 1, fr = lane & 15, fq = lane >> 4;
    const int schunk = ((tid & 7) ^ ((tid >> 4) & 7)) * 8;
    const bf16_t* ga[4];
#pragma unroll
    for (int i = 0; i < 4; ++i) ga[i] = rowptr(i * 32 + (tid >> 3)) + schunk;
    const bf16_t* gb = Bt + (size_t)(tid >> 3) * ldb + schunk;
    const size_t gbs = (size_t)32 * ldb;
    auto stage = [&](int kt, int s) {
#pragma unroll
        for (int i = 0; i < 4; ++i) {
            __builtin_amdgcn_global_load_lds((const unsigned*)(ga[i] + kt * 64), (LAS unsigned*)(lds + s * 32768 + (i * 256 + tid) * 16), 16, 0, 0);
            __builtin_amdgcn_global_load_lds((const unsigned*)(gb + i * gbs + kt * 64), (LAS unsigned*)(lds + s * 32768 + 16384 + (i * 256 + tid) * 16), 16, 0, 0);
        }
    };
    f32x4 acc[4][4];
#pragma unroll
    for (int m = 0; m < 4; ++m)
#pragma unroll
        for (int n = 0; n < 4; ++n) acc[m][n] = (f32x4){0.f, 0.f, 0.f, 0.f};
    const int nskip = kskip_hi - kskip_lo, nk = (K >> 6) - nskip;
    const int swz = (fr >> 1) & 7;
    const int aoff = (wr * 64 + fr) * 128, boff = 16384 + (wc * 64 + fr) * 128;
    stage(kskip_lo == 0 ? nskip : 0, 0);
#pragma unroll 1
    for (int kt = 0; kt < nk; ++kt) {
        asm volatile("s_waitcnt vmcnt(0)" ::: "memory");
        __syncthreads();
        if (kt + 1 < nk) stage(kt + 1 < kskip_lo ? kt + 1 : kt + 1 + nskip, (kt + 1) & 1);
        const LAS unsigned char* cur = lds + (kt & 1) * 32768;
#pragma unroll
        for (int ks = 0; ks < 2; ++ks) {
            bf16x8 af[4], bfr[4];
            const int co = ((ks * 4 + fq) ^ swz) * 16;
#pragma unroll
            for (int m = 0; m < 4; ++m) af[m] = *(const LAS bf16x8*)(cur + aoff + m * 2048 + co);
#pragma unroll
            for (int n = 0; n < 4; ++n) bfr[n] = *(const LAS bf16x8*)(cur + boff + n * 2048 + co);
#pragma unroll
            for (int m = 0; m < 4; ++m)
#pragma unroll
                for (int n = 0; n < 4; ++n) acc[m][n] = TRANS ? __builtin_amdgcn_mfma_f32_16x16x32_bf16(bfr[n], af[m], acc[m][n], 0, 0, 0) : __builtin_amdgcn_mfma_f32_16x16x32_bf16(af[m], bfr[n], acc[m][n], 0, 0, 0);
        }
    }
    __syncthreads();
    epi(acc, wr, wc, lane);
}

DI int vblock() { const int G = gridDim.x; return (G & 7) == 0 ? (int)(blockIdx.x & 7) * (G >> 3) + (int)(blockIdx.x >> 3) : (int)blockIdx.x; }
DI void tile_mn(int it, int nN, int& mt, int& nt) { const int per = 8 * nN, grp = it / per, idx = it - grp * per; nt = idx >> 3; mt = grp * 8 + (idx & 7); }

DI int rope_pos(int l) { return (l & ~63) + ((2 * ((l & 31) >> 4) + ((l >> 5) & 1)) << 4) + (l & 15); }
DI int rowmap(int kind, int n) {
    if (kind == 1) {
        if (n < 512 || (n >= 512 && n < 640) || (n >= 768 && n < 896) || (n >= 1024 && n < 1152)) return rope_pos(n);
        return n < 1304 ? n : n + 104;
    }
    if (kind == 4) return n < 2048 ? rope_pos(n) : n;
    if (kind == 2) return ((n >> 5) << 6) + (n & 31);
    if (kind == 3) return ((n >> 5) << 6) + 32 + (n & 31);
    return n;
}
DI void tr_tile(const float* __restrict__ src, int K, int N, bf16_t* __restrict__ dst, int kind, int kt, int nt, float* s) {
    const int tid = threadIdx.x, k0 = kt * 64, n0 = nt * 64;
    {
        const int nn = tid & 63, kq = tid >> 6, n = n0 + nn;
#pragma unroll
        for (int i = 0; i < 16; ++i) { const int kk = kq + 4 * i; s[kk * 65 + nn] = (n < N) ? src[(size_t)(k0 + kk) * N + n] : 0.f; }
    }
    __syncthreads();
    {
        const int rn = tid >> 2, kseg = (tid & 3) * 16, n = n0 + rn;
        if (n < N) {
            unsigned w[8];
#pragma unroll
            for (int i = 0; i < 8; ++i) w[i] = pk2(s[(kseg + 2 * i) * 65 + rn], s[(kseg + 2 * i + 1) * 65 + rn]);
            bf16_t* d = dst + (size_t)rowmap(kind, n) * K + k0 + kseg;
            *(uint4*)d = make_uint4(w[0], w[1], w[2], w[3]);
            *(uint4*)(d + 8) = make_uint4(w[4], w[5], w[6], w[7]);
        }
    }
    __syncthreads();
}
struct CF { float re, im; };
DI CF cmul(CF a, CF b) { return {a.re * b.re - a.im * b.im, a.re * b.im + a.im * b.re}; }
DI CF s5_apow(const Params& P, int g, int p, float tau) {
    const float step = expf(P.in[10][g]);
    const float lr = P.in[8][g * 64 + p], li = P.in[9][g * 64 + p];
    const float mag = expf(lr * step * tau);
    float sn, cs; sincosf(li * step * tau, &sn, &cs);
    return {mag * cs, mag * sn};
}
DI CF s5_f(const Params& P, int g, int p) {
    const CF a = s5_apow(P, g, p, 1.f);
    const float lr = P.in[8][g * 64 + p], li = P.in[9][g * 64 + p];
    const float den = lr * lr + li * li;
    return {((a.re - 1.f) * lr + a.im * li) / den, (a.im * lr - (a.re - 1.f) * li) / den};
}
DI void phase0(const Params& P, unsigned char* smem) {
    const int tid = threadIdx.x;
    unsigned char* ws = P.ws;
    float* sf = (float*)smem;
    constexpr int N_TR0 = 16 * 29, N_TR1 = 256, N_TR2 = 16 * 48, N_TR3 = 256, N_TR4 = 64, N_TR5 = 64, N_TR6 = 64, N_TR7 = 2, N_TR8 = 2;
    constexpr int N_TRG = 64 * 32, N_TRU = 64 * 32, N_TRD = 64 * 32;
    constexpr int N_X = NT * DM / 8192, N_ROPE = 512, N_CB = 16, N_AL = 8, N_BTE = 256, N_BTYM = 32 * 63, N_BTYQ = 4096, N_ZP = 13;
    constexpr int N_RW = 2 * 36864 / 256;
    constexpr int TOTAL = N_RW + N_TR0 + N_TR1 + N_TR4 + N_TR5 + N_TR6 + N_TR7 + N_TR8 + N_X + N_ROPE + N_CB + N_AL + N_BTE + N_BTYM + N_BTYQ + N_ZP;
    for (int it0 = blockIdx.x; it0 < TOTAL; it0 += gridDim.x) {
        int it = it0;
        if (it < N_RW) {
            const int e = it * 256 + tid, layer = e / 36864, r = e % 36864;
            float* dst = (float*)(ws + WS_RTRW) + (size_t)layer * 36864;
            if (r < 4096) { const int o = r & 3, l = (r >> 2) & 63, jk = r >> 8, d = 4 * l + 256 * (jk >> 2) + (jk & 3); dst[r] = P.in[25][((size_t)layer * 1024 + d) * 4 + o]; }
            else { const int q = r - 4096, o = q & 3, l = (q >> 2) & 63, hf = (q >> 8) & 1, jk = (q >> 9) & 15, g = q >> 13, d = 4 * l + 256 * (jk >> 2) + (jk & 3);
                   dst[r] = P.in[27][(((size_t)layer * 4 + g) * 1024 + d) * 8 + hf * 4 + o]; }
            continue;
        } it -= N_RW;
        if (it < N_TR0) { tr_tile(P.in[1], 1024, 1816, (bf16_t*)(ws + WS_WIN0), 1, it / 29, it % 29, sf); continue; } it -= N_TR0;
        if (it < N_TR1) { tr_tile(P.in[18], 1024, 1024, (bf16_t*)(ws + WS_WOUT0), 0, it / 16, it % 16, sf); continue; } it -= N_TR1;
        if (it < N_TR4) { tr_tile(P.in[16], 512, 512, (bf16_t*)(ws + WS_WGLU), 0, it / 8, it % 8, sf); continue; } it -= N_TR4;
        if (it < N_TR5) { tr_tile(P.in[4], 2048, 128, (bf16_t*)(ws + WS_WCK1), 0, it / 2, it % 2, sf); continue; } it -= N_TR5;
        if (it < N_TR6) { tr_tile(P.in[6], 2048, 128, (bf16_t*)(ws + WS_WCV1), 0, it / 2, it % 2, sf); continue; } it -= N_TR6;
        if (it < N_TR7) { tr_tile(P.in[5], 128, 64, (bf16_t*)(ws + WS_WCK2), 0, it, 0, sf); continue; } it -= N_TR7;
        if (it < N_TR8) { tr_tile(P.in[7], 128, 64, (bf16_t*)(ws + WS_WCV2), 0, it, 0, sf); continue; } it -= N_TR8;
        if (it < N_X) {
            const float* x = P.in[0]; bf16_t* xb = (bf16_t*)(ws + WS_ACTB);
#pragma unroll
            for (int i = 0; i < 4; ++i) {
                const size_t idx = (size_t)it * 8192 + i * 2048 + tid * 8;
                const f32x4 a = __builtin_nontemporal_load((const f32x4*)(x + idx)), b = __builtin_nontemporal_load((const f32x4*)(x + idx + 4));
                *(uint4*)(xb + idx) = make_uint4(pk2(a.x, a.y), pk2(a.z, a.w), pk2(b.x, b.y), pk2(b.z, b.w));
            }
            continue;
        } it -= N_X;
        if (it < N_ROPE) {
            const int e = it * 256 + tid, pos = e >> 5, i = e & 31;
            const float inv = 1.0f / powf(10000.0f, (float)(2 * i) / 64.0f);
            const float ang = (float)pos * inv;
            ((float*)(ws + WS_ROPE))[e] = (float)cos((double)ang);
            ((float*)(ws + WS_ROPE))[4096 * 32 + e] = (float)sin((double)ang);
            continue;
        } it -= N_ROPE;
        if (it < N_CB) {
            const int kv = it >> 3, j0 = (it & 7) * 16, j = j0 + (tid & 15), sl = tid >> 4;
            const float* pe = P.in[kv ? 3 : 2]; const float* w1 = P.in[kv ? 6 : 4];
            float a = 0.f;
            for (int i = sl * 128; i < sl * 128 + 128; ++i) a += pe[i] * w1[(size_t)i * 128 + j];
            sf[tid] = a; __syncthreads();
            if (tid < 16) { float t = 0.f; for (int q = 0; q < 16; ++q) t += sf[q * 16 + tid]; ((float*)(ws + WS_CBIAS))[kv * 128 + j0 + tid] = t; }
            __syncthreads();
            continue;
        } it -= N_CB;
        if (it < N_AL) {
            const int e = it * 256 + tid, g = e >> 6, p = e & 63;
            const CF a = s5_apow(P, g, p, 32.f);
            ((float*)(ws + WS_S5AL))[e * 2] = a.re; ((float*)(ws + WS_S5AL))[e * 2 + 1] = a.im;
            continue;
        } it -= N_AL;
        if (it < N_BTE) {
            const int e = it * 256 + tid, g = e >> 11, p = (e >> 5) & 63, r = e & 31;
            const CF w = cmul(s5_apow(P, g, p, (float)(31 - r)), s5_f(P, g, p));
            bf16_t* d = (bf16_t*)(ws + WS_BTE) + (size_t)g * 128 * 512;
#pragma unroll
            for (int c = 0; c < 16; ++c) {
                const CF bb = {P.in[11][(g * 64 + p) * 16 + c], P.in[12][(g * 64 + p) * 16 + c]};
                const CF v = cmul(w, bb);
                d[(size_t)p * 512 + r * 16 + c] = f2bf(v.re);
                d[(size_t)(64 + p) * 512 + r * 16 + c] = f2bf(v.im);
            }
            continue;
        } it -= N_BTE;
        if (it < N_BTYM) {
            const int g = it / 63, dd = it % 63 - 31, ch = tid >> 4, c = tid & 15;
            float val = 0.f;
            if (dd >= 0) {
                float* sw = sf; float* sb = sf + 128; float* sc = sf + 128 + 2048;
                if (tid < 64) { const CF w = cmul(s5_apow(P, g, tid, (float)dd), s5_f(P, g, tid)); sw[2 * tid] = w.re; sw[2 * tid + 1] = w.im; }
#pragma unroll
                for (int i = 0; i < 4; ++i) {
                    const int e = tid + 256 * i;
                    sb[2 * e] = P.in[11][(size_t)g * 1024 + e]; sb[2 * e + 1] = P.in[12][(size_t)g * 1024 + e];
                    sc[2 * e] = P.in[13][(size_t)g * 1024 + e]; sc[2 * e + 1] = P.in[14][(size_t)g * 1024 + e];
                }
                __syncthreads();
#pragma unroll 8
                for (int p = 0; p < 64; ++p) {
                    const CF bb = {sb[2 * (p * 16 + c)], sb[2 * (p * 16 + c) + 1]};
                    const CF cc = {sc[2 * (ch * 64 + p)], sc[2 * (ch * 64 + p) + 1]};
                    const CF w = {sw[2 * p], sw[2 * p + 1]};
                    val += cmul(cc, cmul(w, bb)).re;
                }
                __syncthreads();
            }
            bf16_t* d = (bf16_t*)(ws + WS_BTY) + (size_t)g * 512 * 640;
            const bf16_t hv = f2bf(val);
            for (int r = 0; r < 32; ++r) { const int s = r + dd; if (s >= 0 && s < 32) d[(size_t)(s * 16 + ch) * 640 + r * 16 + c] = hv; }
            continue;
        } it -= N_BTYM;
        if (it < N_BTYQ) {
            const int e = it * 256 + tid, g = e >> 15, s = (e >> 10) & 31, ch = (e >> 6) & 15, p = e & 63;
            const CF cc = {P.in[13][(g * 16 + ch) * 64 + p], P.in[14][(g * 16 + ch) * 64 + p]};
            const CF w = cmul(cc, s5_apow(P, g, p, (float)(s + 1)));
            bf16_t* d = (bf16_t*)(ws + WS_BTY) + ((size_t)g * 512 + s * 16 + ch) * 640 + 512;
            d[p] = f2bf(w.re); d[64 + p] = f2bf(-w.im);
            continue;
        } it -= N_BTYQ;
        {
            uint4* d = (uint4*)((bf16_t*)(ws + WS_WIN0) + (size_t)(1304 + it * 8) * 1024);
#pragma unroll
            for (int i = 0; i < 4; ++i) d[i * 256 + tid] = make_uint4(0, 0, 0, 0);
        }
    }
}

DI void phase_inproj0(const Params& P, unsigned char* smem) {
    unsigned char* ws = P.ws;
    const bf16_t* A = (const bf16_t*)(ws + WS_ACTB);
    const float* cosT = (const float*)(ws + WS_ROPE);
    const float* sinT = cosT + 4096 * 32;
    constexpr int NTN = NIN0 / 128;
    for (int it = vblock(); it < (NT / 128) * NTN; it += gridDim.x) {
        int mt, nt; tile_mn(it, NTN, mt, nt);
        const int m0 = mt * 128;
        auto rowptr = [=](int r) { return A + (size_t)(m0 + r) * 1024; };
        const bf16_t* Bt = (const bf16_t*)(ws + WS_WIN0) + (size_t)nt * 128 * 1024;
        if (nt == 7 || nt == 9) {
            auto epi = [=](f32x4 (&acc)[4][4], int wr, int wc, int lane) {
                const int fr = lane & 15, fq = lane >> 4, which = nt == 7 ? 3 : 5, g = wc;
#pragma unroll
                for (int m = 0; m < 4; ++m) {
                    const int t = m0 + wr * 64 + m * 16 + fq * 4, s = t & 4095, b = t >> 12;
                    bf16_t* dst = (bf16_t*)(ws + XP_KC + (size_t)which * KVSZ) + (size_t)(b * 2 + g) * 4096 * 64;
#pragma unroll
                    for (int n = 0; n < 4; ++n) *(u32x2*)(dst + vp_off(s, n * 16 + fr)) = cvt4(acc[m][n]);
                }
            };
            gemm128<false>(rowptr, Bt, 1024, 1024, smem, epi);
            continue;
        }
        auto epi = [=](f32x4 (&acc)[4][4], int wr, int wc, int lane) {
            const int u64 = nt * 2 + wc, fr = lane & 15, fq = lane >> 4;
#pragma unroll
            for (int m = 0; m < 4; ++m) {
                const int t = m0 + wr * 64 + m * 16 + fr, s = t & 4095, b = t >> 12;
                if (u64 < 20) {
                    const bool isq = u64 < 8;
                    const int which = (u64 - 8) >> 1, g = (u64 - 8) & 1;
                    if (isq || ((which & 1) == 0)) {
#pragma unroll
                        for (int n2 = 0; n2 < 2; ++n2) {
                            const int i = n2 * 16 + fq * 4;
                            const f32x4 c = *(const f32x4*)(cosT + s * 32 + i), sn = *(const f32x4*)(sinT + s * 32 + i);
                            const f32x4 x1 = acc[m][2 * n2], x2 = acc[m][2 * n2 + 1];
                            const u32x2 o1 = cvt4(x1 * c - x2 * sn), o2 = cvt4(x1 * sn + x2 * c);
                            if (isq) { bf16_t* dst = (bf16_t*)(ws + XP_Q0) + (size_t)t * 512 + u64 * 64; *(u32x2*)(dst + i) = o1; *(u32x2*)(dst + i + 32) = o2; }
                            else {
                                bf16_t* dst = (bf16_t*)(ws + XP_KC + (size_t)which * KVSZ) + (size_t)(b * 2 + g) * 4096 * 64;
                                if (which == 0) { *(u32x2*)(dst + (size_t)s * 64 + i) = o1; *(u32x2*)(dst + (size_t)s * 64 + i + 32) = o2; }
                                else { *(u32x2*)(dst + kp_off(s, i)) = o1; *(u32x2*)(dst + kp_off(s, i + 32)) = o2; }
                            }
                        }
                    } else {
                        bf16_t* dst = (bf16_t*)(ws + XP_KC + (size_t)which * KVSZ) + ((size_t)(b * 2 + g) * 4096 + s) * 64;
#pragma unroll
                        for (int n = 0; n < 4; ++n) *(u32x2*)(dst + n * 16 + fq * 4) = cvt4(acc[m][n]);
                    }
                } else if (u64 == 20) {
#pragma unroll
                    for (int n = 0; n < 2; ++n) {
                        const int c0 = n * 16 + fq * 4;
                        if (c0 < 24) { f32x4 o; o.x = sigmoidf_(acc[m][n].x); o.y = sigmoidf_(acc[m][n].y); o.z = sigmoidf_(acc[m][n].z); o.w = sigmoidf_(acc[m][n].w); *(f32x4*)((float*)(ws + XP_GATES) + (size_t)t * 24 + c0) = o; }
                    }
                } else if (u64 >= 22) {
#pragma unroll
                    for (int n = 0; n < 4; ++n) {
                        const int g5 = (u64 - 22) * 4 + n;
                        *(u32x2*)((bf16_t*)(ws + XP_AEXT) + ((size_t)g5 * 1024 + (t >> 5)) * 640 + (t & 31) * 16 + fq * 4) = cvt4(acc[m][n]);
                    }
                }
            }
        };
        gemm128(rowptr, Bt, 1024, 1024, smem, epi);
    }
}

constexpr int N_LATE = 16 * 48 + 256 + 3 * 64 * 32;
DI void late_weights(const Params& P, unsigned char* smem, int it) {
    unsigned char* ws = P.ws;
    float* sf = (float*)smem;
    constexpr int N_TR2 = 16 * 48, N_TR3 = 256, N_TRG = 64 * 32, N_TRU = 64 * 32;
    if (it < N_TR2) { tr_tile(P.in[19], 1024, 3072, (bf16_t*)(ws + WS_WIN1), 4, it / 48, it % 48, sf); return; } it -= N_TR2;
    if (it < N_TR3) { tr_tile(P.in[20], 1024, 1024, (bf16_t*)(ws + WS_WOUT1), 0, it / 16, it % 16, sf); return; } it -= N_TR3;
    if (it < N_TRG) { const int mat = it >> 5, r = it & 31; tr_tile(P.in[29] + (size_t)mat * 1024 * 128, 1024, 128, (bf16_t*)(ws + WS_WGU) + (size_t)mat * 256 * 1024, 2, r >> 1, r & 1, sf); return; } it -= N_TRG;
    if (it < N_TRU) { const int mat = it >> 5, r = it & 31; tr_tile(P.in[30] + (size_t)mat * 1024 * 128, 1024, 128, (bf16_t*)(ws + WS_WGU) + (size_t)mat * 256 * 1024, 3, r >> 1, r & 1, sf); return; } it -= N_TRU;
    { const int mat = it >> 5, r = it & 31; tr_tile(P.in[31] + (size_t)mat * 128 * 1024, 128, 1024, (bf16_t*)(ws + WS_WDN) + (size_t)mat * 1024 * 128, 0, r >> 4, r & 15, sf); }
}

DI void s5y_tile(const Params& P, unsigned char* smem, int g, int mt, int nt);
DI void phase_cmp_s5e(const Params& P, unsigned char* smem) {
    unsigned char* ws = P.ws;
    const int tid = threadIdx.x, lane = tid & 63, wave = tid >> 6;
    for (int it = blockIdx.x; it < 64 + 256 + N_LATE; it += gridDim.x) {
        if (it >= 64 + 256) { late_weights(P, smem, it - 320); continue; }
        if (it < 64) {
            const int kv = it >> 5, bg = (it >> 1) & 15, mt = it & 1;
            const bf16_t* src = (const bf16_t*)(ws + XP_KC + (size_t)kv * KVSZ) + (size_t)bg * 4096 * 64;
            const float* cb = (const float*)(ws + WS_CBIAS) + kv * 128;
            bf16_t* sH = (bf16_t*)smem;
            auto rowptr = [=](int r) { int rr = mt * 128 + r; rr = rr > 254 ? 254 : rr; return src + (size_t)rr * 1024; };
            auto epi = [=](f32x4 (&acc)[4][4], int wr, int wc, int ln) {
                const int fr = ln & 15, fq = ln >> 4;
#pragma unroll
                for (int m = 0; m < 4; ++m)
#pragma unroll
                    for (int n = 0; n < 4; ++n)
#pragma unroll
                        for (int j = 0; j < 4; ++j) {
                            const int r = wr * 64 + m * 16 + fr, c = wc * 64 + n * 16 + fq * 4 + j;
                            sH[r * 136 + c] = f2bf(gelu_tanh(acc[m][n][j] + cb[c]));
                        }
            };
            gemm128(rowptr, (const bf16_t*)(ws + (kv ? WS_WCV1 : WS_WCK1)), 2048, 2048, smem, epi);
            __syncthreads();
            const bf16_t* W2 = (const bf16_t*)(ws + (kv ? WS_WCV2 : WS_WCK2));
            f32x4 a2[2][4];
#pragma unroll
            for (int m = 0; m < 2; ++m)
#pragma unroll
                for (int n = 0; n < 4; ++n) a2[m][n] = (f32x4){0.f, 0.f, 0.f, 0.f};
#pragma unroll
            for (int ks = 0; ks < 4; ++ks) {
                bf16x8 af[2], bfr[4];
#pragma unroll
                for (int m = 0; m < 2; ++m) af[m] = *(const bf16x8*)(sH + (wave * 32 + m * 16 + (lane & 15)) * 136 + ks * 32 + (lane >> 4) * 8);
#pragma unroll
                for (int n = 0; n < 4; ++n) bfr[n] = *(const bf16x8*)(W2 + (n * 16 + (lane & 15)) * 128 + ks * 32 + (lane >> 4) * 8);
#pragma unroll
                for (int m = 0; m < 2; ++m)
#pragma unroll
                    for (int n = 0; n < 4; ++n) a2[m][n] = __builtin_amdgcn_mfma_f32_16x16x32_bf16(af[m], bfr[n], a2[m][n], 0, 0, 0);
            }
            bf16_t* dst = (bf16_t*)(ws + (kv ? WS_VCMP : WS_KCMP)) + (size_t)bg * 256 * 64;
#pragma unroll
            for (int m = 0; m < 2; ++m)
#pragma unroll
                for (int n = 0; n < 4; ++n)
#pragma unroll
                    for (int j = 0; j < 4; ++j) {
                        const int row = mt * 128 + wave * 32 + m * 16 + (lane >> 4) * 4 + j, col = n * 16 + (lane & 15);
                        dst[kv ? vp_off(row, col) : kp_off(row, col)] = row < 255 ? f2bf(a2[m][n][j]) : (bf16_t)0;
                    }
            __syncthreads();
        } else {
            const int it2 = it - 64, g = it2 >> 3, b = it2 & 7;
            bf16_t* aext = (bf16_t*)(ws + XP_AEXT) + ((size_t)g * 1024 + b * 128) * 640;
            float* sE = (float*)smem;
            auto rowptr = [=](int r) { return (const bf16_t*)aext + (size_t)r * 640; };
            auto epi = [=](f32x4 (&acc)[4][4], int wr, int wc, int ln) {
                const int fr = ln & 15, fq = ln >> 4;
#pragma unroll
                for (int m = 0; m < 4; ++m)
#pragma unroll
                    for (int n = 0; n < 4; ++n)
#pragma unroll
                        for (int j = 0; j < 4; ++j) sE[(wr * 64 + m * 16 + fr) * 129 + wc * 64 + n * 16 + fq * 4 + j] = acc[m][n][j];
            };
            gemm128(rowptr, (const bf16_t*)(ws + WS_BTE) + (size_t)g * 128 * 512, 512, 512, smem, epi);
            __syncthreads();
            {
                const int p = tid & 63, c0 = wave * 32;
                const float ar = ((const float*)(ws + WS_S5AL))[(g * 64 + p) * 2], ai = ((const float*)(ws + WS_S5AL))[(g * 64 + p) * 2 + 1];
                float* send = (float*)(smem + 128 * 129 * 4);
                float xr = 0.f, xi = 0.f;
                for (int c = c0; c < c0 + 32; ++c) {
                    const float er = sE[c * 129 + p], ei = sE[c * 129 + 64 + p];
                    const float nr = ar * xr - ai * xi + er, ni = ar * xi + ai * xr + ei;
                    xr = nr; xi = ni;
                }
                send[(wave * 64 + p) * 2] = xr; send[(wave * 64 + p) * 2 + 1] = xi;
                float qr = ar, qi = ai;
#pragma unroll
                for (int k = 0; k < 5; ++k) { const float tr = qr * qr - qi * qi, ti = 2.f * qr * qi; qr = tr; qi = ti; }
                __syncthreads();
                xr = 0.f; xi = 0.f;
                for (int k = 0; k < wave; ++k) {
                    const float er = send[(k * 64 + p) * 2], ei = send[(k * 64 + p) * 2 + 1];
                    const float nr = qr * xr - qi * xi + er, ni = qr * xi + qi * xr + ei;
                    xr = nr; xi = ni;
                }
                for (int c = c0; c < c0 + 32; ++c) {
                    aext[(size_t)c * 640 + 512 + p] = f2bf(xr);
                    aext[(size_t)c * 640 + 576 + p] = f2bf(xi);
                    const float er = sE[c * 129 + p], ei = sE[c * 129 + 64 + p];
                    const float nr = ar * xr - ai * xi + er, ni = ar * xi + ai * xr + ei;
                    xr = nr; xi = ni;
                }
            }
            asm volatile("s_waitcnt vmcnt(0)" ::: "memory");
            __syncthreads();
#pragma unroll 1
            for (int nt = 0; nt < 4; ++nt) s5y_tile(P, smem, g, b, nt);
        }
    }
}

DI void s5y_tile(const Params& P, unsigned char* smem, int g, int mt, int nt) {
    unsigned char* ws = P.ws;
    const bf16_t* aext = (const bf16_t*)(ws + XP_AEXT) + (size_t)g * 1024 * 640;
    const float* dsk = P.in[15];
    auto rowptr = [=](int r) { return aext + (size_t)(mt * 128 + r) * 640; };
    auto epi = [=](f32x4 (&acc)[4][4], int wr, int wc, int ln) {
        const int fr = ln & 15, fq = ln >> 4;
        const f32x4 dk = *(const f32x4*)(dsk + g * 16 + fq * 4);
#pragma unroll
        for (int m = 0; m < 4; ++m) {
            const int cr = mt * 128 + wr * 64 + m * 16 + fr;
#pragma unroll
            for (int n = 0; n < 4; ++n) {
                const int sp = nt * 8 + wc * 4 + n, t = cr * 32 + sp;
                const f32x4 u = bf4_to_f(*(const u32x2*)(aext + (size_t)cr * 640 + sp * 16 + fq * 4));
                const f32x4 y = acc[m][n] + dk * u;
                *(u32x2*)((bf16_t*)(ws + XP_G5) + (size_t)t * 512 + g * 16 + fq * 4) = cvt4((f32x4){gelu_tanh(y.x), gelu_tanh(y.y), gelu_tanh(y.z), gelu_tanh(y.w)});
            }
        }
    };
    gemm128(rowptr, (const bf16_t*)(ws + WS_BTY) + ((size_t)g * 512 + nt * 128) * 640, 640, 640, smem, epi, 2 * nt + 2, 8);
}
struct FA { f32x16 o0, o1; float m, l; };
DI void fa_init(FA& st) {
#pragma unroll
    for (int i = 0; i < 16; ++i) { st.o0[i] = 0.f; st.o1[i] = 0.f; }
    st.m = -1e30f; st.l = 0.f;
}
constexpr float FA_THR = 8.f;
template <int MODE, class Valid>
DI void fa_tile(FA& st, const bf16x8 (&qf)[4], const LAS bf16_t* Kt, const LAS bf16_t* Vt, int r, int h, float c, bool rowok, Valid valid) {
    const LAS bf16_t* kb = Kt + r * 16 + 8 * h;
    const LAS bf16_t* vb = Vt + r * 16 + 8 * h;
    bf16x8 kf[4], vf[4];
#pragma unroll
    for (int ks = 0; ks < 4; ++ks) kf[ks] = *(const LAS bf16x8*)(kb + ks * 512);
#pragma unroll
    for (int sub = 0; sub < 2; ++sub) {
        f32x16 acc;
#pragma unroll
        for (int i = 0; i < 16; ++i) acc[i] = 0.f;
#pragma unroll
        for (int ks = 0; ks < 4; ++ks) acc = MFMA32(kf[ks], qf[ks], acc);
#pragma unroll
        for (int s2 = 0; s2 < 2; ++s2) { vf[2 * s2] = *(const LAS bf16x8*)(vb + ((sub * 2 + s2) * 64) * 16); vf[2 * s2 + 1] = *(const LAS bf16x8*)(vb + ((sub * 2 + s2) * 64 + 32) * 16); }
        if (sub == 0) {
#pragma unroll
            for (int ks = 0; ks < 4; ++ks) kf[ks] = *(const LAS bf16x8*)(kb + (4 + ks) * 512);
        }
        __builtin_amdgcn_sched_barrier(0);
        float mx = -INFINITY;
#pragma unroll
        for (int i = 0; i < 16; ++i) {
            if (MODE == 2) { const int koff = sub * 32 + (i & 3) + 8 * (i >> 2) + 4 * h; acc[i] = valid(koff) ? acc[i] : -INFINITY; }
            mx = fmaxf(mx, acc[i]);
        }
        {
            const auto sw = __builtin_amdgcn_permlane32_swap(__float_as_uint(mx), __float_as_uint(mx), false, false);
            mx = fmaxf(__uint_as_float(sw[0]), __uint_as_float(sw[1]));
        }
        const float cand = mx * c;
        const bool upd = cand > st.m + FA_THR;
        if (__ballot(upd)) {
            const float mn = upd ? cand : st.m, alpha = __builtin_amdgcn_exp2f(st.m - mn);
            st.m = mn; st.l *= alpha;
#pragma unroll
            for (int i = 0; i < 16; ++i) { st.o0[i] *= alpha; st.o1[i] *= alpha; }
        }
        const float nb = (MODE == 1 && !rowok) ? -INFINITY : -st.m;
        float ps0 = 0.f, ps1 = 0.f;
#pragma unroll
        for (int i = 0; i < 16; i += 2) {
            acc[i] = __builtin_amdgcn_exp2f(__builtin_fmaf(acc[i], c, nb));
            acc[i + 1] = __builtin_amdgcn_exp2f(__builtin_fmaf(acc[i + 1], c, nb));
            ps0 += acc[i]; ps1 += acc[i + 1];
        }
        st.l += ps0 + ps1;
#pragma unroll
        for (int s2 = 0; s2 < 2; ++s2) {
            const bf16x8 pk = cvt8((f32x8){acc[8 * s2], acc[8 * s2 + 1], acc[8 * s2 + 2], acc[8 * s2 + 3], acc[8 * s2 + 4], acc[8 * s2 + 5], acc[8 * s2 + 6], acc[8 * s2 + 7]});
            st.o0 = MFMA32(vf[2 * s2], pk, st.o0);
            st.o1 = MFMA32(vf[2 * s2 + 1], pk, st.o1);
        }
    }
}
DI void fa_issue(const bf16_t* gK, const bf16_t* gV, LAS unsigned char* buf, int tid) {
    __builtin_amdgcn_global_load_lds((const unsigned*)(gK + tid * 8), (LAS unsigned*)(buf + tid * 16), 16, 0, 0);
    __builtin_amdgcn_global_load_lds((const unsigned*)(gK + (tid + 256) * 8), (LAS unsigned*)(buf + (tid + 256) * 16), 16, 0, 0);
    __builtin_amdgcn_global_load_lds((const unsigned*)(gV + tid * 8), (LAS unsigned*)(buf + 8192 + tid * 16), 16, 0, 0);
    __builtin_amdgcn_global_load_lds((const unsigned*)(gV + (tid + 256) * 8), (LAS unsigned*)(buf + 8192 + (tid + 256) * 16), 16, 0, 0);
}
DI void fa_wait(int j, int n) {
    const int rem = n - 1 - j;
    if (rem >= 2) asm volatile("s_waitcnt vmcnt(8)" ::: "memory");
    else if (rem == 1) asm volatile("s_waitcnt vmcnt(4)" ::: "memory");
    else asm volatile("s_waitcnt vmcnt(0)" ::: "memory");
    __builtin_amdgcn_s_barrier();
    asm volatile("" ::: "memory");
}

constexpr int NSA_LDS_IMP = 65536;
constexpr int NSA_LDS_SCS = NSA_LDS_IMP + 8192;
constexpr int NSA_LDS_MSK = NSA_LDS_SCS + 1024;
DI void phase_nsa(const Params& P, unsigned char* smem) {
    unsigned char* ws = P.ws;
    const int tid = threadIdx.x, lane = tid & 63, wave = tid >> 6, r = lane & 31, h = lane >> 5;
    const float c = 0.125f * 1.4426950408889634f;
    LAS unsigned char* lds = (LAS unsigned char*)smem;
    float* impw = (float*)(smem + NSA_LDS_IMP) + wave * 512;
    float* scs = (float*)(smem + NSA_LDS_SCS) + wave * 64;
    unsigned long long* mskw = (unsigned long long*)(smem + NSA_LDS_MSK) + wave * 8;
    for (int it = blockIdx.x; it < 2048; it += gridDim.x) {
        const int qt = 127 - (it >> 4), bg = it & 15, b = bg >> 1, g = bg & 1, t0 = qt * 32, qblk = t0 >> 6;
        const int ql = r >> 2, z = r & 3, s = t0 + wave * 8 + ql, t = b * 4096 + s;
        const bf16_t* Qg = (const bf16_t*)(ws + XP_Q0) + (size_t)t * 512 + (g * 4 + z) * 64;
        bf16x8 qf[4];
#pragma unroll
        for (int ks = 0; ks < 4; ++ks) qf[ks] = *(const bf16x8*)(Qg + ks * 16 + 8 * h);
        const float* gt = (const float*)(ws + XP_GATES) + (size_t)t * 24 + (g * 4 + z) * 3;
        const float g_c = gt[0], g_s = gt[1], g_w = gt[2];
        const bf16_t* Kc = (const bf16_t*)(ws + WS_KCMP) + (size_t)bg * 256 * 64;
        const bf16_t* Vc = (const bf16_t*)(ws + WS_VCMP) + (size_t)bg * 256 * 64;
        const bf16_t* Ks = (const bf16_t*)(ws + XP_KC + 2 * KVSZ) + (size_t)bg * 4096 * 64;
        const bf16_t* Vs = (const bf16_t*)(ws + XP_KC + 3 * KVSZ) + (size_t)bg * 4096 * 64;
        const bf16_t* Kw = (const bf16_t*)(ws + XP_KC + 4 * KVSZ) + (size_t)bg * 4096 * 64;
        const bf16_t* Vw = (const bf16_t*)(ws + XP_KC + 5 * KVSZ) + (size_t)bg * 4096 * 64;
        const int nct = ((t0 >> 4) + 1 + 63) >> 6;
        const int w0 = (t0 - 255) < 0 ? 0 : (t0 - 255) >> 6;
        const int e1 = nct, e2 = 2 * nct, e3 = e2 + qblk + 1, e4 = e3 + (qblk - w0 + 1);
        const int nc = s >= 31 ? ((s - 31) >> 4) + 1 : 0;
        const int s_lo = t0 + wave * 8, s_hi = s_lo + 7, nc_min = s_lo >= 31 ? ((s_lo - 31) >> 4) + 1 : 0;
        for (int i = lane; i < 512; i += 64) impw[i] = 0.f;
        auto tile_ptrs = [&](int i, const bf16_t*& gk, const bf16_t*& gv) {
            if (i < e1) { gk = Kc + (size_t)i * 4096; gv = Vc + (size_t)i * 4096; }
            else if (i < e2) { gk = Kc + (size_t)(i - e1) * 4096; gv = Vc + (size_t)(i - e1) * 4096; }
            else if (i < e3) { gk = Ks + (size_t)(i - e2) * 4096; gv = Vs + (size_t)(i - e2) * 4096; }
            else { gk = Kw + (size_t)(w0 + i - e3) * 4096; gv = Vw + (size_t)(w0 + i - e3) * 4096; }
        };
        FA st; fa_init(st);
        f32x16 out0, out1;
#pragma unroll
        for (int i = 0; i < 16; ++i) { out0[i] = 0.f; out1[i] = 0.f; }
        float m_c = -1e30f, il_c = 0.f;
        unsigned long long mymask = 0ull;
        asm volatile("s_waitcnt vmcnt(0)" ::: "memory");
        __builtin_amdgcn_s_barrier();
#pragma unroll
        for (int i = 0; i < 3; ++i) if (i < e4) { const bf16_t *gk, *gv; tile_ptrs(i, gk, gv); fa_issue(gk, gv, lds + i * 16384, tid); }
        for (int i = 0; i < e4; ++i) {
            fa_wait(i, e4);
            if (i + 3 < e4) { const bf16_t *gk, *gv; tile_ptrs(i + 3, gk, gv); fa_issue(gk, gv, lds + ((i + 3) & 3) * 16384, tid); }
            const LAS bf16_t* cur = (const LAS bf16_t*)(lds + (i & 3) * 16384);
            if (i < e1) {
                const int nb = i * 64;
                { if (nb + 63 < nc_min) fa_tile<0>(st, qf, cur, cur + 4096, r, h, c, true, [=](int) { return true; }); else fa_tile<2>(st, qf, cur, cur + 4096, r, h, c, true, [=](int koff) { return nb + koff < nc; }); }
                if (i == e1 - 1) {
                    const float l = st.l + __shfl_xor(st.l, 32);
                    il_c = 1.f / fmaxf(l, 1e-30f); m_c = st.m;
                    const float f = g_c * il_c;
#pragma unroll
                    for (int k = 0; k < 16; ++k) { out0[k] = st.o0[k] * f; out1[k] = st.o1[k] * f; }
                    fa_init(st);
                }
            } else if (i < e2) {
                const int nb = (i - e1) * 64;
#pragma unroll
                for (int sub = 0; sub < 2; ++sub) {
                    f32x16 acc;
#pragma unroll
                    for (int k = 0; k < 16; ++k) acc[k] = 0.f;
#pragma unroll
                    for (int ks = 0; ks < 4; ++ks) acc = MFMA32(*(const LAS bf16x8*)(cur + ((sub * 4 + ks) * 32 + r) * 16 + 8 * h), qf[ks], acc);
#pragma unroll
                    for (int q4 = 0; q4 < 4; ++q4) {
                        float p[4];
#pragma unroll
                        for (int k = 0; k < 4; ++k) {
                            const int n = nb + sub * 32 + 8 * q4 + 4 * h + k;
                            p[k] = (n < nc) ? __builtin_amdgcn_exp2f(acc[4 * q4 + k] * c - m_c) * il_c : 0.f;
                        }
                        float a = (p[0] + p[1]) + (p[2] + 0.5f * p[3]), cn = 0.5f * p[3];
                        a += __shfl_xor(a, 1); a += __shfl_xor(a, 2);
                        cn += __shfl_xor(cn, 1); cn += __shfl_xor(cn, 2);
                        const int jb = ((nb + sub * 32) >> 2) + 2 * q4 + h;
                        if (z == 0) { atomicAdd(&impw[ql * 64 + jb], a); if (jb + 1 < 64) atomicAdd(&impw[ql * 64 + jb + 1], cn); }
                    }
                }
                if (i == e2 - 1) {
                    __builtin_amdgcn_wave_barrier();
#pragma unroll 1
                    for (int qq = 0; qq < 8; ++qq) {
                        const int j = lane;
                        const float imp = impw[qq * 64 + j];
                        const float score = (j > qblk) ? -1.f : ((j == 0 || j == qblk || j == qblk - 1) ? 1e3f : imp);
                        scs[j] = score;
                        __builtin_amdgcn_wave_barrier();
                        int rank = 0;
#pragma unroll 8
                        for (int jj = 0; jj < 64; ++jj) { const float o = scs[jj]; rank += (o > score || (o == score && jj < j)) ? 1 : 0; }
                        const unsigned long long mk = __ballot(rank < 8 && score >= 0.f);
                        if (lane == 0) mskw[qq] = mk;
                        __builtin_amdgcn_wave_barrier();
                    }
                    mymask = mskw[ql];
                }
            } else if (i < e3) {
                const int j = i - e2;
                const bool sel = (mymask >> j) & 1ull;
                if (__ballot(sel)) {
                    if (j < qblk) fa_tile<1>(st, qf, cur, cur + 4096, r, h, c, sel, [=](int) { return true; });
                    else { const int kb = j * 64; fa_tile<2>(st, qf, cur, cur + 4096, r, h, c, true, [=](int koff) { return sel && (kb + koff <= s); }); }
                }
                if (i == e3 - 1) {
                    const float l = st.l + __shfl_xor(st.l, 32);
                    const float f = g_s / fmaxf(l, 1e-30f);
#pragma unroll
                    for (int k = 0; k < 16; ++k) { out0[k] += st.o0[k] * f; out1[k] += st.o1[k] * f; }
                    fa_init(st);
                }
            } else {
                const int kb = (w0 + i - e3) * 64;
                { if (kb >= s_hi - 255 && kb + 63 <= s_lo) fa_tile<0>(st, qf, cur, cur + 4096, r, h, c, true, [=](int) { return true; }); else fa_tile<2>(st, qf, cur, cur + 4096, r, h, c, true, [=](int koff) { const int key = kb + koff; return key <= s && key >= s - 255; }); }
            }
        }
        {
            const float l = st.l + __shfl_xor(st.l, 32);
            const float f = g_w / fmaxf(l, 1e-30f);
#pragma unroll
            for (int k = 0; k < 16; ++k) { out0[k] += st.o0[k] * f; out1[k] += st.o1[k] * f; }
        }
        bf16_t* o = (bf16_t*)(ws + WS_MIX) + (size_t)t * 1024 + (g * 4 + z) * 64;
#pragma unroll
        for (int g4 = 0; g4 < 4; ++g4) {
            *(u32x2*)(o + 8 * g4 + 4 * h) = cvt4((f32x4){out0[4 * g4], out0[4 * g4 + 1], out0[4 * g4 + 2], out0[4 * g4 + 3]});
            *(u32x2*)(o + 32 + 8 * g4 + 4 * h) = cvt4((f32x4){out1[4 * g4], out1[4 * g4 + 1], out1[4 * g4 + 2], out1[4 * g4 + 3]});
        }
    }
}

DI void phase_glu(const Params& P, unsigned char* smem) {
    unsigned char* ws = P.ws;
    const bf16_t* G5 = (const bf16_t*)(ws + XP_G5);
    const float* gb = P.in[17];
    for (int it = vblock(); it < (NT / 128) * 4; it += gridDim.x) {
        int mt, nt; tile_mn(it, 4, mt, nt);
        const int m0 = mt * 128;
        auto rowptr = [=](int r) { return G5 + (size_t)(m0 + r) * 512; };
        auto epi = [=](f32x4 (&acc)[4][4], int wr, int wc, int ln) {
            const int fr = ln & 15, fq = ln >> 4;
#pragma unroll
            for (int m = 0; m < 4; ++m) {
                const int row = m0 + wr * 64 + m * 16 + fr;
#pragma unroll
                for (int n = 0; n < 4; ++n) {
                    const int col = nt * 128 + wc * 64 + n * 16 + fq * 4;
                    const f32x4 gv = bf4_to_f(*(const u32x2*)(G5 + (size_t)row * 512 + col)), bb = *(const f32x4*)(gb + col), z = acc[m][n] + bb;
                    *(u32x2*)((bf16_t*)(ws + WS_MIX) + (size_t)row * 1024 + 512 + col) = cvt4((f32x4){gv.x * sigmoidf_(z.x), gv.y * sigmoidf_(z.y), gv.z * sigmoidf_(z.z), gv.w * sigmoidf_(z.w)});
                }
            }
        };
        gemm128(rowptr, (const bf16_t*)(ws + WS_WGLU) + (size_t)nt * 128 * 512, 512, 512, smem, epi);
    }
}

DI void phase_outproj(const Params& P, unsigned char* smem, const float* xres, size_t wt_off) {
    unsigned char* ws = P.ws;
    const bf16_t* A = (const bf16_t*)(ws + WS_MIX);
    float* out = P.out;
    for (int it = vblock(); it < (NT / 128) * 8; it += gridDim.x) {
        int mt, nt; tile_mn(it, 8, mt, nt);
        const int m0 = mt * 128;
        auto rowptr = [=](int r) { return A + (size_t)(m0 + r) * 1024; };
        auto epi = [=](f32x4 (&acc)[4][4], int wr, int wc, int ln) {
            const int fr = ln & 15, fq = ln >> 4;
#pragma unroll
            for (int m = 0; m < 4; ++m) {
                const size_t base = (size_t)(m0 + wr * 64 + m * 16 + fr) * 1024 + nt * 128 + wc * 64 + fq * 4;
                f32x4 xr[4];
#pragma unroll
                for (int n = 0; n < 4; ++n) xr[n] = *(const f32x4*)(xres + base + n * 16);
#pragma unroll
                for (int n = 0; n < 4; ++n) *(f32x4*)(out + base + n * 16) = xr[n] * ALPHA + acc[m][n];
            }
        };
        gemm128(rowptr, (const bf16_t*)(ws + wt_off) + (size_t)nt * 128 * 1024, 1024, 1024, smem, epi);
    }
}

DI void ln_row(float (&v)[16], const float* __restrict__ g, const float* __restrict__ bta, int lane) {
    float s = 0.f;
#pragma unroll
    for (int i = 0; i < 16; ++i) s += v[i];
    const float mu = wave_sum(s) * (1.f / 1024.f);
    float q = 0.f;
#pragma unroll
    for (int i = 0; i < 16; ++i) { v[i] -= mu; q += v[i] * v[i]; }
    const float rstd = rsqrtf(wave_sum(q) * (1.f / 1024.f) + LN_EPS);
#pragma unroll
    for (int j = 0; j < 4; ++j) {
        const float4 gg = *(const float4*)(g + 4 * lane + 256 * j), bb = *(const float4*)(bta + 4 * lane + 256 * j);
        v[4 * j + 0] = v[4 * j + 0] * rstd * gg.x + bb.x; v[4 * j + 1] = v[4 * j + 1] * rstd * gg.y + bb.y;
        v[4 * j + 2] = v[4 * j + 2] * rstd * gg.z + bb.z; v[4 * j + 3] = v[4 * j + 3] * rstd * gg.w + bb.w;
    }
}

DI void phase_ln_router(const Params& P, int layer) {
    unsigned char* ws = P.ws;
    const int lane = threadIdx.x & 63, wave = threadIdx.x >> 6;
    const float* g = P.in[21] + layer * 1024; const float* bta = P.in[22] + layer * 1024;
    const float* wc = (const float*)(ws + WS_RTRW) + (size_t)layer * 36864; const float* bc = P.in[26] + layer * 4;
    const float* wf = wc + 4096; const float* bfn = P.in[28] + layer * 32;
    int* cnt = (int*)(ws + WS_CTL) + layer * 2048;
    int* list = (int*)(ws + WS_LIST2);
    float* wgt = (float*)(ws + WS_WGT);
    bf16_t* xb = (bf16_t*)(ws + WS_ACTB);
    for (int task = blockIdx.x * 4 + wave; task < NT / 16; task += gridDim.x * 4) {
        int my_e = 0; float my_w = 0.f;
        f32x4 wcr[16];
#pragma unroll
        for (int q = 0; q < 16; ++q) wcr[q] = *(const f32x4*)(wc + (q * 64 + lane) * 4);
        f32x4 nx[4];
#pragma unroll
        for (int j = 0; j < 4; ++j) nx[j] = __builtin_nontemporal_load((const f32x4*)(P.out + (size_t)(task * 16) * 1024 + 4 * lane + 256 * j));
#pragma unroll 1
        for (int i = 0; i < 16; ++i) {
            const int t = task * 16 + i;
            float v[16];
#pragma unroll
            for (int j = 0; j < 4; ++j) { v[4 * j] = nx[j].x; v[4 * j + 1] = nx[j].y; v[4 * j + 2] = nx[j].z; v[4 * j + 3] = nx[j].w; }
            if (i + 1 < 16) {
#pragma unroll
                for (int j = 0; j < 4; ++j) nx[j] = __builtin_nontemporal_load((const f32x4*)(P.out + (size_t)(t + 1) * 1024 + 4 * lane + 256 * j));
            }
            ln_row(v, g, bta, lane);
#pragma unroll
            for (int j = 0; j < 4; ++j) {
                *(u32x2*)(xb + (size_t)t * 1024 + 4 * lane + 256 * j) = cvt4((f32x4){v[4 * j], v[4 * j + 1], v[4 * j + 2], v[4 * j + 3]});
            }
            float lc[4] = {0.f, 0.f, 0.f, 0.f};
#pragma unroll
            for (int j = 0; j < 4; ++j)
#pragma unroll
                for (int k = 0; k < 4; ++k) {
                    const f32x4 w = wcr[j * 4 + k];
                    const float x = v[4 * j + k];
                    lc[0] += x * w.x; lc[1] += x * w.y; lc[2] += x * w.z; lc[3] += x * w.w;
                }
#pragma unroll
            for (int c = 0; c < 4; ++c) lc[c] = wave_sum(lc[c]) + bc[c];
            int gi = 0; float lm = lc[0];
#pragma unroll
            for (int c = 1; c < 4; ++c) if (lc[c] > lm) { lm = lc[c]; gi = c; }
            gi = __builtin_amdgcn_readfirstlane(gi);
            float den = 0.f;
#pragma unroll
            for (int c = 0; c < 4; ++c) den += expf(lc[c] - lm);
            const float gv = 1.f / den;
            float lf[8] = {0.f, 0.f, 0.f, 0.f, 0.f, 0.f, 0.f, 0.f};
            const float* wfg = wf + (size_t)gi * 8192;
#pragma unroll
            for (int j = 0; j < 4; ++j)
#pragma unroll
                for (int k = 0; k < 4; ++k) {
                    const f32x4 w0 = *(const f32x4*)(wfg + (((j * 4 + k) * 2 + 0) * 64 + lane) * 4), w1 = *(const f32x4*)(wfg + (((j * 4 + k) * 2 + 1) * 64 + lane) * 4);
                    const float x = v[4 * j + k];
                    lf[0] += x * w0.x; lf[1] += x * w0.y; lf[2] += x * w0.z; lf[3] += x * w0.w;
                    lf[4] += x * w1.x; lf[5] += x * w1.y; lf[6] += x * w1.z; lf[7] += x * w1.w;
                }
#pragma unroll
            for (int e = 0; e < 8; ++e) lf[e] = wave_sum(lf[e]) + bfn[gi * 8 + e];
            int e1 = 0; float l1 = lf[0];
#pragma unroll
            for (int e = 1; e < 8; ++e) if (lf[e] > l1) { l1 = lf[e]; e1 = e; }
            int e2 = 0; float l2 = -INFINITY;
#pragma unroll
            for (int e = 0; e < 8; ++e) if (e != e1 && lf[e] > l2) { l2 = lf[e]; e2 = e; }
            const float r = expf(l2 - l1);
            if (lane == i) { my_e = gi * 8 + e1; my_w = gv / (1.f + r); }
            if (lane == 16 + i) { my_e = gi * 8 + e2; my_w = gv * r / (1.f + r); }
        }
        if (lane < 32) {
            const int t = task * 16 + (lane & 15), k = lane >> 4, slot = (task & 63) * 32 + my_e;
            const int pos = atomicAdd(&cnt[slot], 1);
            list[(slot << 10) + pos] = t * 2 + k;
            wgt[t * 2 + k] = my_w;
        }
    }
}

constexpr int MOE_LDS_TAB = 65536;
constexpr int MOE_LDS_ROW = 65536 + 8448;
DI void moe_tables(const int* cnt, unsigned char* smem) {
    int* tab = (int*)(smem + MOE_LDS_TAB);
    if (threadIdx.x < 32) { const int e = threadIdx.x; int run = 0; for (int s = 0; s < 64; ++s) { tab[e * 65 + s] = run; run += cnt[s * 32 + e]; } tab[e * 65 + 64] = run; }
    __syncthreads();
}
DI bool moe_tile(const int* tab, int tile, int& e, int& mt, int& off, int& ce) {
    int acc_t = 0, acc_r = 0;
    for (int i = 0; i < 32; ++i) {
        const int c = tab[i * 65 + 64], nt = (c + 127) >> 7;
        if (tile < acc_t + nt) { e = i; mt = tile - acc_t; off = acc_r; ce = c; return true; }
        acc_t += nt; acc_r += c;
    }
    return false;
}
DI int moe_ntiles(const int* tab) { int a = 0; for (int i = 0; i < 32; ++i) a += (tab[i * 65 + 64] + 127) >> 7; return a; }
DI void moe_rows(const int* tab, const int* list, int e, int mt, int ce, int* rowidx) {
    if (threadIdx.x < 128) {
        const int pos = mt * 128 + threadIdx.x;
        int idx = -1;
        if (pos < ce) {
            int lo = 0, hi = 64;
            while (hi - lo > 1) { const int mid = (lo + hi) >> 1; if (tab[e * 65 + mid] <= pos) lo = mid; else hi = mid; }
            idx = list[((lo * 32 + e) << 10) + pos - tab[e * 65 + lo]];
        }
        rowidx[threadIdx.x] = idx;
    }
    __syncthreads();
}

DI void phase_moe_gu(const Params& P, unsigned char* smem, int layer) {
    unsigned char* ws = P.ws;
    const int* cnt = (const int*)(ws + WS_CTL) + layer * 2048;
    const int* list = (const int*)(ws + WS_LIST2);
    const float* wgt = (const float*)(ws + WS_WGT);
    const bf16_t* xb = (const bf16_t*)(ws + WS_ACTB);
    bf16_t* H = (bf16_t*)(ws + XP_H);
    const int* tab = (const int*)(smem + MOE_LDS_TAB);
    int* rowidx = (int*)(smem + MOE_LDS_ROW);
    moe_tables(cnt, smem);
    const int ntile = moe_ntiles(tab);
    for (int it = vblock(); it < ntile * 2; it += gridDim.x) {
        int e, mt, off, ce; moe_tile(tab, it >> 1, e, mt, off, ce);
        const int nt = it & 1;
        moe_rows(tab, list, e, mt, ce, rowidx);
        auto rowptr = [=](int r) { int idx = rowidx[r]; idx = idx < 0 ? rowidx[0] : idx; return xb + (size_t)(idx >> 1) * 1024; };
        auto epi = [=](f32x4 (&acc)[4][4], int wr, int wc, int ln) {
            const int fr = ln & 15, fq = ln >> 4;
#pragma unroll
            for (int m = 0; m < 4; ++m) {
                const int rl = wr * 64 + m * 16 + fr, idx = rowidx[rl];
                if (idx >= 0) {
                    const float w = wgt[idx];
#pragma unroll
                    for (int n = 0; n < 2; ++n) {
                        const f32x4 gte = acc[m][n], up = acc[m][n + 2];
                        *(u32x2*)(H + (size_t)(off + mt * 128 + rl) * 128 + (nt * 2 + wc) * 32 + n * 16 + fq * 4) =
                            cvt4((f32x4){gte.x * sigmoidf_(gte.x) * up.x * w, gte.y * sigmoidf_(gte.y) * up.y * w, gte.z * sigmoidf_(gte.z) * up.z * w, gte.w * sigmoidf_(gte.w) * up.w * w});
                    }
                }
            }
        };
        gemm128(rowptr, (const bf16_t*)(ws + WS_WGU) + ((size_t)(layer * 32 + e) * 256 + nt * 128) * 1024, 1024, 1024, smem, epi);
        __syncthreads();
    }
}
DI void phase_moe_down(const Params& P, unsigned char* smem, int layer) {
    unsigned char* ws = P.ws;
    const int* cnt = (const int*)(ws + WS_CTL) + layer * 2048;
    const int* list = (const int*)(ws + WS_LIST2);
    const bf16_t* H = (const bf16_t*)(ws + XP_H);
    bf16_t* YB = (bf16_t*)(ws + XP_YB);
    const int* tab = (const int*)(smem + MOE_LDS_TAB);
    int* rowidx = (int*)(smem + MOE_LDS_ROW);
    moe_tables(cnt, smem);
    const int ntile = moe_ntiles(tab);
    for (int it = vblock(); it < ntile * 8; it += gridDim.x) {
        int e, mt, off, ce; moe_tile(tab, it >> 3, e, mt, off, ce);
        const int nt = it & 7;
        moe_rows(tab, list, e, mt, ce, rowidx);
        auto rowptr = [=](int r) { int pos = mt * 128 + r; pos = pos < ce ? pos : 0; return H + (size_t)(off + pos) * 128; };
        auto epi = [=](f32x4 (&acc)[4][4], int wr, int wc, int ln) {
            const int fr = ln & 15, fq = ln >> 4;
#pragma unroll
            for (int m = 0; m < 4; ++m) {
                const int idx = rowidx[wr * 64 + m * 16 + fr];
                if (idx >= 0) {
                    bf16_t* dst = YB + (size_t)idx * 1024 + nt * 128 + wc * 64 + fq * 4;
#pragma unroll
                    for (int n = 0; n < 4; ++n) *(u32x2*)(dst + n * 16) = cvt4(acc[m][n]);
                }
            }
        };
        gemm128(rowptr, (const bf16_t*)(ws + WS_WDN) + ((size_t)(layer * 32 + e) * 1024 + nt * 128) * 128, 128, 128, smem, epi);
        __syncthreads();
    }
}
DI void phase_ln_ffn(const Params& P, int layer) {
    unsigned char* ws = P.ws;
    const int lane = threadIdx.x & 63, wave = threadIdx.x >> 6;
    const float* g = P.in[23] + layer * 1024; const float* bta = P.in[24] + layer * 1024;
    const bf16_t* YB = (const bf16_t*)(ws + XP_YB);
    bf16_t* xb = (bf16_t*)(ws + WS_ACTB);
    for (int task = blockIdx.x * 4 + wave; task < NT / 16; task += gridDim.x * 4) {
        u32x2 nxm[4], ny0[4], ny1[4];
        auto fetch = [&](int t) {
#pragma unroll
            for (int j = 0; j < 4; ++j) {
                nxm[j] = __builtin_nontemporal_load((const u32x2*)(xb + (size_t)t * 1024 + 4 * lane + 256 * j));
                ny0[j] = __builtin_nontemporal_load((const u32x2*)(YB + (size_t)(2 * t) * 1024 + 4 * lane + 256 * j));
                ny1[j] = __builtin_nontemporal_load((const u32x2*)(YB + (size_t)(2 * t + 1) * 1024 + 4 * lane + 256 * j));
            }
        };
        fetch(task * 16);
#pragma unroll 1
        for (int i = 0; i < 16; ++i) {
            const int t = task * 16 + i;
            float v[16];
#pragma unroll
            for (int j = 0; j < 4; ++j) {
                const f32x4 a = bf4_to_f(nxm[j]), y0 = bf4_to_f(ny0[j]), y1 = bf4_to_f(ny1[j]);
                v[4 * j + 0] = ALPHA * a.x + (y0.x + y1.x); v[4 * j + 1] = ALPHA * a.y + (y0.y + y1.y);
                v[4 * j + 2] = ALPHA * a.z + (y0.z + y1.z); v[4 * j + 3] = ALPHA * a.w + (y0.w + y1.w);
            }
            if (i + 1 < 16) fetch(t + 1);
            ln_row(v, g, bta, lane);
            float* row = P.out + (size_t)t * 1024;
#pragma unroll
            for (int j = 0; j < 4; ++j) {
                *(f32x4*)(row + 4 * lane + 256 * j) = (f32x4){v[4 * j], v[4 * j + 1], v[4 * j + 2], v[4 * j + 3]};
                if (layer == 0) *(u32x2*)(xb + (size_t)t * 1024 + 4 * lane + 256 * j) = cvt4((f32x4){v[4 * j], v[4 * j + 1], v[4 * j + 2], v[4 * j + 3]});
            }
        }
    }
}

DI void phase_inproj1(const Params& P, unsigned char* smem) {
    unsigned char* ws = P.ws;
    const bf16_t* A = (const bf16_t*)(ws + WS_ACTB);
    const float* cosT = (const float*)(ws + WS_ROPE);
    const float* sinT = cosT + 4096 * 32;
    for (int it = vblock(); it < (NT / 128) * 24; it += gridDim.x) {
        int mt, nt; tile_mn(it, 24, mt, nt);
        const int m0 = mt * 128;
        auto rowptr = [=](int r) { return A + (size_t)(m0 + r) * 1024; };
        const bf16_t* Bt = (const bf16_t*)(ws + WS_WIN1) + (size_t)nt * 128 * 1024;
        if (nt >= 16) {
            auto epi = [=](f32x4 (&acc)[4][4], int wr, int wc, int lane) {
                const int head = (nt * 2 + wc) & 15, fr = lane & 15, fq = lane >> 4;
#pragma unroll
                for (int m = 0; m < 4; ++m) {
                    const int t = m0 + wr * 64 + m * 16 + fq * 4, s = t & 4095, b = t >> 12;
                    bf16_t* base = (bf16_t*)(ws + XP_Q1 + (size_t)2 * 64 * MiB) + (size_t)(b * 16 + head) * 4096 * 64;
#pragma unroll
                    for (int n = 0; n < 4; ++n) *(u32x2*)(base + vp_off(s, n * 16 + fr)) = cvt4(acc[m][n]);
                }
            };
            gemm128<false>(rowptr, Bt, 1024, 1024, smem, epi);
            continue;
        }
        auto epi = [=](f32x4 (&acc)[4][4], int wr, int wc, int lane) {
            const int u64 = nt * 2 + wc, kind = u64 >> 4, head = u64 & 15, fr = lane & 15, fq = lane >> 4;
            f32x4 cs[2][2];
#pragma unroll
            for (int n2 = 0; n2 < 2; ++n2) { cs[n2][0] = (f32x4){0.f, 0.f, 0.f, 0.f}; cs[n2][1] = cs[n2][0]; }
#pragma unroll
            for (int m = 0; m < 4; ++m) {
                const int t = m0 + wr * 64 + m * 16 + fr, s = t & 4095, b = t >> 12;
                bf16_t* base = (bf16_t*)(ws + XP_Q1 + (size_t)kind * 64 * MiB) + (size_t)(b * 16 + head) * 4096 * 64;
#pragma unroll
                for (int n2 = 0; n2 < 2; ++n2) {
                    const int i = n2 * 16 + fq * 4;
                    const f32x4 c = *(const f32x4*)(cosT + s * 32 + i), sn = *(const f32x4*)(sinT + s * 32 + i);
                    const f32x4 x1 = acc[m][2 * n2], x2 = acc[m][2 * n2 + 1];
                    const f32x4 r1 = x1 * c - x2 * sn, r2 = x1 * sn + x2 * c;
                    const u32x2 o1 = cvt4(r1), o2 = cvt4(r2);
                    if (kind == 0) { *(u32x2*)(base + (size_t)s * 64 + i) = o1; *(u32x2*)(base + (size_t)s * 64 + i + 32) = o2; }
                    else { *(u32x2*)(base + kp_off(s, i)) = o1; *(u32x2*)(base + kp_off(s, i + 32)) = o2; cs[n2][0] += r1; cs[n2][1] += r2; }
                }
            }
            if (kind == 1) {
                const int t0 = m0 + wr * 64, bh = (t0 >> 12) * 16 + head, seg = (t0 & 4095) >> 6;
                float* dst = (float*)(ws + WS_KMP) + ((size_t)bh * 64 + seg) * 64;
#pragma unroll
                for (int n2 = 0; n2 < 2; ++n2)
#pragma unroll
                    for (int hf = 0; hf < 2; ++hf) {
                        f32x4 v = cs[n2][hf];
#pragma unroll
                        for (int k = 0; k < 4; ++k) { float x = v[k]; x += dpp_f<0xB1>(x); x += dpp_f<0x4E>(x); x += dpp_f<0x141>(x); x += dpp_f<0x140>(x); v[k] = x; }
                        if (fr == 0) *(f32x4*)(dst + n2 * 16 + fq * 4 + hf * 32) = v;
                    }
            }
        };
        gemm128(rowptr, Bt, 1024, 1024, smem, epi);
    }
}
DI void moba_kmeans_slab(const Params& P, bf16_t* kml, int bh, int tid) {
    const float* kp = (const float*)(P.ws + WS_KMP) + (size_t)bh * 64 * 64;
    for (int e = tid; e < 2048; e += 256) {
        const int d = e & 63, n = e >> 6;
        float a = 0.f;
        if (n < 16) a = ((kp[(4 * n) * 64 + d] + kp[(4 * n + 1) * 64 + d]) + (kp[(4 * n + 2) * 64 + d] + kp[(4 * n + 3) * 64 + d])) * (1.f / 256.f);
        kml[((d >> 4) * 32 + n) * 16 + (d & 15)] = f2bf(a);
    }
}
DI unsigned moba_gate_rows(const bf16_t* km, const bf16x8 (&qf)[4], int own, int r, int h) {
    f32x16 g;
#pragma unroll
    for (int i = 0; i < 16; ++i) g[i] = 0.f;
#pragma unroll
    for (int ks = 0; ks < 4; ++ks) g = MFMA32(*(const bf16x8*)(km + (ks * 32 + r) * 16 + 8 * h), qf[ks], g);
    float mine[8], oth[8];
#pragma unroll
    for (int i = 0; i < 8; ++i) { const int n = (i & 3) + 8 * (i >> 2) + 4 * h; mine[i] = n < own ? g[i] : -INFINITY; oth[i] = __shfl_xor(mine[i], 32); }
    unsigned selmask = 0;
#pragma unroll
    for (int i = 0; i < 8; ++i) {
        const int n = (i & 3) + 8 * (i >> 2) + 4 * h;
        int rank = 0;
#pragma unroll
        for (int k = 0; k < 8; ++k) {
            const int nk = (k & 3) + 8 * (k >> 2) + 4 * h, no = (k & 3) + 8 * (k >> 2) + 4 * (1 - h);
            rank += (mine[k] > mine[i] || (mine[k] == mine[i] && nk < n)) ? 1 : 0;
            rank += (oth[k] > mine[i] || (oth[k] == mine[i] && no < n)) ? 1 : 0;
        }
        if (n < own && rank < 3) selmask |= 1u << n;
    }
    return selmask | __shfl_xor(selmask, 32);
}
DI void phase_moba_gate(const Params& P, unsigned char* smem) {
    unsigned char* ws = P.ws;
    const int tid = threadIdx.x, lane = tid & 63, wave = tid >> 6, r = lane & 31, h = lane >> 5;
    bf16_t* kml = (bf16_t*)smem;
    unsigned short* smask = (unsigned short*)(smem + 4096);
    unsigned short* selm = (unsigned short*)(ws + WS_SELM);
    unsigned short* mcnt = (unsigned short*)(ws + WS_MCNT);
    unsigned char* mlist = ws + WS_MLIST;
    int km_bh = -1;
    for (int it = blockIdx.x; it < 2048; it += gridDim.x) {
        const int bh = it & 127, qb = it >> 7;
        if (bh != km_bh) { km_bh = bh; __syncthreads(); moba_kmeans_slab(P, kml, bh, tid); }
        __syncthreads();
#pragma unroll 1
        for (int g2 = 0; g2 < 2; ++g2) {
            const int rl = wave * 64 + g2 * 32 + r, q = qb * 256 + rl;
            const bf16_t* Qg = (const bf16_t*)(ws + XP_Q1) + ((size_t)bh * 4096 + q) * 64;
            bf16x8 qf[4];
#pragma unroll
            for (int ks = 0; ks < 4; ++ks) qf[ks] = *(const bf16x8*)(Qg + ks * 16 + 8 * h);
            const unsigned sm = qb > 0 ? moba_gate_rows(kml, qf, qb, r, h) : 0u;
            if (h == 0) { selm[(size_t)bh * 4096 + q] = (unsigned short)sm; smask[rl] = (unsigned short)sm; }
        }
        __syncthreads();
        for (int n = wave; n < qb; n += 4) {
            unsigned char* lp = mlist + ((size_t)(bh * 16 + qb) * 16 + n) * 256;
            int base = 0;
#pragma unroll
            for (int c4 = 0; c4 < 4; ++c4) {
                const int row = c4 * 64 + lane;
                const bool bit = (smask[row] >> n) & 1;
                const unsigned long long bal = __ballot(bit);
                if (bit) lp[base + __builtin_popcountll(bal & ((1ull << lane) - 1ull))] = (unsigned char)row;
                base += __builtin_popcountll(bal);
            }
            if (lane == 0) mcnt[(bh * 16 + qb) * 16 + n] = (unsigned short)base;
        }
    }
}
DI bf16_t* moba_po(const Params& P, int slot) { return (bf16_t*)(P.ws + (slot == 0 ? WS_MIX : slot == 1 ? WS_ACTB : WS_PO2)); }
DI void phase_moba_kv(const Params& P, unsigned char* smem) {
    unsigned char* ws = P.ws;
    const int tid = threadIdx.x, lane = tid & 63, wave = tid >> 6, r = lane & 31, h = lane >> 5;
    const float c = 0.125f * 1.4426950408889634f;
    LAS unsigned char* lds = (LAS unsigned char*)smem;
    const unsigned short* selm = (const unsigned short*)(ws + WS_SELM);
    const unsigned short* mcnt = (const unsigned short*)(ws + WS_MCNT);
    const unsigned char* mlist = ws + WS_MLIST;
    float* pml = (float*)(ws + WS_PML);
    const bool bal = (gridDim.x == 512);
    const int nit = bal ? ((blockIdx.x >> 7) == 3 ? 3 : 4) : (1920 + (int)gridDim.x - 1 - (int)blockIdx.x) / (int)gridDim.x;
    for (int iti = 0; iti < nit; ++iti) {
        int bh, n;
        if (bal) { const int gq = blockIdx.x >> 7; bh = blockIdx.x & 127; const int tab = gq == 0 ? 0x0DA90 : gq == 1 ? 0x0CB61 : gq == 2 ? 0x0E852 : 0x00743; n = (tab >> (4 * iti)) & 15; }
        else { const int it = blockIdx.x + iti * gridDim.x; n = it >> 7; bh = it & 127; }
        const bf16_t* Kg = (const bf16_t*)(ws + XP_Q1 + 64 * MiB) + (size_t)bh * 4096 * 64 + (size_t)n * 4 * 4096;
        const bf16_t* Vg = (const bf16_t*)(ws + XP_Q1 + 128 * MiB) + (size_t)bh * 4096 * 64 + (size_t)n * 4 * 4096;
        asm volatile("s_waitcnt vmcnt(0)" ::: "memory");
        __builtin_amdgcn_s_barrier();
#pragma unroll
        for (int j = 0; j < 4; ++j) fa_issue(Kg + (size_t)j * 4096, Vg + (size_t)j * 4096, lds + j * 16384, tid);
        const int cntv = (lane < 16 && lane > n) ? (int)mcnt[(bh * 16 + lane) * 16 + n] : 0;
        asm volatile("s_waitcnt vmcnt(0)" ::: "memory");
        __builtin_amdgcn_s_barrier();
        asm volatile("" ::: "memory");
        int prefv = 0, total = 0;
#pragma unroll 1
        for (int qb = 0; qb < 16; ++qb) { if (lane == qb) prefv = total; total += __builtin_amdgcn_readlane(cntv, qb); }
#pragma unroll 1
        for (int v0 = wave * 32; v0 < total; v0 += 128) {
            const int v = v0 + r;
            const bool valid = v < total;
            const int vv = valid ? v : v0;
            int qb = n + 1;
#pragma unroll 1
            for (int l = n + 2; l < 16; ++l) if (vv >= __builtin_amdgcn_readlane(prefv, l)) qb = l;
            const int idx = vv - __shfl(prefv, qb);
            const int q = qb * 256 + (int)mlist[((size_t)(bh * 16 + qb) * 16 + n) * 256 + idx];
            const bf16_t* Qg = (const bf16_t*)(ws + XP_Q1) + ((size_t)bh * 4096 + q) * 64;
            bf16x8 qf[4];
#pragma unroll
            for (int ks = 0; ks < 4; ++ks) qf[ks] = *(const bf16x8*)(Qg + ks * 16 + 8 * h);
            FA st; fa_init(st);
#pragma unroll 1
            for (int j = 0; j < 4; ++j) {
                const LAS bf16_t* cur = (const LAS bf16_t*)(lds + j * 16384);
                fa_tile<0>(st, qf, cur, cur + 4096, r, h, c, true, [=](int) { return true; });
            }
            const float l = st.l + __shfl_xor(st.l, 32);
            const float inv = 1.f / fmaxf(l, 1e-30f);
            if (valid) {
                const int slot = __builtin_popcount((unsigned)selm[(size_t)bh * 4096 + q] & ((1u << n) - 1u));
                bf16_t* o = moba_po(P, slot) + ((size_t)(bh >> 4) * 4096 + q) * 1024 + (bh & 15) * 64;
#pragma unroll
                for (int g4 = 0; g4 < 4; ++g4) {
                    *(u32x2*)(o + 8 * g4 + 4 * h) = cvt4((f32x4){st.o0[4 * g4] * inv, st.o0[4 * g4 + 1] * inv, st.o0[4 * g4 + 2] * inv, st.o0[4 * g4 + 3] * inv});
                    *(u32x2*)(o + 32 + 8 * g4 + 4 * h) = cvt4((f32x4){st.o1[4 * g4] * inv, st.o1[4 * g4 + 1] * inv, st.o1[4 * g4 + 2] * inv, st.o1[4 * g4 + 3] * inv});
                }
                if (h == 0) { float* pm = pml + (((size_t)bh * 4096 + q) * 3 + slot) * 2; pm[0] = st.m; pm[1] = l; }
            }
        }
    }
}
DI void phase_moba_own(const Params& P, unsigned char* smem) {
    unsigned char* ws = P.ws;
    const int tid = threadIdx.x, lane = tid & 63, wave = tid >> 6, r = lane & 31, h = lane >> 5;
    const float c = 0.125f * 1.4426950408889634f;
    LAS unsigned char* lds = (LAS unsigned char*)smem;
    const unsigned short* selm = (const unsigned short*)(ws + WS_SELM);
    const float* pml = (const float*)(ws + WS_PML);
    for (int it = blockIdx.x; it < 2048; it += gridDim.x) {
        const int own = 15 - (it >> 7), bh = it & 127, t0 = own * 256;
        const bf16_t* Kg = (const bf16_t*)(ws + XP_Q1 + 64 * MiB) + (size_t)bh * 4096 * 64 + (size_t)own * 4 * 4096;
        const bf16_t* Vg = (const bf16_t*)(ws + XP_Q1 + 128 * MiB) + (size_t)bh * 4096 * 64 + (size_t)own * 4 * 4096;
        asm volatile("s_waitcnt vmcnt(0)" ::: "memory");
        __builtin_amdgcn_s_barrier();
#pragma unroll
        for (int j = 0; j < 4; ++j) fa_issue(Kg + (size_t)j * 4096, Vg + (size_t)j * 4096, lds + j * 16384, tid);
        asm volatile("s_waitcnt vmcnt(0)" ::: "memory");
        __builtin_amdgcn_s_barrier();
        asm volatile("" ::: "memory");
#pragma unroll 1
        for (int g2 = 0; g2 < 2; ++g2) {
            const int row0 = t0 + g2 * 128 + wave * 32, q = row0 + r;
            const bf16_t* Qg = (const bf16_t*)(ws + XP_Q1) + ((size_t)bh * 4096 + q) * 64;
            bf16x8 qf[4];
#pragma unroll
            for (int ks = 0; ks < 4; ++ks) qf[ks] = *(const bf16x8*)(Qg + ks * 16 + 8 * h);
            const int nsel = __builtin_popcount((unsigned)selm[(size_t)bh * 4096 + q]);
            const size_t orow = ((size_t)(bh >> 4) * 4096 + q) * 1024 + (bh & 15) * 64;
            const float* pm = pml + ((size_t)bh * 4096 + q) * 6;
            float mi[3], li[3];
            u32x2 pa[3][8];
#pragma unroll
            for (int i = 0; i < 3; ++i) {
                mi[i] = i < nsel ? pm[2 * i] : -INFINITY; li[i] = i < nsel ? pm[2 * i + 1] : 0.f;
                const bf16_t* po = moba_po(P, i) + orow;
#pragma unroll
                for (int g4 = 0; g4 < 4; ++g4) {
                    pa[i][2 * g4] = i < nsel ? *(const u32x2*)(po + 8 * g4 + 4 * h) : (u32x2){0u, 0u};
                    pa[i][2 * g4 + 1] = i < nsel ? *(const u32x2*)(po + 32 + 8 * g4 + 4 * h) : (u32x2){0u, 0u};
                }
            }
            FA st; fa_init(st);
            const int jmax = (row0 + 31 - t0) >> 6;
#pragma unroll 1
            for (int j = 0; j <= jmax; ++j) {
                const LAS bf16_t* cur = (const LAS bf16_t*)(lds + j * 16384);
                const int kbase = t0 + j * 64;
                if (kbase + 63 <= row0) fa_tile<0>(st, qf, cur, cur + 4096, r, h, c, true, [=](int) { return true; });
                else fa_tile<2>(st, qf, cur, cur + 4096, r, h, c, true, [=](int koff) { return kbase + koff <= q; });
            }
            const float l_own = st.l + __shfl_xor(st.l, 32);
            const float M = fmaxf(fmaxf(st.m, mi[0]), fmaxf(mi[1], mi[2]));
            const float wo = __builtin_amdgcn_exp2f(st.m - M);
            float L = l_own * wo;
#pragma unroll
            for (int k = 0; k < 16; ++k) { st.o0[k] *= wo; st.o1[k] *= wo; }
#pragma unroll
            for (int i = 0; i < 3; ++i) {
                const float wi = li[i] * __builtin_amdgcn_exp2f(mi[i] - M);
                L += wi;
#pragma unroll
                for (int g4 = 0; g4 < 4; ++g4) {
                    const f32x4 a = bf4_to_f(pa[i][2 * g4]), b2 = bf4_to_f(pa[i][2 * g4 + 1]);
                    st.o0[4 * g4] += wi * a.x; st.o0[4 * g4 + 1] += wi * a.y; st.o0[4 * g4 + 2] += wi * a.z; st.o0[4 * g4 + 3] += wi * a.w;
                    st.o1[4 * g4] += wi * b2.x; st.o1[4 * g4 + 1] += wi * b2.y; st.o1[4 * g4 + 2] += wi * b2.z; st.o1[4 * g4 + 3] += wi * b2.w;
                }
            }
            const float inv = 1.f / fmaxf(L, 1e-30f);
            bf16_t* o = (bf16_t*)(ws + WS_MIX) + orow;
#pragma unroll
            for (int g4 = 0; g4 < 4; ++g4) {
                *(u32x2*)(o + 8 * g4 + 4 * h) = cvt4((f32x4){st.o0[4 * g4] * inv, st.o0[4 * g4 + 1] * inv, st.o0[4 * g4 + 2] * inv, st.o0[4 * g4 + 3] * inv});
                *(u32x2*)(o + 32 + 8 * g4 + 4 * h) = cvt4((f32x4){st.o1[4 * g4] * inv, st.o1[4 * g4 + 1] * inv, st.o1[4 * g4 + 2] * inv, st.o1[4 * g4 + 3] * inv});
            }
        }
    }
}

constexpr int SMEM_BYTES = 65536 + 8192 + 1024 + 512;
static_assert(SMEM_BYTES >= 128 * 129 * 4 && SMEM_BYTES >= MOE_LDS_ROW + 512 && SMEM_BYTES >= NSA_LDS_MSK + 256, "LDS map");
constexpr int SMEM_OLD = 128 * 129 * 4;
typedef __attribute__((address_space(1))) unsigned gu32;
#define XB_TMO      128
#define XB_XCNT(j)  (256  + 64 * (j))
#define XB_XSUB(j)  (1280 + 64 * (j))
#define XB_XGEN(j)  (2304 + 64 * (j))
#define XB_TOP      3328
#define XB_TOPGEN   3392
#define XCD_BAR_WORDS 3456
#define XB_SPIN_CAP (1u << 18)

__device__ __forceinline__ unsigned xb_ld(unsigned* p)              { return __hip_atomic_load(p, __ATOMIC_RELAXED, __HIP_MEMORY_SCOPE_AGENT); }
__device__ __forceinline__ unsigned xb_add(unsigned* p, unsigned v) { return __hip_atomic_fetch_add(p, v, __ATOMIC_RELAXED, __HIP_MEMORY_SCOPE_AGENT); }
__device__ __forceinline__ unsigned xb_xcc_id() { return (unsigned)__builtin_amdgcn_s_getreg((3 << 11) | 20) & 0xFu; }
#define XB_SPIN(cond, bar) do { unsigned _sp = 0; while (cond) { __builtin_amdgcn_s_sleep(1); \
    if ((++_sp & 255u) == 0u) { if (xb_ld(&(bar)[XB_TMO])) break; if (_sp > XB_SPIN_CAP) { atomicAdd(&(bar)[XB_TMO], 1u); break; } } } } while (0)

struct XcdBarrier {
    unsigned* bar; unsigned x;
    volatile LAS unsigned* st;
};

__device__ __forceinline__ XcdBarrier xcd_barrier_post(unsigned* bar, volatile LAS unsigned* st) {
    XcdBarrier b; b.bar = bar; b.x = xb_xcc_id(); b.st = st;
    if (threadIdx.x == 0) (void)xb_add(&bar[XB_XCNT(b.x)], 1u);
    return b;
}
__device__ __forceinline__ void xcd_barrier_complete(unsigned* bar, unsigned x, unsigned& nloc, unsigned& nx) {
    const unsigned G = gridDim.x * gridDim.y * gridDim.z;
    unsigned sum, cnt, mine, sp = 0u;
    for (;;) {
        sum = 0u; cnt = 0u; mine = 0u;
#pragma unroll
        for (unsigned j = 0; j < 16; ++j) { const unsigned c = xb_ld(&bar[XB_XCNT(j)]); sum += c; cnt += (c > 0u) ? 1u : 0u; mine = (j == x) ? c : mine; }
        if (sum == G) break;
        __builtin_amdgcn_s_sleep(1);
        if ((++sp & 255u) == 0u) { if (xb_ld(&bar[XB_TMO])) break; if (sp > XB_SPIN_CAP) { atomicAdd(&bar[XB_TMO], 1u); break; } }
    }
    nloc = mine > 0u ? mine : 1u; nx = cnt > 0u ? cnt : 1u;
}

__device__ __forceinline__ void xcd_barrier(const XcdBarrier& b) {
    asm volatile("s_waitcnt vmcnt(0)" ::: "memory");
    __syncthreads();
    if (threadIdx.x == 0) {
        unsigned* bar = b.bar;
        __builtin_amdgcn_s_waitcnt(0);
        unsigned nloc = b.st[0], nx = b.st[1];
        if (nloc == 0u) { xcd_barrier_complete(bar, b.x, nloc, nx); b.st[0] = nloc; b.st[1] = nx; }
        const unsigned old = xb_add(&bar[XB_XSUB(b.x)], 1u);
        const unsigned gen = old / nloc;
        if (old + 1u == (gen + 1u) * nloc) {
            __builtin_amdgcn_fence(__ATOMIC_RELEASE, "agent");
            asm volatile("s_waitcnt vmcnt(0)" ::: "memory");
            const unsigned og = xb_add(&bar[XB_TOP], 1u);
            const unsigned tg = og / nx;
            if (og + 1u == (tg + 1u) * nx) xb_add(&bar[XB_TOPGEN], 1u);
            else XB_SPIN(xb_ld(&bar[XB_TOPGEN]) == tg, bar);
            __builtin_amdgcn_fence(__ATOMIC_ACQUIRE, "agent");
            xb_add(&bar[XB_XGEN(b.x)], 1u);
            asm volatile("s_waitcnt vmcnt(0)" ::: "memory");
        } else {
            XB_SPIN(xb_ld(&bar[XB_XGEN(b.x)]) == gen, bar);
            __builtin_amdgcn_fence(__ATOMIC_ACQUIRE, "agent");
            asm volatile("s_waitcnt vmcnt(0)" ::: "memory");
        }
    }
    __syncthreads();
}

constexpr size_t CTL_BAR = 16384;
constexpr size_t CTL_BYTES = 32768;

#define PHASE(k, call) if (P.ph_lo <= (k) && (k) < P.ph_hi) { call; if ((k) + 1 < P.ph_hi) xcd_barrier(xb); }
__global__ void __launch_bounds__(256, 2) mega(Params P) {
    __shared__ __attribute__((aligned(16))) unsigned char smem[SMEM_BYTES + 16];
    unsigned* xbst = (unsigned*)(smem + SMEM_BYTES);
    cg::grid_group grid = cg::this_grid();
    if (threadIdx.x < 4) xbst[threadIdx.x] = 0u;
    __syncthreads();
    if (P.ph_lo < 0) grid.sync();
    XcdBarrier xb = xcd_barrier_post((unsigned*)(P.ws + WS_CTL + CTL_BAR), (volatile LAS unsigned*)xbst);
    PHASE(0, phase0(P, smem))
    PHASE(1, phase_inproj0(P, smem))
    PHASE(2, phase_cmp_s5e(P, smem))
    PHASE(3, phase_glu(P, smem); phase_nsa(P, smem))
    PHASE(6, phase_outproj(P, smem, P.in[0], WS_WOUT0))
    PHASE(7, phase_ln_router(P, 0))
    PHASE(8, phase_moe_gu(P, smem, 0))
    PHASE(9, phase_moe_down(P, smem, 0))
    PHASE(10, phase_ln_ffn(P, 0))
    PHASE(11, phase_inproj1(P, smem))
    PHASE(12, phase_moba_gate(P, smem))
    PHASE(13, phase_moba_kv(P, smem))
    PHASE(14, phase_moba_own(P, smem))
    PHASE(15, phase_outproj(P, smem, P.out, WS_WOUT1))
    PHASE(16, phase_ln_router(P, 1))
    PHASE(17, phase_moe_gu(P, smem, 1))
    PHASE(18, phase_moe_down(P, smem, 1))
    PHASE(20, phase_ln_ffn(P, 1))
}

extern "C" void kernel_launch(void* const* d_in, const int* in_sizes, int n_in, void* d_out, int out_size, void* d_ws, size_t ws_size, hipStream_t stream) {
    static int grid = 0;
    if (grid == 0) {
        if (n_in != 32 || out_size != NT * DM || ws_size < WS_END) { fprintf(stderr, "kernel_launch: unexpected shapes (n_in %d, out %d, ws %zu)\n", n_in, out_size, ws_size); grid = -1; return; }
        int dev = 0, cus = 0, per_cu = 0;
        (void)hipGetDevice(&dev);
        (void)hipDeviceGetAttribute(&cus, hipDeviceAttributeMultiprocessorCount, dev);
        (void)hipOccupancyMaxActiveBlocksPerMultiprocessor(&per_cu, mega, 256, 0);
        if (per_cu < 1) per_cu = 1;
        if (per_cu > 2) per_cu = 2;
        grid = cus * per_cu;
    }
    if (grid < 0) return;
    (void)hipMemsetAsync((char*)d_ws + WS_CTL, 0, CTL_BYTES, stream);
    Params p{};
    for (int i = 0; i < 32; ++i) p.in[i] = (const float*)d_in[i];
    p.out = (float*)d_out; p.ws = (unsigned char*)d_ws;
    p.ph_lo = 0; p.ph_hi = NPH;
    void* args[] = {&p};
    hipError_t e = hipLaunchCooperativeKernel((void*)mega, dim3(grid), dim3(256), args, 0, stream);
    if (e != hipSuccess) fprintf(stderr, "cooperative launch failed: %s (grid %d)\n", hipGetErrorString(e), grid);
}
```

```cpp
#include <hip/hip_runtime.h>
#include <hip/hip_cooperative_groups.h>
#include <cstdio>
#include <cstdint>
namespace cg = cooperative_groups;

typedef unsigned short bf16_t;
typedef short bf16x8 __attribute__((ext_vector_type(8)));
typedef float f32x4 __attribute__((ext_vector_type(4)));
typedef unsigned u32x4 __attribute__((ext_vector_type(4)));
typedef unsigned u32x2 __attribute__((ext_vector_type(2)));
#define DI __device__ __forceinline__
#define LAS __attribute__((address_space(3)))
typedef float f32x16 __attribute__((ext_vector_type(16)));
typedef float f32x8 __attribute__((ext_vector_type(8)));
typedef __bf16 bf16x8v __attribute__((ext_vector_type(8)));
typedef __bf16 bf16x4v __attribute__((ext_vector_type(4)));
#define MFMA32(a, b, c) __builtin_amdgcn_mfma_f32_32x32x16_bf16((a), (b), (c), 0, 0, 0)

constexpr int NB = 8, SEQ = 4096, DM = 1024, NT = NB * SEQ;
constexpr float ALPHA = 1.41421356237f;
constexpr float LN_EPS = 1e-5f;
constexpr int NIN0 = 1920;
constexpr int NPH = 21;

constexpr size_t MiB = 1u << 20;
constexpr size_t WS_CTL = 0;
constexpr size_t WS_ROPE = 1 * MiB;
constexpr size_t WS_WIN0 = 2 * MiB;
constexpr size_t WS_WOUT0 = 6 * MiB;
constexpr size_t WS_WIN1 = 8 * MiB;
constexpr size_t WS_WOUT1 = 14 * MiB;
constexpr size_t WS_WGLU = 16 * MiB;
constexpr size_t WS_WCK1 = 16 * MiB + 512 * 1024;
constexpr size_t WS_WCV1 = 17 * MiB;
constexpr size_t WS_WCK2 = 17 * MiB + 512 * 1024;
constexpr size_t WS_WCV2 = WS_WCK2 + 16384;
constexpr size_t WS_CBIAS = WS_WCV2 + 16384;
constexpr size_t WS_S5AL = WS_CBIAS + 4096;
constexpr size_t WS_RTRW = 17 * MiB + 640 * 1024;
constexpr size_t WS_BTE = 18 * MiB;
constexpr size_t WS_BTY = 22 * MiB;
constexpr size_t WS_WGU = 42 * MiB;
constexpr size_t WS_WDN = 74 * MiB;
constexpr size_t WS_KMP = 90 * MiB;
constexpr size_t WS_WGT = 94 * MiB;
constexpr size_t WS_KMEAN = 94 * MiB + 512 * 1024;
constexpr size_t WS_KCMP = 95 * MiB;
constexpr size_t WS_VCMP = 95 * MiB + 512 * 1024;
constexpr size_t WS_ACTB = 96 * MiB;
constexpr size_t WS_MIX = 160 * MiB;
constexpr size_t WS_XP = 224 * MiB;
constexpr size_t WS_LIST2 = 416 * MiB;
constexpr size_t WS_SELM = 92 * MiB;
constexpr size_t WS_MCNT = 93 * MiB;
constexpr size_t WS_MLIST = WS_LIST2;
constexpr size_t WS_PO2 = 424 * MiB;
constexpr size_t WS_PML = 488 * MiB;
constexpr size_t WS_END = 504 * MiB;
constexpr size_t XP_Q0 = WS_XP;
constexpr size_t XP_KC = WS_XP + 32 * MiB;
constexpr size_t KVSZ = 8 * MiB;
constexpr size_t XP_GATES = WS_XP + 80 * MiB;
constexpr size_t XP_AEXT = WS_XP + 84 * MiB;
constexpr size_t XP_G5 = WS_XP + 124 * MiB;
constexpr size_t XP_YB = WS_XP;
constexpr size_t XP_H = WS_XP + 128 * MiB;
constexpr size_t XP_Q1 = WS_XP;

struct Params {
    const float* in[32];
    float* out;
    unsigned char* ws;
    int ph_lo, ph_hi;
};

DI bf16_t f2bf(float f) { unsigned u = __float_as_uint(f); return (bf16_t)((u + 0x7fffu + ((u >> 16) & 1u)) >> 16); }
DI float bf2f(bf16_t h) { return __uint_as_float(((unsigned)h) << 16); }
DI unsigned pk2(float lo, float hi) { return (unsigned)f2bf(lo) | ((unsigned)f2bf(hi) << 16); }
DI bf16x8 cvt8(f32x8 v) { return __builtin_bit_cast(bf16x8, __builtin_convertvector(v, bf16x8v)); }
DI u32x2 cvt4(f32x4 v) { return __builtin_bit_cast(u32x2, __builtin_convertvector(v, bf16x4v)); }
DI size_t kp_off(int key, int d) { return ((size_t)((key >> 5) * 4 + (d >> 4)) * 32 + (key & 31)) * 16 + (d & 15); }
DI int vp_pos(int ko) { return 8 * ((ko >> 2) & 1) + 4 * (ko >> 3) + (ko & 3); }
DI size_t vp_off(int key, int d) { return ((size_t)(key >> 4) * 64 + d) * 16 + vp_pos(key & 15); }
DI bf16_t ld_bf(const bf16_t* p) { return *p; }
DI f32x4 bf4_to_f(u32x2 w) { return (f32x4){__uint_as_float(w.x << 16), __uint_as_float(w.x & 0xffff0000u), __uint_as_float(w.y << 16), __uint_as_float(w.y & 0xffff0000u)}; }
template <int CTRL> DI float dpp_f(float v) { return __builtin_bit_cast(float, __builtin_amdgcn_update_dpp(0, __builtin_bit_cast(int, v), CTRL, 0xF, 0xF, true)); }
DI float wave_sum(float v) {
    v += dpp_f<0xB1>(v);
    v += dpp_f<0x4E>(v);
    v += dpp_f<0x141>(v);
    v += dpp_f<0x140>(v);
    { const auto s = __builtin_amdgcn_permlane16_swap(__float_as_uint(v), __float_as_uint(v), false, false); v = __uint_as_float(s[0]) + __uint_as_float(s[1]); }
    { const auto s = __builtin_amdgcn_permlane32_swap(__float_as_uint(v), __float_as_uint(v), false, false); v = __uint_as_float(s[0]) + __uint_as_float(s[1]); }
    return v;
}
DI float wave_max(float v) {
#pragma unroll
    for (int o = 32; o > 0; o >>= 1) v = fmaxf(v, __shfl_xor(v, o));
    return v;
}
DI float sigmoidf_(float x) { return __builtin_amdgcn_rcpf(1.f + __expf(-x)); }
DI float gelu_tanh(float x) { const float z = 0.7978845608028654f * (x + 0.044715f * x * x * x); return x * sigmoidf_(2.f * z); }

constexpr int GEMM_LDS = 65536;
template <bool TRANS = true, class RowPtr, class Epi>
DI void gemm128(RowPtr rowptr, const bf16_t* __restrict__ Bt, int ldb, int K, unsigned char* smem, Epi epi, int kskip_lo = 0, int kskip_hi = 0) {
    LAS unsigned char* lds = (LAS unsigned char*)smem;
    const int tid = threadIdx.x, lane = tid & 63, wave = tid >> 6, wr = wave >> 1, wc = wave & 1, fr = lane & 15, fq = lane >> 4;
    const int schunk = ((tid & 7) ^ ((tid >> 4) & 7)) * 8;
    const bf16_t* ga[4];
#pragma unroll
    for (int i = 0; i < 4; ++i) ga[i] = rowptr(i * 32 + (tid >> 3)) + schunk;
    const bf16_t* gb = Bt + (size_t)(tid >> 3) * ldb + schunk;
    const size_t gbs = (size_t)32 * ldb;
    auto stage = [&](int kt, int s) {
#pragma unroll
        for (int i = 0; i < 4; ++i) {
            __builtin_amdgcn_global_load_lds((const unsigned*)(ga[i] + kt * 64), (LAS unsigned*)(lds + s * 32768 + (i * 256 + tid) * 16), 16, 0, 0);
            __builtin_amdgcn_global_load_lds((const unsigned*)(gb + i * gbs + kt * 64), (LAS unsigned*)(lds + s * 32768 + 16384 + (i * 256 + tid) * 16), 16, 0, 0);
        }
    };
    f32x4 acc[4][4];
#pragma unroll
    for (int m = 0; m < 4; ++m)
#pragma unroll
        for (int n = 0; n < 4; ++n) acc[m][n] = (f32x4){0.f, 0.f, 0.f, 0.f};
    const int nskip = kskip_hi - kskip_lo, nk = (K >> 6) - nskip;
    const int swz = (fr >> 1) & 7;
    const int aoff = (wr * 64 + fr) * 128, boff = 16384 + (wc * 64 + fr) * 128;
    stage(kskip_lo == 0 ? nskip : 0, 0);
#pragma unroll 1
    for (int kt = 0; kt < nk; ++kt) {
        asm volatile("s_waitcnt vmcnt(0)" ::: "memory");
        __syncthreads();
        if (kt + 1 < nk) stage(kt + 1 < kskip_lo ? kt + 1 : kt + 1 + nskip, (kt + 1) & 1);
        const LAS unsigned char* cur = lds + (kt & 1) * 32768;
#pragma unroll
        for (int ks = 0; ks < 2; ++ks) {
            bf16x8 af[4], bfr[4];
            const int co = ((ks * 4 + fq) ^ swz) * 16;
#pragma unroll
            for (int m = 0; m < 4; ++m) af[m] = *(const LAS bf16x8*)(cur + aoff + m * 2048 + co);
#pragma unroll
            for (int n = 0; n < 4; ++n) bfr[n] = *(const LAS bf16x8*)(cur + boff + n * 2048 + co);
#pragma unroll
            for (int m = 0; m < 4; ++m)
#pragma unroll
                for (int n = 0; n < 4; ++n) acc[m][n] = TRANS ? __builtin_amdgcn_mfma_f32_16x16x32_bf16(bfr[n], af[m], acc[m][n], 0, 0, 0) : __builtin_amdgcn_mfma_f32_16x16x32_bf16(af[m], bfr[n], acc[m][n], 0, 0, 0);
        }
    }
    __syncthreads();
    epi(acc, wr, wc, lane);
}

template <bool TRANS = true, class RowPtr, class Epi, class NextRow>
DI void gemm128s(RowPtr rowptr, const bf16_t* __restrict__ Bt, int ldb, int K, unsigned char* smem, Epi epi, bool prefetched, bool has_next, NextRow nextrow, const bf16_t* __restrict__ nextBt) {
    LAS unsigned char* lds = (LAS unsigned char*)smem;
    const int tid = threadIdx.x, lane = tid & 63, wave = tid >> 6, wr = wave >> 1, wc = wave & 1, fr = lane & 15, fq = lane >> 4;
    const int schunk = ((tid & 7) ^ ((tid >> 4) & 7)) * 8;
    const bf16_t* ga[4];
#pragma unroll
    for (int i = 0; i < 4; ++i) ga[i] = rowptr(i * 32 + (tid >> 3)) + schunk;
    const bf16_t* gb = Bt + (size_t)(tid >> 3) * ldb + schunk;
    const size_t gbs = (size_t)32 * ldb;
    auto stage = [&](int kt, int s) {
#pragma unroll
        for (int i = 0; i < 4; ++i) {
            __builtin_amdgcn_global_load_lds((const unsigned*)(ga[i] + kt * 64), (LAS unsigned*)(lds + s * 32768 + (i * 256 + tid) * 16), 16, 0, 0);
            __builtin_amdgcn_global_load_lds((const unsigned*)(gb + i * gbs + kt * 64), (LAS unsigned*)(lds + s * 32768 + 16384 + (i * 256 + tid) * 16), 16, 0, 0);
        }
    };
    f32x4 acc[4][4];
#pragma unroll
    for (int m = 0; m < 4; ++m)
#pragma unroll
        for (int n = 0; n < 4; ++n) acc[m][n] = (f32x4){0.f, 0.f, 0.f, 0.f};
    const int nk = K >> 6;
    const int swz = (fr >> 1) & 7;
    const int aoff = (wr * 64 + fr) * 128, boff = 16384 + (wc * 64 + fr) * 128;
    if (!prefetched) stage(0, 0);
#pragma unroll 1
    for (int kt = 0; kt < nk; ++kt) {
        asm volatile("s_waitcnt vmcnt(0)" ::: "memory");
        __syncthreads();
        if (kt + 1 < nk) stage(kt + 1, (kt + 1) & 1);
        else if (has_next) {
#pragma unroll
            for (int i = 0; i < 4; ++i) {
                __builtin_amdgcn_global_load_lds((const unsigned*)(nextrow(i * 32 + (tid >> 3)) + schunk), (LAS unsigned*)(lds + (i * 256 + tid) * 16), 16, 0, 0);
                __builtin_amdgcn_global_load_lds((const unsigned*)(nextBt + (size_t)(tid >> 3) * ldb + schunk + i * gbs), (LAS unsigned*)(lds + 16384 + (i * 256 + tid) * 16), 16, 0, 0);
            }
        }
        const LAS unsigned char* cur = lds + (kt & 1) * 32768;
#pragma unroll
        for (int ks = 0; ks < 2; ++ks) {
            bf16x8 af[4], bfr[4];
            const int co = ((ks * 4 + fq) ^ swz) * 16;
#pragma unroll
            for (int m = 0; m < 4; ++m) af[m] = *(const LAS bf16x8*)(cur + aoff + m * 2048 + co);
#pragma unroll
            for (int n = 0; n < 4; ++n) bfr[n] = *(const LAS bf16x8*)(cur + boff + n * 2048 + co);
#pragma unroll
            for (int m = 0; m < 4; ++m)
#pragma unroll
                for (int n = 0; n < 4; ++n) acc[m][n] = TRANS ? __builtin_amdgcn_mfma_f32_16x16x32_bf16(bfr[n], af[m], acc[m][n], 0, 0, 0) : __builtin_amdgcn_mfma_f32_16x16x32_bf16(af[m], bfr[n], acc[m][n], 0, 0, 0);
        }
    }
    epi(acc, wr, wc, lane);
}

DI int vblock() { const int G = gridDim.x; return (G & 7) == 0 ? (int)(blockIdx.x & 7) * (G >> 3) + (int)(blockIdx.x >> 3) : (int)blockIdx.x; }
DI void tile_mn(int it, int nN, int& mt, int& nt) { const int per = 8 * nN, grp = it / per, idx = it - grp * per; nt = idx >> 3; mt = grp * 8 + (idx & 7); }

DI int rope_pos(int l) { return (l & ~63) + ((2 * ((l & 31) >> 4) + ((l >> 5) & 1)) << 4) + (l & 15); }
DI int rowmap(int kind, int n) {
    if (kind == 1) {
        if (n < 512 || (n >= 512 && n < 640) || (n >= 768 && n < 896) || (n >= 1024 && n < 1152)) return rope_pos(n);
        return n < 1304 ? n : n + 104;
    }
    if (kind == 4) return n < 2048 ? rope_pos(n) : n;
    if (kind == 2) return ((n >> 5) << 6) + (n & 31);
    if (kind == 3) return ((n >> 5) << 6) + 32 + (n & 31);
    return n;
}
DI void tr_tile(const float* __restrict__ src, int K, int N, bf16_t* __restrict__ dst, int kind, int kt, int nt, float* s) {
    const int tid = threadIdx.x, k0 = kt * 64, n0 = nt * 64;
    {
        const int nn = tid & 63, kq = tid >> 6, n = n0 + nn;
#pragma unroll
        for (int i = 0; i < 16; ++i) { const int kk = kq + 4 * i; s[kk * 65 + nn] = (n < N) ? src[(size_t)(k0 + kk) * N + n] : 0.f; }
    }
    __syncthreads();
    {
        const int rn = tid >> 2, kseg = (tid & 3) * 16, n = n0 + rn;
        if (n < N) {
            unsigned w[8];
#pragma unroll
            for (int i = 0; i < 8; ++i) w[i] = pk2(s[(kseg + 2 * i) * 65 + rn], s[(kseg + 2 * i + 1) * 65 + rn]);
            bf16_t* d = dst + (size_t)rowmap(kind, n) * K + k0 + kseg;
            *(uint4*)d = make_uint4(w[0], w[1], w[2], w[3]);
            *(uint4*)(d + 8) = make_uint4(w[4], w[5], w[6], w[7]);
        }
    }
    __syncthreads();
}
struct CF { float re, im; };
DI CF cmul(CF a, CF b) { return {a.re * b.re - a.im * b.im, a.re * b.im + a.im * b.re}; }
DI CF s5_apow(const Params& P, int g, int p, float tau) {
    const float step = expf(P.in[10][g]);
    const float lr = P.in[8][g * 64 + p], li = P.in[9][g * 64 + p];
    const float mag = expf(lr * step * tau);
    float sn, cs; sincosf(li * step * tau, &sn, &cs);
    return {mag * cs, mag * sn};
}
DI CF s5_f(const Params& P, int g, int p) {
    const CF a = s5_apow(P, g, p, 1.f);
    const float lr = P.in[8][g * 64 + p], li = P.in[9][g * 64 + p];
    const float den = lr * lr + li * li;
    return {((a.re - 1.f) * lr + a.im * li) / den, (a.im * lr - (a.re - 1.f) * li) / den};
}
DI void phase0(const Params& P, unsigned char* smem) {
    const int tid = threadIdx.x;
    unsigned char* ws = P.ws;
    float* sf = (float*)smem;
    constexpr int N_TR0 = 16 * 29, N_TR1 = 256, N_TR2 = 16 * 48, N_TR3 = 256, N_TR4 = 64, N_TR5 = 64, N_TR6 = 64, N_TR7 = 2, N_TR8 = 2;
    constexpr int N_TRG = 64 * 32, N_TRU = 64 * 32, N_TRD = 64 * 32;
    constexpr int N_X = NT * DM / 8192, N_ROPE = 512, N_CB = 16, N_AL = 8, N_BTE = 256, N_BTYM = 32 * 63, N_BTYQ = 4096, N_ZP = 13;
    constexpr int N_RW = 2 * 36864 / 256;
    constexpr int TOTAL = N_RW + N_TR0 + N_TR1 + N_TR4 + N_TR5 + N_TR6 + N_TR7 + N_TR8 + N_X + N_ROPE + N_CB + N_AL + N_BTE + N_BTYM + N_BTYQ + N_ZP;
    for (int it0 = blockIdx.x; it0 < TOTAL; it0 += gridDim.x) {
        int it = it0;
        if (it < N_RW) {
            const int e = it * 256 + tid, layer = e / 36864, r = e % 36864;
            float* dst = (float*)(ws + WS_RTRW) + (size_t)layer * 36864;
            if (r < 4096) { const int o = r & 3, l = (r >> 2) & 63, jk = r >> 8, d = 4 * l + 256 * (jk >> 2) + (jk & 3); dst[r] = P.in[25][((size_t)layer * 1024 + d) * 4 + o]; }
            else { const int q = r - 4096, o = q & 3, l = (q >> 2) & 63, hf = (q >> 8) & 1, jk = (q >> 9) & 15, g = q >> 13, d = 4 * l + 256 * (jk >> 2) + (jk & 3);
                   dst[r] = P.in[27][(((size_t)layer * 4 + g) * 1024 + d) * 8 + hf * 4 + o]; }
            continue;
        } it -= N_RW;
        if (it < N_TR0) { tr_tile(P.in[1], 1024, 1816, (bf16_t*)(ws + WS_WIN0), 1, it / 29, it % 29, sf); continue; } it -= N_TR0;
        if (it < N_TR1) { tr_tile(P.in[18], 1024, 1024, (bf16_t*)(ws + WS_WOUT0), 0, it / 16, it % 16, sf); continue; } it -= N_TR1;
        if (it < N_TR4) { tr_tile(P.in[16], 512, 512, (bf16_t*)(ws + WS_WGLU), 0, it / 8, it % 8, sf); continue; } it -= N_TR4;
        if (it < N_TR5) { tr_tile(P.in[4], 2048, 128, (bf16_t*)(ws + WS_WCK1), 0, it / 2, it % 2, sf); continue; } it -= N_TR5;
        if (it < N_TR6) { tr_tile(P.in[6], 2048, 128, (bf16_t*)(ws + WS_WCV1), 0, it / 2, it % 2, sf); continue; } it -= N_TR6;
        if (it < N_TR7) { tr_tile(P.in[5], 128, 64, (bf16_t*)(ws + WS_WCK2), 0, it, 0, sf); continue; } it -= N_TR7;
        if (it < N_TR8) { tr_tile(P.in[7], 128, 64, (bf16_t*)(ws + WS_WCV2), 0, it, 0, sf); continue; } it -= N_TR8;
        if (it < N_X) {
            const float* x = P.in[0]; bf16_t* xb = (bf16_t*)(ws + WS_ACTB);
#pragma unroll
            for (int i = 0; i < 4; ++i) {
                const size_t idx = (size_t)it * 8192 + i * 2048 + tid * 8;
                const f32x4 a = __builtin_nontemporal_load((const f32x4*)(x + idx)), b = __builtin_nontemporal_load((const f32x4*)(x + idx + 4));
                *(uint4*)(xb + idx) = make_uint4(pk2(a.x, a.y), pk2(a.z, a.w), pk2(b.x, b.y), pk2(b.z, b.w));
            }
            continue;
        } it -= N_X;
        if (it < N_ROPE) {
            const int e = it * 256 + tid, pos = e >> 5, i = e & 31;
            const float inv = 1.0f / powf(10000.0f, (float)(2 * i) / 64.0f);
            const float ang = (float)pos * inv;
            ((float*)(ws + WS_ROPE))[e] = (float)cos((double)ang);
            ((float*)(ws + WS_ROPE))[4096 * 32 + e] = (float)sin((double)ang);
            continue;
        } it -= N_ROPE;
        if (it < N_CB) {
            const int kv = it >> 3, j0 = (it & 7) * 16, j = j0 + (tid & 15), sl = tid >> 4;
            const float* pe = P.in[kv ? 3 : 2]; const float* w1 = P.in[kv ? 6 : 4];
            float a = 0.f;
            for (int i = sl * 128; i < sl * 128 + 128; ++i) a += pe[i] * w1[(size_t)i * 128 + j];
            sf[tid] = a; __syncthreads();
            if (tid < 16) { float t = 0.f; for (int q = 0; q < 16; ++q) t += sf[q * 16 + tid]; ((float*)(ws + WS_CBIAS))[kv * 128 + j0 + tid] = t; }
            __syncthreads();
            continue;
        } it -= N_CB;
        if (it < N_AL) {
            const int e = it * 256 + tid, g = e >> 6, p = e & 63;
            const CF a = s5_apow(P, g, p, 32.f);
            ((float*)(ws + WS_S5AL))[e * 2] = a.re; ((float*)(ws + WS_S5AL))[e * 2 + 1] = a.im;
            continue;
        } it -= N_AL;
        if (it < N_BTE) {
            const int e = it * 256 + tid, g = e >> 11, p = (e >> 5) & 63, r = e & 31;
            const CF w = cmul(s5_apow(P, g, p, (float)(31 - r)), s5_f(P, g, p));
            bf16_t* d = (bf16_t*)(ws + WS_BTE) + (size_t)g * 128 * 512;
#pragma unroll
            for (int c = 0; c < 16; ++c) {
                const CF bb = {P.in[11][(g * 64 + p) * 16 + c], P.in[12][(g * 64 + p) * 16 + c]};
                const CF v = cmul(w, bb);
                d[(size_t)p * 512 + r * 16 + c] = f2bf(v.re);
                d[(size_t)(64 + p) * 512 + r * 16 + c] = f2bf(v.im);
            }
            continue;
        } it -= N_BTE;
        if (it < N_BTYM) {
            const int g = it / 63, dd = it % 63 - 31, ch = tid >> 4, c = tid & 15;
            float val = 0.f;
            if (dd >= 0) {
                float* sw = sf; float* sb = sf + 128; float* sc = sf + 128 + 2048;
                if (tid < 64) { const CF w = cmul(s5_apow(P, g, tid, (float)dd), s5_f(P, g, tid)); sw[2 * tid] = w.re; sw[2 * tid + 1] = w.im; }
#pragma unroll
                for (int i = 0; i < 4; ++i) {
                    const int e = tid + 256 * i;
                    sb[2 * e] = P.in[11][(size_t)g * 1024 + e]; sb[2 * e + 1] = P.in[12][(size_t)g * 1024 + e];
                    sc[2 * e] = P.in[13][(size_t)g * 1024 + e]; sc[2 * e + 1] = P.in[14][(size_t)g * 1024 + e];
                }
                __syncthreads();
#pragma unroll 8
                for (int p = 0; p < 64; ++p) {
                    const CF bb = {sb[2 * (p * 16 + c)], sb[2 * (p * 16 + c) + 1]};
                    const CF cc = {sc[2 * (ch * 64 + p)], sc[2 * (ch * 64 + p) + 1]};
                    const CF w = {sw[2 * p], sw[2 * p + 1]};
                    val += cmul(cc, cmul(w, bb)).re;
                }
                __syncthreads();
            }
            bf16_t* d = (bf16_t*)(ws + WS_BTY) + (size_t)g * 512 * 640;
            const bf16_t hv = f2bf(val);
            for (int r = 0; r < 32; ++r) { const int s = r + dd; if (s >= 0 && s < 32) d[(size_t)(s * 16 + ch) * 640 + r * 16 + c] = hv; }
            continue;
        } it -= N_BTYM;
        if (it < N_BTYQ) {
            const int e = it * 256 + tid, g = e >> 15, s = (e >> 10) & 31, ch = (e >> 6) & 15, p = e & 63;
            const CF cc = {P.in[13][(g * 16 + ch) * 64 + p], P.in[14][(g * 16 + ch) * 64 + p]};
            const CF w = cmul(cc, s5_apow(P, g, p, (float)(s + 1)));
            bf16_t* d = (bf16_t*)(ws + WS_BTY) + ((size_t)g * 512 + s * 16 + ch) * 640 + 512;
            d[p] = f2bf(w.re); d[64 + p] = f2bf(-w.im);
            continue;
        } it -= N_BTYQ;
        {
            uint4* d = (uint4*)((bf16_t*)(ws + WS_WIN0) + (size_t)(1304 + it * 8) * 1024);
#pragma unroll
            for (int i = 0; i < 4; ++i) d[i * 256 + tid] = make_uint4(0, 0, 0, 0);
        }
    }
}

DI void phase_inproj0(const Params& P, unsigned char* smem) {
    unsigned char* ws = P.ws;
    const bf16_t* A = (const bf16_t*)(ws + WS_ACTB);
    const float* cosT = (const float*)(ws + WS_ROPE);
    const float* sinT = cosT + 4096 * 32;
    constexpr int NTN = NIN0 / 128;
    bool pre = false;
    for (int it = vblock(); it < (NT / 128) * NTN; it += gridDim.x) {
        int mt, nt; tile_mn(it, NTN, mt, nt);
        const int m0 = mt * 128;
        auto rowptr = [=](int r) { return A + (size_t)(m0 + r) * 1024; };
        const bf16_t* Bt = (const bf16_t*)(ws + WS_WIN0) + (size_t)nt * 128 * 1024;
        const bool hn = it + (int)gridDim.x < (NT / 128) * NTN;
        int mtn = 0, ntn = 0; if (hn) tile_mn(it + gridDim.x, NTN, mtn, ntn);
        auto nextrow = [=](int r) { return A + (size_t)(mtn * 128 + r) * 1024; };
        const bf16_t* nBt = (const bf16_t*)(ws + WS_WIN0) + (size_t)ntn * 128 * 1024;
        if (nt == 7 || nt == 9) {
            auto epi = [=](f32x4 (&acc)[4][4], int wr, int wc, int lane) {
                const int fr = lane & 15, fq = lane >> 4, which = nt == 7 ? 3 : 5, g = wc;
#pragma unroll
                for (int m = 0; m < 4; ++m) {
                    const int t = m0 + wr * 64 + m * 16 + fq * 4, s = t & 4095, b = t >> 12;
                    bf16_t* dst = (bf16_t*)(ws + XP_KC + (size_t)which * KVSZ) + (size_t)(b * 2 + g) * 4096 * 64;
#pragma unroll
                    for (int n = 0; n < 4; ++n) *(u32x2*)(dst + vp_off(s, n * 16 + fr)) = cvt4(acc[m][n]);
                }
            };
            gemm128s<false>(rowptr, Bt, 1024, 1024, smem, epi, pre, hn, nextrow, nBt);
            pre = hn;
            continue;
        }
        auto epi = [=](f32x4 (&acc)[4][4], int wr, int wc, int lane) {
            const int u64 = nt * 2 + wc, fr = lane & 15, fq = lane >> 4;
#pragma unroll
            for (int m = 0; m < 4; ++m) {
                const int t = m0 + wr * 64 + m * 16 + fr, s = t & 4095, b = t >> 12;
                if (u64 < 20) {
                    const bool isq = u64 < 8;
                    const int which = (u64 - 8) >> 1, g = (u64 - 8) & 1;
                    if (isq || ((which & 1) == 0)) {
#pragma unroll
                        for (int n2 = 0; n2 < 2; ++n2) {
                            const int i = n2 * 16 + fq * 4;
                            const f32x4 c = *(const f32x4*)(cosT + s * 32 + i), sn = *(const f32x4*)(sinT + s * 32 + i);
                            const f32x4 x1 = acc[m][2 * n2], x2 = acc[m][2 * n2 + 1];
                            const u32x2 o1 = cvt4(x1 * c - x2 * sn), o2 = cvt4(x1 * sn + x2 * c);
                            if (isq) { bf16_t* dst = (bf16_t*)(ws + XP_Q0) + (size_t)t * 512 + u64 * 64; *(u32x2*)(dst + i) = o1; *(u32x2*)(dst + i + 32) = o2; }
                            else {
                                bf16_t* dst = (bf16_t*)(ws + XP_KC + (size_t)which * KVSZ) + (size_t)(b * 2 + g) * 4096 * 64;
                                if (which == 0) { *(u32x2*)(dst + (size_t)s * 64 + i) = o1; *(u32x2*)(dst + (size_t)s * 64 + i + 32) = o2; }
                                else { *(u32x2*)(dst + kp_off(s, i)) = o1; *(u32x2*)(dst + kp_off(s, i + 32)) = o2; }
                            }
                        }
                    } else {
                        bf16_t* dst = (bf16_t*)(ws + XP_KC + (size_t)which * KVSZ) + ((size_t)(b * 2 + g) * 4096 + s) * 64;
#pragma unroll
                        for (int n = 0; n < 4; ++n) *(u32x2*)(dst + n * 16 + fq * 4) = cvt4(acc[m][n]);
                    }
                } else if (u64 == 20) {
#pragma unroll
                    for (int n = 0; n < 2; ++n) {
                        const int c0 = n * 16 + fq * 4;
                        if (c0 < 24) { f32x4 o; o.x = sigmoidf_(acc[m][n].x); o.y = sigmoidf_(acc[m][n].y); o.z = sigmoidf_(acc[m][n].z); o.w = sigmoidf_(acc[m][n].w); *(f32x4*)((float*)(ws + XP_GATES) + (size_t)t * 24 + c0) = o; }
                    }
                } else if (u64 >= 22) {
#pragma unroll
                    for (int n = 0; n < 4; ++n) {
                        const int g5 = (u64 - 22) * 4 + n;
                        *(u32x2*)((bf16_t*)(ws + XP_AEXT) + ((size_t)g5 * 1024 + (t >> 5)) * 640 + (t & 31) * 16 + fq * 4) = cvt4(acc[m][n]);
                    }
                }
            }
        };
        gemm128s(rowptr, Bt, 1024, 1024, smem, epi, pre, hn, nextrow, nBt);
        pre = hn;
    }
}

constexpr int N_LATE = 16 * 48 + 256 + 3 * 64 * 32;
DI void late_weights(const Params& P, unsigned char* smem, int it) {
    unsigned char* ws = P.ws;
    float* sf = (float*)smem;
    constexpr int N_TR2 = 16 * 48, N_TR3 = 256, N_TRG = 64 * 32, N_TRU = 64 * 32;
    if (it < N_TR2) { tr_tile(P.in[19], 1024, 3072, (bf16_t*)(ws + WS_WIN1), 4, it / 48, it % 48, sf); return; } it -= N_TR2;
    if (it < N_TR3) { tr_tile(P.in[20], 1024, 1024, (bf16_t*)(ws + WS_WOUT1), 0, it / 16, it % 16, sf); return; } it -= N_TR3;
    if (it < N_TRG) { const int mat = it >> 5, r = it & 31; tr_tile(P.in[29] + (size_t)mat * 1024 * 128, 1024, 128, (bf16_t*)(ws + WS_WGU) + (size_t)mat * 256 * 1024, 2, r >> 1, r & 1, sf); return; } it -= N_TRG;
    if (it < N_TRU) { const int mat = it >> 5, r = it & 31; tr_tile(P.in[30] + (size_t)mat * 1024 * 128, 1024, 128, (bf16_t*)(ws + WS_WGU) + (size_t)mat * 256 * 1024, 3, r >> 1, r & 1, sf); return; } it -= N_TRU;
    { const int mat = it >> 5, r = it & 31; tr_tile(P.in[31] + (size_t)mat * 128 * 1024, 128, 1024, (bf16_t*)(ws + WS_WDN) + (size_t)mat * 1024 * 128, 0, r >> 4, r & 15, sf); }
}

DI void s5y_tile(const Params& P, unsigned char* smem, int g, int mt, int nt);
DI void phase_cmp_s5e(const Params& P, unsigned char* smem) {
    unsigned char* ws = P.ws;
    const int tid = threadIdx.x, lane = tid & 63, wave = tid >> 6;
    for (int it = blockIdx.x; it < 64 + 256 + N_LATE; it += gridDim.x) {
        if (it >= 64 + 256) { late_weights(P, smem, it - 320); continue; }
        if (it < 64) {
            const int kv = it >> 5, bg = (it >> 1) & 15, mt = it & 1;
            const bf16_t* src = (const bf16_t*)(ws + XP_KC + (size_t)kv * KVSZ) + (size_t)bg * 4096 * 64;
            const float* cb = (const float*)(ws + WS_CBIAS) + kv * 128;
            bf16_t* sH = (bf16_t*)smem;
            auto rowptr = [=](int r) { int rr = mt * 128 + r; rr = rr > 254 ? 254 : rr; return src + (size_t)rr * 1024; };
            auto epi = [=](f32x4 (&acc)[4][4], int wr, int wc, int ln) {
                const int fr = ln & 15, fq = ln >> 4;
#pragma unroll
                for (int m = 0; m < 4; ++m)
#pragma unroll
                    for (int n = 0; n < 4; ++n)
#pragma unroll
                        for (int j = 0; j < 4; ++j) {
                            const int r = wr * 64 + m * 16 + fr, c = wc * 64 + n * 16 + fq * 4 + j;
                            sH[r * 136 + c] = f2bf(gelu_tanh(acc[m][n][j] + cb[c]));
                        }
            };
            gemm128(rowptr, (const bf16_t*)(ws + (kv ? WS_WCV1 : WS_WCK1)), 2048, 2048, smem, epi);
            __syncthreads();
            const bf16_t* W2 = (const bf16_t*)(ws + (kv ? WS_WCV2 : WS_WCK2));
            f32x4 a2[2][4];
#pragma unroll
            for (int m = 0; m < 2; ++m)
#pragma unroll
                for (int n = 0; n < 4; ++n) a2[m][n] = (f32x4){0.f, 0.f, 0.f, 0.f};
#pragma unroll
            for (int ks = 0; ks < 4; ++ks) {
                bf16x8 af[2], bfr[4];
#pragma unroll
                for (int m = 0; m < 2; ++m) af[m] = *(const bf16x8*)(sH + (wave * 32 + m * 16 + (lane & 15)) * 136 + ks * 32 + (lane >> 4) * 8);
#pragma unroll
                for (int n = 0; n < 4; ++n) bfr[n] = *(const bf16x8*)(W2 + (n * 16 + (lane & 15)) * 128 + ks * 32 + (lane >> 4) * 8);
#pragma unroll
                for (int m = 0; m < 2; ++m)
#pragma unroll
                    for (int n = 0; n < 4; ++n) a2[m][n] = __builtin_amdgcn_mfma_f32_16x16x32_bf16(af[m], bfr[n], a2[m][n], 0, 0, 0);
            }
            bf16_t* dst = (bf16_t*)(ws + (kv ? WS_VCMP : WS_KCMP)) + (size_t)bg * 256 * 64;
#pragma unroll
            for (int m = 0; m < 2; ++m)
#pragma unroll
                for (int n = 0; n < 4; ++n)
#pragma unroll
                    for (int j = 0; j < 4; ++j) {
                        const int row = mt * 128 + wave * 32 + m * 16 + (lane >> 4) * 4 + j, col = n * 16 + (lane & 15);
                        dst[kv ? vp_off(row, col) : kp_off(row, col)] = row < 255 ? f2bf(a2[m][n][j]) : (bf16_t)0;
                    }
            __syncthreads();
        } else {
            const int it2 = it - 64, g = it2 >> 3, b = it2 & 7;
            bf16_t* aext = (bf16_t*)(ws + XP_AEXT) + ((size_t)g * 1024 + b * 128) * 640;
            float* sE = (float*)smem;
            auto rowptr = [=](int r) { return (const bf16_t*)aext + (size_t)r * 640; };
            auto epi = [=](f32x4 (&acc)[4][4], int wr, int wc, int ln) {
                const int fr = ln & 15, fq = ln >> 4;
#pragma unroll
                for (int m = 0; m < 4; ++m)
#pragma unroll
                    for (int n = 0; n < 4; ++n)
#pragma unroll
                        for (int j = 0; j < 4; ++j) sE[(wr * 64 + m * 16 + fr) * 129 + wc * 64 + n * 16 + fq * 4 + j] = acc[m][n][j];
            };
            gemm128(rowptr, (const bf16_t*)(ws + WS_BTE) + (size_t)g * 128 * 512, 512, 512, smem, epi);
            __syncthreads();
            {
                const int p = tid & 63, c0 = wave * 32;
                const float ar = ((const float*)(ws + WS_S5AL))[(g * 64 + p) * 2], ai = ((const float*)(ws + WS_S5AL))[(g * 64 + p) * 2 + 1];
                float* send = (float*)(smem + 128 * 129 * 4);
                float xr = 0.f, xi = 0.f;
                for (int c = c0; c < c0 + 32; ++c) {
                    const float er = sE[c * 129 + p], ei = sE[c * 129 + 64 + p];
                    const float nr = ar * xr - ai * xi + er, ni = ar * xi + ai * xr + ei;
                    xr = nr; xi = ni;
                }
                send[(wave * 64 + p) * 2] = xr; send[(wave * 64 + p) * 2 + 1] = xi;
                float qr = ar, qi = ai;
#pragma unroll
                for (int k = 0; k < 5; ++k) { const float tr = qr * qr - qi * qi, ti = 2.f * qr * qi; qr = tr; qi = ti; }
                __syncthreads();
                xr = 0.f; xi = 0.f;
                for (int k = 0; k < wave; ++k) {
                    const float er = send[(k * 64 + p) * 2], ei = send[(k * 64 + p) * 2 + 1];
                    const float nr = qr * xr - qi * xi + er, ni = qr * xi + qi * xr + ei;
                    xr = nr; xi = ni;
                }
                for (int c = c0; c < c0 + 32; ++c) {
                    aext[(size_t)c * 640 + 512 + p] = f2bf(xr);
                    aext[(size_t)c * 640 + 576 + p] = f2bf(xi);
                    const float er = sE[c * 129 + p], ei = sE[c * 129 + 64 + p];
                    const float nr = ar * xr - ai * xi + er, ni = ar * xi + ai * xr + ei;
                    xr = nr; xi = ni;
                }
            }
            asm volatile("s_waitcnt vmcnt(0)" ::: "memory");
            __syncthreads();
#pragma unroll 1
            for (int nt = 0; nt < 4; ++nt) s5y_tile(P, smem, g, b, nt);
        }
    }
}

DI void s5y_tile(const Params& P, unsigned char* smem, int g, int mt, int nt) {
    unsigned char* ws = P.ws;
    const bf16_t* aext = (const bf16_t*)(ws + XP_AEXT) + (size_t)g * 1024 * 640;
    const float* dsk = P.in[15];
    auto rowptr = [=](int r) { return aext + (size_t)(mt * 128 + r) * 640; };
    auto epi = [=](f32x4 (&acc)[4][4], int wr, int wc, int ln) {
        const int fr = ln & 15, fq = ln >> 4;
        const f32x4 dk = *(const f32x4*)(dsk + g * 16 + fq * 4);
#pragma unroll
        for (int m = 0; m < 4; ++m) {
            const int cr = mt * 128 + wr * 64 + m * 16 + fr;
#pragma unroll
            for (int n = 0; n < 4; ++n) {
                const int sp = nt * 8 + wc * 4 + n, t = cr * 32 + sp;
                const f32x4 u = bf4_to_f(*(const u32x2*)(aext + (size_t)cr * 640 + sp * 16 + fq * 4));
                const f32x4 y = acc[m][n] + dk * u;
                *(u32x2*)((bf16_t*)(ws + XP_G5) + (size_t)t * 512 + g * 16 + fq * 4) = cvt4((f32x4){gelu_tanh(y.x), gelu_tanh(y.y), gelu_tanh(y.z), gelu_tanh(y.w)});
            }
        }
    };
    gemm128(rowptr, (const bf16_t*)(ws + WS_BTY) + ((size_t)g * 512 + nt * 128) * 640, 640, 640, smem, epi, 2 * nt + 2, 8);
}
struct FA { f32x16 o0, o1; float m, l; };
DI void fa_init(FA& st) {
#pragma unroll
    for (int i = 0; i < 16; ++i) { st.o0[i] = 0.f; st.o1[i] = 0.f; }
    st.m = -1e30f; st.l = 0.f;
}
constexpr float FA_THR = 8.f;
template <int MODE, class Valid>
DI void fa_tile(FA& st, const bf16x8 (&qf)[4], const LAS bf16_t* Kt, const LAS bf16_t* Vt, int r, int h, float c, bool rowok, Valid valid) {
    const LAS bf16_t* kb = Kt + r * 16 + 8 * h;
    const LAS bf16_t* vb = Vt + r * 16 + 8 * h;
    bf16x8 kf[4], vf[4];
#pragma unroll
    for (int ks = 0; ks < 4; ++ks) kf[ks] = *(const LAS bf16x8*)(kb + ks * 512);
#pragma unroll
    for (int sub = 0; sub < 2; ++sub) {
        f32x16 acc;
#pragma unroll
        for (int i = 0; i < 16; ++i) acc[i] = 0.f;
#pragma unroll
        for (int ks = 0; ks < 4; ++ks) acc = MFMA32(kf[ks], qf[ks], acc);
#pragma unroll
        for (int s2 = 0; s2 < 2; ++s2) { vf[2 * s2] = *(const LAS bf16x8*)(vb + ((sub * 2 + s2) * 64) * 16); vf[2 * s2 + 1] = *(const LAS bf16x8*)(vb + ((sub * 2 + s2) * 64 + 32) * 16); }
        if (sub == 0) {
#pragma unroll
            for (int ks = 0; ks < 4; ++ks) kf[ks] = *(const LAS bf16x8*)(kb + (4 + ks) * 512);
        }
        __builtin_amdgcn_sched_barrier(0);
        float mx = -INFINITY;
#pragma unroll
        for (int i = 0; i < 16; ++i) {
            if (MODE == 2) { const int koff = sub * 32 + (i & 3) + 8 * (i >> 2) + 4 * h; acc[i] = valid(koff) ? acc[i] : -INFINITY; }
            mx = fmaxf(mx, acc[i]);
        }
        {
            const auto sw = __builtin_amdgcn_permlane32_swap(__float_as_uint(mx), __float_as_uint(mx), false, false);
            mx = fmaxf(__uint_as_float(sw[0]), __uint_as_float(sw[1]));
        }
        const float cand = mx * c;
        const bool upd = cand > st.m + FA_THR;
        if (__ballot(upd)) {
            const float mn = upd ? cand : st.m, alpha = __builtin_amdgcn_exp2f(st.m - mn);
            st.m = mn; st.l *= alpha;
#pragma unroll
            for (int i = 0; i < 16; ++i) { st.o0[i] *= alpha; st.o1[i] *= alpha; }
        }
        const float nb = (MODE == 1 && !rowok) ? -INFINITY : -st.m;
        float ps0 = 0.f, ps1 = 0.f;
#pragma unroll
        for (int i = 0; i < 16; i += 2) {
            acc[i] = __builtin_amdgcn_exp2f(__builtin_fmaf(acc[i], c, nb));
            acc[i + 1] = __builtin_amdgcn_exp2f(__builtin_fmaf(acc[i + 1], c, nb));
            ps0 += acc[i]; ps1 += acc[i + 1];
        }
        st.l += ps0 + ps1;
#pragma unroll
        for (int s2 = 0; s2 < 2; ++s2) {
            const bf16x8 pk = cvt8((f32x8){acc[8 * s2], acc[8 * s2 + 1], acc[8 * s2 + 2], acc[8 * s2 + 3], acc[8 * s2 + 4], acc[8 * s2 + 5], acc[8 * s2 + 6], acc[8 * s2 + 7]});
            st.o0 = MFMA32(vf[2 * s2], pk, st.o0);
            st.o1 = MFMA32(vf[2 * s2 + 1], pk, st.o1);
        }
    }
}
DI void fa_issue(const bf16_t* gK, const bf16_t* gV, LAS unsigned char* buf, int tid) {
    __builtin_amdgcn_global_load_lds((const unsigned*)(gK + tid * 8), (LAS unsigned*)(buf + tid * 16), 16, 0, 0);
    __builtin_amdgcn_global_load_lds((const unsigned*)(gK + (tid + 256) * 8), (LAS unsigned*)(buf + (tid + 256) * 16), 16, 0, 0);
    __builtin_amdgcn_global_load_lds((const unsigned*)(gV + tid * 8), (LAS unsigned*)(buf + 8192 + tid * 16), 16, 0, 0);
    __builtin_amdgcn_global_load_lds((const unsigned*)(gV + (tid + 256) * 8), (LAS unsigned*)(buf + 8192 + (tid + 256) * 16), 16, 0, 0);
}
DI void fa_wait(int j, int n) {
    const int rem = n - 1 - j;
    if (rem >= 2) asm volatile("s_waitcnt vmcnt(8)" ::: "memory");
    else if (rem == 1) asm volatile("s_waitcnt vmcnt(4)" ::: "memory");
    else asm volatile("s_waitcnt vmcnt(0)" ::: "memory");
    __builtin_amdgcn_s_barrier();
    asm volatile("" ::: "memory");
}

constexpr int NSA_LDS_IMP = 65536;
constexpr int NSA_LDS_SCS = NSA_LDS_IMP + 8192;
constexpr int NSA_LDS_MSK = NSA_LDS_SCS + 1024;
DI void phase_nsa(const Params& P, unsigned char* smem) {
    unsigned char* ws = P.ws;
    const int tid = threadIdx.x, lane = tid & 63, wave = tid >> 6, r = lane & 31, h = lane >> 5;
    const float c = 0.125f * 1.4426950408889634f;
    LAS unsigned char* lds = (LAS unsigned char*)smem;
    float* impw = (float*)(smem + NSA_LDS_IMP) + wave * 512;
    float* scs = (float*)(smem + NSA_LDS_SCS) + wave * 64;
    unsigned long long* mskw = (unsigned long long*)(smem + NSA_LDS_MSK) + wave * 8;
    for (int it = blockIdx.x; it < 2048; it += gridDim.x) {
        const int qt = 127 - (it >> 4), bg = it & 15, b = bg >> 1, g = bg & 1, t0 = qt * 32, qblk = t0 >> 6;
        const int ql = r >> 2, z = r & 3, s = t0 + wave * 8 + ql, t = b * 4096 + s;
        const bf16_t* Qg = (const bf16_t*)(ws + XP_Q0) + (size_t)t * 512 + (g * 4 + z) * 64;
        bf16x8 qf[4];
#pragma unroll
        for (int ks = 0; ks < 4; ++ks) qf[ks] = *(const bf16x8*)(Qg + ks * 16 + 8 * h);
        const float* gt = (const float*)(ws + XP_GATES) + (size_t)t * 24 + (g * 4 + z) * 3;
        const float g_c = gt[0], g_s = gt[1], g_w = gt[2];
        const bf16_t* Kc = (const bf16_t*)(ws + WS_KCMP) + (size_t)bg * 256 * 64;
        const bf16_t* Vc = (const bf16_t*)(ws + WS_VCMP) + (size_t)bg * 256 * 64;
        const bf16_t* Ks = (const bf16_t*)(ws + XP_KC + 2 * KVSZ) + (size_t)bg * 4096 * 64;
        const bf16_t* Vs = (const bf16_t*)(ws + XP_KC + 3 * KVSZ) + (size_t)bg * 4096 * 64;
        const bf16_t* Kw = (const bf16_t*)(ws + XP_KC + 4 * KVSZ) + (size_t)bg * 4096 * 64;
        const bf16_t* Vw = (const bf16_t*)(ws + XP_KC + 5 * KVSZ) + (size_t)bg * 4096 * 64;
        const int nct = ((t0 >> 4) + 1 + 63) >> 6;
        const int w0 = (t0 - 255) < 0 ? 0 : (t0 - 255) >> 6;
        const int e1 = nct, e2 = 2 * nct, e3 = e2 + qblk + 1, e4 = e3 + (qblk - w0 + 1);
        const int nc = s >= 31 ? ((s - 31) >> 4) + 1 : 0;
        const int s_lo = t0 + wave * 8, s_hi = s_lo + 7, nc_min = s_lo >= 31 ? ((s_lo - 31) >> 4) + 1 : 0;
        for (int i = lane; i < 512; i += 64) impw[i] = 0.f;
        auto tile_ptrs = [&](int i, const bf16_t*& gk, const bf16_t*& gv) {
            if (i < e1) { gk = Kc + (size_t)i * 4096; gv = Vc + (size_t)i * 4096; }
            else if (i < e2) { gk = Kc + (size_t)(i - e1) * 4096; gv = Vc + (size_t)(i - e1) * 4096; }
            else if (i < e3) { gk = Ks + (size_t)(i - e2) * 4096; gv = Vs + (size_t)(i - e2) * 4096; }
            else { gk = Kw + (size_t)(w0 + i - e3) * 4096; gv = Vw + (size_t)(w0 + i - e3) * 4096; }
        };
        FA st; fa_init(st);
        f32x16 out0, out1;
#pragma unroll
        for (int i = 0; i < 16; ++i) { out0[i] = 0.f; out1[i] = 0.f; }
        float m_c = -1e30f, il_c = 0.f;
        unsigned long long mymask = 0ull;
        asm volatile("s_waitcnt vmcnt(0)" ::: "memory");
        __builtin_amdgcn_s_barrier();
#pragma unroll
        for (int i = 0; i < 3; ++i) if (i < e4) { const bf16_t *gk, *gv; tile_ptrs(i, gk, gv); fa_issue(gk, gv, lds + i * 16384, tid); }
        for (int i = 0; i < e4; ++i) {
            fa_wait(i, e4);
            if (i + 3 < e4) { const bf16_t *gk, *gv; tile_ptrs(i + 3, gk, gv); fa_issue(gk, gv, lds + ((i + 3) & 3) * 16384, tid); }
            const LAS bf16_t* cur = (const LAS bf16_t*)(lds + (i & 3) * 16384);
            if (i < e1) {
                const int nb = i * 64;
                { if (nb + 63 < nc_min) fa_tile<0>(st, qf, cur, cur + 4096, r, h, c, true, [=](int) { return true; }); else fa_tile<2>(st, qf, cur, cur + 4096, r, h, c, true, [=](int koff) { return nb + koff < nc; }); }
                if (i == e1 - 1) {
                    const float l = st.l + __shfl_xor(st.l, 32);
                    il_c = 1.f / fmaxf(l, 1e-30f); m_c = st.m;
                    const float f = g_c * il_c;
#pragma unroll
                    for (int k = 0; k < 16; ++k) { out0[k] = st.o0[k] * f; out1[k] = st.o1[k] * f; }
                    fa_init(st);
                }
            } else if (i < e2) {
                const int nb = (i - e1) * 64;
#pragma unroll
                for (int sub = 0; sub < 2; ++sub) {
                    f32x16 acc;
#pragma unroll
                    for (int k = 0; k < 16; ++k) acc[k] = 0.f;
#pragma unroll
                    for (int ks = 0; ks < 4; ++ks) acc = MFMA32(*(const LAS bf16x8*)(cur + ((sub * 4 + ks) * 32 + r) * 16 + 8 * h), qf[ks], acc);
#pragma unroll
                    for (int q4 = 0; q4 < 4; ++q4) {
                        float p[4];
#pragma unroll
                        for (int k = 0; k < 4; ++k) {
                            const int n = nb + sub * 32 + 8 * q4 + 4 * h + k;
                            p[k] = (n < nc) ? __builtin_amdgcn_exp2f(acc[4 * q4 + k] * c - m_c) * il_c : 0.f;
                        }
                        float a = (p[0] + p[1]) + (p[2] + 0.5f * p[3]), cn = 0.5f * p[3];
                        a += __shfl_xor(a, 1); a += __shfl_xor(a, 2);
                        cn += __shfl_xor(cn, 1); cn += __shfl_xor(cn, 2);
                        const int jb = ((nb + sub * 32) >> 2) + 2 * q4 + h;
                        if (z == 0) { atomicAdd(&impw[ql * 64 + jb], a); if (jb + 1 < 64) atomicAdd(&impw[ql * 64 + jb + 1], cn); }
                    }
                }
                if (i == e2 - 1) {
                    __builtin_amdgcn_wave_barrier();
#pragma unroll 1
                    for (int qq = 0; qq < 8; ++qq) {
                        const int j = lane;
                        const float imp = impw[qq * 64 + j];
                        const float score = (j > qblk) ? -1.f : ((j == 0 || j == qblk || j == qblk - 1) ? 1e3f : imp);
                        scs[j] = score;
                        __builtin_amdgcn_wave_barrier();
                        int rank = 0;
#pragma unroll 8
                        for (int jj = 0; jj < 64; ++jj) { const float o = scs[jj]; rank += (o > score || (o == score && jj < j)) ? 1 : 0; }
                        const unsigned long long mk = __ballot(rank < 8 && score >= 0.f);
                        if (lane == 0) mskw[qq] = mk;
                        __builtin_amdgcn_wave_barrier();
                    }
                    mymask = mskw[ql];
                }
            } else if (i < e3) {
                const int j = i - e2;
                const bool sel = (mymask >> j) & 1ull;
                if (__ballot(sel)) {
                    if (j < qblk) fa_tile<1>(st, qf, cur, cur + 4096, r, h, c, sel, [=](int) { return true; });
                    else { const int kb = j * 64; fa_tile<2>(st, qf, cur, cur + 4096, r, h, c, true, [=](int koff) { return sel && (kb + koff <= s); }); }
                }
                if (i == e3 - 1) {
                    const float l = st.l + __shfl_xor(st.l, 32);
                    const float f = g_s / fmaxf(l, 1e-30f);
#pragma unroll
                    for (int k = 0; k < 16; ++k) { out0[k] += st.o0[k] * f; out1[k] += st.o1[k] * f; }
                    fa_init(st);
                }
            } else {
                const int kb = (w0 + i - e3) * 64;
                { if (kb >= s_hi - 255 && kb + 63 <= s_lo) fa_tile<0>(st, qf, cur, cur + 4096, r, h, c, true, [=](int) { return true; }); else fa_tile<2>(st, qf, cur, cur + 4096, r, h, c, true, [=](int koff) { const int key = kb + koff; return key <= s && key >= s - 255; }); }
            }
        }
        {
            const float l = st.l + __shfl_xor(st.l, 32);
            const float f = g_w / fmaxf(l, 1e-30f);
#pragma unroll
            for (int k = 0; k < 16; ++k) { out0[k] += st.o0[k] * f; out1[k] += st.o1[k] * f; }
        }
        bf16_t* o = (bf16_t*)(ws + WS_MIX) + (size_t)t * 1024 + (g * 4 + z) * 64;
#pragma unroll
        for (int g4 = 0; g4 < 4; ++g4) {
            *(u32x2*)(o + 8 * g4 + 4 * h) = cvt4((f32x4){out0[4 * g4], out0[4 * g4 + 1], out0[4 * g4 + 2], out0[4 * g4 + 3]});
            *(u32x2*)(o + 32 + 8 * g4 + 4 * h) = cvt4((f32x4){out1[4 * g4], out1[4 * g4 + 1], out1[4 * g4 + 2], out1[4 * g4 + 3]});
        }
    }
}

DI void phase_glu(const Params& P, unsigned char* smem) {
    unsigned char* ws = P.ws;
    const bf16_t* G5 = (const bf16_t*)(ws + XP_G5);
    const float* gb = P.in[17];
    bool pre = false;
    for (int it = vblock(); it < (NT / 128) * 4; it += gridDim.x) {
        int mt, nt; tile_mn(it, 4, mt, nt);
        const int m0 = mt * 128;
        const bool hn = it + (int)gridDim.x < (NT / 128) * 4;
        int mtn = 0, ntn = 0; if (hn) tile_mn(it + gridDim.x, 4, mtn, ntn);
        auto nextrow = [=](int r) { return G5 + (size_t)(mtn * 128 + r) * 512; };
        auto rowptr = [=](int r) { return G5 + (size_t)(m0 + r) * 512; };
        auto epi = [=](f32x4 (&acc)[4][4], int wr, int wc, int ln) {
            const int fr = ln & 15, fq = ln >> 4;
#pragma unroll
            for (int m = 0; m < 4; ++m) {
                const int row = m0 + wr * 64 + m * 16 + fr;
#pragma unroll
                for (int n = 0; n < 4; ++n) {
                    const int col = nt * 128 + wc * 64 + n * 16 + fq * 4;
                    const f32x4 gv = bf4_to_f(*(const u32x2*)(G5 + (size_t)row * 512 + col)), bb = *(const f32x4*)(gb + col), z = acc[m][n] + bb;
                    *(u32x2*)((bf16_t*)(ws + WS_MIX) + (size_t)row * 1024 + 512 + col) = cvt4((f32x4){gv.x * sigmoidf_(z.x), gv.y * sigmoidf_(z.y), gv.z * sigmoidf_(z.z), gv.w * sigmoidf_(z.w)});
                }
            }
        };
        gemm128s(rowptr, (const bf16_t*)(ws + WS_WGLU) + (size_t)nt * 128 * 512, 512, 512, smem, epi, pre, hn, nextrow, (const bf16_t*)(ws + WS_WGLU) + (size_t)ntn * 128 * 512);
        pre = hn;
    }
}

DI void phase_outproj(const Params& P, unsigned char* smem, const float* xres, size_t wt_off) {
    unsigned char* ws = P.ws;
    const bf16_t* A = (const bf16_t*)(ws + WS_MIX);
    float* out = P.out;
    bool pre = false;
    for (int it = vblock(); it < (NT / 128) * 8; it += gridDim.x) {
        int mt, nt; tile_mn(it, 8, mt, nt);
        const int m0 = mt * 128;
        const bool hn = it + (int)gridDim.x < (NT / 128) * 8;
        int mtn = 0, ntn = 0; if (hn) tile_mn(it + gridDim.x, 8, mtn, ntn);
        auto nextrow = [=](int r) { return A + (size_t)(mtn * 128 + r) * 1024; };
        auto rowptr = [=](int r) { return A + (size_t)(m0 + r) * 1024; };
        auto epi = [=](f32x4 (&acc)[4][4], int wr, int wc, int ln) {
            const int fr = ln & 15, fq = ln >> 4;
#pragma unroll
            for (int m = 0; m < 4; ++m) {
                const size_t base = (size_t)(m0 + wr * 64 + m * 16 + fr) * 1024 + nt * 128 + wc * 64 + fq * 4;
                f32x4 xr[4];
#pragma unroll
                for (int n = 0; n < 4; ++n) xr[n] = *(const f32x4*)(xres + base + n * 16);
#pragma unroll
                for (int n = 0; n < 4; ++n) *(f32x4*)(out + base + n * 16) = xr[n] * ALPHA + acc[m][n];
            }
        };
        gemm128s(rowptr, (const bf16_t*)(ws + wt_off) + (size_t)nt * 128 * 1024, 1024, 1024, smem, epi, pre, hn, nextrow, (const bf16_t*)(ws + wt_off) + (size_t)ntn * 128 * 1024);
        pre = hn;
    }
}

DI void ln_row(float (&v)[16], const float* __restrict__ g, const float* __restrict__ bta, int lane) {
    float s = 0.f;
#pragma unroll
    for (int i = 0; i < 16; ++i) s += v[i];
    const float mu = wave_sum(s) * (1.f / 1024.f);
    float q = 0.f;
#pragma unroll
    for (int i = 0; i < 16; ++i) { v[i] -= mu; q += v[i] * v[i]; }
    const float rstd = rsqrtf(wave_sum(q) * (1.f / 1024.f) + LN_EPS);
#pragma unroll
    for (int j = 0; j < 4; ++j) {
        const float4 gg = *(const float4*)(g + 4 * lane + 256 * j), bb = *(const float4*)(bta + 4 * lane + 256 * j);
        v[4 * j + 0] = v[4 * j + 0] * rstd * gg.x + bb.x; v[4 * j + 1] = v[4 * j + 1] * rstd * gg.y + bb.y;
        v[4 * j + 2] = v[4 * j + 2] * rstd * gg.z + bb.z; v[4 * j + 3] = v[4 * j + 3] * rstd * gg.w + bb.w;
    }
}

DI void phase_ln_router(const Params& P, int layer) {
    unsigned char* ws = P.ws;
    const int lane = threadIdx.x & 63, wave = threadIdx.x >> 6;
    const float* g = P.in[21] + layer * 1024; const float* bta = P.in[22] + layer * 1024;
    const float* wc = (const float*)(ws + WS_RTRW) + (size_t)layer * 36864; const float* bc = P.in[26] + layer * 4;
    const float* wf = wc + 4096; const float* bfn = P.in[28] + layer * 32;
    int* cnt = (int*)(ws + WS_CTL) + layer * 2048;
    int* list = (int*)(ws + WS_LIST2);
    float* wgt = (float*)(ws + WS_WGT);
    bf16_t* xb = (bf16_t*)(ws + WS_ACTB);
    for (int task = blockIdx.x * 4 + wave; task < NT / 16; task += gridDim.x * 4) {
        int my_e = 0; float my_w = 0.f;
        f32x4 wcr[16];
#pragma unroll
        for (int q = 0; q < 16; ++q) wcr[q] = *(const f32x4*)(wc + (q * 64 + lane) * 4);
        f32x4 nx[4];
#pragma unroll
        for (int j = 0; j < 4; ++j) nx[j] = __builtin_nontemporal_load((const f32x4*)(P.out + (size_t)(task * 16) * 1024 + 4 * lane + 256 * j));
#pragma unroll 1
        for (int i = 0; i < 16; ++i) {
            const int t = task * 16 + i;
            float v[16];
#pragma unroll
            for (int j = 0; j < 4; ++j) { v[4 * j] = nx[j].x; v[4 * j + 1] = nx[j].y; v[4 * j + 2] = nx[j].z; v[4 * j + 3] = nx[j].w; }
            if (i + 1 < 16) {
#pragma unroll
                for (int j = 0; j < 4; ++j) nx[j] = __builtin_nontemporal_load((const f32x4*)(P.out + (size_t)(t + 1) * 1024 + 4 * lane + 256 * j));
            }
            ln_row(v, g, bta, lane);
#pragma unroll
            for (int j = 0; j < 4; ++j) {
                *(u32x2*)(xb + (size_t)t * 1024 + 4 * lane + 256 * j) = cvt4((f32x4){v[4 * j], v[4 * j + 1], v[4 * j + 2], v[4 * j + 3]});
            }
            float lc[4] = {0.f, 0.f, 0.f, 0.f};
#pragma unroll
            for (int j = 0; j < 4; ++j)
#pragma unroll
                for (int k = 0; k < 4; ++k) {
                    const f32x4 w = wcr[j * 4 + k];
                    const float x = v[4 * j + k];
                    lc[0] += x * w.x; lc[1] += x * w.y; lc[2] += x * w.z; lc[3] += x * w.w;
                }
#pragma unroll
            for (int c = 0; c < 4; ++c) lc[c] = wave_sum(lc[c]) + bc[c];
            int gi = 0; float lm = lc[0];
#pragma unroll
            for (int c = 1; c < 4; ++c) if (lc[c] > lm) { lm = lc[c]; gi = c; }
            gi = __builtin_amdgcn_readfirstlane(gi);
            float den = 0.f;
#pragma unroll
            for (int c = 0; c < 4; ++c) den += expf(lc[c] - lm);
            const float gv = 1.f / den;
            float lf[8] = {0.f, 0.f, 0.f, 0.f, 0.f, 0.f, 0.f, 0.f};
            const float* wfg = wf + (size_t)gi * 8192;
#pragma unroll
            for (int j = 0; j < 4; ++j)
#pragma unroll
                for (int k = 0; k < 4; ++k) {
                    const f32x4 w0 = *(const f32x4*)(wfg + (((j * 4 + k) * 2 + 0) * 64 + lane) * 4), w1 = *(const f32x4*)(wfg + (((j * 4 + k) * 2 + 1) * 64 + lane) * 4);
                    const float x = v[4 * j + k];
                    lf[0] += x * w0.x; lf[1] += x * w0.y; lf[2] += x * w0.z; lf[3] += x * w0.w;
                    lf[4] += x * w1.x; lf[5] += x * w1.y; lf[6] += x * w1.z; lf[7] += x * w1.w;
                }
#pragma unroll
            for (int e = 0; e < 8; ++e) lf[e] = wave_sum(lf[e]) + bfn[gi * 8 + e];
            int e1 = 0; float l1 = lf[0];
#pragma unroll
            for (int e = 1; e < 8; ++e) if (lf[e] > l1) { l1 = lf[e]; e1 = e; }
            int e2 = 0; float l2 = -INFINITY;
#pragma unroll
            for (int e = 0; e < 8; ++e) if (e != e1 && lf[e] > l2) { l2 = lf[e]; e2 = e; }
            const float r = expf(l2 - l1);
            if (lane == i) { my_e = gi * 8 + e1; my_w = gv / (1.f + r); }
            if (lane == 16 + i) { my_e = gi * 8 + e2; my_w = gv * r / (1.f + r); }
        }
        if (lane < 32) {
            const int t = task * 16 + (lane & 15), k = lane >> 4, slot = (task & 63) * 32 + my_e;
            const int pos = atomicAdd(&cnt[slot], 1);
            list[(slot << 10) + pos] = t * 2 + k;
            wgt[t * 2 + k] = my_w;
        }
    }
}

constexpr int MOE_LDS_TAB = 65536;
constexpr int MOE_LDS_ROW = 65536 + 8448;
DI void moe_tables(const int* cnt, unsigned char* smem) {
    int* tab = (int*)(smem + MOE_LDS_TAB);
    if (threadIdx.x < 32) { const int e = threadIdx.x; int run = 0; for (int s = 0; s < 64; ++s) { tab[e * 65 + s] = run; run += cnt[s * 32 + e]; } tab[e * 65 + 64] = run; }
    __syncthreads();
}
DI bool moe_tile(const int* tab, int tile, int& e, int& mt, int& off, int& ce) {
    int acc_t = 0, acc_r = 0;
    for (int i = 0; i < 32; ++i) {
        const int c = tab[i * 65 + 64], nt = (c + 127) >> 7;
        if (tile < acc_t + nt) { e = i; mt = tile - acc_t; off = acc_r; ce = c; return true; }
        acc_t += nt; acc_r += c;
    }
    return false;
}
DI int moe_ntiles(const int* tab) { int a = 0; for (int i = 0; i < 32; ++i) a += (tab[i * 65 + 64] + 127) >> 7; return a; }
DI void moe_rows(const int* tab, const int* list, int e, int mt, int ce, int* rowidx) {
    if (threadIdx.x < 128) {
        const int pos = mt * 128 + threadIdx.x;
        int idx = -1;
        if (pos < ce) {
            int lo = 0, hi = 64;
            while (hi - lo > 1) { const int mid = (lo + hi) >> 1; if (tab[e * 65 + mid] <= pos) lo = mid; else hi = mid; }
            idx = list[((lo * 32 + e) << 10) + pos - tab[e * 65 + lo]];
        }
        rowidx[threadIdx.x] = idx;
    }
    __syncthreads();
}

DI void phase_moe_gu(const Params& P, unsigned char* smem, int layer) {
    unsigned char* ws = P.ws;
    const int* cnt = (const int*)(ws + WS_CTL) + layer * 2048;
    const int* list = (const int*)(ws + WS_LIST2);
    const float* wgt = (const float*)(ws + WS_WGT);
    const bf16_t* xb = (const bf16_t*)(ws + WS_ACTB);
    bf16_t* H = (bf16_t*)(ws + XP_H);
    const int* tab = (const int*)(smem + MOE_LDS_TAB);
    int* rowidx = (int*)(smem + MOE_LDS_ROW);
    moe_tables(cnt, smem);
    const int ntile = moe_ntiles(tab);
    for (int it = vblock(); it < ntile * 2; it += gridDim.x) {
        int e, mt, off, ce; moe_tile(tab, it >> 1, e, mt, off, ce);
        const int nt = it & 1;
        moe_rows(tab, list, e, mt, ce, rowidx);
        auto rowptr = [=](int r) { int idx = rowidx[r]; idx = idx < 0 ? rowidx[0] : idx; return xb + (size_t)(idx >> 1) * 1024; };
        auto epi = [=](f32x4 (&acc)[4][4], int wr, int wc, int ln) {
            const int fr = ln & 15, fq = ln >> 4;
#pragma unroll
            for (int m = 0; m < 4; ++m) {
                const int rl = wr * 64 + m * 16 + fr, idx = rowidx[rl];
                if (idx >= 0) {
                    const float w = wgt[idx];
#pragma unroll
                    for (int n = 0; n < 2; ++n) {
                        const f32x4 gte = acc[m][n], up = acc[m][n + 2];
                        *(u32x2*)(H + (size_t)(off + mt * 128 + rl) * 128 + (nt * 2 + wc) * 32 + n * 16 + fq * 4) =
                            cvt4((f32x4){gte.x * sigmoidf_(gte.x) * up.x * w, gte.y * sigmoidf_(gte.y) * up.y * w, gte.z * sigmoidf_(gte.z) * up.z * w, gte.w * sigmoidf_(gte.w) * up.w * w});
                    }
                }
            }
        };
        gemm128(rowptr, (const bf16_t*)(ws + WS_WGU) + ((size_t)(layer * 32 + e) * 256 + nt * 128) * 1024, 1024, 1024, smem, epi);
        __syncthreads();
    }
}
DI void phase_moe_down(const Params& P, unsigned char* smem, int layer) {
    unsigned char* ws = P.ws;
    const int* cnt = (const int*)(ws + WS_CTL) + layer * 2048;
    const int* list = (const int*)(ws + WS_LIST2);
    const bf16_t* H = (const bf16_t*)(ws + XP_H);
    bf16_t* YB = (bf16_t*)(ws + XP_YB);
    const int* tab = (const int*)(smem + MOE_LDS_TAB);
    int* rowidx = (int*)(smem + MOE_LDS_ROW);
    moe_tables(cnt, smem);
    const int ntile = moe_ntiles(tab);
    for (int it = vblock(); it < ntile * 8; it += gridDim.x) {
        int e, mt, off, ce; moe_tile(tab, it >> 3, e, mt, off, ce);
        const int nt = it & 7;
        moe_rows(tab, list, e, mt, ce, rowidx);
        auto rowptr = [=](int r) { int pos = mt * 128 + r; pos = pos < ce ? pos : 0; return H + (size_t)(off + pos) * 128; };
        auto epi = [=](f32x4 (&acc)[4][4], int wr, int wc, int ln) {
            const int fr = ln & 15, fq = ln >> 4;
#pragma unroll
            for (int m = 0; m < 4; ++m) {
                const int idx = rowidx[wr * 64 + m * 16 + fr];
                if (idx >= 0) {
                    bf16_t* dst = YB + (size_t)idx * 1024 + nt * 128 + wc * 64 + fq * 4;
#pragma unroll
                    for (int n = 0; n < 4; ++n) *(u32x2*)(dst + n * 16) = cvt4(acc[m][n]);
                }
            }
        };
        gemm128(rowptr, (const bf16_t*)(ws + WS_WDN) + ((size_t)(layer * 32 + e) * 1024 + nt * 128) * 128, 128, 128, smem, epi);
        __syncthreads();
    }
}
DI void phase_ln_ffn(const Params& P, int layer) {
    unsigned char* ws = P.ws;
    const int lane = threadIdx.x & 63, wave = threadIdx.x >> 6;
    const float* g = P.in[23] + layer * 1024; const float* bta = P.in[24] + layer * 1024;
    const bf16_t* YB = (const bf16_t*)(ws + XP_YB);
    bf16_t* xb = (bf16_t*)(ws + WS_ACTB);
    for (int task = blockIdx.x * 4 + wave; task < NT / 16; task += gridDim.x * 4) {
        u32x2 nxm[4], ny0[4], ny1[4];
        auto fetch = [&](int t) {
#pragma unroll
            for (int j = 0; j < 4; ++j) {
                nxm[j] = __builtin_nontemporal_load((const u32x2*)(xb + (size_t)t * 1024 + 4 * lane + 256 * j));
                ny0[j] = __builtin_nontemporal_load((const u32x2*)(YB + (size_t)(2 * t) * 1024 + 4 * lane + 256 * j));
                ny1[j] = __builtin_nontemporal_load((const u32x2*)(YB + (size_t)(2 * t + 1) * 1024 + 4 * lane + 256 * j));
            }
        };
        fetch(task * 16);
#pragma unroll 1
        for (int i = 0; i < 16; ++i) {
            const int t = task * 16 + i;
            float v[16];
#pragma unroll
            for (int j = 0; j < 4; ++j) {
                const f32x4 a = bf4_to_f(nxm[j]), y0 = bf4_to_f(ny0[j]), y1 = bf4_to_f(ny1[j]);
                v[4 * j + 0] = ALPHA * a.x + (y0.x + y1.x); v[4 * j + 1] = ALPHA * a.y + (y0.y + y1.y);
                v[4 * j + 2] = ALPHA * a.z + (y0.z + y1.z); v[4 * j + 3] = ALPHA * a.w + (y0.w + y1.w);
            }
            if (i + 1 < 16) fetch(t + 1);
            ln_row(v, g, bta, lane);
            float* row = P.out + (size_t)t * 1024;
#pragma unroll
            for (int j = 0; j < 4; ++j) {
                *(f32x4*)(row + 4 * lane + 256 * j) = (f32x4){v[4 * j], v[4 * j + 1], v[4 * j + 2], v[4 * j + 3]};
                if (layer == 0) *(u32x2*)(xb + (size_t)t * 1024 + 4 * lane + 256 * j) = cvt4((f32x4){v[4 * j], v[4 * j + 1], v[4 * j + 2], v[4 * j + 3]});
            }
        }
    }
}

DI void phase_inproj1(const Params& P, unsigned char* smem) {
    unsigned char* ws = P.ws;
    const bf16_t* A = (const bf16_t*)(ws + WS_ACTB);
    const float* cosT = (const float*)(ws + WS_ROPE);
    const float* sinT = cosT + 4096 * 32;
    bool pre = false;
    for (int it = vblock(); it < (NT / 128) * 24; it += gridDim.x) {
        int mt, nt; tile_mn(it, 24, mt, nt);
        const int m0 = mt * 128;
        auto rowptr = [=](int r) { return A + (size_t)(m0 + r) * 1024; };
        const bf16_t* Bt = (const bf16_t*)(ws + WS_WIN1) + (size_t)nt * 128 * 1024;
        const bool hn = it + (int)gridDim.x < (NT / 128) * 24;
        int mtn = 0, ntn = 0; if (hn) tile_mn(it + gridDim.x, 24, mtn, ntn);
        auto nextrow = [=](int r) { return A + (size_t)(mtn * 128 + r) * 1024; };
        const bf16_t* nBt = (const bf16_t*)(ws + WS_WIN1) + (size_t)ntn * 128 * 1024;
        if (nt >= 16) {
            auto epi = [=](f32x4 (&acc)[4][4], int wr, int wc, int lane) {
                const int head = (nt * 2 + wc) & 15, fr = lane & 15, fq = lane >> 4;
#pragma unroll
                for (int m = 0; m < 4; ++m) {
                    const int t = m0 + wr * 64 + m * 16 + fq * 4, s = t & 4095, b = t >> 12;
                    bf16_t* base = (bf16_t*)(ws + XP_Q1 + (size_t)2 * 64 * MiB) + (size_t)(b * 16 + head) * 4096 * 64;
#pragma unroll
                    for (int n = 0; n < 4; ++n) *(u32x2*)(base + vp_off(s, n * 16 + fr)) = cvt4(acc[m][n]);
                }
            };
            gemm128s<false>(rowptr, Bt, 1024, 1024, smem, epi, pre, hn, nextrow, nBt);
            pre = hn;
            continue;
        }
        auto epi = [=](f32x4 (&acc)[4][4], int wr, int wc, int lane) {
            const int u64 = nt * 2 + wc, kind = u64 >> 4, head = u64 & 15, fr = lane & 15, fq = lane >> 4;
            f32x4 cs[2][2];
#pragma unroll
            for (int n2 = 0; n2 < 2; ++n2) { cs[n2][0] = (f32x4){0.f, 0.f, 0.f, 0.f}; cs[n2][1] = cs[n2][0]; }
#pragma unroll
            for (int m = 0; m < 4; ++m) {
                const int t = m0 + wr * 64 + m * 16 + fr, s = t & 4095, b = t >> 12;
                bf16_t* base = (bf16_t*)(ws + XP_Q1 + (size_t)kind * 64 * MiB) + (size_t)(b * 16 + head) * 4096 * 64;
#pragma unroll
                for (int n2 = 0; n2 < 2; ++n2) {
                    const int i = n2 * 16 + fq * 4;
                    const f32x4 c = *(const f32x4*)(cosT + s * 32 + i), sn = *(const f32x4*)(sinT + s * 32 + i);
                    const f32x4 x1 = acc[m][2 * n2], x2 = acc[m][2 * n2 + 1];
                    const f32x4 r1 = x1 * c - x2 * sn, r2 = x1 * sn + x2 * c;
                    const u32x2 o1 = cvt4(r1), o2 = cvt4(r2);
                    if (kind == 0) { *(u32x2*)(base + (size_t)s * 64 + i) = o1; *(u32x2*)(base + (size_t)s * 64 + i + 32) = o2; }
                    else { *(u32x2*)(base + kp_off(s, i)) = o1; *(u32x2*)(base + kp_off(s, i + 32)) = o2; cs[n2][0] += r1; cs[n2][1] += r2; }
                }
            }
            if (kind == 1) {
                const int t0 = m0 + wr * 64, bh = (t0 >> 12) * 16 + head, seg = (t0 & 4095) >> 6;
                float* dst = (float*)(ws + WS_KMP) + ((size_t)bh * 64 + seg) * 64;
#pragma unroll
                for (int n2 = 0; n2 < 2; ++n2)
#pragma unroll
                    for (int hf = 0; hf < 2; ++hf) {
                        f32x4 v = cs[n2][hf];
#pragma unroll
                        for (int k = 0; k < 4; ++k) { float x = v[k]; x += dpp_f<0xB1>(x); x += dpp_f<0x4E>(x); x += dpp_f<0x141>(x); x += dpp_f<0x140>(x); v[k] = x; }
                        if (fr == 0) *(f32x4*)(dst + n2 * 16 + fq * 4 + hf * 32) = v;
                    }
            }
        };
        gemm128s(rowptr, Bt, 1024, 1024, smem, epi, pre, hn, nextrow, nBt);
        pre = hn;
    }
}
DI void moba_kmeans_slab(const Params& P, bf16_t* kml, int bh, int tid) {
    const float* kp = (const float*)(P.ws + WS_KMP) + (size_t)bh * 64 * 64;
    for (int e = tid; e < 2048; e += 256) {
        const int d = e & 63, n = e >> 6;
        float a = 0.f;
        if (n < 16) a = ((kp[(4 * n) * 64 + d] + kp[(4 * n + 1) * 64 + d]) + (kp[(4 * n + 2) * 64 + d] + kp[(4 * n + 3) * 64 + d])) * (1.f / 256.f);
        kml[((d >> 4) * 32 + n) * 16 + (d & 15)] = f2bf(a);
    }
}
DI unsigned moba_gate_rows(const bf16_t* km, const bf16x8 (&qf)[4], int own, int r, int h) {
    f32x16 g;
#pragma unroll
    for (int i = 0; i < 16; ++i) g[i] = 0.f;
#pragma unroll
    for (int ks = 0; ks < 4; ++ks) g = MFMA32(*(const bf16x8*)(km + (ks * 32 + r) * 16 + 8 * h), qf[ks], g);
    float mine[8], oth[8];
#pragma unroll
    for (int i = 0; i < 8; ++i) { const int n = (i & 3) + 8 * (i >> 2) + 4 * h; mine[i] = n < own ? g[i] : -INFINITY; oth[i] = __shfl_xor(mine[i], 32); }
    unsigned selmask = 0;
#pragma unroll
    for (int i = 0; i < 8; ++i) {
        const int n = (i & 3) + 8 * (i >> 2) + 4 * h;
        int rank = 0;
#pragma unroll
        for (int k = 0; k < 8; ++k) {
            const int nk = (k & 3) + 8 * (k >> 2) + 4 * h, no = (k & 3) + 8 * (k >> 2) + 4 * (1 - h);
            rank += (mine[k] > mine[i] || (mine[k] == mine[i] && nk < n)) ? 1 : 0;
            rank += (oth[k] > mine[i] || (oth[k] == mine[i] && no < n)) ? 1 : 0;
        }
        if (n < own && rank < 3) selmask |= 1u << n;
    }
    return selmask | __shfl_xor(selmask, 32);
}
DI void phase_moba_gate(const Params& P, unsigned char* smem) {
    unsigned char* ws = P.ws;
    const int tid = threadIdx.x, lane = tid & 63, wave = tid >> 6, r = lane & 31, h = lane >> 5;
    bf16_t* kml = (bf16_t*)smem;
    unsigned short* smask = (unsigned short*)(smem + 4096);
    unsigned short* selm = (unsigned short*)(ws + WS_SELM);
    unsigned short* mcnt = (unsigned short*)(ws + WS_MCNT);
    unsigned char* mlist = ws + WS_MLIST;
    int km_bh = -1;
    for (int it = blockIdx.x; it < 2048; it += gridDim.x) {
        const int bh = it & 127, qb = it >> 7;
        if (bh != km_bh) { km_bh = bh; __syncthreads(); moba_kmeans_slab(P, kml, bh, tid); }
        __syncthreads();
#pragma unroll 1
        for (int g2 = 0; g2 < 2; ++g2) {
            const int rl = wave * 64 + g2 * 32 + r, q = qb * 256 + rl;
            const bf16_t* Qg = (const bf16_t*)(ws + XP_Q1) + ((size_t)bh * 4096 + q) * 64;
            bf16x8 qf[4];
#pragma unroll
            for (int ks = 0; ks < 4; ++ks) qf[ks] = *(const bf16x8*)(Qg + ks * 16 + 8 * h);
            const unsigned sm = qb > 0 ? moba_gate_rows(kml, qf, qb, r, h) : 0u;
            if (h == 0) { selm[(size_t)bh * 4096 + q] = (unsigned short)sm; smask[rl] = (unsigned short)sm; }
        }
        __syncthreads();
        for (int n = wave; n < qb; n += 4) {
            unsigned char* lp = mlist + ((size_t)(bh * 16 + qb) * 16 + n) * 256;
            int base = 0;
#pragma unroll
            for (int c4 = 0; c4 < 4; ++c4) {
                const int row = c4 * 64 + lane;
                const bool bit = (smask[row] >> n) & 1;
                const unsigned long long bal = __ballot(bit);
                if (bit) lp[base + __builtin_popcountll(bal & ((1ull << lane) - 1ull))] = (unsigned char)row;
                base += __builtin_popcountll(bal);
            }
            if (lane == 0) mcnt[(bh * 16 + qb) * 16 + n] = (unsigned short)base;
        }
    }
}
DI bf16_t* moba_po(const Params& P, int slot) { return (bf16_t*)(P.ws + (slot == 0 ? WS_MIX : slot == 1 ? WS_ACTB : WS_PO2)); }
DI void phase_moba_kv(const Params& P, unsigned char* smem) {
    unsigned char* ws = P.ws;
    const int tid = threadIdx.x, lane = tid & 63, wave = tid >> 6, r = lane & 31, h = lane >> 5;
    const float c = 0.125f * 1.4426950408889634f;
    LAS unsigned char* lds = (LAS unsigned char*)smem;
    const unsigned short* selm = (const unsigned short*)(ws + WS_SELM);
    const unsigned short* mcnt = (const unsigned short*)(ws + WS_MCNT);
    const unsigned char* mlist = ws + WS_MLIST;
    float* pml = (float*)(ws + WS_PML);
    const bool bal = (gridDim.x == 512);
    const int nit = bal ? ((blockIdx.x >> 7) == 3 ? 3 : 4) : (1920 + (int)gridDim.x - 1 - (int)blockIdx.x) / (int)gridDim.x;
    for (int iti = 0; iti < nit; ++iti) {
        int bh, n;
        if (bal) { const int gq = blockIdx.x >> 7; bh = blockIdx.x & 127; const int tab = gq == 0 ? 0x0DA90 : gq == 1 ? 0x0CB61 : gq == 2 ? 0x0E852 : 0x00743; n = (tab >> (4 * iti)) & 15; }
        else { const int it = blockIdx.x + iti * gridDim.x; n = it >> 7; bh = it & 127; }
        const bf16_t* Kg = (const bf16_t*)(ws + XP_Q1 + 64 * MiB) + (size_t)bh * 4096 * 64 + (size_t)n * 4 * 4096;
        const bf16_t* Vg = (const bf16_t*)(ws + XP_Q1 + 128 * MiB) + (size_t)bh * 4096 * 64 + (size_t)n * 4 * 4096;
        asm volatile("s_waitcnt vmcnt(0)" ::: "memory");
        __builtin_amdgcn_s_barrier();
#pragma unroll
        for (int j = 0; j < 4; ++j) fa_issue(Kg + (size_t)j * 4096, Vg + (size_t)j * 4096, lds + j * 16384, tid);
        const int cntv = (lane < 16 && lane > n) ? (int)mcnt[(bh * 16 + lane) * 16 + n] : 0;
        asm volatile("s_waitcnt vmcnt(0)" ::: "memory");
        __builtin_amdgcn_s_barrier();
        asm volatile("" ::: "memory");
        int prefv = 0, total = 0;
#pragma unroll 1
        for (int qb = 0; qb < 16; ++qb) { if (lane == qb) prefv = total; total += __builtin_amdgcn_readlane(cntv, qb); }
#pragma unroll 1
        for (int v0 = wave * 32; v0 < total; v0 += 128) {
            const int v = v0 + r;
            const bool valid = v < total;
            const int vv = valid ? v : v0;
            int qb = n + 1;
#pragma unroll 1
            for (int l = n + 2; l < 16; ++l) if (vv >= __builtin_amdgcn_readlane(prefv, l)) qb = l;
            const int idx = vv - __shfl(prefv, qb);
            const int q = qb * 256 + (int)mlist[((size_t)(bh * 16 + qb) * 16 + n) * 256 + idx];
            const bf16_t* Qg = (const bf16_t*)(ws + XP_Q1) + ((size_t)bh * 4096 + q) * 64;
            bf16x8 qf[4];
#pragma unroll
            for (int ks = 0; ks < 4; ++ks) qf[ks] = *(const bf16x8*)(Qg + ks * 16 + 8 * h);
            FA st; fa_init(st);
#pragma unroll 1
            for (int j = 0; j < 4; ++j) {
                const LAS bf16_t* cur = (const LAS bf16_t*)(lds + j * 16384);
                fa_tile<0>(st, qf, cur, cur + 4096, r, h, c, true, [=](int) { return true; });
            }
            const float l = st.l + __shfl_xor(st.l, 32);
            const float inv = 1.f / fmaxf(l, 1e-30f);
            if (valid) {
                const int slot = __builtin_popcount((unsigned)selm[(size_t)bh * 4096 + q] & ((1u << n) - 1u));
                bf16_t* o = moba_po(P, slot) + ((size_t)(bh >> 4) * 4096 + q) * 1024 + (bh & 15) * 64;
#pragma unroll
                for (int g4 = 0; g4 < 4; ++g4) {
                    *(u32x2*)(o + 8 * g4 + 4 * h) = cvt4((f32x4){st.o0[4 * g4] * inv, st.o0[4 * g4 + 1] * inv, st.o0[4 * g4 + 2] * inv, st.o0[4 * g4 + 3] * inv});
                    *(u32x2*)(o + 32 + 8 * g4 + 4 * h) = cvt4((f32x4){st.o1[4 * g4] * inv, st.o1[4 * g4 + 1] * inv, st.o1[4 * g4 + 2] * inv, st.o1[4 * g4 + 3] * inv});
                }
                if (h == 0) { float* pm = pml + (((size_t)bh * 4096 + q) * 3 + slot) * 2; pm[0] = st.m; pm[1] = l; }
            }
        }
    }
}
DI void phase_moba_own(const Params& P, unsigned char* smem) {
    unsigned char* ws = P.ws;
    const int tid = threadIdx.x, lane = tid & 63, wave = tid >> 6, r = lane & 31, h = lane >> 5;
    const float c = 0.125f * 1.4426950408889634f;
    LAS unsigned char* lds = (LAS unsigned char*)smem;
    const unsigned short* selm = (const unsigned short*)(ws + WS_SELM);
    const float* pml = (const float*)(ws + WS_PML);
    for (int it = blockIdx.x; it < 2048; it += gridDim.x) {
        const int own = 15 - (it >> 7), bh = it & 127, t0 = own * 256;
        const bf16_t* Kg = (const bf16_t*)(ws + XP_Q1 + 64 * MiB) + (size_t)bh * 4096 * 64 + (size_t)own * 4 * 4096;
        const bf16_t* Vg = (const bf16_t*)(ws + XP_Q1 + 128 * MiB) + (size_t)bh * 4096 * 64 + (size_t)own * 4 * 4096;
        asm volatile("s_waitcnt vmcnt(0)" ::: "memory");
        __builtin_amdgcn_s_barrier();
#pragma unroll
        for (int j = 0; j < 4; ++j) fa_issue(Kg + (size_t)j * 4096, Vg + (size_t)j * 4096, lds + j * 16384, tid);
        asm volatile("s_waitcnt vmcnt(0)" ::: "memory");
        __builtin_amdgcn_s_barrier();
        asm volatile("" ::: "memory");
#pragma unroll 1
        for (int g2 = 0; g2 < 2; ++g2) {
            const int row0 = t0 + g2 * 128 + wave * 32, q = row0 + r;
            const bf16_t* Qg = (const bf16_t*)(ws + XP_Q1) + ((size_t)bh * 4096 + q) * 64;
            bf16x8 qf[4];
#pragma unroll
            for (int ks = 0; ks < 4; ++ks) qf[ks] = *(const bf16x8*)(Qg + ks * 16 + 8 * h);
            const int nsel = __builtin_popcount((unsigned)selm[(size_t)bh * 4096 + q]);
            const size_t orow = ((size_t)(bh >> 4) * 4096 + q) * 1024 + (bh & 15) * 64;
            const float* pm = pml + ((size_t)bh * 4096 + q) * 6;
            float mi[3], li[3];
            u32x2 pa[3][8];
#pragma unroll
            for (int i = 0; i < 3; ++i) {
                mi[i] = i < nsel ? pm[2 * i] : -INFINITY; li[i] = i < nsel ? pm[2 * i + 1] : 0.f;
                const bf16_t* po = moba_po(P, i) + orow;
#pragma unroll
                for (int g4 = 0; g4 < 4; ++g4) {
                    pa[i][2 * g4] = i < nsel ? *(const u32x2*)(po + 8 * g4 + 4 * h) : (u32x2){0u, 0u};
                    pa[i][2 * g4 + 1] = i < nsel ? *(const u32x2*)(po + 32 + 8 * g4 + 4 * h) : (u32x2){0u, 0u};
                }
            }
            FA st; fa_init(st);
            const int jmax = (row0 + 31 - t0) >> 6;
#pragma unroll 1
            for (int j = 0; j <= jmax; ++j) {
                const LAS bf16_t* cur = (const LAS bf16_t*)(lds + j * 16384);
                const int kbase = t0 + j * 64;
                if (kbase + 63 <= row0) fa_tile<0>(st, qf, cur, cur + 4096, r, h, c, true, [=](int) { return true; });
                else fa_tile<2>(st, qf, cur, cur + 4096, r, h, c, true, [=](int koff) { return kbase + koff <= q; });
            }
            const float l_own = st.l + __shfl_xor(st.l, 32);
            const float M = fmaxf(fmaxf(st.m, mi[0]), fmaxf(mi[1], mi[2]));
            const float wo = __builtin_amdgcn_exp2f(st.m - M);
            float L = l_own * wo;
#pragma unroll
            for (int k = 0; k < 16; ++k) { st.o0[k] *= wo; st.o1[k] *= wo; }
#pragma unroll
            for (int i = 0; i < 3; ++i) {
                const float wi = li[i] * __builtin_amdgcn_exp2f(mi[i] - M);
                L += wi;
#pragma unroll
                for (int g4 = 0; g4 < 4; ++g4) {
                    const f32x4 a = bf4_to_f(pa[i][2 * g4]), b2 = bf4_to_f(pa[i][2 * g4 + 1]);
                    st.o0[4 * g4] += wi * a.x; st.o0[4 * g4 + 1] += wi * a.y; st.o0[4 * g4 + 2] += wi * a.z; st.o0[4 * g4 + 3] += wi * a.w;
                    st.o1[4 * g4] += wi * b2.x; st.o1[4 * g4 + 1] += wi * b2.y; st.o1[4 * g4 + 2] += wi * b2.z; st.o1[4 * g4 + 3] += wi * b2.w;
                }
            }
            const float inv = 1.f / fmaxf(L, 1e-30f);
            bf16_t* o = (bf16_t*)(ws + WS_MIX) + orow;
#pragma unroll
            for (int g4 = 0; g4 < 4; ++g4) {
                *(u32x2*)(o + 8 * g4 + 4 * h) = cvt4((f32x4){st.o0[4 * g4] * inv, st.o0[4 * g4 + 1] * inv, st.o0[4 * g4 + 2] * inv, st.o0[4 * g4 + 3] * inv});
                *(u32x2*)(o + 32 + 8 * g4 + 4 * h) = cvt4((f32x4){st.o1[4 * g4] * inv, st.o1[4 * g4 + 1] * inv, st.o1[4 * g4 + 2] * inv, st.o1[4 * g4 + 3] * inv});
            }
        }
    }
}

constexpr int SMEM_BYTES = 65536 + 8192 + 1024 + 512;
static_assert(SMEM_BYTES >= 128 * 129 * 4 && SMEM_BYTES >= MOE_LDS_ROW + 512 && SMEM_BYTES >= NSA_LDS_MSK + 256, "LDS map");
constexpr int SMEM_OLD = 128 * 129 * 4;
typedef __attribute__((address_space(1))) unsigned gu32;
#define XB_TMO      128
#define XB_XCNT(j)  (256  + 64 * (j))
#define XB_XSUB(j)  (1280 + 64 * (j))
#define XB_XGEN(j)  (2304 + 64 * (j))
#define XB_TOP      3328
#define XB_TOPGEN   3392
#define XCD_BAR_WORDS 3456
#define XB_SPIN_CAP (1u << 18)

__device__ __forceinline__ unsigned xb_ld(unsigned* p)              { return __hip_atomic_load(p, __ATOMIC_RELAXED, __HIP_MEMORY_SCOPE_AGENT); }
__device__ __forceinline__ unsigned xb_add(unsigned* p, unsigned v) { return __hip_atomic_fetch_add(p, v, __ATOMIC_RELAXED, __HIP_MEMORY_SCOPE_AGENT); }
__device__ __forceinline__ unsigned xb_xcc_id() { return (unsigned)__builtin_amdgcn_s_getreg((3 << 11) | 20) & 0xFu; }
#define XB_SPIN(cond, bar) do { unsigned _sp = 0; while (cond) { __builtin_amdgcn_s_sleep(1); \
    if ((++_sp & 255u) == 0u) { if (xb_ld(&(bar)[XB_TMO])) break; if (_sp > XB_SPIN_CAP) { atomicAdd(&(bar)[XB_TMO], 1u); break; } } } } while (0)

struct XcdBarrier {
    unsigned* bar; unsigned x;
    volatile LAS unsigned* st;
};

__device__ __forceinline__ XcdBarrier xcd_barrier_post(unsigned* bar, volatile LAS unsigned* st) {
    XcdBarrier b; b.bar = bar; b.x = xb_xcc_id(); b.st = st;
    if (threadIdx.x == 0) (void)xb_add(&bar[XB_XCNT(b.x)], 1u);
    return b;
}
__device__ __forceinline__ void xcd_barrier_complete(unsigned* bar, unsigned x, unsigned& nloc, unsigned& nx) {
    const unsigned G = gridDim.x * gridDim.y * gridDim.z;
    unsigned sum, cnt, mine, sp = 0u;
    for (;;) {
        sum = 0u; cnt = 0u; mine = 0u;
#pragma unroll
        for (unsigned j = 0; j < 16; ++j) { const unsigned c = xb_ld(&bar[XB_XCNT(j)]); sum += c; cnt += (c > 0u) ? 1u : 0u; mine = (j == x) ? c : mine; }
        if (sum == G) break;
        __builtin_amdgcn_s_sleep(1);
        if ((++sp & 255u) == 0u) { if (xb_ld(&bar[XB_TMO])) break; if (sp > XB_SPIN_CAP) { atomicAdd(&bar[XB_TMO], 1u); break; } }
    }
    nloc = mine > 0u ? mine : 1u; nx = cnt > 0u ? cnt : 1u;
}

__device__ __forceinline__ void xcd_barrier(const XcdBarrier& b) {
    asm volatile("s_waitcnt vmcnt(0)" ::: "memory");
    __syncthreads();
    if (threadIdx.x == 0) {
        unsigned* bar = b.bar;
        __builtin_amdgcn_s_waitcnt(0);
        unsigned nloc = b.st[0], nx = b.st[1];
        if (nloc == 0u) { xcd_barrier_complete(bar, b.x, nloc, nx); b.st[0] = nloc; b.st[1] = nx; }
        const unsigned old = xb_add(&bar[XB_XSUB(b.x)], 1u);
        const unsigned gen = old / nloc;
        if (old + 1u == (gen + 1u) * nloc) {
            __builtin_amdgcn_fence(__ATOMIC_RELEASE, "agent");
            asm volatile("s_waitcnt vmcnt(0)" ::: "memory");
            const unsigned og = xb_add(&bar[XB_TOP], 1u);
            const unsigned tg = og / nx;
            if (og + 1u == (tg + 1u) * nx) xb_add(&bar[XB_TOPGEN], 1u);
            else XB_SPIN(xb_ld(&bar[XB_TOPGEN]) == tg, bar);
            __builtin_amdgcn_fence(__ATOMIC_ACQUIRE, "agent");
            xb_add(&bar[XB_XGEN(b.x)], 1u);
            asm volatile("s_waitcnt vmcnt(0)" ::: "memory");
        } else {
            XB_SPIN(xb_ld(&bar[XB_XGEN(b.x)]) == gen, bar);
            __builtin_amdgcn_fence(__ATOMIC_ACQUIRE, "agent");
            asm volatile("s_waitcnt vmcnt(0)" ::: "memory");
        }
    }
    __syncthreads();
}

constexpr size_t CTL_BAR = 16384;
constexpr size_t CTL_BYTES = 32768;

#define PHASE(k, call) if (P.ph_lo <= (k) && (k) < P.ph_hi) { call; if ((k) + 1 < P.ph_hi) xcd_barrier(xb); }
__global__ void __launch_bounds__(256, 2) mega(Params P) {
    __shared__ __attribute__((aligned(16))) unsigned char smem[SMEM_BYTES + 16];
    unsigned* xbst = (unsigned*)(smem + SMEM_BYTES);
    cg::grid_group grid = cg::this_grid();
    if (threadIdx.x < 4) xbst[threadIdx.x] = 0u;
    __syncthreads();
    if (P.ph_lo < 0) grid.sync();
    XcdBarrier xb = xcd_barrier_post((unsigned*)(P.ws + WS_CTL + CTL_BAR), (volatile LAS unsigned*)xbst);
    PHASE(0, phase0(P, smem))
    PHASE(1, phase_inproj0(P, smem))
    PHASE(2, phase_cmp_s5e(P, smem))
    PHASE(3, phase_glu(P, smem); phase_nsa(P, smem))
    PHASE(6, phase_outproj(P, smem, P.in[0], WS_WOUT0))
    PHASE(7, phase_ln_router(P, 0))
    PHASE(8, phase_moe_gu(P, smem, 0))
    PHASE(9, phase_moe_down(P, smem, 0))
    PHASE(10, phase_ln_ffn(P, 0))
    PHASE(11, phase_inproj1(P, smem))
    PHASE(12, phase_moba_gate(P, smem))
    PHASE(13, phase_moba_kv(P, smem))
    PHASE(14, phase_moba_own(P, smem))
    PHASE(15, phase_outproj(P, smem, P.out, WS_WOUT1))
    PHASE(16, phase_ln_router(P, 1))
    PHASE(17, phase_moe_gu(P, smem, 1))
    PHASE(18, phase_moe_down(P, smem, 1))
    PHASE(20, phase_ln_ffn(P, 1))
}

extern "C" void kernel_launch(void* const* d_in, const int* in_sizes, int n_in, void* d_out, int out_size, void* d_ws, size_t ws_size, hipStream_t stream) {
    static int grid = 0;
    if (grid == 0) {
        if (n_in != 32 || out_size != NT * DM || ws_size < WS_END) { fprintf(stderr, "kernel_launch: unexpected shapes (n_in %d, out %d, ws %zu)\n", n_in, out_size, ws_size); grid = -1; return; }
        int dev = 0, cus = 0, per_cu = 0;
        (void)hipGetDevice(&dev);
        (void)hipDeviceGetAttribute(&cus, hipDeviceAttributeMultiprocessorCount, dev);
        (void)hipOccupancyMaxActiveBlocksPerMultiprocessor(&per_cu, mega, 256, 0);
        if (per_cu < 1) per_cu = 1;
        if (per_cu > 2) per_cu = 2;
        grid = cus * per_cu;
    }
    if (grid < 0) return;
    (void)hipMemsetAsync((char*)d_ws + WS_CTL, 0, CTL_BYTES, stream);
    Params p{};
    for (int i = 0; i < 32; ++i) p.in[i] = (const float*)d_in[i];
    p.out = (float*)d_out; p.ws = (unsigned char*)d_ws;
    p.ph_lo = 0; p.ph_hi = NPH;
    void* args[] = {&p};
    hipError_t e = hipLaunchCooperativeKernel((void*)mega, dim3(grid), dim3(256), args, 0, stream);
    if (e != hipSuccess) fprintf(stderr, "cooperative launch failed: %s (grid %d)\n", hipGetErrorString(e), grid);
}
```

```cpp
#include <hip/hip_runtime.h>
#include <hip/hip_cooperative_groups.h>
#include <cstdio>
#include <cstdint>
namespace cg = cooperative_groups;

typedef unsigned short bf16_t;
typedef short bf16x8 __attribute__((ext_vector_type(8)));
typedef float f32x4 __attribute__((ext_vector_type(4)));
typedef unsigned u32x4 __attribute__((ext_vector_type(4)));
typedef unsigned u32x2 __attribute__((ext_vector_type(2)));
#define DI __device__ __forceinline__
#define LAS __attribute__((address_space(3)))
typedef float f32x16 __attribute__((ext_vector_type(16)));
typedef float f32x8 __attribute__((ext_vector_type(8)));
typedef __bf16 bf16x8v __attribute__((ext_vector_type(8)));
typedef __bf16 bf16x4v __attribute__((ext_vector_type(4)));
#define MFMA32(a, b, c) __builtin_amdgcn_mfma_f32_32x32x16_bf16((a), (b), (c), 0, 0, 0)

constexpr int NB = 8, SEQ = 4096, DM = 1024, NT = NB * SEQ;
constexpr float ALPHA = 1.41421356237f;
constexpr float LN_EPS = 1e-5f;
constexpr int NIN0 = 1920;
constexpr int NPH = 21;

constexpr size_t MiB = 1u << 20;
constexpr size_t WS_CTL = 0;
constexpr size_t WS_ROPE = 1 * MiB;
constexpr size_t WS_WIN0 = 2 * MiB;
constexpr size_t WS_WOUT0 = 6 * MiB;
constexpr size_t WS_WIN1 = 8 * MiB;
constexpr size_t WS_WOUT1 = 14 * MiB;
constexpr size_t WS_WGLU = 16 * MiB;
constexpr size_t WS_WCK1 = 16 * MiB + 512 * 1024;
constexpr size_t WS_WCV1 = 17 * MiB;
constexpr size_t WS_WCK2 = 17 * MiB + 512 * 1024;
constexpr size_t WS_WCV2 = WS_WCK2 + 16384;
constexpr size_t WS_CBIAS = WS_WCV2 + 16384;
constexpr size_t WS_S5AL = WS_CBIAS + 4096;
constexpr size_t WS_RTRW = 17 * MiB + 640 * 1024;
constexpr size_t WS_BTE = 18 * MiB;
constexpr size_t WS_BTY = 22 * MiB;
constexpr size_t WS_WGU = 42 * MiB;
constexpr size_t WS_WDN = 74 * MiB;
constexpr size_t WS_KMP = 90 * MiB;
constexpr size_t WS_WGT = 94 * MiB;
constexpr size_t WS_KMEAN = 94 * MiB + 512 * 1024;
constexpr size_t WS_KCMP = 95 * MiB;
constexpr size_t WS_VCMP = 95 * MiB + 512 * 1024;
constexpr size_t WS_ACTB = 96 * MiB;
constexpr size_t WS_MIX = 160 * MiB;
constexpr size_t WS_XP = 224 * MiB;
constexpr size_t WS_LIST2 = 416 * MiB;
constexpr size_t WS_SELM = 92 * MiB;
constexpr size_t WS_MCNT = 93 * MiB;
constexpr size_t WS_MLIST = WS_LIST2;
constexpr size_t WS_PO2 = 424 * MiB;
constexpr size_t WS_PML = 488 * MiB;
constexpr size_t WS_END = 504 * MiB;
constexpr size_t XP_Q0 = WS_XP;
constexpr size_t XP_KC = WS_XP + 32 * MiB;
constexpr size_t KVSZ = 8 * MiB;
constexpr size_t XP_GATES = WS_XP + 80 * MiB;
constexpr size_t XP_AEXT = WS_XP + 84 * MiB;
constexpr size_t XP_G5 = WS_XP + 124 * MiB;
constexpr size_t XP_YB = WS_XP;
constexpr size_t XP_H = WS_XP + 128 * MiB;
constexpr size_t XP_Q1 = WS_XP;

struct Params {
    const float* in[32];
    float* out;
    unsigned char* ws;
    int ph_lo, ph_hi;
};

DI bf16_t f2bf(float f) { unsigned u = __float_as_uint(f); return (bf16_t)((u + 0x7fffu + ((u >> 16) & 1u)) >> 16); }
DI float bf2f(bf16_t h) { return __uint_as_float(((unsigned)h) << 16); }
DI unsigned pk2(float lo, float hi) { return (unsigned)f2bf(lo) | ((unsigned)f2bf(hi) << 16); }
DI bf16x8 cvt8(f32x8 v) { return __builtin_bit_cast(bf16x8, __builtin_convertvector(v, bf16x8v)); }
DI u32x2 cvt4(f32x4 v) { return __builtin_bit_cast(u32x2, __builtin_convertvector(v, bf16x4v)); }
DI size_t kp_off(int key, int d) { return ((size_t)((key >> 5) * 4 + (d >> 4)) * 32 + (key & 31)) * 16 + (d & 15); }
DI int vp_pos(int ko) { return 8 * ((ko >> 2) & 1) + 4 * (ko >> 3) + (ko & 3); }
DI size_t vp_off(int key, int d) { return ((size_t)(key >> 4) * 64 + d) * 16 + vp_pos(key & 15); }
DI bf16_t ld_bf(const bf16_t* p) { return *p; }
DI f32x4 bf4_to_f(u32x2 w) { return (f32x4){__uint_as_float(w.x << 16), __uint_as_float(w.x & 0xffff0000u), __uint_as_float(w.y << 16), __uint_as_float(w.y & 0xffff0000u)}; }
template <int CTRL> DI float dpp_f(float v) { return __builtin_bit_cast(float, __builtin_amdgcn_update_dpp(0, __builtin_bit_cast(int, v), CTRL, 0xF, 0xF, true)); }
DI float wave_sum(float v) {
    v += dpp_f<0xB1>(v);
    v += dpp_f<0x4E>(v);
    v += dpp_f<0x141>(v);
    v += dpp_f<0x140>(v);
    { const auto s = __builtin_amdgcn_permlane16_swap(__float_as_uint(v), __float_as_uint(v), false, false); v = __uint_as_float(s[0]) + __uint_as_float(s[1]); }
    { const auto s = __builtin_amdgcn_permlane32_swap(__float_as_uint(v), __float_as_uint(v), false, false); v = __uint_as_float(s[0]) + __uint_as_float(s[1]); }
    return v;
}
DI float wave_max(float v) {
#pragma unroll
    for (int o = 32; o > 0; o >>= 1) v = fmaxf(v, __shfl_xor(v, o));
    return v;
}
DI float sigmoidf_(float x) { return __builtin_amdgcn_rcpf(1.f + __expf(-x)); }
DI float gelu_tanh(float x) { const float z = 0.7978845608028654f * (x + 0.044715f * x * x * x); return x * sigmoidf_(2.f * z); }

constexpr int GEMM_LDS = 65536;
template <bool TRANS = true, class RowPtr, class Epi>
DI void gemm128(RowPtr rowptr, const bf16_t* __restrict__ Bt, int ldb, int K, unsigned char* smem, Epi epi, int kskip_lo = 0, int kskip_hi = 0) {
    LAS unsigned char* lds = (LAS unsigned char*)smem;
    const int tid = threadIdx.x, lane = tid & 63, wave = tid >> 6, wr = wave >> 1, wc = wave & 1, fr = lane & 15, fq = lane >> 4;
    const int schunk = ((tid & 7) ^ ((tid >> 4) & 7)) * 8;
    const bf16_t* ga[4];
#pragma unroll
    for (int i = 0; i < 4; ++i) ga[i] = rowptr(i * 32 + (tid >> 3)) + schunk;
    const bf16_t* gb = Bt + (size_t)(tid >> 3) * ldb + schunk;
    const size_t gbs = (size_t)32 * ldb;
    auto stage = [&](int kt, int s) {
#pragma unroll
        for (int i = 0; i < 4; ++i) {
            __builtin_amdgcn_global_load_lds((const unsigned*)(ga[i] + kt * 64), (LAS unsigned*)(lds + s * 32768 + (i * 256 + tid) * 16), 16, 0, 0);
            __builtin_amdgcn_global_load_lds((const unsigned*)(gb + i * gbs + kt * 64), (LAS unsigned*)(lds + s * 32768 + 16384 + (i * 256 + tid) * 16), 16, 0, 0);
        }
    };
    f32x4 acc[4][4];
#pragma unroll
    for (int m = 0; m < 4; ++m)
#pragma unroll
        for (int n = 0; n < 4; ++n) acc[m][n] = (f32x4){0.f, 0.f, 0.f, 0.f};
    const int nskip = kskip_hi - kskip_lo, nk = (K >> 6) - nskip;
    const int swz = (fr >> 1) & 7;
    const int aoff = (wr * 64 + fr) * 128, boff = 16384 + (wc * 64 + fr) * 128;
    stage(kskip_lo == 0 ? nskip : 0, 0);
#pragma unroll 1
    for (int kt = 0; kt < nk; ++kt) {
        asm volatile("s_waitcnt vmcnt(0)" ::: "memory");
        __syncthreads();
        if (kt + 1 < nk) stage(kt + 1 < kskip_lo ? kt + 1 : kt + 1 + nskip, (kt + 1) & 1);
        const LAS unsigned char* cur = lds + (kt & 1) * 32768;
#pragma unroll
        for (int ks = 0; ks < 2; ++ks) {
            bf16x8 af[4], bfr[4];
            const int co = ((ks * 4 + fq) ^ swz) * 16;
#pragma unroll
            for (int m = 0; m < 4; ++m) af[m] = *(const LAS bf16x8*)(cur + aoff + m * 2048 + co);
#pragma unroll
            for (int n = 0; n < 4; ++n) bfr[n] = *(const LAS bf16x8*)(cur + boff + n * 2048 + co);
#pragma unroll
            for (int m = 0; m < 4; ++m)
#pragma unroll
                for (int n = 0; n < 4; ++n) acc[m][n] = TRANS ? __builtin_amdgcn_mfma_f32_16x16x32_bf16(bfr[n], af[m], acc[m][n], 0, 0, 0) : __builtin_amdgcn_mfma_f32_16x16x32_bf16(af[m], bfr[n], acc[m][n], 0, 0, 0);
        }
    }
    __syncthreads();
    epi(acc, wr, wc, lane);
}

template <bool TRANS = true, class RowPtr, class Epi, class NextRow>
DI void gemm128s(RowPtr rowptr, const bf16_t* __restrict__ Bt, int ldb, int K, unsigned char* smem, Epi epi, bool prefetched, bool has_next, NextRow nextrow, const bf16_t* __restrict__ nextBt) {
    LAS unsigned char* lds = (LAS unsigned char*)smem;
    const int tid = threadIdx.x, lane = tid & 63, wave = tid >> 6, wr = wave >> 1, wc = wave & 1, fr = lane & 15, fq = lane >> 4;
    const int schunk = ((tid & 7) ^ ((tid >> 4) & 7)) * 8;
    const bf16_t* ga[4];
#pragma unroll
    for (int i = 0; i < 4; ++i) ga[i] = rowptr(i * 32 + (tid >> 3)) + schunk;
    const bf16_t* gb = Bt + (size_t)(tid >> 3) * ldb + schunk;
    const size_t gbs = (size_t)32 * ldb;
    auto stage = [&](int kt, int s) {
#pragma unroll
        for (int i = 0; i < 4; ++i) {
            __builtin_amdgcn_global_load_lds((const unsigned*)(ga[i] + kt * 64), (LAS unsigned*)(lds + s * 32768 + (i * 256 + tid) * 16), 16, 0, 0);
            __builtin_amdgcn_global_load_lds((const unsigned*)(gb + i * gbs + kt * 64), (LAS unsigned*)(lds + s * 32768 + 16384 + (i * 256 + tid) * 16), 16, 0, 0);
        }
    };
    f32x4 acc[4][4];
#pragma unroll
    for (int m = 0; m < 4; ++m)
#pragma unroll
        for (int n = 0; n < 4; ++n) acc[m][n] = (f32x4){0.f, 0.f, 0.f, 0.f};
    const int nk = K >> 6;
    const int swz = (fr >> 1) & 7;
    const int aoff = (wr * 64 + fr) * 128, boff = 16384 + (wc * 64 + fr) * 128;
    if (!prefetched) stage(0, 0);
#pragma unroll 1
    for (int kt = 0; kt < nk; ++kt) {
        asm volatile("s_waitcnt vmcnt(0)" ::: "memory");
        __syncthreads();
        if (kt + 1 < nk) stage(kt + 1, (kt + 1) & 1);
        else if (has_next) {
#pragma unroll
            for (int i = 0; i < 4; ++i) {
                __builtin_amdgcn_global_load_lds((const unsigned*)(nextrow(i * 32 + (tid >> 3)) + schunk), (LAS unsigned*)(lds + (i * 256 + tid) * 16), 16, 0, 0);
                __builtin_amdgcn_global_load_lds((const unsigned*)(nextBt + (size_t)(tid >> 3) * ldb + schunk + i * gbs), (LAS unsigned*)(lds + 16384 + (i * 256 + tid) * 16), 16, 0, 0);
            }
        }
        const LAS unsigned char* cur = lds + (kt & 1) * 32768;
#pragma unroll
        for (int ks = 0; ks < 2; ++ks) {
            bf16x8 af[4], bfr[4];
            const int co = ((ks * 4 + fq) ^ swz) * 16;
#pragma unroll
            for (int m = 0; m < 4; ++m) af[m] = *(const LAS bf16x8*)(cur + aoff + m * 2048 + co);
#pragma unroll
            for (int n = 0; n < 4; ++n) bfr[n] = *(const LAS bf16x8*)(cur + boff + n * 2048 + co);
#pragma unroll
            for (int m = 0; m < 4; ++m)
#pragma unroll
                for (int n = 0; n < 4; ++n) acc[m][n] = TRANS ? __builtin_amdgcn_mfma_f32_16x16x32_bf16(bfr[n], af[m], acc[m][n], 0, 0, 0) : __builtin_amdgcn_mfma_f32_16x16x32_bf16(af[m], bfr[n], acc[m][n], 0, 0, 0);
        }
    }
    epi(acc, wr, wc, lane);
}

DI int vblock() { const int G = gridDim.x; return (G & 7) == 0 ? (int)(blockIdx.x & 7) * (G >> 3) + (int)(blockIdx.x >> 3) : (int)blockIdx.x; }
DI void tile_mn(int it, int nN, int& mt, int& nt) { const int per = 8 * nN, grp = it / per, idx = it - grp * per; nt = idx >> 3; mt = grp * 8 + (idx & 7); }

DI int rope_pos(int l) { return (l & ~63) + ((2 * ((l & 31) >> 4) + ((l >> 5) & 1)) << 4) + (l & 15); }
DI int rowmap(int kind, int n) {
    if (kind == 1) {
        if (n < 512 || (n >= 512 && n < 640) || (n >= 768 && n < 896) || (n >= 1024 && n < 1152)) return rope_pos(n);
        return n < 1304 ? n : n + 104;
    }
    if (kind == 4) return n < 2048 ? rope_pos(n) : n;
    if (kind == 2) return ((n >> 5) << 6) + (n & 31);
    if (kind == 3) return ((n >> 5) << 6) + 32 + (n & 31);
    return n;
}
DI void tr_tile(const float* __restrict__ src, int K, int N, bf16_t* __restrict__ dst, int kind, int kt, int nt, float* s) {
    const int tid = threadIdx.x, k0 = kt * 64, n0 = nt * 64;
    {
        const int nn = tid & 63, kq = tid >> 6, n = n0 + nn;
#pragma unroll
        for (int i = 0; i < 16; ++i) { const int kk = kq + 4 * i; s[kk * 65 + nn] = (n < N) ? src[(size_t)(k0 + kk) * N + n] : 0.f; }
    }
    __syncthreads();
    {
        const int rn = tid >> 2, kseg = (tid & 3) * 16, n = n0 + rn;
        if (n < N) {
            unsigned w[8];
#pragma unroll
            for (int i = 0; i < 8; ++i) w[i] = pk2(s[(kseg + 2 * i) * 65 + rn], s[(kseg + 2 * i + 1) * 65 + rn]);
            bf16_t* d = dst + (size_t)rowmap(kind, n) * K + k0 + kseg;
            *(uint4*)d = make_uint4(w[0], w[1], w[2], w[3]);
            *(uint4*)(d + 8) = make_uint4(w[4], w[5], w[6], w[7]);
        }
    }
    __syncthreads();
}
struct CF { float re, im; };
DI CF cmul(CF a, CF b) { return {a.re * b.re - a.im * b.im, a.re * b.im + a.im * b.re}; }
DI CF s5_apow(const Params& P, int g, int p, float tau) {
    const float step = expf(P.in[10][g]);
    const float lr = P.in[8][g * 64 + p], li = P.in[9][g * 64 + p];
    const float mag = expf(lr * step * tau);
    float sn, cs; sincosf(li * step * tau, &sn, &cs);
    return {mag * cs, mag * sn};
}
DI CF s5_f(const Params& P, int g, int p) {
    const CF a = s5_apow(P, g, p, 1.f);
    const float lr = P.in[8][g * 64 + p], li = P.in[9][g * 64 + p];
    const float den = lr * lr + li * li;
    return {((a.re - 1.f) * lr + a.im * li) / den, (a.im * lr - (a.re - 1.f) * li) / den};
}
DI void phase0(const Params& P, unsigned char* smem) {
    const int tid = threadIdx.x;
    unsigned char* ws = P.ws;
    float* sf = (float*)smem;
    constexpr int N_TR0 = 16 * 29, N_TR1 = 256, N_TR2 = 16 * 48, N_TR3 = 256, N_TR4 = 64, N_TR5 = 64, N_TR6 = 64, N_TR7 = 2, N_TR8 = 2;
    constexpr int N_TRG = 64 * 32, N_TRU = 64 * 32, N_TRD = 64 * 32;
    constexpr int N_X = NT * DM / 8192, N_ROPE = 512, N_CB = 16, N_AL = 8, N_BTE = 256, N_BTYM = 32 * 63, N_BTYQ = 4096, N_ZP = 13;
    constexpr int N_RW = 2 * 36864 / 256;
    constexpr int TOTAL = N_RW + N_TR0 + N_TR1 + N_TR4 + N_TR5 + N_TR6 + N_TR7 + N_TR8 + N_X + N_ROPE + N_CB + N_AL + N_BTE + N_BTYM + N_BTYQ + N_ZP;
    for (int it0 = blockIdx.x; it0 < TOTAL; it0 += gridDim.x) {
        int it = it0;
        if (it < N_RW) {
            const int e = it * 256 + tid, layer = e / 36864, r = e % 36864;
            float* dst = (float*)(ws + WS_RTRW) + (size_t)layer * 36864;
            if (r < 4096) { const int o = r & 3, l = (r >> 2) & 63, jk = r >> 8, d = 4 * l + 256 * (jk >> 2) + (jk & 3); dst[r] = P.in[25][((size_t)layer * 1024 + d) * 4 + o]; }
            else { const int q = r - 4096, o = q & 3, l = (q >> 2) & 63, hf = (q >> 8) & 1, jk = (q >> 9) & 15, g = q >> 13, d = 4 * l + 256 * (jk >> 2) + (jk & 3);
                   dst[r] = P.in[27][(((size_t)layer * 4 + g) * 1024 + d) * 8 + hf * 4 + o]; }
            continue;
        } it -= N_RW;
        if (it < N_TR0) { tr_tile(P.in[1], 1024, 1816, (bf16_t*)(ws + WS_WIN0), 1, it / 29, it % 29, sf); continue; } it -= N_TR0;
        if (it < N_TR1) { tr_tile(P.in[18], 1024, 1024, (bf16_t*)(ws + WS_WOUT0), 0, it / 16, it % 16, sf); continue; } it -= N_TR1;
        if (it < N_TR4) { tr_tile(P.in[16], 512, 512, (bf16_t*)(ws + WS_WGLU), 0, it / 8, it % 8, sf); continue; } it -= N_TR4;
        if (it < N_TR5) { tr_tile(P.in[4], 2048, 128, (bf16_t*)(ws + WS_WCK1), 0, it / 2, it % 2, sf); continue; } it -= N_TR5;
        if (it < N_TR6) { tr_tile(P.in[6], 2048, 128, (bf16_t*)(ws + WS_WCV1), 0, it / 2, it % 2, sf); continue; } it -= N_TR6;
        if (it < N_TR7) { tr_tile(P.in[5], 128, 64, (bf16_t*)(ws + WS_WCK2), 0, it, 0, sf); continue; } it -= N_TR7;
        if (it < N_TR8) { tr_tile(P.in[7], 128, 64, (bf16_t*)(ws + WS_WCV2), 0, it, 0, sf); continue; } it -= N_TR8;
        if (it < N_X) {
            const float* x = P.in[0]; bf16_t* xb = (bf16_t*)(ws + WS_ACTB);
#pragma unroll
            for (int i = 0; i < 4; ++i) {
                const size_t idx = (size_t)it * 8192 + i * 2048 + tid * 8;
                const f32x4 a = __builtin_nontemporal_load((const f32x4*)(x + idx)), b = __builtin_nontemporal_load((const f32x4*)(x + idx + 4));
                *(uint4*)(xb + idx) = make_uint4(pk2(a.x, a.y), pk2(a.z, a.w), pk2(b.x, b.y), pk2(b.z, b.w));
            }
            continue;
        } it -= N_X;
        if (it < N_ROPE) {
            const int e = it * 256 + tid, pos = e >> 5, i = e & 31;
            const float inv = 1.0f / powf(10000.0f, (float)(2 * i) / 64.0f);
            const float ang = (float)pos * inv;
            ((float*)(ws + WS_ROPE))[e] = (float)cos((double)ang);
            ((float*)(ws + WS_ROPE))[4096 * 32 + e] = (float)sin((double)ang);
            continue;
        } it -= N_ROPE;
        if (it < N_CB) {
            const int kv = it >> 3, j0 = (it & 7) * 16, j = j0 + (tid & 15), sl = tid >> 4;
            const float* pe = P.in[kv ? 3 : 2]; const float* w1 = P.in[kv ? 6 : 4];
            float a = 0.f;
            for (int i = sl * 128; i < sl * 128 + 128; ++i) a += pe[i] * w1[(size_t)i * 128 + j];
            sf[tid] = a; __syncthreads();
            if (tid < 16) { float t = 0.f; for (int q = 0; q < 16; ++q) t += sf[q * 16 + tid]; ((float*)(ws + WS_CBIAS))[kv * 128 + j0 + tid] = t; }
            __syncthreads();
            continue;
        } it -= N_CB;
        if (it < N_AL) {
            const int e = it * 256 + tid, g = e >> 6, p = e & 63;
            const CF a = s5_apow(P, g, p, 32.f);
            ((float*)(ws + WS_S5AL))[e * 2] = a.re; ((float*)(ws + WS_S5AL))[e * 2 + 1] = a.im;
            continue;
        } it -= N_AL;
        if (it < N_BTE) {
            const int e = it * 256 + tid, g = e >> 11, p = (e >> 5) & 63, r = e & 31;
            const CF w = cmul(s5_apow(P, g, p, (float)(31 - r)), s5_f(P, g, p));
            bf16_t* d = (bf16_t*)(ws + WS_BTE) + (size_t)g * 128 * 512;
#pragma unroll
            for (int c = 0; c < 16; ++c) {
                const CF bb = {P.in[11][(g * 64 + p) * 16 + c], P.in[12][(g * 64 + p) * 16 + c]};
                const CF v = cmul(w, bb);
                d[(size_t)p * 512 + r * 16 + c] = f2bf(v.re);
                d[(size_t)(64 + p) * 512 + r * 16 + c] = f2bf(v.im);
            }
            continue;
        } it -= N_BTE;
        if (it < N_BTYM) {
            const int g = it / 63, dd = it % 63 - 31, ch = tid >> 4, c = tid & 15;
            float val = 0.f;
            if (dd >= 0) {
                float* sw = sf; float* sb = sf + 128; float* sc = sf + 128 + 2048;
                if (tid < 64) { const CF w = cmul(s5_apow(P, g, tid, (float)dd), s5_f(P, g, tid)); sw[2 * tid] = w.re; sw[2 * tid + 1] = w.im; }
#pragma unroll
                for (int i = 0; i < 4; ++i) {
                    const int e = tid + 256 * i;
                    sb[2 * e] = P.in[11][(size_t)g * 1024 + e]; sb[2 * e + 1] = P.in[12][(size_t)g * 1024 + e];
                    sc[2 * e] = P.in[13][(size_t)g * 1024 + e]; sc[2 * e + 1] = P.in[14][(size_t)g * 1024 + e];
                }
                __syncthreads();
#pragma unroll 8
                for (int p = 0; p < 64; ++p) {
                    const CF bb = {sb[2 * (p * 16 + c)], sb[2 * (p * 16 + c) + 1]};
                    const CF cc = {sc[2 * (ch * 64 + p)], sc[2 * (ch * 64 + p) + 1]};
                    const CF w = {sw[2 * p], sw[2 * p + 1]};
                    val += cmul(cc, cmul(w, bb)).re;
                }
                __syncthreads();
            }
            bf16_t* d = (bf16_t*)(ws + WS_BTY) + (size_t)g * 512 * 640;
            const bf16_t hv = f2bf(val);
            for (int r = 0; r < 32; ++r) { const int s = r + dd; if (s >= 0 && s < 32) d[(size_t)(s * 16 + ch) * 640 + r * 16 + c] = hv; }
            continue;
        } it -= N_BTYM;
        if (it < N_BTYQ) {
            const int e = it * 256 + tid, g = e >> 15, s = (e >> 10) & 31, ch = (e >> 6) & 15, p = e & 63;
            const CF cc = {P.in[13][(g * 16 + ch) * 64 + p], P.in[14][(g * 16 + ch) * 64 + p]};
            const CF w = cmul(cc, s5_apow(P, g, p, (float)(s + 1)));
            bf16_t* d = (bf16_t*)(ws + WS_BTY) + ((size_t)g * 512 + s * 16 + ch) * 640 + 512;
            d[p] = f2bf(w.re); d[64 + p] = f2bf(-w.im);
            continue;
        } it -= N_BTYQ;
        {
            uint4* d = (uint4*)((bf16_t*)(ws + WS_WIN0) + (size_t)(1304 + it * 8) * 1024);
#pragma unroll
            for (int i = 0; i < 4; ++i) d[i * 256 + tid] = make_uint4(0, 0, 0, 0);
        }
    }
}

DI void phase_inproj0(const Params& P, unsigned char* smem) {
    unsigned char* ws = P.ws;
    const bf16_t* A = (const bf16_t*)(ws + WS_ACTB);
    const float* cosT = (const float*)(ws + WS_ROPE);
    const float* sinT = cosT + 4096 * 32;
    constexpr int NTN = NIN0 / 128;
    bool pre = false;
    for (int it = vblock(); it < (NT / 128) * NTN; it += gridDim.x) {
        int mt, nt; tile_mn(it, NTN, mt, nt);
        const int m0 = mt * 128;
        auto rowptr = [=](int r) { return A + (size_t)(m0 + r) * 1024; };
        const bf16_t* Bt = (const bf16_t*)(ws + WS_WIN0) + (size_t)nt * 128 * 1024;
        const bool hn = it + (int)gridDim.x < (NT / 128) * NTN;
        int mtn = 0, ntn = 0; if (hn) tile_mn(it + gridDim.x, NTN, mtn, ntn);
        auto nextrow = [=](int r) { return A + (size_t)(mtn * 128 + r) * 1024; };
        const bf16_t* nBt = (const bf16_t*)(ws + WS_WIN0) + (size_t)ntn * 128 * 1024;
        if (nt == 7 || nt == 9) {
            auto epi = [=](f32x4 (&acc)[4][4], int wr, int wc, int lane) {
                const int fr = lane & 15, fq = lane >> 4, which = nt == 7 ? 3 : 5, g = wc;
#pragma unroll
                for (int m = 0; m < 4; ++m) {
                    const int t = m0 + wr * 64 + m * 16 + fq * 4, s = t & 4095, b = t >> 12;
                    bf16_t* dst = (bf16_t*)(ws + XP_KC + (size_t)which * KVSZ) + (size_t)(b * 2 + g) * 4096 * 64;
#pragma unroll
                    for (int n = 0; n < 4; ++n) *(u32x2*)(dst + vp_off(s, n * 16 + fr)) = cvt4(acc[m][n]);
                }
            };
            gemm128s<false>(rowptr, Bt, 1024, 1024, smem, epi, pre, hn, nextrow, nBt);
            pre = hn;
            continue;
        }
        auto epi = [=](f32x4 (&acc)[4][4], int wr, int wc, int lane) {
            const int u64 = nt * 2 + wc, fr = lane & 15, fq = lane >> 4;
#pragma unroll
            for (int m = 0; m < 4; ++m) {
                const int t = m0 + wr * 64 + m * 16 + fr, s = t & 4095, b = t >> 12;
                if (u64 < 20) {
                    const bool isq = u64 < 8;
                    const int which = (u64 - 8) >> 1, g = (u64 - 8) & 1;
                    if (isq || ((which & 1) == 0)) {
#pragma unroll
                        for (int n2 = 0; n2 < 2; ++n2) {
                            const int i = n2 * 16 + fq * 4;
                            const f32x4 c = *(const f32x4*)(cosT + s * 32 + i), sn = *(const f32x4*)(sinT + s * 32 + i);
                            const f32x4 x1 = acc[m][2 * n2], x2 = acc[m][2 * n2 + 1];
                            const u32x2 o1 = cvt4(x1 * c - x2 * sn), o2 = cvt4(x1 * sn + x2 * c);
                            if (isq) { bf16_t* dst = (bf16_t*)(ws + XP_Q0) + (size_t)t * 512 + u64 * 64; *(u32x2*)(dst + i) = o1; *(u32x2*)(dst + i + 32) = o2; }
                            else {
                                bf16_t* dst = (bf16_t*)(ws + XP_KC + (size_t)which * KVSZ) + (size_t)(b * 2 + g) * 4096 * 64;
                                if (which == 0) { *(u32x2*)(dst + (size_t)s * 64 + i) = o1; *(u32x2*)(dst + (size_t)s * 64 + i + 32) = o2; }
                                else { *(u32x2*)(dst + kp_off(s, i)) = o1; *(u32x2*)(dst + kp_off(s, i + 32)) = o2; }
                            }
                        }
                    } else {
                        bf16_t* dst = (bf16_t*)(ws + XP_KC + (size_t)which * KVSZ) + ((size_t)(b * 2 + g) * 4096 + s) * 64;
#pragma unroll
                        for (int n = 0; n < 4; ++n) *(u32x2*)(dst + n * 16 + fq * 4) = cvt4(acc[m][n]);
                    }
                } else if (u64 == 20) {
#pragma unroll
                    for (int n = 0; n < 2; ++n) {
                        const int c0 = n * 16 + fq * 4;
                        if (c0 < 24) { f32x4 o; o.x = sigmoidf_(acc[m][n].x); o.y = sigmoidf_(acc[m][n].y); o.z = sigmoidf_(acc[m][n].z); o.w = sigmoidf_(acc[m][n].w); *(f32x4*)((float*)(ws + XP_GATES) + (size_t)t * 24 + c0) = o; }
                    }
                } else if (u64 >= 22) {
#pragma unroll
                    for (int n = 0; n < 4; ++n) {
                        const int g5 = (u64 - 22) * 4 + n;
                        *(u32x2*)((bf16_t*)(ws + XP_AEXT) + ((size_t)g5 * 1024 + (t >> 5)) * 640 + (t & 31) * 16 + fq * 4) = cvt4(acc[m][n]);
                    }
                }
            }
        };
        gemm128s(rowptr, Bt, 1024, 1024, smem, epi, pre, hn, nextrow, nBt);
        pre = hn;
    }
}

constexpr int N_LATE = 16 * 48 + 256 + 3 * 64 * 32;
DI void late_weights(const Params& P, unsigned char* smem, int it) {
    unsigned char* ws = P.ws;
    float* sf = (float*)smem;
    constexpr int N_TR2 = 16 * 48, N_TR3 = 256, N_TRG = 64 * 32, N_TRU = 64 * 32;
    if (it < N_TR2) { tr_tile(P.in[19], 1024, 3072, (bf16_t*)(ws + WS_WIN1), 4, it / 48, it % 48, sf); return; } it -= N_TR2;
    if (it < N_TR3) { tr_tile(P.in[20], 1024, 1024, (bf16_t*)(ws + WS_WOUT1), 0, it / 16, it % 16, sf); return; } it -= N_TR3;
    if (it < N_TRG) { const int mat = it >> 5, r = it & 31; tr_tile(P.in[29] + (size_t)mat * 1024 * 128, 1024, 128, (bf16_t*)(ws + WS_WGU) + (size_t)mat * 256 * 1024, 2, r >> 1, r & 1, sf); return; } it -= N_TRG;
    if (it < N_TRU) { const int mat = it >> 5, r = it & 31; tr_tile(P.in[30] + (size_t)mat * 1024 * 128, 1024, 128, (bf16_t*)(ws + WS_WGU) + (size_t)mat * 256 * 1024, 3, r >> 1, r & 1, sf); return; } it -= N_TRU;
    { const int mat = it >> 5, r = it & 31; tr_tile(P.in[31] + (size_t)mat * 128 * 1024, 128, 1024, (bf16_t*)(ws + WS_WDN) + (size_t)mat * 1024 * 128, 0, r >> 4, r & 15, sf); }
}

DI void s5y_tile(const Params& P, unsigned char* smem, int g, int mt, int nt);
DI void phase_cmp_s5e(const Params& P, unsigned char* smem) {
    unsigned char* ws = P.ws;
    const int tid = threadIdx.x, lane = tid & 63, wave = tid >> 6;
    const int G = gridDim.x, bid = blockIdx.x;
    const bool split = G >= 384;
    const int nmine = !split ? (320 + N_LATE + G - 1 - bid) / G : (bid < 320 ? 1 : (N_LATE + (G - 320) - 1 - (bid - 320)) / (G - 320));
    for (int k = 0; k < nmine; ++k) {
        const int it = !split ? bid + k * G : (bid < 320 ? bid : 320 + (bid - 320) + k * (G - 320));
        if (it >= 64 + 256) { late_weights(P, smem, it - 320); continue; }
        if (it < 64) {
            const int kv = it >> 5, bg = (it >> 1) & 15, mt = it & 1;
            const bf16_t* src = (const bf16_t*)(ws + XP_KC + (size_t)kv * KVSZ) + (size_t)bg * 4096 * 64;
            const float* cb = (const float*)(ws + WS_CBIAS) + kv * 128;
            bf16_t* sH = (bf16_t*)smem;
            auto rowptr = [=](int r) { int rr = mt * 128 + r; rr = rr > 254 ? 254 : rr; return src + (size_t)rr * 1024; };
            auto epi = [=](f32x4 (&acc)[4][4], int wr, int wc, int ln) {
                const int fr = ln & 15, fq = ln >> 4;
#pragma unroll
                for (int m = 0; m < 4; ++m)
#pragma unroll
                    for (int n = 0; n < 4; ++n)
#pragma unroll
                        for (int j = 0; j < 4; ++j) {
                            const int r = wr * 64 + m * 16 + fr, c = wc * 64 + n * 16 + fq * 4 + j;
                            sH[r * 136 + c] = f2bf(gelu_tanh(acc[m][n][j] + cb[c]));
                        }
            };
            gemm128(rowptr, (const bf16_t*)(ws + (kv ? WS_WCV1 : WS_WCK1)), 2048, 2048, smem, epi);
            __syncthreads();
            const bf16_t* W2 = (const bf16_t*)(ws + (kv ? WS_WCV2 : WS_WCK2));
            f32x4 a2[2][4];
#pragma unroll
            for (int m = 0; m < 2; ++m)
#pragma unroll
                for (int n = 0; n < 4; ++n) a2[m][n] = (f32x4){0.f, 0.f, 0.f, 0.f};
#pragma unroll
            for (int ks = 0; ks < 4; ++ks) {
                bf16x8 af[2], bfr[4];
#pragma unroll
                for (int m = 0; m < 2; ++m) af[m] = *(const bf16x8*)(sH + (wave * 32 + m * 16 + (lane & 15)) * 136 + ks * 32 + (lane >> 4) * 8);
#pragma unroll
                for (int n = 0; n < 4; ++n) bfr[n] = *(const bf16x8*)(W2 + (n * 16 + (lane & 15)) * 128 + ks * 32 + (lane >> 4) * 8);
#pragma unroll
                for (int m = 0; m < 2; ++m)
#pragma unroll
                    for (int n = 0; n < 4; ++n) a2[m][n] = __builtin_amdgcn_mfma_f32_16x16x32_bf16(af[m], bfr[n], a2[m][n], 0, 0, 0);
            }
            bf16_t* dst = (bf16_t*)(ws + (kv ? WS_VCMP : WS_KCMP)) + (size_t)bg * 256 * 64;
#pragma unroll
            for (int m = 0; m < 2; ++m)
#pragma unroll
                for (int n = 0; n < 4; ++n)
#pragma unroll
                    for (int j = 0; j < 4; ++j) {
                        const int row = mt * 128 + wave * 32 + m * 16 + (lane >> 4) * 4 + j, col = n * 16 + (lane & 15);
                        dst[kv ? vp_off(row, col) : kp_off(row, col)] = row < 255 ? f2bf(a2[m][n][j]) : (bf16_t)0;
                    }
            __syncthreads();
        } else {
            const int it2 = it - 64, g = it2 >> 3, b = it2 & 7;
            bf16_t* aext = (bf16_t*)(ws + XP_AEXT) + ((size_t)g * 1024 + b * 128) * 640;
            float* sE = (float*)smem;
            auto rowptr = [=](int r) { return (const bf16_t*)aext + (size_t)r * 640; };
            auto epi = [=](f32x4 (&acc)[4][4], int wr, int wc, int ln) {
                const int fr = ln & 15, fq = ln >> 4;
#pragma unroll
                for (int m = 0; m < 4; ++m)
#pragma unroll
                    for (int n = 0; n < 4; ++n)
#pragma unroll
                        for (int j = 0; j < 4; ++j) sE[(wr * 64 + m * 16 + fr) * 129 + wc * 64 + n * 16 + fq * 4 + j] = acc[m][n][j];
            };
            gemm128(rowptr, (const bf16_t*)(ws + WS_BTE) + (size_t)g * 128 * 512, 512, 512, smem, epi);
            __syncthreads();
            {
                const int p = tid & 63, c0 = wave * 32;
                const float ar = ((const float*)(ws + WS_S5AL))[(g * 64 + p) * 2], ai = ((const float*)(ws + WS_S5AL))[(g * 64 + p) * 2 + 1];
                float* send = (float*)(smem + 128 * 129 * 4);
                float xr = 0.f, xi = 0.f;
                for (int c = c0; c < c0 + 32; ++c) {
                    const float er = sE[c * 129 + p], ei = sE[c * 129 + 64 + p];
                    const float nr = ar * xr - ai * xi + er, ni = ar * xi + ai * xr + ei;
                    xr = nr; xi = ni;
                }
                send[(wave * 64 + p) * 2] = xr; send[(wave * 64 + p) * 2 + 1] = xi;
                float qr = ar, qi = ai;
#pragma unroll
                for (int k = 0; k < 5; ++k) { const float tr = qr * qr - qi * qi, ti = 2.f * qr * qi; qr = tr; qi = ti; }
                __syncthreads();
                xr = 0.f; xi = 0.f;
                for (int k = 0; k < wave; ++k) {
                    const float er = send[(k * 64 + p) * 2], ei = send[(k * 64 + p) * 2 + 1];
                    const float nr = qr * xr - qi * xi + er, ni = qr * xi + qi * xr + ei;
                    xr = nr; xi = ni;
                }
                for (int c = c0; c < c0 + 32; ++c) {
                    aext[(size_t)c * 640 + 512 + p] = f2bf(xr);
                    aext[(size_t)c * 640 + 576 + p] = f2bf(xi);
                    const float er = sE[c * 129 + p], ei = sE[c * 129 + 64 + p];
                    const float nr = ar * xr - ai * xi + er, ni = ar * xi + ai * xr + ei;
                    xr = nr; xi = ni;
                }
            }
            asm volatile("s_waitcnt vmcnt(0)" ::: "memory");
            __syncthreads();
#pragma unroll 1
            for (int nt = 0; nt < 4; ++nt) s5y_tile(P, smem, g, b, nt);
        }
    }
}

DI void s5y_tile(const Params& P, unsigned char* smem, int g, int mt, int nt) {
    unsigned char* ws = P.ws;
    const bf16_t* aext = (const bf16_t*)(ws + XP_AEXT) + (size_t)g * 1024 * 640;
    const float* dsk = P.in[15];
    auto rowptr = [=](int r) { return aext + (size_t)(mt * 128 + r) * 640; };
    auto epi = [=](f32x4 (&acc)[4][4], int wr, int wc, int ln) {
        const int fr = ln & 15, fq = ln >> 4;
        const f32x4 dk = *(const f32x4*)(dsk + g * 16 + fq * 4);
#pragma unroll
        for (int m = 0; m < 4; ++m) {
            const int cr = mt * 128 + wr * 64 + m * 16 + fr;
#pragma unroll
            for (int n = 0; n < 4; ++n) {
                const int sp = nt * 8 + wc * 4 + n, t = cr * 32 + sp;
                const f32x4 u = bf4_to_f(*(const u32x2*)(aext + (size_t)cr * 640 + sp * 16 + fq * 4));
                const f32x4 y = acc[m][n] + dk * u;
                *(u32x2*)((bf16_t*)(ws + XP_G5) + (size_t)t * 512 + g * 16 + fq * 4) = cvt4((f32x4){gelu_tanh(y.x), gelu_tanh(y.y), gelu_tanh(y.z), gelu_tanh(y.w)});
            }
        }
    };
    gemm128(rowptr, (const bf16_t*)(ws + WS_BTY) + ((size_t)g * 512 + nt * 128) * 640, 640, 640, smem, epi, 2 * nt + 2, 8);
}
struct FA { f32x16 o0, o1; float m, l; };
DI void fa_init(FA& st) {
#pragma unroll
    for (int i = 0; i < 16; ++i) { st.o0[i] = 0.f; st.o1[i] = 0.f; }
    st.m = -1e30f; st.l = 0.f;
}
constexpr float FA_THR = 8.f;
template <int MODE, class Valid>
DI void fa_tile(FA& st, const bf16x8 (&qf)[4], const LAS bf16_t* Kt, const LAS bf16_t* Vt, int r, int h, float c, bool rowok, Valid valid) {
    const LAS bf16_t* kb = Kt + r * 16 + 8 * h;
    const LAS bf16_t* vb = Vt + r * 16 + 8 * h;
    bf16x8 kf[4], vf[4];
#pragma unroll
    for (int ks = 0; ks < 4; ++ks) kf[ks] = *(const LAS bf16x8*)(kb + ks * 512);
#pragma unroll
    for (int sub = 0; sub < 2; ++sub) {
        f32x16 acc;
#pragma unroll
        for (int i = 0; i < 16; ++i) acc[i] = 0.f;
#pragma unroll
        for (int ks = 0; ks < 4; ++ks) acc = MFMA32(kf[ks], qf[ks], acc);
#pragma unroll
        for (int s2 = 0; s2 < 2; ++s2) { vf[2 * s2] = *(const LAS bf16x8*)(vb + ((sub * 2 + s2) * 64) * 16); vf[2 * s2 + 1] = *(const LAS bf16x8*)(vb + ((sub * 2 + s2) * 64 + 32) * 16); }
        if (sub == 0) {
#pragma unroll
            for (int ks = 0; ks < 4; ++ks) kf[ks] = *(const LAS bf16x8*)(kb + (4 + ks) * 512);
        }
        __builtin_amdgcn_sched_barrier(0);
        float mx = -INFINITY;
#pragma unroll
        for (int i = 0; i < 16; ++i) {
            if (MODE == 2) { const int koff = sub * 32 + (i & 3) + 8 * (i >> 2) + 4 * h; acc[i] = valid(koff) ? acc[i] : -INFINITY; }
            mx = fmaxf(mx, acc[i]);
        }
        {
            const auto sw = __builtin_amdgcn_permlane32_swap(__float_as_uint(mx), __float_as_uint(mx), false, false);
            mx = fmaxf(__uint_as_float(sw[0]), __uint_as_float(sw[1]));
        }
        const float cand = mx * c;
        const bool upd = cand > st.m + FA_THR;
        if (__ballot(upd)) {
            const float mn = upd ? cand : st.m, alpha = __builtin_amdgcn_exp2f(st.m - mn);
            st.m = mn; st.l *= alpha;
#pragma unroll
            for (int i = 0; i < 16; ++i) { st.o0[i] *= alpha; st.o1[i] *= alpha; }
        }
        const float nb = (MODE == 1 && !rowok) ? -INFINITY : -st.m;
        float ps0 = 0.f, ps1 = 0.f;
#pragma unroll
        for (int i = 0; i < 16; i += 2) {
            acc[i] = __builtin_amdgcn_exp2f(__builtin_fmaf(acc[i], c, nb));
            acc[i + 1] = __builtin_amdgcn_exp2f(__builtin_fmaf(acc[i + 1], c, nb));
            ps0 += acc[i]; ps1 += acc[i + 1];
        }
        st.l += ps0 + ps1;
#pragma unroll
        for (int s2 = 0; s2 < 2; ++s2) {
            const bf16x8 pk = cvt8((f32x8){acc[8 * s2], acc[8 * s2 + 1], acc[8 * s2 + 2], acc[8 * s2 + 3], acc[8 * s2 + 4], acc[8 * s2 + 5], acc[8 * s2 + 6], acc[8 * s2 + 7]});
            st.o0 = MFMA32(vf[2 * s2], pk, st.o0);
            st.o1 = MFMA32(vf[2 * s2 + 1], pk, st.o1);
        }
    }
}
DI void fa_issue(const bf16_t* gK, const bf16_t* gV, LAS unsigned char* buf, int tid) {
    __builtin_amdgcn_global_load_lds((const unsigned*)(gK + tid * 8), (LAS unsigned*)(buf + tid * 16), 16, 0, 0);
    __builtin_amdgcn_global_load_lds((const unsigned*)(gK + (tid + 256) * 8), (LAS unsigned*)(buf + (tid + 256) * 16), 16, 0, 0);
    __builtin_amdgcn_global_load_lds((const unsigned*)(gV + tid * 8), (LAS unsigned*)(buf + 8192 + tid * 16), 16, 0, 0);
    __builtin_amdgcn_global_load_lds((const unsigned*)(gV + (tid + 256) * 8), (LAS unsigned*)(buf + 8192 + (tid + 256) * 16), 16, 0, 0);
}
DI void fa_wait(int j, int n) {
    const int rem = n - 1 - j;
    if (rem >= 2) asm volatile("s_waitcnt vmcnt(8)" ::: "memory");
    else if (rem == 1) asm volatile("s_waitcnt vmcnt(4)" ::: "memory");
    else asm volatile("s_waitcnt vmcnt(0)" ::: "memory");
    __builtin_amdgcn_s_barrier();
    asm volatile("" ::: "memory");
}

constexpr int NSA_LDS_IMP = 65536;
constexpr int NSA_LDS_SCS = NSA_LDS_IMP + 8192;
constexpr int NSA_LDS_MSK = NSA_LDS_SCS + 1024;
DI void phase_nsa(const Params& P, unsigned char* smem) {
    unsigned char* ws = P.ws;
    const int tid = threadIdx.x, lane = tid & 63, wave = tid >> 6, r = lane & 31, h = lane >> 5;
    const float c = 0.125f * 1.4426950408889634f;
    LAS unsigned char* lds = (LAS unsigned char*)smem;
    float* impw = (float*)(smem + NSA_LDS_IMP) + wave * 512;
    float* scs = (float*)(smem + NSA_LDS_SCS) + wave * 64;
    unsigned long long* mskw = (unsigned long long*)(smem + NSA_LDS_MSK) + wave * 8;
    for (int it = blockIdx.x; it < 2048; it += gridDim.x) {
        const int qt = 127 - (it >> 4), bg = it & 15, b = bg >> 1, g = bg & 1, t0 = qt * 32, qblk = t0 >> 6;
        const int ql = r >> 2, z = r & 3, s = t0 + wave * 8 + ql, t = b * 4096 + s;
        const bf16_t* Qg = (const bf16_t*)(ws + XP_Q0) + (size_t)t * 512 + (g * 4 + z) * 64;
        bf16x8 qf[4];
#pragma unroll
        for (int ks = 0; ks < 4; ++ks) qf[ks] = *(const bf16x8*)(Qg + ks * 16 + 8 * h);
        const float* gt = (const float*)(ws + XP_GATES) + (size_t)t * 24 + (g * 4 + z) * 3;
        const float g_c = gt[0], g_s = gt[1], g_w = gt[2];
        const bf16_t* Kc = (const bf16_t*)(ws + WS_KCMP) + (size_t)bg * 256 * 64;
        const bf16_t* Vc = (const bf16_t*)(ws + WS_VCMP) + (size_t)bg * 256 * 64;
        const bf16_t* Ks = (const bf16_t*)(ws + XP_KC + 2 * KVSZ) + (size_t)bg * 4096 * 64;
        const bf16_t* Vs = (const bf16_t*)(ws + XP_KC + 3 * KVSZ) + (size_t)bg * 4096 * 64;
        const bf16_t* Kw = (const bf16_t*)(ws + XP_KC + 4 * KVSZ) + (size_t)bg * 4096 * 64;
        const bf16_t* Vw = (const bf16_t*)(ws + XP_KC + 5 * KVSZ) + (size_t)bg * 4096 * 64;
        const int nct = ((t0 >> 4) + 1 + 63) >> 6;
        const int w0 = (t0 - 255) < 0 ? 0 : (t0 - 255) >> 6;
        const int e1 = nct, e2 = 2 * nct, e3 = e2 + qblk + 1, e4 = e3 + (qblk - w0 + 1);
        const int nc = s >= 31 ? ((s - 31) >> 4) + 1 : 0;
        const int s_lo = t0 + wave * 8, s_hi = s_lo + 7, nc_min = s_lo >= 31 ? ((s_lo - 31) >> 4) + 1 : 0;
        for (int i = lane; i < 512; i += 64) impw[i] = 0.f;
        auto tile_ptrs = [&](int i, const bf16_t*& gk, const bf16_t*& gv) {
            if (i < e1) { gk = Kc + (size_t)i * 4096; gv = Vc + (size_t)i * 4096; }
            else if (i < e2) { gk = Kc + (size_t)(i - e1) * 4096; gv = Vc + (size_t)(i - e1) * 4096; }
            else if (i < e3) { gk = Ks + (size_t)(i - e2) * 4096; gv = Vs + (size_t)(i - e2) * 4096; }
            else { gk = Kw + (size_t)(w0 + i - e3) * 4096; gv = Vw + (size_t)(w0 + i - e3) * 4096; }
        };
        FA st; fa_init(st);
        f32x16 out0, out1;
#pragma unroll
        for (int i = 0; i < 16; ++i) { out0[i] = 0.f; out1[i] = 0.f; }
        float m_c = -1e30f, il_c = 0.f;
        unsigned long long mymask = 0ull;
        asm volatile("s_waitcnt vmcnt(0)" ::: "memory");
        __builtin_amdgcn_s_barrier();
#pragma unroll
        for (int i = 0; i < 3; ++i) if (i < e4) { const bf16_t *gk, *gv; tile_ptrs(i, gk, gv); fa_issue(gk, gv, lds + i * 16384, tid); }
        for (int i = 0; i < e4; ++i) {
            fa_wait(i, e4);
            if (i + 3 < e4) { const bf16_t *gk, *gv; tile_ptrs(i + 3, gk, gv); fa_issue(gk, gv, lds + ((i + 3) & 3) * 16384, tid); }
            const LAS bf16_t* cur = (const LAS bf16_t*)(lds + (i & 3) * 16384);
            if (i < e1) {
                const int nb = i * 64;
                { if (nb + 63 < nc_min) fa_tile<0>(st, qf, cur, cur + 4096, r, h, c, true, [=](int) { return true; }); else fa_tile<2>(st, qf, cur, cur + 4096, r, h, c, true, [=](int koff) { return nb + koff < nc; }); }
                if (i == e1 - 1) {
                    const float l = st.l + __shfl_xor(st.l, 32);
                    il_c = 1.f / fmaxf(l, 1e-30f); m_c = st.m;
                    const float f = g_c * il_c;
#pragma unroll
                    for (int k = 0; k < 16; ++k) { out0[k] = st.o0[k] * f; out1[k] = st.o1[k] * f; }
                    fa_init(st);
                }
            } else if (i < e2) {
                const int nb = (i - e1) * 64;
#pragma unroll
                for (int sub = 0; sub < 2; ++sub) {
                    f32x16 acc;
#pragma unroll
                    for (int k = 0; k < 16; ++k) acc[k] = 0.f;
#pragma unroll
                    for (int ks = 0; ks < 4; ++ks) acc = MFMA32(*(const LAS bf16x8*)(cur + ((sub * 4 + ks) * 32 + r) * 16 + 8 * h), qf[ks], acc);
#pragma unroll
                    for (int q4 = 0; q4 < 4; ++q4) {
                        float p[4];
#pragma unroll
                        for (int k = 0; k < 4; ++k) {
                            const int n = nb + sub * 32 + 8 * q4 + 4 * h + k;
                            p[k] = (n < nc) ? __builtin_amdgcn_exp2f(acc[4 * q4 + k] * c - m_c) * il_c : 0.f;
                        }
                        float a = (p[0] + p[1]) + (p[2] + 0.5f * p[3]), cn = 0.5f * p[3];
                        a += __shfl_xor(a, 1); a += __shfl_xor(a, 2);
                        cn += __shfl_xor(cn, 1); cn += __shfl_xor(cn, 2);
                        const int jb = ((nb + sub * 32) >> 2) + 2 * q4 + h;
                        if (z == 0) { atomicAdd(&impw[ql * 64 + jb], a); if (jb + 1 < 64) atomicAdd(&impw[ql * 64 + jb + 1], cn); }
                    }
                }
                if (i == e2 - 1) {
                    __builtin_amdgcn_wave_barrier();
#pragma unroll 1
                    for (int qq = 0; qq < 8; ++qq) {
                        const int j = lane;
                        const float imp = impw[qq * 64 + j];
                        const float score = (j > qblk) ? -1.f : ((j == 0 || j == qblk || j == qblk - 1) ? 1e3f : imp);
                        scs[j] = score;
                        __builtin_amdgcn_wave_barrier();
                        int rank = 0;
#pragma unroll 8
                        for (int jj = 0; jj < 64; ++jj) { const float o = scs[jj]; rank += (o > score || (o == score && jj < j)) ? 1 : 0; }
                        const unsigned long long mk = __ballot(rank < 8 && score >= 0.f);
                        if (lane == 0) mskw[qq] = mk;
                        __builtin_amdgcn_wave_barrier();
                    }
                    mymask = mskw[ql];
                }
            } else if (i < e3) {
                const int j = i - e2;
                const bool sel = (mymask >> j) & 1ull;
                if (__ballot(sel)) {
                    if (j < qblk) fa_tile<1>(st, qf, cur, cur + 4096, r, h, c, sel, [=](int) { return true; });
                    else { const int kb = j * 64; fa_tile<2>(st, qf, cur, cur + 4096, r, h, c, true, [=](int koff) { return sel && (kb + koff <= s); }); }
                }
                if (i == e3 - 1) {
                    const float l = st.l + __shfl_xor(st.l, 32);
                    const float f = g_s / fmaxf(l, 1e-30f);
#pragma unroll
                    for (int k = 0; k < 16; ++k) { out0[k] += st.o0[k] * f; out1[k] += st.o1[k] * f; }
                    fa_init(st);
                }
            } else {
                const int kb = (w0 + i - e3) * 64;
                { if (kb >= s_hi - 255 && kb + 63 <= s_lo) fa_tile<0>(st, qf, cur, cur + 4096, r, h, c, true, [=](int) { return true; }); else fa_tile<2>(st, qf, cur, cur + 4096, r, h, c, true, [=](int koff) { const int key = kb + koff; return key <= s && key >= s - 255; }); }
            }
        }
        {
            const float l = st.l + __shfl_xor(st.l, 32);
            const float f = g_w / fmaxf(l, 1e-30f);
#pragma unroll
            for (int k = 0; k < 16; ++k) { out0[k] += st.o0[k] * f; out1[k] += st.o1[k] * f; }
        }
        bf16_t* o = (bf16_t*)(ws + WS_MIX) + (size_t)t * 1024 + (g * 4 + z) * 64;
#pragma unroll
        for (int g4 = 0; g4 < 4; ++g4) {
            *(u32x2*)(o + 8 * g4 + 4 * h) = cvt4((f32x4){out0[4 * g4], out0[4 * g4 + 1], out0[4 * g4 + 2], out0[4 * g4 + 3]});
            *(u32x2*)(o + 32 + 8 * g4 + 4 * h) = cvt4((f32x4){out1[4 * g4], out1[4 * g4 + 1], out1[4 * g4 + 2], out1[4 * g4 + 3]});
        }
    }
}

DI void phase_glu(const Params& P, unsigned char* smem) {
    unsigned char* ws = P.ws;
    const bf16_t* G5 = (const bf16_t*)(ws + XP_G5);
    const float* gb = P.in[17];
    bool pre = false;
    for (int it = vblock(); it < (NT / 128) * 4; it += gridDim.x) {
        int mt, nt; tile_mn(it, 4, mt, nt);
        const int m0 = mt * 128;
        const bool hn = it + (int)gridDim.x < (NT / 128) * 4;
        int mtn = 0, ntn = 0; if (hn) tile_mn(it + gridDim.x, 4, mtn, ntn);
        auto nextrow = [=](int r) { return G5 + (size_t)(mtn * 128 + r) * 512; };
        auto rowptr = [=](int r) { return G5 + (size_t)(m0 + r) * 512; };
        auto epi = [=](f32x4 (&acc)[4][4], int wr, int wc, int ln) {
            const int fr = ln & 15, fq = ln >> 4;
#pragma unroll
            for (int m = 0; m < 4; ++m) {
                const int row = m0 + wr * 64 + m * 16 + fr;
#pragma unroll
                for (int n = 0; n < 4; ++n) {
                    const int col = nt * 128 + wc * 64 + n * 16 + fq * 4;
                    const f32x4 gv = bf4_to_f(*(const u32x2*)(G5 + (size_t)row * 512 + col)), bb = *(const f32x4*)(gb + col), z = acc[m][n] + bb;
                    *(u32x2*)((bf16_t*)(ws + WS_MIX) + (size_t)row * 1024 + 512 + col) = cvt4((f32x4){gv.x * sigmoidf_(z.x), gv.y * sigmoidf_(z.y), gv.z * sigmoidf_(z.z), gv.w * sigmoidf_(z.w)});
                }
            }
        };
        gemm128s(rowptr, (const bf16_t*)(ws + WS_WGLU) + (size_t)nt * 128 * 512, 512, 512, smem, epi, pre, hn, nextrow, (const bf16_t*)(ws + WS_WGLU) + (size_t)ntn * 128 * 512);
        pre = hn;
    }
}

DI void phase_outproj(const Params& P, unsigned char* smem, const float* xres, size_t wt_off) {
    unsigned char* ws = P.ws;
    const bf16_t* A = (const bf16_t*)(ws + WS_MIX);
    float* out = P.out;
    bool pre = false;
    for (int it = vblock(); it < (NT / 128) * 8; it += gridDim.x) {
        int mt, nt; tile_mn(it, 8, mt, nt);
        const int m0 = mt * 128;
        const bool hn = it + (int)gridDim.x < (NT / 128) * 8;
        int mtn = 0, ntn = 0; if (hn) tile_mn(it + gridDim.x, 8, mtn, ntn);
        auto nextrow = [=](int r) { return A + (size_t)(mtn * 128 + r) * 1024; };
        auto rowptr = [=](int r) { return A + (size_t)(m0 + r) * 1024; };
        auto epi = [=](f32x4 (&acc)[4][4], int wr, int wc, int ln) {
            const int fr = ln & 15, fq = ln >> 4;
#pragma unroll
            for (int m = 0; m < 4; ++m) {
                const size_t base = (size_t)(m0 + wr * 64 + m * 16 + fr) * 1024 + nt * 128 + wc * 64 + fq * 4;
                f32x4 xr[4];
#pragma unroll
                for (int n = 0; n < 4; ++n) xr[n] = *(const f32x4*)(xres + base + n * 16);
#pragma unroll
                for (int n = 0; n < 4; ++n) *(f32x4*)(out + base + n * 16) = xr[n] * ALPHA + acc[m][n];
            }
        };
        gemm128s(rowptr, (const bf16_t*)(ws + wt_off) + (size_t)nt * 128 * 1024, 1024, 1024, smem, epi, pre, hn, nextrow, (const bf16_t*)(ws + wt_off) + (size_t)ntn * 128 * 1024);
        pre = hn;
    }
}

DI void ln_row(float (&v)[16], const float* __restrict__ g, const float* __restrict__ bta, int lane) {
    float s = 0.f;
#pragma unroll
    for (int i = 0; i < 16; ++i) s += v[i];
    const float mu = wave_sum(s) * (1.f / 1024.f);
    float q = 0.f;
#pragma unroll
    for (int i = 0; i < 16; ++i) { v[i] -= mu; q += v[i] * v[i]; }
    const float rstd = rsqrtf(wave_sum(q) * (1.f / 1024.f) + LN_EPS);
#pragma unroll
    for (int j = 0; j < 4; ++j) {
        const float4 gg = *(const float4*)(g + 4 * lane + 256 * j), bb = *(const float4*)(bta + 4 * lane + 256 * j);
        v[4 * j + 0] = v[4 * j + 0] * rstd * gg.x + bb.x; v[4 * j + 1] = v[4 * j + 1] * rstd * gg.y + bb.y;
        v[4 * j + 2] = v[4 * j + 2] * rstd * gg.z + bb.z; v[4 * j + 3] = v[4 * j + 3] * rstd * gg.w + bb.w;
    }
}

DI void phase_ln_router(const Params& P, int layer) {
    unsigned char* ws = P.ws;
    const int lane = threadIdx.x & 63, wave = threadIdx.x >> 6;
    const float* g = P.in[21] + layer * 1024; const float* bta = P.in[22] + layer * 1024;
    const float* wc = (const float*)(ws + WS_RTRW) + (size_t)layer * 36864; const float* bc = P.in[26] + layer * 4;
    const float* wf = wc + 4096; const float* bfn = P.in[28] + layer * 32;
    int* cnt = (int*)(ws + WS_CTL) + layer * 2048;
    int* list = (int*)(ws + WS_LIST2);
    float* wgt = (float*)(ws + WS_WGT);
    bf16_t* xb = (bf16_t*)(ws + WS_ACTB);
    for (int task = blockIdx.x * 4 + wave; task < NT / 16; task += gridDim.x * 4) {
        int my_e = 0; float my_w = 0.f;
        f32x4 wcr[16];
#pragma unroll
        for (int q = 0; q < 16; ++q) wcr[q] = *(const f32x4*)(wc + (q * 64 + lane) * 4);
        f32x4 nx[4];
#pragma unroll
        for (int j = 0; j < 4; ++j) nx[j] = __builtin_nontemporal_load((const f32x4*)(P.out + (size_t)(task * 16) * 1024 + 4 * lane + 256 * j));
#pragma unroll 1
        for (int i = 0; i < 16; ++i) {
            const int t = task * 16 + i;
            float v[16];
#pragma unroll
            for (int j = 0; j < 4; ++j) { v[4 * j] = nx[j].x; v[4 * j + 1] = nx[j].y; v[4 * j + 2] = nx[j].z; v[4 * j + 3] = nx[j].w; }
            if (i + 1 < 16) {
#pragma unroll
                for (int j = 0; j < 4; ++j) nx[j] = __builtin_nontemporal_load((const f32x4*)(P.out + (size_t)(t + 1) * 1024 + 4 * lane + 256 * j));
            }
            ln_row(v, g, bta, lane);
#pragma unroll
            for (int j = 0; j < 4; ++j) {
                *(u32x2*)(xb + (size_t)t * 1024 + 4 * lane + 256 * j) = cvt4((f32x4){v[4 * j], v[4 * j + 1], v[4 * j + 2], v[4 * j + 3]});
            }
            float lc[4] = {0.f, 0.f, 0.f, 0.f};
#pragma unroll
            for (int j = 0; j < 4; ++j)
#pragma unroll
                for (int k = 0; k < 4; ++k) {
                    const f32x4 w = wcr[j * 4 + k];
                    const float x = v[4 * j + k];
                    lc[0] += x * w.x; lc[1] += x * w.y; lc[2] += x * w.z; lc[3] += x * w.w;
                }
#pragma unroll
            for (int c = 0; c < 4; ++c) lc[c] = wave_sum(lc[c]) + bc[c];
            int gi = 0; float lm = lc[0];
#pragma unroll
            for (int c = 1; c < 4; ++c) if (lc[c] > lm) { lm = lc[c]; gi = c; }
            gi = __builtin_amdgcn_readfirstlane(gi);
            float den = 0.f;
#pragma unroll
            for (int c = 0; c < 4; ++c) den += expf(lc[c] - lm);
            const float gv = 1.f / den;
            float lf[8] = {0.f, 0.f, 0.f, 0.f, 0.f, 0.f, 0.f, 0.f};
            const float* wfg = wf + (size_t)gi * 8192;
#pragma unroll
            for (int j = 0; j < 4; ++j)
#pragma unroll
                for (int k = 0; k < 4; ++k) {
                    const f32x4 w0 = *(const f32x4*)(wfg + (((j * 4 + k) * 2 + 0) * 64 + lane) * 4), w1 = *(const f32x4*)(wfg + (((j * 4 + k) * 2 + 1) * 64 + lane) * 4);
                    const float x = v[4 * j + k];
                    lf[0] += x * w0.x; lf[1] += x * w0.y; lf[2] += x * w0.z; lf[3] += x * w0.w;
                    lf[4] += x * w1.x; lf[5] += x * w1.y; lf[6] += x * w1.z; lf[7] += x * w1.w;
                }
#pragma unroll
            for (int e = 0; e < 8; ++e) lf[e] = wave_sum(lf[e]) + bfn[gi * 8 + e];
            int e1 = 0; float l1 = lf[0];
#pragma unroll
            for (int e = 1; e < 8; ++e) if (lf[e] > l1) { l1 = lf[e]; e1 = e; }
            int e2 = 0; float l2 = -INFINITY;
#pragma unroll
            for (int e = 0; e < 8; ++e) if (e != e1 && lf[e] > l2) { l2 = lf[e]; e2 = e; }
            const float r = expf(l2 - l1);
            if (lane == i) { my_e = gi * 8 + e1; my_w = gv / (1.f + r); }
            if (lane == 16 + i) { my_e = gi * 8 + e2; my_w = gv * r / (1.f + r); }
        }
        if (lane < 32) {
            const int t = task * 16 + (lane & 15), k = lane >> 4, slot = (task & 63) * 32 + my_e;
            const int pos = atomicAdd(&cnt[slot], 1);
            list[(slot << 10) + pos] = t * 2 + k;
            wgt[t * 2 + k] = my_w;
        }
    }
}

constexpr int MOE_LDS_TAB = 65536;
constexpr int MOE_LDS_ROW = 65536 + 8448;
DI void moe_tables(const int* cnt, unsigned char* smem) {
    int* tab = (int*)(smem + MOE_LDS_TAB);
    if (threadIdx.x < 32) { const int e = threadIdx.x; int run = 0; for (int s = 0; s < 64; ++s) { tab[e * 65 + s] = run; run += cnt[s * 32 + e]; } tab[e * 65 + 64] = run; }
    __syncthreads();
}
DI bool moe_tile(const int* tab, int tile, int& e, int& mt, int& off, int& ce) {
    int acc_t = 0, acc_r = 0;
    for (int i = 0; i < 32; ++i) {
        const int c = tab[i * 65 + 64], nt = (c + 127) >> 7;
        if (tile < acc_t + nt) { e = i; mt = tile - acc_t; off = acc_r; ce = c; return true; }
        acc_t += nt; acc_r += c;
    }
    return false;
}
DI int moe_ntiles(const int* tab) { int a = 0; for (int i = 0; i < 32; ++i) a += (tab[i * 65 + 64] + 127) >> 7; return a; }
DI void moe_rows(const int* tab, const int* list, int e, int mt, int ce, int* rowidx) {
    if (threadIdx.x < 128) {
        const int pos = mt * 128 + threadIdx.x;
        int idx = -1;
        if (pos < ce) {
            int lo = 0, hi = 64;
            while (hi - lo > 1) { const int mid = (lo + hi) >> 1; if (tab[e * 65 + mid] <= pos) lo = mid; else hi = mid; }
            idx = list[((lo * 32 + e) << 10) + pos - tab[e * 65 + lo]];
        }
        rowidx[threadIdx.x] = idx;
    }
    __syncthreads();
}

DI void phase_moe_gu(const Params& P, unsigned char* smem, int layer) {
    unsigned char* ws = P.ws;
    const int* cnt = (const int*)(ws + WS_CTL) + layer * 2048;
    const int* list = (const int*)(ws + WS_LIST2);
    const float* wgt = (const float*)(ws + WS_WGT);
    const bf16_t* xb = (const bf16_t*)(ws + WS_ACTB);
    bf16_t* H = (bf16_t*)(ws + XP_H);
    const int* tab = (const int*)(smem + MOE_LDS_TAB);
    int* rowidx = (int*)(smem + MOE_LDS_ROW);
    moe_tables(cnt, smem);
    const int ntile = moe_ntiles(tab);
    for (int it = vblock(); it < ntile * 2; it += gridDim.x) {
        int e, mt, off, ce; moe_tile(tab, it >> 1, e, mt, off, ce);
        const int nt = it & 1;
        moe_rows(tab, list, e, mt, ce, rowidx);
        auto rowptr = [=](int r) { int idx = rowidx[r]; idx = idx < 0 ? rowidx[0] : idx; return xb + (size_t)(idx >> 1) * 1024; };
        auto epi = [=](f32x4 (&acc)[4][4], int wr, int wc, int ln) {
            const int fr = ln & 15, fq = ln >> 4;
#pragma unroll
            for (int m = 0; m < 4; ++m) {
                const int rl = wr * 64 + m * 16 + fr, idx = rowidx[rl];
                if (idx >= 0) {
                    const float w = wgt[idx];
#pragma unroll
                    for (int n = 0; n < 2; ++n) {
                        const f32x4 gte = acc[m][n], up = acc[m][n + 2];
                        *(u32x2*)(H + (size_t)(off + mt * 128 + rl) * 128 + (nt * 2 + wc) * 32 + n * 16 + fq * 4) =
                            cvt4((f32x4){gte.x * sigmoidf_(gte.x) * up.x * w, gte.y * sigmoidf_(gte.y) * up.y * w, gte.z * sigmoidf_(gte.z) * up.z * w, gte.w * sigmoidf_(gte.w) * up.w * w});
                    }
                }
            }
        };
        gemm128(rowptr, (const bf16_t*)(ws + WS_WGU) + ((size_t)(layer * 32 + e) * 256 + nt * 128) * 1024, 1024, 1024, smem, epi);
        __syncthreads();
    }
}
DI void phase_moe_down(const Params& P, unsigned char* smem, int layer) {
    unsigned char* ws = P.ws;
    const int* cnt = (const int*)(ws + WS_CTL) + layer * 2048;
    const int* list = (const int*)(ws + WS_LIST2);
    const bf16_t* H = (const bf16_t*)(ws + XP_H);
    bf16_t* YB = (bf16_t*)(ws + XP_YB);
    const int* tab = (const int*)(smem + MOE_LDS_TAB);
    int* rowidx = (int*)(smem + MOE_LDS_ROW);
    moe_tables(cnt, smem);
    const int ntile = moe_ntiles(tab);
    for (int it = vblock(); it < ntile * 8; it += gridDim.x) {
        int e, mt, off, ce; moe_tile(tab, it >> 3, e, mt, off, ce);
        const int nt = it & 7;
        moe_rows(tab, list, e, mt, ce, rowidx);
        auto rowptr = [=](int r) { int pos = mt * 128 + r; pos = pos < ce ? pos : 0; return H + (size_t)(off + pos) * 128; };
        auto epi = [=](f32x4 (&acc)[4][4], int wr, int wc, int ln) {
            const int fr = ln & 15, fq = ln >> 4;
#pragma unroll
            for (int m = 0; m < 4; ++m) {
                const int idx = rowidx[wr * 64 + m * 16 + fr];
                if (idx >= 0) {
                    bf16_t* dst = YB + (size_t)idx * 1024 + nt * 128 + wc * 64 + fq * 4;
#pragma unroll
                    for (int n = 0; n < 4; ++n) *(u32x2*)(dst + n * 16) = cvt4(acc[m][n]);
                }
            }
        };
        gemm128(rowptr, (const bf16_t*)(ws + WS_WDN) + ((size_t)(layer * 32 + e) * 1024 + nt * 128) * 128, 128, 128, smem, epi);
        __syncthreads();
    }
}
DI void phase_ln_ffn(const Params& P, int layer) {
    unsigned char* ws = P.ws;
    const int lane = threadIdx.x & 63, wave = threadIdx.x >> 6;
    const float* g = P.in[23] + layer * 1024; const float* bta = P.in[24] + layer * 1024;
    const bf16_t* YB = (const bf16_t*)(ws + XP_YB);
    bf16_t* xb = (bf16_t*)(ws + WS_ACTB);
    for (int task = blockIdx.x * 4 + wave; task < NT / 16; task += gridDim.x * 4) {
        u32x2 nxm[4], ny0[4], ny1[4];
        auto fetch = [&](int t) {
#pragma unroll
            for (int j = 0; j < 4; ++j) {
                nxm[j] = __builtin_nontemporal_load((const u32x2*)(xb + (size_t)t * 1024 + 4 * lane + 256 * j));
                ny0[j] = __builtin_nontemporal_load((const u32x2*)(YB + (size_t)(2 * t) * 1024 + 4 * lane + 256 * j));
                ny1[j] = __builtin_nontemporal_load((const u32x2*)(YB + (size_t)(2 * t + 1) * 1024 + 4 * lane + 256 * j));
            }
        };
        fetch(task * 16);
#pragma unroll 1
        for (int i = 0; i < 16; ++i) {
            const int t = task * 16 + i;
            float v[16];
#pragma unroll
            for (int j = 0; j < 4; ++j) {
                const f32x4 a = bf4_to_f(nxm[j]), y0 = bf4_to_f(ny0[j]), y1 = bf4_to_f(ny1[j]);
                v[4 * j + 0] = ALPHA * a.x + (y0.x + y1.x); v[4 * j + 1] = ALPHA * a.y + (y0.y + y1.y);
                v[4 * j + 2] = ALPHA * a.z + (y0.z + y1.z); v[4 * j + 3] = ALPHA * a.w + (y0.w + y1.w);
            }
            if (i + 1 < 16) fetch(t + 1);
            ln_row(v, g, bta, lane);
            float* row = P.out + (size_t)t * 1024;
#pragma unroll
            for (int j = 0; j < 4; ++j) {
                *(f32x4*)(row + 4 * lane + 256 * j) = (f32x4){v[4 * j], v[4 * j + 1], v[4 * j + 2], v[4 * j + 3]};
                if (layer == 0) *(u32x2*)(xb + (size_t)t * 1024 + 4 * lane + 256 * j) = cvt4((f32x4){v[4 * j], v[4 * j + 1], v[4 * j + 2], v[4 * j + 3]});
            }
        }
    }
}

DI void phase_inproj1(const Params& P, unsigned char* smem) {
    unsigned char* ws = P.ws;
    const bf16_t* A = (const bf16_t*)(ws + WS_ACTB);
    const float* cosT = (const float*)(ws + WS_ROPE);
    const float* sinT = cosT + 4096 * 32;
    bool pre = false;
    for (int it = vblock(); it < (NT / 128) * 24; it += gridDim.x) {
        int mt, nt; tile_mn(it, 24, mt, nt);
        const int m0 = mt * 128;
        auto rowptr = [=](int r) { return A + (size_t)(m0 + r) * 1024; };
        const bf16_t* Bt = (const bf16_t*)(ws + WS_WIN1) + (size_t)nt * 128 * 1024;
        const bool hn = it + (int)gridDim.x < (NT / 128) * 24;
        int mtn = 0, ntn = 0; if (hn) tile_mn(it + gridDim.x, 24, mtn, ntn);
        auto nextrow = [=](int r) { return A + (size_t)(mtn * 128 + r) * 1024; };
        const bf16_t* nBt = (const bf16_t*)(ws + WS_WIN1) + (size_t)ntn * 128 * 1024;
        if (nt >= 16) {
            auto epi = [=](f32x4 (&acc)[4][4], int wr, int wc, int lane) {
                const int head = (nt * 2 + wc) & 15, fr = lane & 15, fq = lane >> 4;
#pragma unroll
                for (int m = 0; m < 4; ++m) {
                    const int t = m0 + wr * 64 + m * 16 + fq * 4, s = t & 4095, b = t >> 12;
                    bf16_t* base = (bf16_t*)(ws + XP_Q1 + (size_t)2 * 64 * MiB) + (size_t)(b * 16 + head) * 4096 * 64;
#pragma unroll
                    for (int n = 0; n < 4; ++n) *(u32x2*)(base + vp_off(s, n * 16 + fr)) = cvt4(acc[m][n]);
                }
            };
            gemm128s<false>(rowptr, Bt, 1024, 1024, smem, epi, pre, hn, nextrow, nBt);
            pre = hn;
            continue;
        }
        auto epi = [=](f32x4 (&acc)[4][4], int wr, int wc, int lane) {
            const int u64 = nt * 2 + wc, kind = u64 >> 4, head = u64 & 15, fr = lane & 15, fq = lane >> 4;
            f32x4 cs[2][2];
#pragma unroll
            for (int n2 = 0; n2 < 2; ++n2) { cs[n2][0] = (f32x4){0.f, 0.f, 0.f, 0.f}; cs[n2][1] = cs[n2][0]; }
#pragma unroll
            for (int m = 0; m < 4; ++m) {
                const int t = m0 + wr * 64 + m * 16 + fr, s = t & 4095, b = t >> 12;
                bf16_t* base = (bf16_t*)(ws + XP_Q1 + (size_t)kind * 64 * MiB) + (size_t)(b * 16 + head) * 4096 * 64;
#pragma unroll
                for (int n2 = 0; n2 < 2; ++n2) {
                    const int i = n2 * 16 + fq * 4;
                    const f32x4 c = *(const f32x4*)(cosT + s * 32 + i), sn = *(const f32x4*)(sinT + s * 32 + i);
                    const f32x4 x1 = acc[m][2 * n2], x2 = acc[m][2 * n2 + 1];
                    const f32x4 r1 = x1 * c - x2 * sn, r2 = x1 * sn + x2 * c;
                    const u32x2 o1 = cvt4(r1), o2 = cvt4(r2);
                    if (kind == 0) { *(u32x2*)(base + (size_t)s * 64 + i) = o1; *(u32x2*)(base + (size_t)s * 64 + i + 32) = o2; }
                    else { *(u32x2*)(base + kp_off(s, i)) = o1; *(u32x2*)(base + kp_off(s, i + 32)) = o2; cs[n2][0] += r1; cs[n2][1] += r2; }
                }
            }
            if (kind == 1) {
                const int t0 = m0 + wr * 64, bh = (t0 >> 12) * 16 + head, seg = (t0 & 4095) >> 6;
                float* dst = (float*)(ws + WS_KMP) + ((size_t)bh * 64 + seg) * 64;
#pragma unroll
                for (int n2 = 0; n2 < 2; ++n2)
#pragma unroll
                    for (int hf = 0; hf < 2; ++hf) {
                        f32x4 v = cs[n2][hf];
#pragma unroll
                        for (int k = 0; k < 4; ++k) { float x = v[k]; x += dpp_f<0xB1>(x); x += dpp_f<0x4E>(x); x += dpp_f<0x141>(x); x += dpp_f<0x140>(x); v[k] = x; }
                        if (fr == 0) *(f32x4*)(dst + n2 * 16 + fq * 4 + hf * 32) = v;
                    }
            }
        };
        gemm128s(rowptr, Bt, 1024, 1024, smem, epi, pre, hn, nextrow, nBt);
        pre = hn;
    }
}
DI void moba_kmeans_slab(const Params& P, bf16_t* kml, int bh, int tid) {
    const float* kp = (const float*)(P.ws + WS_KMP) + (size_t)bh * 64 * 64;
    for (int e = tid; e < 2048; e += 256) {
        const int d = e & 63, n = e >> 6;
        float a = 0.f;
        if (n < 16) a = ((kp[(4 * n) * 64 + d] + kp[(4 * n + 1) * 64 + d]) + (kp[(4 * n + 2) * 64 + d] + kp[(4 * n + 3) * 64 + d])) * (1.f / 256.f);
        kml[((d >> 4) * 32 + n) * 16 + (d & 15)] = f2bf(a);
    }
}
DI unsigned moba_gate_rows(const bf16_t* km, const bf16x8 (&qf)[4], int own, int r, int h) {
    f32x16 g;
#pragma unroll
    for (int i = 0; i < 16; ++i) g[i] = 0.f;
#pragma unroll
    for (int ks = 0; ks < 4; ++ks) g = MFMA32(*(const bf16x8*)(km + (ks * 32 + r) * 16 + 8 * h), qf[ks], g);
    float mine[8], oth[8];
#pragma unroll
    for (int i = 0; i < 8; ++i) { const int n = (i & 3) + 8 * (i >> 2) + 4 * h; mine[i] = n < own ? g[i] : -INFINITY; oth[i] = __shfl_xor(mine[i], 32); }
    unsigned selmask = 0;
#pragma unroll
    for (int i = 0; i < 8; ++i) {
        const int n = (i & 3) + 8 * (i >> 2) + 4 * h;
        int rank = 0;
#pragma unroll
        for (int k = 0; k < 8; ++k) {
            const int nk = (k & 3) + 8 * (k >> 2) + 4 * h, no = (k & 3) + 8 * (k >> 2) + 4 * (1 - h);
            rank += (mine[k] > mine[i] || (mine[k] == mine[i] && nk < n)) ? 1 : 0;
            rank += (oth[k] > mine[i] || (oth[k] == mine[i] && no < n)) ? 1 : 0;
        }
        if (n < own && rank < 3) selmask |= 1u << n;
    }
    return selmask | __shfl_xor(selmask, 32);
}
DI void phase_moba_gate(const Params& P, unsigned char* smem) {
    unsigned char* ws = P.ws;
    const int tid = threadIdx.x, lane = tid & 63, wave = tid >> 6, r = lane & 31, h = lane >> 5;
    bf16_t* kml = (bf16_t*)smem;
    unsigned short* smask = (unsigned short*)(smem + 4096);
    unsigned short* selm = (unsigned short*)(ws + WS_SELM);
    unsigned short* mcnt = (unsigned short*)(ws + WS_MCNT);
    unsigned char* mlist = ws + WS_MLIST;
    int km_bh = -1;
    for (int it = blockIdx.x; it < 2048; it += gridDim.x) {
        const int bh = it & 127, qb = it >> 7;
        if (bh != km_bh) { km_bh = bh; __syncthreads(); moba_kmeans_slab(P, kml, bh, tid); }
        __syncthreads();
#pragma unroll 1
        for (int g2 = 0; g2 < 2; ++g2) {
            const int rl = wave * 64 + g2 * 32 + r, q = qb * 256 + rl;
            const bf16_t* Qg = (const bf16_t*)(ws + XP_Q1) + ((size_t)bh * 4096 + q) * 64;
            bf16x8 qf[4];
#pragma unroll
            for (int ks = 0; ks < 4; ++ks) qf[ks] = *(const bf16x8*)(Qg + ks * 16 + 8 * h);
            const unsigned sm = qb > 0 ? moba_gate_rows(kml, qf, qb, r, h) : 0u;
            if (h == 0) { selm[(size_t)bh * 4096 + q] = (unsigned short)sm; smask[rl] = (unsigned short)sm; }
        }
        __syncthreads();
        for (int n = wave; n < qb; n += 4) {
            unsigned char* lp = mlist + ((size_t)(bh * 16 + qb) * 16 + n) * 256;
            int base = 0;
#pragma unroll
            for (int c4 = 0; c4 < 4; ++c4) {
                const int row = c4 * 64 + lane;
                const bool bit = (smask[row] >> n) & 1;
                const unsigned long long bal = __ballot(bit);
                if (bit) lp[base + __builtin_popcountll(bal & ((1ull << lane) - 1ull))] = (unsigned char)row;
                base += __builtin_popcountll(bal);
            }
            if (lane == 0) mcnt[(bh * 16 + qb) * 16 + n] = (unsigned short)base;
        }
    }
}
DI bf16_t* moba_po(const Params& P, int slot) { return (bf16_t*)(P.ws + (slot == 0 ? WS_MIX : slot == 1 ? WS_ACTB : WS_PO2)); }
DI void phase_moba_kv(const Params& P, unsigned char* smem) {
    unsigned char* ws = P.ws;
    const int tid = threadIdx.x, lane = tid & 63, wave = tid >> 6, r = lane & 31, h = lane >> 5;
    const float c = 0.125f * 1.4426950408889634f;
    LAS unsigned char* lds = (LAS unsigned char*)smem;
    const unsigned short* selm = (const unsigned short*)(ws + WS_SELM);
    const unsigned short* mcnt = (const unsigned short*)(ws + WS_MCNT);
    const unsigned char* mlist = ws + WS_MLIST;
    float* pml = (float*)(ws + WS_PML);
    const bool bal = (gridDim.x == 512);
    const int nit = bal ? ((blockIdx.x >> 7) == 3 ? 3 : 4) : (1920 + (int)gridDim.x - 1 - (int)blockIdx.x) / (int)gridDim.x;
    for (int iti = 0; iti < nit; ++iti) {
        int bh, n;
        if (bal) { const int gq = blockIdx.x >> 7; bh = blockIdx.x & 127; const int tab = gq == 0 ? 0x0DA90 : gq == 1 ? 0x0CB61 : gq == 2 ? 0x0E852 : 0x00743; n = (tab >> (4 * iti)) & 15; }
        else { const int it = blockIdx.x + iti * gridDim.x; n = it >> 7; bh = it & 127; }
        const bf16_t* Kg = (const bf16_t*)(ws + XP_Q1 + 64 * MiB) + (size_t)bh * 4096 * 64 + (size_t)n * 4 * 4096;
        const bf16_t* Vg = (const bf16_t*)(ws + XP_Q1 + 128 * MiB) + (size_t)bh * 4096 * 64 + (size_t)n * 4 * 4096;
        asm volatile("s_waitcnt vmcnt(0)" ::: "memory");
        __builtin_amdgcn_s_barrier();
#pragma unroll
        for (int j = 0; j < 4; ++j) fa_issue(Kg + (size_t)j * 4096, Vg + (size_t)j * 4096, lds + j * 16384, tid);
        const int cntv = (lane < 16 && lane > n) ? (int)mcnt[(bh * 16 + lane) * 16 + n] : 0;
        asm volatile("s_waitcnt vmcnt(0)" ::: "memory");
        __builtin_amdgcn_s_barrier();
        asm volatile("" ::: "memory");
        int prefv = 0, total = 0;
#pragma unroll 1
        for (int qb = 0; qb < 16; ++qb) { if (lane == qb) prefv = total; total += __builtin_amdgcn_readlane(cntv, qb); }
#pragma unroll 1
        for (int v0 = wave * 32; v0 < total; v0 += 128) {
            const int v = v0 + r;
            const bool valid = v < total;
            const int vv = valid ? v : v0;
            int qb = n + 1;
#pragma unroll 1
            for (int l = n + 2; l < 16; ++l) if (vv >= __builtin_amdgcn_readlane(prefv, l)) qb = l;
            const int idx = vv - __shfl(prefv, qb);
            const int q = qb * 256 + (int)mlist[((size_t)(bh * 16 + qb) * 16 + n) * 256 + idx];
            const bf16_t* Qg = (const bf16_t*)(ws + XP_Q1) + ((size_t)bh * 4096 + q) * 64;
            bf16x8 qf[4];
#pragma unroll
            for (int ks = 0; ks < 4; ++ks) qf[ks] = *(const bf16x8*)(Qg + ks * 16 + 8 * h);
            FA st; fa_init(st);
#pragma unroll 1
            for (int j = 0; j < 4; ++j) {
                const LAS bf16_t* cur = (const LAS bf16_t*)(lds + j * 16384);
                fa_tile<0>(st, qf, cur, cur + 4096, r, h, c, true, [=](int) { return true; });
            }
            const float l = st.l + __shfl_xor(st.l, 32);
            const float inv = 1.f / fmaxf(l, 1e-30f);
            if (valid) {
                const int slot = __builtin_popcount((unsigned)selm[(size_t)bh * 4096 + q] & ((1u << n) - 1u));
                bf16_t* o = moba_po(P, slot) + ((size_t)(bh >> 4) * 4096 + q) * 1024 + (bh & 15) * 64;
#pragma unroll
                for (int g4 = 0; g4 < 4; ++g4) {
                    *(u32x2*)(o + 8 * g4 + 4 * h) = cvt4((f32x4){st.o0[4 * g4] * inv, st.o0[4 * g4 + 1] * inv, st.o0[4 * g4 + 2] * inv, st.o0[4 * g4 + 3] * inv});
                    *(u32x2*)(o + 32 + 8 * g4 + 4 * h) = cvt4((f32x4){st.o1[4 * g4] * inv, st.o1[4 * g4 + 1] * inv, st.o1[4 * g4 + 2] * inv, st.o1[4 * g4 + 3] * inv});
                }
                if (h == 0) { float* pm = pml + (((size_t)bh * 4096 + q) * 3 + slot) * 2; pm[0] = st.m; pm[1] = l; }
            }
        }
    }
}
DI void phase_moba_own(const Params& P, unsigned char* smem) {
    unsigned char* ws = P.ws;
    const int tid = threadIdx.x, lane = tid & 63, wave = tid >> 6, r = lane & 31, h = lane >> 5;
    const float c = 0.125f * 1.4426950408889634f;
    LAS unsigned char* lds = (LAS unsigned char*)smem;
    const unsigned short* selm = (const unsigned short*)(ws + WS_SELM);
    const float* pml = (const float*)(ws + WS_PML);
    for (int it = blockIdx.x; it < 2048; it += gridDim.x) {
        const int own = 15 - (it >> 7), bh = it & 127, t0 = own * 256;
        const bf16_t* Kg = (const bf16_t*)(ws + XP_Q1 + 64 * MiB) + (size_t)bh * 4096 * 64 + (size_t)own * 4 * 4096;
        const bf16_t* Vg = (const bf16_t*)(ws + XP_Q1 + 128 * MiB) + (size_t)bh * 4096 * 64 + (size_t)own * 4 * 4096;
        asm volatile("s_waitcnt vmcnt(0)" ::: "memory");
        __builtin_amdgcn_s_barrier();
#pragma unroll
        for (int j = 0; j < 4; ++j) fa_issue(Kg + (size_t)j * 4096, Vg + (size_t)j * 4096, lds + j * 16384, tid);
        asm volatile("s_waitcnt vmcnt(0)" ::: "memory");
        __builtin_amdgcn_s_barrier();
        asm volatile("" ::: "memory");
#pragma unroll 1
        for (int g2 = 0; g2 < 2; ++g2) {
            const int row0 = t0 + g2 * 128 + wave * 32, q = row0 + r;
            const bf16_t* Qg = (const bf16_t*)(ws + XP_Q1) + ((size_t)bh * 4096 + q) * 64;
            bf16x8 qf[4];
#pragma unroll
            for (int ks = 0; ks < 4; ++ks) qf[ks] = *(const bf16x8*)(Qg + ks * 16 + 8 * h);
            const int nsel = __builtin_popcount((unsigned)selm[(size_t)bh * 4096 + q]);
            const size_t orow = ((size_t)(bh >> 4) * 4096 + q) * 1024 + (bh & 15) * 64;
            const float* pm = pml + ((size_t)bh * 4096 + q) * 6;
            float mi[3], li[3];
            u32x2 pa[3][8];
#pragma unroll
            for (int i = 0; i < 3; ++i) {
                mi[i] = i < nsel ? pm[2 * i] : -INFINITY; li[i] = i < nsel ? pm[2 * i + 1] : 0.f;
                const bf16_t* po = moba_po(P, i) + orow;
#pragma unroll
                for (int g4 = 0; g4 < 4; ++g4) {
                    pa[i][2 * g4] = i < nsel ? *(const u32x2*)(po + 8 * g4 + 4 * h) : (u32x2){0u, 0u};
                    pa[i][2 * g4 + 1] = i < nsel ? *(const u32x2*)(po + 32 + 8 * g4 + 4 * h) : (u32x2){0u, 0u};
                }
            }
            FA st; fa_init(st);
            const int jmax = (row0 + 31 - t0) >> 6;
#pragma unroll 1
            for (int j = 0; j <= jmax; ++j) {
                const LAS bf16_t* cur = (const LAS bf16_t*)(lds + j * 16384);
                const int kbase = t0 + j * 64;
                if (kbase + 63 <= row0) fa_tile<0>(st, qf, cur, cur + 4096, r, h, c, true, [=](int) { return true; });
                else fa_tile<2>(st, qf, cur, cur + 4096, r, h, c, true, [=](int koff) { return kbase + koff <= q; });
            }
            const float l_own = st.l + __shfl_xor(st.l, 32);
            const float M = fmaxf(fmaxf(st.m, mi[0]), fmaxf(mi[1], mi[2]));
            const float wo = __builtin_amdgcn_exp2f(st.m - M);
            float L = l_own * wo;
#pragma unroll
            for (int k = 0; k < 16; ++k) { st.o0[k] *= wo; st.o1[k] *= wo; }
#pragma unroll
            for (int i = 0; i < 3; ++i) {
                const float wi = li[i] * __builtin_amdgcn_exp2f(mi[i] - M);
                L += wi;
#pragma unroll
                for (int g4 = 0; g4 < 4; ++g4) {
                    const f32x4 a = bf4_to_f(pa[i][2 * g4]), b2 = bf4_to_f(pa[i][2 * g4 + 1]);
                    st.o0[4 * g4] += wi * a.x; st.o0[4 * g4 + 1] += wi * a.y; st.o0[4 * g4 + 2] += wi * a.z; st.o0[4 * g4 + 3] += wi * a.w;
                    st.o1[4 * g4] += wi * b2.x; st.o1[4 * g4 + 1] += wi * b2.y; st.o1[4 * g4 + 2] += wi * b2.z; st.o1[4 * g4 + 3] += wi * b2.w;
                }
            }
            const float inv = 1.f / fmaxf(L, 1e-30f);
            bf16_t* o = (bf16_t*)(ws + WS_MIX) + orow;
#pragma unroll
            for (int g4 = 0; g4 < 4; ++g4) {
                *(u32x2*)(o + 8 * g4 + 4 * h) = cvt4((f32x4){st.o0[4 * g4] * inv, st.o0[4 * g4 + 1] * inv, st.o0[4 * g4 + 2] * inv, st.o0[4 * g4 + 3] * inv});
                *(u32x2*)(o + 32 + 8 * g4 + 4 * h) = cvt4((f32x4){st.o1[4 * g4] * inv, st.o1[4 * g4 + 1] * inv, st.o1[4 * g4 + 2] * inv, st.o1[4 * g4 + 3] * inv});
            }
        }
    }
}

constexpr int SMEM_BYTES = 65536 + 8192 + 1024 + 512;
static_assert(SMEM_BYTES >= 128 * 129 * 4 && SMEM_BYTES >= MOE_LDS_ROW + 512 && SMEM_BYTES >= NSA_LDS_MSK + 256, "LDS map");
constexpr int SMEM_OLD = 128 * 129 * 4;
typedef __attribute__((address_space(1))) unsigned gu32;
#define XB_TMO      128
#define XB_XCNT(j)  (256  + 64 * (j))
#define XB_XSUB(j)  (1280 + 64 * (j))
#define XB_XGEN(j)  (2304 + 64 * (j))
#define XB_TOP      3328
#define XB_TOPGEN   3392
#define XCD_BAR_WORDS 3456
#define XB_SPIN_CAP (1u << 18)

__device__ __forceinline__ unsigned xb_ld(unsigned* p)              { return __hip_atomic_load(p, __ATOMIC_RELAXED, __HIP_MEMORY_SCOPE_AGENT); }
__device__ __forceinline__ unsigned xb_add(unsigned* p, unsigned v) { return __hip_atomic_fetch_add(p, v, __ATOMIC_RELAXED, __HIP_MEMORY_SCOPE_AGENT); }
__device__ __forceinline__ unsigned xb_xcc_id() { return (unsigned)__builtin_amdgcn_s_getreg((3 << 11) | 20) & 0xFu; }
#define XB_SPIN(cond, bar) do { unsigned _sp = 0; while (cond) { __builtin_amdgcn_s_sleep(1); \
    if ((++_sp & 255u) == 0u) { if (xb_ld(&(bar)[XB_TMO])) break; if (_sp > XB_SPIN_CAP) { atomicAdd(&(bar)[XB_TMO], 1u); break; } } } } while (0)

struct XcdBarrier {
    unsigned* bar; unsigned x;
    volatile LAS unsigned* st;
};

__device__ __forceinline__ XcdBarrier xcd_barrier_post(unsigned* bar, volatile LAS unsigned* st) {
    XcdBarrier b; b.bar = bar; b.x = xb_xcc_id(); b.st = st;
    if (threadIdx.x == 0) (void)xb_add(&bar[XB_XCNT(b.x)], 1u);
    return b;
}
__device__ __forceinline__ void xcd_barrier_complete(unsigned* bar, unsigned x, unsigned& nloc, unsigned& nx) {
    const unsigned G = gridDim.x * gridDim.y * gridDim.z;
    unsigned sum, cnt, mine, sp = 0u;
    for (;;) {
        sum = 0u; cnt = 0u; mine = 0u;
#pragma unroll
        for (unsigned j = 0; j < 16; ++j) { const unsigned c = xb_ld(&bar[XB_XCNT(j)]); sum += c; cnt += (c > 0u) ? 1u : 0u; mine = (j == x) ? c : mine; }
        if (sum == G) break;
        __builtin_amdgcn_s_sleep(1);
        if ((++sp & 255u) == 0u) { if (xb_ld(&bar[XB_TMO])) break; if (sp > XB_SPIN_CAP) { atomicAdd(&bar[XB_TMO], 1u); break; } }
    }
    nloc = mine > 0u ? mine : 1u; nx = cnt > 0u ? cnt : 1u;
}

__device__ __forceinline__ void xcd_barrier(const XcdBarrier& b) {
    asm volatile("s_waitcnt vmcnt(0)" ::: "memory");
    __syncthreads();
    if (threadIdx.x == 0) {
        unsigned* bar = b.bar;
        __builtin_amdgcn_s_waitcnt(0);
        unsigned nloc = b.st[0], nx = b.st[1];
        if (nloc == 0u) { xcd_barrier_complete(bar, b.x, nloc, nx); b.st[0] = nloc; b.st[1] = nx; }
        const unsigned old = xb_add(&bar[XB_XSUB(b.x)], 1u);
        const unsigned gen = old / nloc;
        if (old + 1u == (gen + 1u) * nloc) {
            __builtin_amdgcn_fence(__ATOMIC_RELEASE, "agent");
            asm volatile("s_waitcnt vmcnt(0)" ::: "memory");
            const unsigned og = xb_add(&bar[XB_TOP], 1u);
            const unsigned tg = og / nx;
            if (og + 1u == (tg + 1u) * nx) xb_add(&bar[XB_TOPGEN], 1u);
            else XB_SPIN(xb_ld(&bar[XB_TOPGEN]) == tg, bar);
            __builtin_amdgcn_fence(__ATOMIC_ACQUIRE, "agent");
            xb_add(&bar[XB_XGEN(b.x)], 1u);
            asm volatile("s_waitcnt vmcnt(0)" ::: "memory");
        } else {
            XB_SPIN(xb_ld(&bar[XB_XGEN(b.x)]) == gen, bar);
            __builtin_amdgcn_fence(__ATOMIC_ACQUIRE, "agent");
            asm volatile("s_waitcnt vmcnt(0)" ::: "memory");
        }
    }
    __syncthreads();
}

constexpr size_t CTL_BAR = 16384;
constexpr size_t CTL_BYTES = 32768;

#define PHASE(k, call) if (P.ph_lo <= (k) && (k) < P.ph_hi) { call; if ((k) + 1 < P.ph_hi) xcd_barrier(xb); }
__global__ void __launch_bounds__(256, 2) mega(Params P) {
    __shared__ __attribute__((aligned(16))) unsigned char smem[SMEM_BYTES + 16];
    unsigned* xbst = (unsigned*)(smem + SMEM_BYTES);
    cg::grid_group grid = cg::this_grid();
    if (threadIdx.x < 4) xbst[threadIdx.x] = 0u;
    __syncthreads();
    if (P.ph_lo < 0) grid.sync();
    XcdBarrier xb = xcd_barrier_post((unsigned*)(P.ws + WS_CTL + CTL_BAR), (volatile LAS unsigned*)xbst);
    PHASE(0, phase0(P, smem))
    PHASE(1, phase_inproj0(P, smem))
    PHASE(2, phase_cmp_s5e(P, smem))
    PHASE(3, phase_glu(P, smem); phase_nsa(P, smem))
    PHASE(6, phase_outproj(P, smem, P.in[0], WS_WOUT0))
    PHASE(7, phase_ln_router(P, 0))
    PHASE(8, phase_moe_gu(P, smem, 0))
    PHASE(9, phase_moe_down(P, smem, 0))
    PHASE(10, phase_ln_ffn(P, 0))
    PHASE(11, phase_inproj1(P, smem))
    PHASE(12, phase_moba_gate(P, smem))
    PHASE(13, phase_moba_kv(P, smem))
    PHASE(14, phase_moba_own(P, smem))
    PHASE(15, phase_outproj(P, smem, P.out, WS_WOUT1))
    PHASE(16, phase_ln_router(P, 1))
    PHASE(17, phase_moe_gu(P, smem, 1))
    PHASE(18, phase_moe_down(P, smem, 1))
    PHASE(20, phase_ln_ffn(P, 1))
}

extern "C" void kernel_launch(void* const* d_in, const int* in_sizes, int n_in, void* d_out, int out_size, void* d_ws, size_t ws_size, hipStream_t stream) {
    static int grid = 0;
    if (grid == 0) {
        if (n_in != 32 || out_size != NT * DM || ws_size < WS_END) { fprintf(stderr, "kernel_launch: unexpected shapes (n_in %d, out %d, ws %zu)\n", n_in, out_size, ws_size); grid = -1; return; }
        int dev = 0, cus = 0, per_cu = 0;
        (void)hipGetDevice(&dev);
        (void)hipDeviceGetAttribute(&cus, hipDeviceAttributeMultiprocessorCount, dev);
        (void)hipOccupancyMaxActiveBlocksPerMultiprocessor(&per_cu, mega, 256, 0);
        if (per_cu < 1) per_cu = 1;
        if (per_cu > 2) per_cu = 2;
        grid = cus * per_cu;
    }
    if (grid < 0) return;
    (void)hipMemsetAsync((char*)d_ws + WS_CTL, 0, CTL_BYTES, stream);
    Params p{};
    for (int i = 0; i < 32; ++i) p.in[i] = (const float*)d_in[i];
    p.out = (float*)d_out; p.ws = (unsigned char*)d_ws;
    p.ph_lo = 0; p.ph_hi = NPH;
    void* args[] = {&p};
    hipError_t e = hipLaunchCooperativeKernel((void*)mega, dim3(grid), dim3(256), args, 0, stream);
    if (e != hipSuccess) fprintf(stderr, "cooperative launch failed: %s (grid %d)\n", hipGetErrorString(e), grid);
}
```

```cpp
#include <hip/hip_runtime.h>
#include <hip/hip_cooperative_groups.h>
#include <cstdio>
#include <cstdint>
namespace cg = cooperative_groups;

typedef unsigned short bf16_t;
typedef short bf16x8 __attribute__((ext_vector_type(8)));
typedef float f32x4 __attribute__((ext_vector_type(4)));
typedef unsigned u32x4 __attribute__((ext_vector_type(4)));
typedef unsigned u32x2 __attribute__((ext_vector_type(2)));
#define DI __device__ __forceinline__
#define LAS __attribute__((address_space(3)))
typedef float f32x16 __attribute__((ext_vector_type(16)));
typedef float f32x8 __attribute__((ext_vector_type(8)));
typedef __bf16 bf16x8v __attribute__((ext_vector_type(8)));
typedef __bf16 bf16x4v __attribute__((ext_vector_type(4)));
#define MFMA32(a, b, c) __builtin_amdgcn_mfma_f32_32x32x16_bf16((a), (b), (c), 0, 0, 0)

constexpr int NB = 8, SEQ = 4096, DM = 1024, NT = NB * SEQ;
constexpr float ALPHA = 1.41421356237f;
constexpr float LN_EPS = 1e-5f;
constexpr int NIN0 = 1920;
constexpr int NPH = 21;

constexpr size_t MiB = 1u << 20;
constexpr size_t WS_CTL = 0;
constexpr size_t WS_ROPE = 1 * MiB;
constexpr size_t WS_WIN0 = 2 * MiB;
constexpr size_t WS_WOUT0 = 6 * MiB;
constexpr size_t WS_WIN1 = 8 * MiB;
constexpr size_t WS_WOUT1 = 14 * MiB;
constexpr size_t WS_WGLU = 16 * MiB;
constexpr size_t WS_WCK1 = 16 * MiB + 512 * 1024;
constexpr size_t WS_WCV1 = 17 * MiB;
constexpr size_t WS_WCK2 = 17 * MiB + 512 * 1024;
constexpr size_t WS_WCV2 = WS_WCK2 + 16384;
constexpr size_t WS_CBIAS = WS_WCV2 + 16384;
constexpr size_t WS_S5AL = WS_CBIAS + 4096;
constexpr size_t WS_RTRW = 17 * MiB + 640 * 1024;
constexpr size_t WS_BTE = 18 * MiB;
constexpr size_t WS_BTY = 22 * MiB;
constexpr size_t WS_WGU = 42 * MiB;
constexpr size_t WS_WDN = 74 * MiB;
constexpr size_t WS_KMP = 90 * MiB;
constexpr size_t WS_WGT = 94 * MiB;
constexpr size_t WS_KMEAN = 94 * MiB + 512 * 1024;
constexpr size_t WS_KCMP = 95 * MiB;
constexpr size_t WS_VCMP = 95 * MiB + 512 * 1024;
constexpr size_t WS_ACTB = 96 * MiB;
constexpr size_t WS_MIX = 160 * MiB;
constexpr size_t WS_XP = 224 * MiB;
constexpr size_t WS_LIST2 = 416 * MiB;
constexpr size_t WS_SELM = 92 * MiB;
constexpr size_t WS_MCNT = 93 * MiB;
constexpr size_t WS_MLIST = WS_LIST2;
constexpr size_t WS_PO2 = 424 * MiB;
constexpr size_t WS_PML = 488 * MiB;
constexpr size_t WS_END = 504 * MiB;
constexpr size_t XP_Q0 = WS_XP;
constexpr size_t XP_KC = WS_XP + 32 * MiB;
constexpr size_t KVSZ = 8 * MiB;
constexpr size_t XP_GATES = WS_XP + 80 * MiB;
constexpr size_t XP_AEXT = WS_XP + 84 * MiB;
constexpr size_t XP_G5 = WS_XP + 124 * MiB;
constexpr size_t XP_YB = WS_XP;
constexpr size_t XP_H = WS_XP + 128 * MiB;
constexpr size_t XP_Q1 = WS_XP;

struct Params {
    const float* in[32];
    float* out;
    unsigned char* ws;
    int ph_lo, ph_hi;
};

DI bf16_t f2bf(float f) { unsigned u = __float_as_uint(f); return (bf16_t)((u + 0x7fffu + ((u >> 16) & 1u)) >> 16); }
DI float bf2f(bf16_t h) { return __uint_as_float(((unsigned)h) << 16); }
DI unsigned pk2(float lo, float hi) { return (unsigned)f2bf(lo) | ((unsigned)f2bf(hi) << 16); }
DI bf16x8 cvt8(f32x8 v) { return __builtin_bit_cast(bf16x8, __builtin_convertvector(v, bf16x8v)); }
DI u32x2 cvt4(f32x4 v) { return __builtin_bit_cast(u32x2, __builtin_convertvector(v, bf16x4v)); }
DI size_t kp_off(int key, int d) { return ((size_t)((key >> 5) * 4 + (d >> 4)) * 32 + (key & 31)) * 16 + (d & 15); }
DI int vp_pos(int ko) { return 8 * ((ko >> 2) & 1) + 4 * (ko >> 3) + (ko & 3); }
DI size_t vp_off(int key, int d) { return ((size_t)(key >> 4) * 64 + d) * 16 + vp_pos(key & 15); }
DI bf16_t ld_bf(const bf16_t* p) { return *p; }
DI f32x4 bf4_to_f(u32x2 w) { return (f32x4){__uint_as_float(w.x << 16), __uint_as_float(w.x & 0xffff0000u), __uint_as_float(w.y << 16), __uint_as_float(w.y & 0xffff0000u)}; }
template <int CTRL> DI float dpp_f(float v) { return __builtin_bit_cast(float, __builtin_amdgcn_update_dpp(0, __builtin_bit_cast(int, v), CTRL, 0xF, 0xF, true)); }
DI float wave_sum(float v) {
    v += dpp_f<0xB1>(v);
    v += dpp_f<0x4E>(v);
    v += dpp_f<0x141>(v);
    v += dpp_f<0x140>(v);
    { const auto s = __builtin_amdgcn_permlane16_swap(__float_as_uint(v), __float_as_uint(v), false, false); v = __uint_as_float(s[0]) + __uint_as_float(s[1]); }
    { const auto s = __builtin_amdgcn_permlane32_swap(__float_as_uint(v), __float_as_uint(v), false, false); v = __uint_as_float(s[0]) + __uint_as_float(s[1]); }
    return v;
}
DI float wave_max(float v) {
#pragma unroll
    for (int o = 32; o > 0; o >>= 1) v = fmaxf(v, __shfl_xor(v, o));
    return v;
}
DI float sigmoidf_(float x) { return __builtin_amdgcn_rcpf(1.f + __expf(-x)); }
DI float gelu_tanh(float x) { const float z = 0.7978845608028654f * (x + 0.044715f * x * x * x); return x * sigmoidf_(2.f * z); }

template <bool TRANS, bool PIN = true>
DI void gemm_kstep(const LAS unsigned char* cur, int aoff, int boff, int fq, int swz, f32x4 (&acc)[4][4]) {
    if (!PIN) {
#pragma unroll
        for (int ks = 0; ks < 2; ++ks) {
            bf16x8 af[4], bfr[4];
            const int co = ((ks * 4 + fq) ^ swz) * 16;
#pragma unroll
            for (int m = 0; m < 4; ++m) af[m] = *(const LAS bf16x8*)(cur + aoff + m * 2048 + co);
#pragma unroll
            for (int n = 0; n < 4; ++n) bfr[n] = *(const LAS bf16x8*)(cur + boff + n * 2048 + co);
#pragma unroll
            for (int m = 0; m < 4; ++m)
#pragma unroll
                for (int n = 0; n < 4; ++n) acc[m][n] = TRANS ? __builtin_amdgcn_mfma_f32_16x16x32_bf16(bfr[n], af[m], acc[m][n], 0, 0, 0) : __builtin_amdgcn_mfma_f32_16x16x32_bf16(af[m], bfr[n], acc[m][n], 0, 0, 0);
        }
        return;
    }
    bf16x8 af[2][4], bfr[2][4];
    const int co0 = (fq ^ swz) * 16, co1 = ((4 + fq) ^ swz) * 16;
    af[0][0] = *(const LAS bf16x8*)(cur + aoff + co0);
#pragma unroll
    for (int n = 0; n < 4; ++n) bfr[0][n] = *(const LAS bf16x8*)(cur + boff + n * 2048 + co0);
#pragma unroll
    for (int m = 1; m < 4; ++m) af[0][m] = *(const LAS bf16x8*)(cur + aoff + m * 2048 + co0);
    __builtin_amdgcn_sched_barrier(0);
#pragma unroll
    for (int n = 0; n < 4; ++n) acc[0][n] = TRANS ? __builtin_amdgcn_mfma_f32_16x16x32_bf16(bfr[0][n], af[0][0], acc[0][n], 0, 0, 0) : __builtin_amdgcn_mfma_f32_16x16x32_bf16(af[0][0], bfr[0][n], acc[0][n], 0, 0, 0);
    __builtin_amdgcn_sched_barrier(0);
    af[1][0] = *(const LAS bf16x8*)(cur + aoff + co1);
#pragma unroll
    for (int n = 0; n < 4; ++n) bfr[1][n] = *(const LAS bf16x8*)(cur + boff + n * 2048 + co1);
#pragma unroll
    for (int m = 1; m < 4; ++m) af[1][m] = *(const LAS bf16x8*)(cur + aoff + m * 2048 + co1);
    __builtin_amdgcn_sched_barrier(0);
#pragma unroll
    for (int m = 1; m < 4; ++m)
#pragma unroll
        for (int n = 0; n < 4; ++n) acc[m][n] = TRANS ? __builtin_amdgcn_mfma_f32_16x16x32_bf16(bfr[0][n], af[0][m], acc[m][n], 0, 0, 0) : __builtin_amdgcn_mfma_f32_16x16x32_bf16(af[0][m], bfr[0][n], acc[m][n], 0, 0, 0);
#pragma unroll
    for (int m = 0; m < 4; ++m)
#pragma unroll
        for (int n = 0; n < 4; ++n) acc[m][n] = TRANS ? __builtin_amdgcn_mfma_f32_16x16x32_bf16(bfr[1][n], af[1][m], acc[m][n], 0, 0, 0) : __builtin_amdgcn_mfma_f32_16x16x32_bf16(af[1][m], bfr[1][n], acc[m][n], 0, 0, 0);
}
constexpr int GEMM_LDS = 65536;
template <bool TRANS = true, bool PIN = true, class RowPtr, class Epi>
DI void gemm128(RowPtr rowptr, const bf16_t* __restrict__ Bt, int ldb, int K, unsigned char* smem, Epi epi, int kskip_lo = 0, int kskip_hi = 0) {
    LAS unsigned char* lds = (LAS unsigned char*)smem;
    const int tid = threadIdx.x, lane = tid & 63, wave = tid >> 6, wr = wave >> 1, wc = wave & 1, fr = lane & 15, fq = lane >> 4;
    const int schunk = ((tid & 7) ^ ((tid >> 4) & 7)) * 8;
    const bf16_t* ga[4];
#pragma unroll
    for (int i = 0; i < 4; ++i) ga[i] = rowptr(i * 32 + (tid >> 3)) + schunk;
    const bf16_t* gb = Bt + (size_t)(tid >> 3) * ldb + schunk;
    const size_t gbs = (size_t)32 * ldb;
    auto stage = [&](int kt, int s) {
#pragma unroll
        for (int i = 0; i < 4; ++i) {
            __builtin_amdgcn_global_load_lds((const unsigned*)(ga[i] + kt * 64), (LAS unsigned*)(lds + s * 32768 + (i * 256 + tid) * 16), 16, 0, 0);
            __builtin_amdgcn_global_load_lds((const unsigned*)(gb + i * gbs + kt * 64), (LAS unsigned*)(lds + s * 32768 + 16384 + (i * 256 + tid) * 16), 16, 0, 0);
        }
    };
    f32x4 acc[4][4];
#pragma unroll
    for (int m = 0; m < 4; ++m)
#pragma unroll
        for (int n = 0; n < 4; ++n) acc[m][n] = (f32x4){0.f, 0.f, 0.f, 0.f};
    const int nskip = kskip_hi - kskip_lo, nk = (K >> 6) - nskip;
    const int swz = (fr >> 1) & 7;
    const int aoff = (wr * 64 + fr) * 128, boff = 16384 + (wc * 64 + fr) * 128;
    stage(kskip_lo == 0 ? nskip : 0, 0);
#pragma unroll 1
    for (int kt = 0; kt < nk; ++kt) {
        asm volatile("s_waitcnt vmcnt(0)" ::: "memory");
        __syncthreads();
        if (kt + 1 < nk) stage(kt + 1 < kskip_lo ? kt + 1 : kt + 1 + nskip, (kt + 1) & 1);
        const LAS unsigned char* cur = lds + (kt & 1) * 32768;
        gemm_kstep<TRANS, PIN>(cur, aoff, boff, fq, swz, acc);
    }
    __syncthreads();
    epi(acc, wr, wc, lane);
}

template <bool TRANS = true, class RowPtr, class Epi, class NextRow>
DI void gemm128s(RowPtr rowptr, const bf16_t* __restrict__ Bt, int ldb, int K, unsigned char* smem, Epi epi, bool prefetched, bool has_next, NextRow nextrow, const bf16_t* __restrict__ nextBt) {
    LAS unsigned char* lds = (LAS unsigned char*)smem;
    const int tid = threadIdx.x, lane = tid & 63, wave = tid >> 6, wr = wave >> 1, wc = wave & 1, fr = lane & 15, fq = lane >> 4;
    const int schunk = ((tid & 7) ^ ((tid >> 4) & 7)) * 8;
    const bf16_t* ga[4];
#pragma unroll
    for (int i = 0; i < 4; ++i) ga[i] = rowptr(i * 32 + (tid >> 3)) + schunk;
    const bf16_t* gb = Bt + (size_t)(tid >> 3) * ldb + schunk;
    const size_t gbs = (size_t)32 * ldb;
    auto stage = [&](int kt, int s) {
#pragma unroll
        for (int i = 0; i < 4; ++i) {
            __builtin_amdgcn_global_load_lds((const unsigned*)(ga[i] + kt * 64), (LAS unsigned*)(lds + s * 32768 + (i * 256 + tid) * 16), 16, 0, 0);
            __builtin_amdgcn_global_load_lds((const unsigned*)(gb + i * gbs + kt * 64), (LAS unsigned*)(lds + s * 32768 + 16384 + (i * 256 + tid) * 16), 16, 0, 0);
        }
    };
    f32x4 acc[4][4];
#pragma unroll
    for (int m = 0; m < 4; ++m)
#pragma unroll
        for (int n = 0; n < 4; ++n) acc[m][n] = (f32x4){0.f, 0.f, 0.f, 0.f};
    const int nk = K >> 6;
    const int swz = (fr >> 1) & 7;
    const int aoff = (wr * 64 + fr) * 128, boff = 16384 + (wc * 64 + fr) * 128;
    if (!prefetched) stage(0, 0);
#pragma unroll 1
    for (int kt = 0; kt < nk; ++kt) {
        asm volatile("s_waitcnt vmcnt(0)" ::: "memory");
        __syncthreads();
        if (kt + 1 < nk) stage(kt + 1, (kt + 1) & 1);
        else if (has_next) {
#pragma unroll
            for (int i = 0; i < 4; ++i) {
                __builtin_amdgcn_global_load_lds((const unsigned*)(nextrow(i * 32 + (tid >> 3)) + schunk), (LAS unsigned*)(lds + (i * 256 + tid) * 16), 16, 0, 0);
                __builtin_amdgcn_global_load_lds((const unsigned*)(nextBt + (size_t)(tid >> 3) * ldb + schunk + i * gbs), (LAS unsigned*)(lds + 16384 + (i * 256 + tid) * 16), 16, 0, 0);
            }
        }
        const LAS unsigned char* cur = lds + (kt & 1) * 32768;
        gemm_kstep<TRANS>(cur, aoff, boff, fq, swz, acc);
    }
    epi(acc, wr, wc, lane);
}

DI int vblock() { const int G = gridDim.x; return (G & 7) == 0 ? (int)(blockIdx.x & 7) * (G >> 3) + (int)(blockIdx.x >> 3) : (int)blockIdx.x; }
DI void tile_mn(int it, int nN, int& mt, int& nt) { const int per = 8 * nN, grp = it / per, idx = it - grp * per; nt = idx >> 3; mt = grp * 8 + (idx & 7); }

DI int rope_pos(int l) { return (l & ~63) + ((2 * ((l & 31) >> 4) + ((l >> 5) & 1)) << 4) + (l & 15); }
DI int rowmap(int kind, int n) {
    if (kind == 1) {
        if (n < 512 || (n >= 512 && n < 640) || (n >= 768 && n < 896) || (n >= 1024 && n < 1152)) return rope_pos(n);
        return n < 1304 ? n : n + 104;
    }
    if (kind == 4) return n < 2048 ? rope_pos(n) : n;
    if (kind == 2) return ((n >> 5) << 6) + (n & 31);
    if (kind == 3) return ((n >> 5) << 6) + 32 + (n & 31);
    return n;
}
DI void tr_tile(const float* __restrict__ src, int K, int N, bf16_t* __restrict__ dst, int kind, int kt, int nt, float* s) {
    const int tid = threadIdx.x, k0 = kt * 64, n0 = nt * 64;
    {
        const int nn = tid & 63, kq = tid >> 6, n = n0 + nn;
#pragma unroll
        for (int i = 0; i < 16; ++i) { const int kk = kq + 4 * i; s[kk * 65 + nn] = (n < N) ? src[(size_t)(k0 + kk) * N + n] : 0.f; }
    }
    __syncthreads();
    {
        const int rn = tid >> 2, kseg = (tid & 3) * 16, n = n0 + rn;
        if (n < N) {
            unsigned w[8];
#pragma unroll
            for (int i = 0; i < 8; ++i) w[i] = pk2(s[(kseg + 2 * i) * 65 + rn], s[(kseg + 2 * i + 1) * 65 + rn]);
            bf16_t* d = dst + (size_t)rowmap(kind, n) * K + k0 + kseg;
            *(uint4*)d = make_uint4(w[0], w[1], w[2], w[3]);
            *(uint4*)(d + 8) = make_uint4(w[4], w[5], w[6], w[7]);
        }
    }
    __syncthreads();
}
struct CF { float re, im; };
DI CF cmul(CF a, CF b) { return {a.re * b.re - a.im * b.im, a.re * b.im + a.im * b.re}; }
DI CF s5_apow(const Params& P, int g, int p, float tau) {
    const float step = expf(P.in[10][g]);
    const float lr = P.in[8][g * 64 + p], li = P.in[9][g * 64 + p];
    const float mag = expf(lr * step * tau);
    float sn, cs; sincosf(li * step * tau, &sn, &cs);
    return {mag * cs, mag * sn};
}
DI CF s5_f(const Params& P, int g, int p) {
    const CF a = s5_apow(P, g, p, 1.f);
    const float lr = P.in[8][g * 64 + p], li = P.in[9][g * 64 + p];
    const float den = lr * lr + li * li;
    return {((a.re - 1.f) * lr + a.im * li) / den, (a.im * lr - (a.re - 1.f) * li) / den};
}
DI void phase0(const Params& P, unsigned char* smem) {
    const int tid = threadIdx.x;
    unsigned char* ws = P.ws;
    float* sf = (float*)smem;
    constexpr int N_TR0 = 16 * 29, N_TR1 = 256, N_TR2 = 16 * 48, N_TR3 = 256, N_TR4 = 64, N_TR5 = 64, N_TR6 = 64, N_TR7 = 2, N_TR8 = 2;
    constexpr int N_TRG = 64 * 32, N_TRU = 64 * 32, N_TRD = 64 * 32;
    constexpr int N_X = NT * DM / 8192, N_ROPE = 512, N_CB = 16, N_AL = 8, N_BTE = 256, N_BTYM = 32 * 63, N_BTYQ = 4096, N_ZP = 13;
    constexpr int N_RW = 2 * 36864 / 256;
    constexpr int TOTAL = N_RW + N_TR0 + N_TR1 + N_TR4 + N_TR5 + N_TR6 + N_TR7 + N_TR8 + N_X + N_ROPE + N_CB + N_AL + N_BTE + N_BTYM + N_BTYQ + N_ZP;
    for (int it0 = blockIdx.x; it0 < TOTAL; it0 += gridDim.x) {
        int it = it0;
        if (it < N_RW) {
            const int e = it * 256 + tid, layer = e / 36864, r = e % 36864;
            float* dst = (float*)(ws + WS_RTRW) + (size_t)layer * 36864;
            if (r < 4096) { const int o = r & 3, l = (r >> 2) & 63, jk = r >> 8, d = 4 * l + 256 * (jk >> 2) + (jk & 3); dst[r] = P.in[25][((size_t)layer * 1024 + d) * 4 + o]; }
            else { const int q = r - 4096, o = q & 3, l = (q >> 2) & 63, hf = (q >> 8) & 1, jk = (q >> 9) & 15, g = q >> 13, d = 4 * l + 256 * (jk >> 2) + (jk & 3);
                   dst[r] = P.in[27][(((size_t)layer * 4 + g) * 1024 + d) * 8 + hf * 4 + o]; }
            continue;
        } it -= N_RW;
        if (it < N_TR0) { tr_tile(P.in[1], 1024, 1816, (bf16_t*)(ws + WS_WIN0), 1, it / 29, it % 29, sf); continue; } it -= N_TR0;
        if (it < N_TR1) { tr_tile(P.in[18], 1024, 1024, (bf16_t*)(ws + WS_WOUT0), 0, it / 16, it % 16, sf); continue; } it -= N_TR1;
        if (it < N_TR4) { tr_tile(P.in[16], 512, 512, (bf16_t*)(ws + WS_WGLU), 0, it / 8, it % 8, sf); continue; } it -= N_TR4;
        if (it < N_TR5) { tr_tile(P.in[4], 2048, 128, (bf16_t*)(ws + WS_WCK1), 0, it / 2, it % 2, sf); continue; } it -= N_TR5;
        if (it < N_TR6) { tr_tile(P.in[6], 2048, 128, (bf16_t*)(ws + WS_WCV1), 0, it / 2, it % 2, sf); continue; } it -= N_TR6;
        if (it < N_TR7) { tr_tile(P.in[5], 128, 64, (bf16_t*)(ws + WS_WCK2), 0, it, 0, sf); continue; } it -= N_TR7;
        if (it < N_TR8) { tr_tile(P.in[7], 128, 64, (bf16_t*)(ws + WS_WCV2), 0, it, 0, sf); continue; } it -= N_TR8;
        if (it < N_X) {
            const float* x = P.in[0]; bf16_t* xb = (bf16_t*)(ws + WS_ACTB);
#pragma unroll
            for (int i = 0; i < 4; ++i) {
                const size_t idx = (size_t)it * 8192 + i * 2048 + tid * 8;
                const f32x4 a = __builtin_nontemporal_load((const f32x4*)(x + idx)), b = __builtin_nontemporal_load((const f32x4*)(x + idx + 4));
                *(uint4*)(xb + idx) = make_uint4(pk2(a.x, a.y), pk2(a.z, a.w), pk2(b.x, b.y), pk2(b.z, b.w));
            }
            continue;
        } it -= N_X;
        if (it < N_ROPE) {
            const int e = it * 256 + tid, pos = e >> 5, i = e & 31;
            const float inv = 1.0f / powf(10000.0f, (float)(2 * i) / 64.0f);
            const float ang = (float)pos * inv;
            ((float*)(ws + WS_ROPE))[e] = (float)cos((double)ang);
            ((float*)(ws + WS_ROPE))[4096 * 32 + e] = (float)sin((double)ang);
            continue;
        } it -= N_ROPE;
        if (it < N_CB) {
            const int kv = it >> 3, j0 = (it & 7) * 16, j = j0 + (tid & 15), sl = tid >> 4;
            const float* pe = P.in[kv ? 3 : 2]; const float* w1 = P.in[kv ? 6 : 4];
            float a = 0.f;
            for (int i = sl * 128; i < sl * 128 + 128; ++i) a += pe[i] * w1[(size_t)i * 128 + j];
            sf[tid] = a; __syncthreads();
            if (tid < 16) { float t = 0.f; for (int q = 0; q < 16; ++q) t += sf[q * 16 + tid]; ((float*)(ws + WS_CBIAS))[kv * 128 + j0 + tid] = t; }
            __syncthreads();
            continue;
        } it -= N_CB;
        if (it < N_AL) {
            const int e = it * 256 + tid, g = e >> 6, p = e & 63;
            const CF a = s5_apow(P, g, p, 32.f);
            ((float*)(ws + WS_S5AL))[e * 2] = a.re; ((float*)(ws + WS_S5AL))[e * 2 + 1] = a.im;
            continue;
        } it -= N_AL;
        if (it < N_BTE) {
            const int e = it * 256 + tid, g = e >> 11, p = (e >> 5) & 63, r = e & 31;
            const CF w = cmul(s5_apow(P, g, p, (float)(31 - r)), s5_f(P, g, p));
            bf16_t* d = (bf16_t*)(ws + WS_BTE) + (size_t)g * 128 * 512;
#pragma unroll
            for (int c = 0; c < 16; ++c) {
                const CF bb = {P.in[11][(g * 64 + p) * 16 + c], P.in[12][(g * 64 + p) * 16 + c]};
                const CF v = cmul(w, bb);
                d[(size_t)p * 512 + r * 16 + c] = f2bf(v.re);
                d[(size_t)(64 + p) * 512 + r * 16 + c] = f2bf(v.im);
            }
            continue;
        } it -= N_BTE;
        if (it < N_BTYM) {
            const int g = it / 63, dd = it % 63 - 31, ch = tid >> 4, c = tid & 15;
            float val = 0.f;
            if (dd >= 0) {
                float* sw = sf; float* sb = sf + 128; float* sc = sf + 128 + 2048;
                if (tid < 64) { const CF w = cmul(s5_apow(P, g, tid, (float)dd), s5_f(P, g, tid)); sw[2 * tid] = w.re; sw[2 * tid + 1] = w.im; }
#pragma unroll
                for (int i = 0; i < 4; ++i) {
                    const int e = tid + 256 * i;
                    sb[2 * e] = P.in[11][(size_t)g * 1024 + e]; sb[2 * e + 1] = P.in[12][(size_t)g * 1024 + e];
                    sc[2 * e] = P.in[13][(size_t)g * 1024 + e]; sc[2 * e + 1] = P.in[14][(size_t)g * 1024 + e];
                }
                __syncthreads();
#pragma unroll 8
                for (int p = 0; p < 64; ++p) {
                    const CF bb = {sb[2 * (p * 16 + c)], sb[2 * (p * 16 + c) + 1]};
                    const CF cc = {sc[2 * (ch * 64 + p)], sc[2 * (ch * 64 + p) + 1]};
                    const CF w = {sw[2 * p], sw[2 * p + 1]};
                    val += cmul(cc, cmul(w, bb)).re;
                }
                __syncthreads();
            }
            bf16_t* d = (bf16_t*)(ws + WS_BTY) + (size_t)g * 512 * 640;
            const bf16_t hv = f2bf(val);
            for (int r = 0; r < 32; ++r) { const int s = r + dd; if (s >= 0 && s < 32) d[(size_t)(s * 16 + ch) * 640 + r * 16 + c] = hv; }
            continue;
        } it -= N_BTYM;
        if (it < N_BTYQ) {
            const int e = it * 256 + tid, g = e >> 15, s = (e >> 10) & 31, ch = (e >> 6) & 15, p = e & 63;
            const CF cc = {P.in[13][(g * 16 + ch) * 64 + p], P.in[14][(g * 16 + ch) * 64 + p]};
            const CF w = cmul(cc, s5_apow(P, g, p, (float)(s + 1)));
            bf16_t* d = (bf16_t*)(ws + WS_BTY) + ((size_t)g * 512 + s * 16 + ch) * 640 + 512;
            d[p] = f2bf(w.re); d[64 + p] = f2bf(-w.im);
            continue;
        } it -= N_BTYQ;
        {
            uint4* d = (uint4*)((bf16_t*)(ws + WS_WIN0) + (size_t)(1304 + it * 8) * 1024);
#pragma unroll
            for (int i = 0; i < 4; ++i) d[i * 256 + tid] = make_uint4(0, 0, 0, 0);
        }
    }
}

DI void phase_inproj0(const Params& P, unsigned char* smem) {
    unsigned char* ws = P.ws;
    const bf16_t* A = (const bf16_t*)(ws + WS_ACTB);
    const float* cosT = (const float*)(ws + WS_ROPE);
    const float* sinT = cosT + 4096 * 32;
    constexpr int NTN = NIN0 / 128;
    bool pre = false;
    for (int it = vblock(); it < (NT / 128) * NTN; it += gridDim.x) {
        int mt, nt; tile_mn(it, NTN, mt, nt);
        const int m0 = mt * 128;
        auto rowptr = [=](int r) { return A + (size_t)(m0 + r) * 1024; };
        const bf16_t* Bt = (const bf16_t*)(ws + WS_WIN0) + (size_t)nt * 128 * 1024;
        const bool hn = it + (int)gridDim.x < (NT / 128) * NTN;
        int mtn = 0, ntn = 0; if (hn) tile_mn(it + gridDim.x, NTN, mtn, ntn);
        auto nextrow = [=](int r) { return A + (size_t)(mtn * 128 + r) * 1024; };
        const bf16_t* nBt = (const bf16_t*)(ws + WS_WIN0) + (size_t)ntn * 128 * 1024;
        if (nt == 7 || nt == 9) {
            auto epi = [=](f32x4 (&acc)[4][4], int wr, int wc, int lane) {
                const int fr = lane & 15, fq = lane >> 4, which = nt == 7 ? 3 : 5, g = wc;
#pragma unroll
                for (int m = 0; m < 4; ++m) {
                    const int t = m0 + wr * 64 + m * 16 + fq * 4, s = t & 4095, b = t >> 12;
                    bf16_t* dst = (bf16_t*)(ws + XP_KC + (size_t)which * KVSZ) + (size_t)(b * 2 + g) * 4096 * 64;
#pragma unroll
                    for (int n = 0; n < 4; ++n) *(u32x2*)(dst + vp_off(s, n * 16 + fr)) = cvt4(acc[m][n]);
                }
            };
            gemm128s<false>(rowptr, Bt, 1024, 1024, smem, epi, pre, hn, nextrow, nBt);
            pre = hn;
            continue;
        }
        auto epi = [=](f32x4 (&acc)[4][4], int wr, int wc, int lane) {
            const int u64 = nt * 2 + wc, fr = lane & 15, fq = lane >> 4;
#pragma unroll
            for (int m = 0; m < 4; ++m) {
                const int t = m0 + wr * 64 + m * 16 + fr, s = t & 4095, b = t >> 12;
                if (u64 < 20) {
                    const bool isq = u64 < 8;
                    const int which = (u64 - 8) >> 1, g = (u64 - 8) & 1;
                    if (isq || ((which & 1) == 0)) {
#pragma unroll
                        for (int n2 = 0; n2 < 2; ++n2) {
                            const int i = n2 * 16 + fq * 4;
                            const f32x4 c = *(const f32x4*)(cosT + s * 32 + i), sn = *(const f32x4*)(sinT + s * 32 + i);
                            const f32x4 x1 = acc[m][2 * n2], x2 = acc[m][2 * n2 + 1];
                            const u32x2 o1 = cvt4(x1 * c - x2 * sn), o2 = cvt4(x1 * sn + x2 * c);
                            if (isq) { bf16_t* dst = (bf16_t*)(ws + XP_Q0) + (size_t)t * 512 + u64 * 64; *(u32x2*)(dst + i) = o1; *(u32x2*)(dst + i + 32) = o2; }
                            else {
                                bf16_t* dst = (bf16_t*)(ws + XP_KC + (size_t)which * KVSZ) + (size_t)(b * 2 + g) * 4096 * 64;
                                if (which == 0) { *(u32x2*)(dst + (size_t)s * 64 + i) = o1; *(u32x2*)(dst + (size_t)s * 64 + i + 32) = o2; }
                                else { *(u32x2*)(dst + kp_off(s, i)) = o1; *(u32x2*)(dst + kp_off(s, i + 32)) = o2; }
                            }
                        }
                    } else {
                        bf16_t* dst = (bf16_t*)(ws + XP_KC + (size_t)which * KVSZ) + ((size_t)(b * 2 + g) * 4096 + s) * 64;
#pragma unroll
                        for (int n = 0; n < 4; ++n) *(u32x2*)(dst + n * 16 + fq * 4) = cvt4(acc[m][n]);
                    }
                } else if (u64 == 20) {
#pragma unroll
                    for (int n = 0; n < 2; ++n) {
                        const int c0 = n * 16 + fq * 4;
                        if (c0 < 24) { f32x4 o; o.x = sigmoidf_(acc[m][n].x); o.y = sigmoidf_(acc[m][n].y); o.z = sigmoidf_(acc[m][n].z); o.w = sigmoidf_(acc[m][n].w); *(f32x4*)((float*)(ws + XP_GATES) + (size_t)t * 24 + c0) = o; }
                    }
                } else if (u64 >= 22) {
#pragma unroll
                    for (int n = 0; n < 4; ++n) {
                        const int g5 = (u64 - 22) * 4 + n;
                        *(u32x2*)((bf16_t*)(ws + XP_AEXT) + ((size_t)g5 * 1024 + (t >> 5)) * 640 + (t & 31) * 16 + fq * 4) = cvt4(acc[m][n]);
                    }
                }
            }
        };
        gemm128s(rowptr, Bt, 1024, 1024, smem, epi, pre, hn, nextrow, nBt);
        pre = hn;
    }
}

constexpr int N_LATE = 16 * 48 + 256 + 3 * 64 * 32;
DI void late_weights(const Params& P, unsigned char* smem, int it) {
    unsigned char* ws = P.ws;
    float* sf = (float*)smem;
    constexpr int N_TR2 = 16 * 48, N_TR3 = 256, N_TRG = 64 * 32, N_TRU = 64 * 32;
    if (it < N_TR2) { tr_tile(P.in[19], 1024, 3072, (bf16_t*)(ws + WS_WIN1), 4, it / 48, it % 48, sf); return; } it -= N_TR2;
    if (it < N_TR3) { tr_tile(P.in[20], 1024, 1024, (bf16_t*)(ws + WS_WOUT1), 0, it / 16, it % 16, sf); return; } it -= N_TR3;
    if (it < N_TRG) { const int mat = it >> 5, r = it & 31; tr_tile(P.in[29] + (size_t)mat * 1024 * 128, 1024, 128, (bf16_t*)(ws + WS_WGU) + (size_t)mat * 256 * 1024, 2, r >> 1, r & 1, sf); return; } it -= N_TRG;
    if (it < N_TRU) { const int mat = it >> 5, r = it & 31; tr_tile(P.in[30] + (size_t)mat * 1024 * 128, 1024, 128, (bf16_t*)(ws + WS_WGU) + (size_t)mat * 256 * 1024, 3, r >> 1, r & 1, sf); return; } it -= N_TRU;
    { const int mat = it >> 5, r = it & 31; tr_tile(P.in[31] + (size_t)mat * 128 * 1024, 128, 1024, (bf16_t*)(ws + WS_WDN) + (size_t)mat * 1024 * 128, 0, r >> 4, r & 15, sf); }
}

DI void s5y_tile(const Params& P, unsigned char* smem, int g, int mt, int nt);
DI void phase_cmp_s5e(const Params& P, unsigned char* smem) {
    unsigned char* ws = P.ws;
    const int tid = threadIdx.x, lane = tid & 63, wave = tid >> 6;
    const int G = gridDim.x, bid = blockIdx.x;
    const bool split = G >= 384;
    const int nmine = !split ? (320 + N_LATE + G - 1 - bid) / G : (bid < 320 ? 1 : (N_LATE + (G - 320) - 1 - (bid - 320)) / (G - 320));
    for (int k = 0; k < nmine; ++k) {
        const int it = !split ? bid + k * G : (bid < 320 ? bid : 320 + (bid - 320) + k * (G - 320));
        if (it >= 64 + 256) { late_weights(P, smem, it - 320); continue; }
        if (it < 64) {
            const int kv = it >> 5, bg = (it >> 1) & 15, mt = it & 1;
            const bf16_t* src = (const bf16_t*)(ws + XP_KC + (size_t)kv * KVSZ) + (size_t)bg * 4096 * 64;
            const float* cb = (const float*)(ws + WS_CBIAS) + kv * 128;
            bf16_t* sH = (bf16_t*)smem;
            auto rowptr = [=](int r) { int rr = mt * 128 + r; rr = rr > 254 ? 254 : rr; return src + (size_t)rr * 1024; };
            auto epi = [=](f32x4 (&acc)[4][4], int wr, int wc, int ln) {
                const int fr = ln & 15, fq = ln >> 4;
#pragma unroll
                for (int m = 0; m < 4; ++m)
#pragma unroll
                    for (int n = 0; n < 4; ++n)
#pragma unroll
                        for (int j = 0; j < 4; ++j) {
                            const int r = wr * 64 + m * 16 + fr, c = wc * 64 + n * 16 + fq * 4 + j;
                            sH[r * 136 + c] = f2bf(gelu_tanh(acc[m][n][j] + cb[c]));
                        }
            };
            gemm128(rowptr, (const bf16_t*)(ws + (kv ? WS_WCV1 : WS_WCK1)), 2048, 2048, smem, epi);
            __syncthreads();
            const bf16_t* W2 = (const bf16_t*)(ws + (kv ? WS_WCV2 : WS_WCK2));
            f32x4 a2[2][4];
#pragma unroll
            for (int m = 0; m < 2; ++m)
#pragma unroll
                for (int n = 0; n < 4; ++n) a2[m][n] = (f32x4){0.f, 0.f, 0.f, 0.f};
#pragma unroll
            for (int ks = 0; ks < 4; ++ks) {
                bf16x8 af[2], bfr[4];
#pragma unroll
                for (int m = 0; m < 2; ++m) af[m] = *(const bf16x8*)(sH + (wave * 32 + m * 16 + (lane & 15)) * 136 + ks * 32 + (lane >> 4) * 8);
#pragma unroll
                for (int n = 0; n < 4; ++n) bfr[n] = *(const bf16x8*)(W2 + (n * 16 + (lane & 15)) * 128 + ks * 32 + (lane >> 4) * 8);
#pragma unroll
                for (int m = 0; m < 2; ++m)
#pragma unroll
                    for (int n = 0; n < 4; ++n) a2[m][n] = __builtin_amdgcn_mfma_f32_16x16x32_bf16(af[m], bfr[n], a2[m][n], 0, 0, 0);
            }
            bf16_t* dst = (bf16_t*)(ws + (kv ? WS_VCMP : WS_KCMP)) + (size_t)bg * 256 * 64;
#pragma unroll
            for (int m = 0; m < 2; ++m)
#pragma unroll
                for (int n = 0; n < 4; ++n)
#pragma unroll
                    for (int j = 0; j < 4; ++j) {
                        const int row = mt * 128 + wave * 32 + m * 16 + (lane >> 4) * 4 + j, col = n * 16 + (lane & 15);
                        dst[kv ? vp_off(row, col) : kp_off(row, col)] = row < 255 ? f2bf(a2[m][n][j]) : (bf16_t)0;
                    }
            __syncthreads();
        } else {
            const int it2 = it - 64, g = it2 >> 3, b = it2 & 7;
            bf16_t* aext = (bf16_t*)(ws + XP_AEXT) + ((size_t)g * 1024 + b * 128) * 640;
            float* sE = (float*)smem;
            auto rowptr = [=](int r) { return (const bf16_t*)aext + (size_t)r * 640; };
            auto epi = [=](f32x4 (&acc)[4][4], int wr, int wc, int ln) {
                const int fr = ln & 15, fq = ln >> 4;
#pragma unroll
                for (int m = 0; m < 4; ++m)
#pragma unroll
                    for (int n = 0; n < 4; ++n)
#pragma unroll
                        for (int j = 0; j < 4; ++j) sE[(wr * 64 + m * 16 + fr) * 129 + wc * 64 + n * 16 + fq * 4 + j] = acc[m][n][j];
            };
            gemm128<true, false>(rowptr, (const bf16_t*)(ws + WS_BTE) + (size_t)g * 128 * 512, 512, 512, smem, epi);
            __syncthreads();
            {
                const int p = tid & 63, c0 = wave * 32;
                const float ar = ((const float*)(ws + WS_S5AL))[(g * 64 + p) * 2], ai = ((const float*)(ws + WS_S5AL))[(g * 64 + p) * 2 + 1];
                float* send = (float*)(smem + 128 * 129 * 4);
                float xr = 0.f, xi = 0.f;
                for (int c = c0; c < c0 + 32; ++c) {
                    const float er = sE[c * 129 + p], ei = sE[c * 129 + 64 + p];
                    const float nr = ar * xr - ai * xi + er, ni = ar * xi + ai * xr + ei;
                    xr = nr; xi = ni;
                }
                send[(wave * 64 + p) * 2] = xr; send[(wave * 64 + p) * 2 + 1] = xi;
                float qr = ar, qi = ai;
#pragma unroll
                for (int k = 0; k < 5; ++k) { const float tr = qr * qr - qi * qi, ti = 2.f * qr * qi; qr = tr; qi = ti; }
                __syncthreads();
                xr = 0.f; xi = 0.f;
                for (int k = 0; k < wave; ++k) {
                    const float er = send[(k * 64 + p) * 2], ei = send[(k * 64 + p) * 2 + 1];
                    const float nr = qr * xr - qi * xi + er, ni = qr * xi + qi * xr + ei;
                    xr = nr; xi = ni;
                }
                for (int c = c0; c < c0 + 32; ++c) {
                    aext[(size_t)c * 640 + 512 + p] = f2bf(xr);
                    aext[(size_t)c * 640 + 576 + p] = f2bf(xi);
                    const float er = sE[c * 129 + p], ei = sE[c * 129 + 64 + p];
                    const float nr = ar * xr - ai * xi + er, ni = ar * xi + ai * xr + ei;
                    xr = nr; xi = ni;
                }
            }
            asm volatile("s_waitcnt vmcnt(0)" ::: "memory");
            __syncthreads();
#pragma unroll 1
            for (int nt = 0; nt < 4; ++nt) s5y_tile(P, smem, g, b, nt);
        }
    }
}

DI void s5y_tile(const Params& P, unsigned char* smem, int g, int mt, int nt) {
    unsigned char* ws = P.ws;
    const bf16_t* aext = (const bf16_t*)(ws + XP_AEXT) + (size_t)g * 1024 * 640;
    const float* dsk = P.in[15];
    auto rowptr = [=](int r) { return aext + (size_t)(mt * 128 + r) * 640; };
    auto epi = [=](f32x4 (&acc)[4][4], int wr, int wc, int ln) {
        const int fr = ln & 15, fq = ln >> 4;
        const f32x4 dk = *(const f32x4*)(dsk + g * 16 + fq * 4);
#pragma unroll
        for (int m = 0; m < 4; ++m) {
            const int cr = mt * 128 + wr * 64 + m * 16 + fr;
#pragma unroll
            for (int n = 0; n < 4; ++n) {
                const int sp = nt * 8 + wc * 4 + n, t = cr * 32 + sp;
                const f32x4 u = bf4_to_f(*(const u32x2*)(aext + (size_t)cr * 640 + sp * 16 + fq * 4));
                const f32x4 y = acc[m][n] + dk * u;
                *(u32x2*)((bf16_t*)(ws + XP_G5) + (size_t)t * 512 + g * 16 + fq * 4) = cvt4((f32x4){gelu_tanh(y.x), gelu_tanh(y.y), gelu_tanh(y.z), gelu_tanh(y.w)});
            }
        }
    };
    gemm128<true, false>(rowptr, (const bf16_t*)(ws + WS_BTY) + ((size_t)g * 512 + nt * 128) * 640, 640, 640, smem, epi, 2 * nt + 2, 8);
}
struct FA { f32x16 o0, o1; float m, l; };
DI void fa_init(FA& st) {
#pragma unroll
    for (int i = 0; i < 16; ++i) { st.o0[i] = 0.f; st.o1[i] = 0.f; }
    st.m = -1e30f; st.l = 0.f;
}
constexpr float FA_THR = 8.f;
template <int MODE, class Valid>
DI void fa_tile(FA& st, const bf16x8 (&qf)[4], const LAS bf16_t* Kt, const LAS bf16_t* Vt, int r, int h, float c, bool rowok, Valid valid) {
    const LAS bf16_t* kb = Kt + r * 16 + 8 * h;
    const LAS bf16_t* vb = Vt + r * 16 + 8 * h;
    bf16x8 kf[4], vf[4];
#pragma unroll
    for (int ks = 0; ks < 4; ++ks) kf[ks] = *(const LAS bf16x8*)(kb + ks * 512);
#pragma unroll
    for (int sub = 0; sub < 2; ++sub) {
        f32x16 acc;
#pragma unroll
        for (int i = 0; i < 16; ++i) acc[i] = 0.f;
#pragma unroll
        for (int ks = 0; ks < 4; ++ks) acc = MFMA32(kf[ks], qf[ks], acc);
#pragma unroll
        for (int s2 = 0; s2 < 2; ++s2) { vf[2 * s2] = *(const LAS bf16x8*)(vb + ((sub * 2 + s2) * 64) * 16); vf[2 * s2 + 1] = *(const LAS bf16x8*)(vb + ((sub * 2 + s2) * 64 + 32) * 16); }
        if (sub == 0) {
#pragma unroll
            for (int ks = 0; ks < 4; ++ks) kf[ks] = *(const LAS bf16x8*)(kb + (4 + ks) * 512);
        }
        __builtin_amdgcn_sched_barrier(0);
        float mx = -INFINITY;
#pragma unroll
        for (int i = 0; i < 16; ++i) {
            if (MODE == 2) { const int koff = sub * 32 + (i & 3) + 8 * (i >> 2) + 4 * h; acc[i] = valid(koff) ? acc[i] : -INFINITY; }
            mx = fmaxf(mx, acc[i]);
        }
        {
            const auto sw = __builtin_amdgcn_permlane32_swap(__float_as_uint(mx), __float_as_uint(mx), false, false);
            mx = fmaxf(__uint_as_float(sw[0]), __uint_as_float(sw[1]));
        }
        const float cand = mx * c;
        const bool upd = cand > st.m + FA_THR;
        if (__ballot(upd)) {
            const float mn = upd ? cand : st.m, alpha = __builtin_amdgcn_exp2f(st.m - mn);
            st.m = mn; st.l *= alpha;
#pragma unroll
            for (int i = 0; i < 16; ++i) { st.o0[i] *= alpha; st.o1[i] *= alpha; }
        }
        const float nb = (MODE == 1 && !rowok) ? -INFINITY : -st.m;
        float ps0 = 0.f, ps1 = 0.f;
#pragma unroll
        for (int i = 0; i < 16; i += 2) {
            acc[i] = __builtin_amdgcn_exp2f(__builtin_fmaf(acc[i], c, nb));
            acc[i + 1] = __builtin_amdgcn_exp2f(__builtin_fmaf(acc[i + 1], c, nb));
            ps0 += acc[i]; ps1 += acc[i + 1];
        }
        st.l += ps0 + ps1;
#pragma unroll
        for (int s2 = 0; s2 < 2; ++s2) {
            const bf16x8 pk = cvt8((f32x8){acc[8 * s2], acc[8 * s2 + 1], acc[8 * s2 + 2], acc[8 * s2 + 3], acc[8 * s2 + 4], acc[8 * s2 + 5], acc[8 * s2 + 6], acc[8 * s2 + 7]});
            st.o0 = MFMA32(vf[2 * s2], pk, st.o0);
            st.o1 = MFMA32(vf[2 * s2 + 1], pk, st.o1);
        }
    }
}
DI void fa_issue(const bf16_t* gK, const bf16_t* gV, LAS unsigned char* buf, int tid) {
    __builtin_amdgcn_global_load_lds((const unsigned*)(gK + tid * 8), (LAS unsigned*)(buf + tid * 16), 16, 0, 0);
    __builtin_amdgcn_global_load_lds((const unsigned*)(gK + (tid + 256) * 8), (LAS unsigned*)(buf + (tid + 256) * 16), 16, 0, 0);
    __builtin_amdgcn_global_load_lds((const unsigned*)(gV + tid * 8), (LAS unsigned*)(buf + 8192 + tid * 16), 16, 0, 0);
    __builtin_amdgcn_global_load_lds((const unsigned*)(gV + (tid + 256) * 8), (LAS unsigned*)(buf + 8192 + (tid + 256) * 16), 16, 0, 0);
}
DI void fa_wait(int j, int n) {
    const int rem = n - 1 - j;
    if (rem >= 2) asm volatile("s_waitcnt vmcnt(8)" ::: "memory");
    else if (rem == 1) asm volatile("s_waitcnt vmcnt(4)" ::: "memory");
    else asm volatile("s_waitcnt vmcnt(0)" ::: "memory");
    __builtin_amdgcn_s_barrier();
    asm volatile("" ::: "memory");
}

constexpr int NSA_LDS_IMP = 65536;
constexpr int NSA_LDS_SCS = NSA_LDS_IMP + 8192;
constexpr int NSA_LDS_MSK = NSA_LDS_SCS + 1024;
DI void phase_nsa(const Params& P, unsigned char* smem) {
    unsigned char* ws = P.ws;
    const int tid = threadIdx.x, lane = tid & 63, wave = tid >> 6, r = lane & 31, h = lane >> 5;
    const float c = 0.125f * 1.4426950408889634f;
    LAS unsigned char* lds = (LAS unsigned char*)smem;
    float* impw = (float*)(smem + NSA_LDS_IMP) + wave * 512;
    float* scs = (float*)(smem + NSA_LDS_SCS) + wave * 64;
    unsigned long long* mskw = (unsigned long long*)(smem + NSA_LDS_MSK) + wave * 8;
    for (int it = blockIdx.x; it < 2048; it += gridDim.x) {
        const int qt = 127 - (it >> 4), bg = it & 15, b = bg >> 1, g = bg & 1, t0 = qt * 32, qblk = t0 >> 6;
        const int ql = r >> 2, z = r & 3, s = t0 + wave * 8 + ql, t = b * 4096 + s;
        const bf16_t* Qg = (const bf16_t*)(ws + XP_Q0) + (size_t)t * 512 + (g * 4 + z) * 64;
        bf16x8 qf[4];
#pragma unroll
        for (int ks = 0; ks < 4; ++ks) qf[ks] = *(const bf16x8*)(Qg + ks * 16 + 8 * h);
        const float* gt = (const float*)(ws + XP_GATES) + (size_t)t * 24 + (g * 4 + z) * 3;
        const float g_c = gt[0], g_s = gt[1], g_w = gt[2];
        const bf16_t* Kc = (const bf16_t*)(ws + WS_KCMP) + (size_t)bg * 256 * 64;
        const bf16_t* Vc = (const bf16_t*)(ws + WS_VCMP) + (size_t)bg * 256 * 64;
        const bf16_t* Ks = (const bf16_t*)(ws + XP_KC + 2 * KVSZ) + (size_t)bg * 4096 * 64;
        const bf16_t* Vs = (const bf16_t*)(ws + XP_KC + 3 * KVSZ) + (size_t)bg * 4096 * 64;
        const bf16_t* Kw = (const bf16_t*)(ws + XP_KC + 4 * KVSZ) + (size_t)bg * 4096 * 64;
        const bf16_t* Vw = (const bf16_t*)(ws + XP_KC + 5 * KVSZ) + (size_t)bg * 4096 * 64;
        const int nct = ((t0 >> 4) + 1 + 63) >> 6;
        const int w0 = (t0 - 255) < 0 ? 0 : (t0 - 255) >> 6;
        const int e1 = nct, e2 = 2 * nct, e3 = e2 + qblk + 1, e4 = e3 + (qblk - w0 + 1);
        const int nc = s >= 31 ? ((s - 31) >> 4) + 1 : 0;
        const int s_lo = t0 + wave * 8, s_hi = s_lo + 7, nc_min = s_lo >= 31 ? ((s_lo - 31) >> 4) + 1 : 0;
        for (int i = lane; i < 512; i += 64) impw[i] = 0.f;
        auto tile_ptrs = [&](int i, const bf16_t*& gk, const bf16_t*& gv) {
            if (i < e1) { gk = Kc + (size_t)i * 4096; gv = Vc + (size_t)i * 4096; }
            else if (i < e2) { gk = Kc + (size_t)(i - e1) * 4096; gv = Vc + (size_t)(i - e1) * 4096; }
            else if (i < e3) { gk = Ks + (size_t)(i - e2) * 4096; gv = Vs + (size_t)(i - e2) * 4096; }
            else { gk = Kw + (size_t)(w0 + i - e3) * 4096; gv = Vw + (size_t)(w0 + i - e3) * 4096; }
        };
        FA st; fa_init(st);
        f32x16 out0, out1;
#pragma unroll
        for (int i = 0; i < 16; ++i) { out0[i] = 0.f; out1[i] = 0.f; }
        float m_c = -1e30f, il_c = 0.f;
        unsigned long long mymask = 0ull;
        asm volatile("s_waitcnt vmcnt(0)" ::: "memory");
        __builtin_amdgcn_s_barrier();
#pragma unroll
        for (int i = 0; i < 3; ++i) if (i < e4) { const bf16_t *gk, *gv; tile_ptrs(i, gk, gv); fa_issue(gk, gv, lds + i * 16384, tid); }
        for (int i = 0; i < e4; ++i) {
            fa_wait(i, e4);
            if (i + 3 < e4) { const bf16_t *gk, *gv; tile_ptrs(i + 3, gk, gv); fa_issue(gk, gv, lds + ((i + 3) & 3) * 16384, tid); }
            const LAS bf16_t* cur = (const LAS bf16_t*)(lds + (i & 3) * 16384);
            if (i < e1) {
                const int nb = i * 64;
                { if (nb + 63 < nc_min) fa_tile<0>(st, qf, cur, cur + 4096, r, h, c, true, [=](int) { return true; }); else fa_tile<2>(st, qf, cur, cur + 4096, r, h, c, true, [=](int koff) { return nb + koff < nc; }); }
                if (i == e1 - 1) {
                    const float l = st.l + __shfl_xor(st.l, 32);
                    il_c = 1.f / fmaxf(l, 1e-30f); m_c = st.m;
                    const float f = g_c * il_c;
#pragma unroll
                    for (int k = 0; k < 16; ++k) { out0[k] = st.o0[k] * f; out1[k] = st.o1[k] * f; }
                    fa_init(st);
                }
            } else if (i < e2) {
                const int nb = (i - e1) * 64;
#pragma unroll
                for (int sub = 0; sub < 2; ++sub) {
                    f32x16 acc;
#pragma unroll
                    for (int k = 0; k < 16; ++k) acc[k] = 0.f;
#pragma unroll
                    for (int ks = 0; ks < 4; ++ks) acc = MFMA32(*(const LAS bf16x8*)(cur + ((sub * 4 + ks) * 32 + r) * 16 + 8 * h), qf[ks], acc);
#pragma unroll
                    for (int q4 = 0; q4 < 4; ++q4) {
                        float p[4];
#pragma unroll
                        for (int k = 0; k < 4; ++k) {
                            const int n = nb + sub * 32 + 8 * q4 + 4 * h + k;
                            p[k] = (n < nc) ? __builtin_amdgcn_exp2f(acc[4 * q4 + k] * c - m_c) * il_c : 0.f;
                        }
                        float a = (p[0] + p[1]) + (p[2] + 0.5f * p[3]), cn = 0.5f * p[3];
                        a += __shfl_xor(a, 1); a += __shfl_xor(a, 2);
                        cn += __shfl_xor(cn, 1); cn += __shfl_xor(cn, 2);
                        const int jb = ((nb + sub * 32) >> 2) + 2 * q4 + h;
                        if (z == 0) { atomicAdd(&impw[ql * 64 + jb], a); if (jb + 1 < 64) atomicAdd(&impw[ql * 64 + jb + 1], cn); }
                    }
                }
                if (i == e2 - 1) {
                    __builtin_amdgcn_wave_barrier();
#pragma unroll 1
                    for (int qq = 0; qq < 8; ++qq) {
                        const int j = lane;
                        const float imp = impw[qq * 64 + j];
                        const float score = (j > qblk) ? -1.f : ((j == 0 || j == qblk || j == qblk - 1) ? 1e3f : imp);
                        scs[j] = score;
                        __builtin_amdgcn_wave_barrier();
                        int rank = 0;
#pragma unroll 8
                        for (int jj = 0; jj < 64; ++jj) { const float o = scs[jj]; rank += (o > score || (o == score && jj < j)) ? 1 : 0; }
                        const unsigned long long mk = __ballot(rank < 8 && score >= 0.f);
                        if (lane == 0) mskw[qq] = mk;
                        __builtin_amdgcn_wave_barrier();
                    }
                    mymask = mskw[ql];
                }
            } else if (i < e3) {
                const int j = i - e2;
                const bool sel = (mymask >> j) & 1ull;
                if (__ballot(sel)) {
                    if (j < qblk) fa_tile<1>(st, qf, cur, cur + 4096, r, h, c, sel, [=](int) { return true; });
                    else { const int kb = j * 64; fa_tile<2>(st, qf, cur, cur + 4096, r, h, c, true, [=](int koff) { return sel && (kb + koff <= s); }); }
                }
                if (i == e3 - 1) {
                    const float l = st.l + __shfl_xor(st.l, 32);
                    const float f = g_s / fmaxf(l, 1e-30f);
#pragma unroll
                    for (int k = 0; k < 16; ++k) { out0[k] += st.o0[k] * f; out1[k] += st.o1[k] * f; }
                    fa_init(st);
                }
            } else {
                const int kb = (w0 + i - e3) * 64;
                { if (kb >= s_hi - 255 && kb + 63 <= s_lo) fa_tile<0>(st, qf, cur, cur + 4096, r, h, c, true, [=](int) { return true; }); else fa_tile<2>(st, qf, cur, cur + 4096, r, h, c, true, [=](int koff) { const int key = kb + koff; return key <= s && key >= s - 255; }); }
            }
        }
        {
            const float l = st.l + __shfl_xor(st.l, 32);
            const float f = g_w / fmaxf(l, 1e-30f);
#pragma unroll
            for (int k = 0; k < 16; ++k) { out0[k] += st.o0[k] * f; out1[k] += st.o1[k] * f; }
        }
        bf16_t* o = (bf16_t*)(ws + WS_MIX) + (size_t)t * 1024 + (g * 4 + z) * 64;
#pragma unroll
        for (int g4 = 0; g4 < 4; ++g4) {
            *(u32x2*)(o + 8 * g4 + 4 * h) = cvt4((f32x4){out0[4 * g4], out0[4 * g4 + 1], out0[4 * g4 + 2], out0[4 * g4 + 3]});
            *(u32x2*)(o + 32 + 8 * g4 + 4 * h) = cvt4((f32x4){out1[4 * g4], out1[4 * g4 + 1], out1[4 * g4 + 2], out1[4 * g4 + 3]});
        }
    }
}

DI void phase_glu(const Params& P, unsigned char* smem) {
    unsigned char* ws = P.ws;
    const bf16_t* G5 = (const bf16_t*)(ws + XP_G5);
    const float* gb = P.in[17];
    bool pre = false;
    for (int it = vblock(); it < (NT / 128) * 4; it += gridDim.x) {
        int mt, nt; tile_mn(it, 4, mt, nt);
        const int m0 = mt * 128;
        const bool hn = it + (int)gridDim.x < (NT / 128) * 4;
        int mtn = 0, ntn = 0; if (hn) tile_mn(it + gridDim.x, 4, mtn, ntn);
        auto nextrow = [=](int r) { return G5 + (size_t)(mtn * 128 + r) * 512; };
        auto rowptr = [=](int r) { return G5 + (size_t)(m0 + r) * 512; };
        auto epi = [=](f32x4 (&acc)[4][4], int wr, int wc, int ln) {
            const int fr = ln & 15, fq = ln >> 4;
#pragma unroll
            for (int m = 0; m < 4; ++m) {
                const int row = m0 + wr * 64 + m * 16 + fr;
#pragma unroll
                for (int n = 0; n < 4; ++n) {
                    const int col = nt * 128 + wc * 64 + n * 16 + fq * 4;
                    const f32x4 gv = bf4_to_f(*(const u32x2*)(G5 + (size_t)row * 512 + col)), bb = *(const f32x4*)(gb + col), z = acc[m][n] + bb;
                    *(u32x2*)((bf16_t*)(ws + WS_MIX) + (size_t)row * 1024 + 512 + col) = cvt4((f32x4){gv.x * sigmoidf_(z.x), gv.y * sigmoidf_(z.y), gv.z * sigmoidf_(z.z), gv.w * sigmoidf_(z.w)});
                }
            }
        };
        gemm128s(rowptr, (const bf16_t*)(ws + WS_WGLU) + (size_t)nt * 128 * 512, 512, 512, smem, epi, pre, hn, nextrow, (const bf16_t*)(ws + WS_WGLU) + (size_t)ntn * 128 * 512);
        pre = hn;
    }
}

DI void phase_outproj(const Params& P, unsigned char* smem, const float* xres, size_t wt_off) {
    unsigned char* ws = P.ws;
    const bf16_t* A = (const bf16_t*)(ws + WS_MIX);
    float* out = P.out;
    bool pre = false;
    for (int it = vblock(); it < (NT / 128) * 8; it += gridDim.x) {
        int mt, nt; tile_mn(it, 8, mt, nt);
        const int m0 = mt * 128;
        const bool hn = it + (int)gridDim.x < (NT / 128) * 8;
        int mtn = 0, ntn = 0; if (hn) tile_mn(it + gridDim.x, 8, mtn, ntn);
        auto nextrow = [=](int r) { return A + (size_t)(mtn * 128 + r) * 1024; };
        auto rowptr = [=](int r) { return A + (size_t)(m0 + r) * 1024; };
        auto epi = [=](f32x4 (&acc)[4][4], int wr, int wc, int ln) {
            const int fr = ln & 15, fq = ln >> 4;
#pragma unroll
            for (int m = 0; m < 4; ++m) {
                const size_t base = (size_t)(m0 + wr * 64 + m * 16 + fr) * 1024 + nt * 128 + wc * 64 + fq * 4;
                f32x4 xr[4];
#pragma unroll
                for (int n = 0; n < 4; ++n) xr[n] = *(const f32x4*)(xres + base + n * 16);
#pragma unroll
                for (int n = 0; n < 4; ++n) *(f32x4*)(out + base + n * 16) = xr[n] * ALPHA + acc[m][n];
            }
        };
        gemm128s(rowptr, (const bf16_t*)(ws + wt_off) + (size_t)nt * 128 * 1024, 1024, 1024, smem, epi, pre, hn, nextrow, (const bf16_t*)(ws + wt_off) + (size_t)ntn * 128 * 1024);
        pre = hn;
    }
}

DI void ln_row(float (&v)[16], const float* __restrict__ g, const float* __restrict__ bta, int lane) {
    float s = 0.f;
#pragma unroll
    for (int i = 0; i < 16; ++i) s += v[i];
    const float mu = wave_sum(s) * (1.f / 1024.f);
    float q = 0.f;
#pragma unroll
    for (int i = 0; i < 16; ++i) { v[i] -= mu; q += v[i] * v[i]; }
    const float rstd = rsqrtf(wave_sum(q) * (1.f / 1024.f) + LN_EPS);
#pragma unroll
    for (int j = 0; j < 4; ++j) {
        const float4 gg = *(const float4*)(g + 4 * lane + 256 * j), bb = *(const float4*)(bta + 4 * lane + 256 * j);
        v[4 * j + 0] = v[4 * j + 0] * rstd * gg.x + bb.x; v[4 * j + 1] = v[4 * j + 1] * rstd * gg.y + bb.y;
        v[4 * j + 2] = v[4 * j + 2] * rstd * gg.z + bb.z; v[4 * j + 3] = v[4 * j + 3] * rstd * gg.w + bb.w;
    }
}

DI void phase_ln_router(const Params& P, int layer) {
    unsigned char* ws = P.ws;
    const int lane = threadIdx.x & 63, wave = threadIdx.x >> 6;
    const float* g = P.in[21] + layer * 1024; const float* bta = P.in[22] + layer * 1024;
    const float* wc = (const float*)(ws + WS_RTRW) + (size_t)layer * 36864; const float* bc = P.in[26] + layer * 4;
    const float* wf = wc + 4096; const float* bfn = P.in[28] + layer * 32;
    int* cnt = (int*)(ws + WS_CTL) + layer * 2048;
    int* list = (int*)(ws + WS_LIST2);
    float* wgt = (float*)(ws + WS_WGT);
    bf16_t* xb = (bf16_t*)(ws + WS_ACTB);
    for (int task = blockIdx.x * 4 + wave; task < NT / 16; task += gridDim.x * 4) {
        int my_e = 0; float my_w = 0.f;
        f32x4 wcr[16];
#pragma unroll
        for (int q = 0; q < 16; ++q) wcr[q] = *(const f32x4*)(wc + (q * 64 + lane) * 4);
        f32x4 nx[4];
#pragma unroll
        for (int j = 0; j < 4; ++j) nx[j] = __builtin_nontemporal_load((const f32x4*)(P.out + (size_t)(task * 16) * 1024 + 4 * lane + 256 * j));
#pragma unroll 1
        for (int i = 0; i < 16; ++i) {
            const int t = task * 16 + i;
            float v[16];
#pragma unroll
            for (int j = 0; j < 4; ++j) { v[4 * j] = nx[j].x; v[4 * j + 1] = nx[j].y; v[4 * j + 2] = nx[j].z; v[4 * j + 3] = nx[j].w; }
            if (i + 1 < 16) {
#pragma unroll
                for (int j = 0; j < 4; ++j) nx[j] = __builtin_nontemporal_load((const f32x4*)(P.out + (size_t)(t + 1) * 1024 + 4 * lane + 256 * j));
            }
            ln_row(v, g, bta, lane);
#pragma unroll
            for (int j = 0; j < 4; ++j) {
                *(u32x2*)(xb + (size_t)t * 1024 + 4 * lane + 256 * j) = cvt4((f32x4){v[4 * j], v[4 * j + 1], v[4 * j + 2], v[4 * j + 3]});
            }
            float lc[4] = {0.f, 0.f, 0.f, 0.f};
#pragma unroll
            for (int j = 0; j < 4; ++j)
#pragma unroll
                for (int k = 0; k < 4; ++k) {
                    const f32x4 w = wcr[j * 4 + k];
                    const float x = v[4 * j + k];
                    lc[0] += x * w.x; lc[1] += x * w.y; lc[2] += x * w.z; lc[3] += x * w.w;
                }
#pragma unroll
            for (int c = 0; c < 4; ++c) lc[c] = wave_sum(lc[c]) + bc[c];
            int gi = 0; float lm = lc[0];
#pragma unroll
            for (int c = 1; c < 4; ++c) if (lc[c] > lm) { lm = lc[c]; gi = c; }
            gi = __builtin_amdgcn_readfirstlane(gi);
            float den = 0.f;
#pragma unroll
            for (int c = 0; c < 4; ++c) den += expf(lc[c] - lm);
            const float gv = 1.f / den;
            float lf[8] = {0.f, 0.f, 0.f, 0.f, 0.f, 0.f, 0.f, 0.f};
            const float* wfg = wf + (size_t)gi * 8192;
#pragma unroll
            for (int j = 0; j < 4; ++j)
#pragma unroll
                for (int k = 0; k < 4; ++k) {
                    const f32x4 w0 = *(const f32x4*)(wfg + (((j * 4 + k) * 2 + 0) * 64 + lane) * 4), w1 = *(const f32x4*)(wfg + (((j * 4 + k) * 2 + 1) * 64 + lane) * 4);
                    const float x = v[4 * j + k];
                    lf[0] += x * w0.x; lf[1] += x * w0.y; lf[2] += x * w0.z; lf[3] += x * w0.w;
                    lf[4] += x * w1.x; lf[5] += x * w1.y; lf[6] += x * w1.z; lf[7] += x * w1.w;
                }
#pragma unroll
            for (int e = 0; e < 8; ++e) lf[e] = wave_sum(lf[e]) + bfn[gi * 8 + e];
            int e1 = 0; float l1 = lf[0];
#pragma unroll
            for (int e = 1; e < 8; ++e) if (lf[e] > l1) { l1 = lf[e]; e1 = e; }
            int e2 = 0; float l2 = -INFINITY;
#pragma unroll
            for (int e = 0; e < 8; ++e) if (e != e1 && lf[e] > l2) { l2 = lf[e]; e2 = e; }
            const float r = expf(l2 - l1);
            if (lane == i) { my_e = gi * 8 + e1; my_w = gv / (1.f + r); }
            if (lane == 16 + i) { my_e = gi * 8 + e2; my_w = gv * r / (1.f + r); }
        }
        if (lane < 32) {
            const int t = task * 16 + (lane & 15), k = lane >> 4, slot = (task & 63) * 32 + my_e;
            const int pos = atomicAdd(&cnt[slot], 1);
            list[(slot << 10) + pos] = t * 2 + k;
            wgt[t * 2 + k] = my_w;
        }
    }
}

constexpr int MOE_LDS_TAB = 65536;
constexpr int MOE_LDS_ROW = 65536 + 8448;
DI void moe_tables(const int* cnt, unsigned char* smem) {
    int* tab = (int*)(smem + MOE_LDS_TAB);
    if (threadIdx.x < 32) { const int e = threadIdx.x; int run = 0; for (int s = 0; s < 64; ++s) { tab[e * 65 + s] = run; run += cnt[s * 32 + e]; } tab[e * 65 + 64] = run; }
    __syncthreads();
}
DI bool moe_tile(const int* tab, int tile, int& e, int& mt, int& off, int& ce) {
    int acc_t = 0, acc_r = 0;
    for (int i = 0; i < 32; ++i) {
        const int c = tab[i * 65 + 64], nt = (c + 127) >> 7;
        if (tile < acc_t + nt) { e = i; mt = tile - acc_t; off = acc_r; ce = c; return true; }
        acc_t += nt; acc_r += c;
    }
    return false;
}
DI int moe_ntiles(const int* tab) { int a = 0; for (int i = 0; i < 32; ++i) a += (tab[i * 65 + 64] + 127) >> 7; return a; }
DI void moe_rows(const int* tab, const int* list, int e, int mt, int ce, int* rowidx) {
    if (threadIdx.x < 128) {
        const int pos = mt * 128 + threadIdx.x;
        int idx = -1;
        if (pos < ce) {
            int lo = 0, hi = 64;
            while (hi - lo > 1) { const int mid = (lo + hi) >> 1; if (tab[e * 65 + mid] <= pos) lo = mid; else hi = mid; }
            idx = list[((lo * 32 + e) << 10) + pos - tab[e * 65 + lo]];
        }
        rowidx[threadIdx.x] = idx;
    }
    __syncthreads();
}

DI void phase_moe_gu(const Params& P, unsigned char* smem, int layer) {
    unsigned char* ws = P.ws;
    const int* cnt = (const int*)(ws + WS_CTL) + layer * 2048;
    const int* list = (const int*)(ws + WS_LIST2);
    const float* wgt = (const float*)(ws + WS_WGT);
    const bf16_t* xb = (const bf16_t*)(ws + WS_ACTB);
    bf16_t* H = (bf16_t*)(ws + XP_H);
    const int* tab = (const int*)(smem + MOE_LDS_TAB);
    int* rowidx = (int*)(smem + MOE_LDS_ROW);
    moe_tables(cnt, smem);
    const int ntile = moe_ntiles(tab);
    for (int it = vblock(); it < ntile * 2; it += gridDim.x) {
        int e, mt, off, ce; moe_tile(tab, it >> 1, e, mt, off, ce);
        const int nt = it & 1;
        moe_rows(tab, list, e, mt, ce, rowidx);
        auto rowptr = [=](int r) { int idx = rowidx[r]; idx = idx < 0 ? rowidx[0] : idx; return xb + (size_t)(idx >> 1) * 1024; };
        auto epi = [=](f32x4 (&acc)[4][4], int wr, int wc, int ln) {
            const int fr = ln & 15, fq = ln >> 4;
#pragma unroll
            for (int m = 0; m < 4; ++m) {
                const int rl = wr * 64 + m * 16 + fr, idx = rowidx[rl];
                if (idx >= 0) {
                    const float w = wgt[idx];
#pragma unroll
                    for (int n = 0; n < 2; ++n) {
                        const f32x4 gte = acc[m][n], up = acc[m][n + 2];
                        *(u32x2*)(H + (size_t)(off + mt * 128 + rl) * 128 + (nt * 2 + wc) * 32 + n * 16 + fq * 4) =
                            cvt4((f32x4){gte.x * sigmoidf_(gte.x) * up.x * w, gte.y * sigmoidf_(gte.y) * up.y * w, gte.z * sigmoidf_(gte.z) * up.z * w, gte.w * sigmoidf_(gte.w) * up.w * w});
                    }
                }
            }
        };
        gemm128(rowptr, (const bf16_t*)(ws + WS_WGU) + ((size_t)(layer * 32 + e) * 256 + nt * 128) * 1024, 1024, 1024, smem, epi);
        __syncthreads();
    }
}
DI void phase_moe_down(const Params& P, unsigned char* smem, int layer) {
    unsigned char* ws = P.ws;
    const int* cnt = (const int*)(ws + WS_CTL) + layer * 2048;
    const int* list = (const int*)(ws + WS_LIST2);
    const bf16_t* H = (const bf16_t*)(ws + XP_H);
    bf16_t* YB = (bf16_t*)(ws + XP_YB);
    const int* tab = (const int*)(smem + MOE_LDS_TAB);
    int* rowidx = (int*)(smem + MOE_LDS_ROW);
    moe_tables(cnt, smem);
    const int ntile = moe_ntiles(tab);
    for (int it = vblock(); it < ntile * 8; it += gridDim.x) {
        int e, mt, off, ce; moe_tile(tab, it >> 3, e, mt, off, ce);
        const int nt = it & 7;
        moe_rows(tab, list, e, mt, ce, rowidx);
        auto rowptr = [=](int r) { int pos = mt * 128 + r; pos = pos < ce ? pos : 0; return H + (size_t)(off + pos) * 128; };
        auto epi = [=](f32x4 (&acc)[4][4], int wr, int wc, int ln) {
            const int fr = ln & 15, fq = ln >> 4;
#pragma unroll
            for (int m = 0; m < 4; ++m) {
                const int idx = rowidx[wr * 64 + m * 16 + fr];
                if (idx >= 0) {
                    bf16_t* dst = YB + (size_t)idx * 1024 + nt * 128 + wc * 64 + fq * 4;
#pragma unroll
                    for (int n = 0; n < 4; ++n) *(u32x2*)(dst + n * 16) = cvt4(acc[m][n]);
                }
            }
        };
        gemm128(rowptr, (const bf16_t*)(ws + WS_WDN) + ((size_t)(layer * 32 + e) * 1024 + nt * 128) * 128, 128, 128, smem, epi);
        __syncthreads();
    }
}
DI void phase_ln_ffn(const Params& P, int layer) {
    unsigned char* ws = P.ws;
    const int lane = threadIdx.x & 63, wave = threadIdx.x >> 6;
    const float* g = P.in[23] + layer * 1024; const float* bta = P.in[24] + layer * 1024;
    const bf16_t* YB = (const bf16_t*)(ws + XP_YB);
    bf16_t* xb = (bf16_t*)(ws + WS_ACTB);
    for (int task = blockIdx.x * 4 + wave; task < NT / 16; task += gridDim.x * 4) {
        u32x2 nxm[4], ny0[4], ny1[4];
        auto fetch = [&](int t) {
#pragma unroll
            for (int j = 0; j < 4; ++j) {
                nxm[j] = __builtin_nontemporal_load((const u32x2*)(xb + (size_t)t * 1024 + 4 * lane + 256 * j));
                ny0[j] = __builtin_nontemporal_load((const u32x2*)(YB + (size_t)(2 * t) * 1024 + 4 * lane + 256 * j));
                ny1[j] = __builtin_nontemporal_load((const u32x2*)(YB + (size_t)(2 * t + 1) * 1024 + 4 * lane + 256 * j));
            }
        };
        fetch(task * 16);
#pragma unroll 1
        for (int i = 0; i < 16; ++i) {
            const int t = task * 16 + i;
            float v[16];
#pragma unroll
            for (int j = 0; j < 4; ++j) {
                const f32x4 a = bf4_to_f(nxm[j]), y0 = bf4_to_f(ny0[j]), y1 = bf4_to_f(ny1[j]);
                v[4 * j + 0] = ALPHA * a.x + (y0.x + y1.x); v[4 * j + 1] = ALPHA * a.y + (y0.y + y1.y);
                v[4 * j + 2] = ALPHA * a.z + (y0.z + y1.z); v[4 * j + 3] = ALPHA * a.w + (y0.w + y1.w);
            }
            if (i + 1 < 16) fetch(t + 1);
            ln_row(v, g, bta, lane);
            float* row = P.out + (size_t)t * 1024;
#pragma unroll
            for (int j = 0; j < 4; ++j) {
                *(f32x4*)(row + 4 * lane + 256 * j) = (f32x4){v[4 * j], v[4 * j + 1], v[4 * j + 2], v[4 * j + 3]};
                if (layer == 0) *(u32x2*)(xb + (size_t)t * 1024 + 4 * lane + 256 * j) = cvt4((f32x4){v[4 * j], v[4 * j + 1], v[4 * j + 2], v[4 * j + 3]});
            }
        }
    }
}

DI void phase_inproj1(const Params& P, unsigned char* smem) {
    unsigned char* ws = P.ws;
    const bf16_t* A = (const bf16_t*)(ws + WS_ACTB);
    const float* cosT = (const float*)(ws + WS_ROPE);
    const float* sinT = cosT + 4096 * 32;
    bool pre = false;
    for (int it = vblock(); it < (NT / 128) * 24; it += gridDim.x) {
        int mt, nt; tile_mn(it, 24, mt, nt);
        const int m0 = mt * 128;
        auto rowptr = [=](int r) { return A + (size_t)(m0 + r) * 1024; };
        const bf16_t* Bt = (const bf16_t*)(ws + WS_WIN1) + (size_t)nt * 128 * 1024;
        const bool hn = it + (int)gridDim.x < (NT / 128) * 24;
        int mtn = 0, ntn = 0; if (hn) tile_mn(it + gridDim.x, 24, mtn, ntn);
        auto nextrow = [=](int r) { return A + (size_t)(mtn * 128 + r) * 1024; };
        const bf16_t* nBt = (const bf16_t*)(ws + WS_WIN1) + (size_t)ntn * 128 * 1024;
        if (nt >= 16) {
            auto epi = [=](f32x4 (&acc)[4][4], int wr, int wc, int lane) {
                const int head = (nt * 2 + wc) & 15, fr = lane & 15, fq = lane >> 4;
#pragma unroll
                for (int m = 0; m < 4; ++m) {
                    const int t = m0 + wr * 64 + m * 16 + fq * 4, s = t & 4095, b = t >> 12;
                    bf16_t* base = (bf16_t*)(ws + XP_Q1 + (size_t)2 * 64 * MiB) + (size_t)(b * 16 + head) * 4096 * 64;
#pragma unroll
                    for (int n = 0; n < 4; ++n) *(u32x2*)(base + vp_off(s, n * 16 + fr)) = cvt4(acc[m][n]);
                }
            };
            gemm128s<false>(rowptr, Bt, 1024, 1024, smem, epi, pre, hn, nextrow, nBt);
            pre = hn;
            continue;
        }
        auto epi = [=](f32x4 (&acc)[4][4], int wr, int wc, int lane) {
            const int u64 = nt * 2 + wc, kind = u64 >> 4, head = u64 & 15, fr = lane & 15, fq = lane >> 4;
            f32x4 cs[2][2];
#pragma unroll
            for (int n2 = 0; n2 < 2; ++n2) { cs[n2][0] = (f32x4){0.f, 0.f, 0.f, 0.f}; cs[n2][1] = cs[n2][0]; }
#pragma unroll
            for (int m = 0; m < 4; ++m) {
                const int t = m0 + wr * 64 + m * 16 + fr, s = t & 4095, b = t >> 12;
                bf16_t* base = (bf16_t*)(ws + XP_Q1 + (size_t)kind * 64 * MiB) + (size_t)(b * 16 + head) * 4096 * 64;
#pragma unroll
                for (int n2 = 0; n2 < 2; ++n2) {
                    const int i = n2 * 16 + fq * 4;
                    const f32x4 c = *(const f32x4*)(cosT + s * 32 + i), sn = *(const f32x4*)(sinT + s * 32 + i);
                    const f32x4 x1 = acc[m][2 * n2], x2 = acc[m][2 * n2 + 1];
                    const f32x4 r1 = x1 * c - x2 * sn, r2 = x1 * sn + x2 * c;
                    const u32x2 o1 = cvt4(r1), o2 = cvt4(r2);
                    if (kind == 0) { *(u32x2*)(base + (size_t)s * 64 + i) = o1; *(u32x2*)(base + (size_t)s * 64 + i + 32) = o2; }
                    else { *(u32x2*)(base + kp_off(s, i)) = o1; *(u32x2*)(base + kp_off(s, i + 32)) = o2; cs[n2][0] += r1; cs[n2][1] += r2; }
                }
            }
            if (kind == 1) {
                const int t0 = m0 + wr * 64, bh = (t0 >> 12) * 16 + head, seg = (t0 & 4095) >> 6;
                float* dst = (float*)(ws + WS_KMP) + ((size_t)bh * 64 + seg) * 64;
#pragma unroll
                for (int n2 = 0; n2 < 2; ++n2)
#pragma unroll
                    for (int hf = 0; hf < 2; ++hf) {
                        f32x4 v = cs[n2][hf];
#pragma unroll
                        for (int k = 0; k < 4; ++k) { float x = v[k]; x += dpp_f<0xB1>(x); x += dpp_f<0x4E>(x); x += dpp_f<0x141>(x); x += dpp_f<0x140>(x); v[k] = x; }
                        if (fr == 0) *(f32x4*)(dst + n2 * 16 + fq * 4 + hf * 32) = v;
                    }
            }
        };
        gemm128s(rowptr, Bt, 1024, 1024, smem, epi, pre, hn, nextrow, nBt);
        pre = hn;
    }
}
DI void moba_kmeans_slab(const Params& P, bf16_t* kml, int bh, int tid) {
    const float* kp = (const float*)(P.ws + WS_KMP) + (size_t)bh * 64 * 64;
    for (int e = tid; e < 2048; e += 256) {
        const int d = e & 63, n = e >> 6;
        float a = 0.f;
        if (n < 16) a = ((kp[(4 * n) * 64 + d] + kp[(4 * n + 1) * 64 + d]) + (kp[(4 * n + 2) * 64 + d] + kp[(4 * n + 3) * 64 + d])) * (1.f / 256.f);
        kml[((d >> 4) * 32 + n) * 16 + (d & 15)] = f2bf(a);
    }
}
DI unsigned moba_gate_rows(const bf16_t* km, const bf16x8 (&qf)[4], int own, int r, int h) {
    f32x16 g;
#pragma unroll
    for (int i = 0; i < 16; ++i) g[i] = 0.f;
#pragma unroll
    for (int ks = 0; ks < 4; ++ks) g = MFMA32(*(const bf16x8*)(km + (ks * 32 + r) * 16 + 8 * h), qf[ks], g);
    float mine[8], oth[8];
#pragma unroll
    for (int i = 0; i < 8; ++i) { const int n = (i & 3) + 8 * (i >> 2) + 4 * h; mine[i] = n < own ? g[i] : -INFINITY; oth[i] = __shfl_xor(mine[i], 32); }
    unsigned selmask = 0;
#pragma unroll
    for (int i = 0; i < 8; ++i) {
        const int n = (i & 3) + 8 * (i >> 2) + 4 * h;
        int rank = 0;
#pragma unroll
        for (int k = 0; k < 8; ++k) {
            const int nk = (k & 3) + 8 * (k >> 2) + 4 * h, no = (k & 3) + 8 * (k >> 2) + 4 * (1 - h);
            rank += (mine[k] > mine[i] || (mine[k] == mine[i] && nk < n)) ? 1 : 0;
            rank += (oth[k] > mine[i] || (oth[k] == mine[i] && no < n)) ? 1 : 0;
        }
        if (n < own && rank < 3) selmask |= 1u << n;
    }
    return selmask | __shfl_xor(selmask, 32);
}
DI void phase_moba_gate(const Params& P, unsigned char* smem) {
    unsigned char* ws = P.ws;
    const int tid = threadIdx.x, lane = tid & 63, wave = tid >> 6, r = lane & 31, h = lane >> 5;
    bf16_t* kml = (bf16_t*)smem;
    unsigned short* smask = (unsigned short*)(smem + 4096);
    unsigned short* selm = (unsigned short*)(ws + WS_SELM);
    unsigned short* mcnt = (unsigned short*)(ws + WS_MCNT);
    unsigned char* mlist = ws + WS_MLIST;
    int km_bh = -1;
    for (int it = blockIdx.x; it < 2048; it += gridDim.x) {
        const int bh = it & 127, qb = it >> 7;
        if (bh != km_bh) { km_bh = bh; __syncthreads(); moba_kmeans_slab(P, kml, bh, tid); }
        __syncthreads();
#pragma unroll 1
        for (int g2 = 0; g2 < 2; ++g2) {
            const int rl = wave * 64 + g2 * 32 + r, q = qb * 256 + rl;
            const bf16_t* Qg = (const bf16_t*)(ws + XP_Q1) + ((size_t)bh * 4096 + q) * 64;
            bf16x8 qf[4];
#pragma unroll
            for (int ks = 0; ks < 4; ++ks) qf[ks] = *(const bf16x8*)(Qg + ks * 16 + 8 * h);
            const unsigned sm = qb > 0 ? moba_gate_rows(kml, qf, qb, r, h) : 0u;
            if (h == 0) { selm[(size_t)bh * 4096 + q] = (unsigned short)sm; smask[rl] = (unsigned short)sm; }
        }
        __syncthreads();
        for (int n = wave; n < qb; n += 4) {
            unsigned char* lp = mlist + ((size_t)(bh * 16 + qb) * 16 + n) * 256;
            int base = 0;
#pragma unroll
            for (int c4 = 0; c4 < 4; ++c4) {
                const int row = c4 * 64 + lane;
                const bool bit = (smask[row] >> n) & 1;
                const unsigned long long bal = __ballot(bit);
                if (bit) lp[base + __builtin_popcountll(bal & ((1ull << lane) - 1ull))] = (unsigned char)row;
                base += __builtin_popcountll(bal);
            }
            if (lane == 0) mcnt[(bh * 16 + qb) * 16 + n] = (unsigned short)base;
        }
    }
}
DI bf16_t* moba_po(const Params& P, int slot) { return (bf16_t*)(P.ws + (slot == 0 ? WS_MIX : slot == 1 ? WS_ACTB : WS_PO2)); }
DI void phase_moba_kv(const Params& P, unsigned char* smem) {
    unsigned char* ws = P.ws;
    const int tid = threadIdx.x, lane = tid & 63, wave = tid >> 6, r = lane & 31, h = lane >> 5;
    const float c = 0.125f * 1.4426950408889634f;
    LAS unsigned char* lds = (LAS unsigned char*)smem;
    const unsigned short* selm = (const unsigned short*)(ws + WS_SELM);
    const unsigned short* mcnt = (const unsigned short*)(ws + WS_MCNT);
    const unsigned char* mlist = ws + WS_MLIST;
    float* pml = (float*)(ws + WS_PML);
    const bool bal = (gridDim.x == 512);
    const int nit = bal ? ((blockIdx.x >> 7) == 3 ? 3 : 4) : (1920 + (int)gridDim.x - 1 - (int)blockIdx.x) / (int)gridDim.x;
    for (int iti = 0; iti < nit; ++iti) {
        int bh, n;
        if (bal) { const int gq = blockIdx.x >> 7; bh = blockIdx.x & 127; const int tab = gq == 0 ? 0x0DA90 : gq == 1 ? 0x0CB61 : gq == 2 ? 0x0E852 : 0x00743; n = (tab >> (4 * iti)) & 15; }
        else { const int it = blockIdx.x + iti * gridDim.x; n = it >> 7; bh = it & 127; }
        const bf16_t* Kg = (const bf16_t*)(ws + XP_Q1 + 64 * MiB) + (size_t)bh * 4096 * 64 + (size_t)n * 4 * 4096;
        const bf16_t* Vg = (const bf16_t*)(ws + XP_Q1 + 128 * MiB) + (size_t)bh * 4096 * 64 + (size_t)n * 4 * 4096;
        asm volatile("s_waitcnt vmcnt(0)" ::: "memory");
        __builtin_amdgcn_s_barrier();
#pragma unroll
        for (int j = 0; j < 4; ++j) fa_issue(Kg + (size_t)j * 4096, Vg + (size_t)j * 4096, lds + j * 16384, tid);
        const int cntv = (lane < 16 && lane > n) ? (int)mcnt[(bh * 16 + lane) * 16 + n] : 0;
        asm volatile("s_waitcnt vmcnt(0)" ::: "memory");
        __builtin_amdgcn_s_barrier();
        asm volatile("" ::: "memory");
        int prefv = 0, total = 0;
#pragma unroll 1
        for (int qb = 0; qb < 16; ++qb) { if (lane == qb) prefv = total; total += __builtin_amdgcn_readlane(cntv, qb); }
#pragma unroll 1
        for (int v0 = wave * 32; v0 < total; v0 += 128) {
            const int v = v0 + r;
            const bool valid = v < total;
            const int vv = valid ? v : v0;
            int qb = n + 1;
#pragma unroll 1
            for (int l = n + 2; l < 16; ++l) if (vv >= __builtin_amdgcn_readlane(prefv, l)) qb = l;
            const int idx = vv - __shfl(prefv, qb);
            const int q = qb * 256 + (int)mlist[((size_t)(bh * 16 + qb) * 16 + n) * 256 + idx];
            const bf16_t* Qg = (const bf16_t*)(ws + XP_Q1) + ((size_t)bh * 4096 + q) * 64;
            bf16x8 qf[4];
#pragma unroll
            for (int ks = 0; ks < 4; ++ks) qf[ks] = *(const bf16x8*)(Qg + ks * 16 + 8 * h);
            FA st; fa_init(st);
#pragma unroll 1
            for (int j = 0; j < 4; ++j) {
                const LAS bf16_t* cur = (const LAS bf16_t*)(lds + j * 16384);
                fa_tile<0>(st, qf, cur, cur + 4096, r, h, c, true, [=](int) { return true; });
            }
            const float l = st.l + __shfl_xor(st.l, 32);
            const float inv = 1.f / fmaxf(l, 1e-30f);
            if (valid) {
                const int slot = __builtin_popcount((unsigned)selm[(size_t)bh * 4096 + q] & ((1u << n) - 1u));
                bf16_t* o = moba_po(P, slot) + ((size_t)(bh >> 4) * 4096 + q) * 1024 + (bh & 15) * 64;
#pragma unroll
                for (int g4 = 0; g4 < 4; ++g4) {
                    *(u32x2*)(o + 8 * g4 + 4 * h) = cvt4((f32x4){st.o0[4 * g4] * inv, st.o0[4 * g4 + 1] * inv, st.o0[4 * g4 + 2] * inv, st.o0[4 * g4 + 3] * inv});
                    *(u32x2*)(o + 32 + 8 * g4 + 4 * h) = cvt4((f32x4){st.o1[4 * g4] * inv, st.o1[4 * g4 + 1] * inv, st.o1[4 * g4 + 2] * inv, st.o1[4 * g4 + 3] * inv});
                }
                if (h == 0) { float* pm = pml + (((size_t)bh * 4096 + q) * 3 + slot) * 2; pm[0] = st.m; pm[1] = l; }
            }
        }
    }
}
DI void phase_moba_own(const Params& P, unsigned char* smem) {
    unsigned char* ws = P.ws;
    const int tid = threadIdx.x, lane = tid & 63, wave = tid >> 6, r = lane & 31, h = lane >> 5;
    const float c = 0.125f * 1.4426950408889634f;
    LAS unsigned char* lds = (LAS unsigned char*)smem;
    const unsigned short* selm = (const unsigned short*)(ws + WS_SELM);
    const float* pml = (const float*)(ws + WS_PML);
    for (int it = blockIdx.x; it < 2048; it += gridDim.x) {
        const int own = 15 - (it >> 7), bh = it & 127, t0 = own * 256;
        const bf16_t* Kg = (const bf16_t*)(ws + XP_Q1 + 64 * MiB) + (size_t)bh * 4096 * 64 + (size_t)own * 4 * 4096;
        const bf16_t* Vg = (const bf16_t*)(ws + XP_Q1 + 128 * MiB) + (size_t)bh * 4096 * 64 + (size_t)own * 4 * 4096;
        asm volatile("s_waitcnt vmcnt(0)" ::: "memory");
        __builtin_amdgcn_s_barrier();
#pragma unroll
        for (int j = 0; j < 4; ++j) fa_issue(Kg + (size_t)j * 4096, Vg + (size_t)j * 4096, lds + j * 16384, tid);
        asm volatile("s_waitcnt vmcnt(0)" ::: "memory");
        __builtin_amdgcn_s_barrier();
        asm volatile("" ::: "memory");
#pragma unroll 1
        for (int g2 = 0; g2 < 2; ++g2) {
            const int row0 = t0 + g2 * 128 + wave * 32, q = row0 + r;
            const bf16_t* Qg = (const bf16_t*)(ws + XP_Q1) + ((size_t)bh * 4096 + q) * 64;
            bf16x8 qf[4];
#pragma unroll
            for (int ks = 0; ks < 4; ++ks) qf[ks] = *(const bf16x8*)(Qg + ks * 16 + 8 * h);
            const int nsel = __builtin_popcount((unsigned)selm[(size_t)bh * 4096 + q]);
            const size_t orow = ((size_t)(bh >> 4) * 4096 + q) * 1024 + (bh & 15) * 64;
            const float* pm = pml + ((size_t)bh * 4096 + q) * 6;
            float mi[3], li[3];
            u32x2 pa[3][8];
#pragma unroll
            for (int i = 0; i < 3; ++i) {
                mi[i] = i < nsel ? pm[2 * i] : -INFINITY; li[i] = i < nsel ? pm[2 * i + 1] : 0.f;
                const bf16_t* po = moba_po(P, i) + orow;
#pragma unroll
                for (int g4 = 0; g4 < 4; ++g4) {
                    pa[i][2 * g4] = i < nsel ? *(const u32x2*)(po + 8 * g4 + 4 * h) : (u32x2){0u, 0u};
                    pa[i][2 * g4 + 1] = i < nsel ? *(const u32x2*)(po + 32 + 8 * g4 + 4 * h) : (u32x2){0u, 0u};
                }
            }
            FA st; fa_init(st);
            const int jmax = (row0 + 31 - t0) >> 6;
#pragma unroll 1
            for (int j = 0; j <= jmax; ++j) {
                const LAS bf16_t* cur = (const LAS bf16_t*)(lds + j * 16384);
                const int kbase = t0 + j * 64;
                if (kbase + 63 <= row0) fa_tile<0>(st, qf, cur, cur + 4096, r, h, c, true, [=](int) { return true; });
                else fa_tile<2>(st, qf, cur, cur + 4096, r, h, c, true, [=](int koff) { return kbase + koff <= q; });
            }
            const float l_own = st.l + __shfl_xor(st.l, 32);
            const float M = fmaxf(fmaxf(st.m, mi[0]), fmaxf(mi[1], mi[2]));
            const float wo = __builtin_amdgcn_exp2f(st.m - M);
            float L = l_own * wo;
#pragma unroll
            for (int k = 0; k < 16; ++k) { st.o0[k] *= wo; st.o1[k] *= wo; }
#pragma unroll
            for (int i = 0; i < 3; ++i) {
                const float wi = li[i] * __builtin_amdgcn_exp2f(mi[i] - M);
                L += wi;
#pragma unroll
                for (int g4 = 0; g4 < 4; ++g4) {
                    const f32x4 a = bf4_to_f(pa[i][2 * g4]), b2 = bf4_to_f(pa[i][2 * g4 + 1]);
                    st.o0[4 * g4] += wi * a.x; st.o0[4 * g4 + 1] += wi * a.y; st.o0[4 * g4 + 2] += wi * a.z; st.o0[4 * g4 + 3] += wi * a.w;
                    st.o1[4 * g4] += wi * b2.x; st.o1[4 * g4 + 1] += wi * b2.y; st.o1[4 * g4 + 2] += wi * b2.z; st.o1[4 * g4 + 3] += wi * b2.w;
                }
            }
            const float inv = 1.f / fmaxf(L, 1e-30f);
            bf16_t* o = (bf16_t*)(ws + WS_MIX) + orow;
#pragma unroll
            for (int g4 = 0; g4 < 4; ++g4) {
                *(u32x2*)(o + 8 * g4 + 4 * h) = cvt4((f32x4){st.o0[4 * g4] * inv, st.o0[4 * g4 + 1] * inv, st.o0[4 * g4 + 2] * inv, st.o0[4 * g4 + 3] * inv});
                *(u32x2*)(o + 32 + 8 * g4 + 4 * h) = cvt4((f32x4){st.o1[4 * g4] * inv, st.o1[4 * g4 + 1] * inv, st.o1[4 * g4 + 2] * inv, st.o1[4 * g4 + 3] * inv});
            }
        }
    }
}

constexpr int SMEM_BYTES = 65536 + 8192 + 1024 + 512;
static_assert(SMEM_BYTES >= 128 * 129 * 4 && SMEM_BYTES >= MOE_LDS_ROW + 512 && SMEM_BYTES >= NSA_LDS_MSK + 256, "LDS map");
constexpr int SMEM_OLD = 128 * 129 * 4;
typedef __attribute__((address_space(1))) unsigned gu32;
#define XB_TMO      128
#define XB_XCNT(j)  (256  + 64 * (j))
#define XB_XSUB(j)  (1280 + 64 * (j))
#define XB_XGEN(j)  (2304 + 64 * (j))
#define XB_TOP      3328
#define XB_TOPGEN   3392
#define XCD_BAR_WORDS 3456
#define XB_SPIN_CAP (1u << 18)

__device__ __forceinline__ unsigned xb_ld(unsigned* p)              { return __hip_atomic_load(p, __ATOMIC_RELAXED, __HIP_MEMORY_SCOPE_AGENT); }
__device__ __forceinline__ unsigned xb_add(unsigned* p, unsigned v) { return __hip_atomic_fetch_add(p, v, __ATOMIC_RELAXED, __HIP_MEMORY_SCOPE_AGENT); }
__device__ __forceinline__ unsigned xb_xcc_id() { return (unsigned)__builtin_amdgcn_s_getreg((3 << 11) | 20) & 0xFu; }
#define XB_SPIN(cond, bar) do { unsigned _sp = 0; while (cond) { __builtin_amdgcn_s_sleep(1); \
    if ((++_sp & 255u) == 0u) { if (xb_ld(&(bar)[XB_TMO])) break; if (_sp > XB_SPIN_CAP) { atomicAdd(&(bar)[XB_TMO], 1u); break; } } } } while (0)

struct XcdBarrier {
    unsigned* bar; unsigned x;
    volatile LAS unsigned* st;
};

__device__ __forceinline__ XcdBarrier xcd_barrier_post(unsigned* bar, volatile LAS unsigned* st) {
    XcdBarrier b; b.bar = bar; b.x = xb_xcc_id(); b.st = st;
    if (threadIdx.x == 0) (void)xb_add(&bar[XB_XCNT(b.x)], 1u);
    return b;
}
__device__ __forceinline__ void xcd_barrier_complete(unsigned* bar, unsigned x, unsigned& nloc, unsigned& nx) {
    const unsigned G = gridDim.x * gridDim.y * gridDim.z;
    unsigned sum, cnt, mine, sp = 0u;
    for (;;) {
        sum = 0u; cnt = 0u; mine = 0u;
#pragma unroll
        for (unsigned j = 0; j < 16; ++j) { const unsigned c = xb_ld(&bar[XB_XCNT(j)]); sum += c; cnt += (c > 0u) ? 1u : 0u; mine = (j == x) ? c : mine; }
        if (sum == G) break;
        __builtin_amdgcn_s_sleep(1);
        if ((++sp & 255u) == 0u) { if (xb_ld(&bar[XB_TMO])) break; if (sp > XB_SPIN_CAP) { atomicAdd(&bar[XB_TMO], 1u); break; } }
    }
    nloc = mine > 0u ? mine : 1u; nx = cnt > 0u ? cnt : 1u;
}

__device__ __forceinline__ void xcd_barrier(const XcdBarrier& b) {
    asm volatile("s_waitcnt vmcnt(0)" ::: "memory");
    __syncthreads();
    if (threadIdx.x == 0) {
        unsigned* bar = b.bar;
        __builtin_amdgcn_s_waitcnt(0);
        unsigned nloc = b.st[0], nx = b.st[1];
        if (nloc == 0u) { xcd_barrier_complete(bar, b.x, nloc, nx); b.st[0] = nloc; b.st[1] = nx; }
        const unsigned old = xb_add(&bar[XB_XSUB(b.x)], 1u);
        const unsigned gen = old / nloc;
        if (old + 1u == (gen + 1u) * nloc) {
            __builtin_amdgcn_fence(__ATOMIC_RELEASE, "agent");
            asm volatile("s_waitcnt vmcnt(0)" ::: "memory");
            const unsigned og = xb_add(&bar[XB_TOP], 1u);
            const unsigned tg = og / nx;
            if (og + 1u == (tg + 1u) * nx) xb_add(&bar[XB_TOPGEN], 1u);
            else XB_SPIN(xb_ld(&bar[XB_TOPGEN]) == tg, bar);
            __builtin_amdgcn_fence(__ATOMIC_ACQUIRE, "agent");
            xb_add(&bar[XB_XGEN(b.x)], 1u);
            asm volatile("s_waitcnt vmcnt(0)" ::: "memory");
        } else {
            XB_SPIN(xb_ld(&bar[XB_XGEN(b.x)]) == gen, bar);
            __builtin_amdgcn_fence(__ATOMIC_ACQUIRE, "agent");
            asm volatile("s_waitcnt vmcnt(0)" ::: "memory");
        }
    }
    __syncthreads();
}

constexpr size_t CTL_BAR = 16384;
constexpr size_t CTL_BYTES = 32768;

#define PHASE(k, call) if (P.ph_lo <= (k) && (k) < P.ph_hi) { call; if ((k) + 1 < P.ph_hi) xcd_barrier(xb); }
__global__ void __launch_bounds__(256, 2) mega(Params P) {
    __shared__ __attribute__((aligned(16))) unsigned char smem[SMEM_BYTES + 16];
    unsigned* xbst = (unsigned*)(smem + SMEM_BYTES);
    cg::grid_group grid = cg::this_grid();
    if (threadIdx.x < 4) xbst[threadIdx.x] = 0u;
    __syncthreads();
    if (P.ph_lo < 0) grid.sync();
    XcdBarrier xb = xcd_barrier_post((unsigned*)(P.ws + WS_CTL + CTL_BAR), (volatile LAS unsigned*)xbst);
    PHASE(0, phase0(P, smem))
    PHASE(1, phase_inproj0(P, smem))
    PHASE(2, phase_cmp_s5e(P, smem))
    PHASE(3, phase_glu(P, smem); phase_nsa(P, smem))
    PHASE(6, phase_outproj(P, smem, P.in[0], WS_WOUT0))
    PHASE(7, phase_ln_router(P, 0))
    PHASE(8, phase_moe_gu(P, smem, 0))
    PHASE(9, phase_moe_down(P, smem, 0))
    PHASE(10, phase_ln_ffn(P, 0))
    PHASE(11, phase_inproj1(P, smem))
    PHASE(12, phase_moba_gate(P, smem))
    PHASE(13, phase_moba_kv(P, smem))
    PHASE(14, phase_moba_own(P, smem))
    PHASE(15, phase_outproj(P, smem, P.out, WS_WOUT1))
    PHASE(16, phase_ln_router(P, 1))
    PHASE(17, phase_moe_gu(P, smem, 1))
    PHASE(18, phase_moe_down(P, smem, 1))
    PHASE(20, phase_ln_ffn(P, 1))
}

extern "C" void kernel_launch(void* const* d_in, const int* in_sizes, int n_in, void* d_out, int out_size, void* d_ws, size_t ws_size, hipStream_t stream) {
    static int grid = 0;
    if (grid == 0) {
        if (n_in != 32 || out_size != NT * DM || ws_size < WS_END) { fprintf(stderr, "kernel_launch: unexpected shapes (n_in %d, out %d, ws %zu)\n", n_in, out_size, ws_size); grid = -1; return; }
        int dev = 0, cus = 0, per_cu = 0;
        (void)hipGetDevice(&dev);
        (void)hipDeviceGetAttribute(&cus, hipDeviceAttributeMultiprocessorCount, dev);
        (void)hipOccupancyMaxActiveBlocksPerMultiprocessor(&per_cu, mega, 256, 0);
        if (per_cu < 1) per_cu = 1;
        if (per_cu > 2) per_cu = 2;
        grid = cus * per_cu;
    }
    if (grid < 0) return;
    (void)hipMemsetAsync((char*)d_ws + WS_CTL, 0, CTL_BYTES, stream);
    Params p{};
    for (int i = 0; i < 32; ++i) p.in[i] = (const float*)d_in[i];
    p.out = (float*)d_out; p.ws = (unsigned char*)d_ws;
    p.ph_lo = 0; p.ph_hi = NPH;
    void* args[] = {&p};
    hipError_t e = hipLaunchCooperativeKernel((void*)mega, dim3(grid), dim3(256), args, 0, stream);
    if (e != hipSuccess) fprintf(stderr, "cooperative launch failed: %s (grid %d)\n", hipGetErrorString(e), grid);
}
```

```cpp
#include <hip/hip_runtime.h>
#include <hip/hip_cooperative_groups.h>
#include <cstdio>
#include <cstdint>
namespace cg = cooperative_groups;

typedef unsigned short bf16_t;
typedef short bf16x8 __attribute__((ext_vector_type(8)));
typedef float f32x4 __attribute__((ext_vector_type(4)));
typedef unsigned u32x4 __attribute__((ext_vector_type(4)));
typedef unsigned u32x2 __attribute__((ext_vector_type(2)));
#define DI __device__ __forceinline__
#define LAS __attribute__((address_space(3)))
typedef float f32x16 __attribute__((ext_vector_type(16)));
typedef float f32x8 __attribute__((ext_vector_type(8)));
typedef __bf16 bf16x8v __attribute__((ext_vector_type(8)));
typedef __bf16 bf16x4v __attribute__((ext_vector_type(4)));
#define MFMA32(a, b, c) __builtin_amdgcn_mfma_f32_32x32x16_bf16((a), (b), (c), 0, 0, 0)

constexpr int NB = 8, SEQ = 4096, DM = 1024, NT = NB * SEQ;
constexpr float ALPHA = 1.41421356237f;
constexpr float LN_EPS = 1e-5f;
constexpr int NIN0 = 1920;
constexpr int NPH = 21;

constexpr size_t MiB = 1u << 20;
constexpr size_t WS_CTL = 0;
constexpr size_t WS_ROPE = 1 * MiB;
constexpr size_t WS_WIN0 = 2 * MiB;
constexpr size_t WS_WOUT0 = 6 * MiB;
constexpr size_t WS_WIN1 = 8 * MiB;
constexpr size_t WS_WOUT1 = 14 * MiB;
constexpr size_t WS_WGLU = 16 * MiB;
constexpr size_t WS_WCK1 = 16 * MiB + 512 * 1024;
constexpr size_t WS_WCV1 = 17 * MiB;
constexpr size_t WS_WCK2 = 17 * MiB + 512 * 1024;
constexpr size_t WS_WCV2 = WS_WCK2 + 16384;
constexpr size_t WS_CBIAS = WS_WCV2 + 16384;
constexpr size_t WS_S5AL = WS_CBIAS + 4096;
constexpr size_t WS_RTRW = 17 * MiB + 640 * 1024;
constexpr size_t WS_BTE = 18 * MiB;
constexpr size_t WS_BTY = 22 * MiB;
constexpr size_t WS_WGU = 42 * MiB;
constexpr size_t WS_WDN = 74 * MiB;
constexpr size_t WS_KMP = 90 * MiB;
constexpr size_t WS_WGT = 94 * MiB;
constexpr size_t WS_KMEAN = 94 * MiB + 512 * 1024;
constexpr size_t WS_KCMP = 95 * MiB;
constexpr size_t WS_VCMP = 95 * MiB + 512 * 1024;
constexpr size_t WS_ACTB = 96 * MiB;
constexpr size_t WS_MIX = 160 * MiB;
constexpr size_t WS_XP = 224 * MiB;
constexpr size_t WS_LIST2 = 416 * MiB;
constexpr size_t WS_SELM = 92 * MiB;
constexpr size_t WS_MCNT = 93 * MiB;
constexpr size_t WS_MLIST = WS_LIST2;
constexpr size_t WS_PO2 = 424 * MiB;
constexpr size_t WS_PML = 488 * MiB;
constexpr size_t WS_END = 504 * MiB;
constexpr size_t XP_Q0 = WS_XP;
constexpr size_t XP_KC = WS_XP + 32 * MiB;
constexpr size_t KVSZ = 8 * MiB;
constexpr size_t XP_GATES = WS_XP + 80 * MiB;
constexpr size_t XP_AEXT = WS_XP + 84 * MiB;
constexpr size_t XP_G5 = WS_XP + 124 * MiB;
constexpr size_t XP_PRE = WS_XP;
constexpr size_t XP_YB = WS_XP;
constexpr size_t XP_H = WS_XP + 128 * MiB;
constexpr size_t XP_Q1 = WS_XP;

struct Params {
    const float* in[32];
    float* out;
    unsigned char* ws;
    int ph_lo, ph_hi;
};

DI bf16_t f2bf(float f) { unsigned u = __float_as_uint(f); return (bf16_t)((u + 0x7fffu + ((u >> 16) & 1u)) >> 16); }
DI float bf2f(bf16_t h) { return __uint_as_float(((unsigned)h) << 16); }
DI unsigned pk2(float lo, float hi) { return (unsigned)f2bf(lo) | ((unsigned)f2bf(hi) << 16); }
DI bf16x8 cvt8(f32x8 v) { return __builtin_bit_cast(bf16x8, __builtin_convertvector(v, bf16x8v)); }
DI u32x2 cvt4(f32x4 v) { return __builtin_bit_cast(u32x2, __builtin_convertvector(v, bf16x4v)); }
DI size_t kp_off(int key, int d) { return ((size_t)((key >> 5) * 4 + (d >> 4)) * 32 + (key & 31)) * 16 + (d & 15); }
DI int vp_pos(int ko) { return 8 * ((ko >> 2) & 1) + 4 * (ko >> 3) + (ko & 3); }
DI size_t vp_off(int key, int d) { return ((size_t)(key >> 4) * 64 + d) * 16 + vp_pos(key & 15); }
DI bf16_t ld_bf(const bf16_t* p) { return *p; }
DI f32x4 bf4_to_f(u32x2 w) { return (f32x4){__uint_as_float(w.x << 16), __uint_as_float(w.x & 0xffff0000u), __uint_as_float(w.y << 16), __uint_as_float(w.y & 0xffff0000u)}; }
template <int CTRL> DI float dpp_f(float v) { return __builtin_bit_cast(float, __builtin_amdgcn_update_dpp(0, __builtin_bit_cast(int, v), CTRL, 0xF, 0xF, true)); }
DI float wave_sum(float v) {
    v += dpp_f<0xB1>(v);
    v += dpp_f<0x4E>(v);
    v += dpp_f<0x141>(v);
    v += dpp_f<0x140>(v);
    { const auto s = __builtin_amdgcn_permlane16_swap(__float_as_uint(v), __float_as_uint(v), false, false); v = __uint_as_float(s[0]) + __uint_as_float(s[1]); }
    { const auto s = __builtin_amdgcn_permlane32_swap(__float_as_uint(v), __float_as_uint(v), false, false); v = __uint_as_float(s[0]) + __uint_as_float(s[1]); }
    return v;
}
DI float wave_max(float v) {
#pragma unroll
    for (int o = 32; o > 0; o >>= 1) v = fmaxf(v, __shfl_xor(v, o));
    return v;
}
DI float sigmoidf_(float x) { return __builtin_amdgcn_rcpf(1.f + __expf(-x)); }
DI float gelu_tanh(float x) { const float z = 0.7978845608028654f * (x + 0.044715f * x * x * x); return x * sigmoidf_(2.f * z); }

template <bool TRANS, bool PIN = true>
DI void gemm_kstep(const LAS unsigned char* cur, int aoff, int boff, int fq, int swz, f32x4 (&acc)[4][4]) {
    if (!PIN) {
#pragma unroll
        for (int ks = 0; ks < 2; ++ks) {
            bf16x8 af[4], bfr[4];
            const int co = ((ks * 4 + fq) ^ swz) * 16;
#pragma unroll
            for (int m = 0; m < 4; ++m) af[m] = *(const LAS bf16x8*)(cur + aoff + m * 2048 + co);
#pragma unroll
            for (int n = 0; n < 4; ++n) bfr[n] = *(const LAS bf16x8*)(cur + boff + n * 2048 + co);
#pragma unroll
            for (int m = 0; m < 4; ++m)
#pragma unroll
                for (int n = 0; n < 4; ++n) acc[m][n] = TRANS ? __builtin_amdgcn_mfma_f32_16x16x32_bf16(bfr[n], af[m], acc[m][n], 0, 0, 0) : __builtin_amdgcn_mfma_f32_16x16x32_bf16(af[m], bfr[n], acc[m][n], 0, 0, 0);
        }
        return;
    }
    bf16x8 af[2][4], bfr[2][4];
    const int co0 = (fq ^ swz) * 16, co1 = ((4 + fq) ^ swz) * 16;
    af[0][0] = *(const LAS bf16x8*)(cur + aoff + co0);
#pragma unroll
    for (int n = 0; n < 4; ++n) bfr[0][n] = *(const LAS bf16x8*)(cur + boff + n * 2048 + co0);
#pragma unroll
    for (int m = 1; m < 4; ++m) af[0][m] = *(const LAS bf16x8*)(cur + aoff + m * 2048 + co0);
    __builtin_amdgcn_sched_barrier(0);
#pragma unroll
    for (int n = 0; n < 4; ++n) acc[0][n] = TRANS ? __builtin_amdgcn_mfma_f32_16x16x32_bf16(bfr[0][n], af[0][0], acc[0][n], 0, 0, 0) : __builtin_amdgcn_mfma_f32_16x16x32_bf16(af[0][0], bfr[0][n], acc[0][n], 0, 0, 0);
    __builtin_amdgcn_sched_barrier(0);
    af[1][0] = *(const LAS bf16x8*)(cur + aoff + co1);
#pragma unroll
    for (int n = 0; n < 4; ++n) bfr[1][n] = *(const LAS bf16x8*)(cur + boff + n * 2048 + co1);
#pragma unroll
    for (int m = 1; m < 4; ++m) af[1][m] = *(const LAS bf16x8*)(cur + aoff + m * 2048 + co1);
    __builtin_amdgcn_sched_barrier(0);
#pragma unroll
    for (int m = 1; m < 4; ++m)
#pragma unroll
        for (int n = 0; n < 4; ++n) acc[m][n] = TRANS ? __builtin_amdgcn_mfma_f32_16x16x32_bf16(bfr[0][n], af[0][m], acc[m][n], 0, 0, 0) : __builtin_amdgcn_mfma_f32_16x16x32_bf16(af[0][m], bfr[0][n], acc[m][n], 0, 0, 0);
#pragma unroll
    for (int m = 0; m < 4; ++m)
#pragma unroll
        for (int n = 0; n < 4; ++n) acc[m][n] = TRANS ? __builtin_amdgcn_mfma_f32_16x16x32_bf16(bfr[1][n], af[1][m], acc[m][n], 0, 0, 0) : __builtin_amdgcn_mfma_f32_16x16x32_bf16(af[1][m], bfr[1][n], acc[m][n], 0, 0, 0);
}
constexpr int GEMM_LDS = 65536;
template <bool TRANS = true, bool PIN = true, class RowPtr, class Epi>
DI void gemm128(RowPtr rowptr, const bf16_t* __restrict__ Bt, int ldb, int K, unsigned char* smem, Epi epi, int kskip_lo = 0, int kskip_hi = 0) {
    LAS unsigned char* lds = (LAS unsigned char*)smem;
    const int tid = threadIdx.x, lane = tid & 63, wave = tid >> 6, wr = wave >> 1, wc = wave & 1, fr = lane & 15, fq = lane >> 4;
    const int schunk = ((tid & 7) ^ ((tid >> 4) & 7)) * 8;
    const bf16_t* ga[4];
#pragma unroll
    for (int i = 0; i < 4; ++i) ga[i] = rowptr(i * 32 + (tid >> 3)) + schunk;
    const bf16_t* gb = Bt + (size_t)(tid >> 3) * ldb + schunk;
    const size_t gbs = (size_t)32 * ldb;
    auto stage = [&](int kt, int s) {
#pragma unroll
        for (int i = 0; i < 4; ++i) {
            __builtin_amdgcn_global_load_lds((const unsigned*)(ga[i] + kt * 64), (LAS unsigned*)(lds + s * 32768 + (i * 256 + tid) * 16), 16, 0, 0);
            __builtin_amdgcn_global_load_lds((const unsigned*)(gb + i * gbs + kt * 64), (LAS unsigned*)(lds + s * 32768 + 16384 + (i * 256 + tid) * 16), 16, 0, 0);
        }
    };
    f32x4 acc[4][4];
#pragma unroll
    for (int m = 0; m < 4; ++m)
#pragma unroll
        for (int n = 0; n < 4; ++n) acc[m][n] = (f32x4){0.f, 0.f, 0.f, 0.f};
    const int nskip = kskip_hi - kskip_lo, nk = (K >> 6) - nskip;
    const int swz = (fr >> 1) & 7;
    const int aoff = (wr * 64 + fr) * 128, boff = 16384 + (wc * 64 + fr) * 128;
    stage(kskip_lo == 0 ? nskip : 0, 0);
#pragma unroll 1
    for (int kt = 0; kt < nk; ++kt) {
        asm volatile("s_waitcnt vmcnt(0)" ::: "memory");
        __syncthreads();
        if (kt + 1 < nk) stage(kt + 1 < kskip_lo ? kt + 1 : kt + 1 + nskip, (kt + 1) & 1);
        const LAS unsigned char* cur = lds + (kt & 1) * 32768;
        gemm_kstep<TRANS, PIN>(cur, aoff, boff, fq, swz, acc);
    }
    __syncthreads();
    epi(acc, wr, wc, lane);
}

template <bool TRANS = true, class RowPtr, class Epi, class NextRow>
DI void gemm128s(RowPtr rowptr, const bf16_t* __restrict__ Bt, int ldb, int K, unsigned char* smem, Epi epi, bool prefetched, bool has_next, NextRow nextrow, const bf16_t* __restrict__ nextBt) {
    LAS unsigned char* lds = (LAS unsigned char*)smem;
    const int tid = threadIdx.x, lane = tid & 63, wave = tid >> 6, wr = wave >> 1, wc = wave & 1, fr = lane & 15, fq = lane >> 4;
    const int schunk = ((tid & 7) ^ ((tid >> 4) & 7)) * 8;
    const bf16_t* ga[4];
#pragma unroll
    for (int i = 0; i < 4; ++i) ga[i] = rowptr(i * 32 + (tid >> 3)) + schunk;
    const bf16_t* gb = Bt + (size_t)(tid >> 3) * ldb + schunk;
    const size_t gbs = (size_t)32 * ldb;
    auto stage = [&](int kt, int s) {
#pragma unroll
        for (int i = 0; i < 4; ++i) {
            __builtin_amdgcn_global_load_lds((const unsigned*)(ga[i] + kt * 64), (LAS unsigned*)(lds + s * 32768 + (i * 256 + tid) * 16), 16, 0, 0);
            __builtin_amdgcn_global_load_lds((const unsigned*)(gb + i * gbs + kt * 64), (LAS unsigned*)(lds + s * 32768 + 16384 + (i * 256 + tid) * 16), 16, 0, 0);
        }
    };
    f32x4 acc[4][4];
#pragma unroll
    for (int m = 0; m < 4; ++m)
#pragma unroll
        for (int n = 0; n < 4; ++n) acc[m][n] = (f32x4){0.f, 0.f, 0.f, 0.f};
    const int nk = K >> 6;
    const int swz = (fr >> 1) & 7;
    const int aoff = (wr * 64 + fr) * 128, boff = 16384 + (wc * 64 + fr) * 128;
    if (!prefetched) stage(0, 0);
#pragma unroll 1
    for (int kt = 0; kt < nk; ++kt) {
        asm volatile("s_waitcnt vmcnt(0)" ::: "memory");
        __syncthreads();
        if (kt + 1 < nk) stage(kt + 1, (kt + 1) & 1);
        else if (has_next) {
#pragma unroll
            for (int i = 0; i < 4; ++i) {
                __builtin_amdgcn_global_load_lds((const unsigned*)(nextrow(i * 32 + (tid >> 3)) + schunk), (LAS unsigned*)(lds + (i * 256 + tid) * 16), 16, 0, 0);
                __builtin_amdgcn_global_load_lds((const unsigned*)(nextBt + (size_t)(tid >> 3) * ldb + schunk + i * gbs), (LAS unsigned*)(lds + 16384 + (i * 256 + tid) * 16), 16, 0, 0);
            }
        }
        const LAS unsigned char* cur = lds + (kt & 1) * 32768;
        gemm_kstep<TRANS>(cur, aoff, boff, fq, swz, acc);
    }
    epi(acc, wr, wc, lane);
}

DI int vblock() { const int G = gridDim.x; return (G & 7) == 0 ? (int)(blockIdx.x & 7) * (G >> 3) + (int)(blockIdx.x >> 3) : (int)blockIdx.x; }
DI void tile_mn(int it, int nN, int& mt, int& nt) { const int per = 8 * nN, grp = it / per, idx = it - grp * per; nt = idx >> 3; mt = grp * 8 + (idx & 7); }

DI int rope_pos(int l) { return (l & ~63) + ((2 * ((l & 31) >> 4) + ((l >> 5) & 1)) << 4) + (l & 15); }
DI int rowmap(int kind, int n) {
    if (kind == 1) {
        if (n < 512 || (n >= 512 && n < 640) || (n >= 768 && n < 896) || (n >= 1024 && n < 1152)) return rope_pos(n);
        return n < 1304 ? n : n + 104;
    }
    if (kind == 4) return n < 2048 ? rope_pos(n) : n;
    if (kind == 2) return ((n >> 5) << 6) + (n & 31);
    if (kind == 3) return ((n >> 5) << 6) + 32 + (n & 31);
    return n;
}
DI void tr_tile(const float* __restrict__ src, int K, int N, bf16_t* __restrict__ dst, int kind, int kt, int nt, float* s) {
    const int tid = threadIdx.x, k0 = kt * 64, n0 = nt * 64;
    {
        const int nn = tid & 63, kq = tid >> 6, n = n0 + nn;
#pragma unroll
        for (int i = 0; i < 16; ++i) { const int kk = kq + 4 * i; s[kk * 65 + nn] = (n < N) ? src[(size_t)(k0 + kk) * N + n] : 0.f; }
    }
    __syncthreads();
    {
        const int rn = tid >> 2, kseg = (tid & 3) * 16, n = n0 + rn;
        if (n < N) {
            unsigned w[8];
#pragma unroll
            for (int i = 0; i < 8; ++i) w[i] = pk2(s[(kseg + 2 * i) * 65 + rn], s[(kseg + 2 * i + 1) * 65 + rn]);
            bf16_t* d = dst + (size_t)rowmap(kind, n) * K + k0 + kseg;
            *(uint4*)d = make_uint4(w[0], w[1], w[2], w[3]);
            *(uint4*)(d + 8) = make_uint4(w[4], w[5], w[6], w[7]);
        }
    }
    __syncthreads();
}
struct CF { float re, im; };
DI CF cmul(CF a, CF b) { return {a.re * b.re - a.im * b.im, a.re * b.im + a.im * b.re}; }
DI CF s5_apow(const Params& P, int g, int p, float tau) {
    const float step = expf(P.in[10][g]);
    const float lr = P.in[8][g * 64 + p], li = P.in[9][g * 64 + p];
    const float mag = expf(lr * step * tau);
    float sn, cs; sincosf(li * step * tau, &sn, &cs);
    return {mag * cs, mag * sn};
}
DI CF s5_f(const Params& P, int g, int p) {
    const CF a = s5_apow(P, g, p, 1.f);
    const float lr = P.in[8][g * 64 + p], li = P.in[9][g * 64 + p];
    const float den = lr * lr + li * li;
    return {((a.re - 1.f) * lr + a.im * li) / den, (a.im * lr - (a.re - 1.f) * li) / den};
}
DI void phase0(const Params& P, unsigned char* smem) {
    const int tid = threadIdx.x;
    unsigned char* ws = P.ws;
    float* sf = (float*)smem;
    constexpr int N_TR0 = 16 * 29, N_TR1 = 256, N_TR2 = 16 * 48, N_TR3 = 256, N_TR4 = 64, N_TR5 = 64, N_TR6 = 64, N_TR7 = 2, N_TR8 = 2;
    constexpr int N_TRG = 64 * 32, N_TRU = 64 * 32, N_TRD = 64 * 32;
    constexpr int N_X = NT * DM / 8192, N_ROPE = 512, N_CB = 16, N_AL = 8, N_BTE = 256, N_BTYM = 32 * 63, N_BTYQ = 4096, N_ZP = 13;
    constexpr int N_RW = 2 * 36864 / 256;
    constexpr int TOTAL = N_RW + N_TR0 + N_TR1 + N_TR4 + N_TR5 + N_TR6 + N_TR7 + N_TR8 + N_X + N_ROPE + N_CB + N_AL + N_BTE + N_BTYM + N_BTYQ + N_ZP;
    for (int it0 = blockIdx.x; it0 < TOTAL; it0 += gridDim.x) {
        int it = it0;
        if (it < N_RW) {
            const int e = it * 256 + tid, layer = e / 36864, r = e % 36864;
            float* dst = (float*)(ws + WS_RTRW) + (size_t)layer * 36864;
            if (r < 4096) { const int o = r & 3, l = (r >> 2) & 63, jk = r >> 8, d = 4 * l + 256 * (jk >> 2) + (jk & 3); dst[r] = P.in[25][((size_t)layer * 1024 + d) * 4 + o]; }
            else { const int q = r - 4096, o = q & 3, l = (q >> 2) & 63, hf = (q >> 8) & 1, jk = (q >> 9) & 15, g = q >> 13, d = 4 * l + 256 * (jk >> 2) + (jk & 3);
                   dst[r] = P.in[27][(((size_t)layer * 4 + g) * 1024 + d) * 8 + hf * 4 + o]; }
            continue;
        } it -= N_RW;
        if (it < N_TR0) { tr_tile(P.in[1], 1024, 1816, (bf16_t*)(ws + WS_WIN0), 1, it / 29, it % 29, sf); continue; } it -= N_TR0;
        if (it < N_TR1) { tr_tile(P.in[18], 1024, 1024, (bf16_t*)(ws + WS_WOUT0), 0, it / 16, it % 16, sf); continue; } it -= N_TR1;
        if (it < N_TR4) { tr_tile(P.in[16], 512, 512, (bf16_t*)(ws + WS_WGLU), 0, it / 8, it % 8, sf); continue; } it -= N_TR4;
        if (it < N_TR5) { tr_tile(P.in[4], 2048, 128, (bf16_t*)(ws + WS_WCK1), 0, it / 2, it % 2, sf); continue; } it -= N_TR5;
        if (it < N_TR6) { tr_tile(P.in[6], 2048, 128, (bf16_t*)(ws + WS_WCV1), 0, it / 2, it % 2, sf); continue; } it -= N_TR6;
        if (it < N_TR7) { tr_tile(P.in[5], 128, 64, (bf16_t*)(ws + WS_WCK2), 0, it, 0, sf); continue; } it -= N_TR7;
        if (it < N_TR8) { tr_tile(P.in[7], 128, 64, (bf16_t*)(ws + WS_WCV2), 0, it, 0, sf); continue; } it -= N_TR8;
        if (it < N_X) {
            const float* x = P.in[0]; bf16_t* xb = (bf16_t*)(ws + WS_ACTB);
#pragma unroll
            for (int i = 0; i < 4; ++i) {
                const size_t idx = (size_t)it * 8192 + i * 2048 + tid * 8;
                const f32x4 a = __builtin_nontemporal_load((const f32x4*)(x + idx)), b = __builtin_nontemporal_load((const f32x4*)(x + idx + 4));
                *(uint4*)(xb + idx) = make_uint4(pk2(a.x, a.y), pk2(a.z, a.w), pk2(b.x, b.y), pk2(b.z, b.w));
            }
            continue;
        } it -= N_X;
        if (it < N_ROPE) {
            const int e = it * 256 + tid, pos = e >> 5, i = e & 31;
            const float inv = 1.0f / powf(10000.0f, (float)(2 * i) / 64.0f);
            const float ang = (float)pos * inv;
            ((float*)(ws + WS_ROPE))[e] = (float)cos((double)ang);
            ((float*)(ws + WS_ROPE))[4096 * 32 + e] = (float)sin((double)ang);
            continue;
        } it -= N_ROPE;
        if (it < N_CB) {
            const int kv = it >> 3, j0 = (it & 7) * 16, j = j0 + (tid & 15), sl = tid >> 4;
            const float* pe = P.in[kv ? 3 : 2]; const float* w1 = P.in[kv ? 6 : 4];
            float a = 0.f;
            for (int i = sl * 128; i < sl * 128 + 128; ++i) a += pe[i] * w1[(size_t)i * 128 + j];
            sf[tid] = a; __syncthreads();
            if (tid < 16) { float t = 0.f; for (int q = 0; q < 16; ++q) t += sf[q * 16 + tid]; ((float*)(ws + WS_CBIAS))[kv * 128 + j0 + tid] = t; }
            __syncthreads();
            continue;
        } it -= N_CB;
        if (it < N_AL) {
            const int e = it * 256 + tid, g = e >> 6, p = e & 63;
            const CF a = s5_apow(P, g, p, 32.f);
            ((float*)(ws + WS_S5AL))[e * 2] = a.re; ((float*)(ws + WS_S5AL))[e * 2 + 1] = a.im;
            continue;
        } it -= N_AL;
        if (it < N_BTE) {
            const int e = it * 256 + tid, g = e >> 11, p = (e >> 5) & 63, r = e & 31;
            const CF w = cmul(s5_apow(P, g, p, (float)(31 - r)), s5_f(P, g, p));
            bf16_t* d = (bf16_t*)(ws + WS_BTE) + (size_t)g * 128 * 512;
#pragma unroll
            for (int c = 0; c < 16; ++c) {
                const CF bb = {P.in[11][(g * 64 + p) * 16 + c], P.in[12][(g * 64 + p) * 16 + c]};
                const CF v = cmul(w, bb);
                d[(size_t)p * 512 + r * 16 + c] = f2bf(v.re);
                d[(size_t)(64 + p) * 512 + r * 16 + c] = f2bf(v.im);
            }
            continue;
        } it -= N_BTE;
        if (it < N_BTYM) {
            const int g = it / 63, dd = it % 63 - 31, ch = tid >> 4, c = tid & 15;
            float val = 0.f;
            if (dd >= 0) {
                float* sw = sf; float* sb = sf + 128; float* sc = sf + 128 + 2048;
                if (tid < 64) { const CF w = cmul(s5_apow(P, g, tid, (float)dd), s5_f(P, g, tid)); sw[2 * tid] = w.re; sw[2 * tid + 1] = w.im; }
#pragma unroll
                for (int i = 0; i < 4; ++i) {
                    const int e = tid + 256 * i;
                    sb[2 * e] = P.in[11][(size_t)g * 1024 + e]; sb[2 * e + 1] = P.in[12][(size_t)g * 1024 + e];
                    sc[2 * e] = P.in[13][(size_t)g * 1024 + e]; sc[2 * e + 1] = P.in[14][(size_t)g * 1024 + e];
                }
                __syncthreads();
#pragma unroll 8
                for (int p = 0; p < 64; ++p) {
                    const CF bb = {sb[2 * (p * 16 + c)], sb[2 * (p * 16 + c) + 1]};
                    const CF cc = {sc[2 * (ch * 64 + p)], sc[2 * (ch * 64 + p) + 1]};
                    const CF w = {sw[2 * p], sw[2 * p + 1]};
                    val += cmul(cc, cmul(w, bb)).re;
                }
                __syncthreads();
            }
            bf16_t* d = (bf16_t*)(ws + WS_BTY) + (size_t)g * 512 * 640;
            const bf16_t hv = f2bf(val);
            for (int r = 0; r < 32; ++r) { const int s = r + dd; if (s >= 0 && s < 32) d[(size_t)(s * 16 + ch) * 640 + r * 16 + c] = hv; }
            continue;
        } it -= N_BTYM;
        if (it < N_BTYQ) {
            const int e = it * 256 + tid, g = e >> 15, s = (e >> 10) & 31, ch = (e >> 6) & 15, p = e & 63;
            const CF cc = {P.in[13][(g * 16 + ch) * 64 + p], P.in[14][(g * 16 + ch) * 64 + p]};
            const CF w = cmul(cc, s5_apow(P, g, p, (float)(s + 1)));
            bf16_t* d = (bf16_t*)(ws + WS_BTY) + ((size_t)g * 512 + s * 16 + ch) * 640 + 512;
            d[p] = f2bf(w.re); d[64 + p] = f2bf(-w.im);
            continue;
        } it -= N_BTYQ;
        {
            uint4* d = (uint4*)((bf16_t*)(ws + WS_WIN0) + (size_t)(1304 + it * 8) * 1024);
#pragma unroll
            for (int i = 0; i < 4; ++i) d[i * 256 + tid] = make_uint4(0, 0, 0, 0);
        }
    }
}

DI void phase_inproj0(const Params& P, unsigned char* smem) {
    unsigned char* ws = P.ws;
    const bf16_t* A = (const bf16_t*)(ws + WS_ACTB);
    const float* cosT = (const float*)(ws + WS_ROPE);
    const float* sinT = cosT + 4096 * 32;
    constexpr int NTN = NIN0 / 128;
    bool pre = false;
    for (int it = vblock(); it < (NT / 128) * NTN; it += gridDim.x) {
        int mt, nt; tile_mn(it, NTN, mt, nt);
        const int m0 = mt * 128;
        auto rowptr = [=](int r) { return A + (size_t)(m0 + r) * 1024; };
        const bf16_t* Bt = (const bf16_t*)(ws + WS_WIN0) + (size_t)nt * 128 * 1024;
        const bool hn = it + (int)gridDim.x < (NT / 128) * NTN;
        int mtn = 0, ntn = 0; if (hn) tile_mn(it + gridDim.x, NTN, mtn, ntn);
        auto nextrow = [=](int r) { return A + (size_t)(mtn * 128 + r) * 1024; };
        const bf16_t* nBt = (const bf16_t*)(ws + WS_WIN0) + (size_t)ntn * 128 * 1024;
        if (nt == 7 || nt == 9) {
            auto epi = [=](f32x4 (&acc)[4][4], int wr, int wc, int lane) {
                const int fr = lane & 15, fq = lane >> 4, which = nt == 7 ? 3 : 5, g = wc;
#pragma unroll
                for (int m = 0; m < 4; ++m) {
                    const int t = m0 + wr * 64 + m * 16 + fq * 4, s = t & 4095, b = t >> 12;
                    bf16_t* dst = (bf16_t*)(ws + XP_KC + (size_t)which * KVSZ) + (size_t)(b * 2 + g) * 4096 * 64;
#pragma unroll
                    for (int n = 0; n < 4; ++n) *(u32x2*)(dst + vp_off(s, n * 16 + fr)) = cvt4(acc[m][n]);
                }
            };
            gemm128s<false>(rowptr, Bt, 1024, 1024, smem, epi, pre, hn, nextrow, nBt);
            pre = hn;
            continue;
        }
        auto epi = [=](f32x4 (&acc)[4][4], int wr, int wc, int lane) {
            const int u64 = nt * 2 + wc, fr = lane & 15, fq = lane >> 4;
#pragma unroll
            for (int m = 0; m < 4; ++m) {
                const int t = m0 + wr * 64 + m * 16 + fr, s = t & 4095, b = t >> 12;
                if (u64 < 20) {
                    const bool isq = u64 < 8;
                    const int which = (u64 - 8) >> 1, g = (u64 - 8) & 1;
                    if (isq || ((which & 1) == 0)) {
#pragma unroll
                        for (int n2 = 0; n2 < 2; ++n2) {
                            const int i = n2 * 16 + fq * 4;
                            const f32x4 c = *(const f32x4*)(cosT + s * 32 + i), sn = *(const f32x4*)(sinT + s * 32 + i);
                            const f32x4 x1 = acc[m][2 * n2], x2 = acc[m][2 * n2 + 1];
                            const u32x2 o1 = cvt4(x1 * c - x2 * sn), o2 = cvt4(x1 * sn + x2 * c);
                            if (isq) { bf16_t* dst = (bf16_t*)(ws + XP_Q0) + (size_t)t * 512 + u64 * 64; *(u32x2*)(dst + i) = o1; *(u32x2*)(dst + i + 32) = o2; }
                            else {
                                bf16_t* dst = (bf16_t*)(ws + XP_KC + (size_t)which * KVSZ) + (size_t)(b * 2 + g) * 4096 * 64;
                                if (which == 0) { *(u32x2*)(dst + (size_t)s * 64 + i) = o1; *(u32x2*)(dst + (size_t)s * 64 + i + 32) = o2; }
                                else { *(u32x2*)(dst + kp_off(s, i)) = o1; *(u32x2*)(dst + kp_off(s, i + 32)) = o2; }
                            }
                        }
                    } else {
                        bf16_t* dst = (bf16_t*)(ws + XP_KC + (size_t)which * KVSZ) + ((size_t)(b * 2 + g) * 4096 + s) * 64;
#pragma unroll
                        for (int n = 0; n < 4; ++n) *(u32x2*)(dst + n * 16 + fq * 4) = cvt4(acc[m][n]);
                    }
                } else if (u64 == 20) {
#pragma unroll
                    for (int n = 0; n < 2; ++n) {
                        const int c0 = n * 16 + fq * 4;
                        if (c0 < 24) { f32x4 o; o.x = sigmoidf_(acc[m][n].x); o.y = sigmoidf_(acc[m][n].y); o.z = sigmoidf_(acc[m][n].z); o.w = sigmoidf_(acc[m][n].w); *(f32x4*)((float*)(ws + XP_GATES) + (size_t)t * 24 + c0) = o; }
                    }
                } else if (u64 >= 22) {
#pragma unroll
                    for (int n = 0; n < 4; ++n) {
                        const int g5 = (u64 - 22) * 4 + n;
                        *(u32x2*)((bf16_t*)(ws + XP_AEXT) + ((size_t)g5 * 1024 + (t >> 5)) * 640 + (t & 31) * 16 + fq * 4) = cvt4(acc[m][n]);
                    }
                }
            }
        };
        gemm128s(rowptr, Bt, 1024, 1024, smem, epi, pre, hn, nextrow, nBt);
        pre = hn;
    }
}

constexpr int N_LATE = 16 * 48 + 256 + 3 * 64 * 32;
DI void late_weights(const Params& P, unsigned char* smem, int it) {
    unsigned char* ws = P.ws;
    float* sf = (float*)smem;
    constexpr int N_TR2 = 16 * 48, N_TR3 = 256, N_TRG = 64 * 32, N_TRU = 64 * 32;
    if (it < N_TR2) { tr_tile(P.in[19], 1024, 3072, (bf16_t*)(ws + WS_WIN1), 4, it / 48, it % 48, sf); return; } it -= N_TR2;
    if (it < N_TR3) { tr_tile(P.in[20], 1024, 1024, (bf16_t*)(ws + WS_WOUT1), 0, it / 16, it % 16, sf); return; } it -= N_TR3;
    if (it < N_TRG) { const int mat = it >> 5, r = it & 31; tr_tile(P.in[29] + (size_t)mat * 1024 * 128, 1024, 128, (bf16_t*)(ws + WS_WGU) + (size_t)mat * 256 * 1024, 2, r >> 1, r & 1, sf); return; } it -= N_TRG;
    if (it < N_TRU) { const int mat = it >> 5, r = it & 31; tr_tile(P.in[30] + (size_t)mat * 1024 * 128, 1024, 128, (bf16_t*)(ws + WS_WGU) + (size_t)mat * 256 * 1024, 3, r >> 1, r & 1, sf); return; } it -= N_TRU;
    { const int mat = it >> 5, r = it & 31; tr_tile(P.in[31] + (size_t)mat * 128 * 1024, 128, 1024, (bf16_t*)(ws + WS_WDN) + (size_t)mat * 1024 * 128, 0, r >> 4, r & 15, sf); }
}

DI void s5y_tile(const Params& P, unsigned char* smem, int g, int mt, int nt);
DI void phase_cmp_s5e(const Params& P, unsigned char* smem) {
    unsigned char* ws = P.ws;
    const int tid = threadIdx.x, lane = tid & 63, wave = tid >> 6;
    const int G = gridDim.x, bid = blockIdx.x;
    const bool split = G >= 384;
    const int nmine = !split ? (320 + N_LATE + G - 1 - bid) / G : (bid < 320 ? 1 : (N_LATE + (G - 320) - 1 - (bid - 320)) / (G - 320));
    for (int k = 0; k < nmine; ++k) {
        const int it = !split ? bid + k * G : (bid < 320 ? bid : 320 + (bid - 320) + k * (G - 320));
        if (it >= 64 + 256) { late_weights(P, smem, it - 320); continue; }
        if (it < 64) {
            const int kv = it >> 5, bg = (it >> 1) & 15, mt = it & 1;
            const bf16_t* src = (const bf16_t*)(ws + XP_KC + (size_t)kv * KVSZ) + (size_t)bg * 4096 * 64;
            const float* cb = (const float*)(ws + WS_CBIAS) + kv * 128;
            bf16_t* sH = (bf16_t*)smem;
            auto rowptr = [=](int r) { int rr = mt * 128 + r; rr = rr > 254 ? 254 : rr; return src + (size_t)rr * 1024; };
            auto epi = [=](f32x4 (&acc)[4][4], int wr, int wc, int ln) {
                const int fr = ln & 15, fq = ln >> 4;
#pragma unroll
                for (int m = 0; m < 4; ++m)
#pragma unroll
                    for (int n = 0; n < 4; ++n)
#pragma unroll
                        for (int j = 0; j < 4; ++j) {
                            const int r = wr * 64 + m * 16 + fr, c = wc * 64 + n * 16 + fq * 4 + j;
                            sH[r * 136 + c] = f2bf(gelu_tanh(acc[m][n][j] + cb[c]));
                        }
            };
            gemm128(rowptr, (const bf16_t*)(ws + (kv ? WS_WCV1 : WS_WCK1)), 2048, 2048, smem, epi);
            __syncthreads();
            const bf16_t* W2 = (const bf16_t*)(ws + (kv ? WS_WCV2 : WS_WCK2));
            f32x4 a2[2][4];
#pragma unroll
            for (int m = 0; m < 2; ++m)
#pragma unroll
                for (int n = 0; n < 4; ++n) a2[m][n] = (f32x4){0.f, 0.f, 0.f, 0.f};
#pragma unroll
            for (int ks = 0; ks < 4; ++ks) {
                bf16x8 af[2], bfr[4];
#pragma unroll
                for (int m = 0; m < 2; ++m) af[m] = *(const bf16x8*)(sH + (wave * 32 + m * 16 + (lane & 15)) * 136 + ks * 32 + (lane >> 4) * 8);
#pragma unroll
                for (int n = 0; n < 4; ++n) bfr[n] = *(const bf16x8*)(W2 + (n * 16 + (lane & 15)) * 128 + ks * 32 + (lane >> 4) * 8);
#pragma unroll
                for (int m = 0; m < 2; ++m)
#pragma unroll
                    for (int n = 0; n < 4; ++n) a2[m][n] = __builtin_amdgcn_mfma_f32_16x16x32_bf16(af[m], bfr[n], a2[m][n], 0, 0, 0);
            }
            bf16_t* dst = (bf16_t*)(ws + (kv ? WS_VCMP : WS_KCMP)) + (size_t)bg * 256 * 64;
#pragma unroll
            for (int m = 0; m < 2; ++m)
#pragma unroll
                for (int n = 0; n < 4; ++n)
#pragma unroll
                    for (int j = 0; j < 4; ++j) {
                        const int row = mt * 128 + wave * 32 + m * 16 + (lane >> 4) * 4 + j, col = n * 16 + (lane & 15);
                        dst[kv ? vp_off(row, col) : kp_off(row, col)] = row < 255 ? f2bf(a2[m][n][j]) : (bf16_t)0;
                    }
            __syncthreads();
        } else {
            const int it2 = it - 64, g = it2 >> 3, b = it2 & 7;
            bf16_t* aext = (bf16_t*)(ws + XP_AEXT) + ((size_t)g * 1024 + b * 128) * 640;
            float* sE = (float*)smem;
            auto rowptr = [=](int r) { return (const bf16_t*)aext + (size_t)r * 640; };
            auto epi = [=](f32x4 (&acc)[4][4], int wr, int wc, int ln) {
                const int fr = ln & 15, fq = ln >> 4;
#pragma unroll
                for (int m = 0; m < 4; ++m)
#pragma unroll
                    for (int n = 0; n < 4; ++n)
#pragma unroll
                        for (int j = 0; j < 4; ++j) sE[(wr * 64 + m * 16 + fr) * 129 + wc * 64 + n * 16 + fq * 4 + j] = acc[m][n][j];
            };
            gemm128<true, false>(rowptr, (const bf16_t*)(ws + WS_BTE) + (size_t)g * 128 * 512, 512, 512, smem, epi);
            __syncthreads();
            {
                const int p = tid & 63, c0 = wave * 32;
                const float ar = ((const float*)(ws + WS_S5AL))[(g * 64 + p) * 2], ai = ((const float*)(ws + WS_S5AL))[(g * 64 + p) * 2 + 1];
                float* send = (float*)(smem + 128 * 129 * 4);
                float xr = 0.f, xi = 0.f;
                for (int c = c0; c < c0 + 32; ++c) {
                    const float er = sE[c * 129 + p], ei = sE[c * 129 + 64 + p];
                    const float nr = ar * xr - ai * xi + er, ni = ar * xi + ai * xr + ei;
                    xr = nr; xi = ni;
                }
                send[(wave * 64 + p) * 2] = xr; send[(wave * 64 + p) * 2 + 1] = xi;
                float qr = ar, qi = ai;
#pragma unroll
                for (int k = 0; k < 5; ++k) { const float tr = qr * qr - qi * qi, ti = 2.f * qr * qi; qr = tr; qi = ti; }
                __syncthreads();
                xr = 0.f; xi = 0.f;
                for (int k = 0; k < wave; ++k) {
                    const float er = send[(k * 64 + p) * 2], ei = send[(k * 64 + p) * 2 + 1];
                    const float nr = qr * xr - qi * xi + er, ni = qr * xi + qi * xr + ei;
                    xr = nr; xi = ni;
                }
                for (int c = c0; c < c0 + 32; ++c) {
                    aext[(size_t)c * 640 + 512 + p] = f2bf(xr);
                    aext[(size_t)c * 640 + 576 + p] = f2bf(xi);
                    const float er = sE[c * 129 + p], ei = sE[c * 129 + 64 + p];
                    const float nr = ar * xr - ai * xi + er, ni = ar * xi + ai * xr + ei;
                    xr = nr; xi = ni;
                }
            }
            asm volatile("s_waitcnt vmcnt(0)" ::: "memory");
            __syncthreads();
#pragma unroll 1
            for (int nt = 0; nt < 4; ++nt) s5y_tile(P, smem, g, b, nt);
        }
    }
}

DI void s5y_tile(const Params& P, unsigned char* smem, int g, int mt, int nt) {
    unsigned char* ws = P.ws;
    const bf16_t* aext = (const bf16_t*)(ws + XP_AEXT) + (size_t)g * 1024 * 640;
    const float* dsk = P.in[15];
    auto rowptr = [=](int r) { return aext + (size_t)(mt * 128 + r) * 640; };
    auto epi = [=](f32x4 (&acc)[4][4], int wr, int wc, int ln) {
        const int fr = ln & 15, fq = ln >> 4;
        const f32x4 dk = *(const f32x4*)(dsk + g * 16 + fq * 4);
#pragma unroll
        for (int m = 0; m < 4; ++m) {
            const int cr = mt * 128 + wr * 64 + m * 16 + fr;
#pragma unroll
            for (int n = 0; n < 4; ++n) {
                const int sp = nt * 8 + wc * 4 + n, t = cr * 32 + sp;
                const f32x4 u = bf4_to_f(*(const u32x2*)(aext + (size_t)cr * 640 + sp * 16 + fq * 4));
                const f32x4 y = acc[m][n] + dk * u;
                *(u32x2*)((bf16_t*)(ws + XP_G5) + (size_t)t * 512 + g * 16 + fq * 4) = cvt4((f32x4){gelu_tanh(y.x), gelu_tanh(y.y), gelu_tanh(y.z), gelu_tanh(y.w)});
            }
        }
    };
    gemm128<true, false>(rowptr, (const bf16_t*)(ws + WS_BTY) + ((size_t)g * 512 + nt * 128) * 640, 640, 640, smem, epi, 2 * nt + 2, 8);
}
struct FA { f32x16 o0, o1; float m, l; };
DI void fa_init(FA& st) {
#pragma unroll
    for (int i = 0; i < 16; ++i) { st.o0[i] = 0.f; st.o1[i] = 0.f; }
    st.m = -1e30f; st.l = 0.f;
}
constexpr float FA_THR = 8.f;
template <int MODE, class Valid>
DI void fa_tile(FA& st, const bf16x8 (&qf)[4], const LAS bf16_t* Kt, const LAS bf16_t* Vt, int r, int h, float c, bool rowok, Valid valid) {
    const LAS bf16_t* kb = Kt + r * 16 + 8 * h;
    const LAS bf16_t* vb = Vt + r * 16 + 8 * h;
    bf16x8 kf[4], vf[4];
#pragma unroll
    for (int ks = 0; ks < 4; ++ks) kf[ks] = *(const LAS bf16x8*)(kb + ks * 512);
#pragma unroll
    for (int sub = 0; sub < 2; ++sub) {
        f32x16 acc;
#pragma unroll
        for (int i = 0; i < 16; ++i) acc[i] = 0.f;
#pragma unroll
        for (int ks = 0; ks < 4; ++ks) acc = MFMA32(kf[ks], qf[ks], acc);
#pragma unroll
        for (int s2 = 0; s2 < 2; ++s2) { vf[2 * s2] = *(const LAS bf16x8*)(vb + ((sub * 2 + s2) * 64) * 16); vf[2 * s2 + 1] = *(const LAS bf16x8*)(vb + ((sub * 2 + s2) * 64 + 32) * 16); }
        if (sub == 0) {
#pragma unroll
            for (int ks = 0; ks < 4; ++ks) kf[ks] = *(const LAS bf16x8*)(kb + (4 + ks) * 512);
        }
        __builtin_amdgcn_sched_barrier(0);
        float mx = -INFINITY;
#pragma unroll
        for (int i = 0; i < 16; ++i) {
            if (MODE == 2) { const int koff = sub * 32 + (i & 3) + 8 * (i >> 2) + 4 * h; acc[i] = valid(koff) ? acc[i] : -INFINITY; }
            mx = fmaxf(mx, acc[i]);
        }
        {
            const auto sw = __builtin_amdgcn_permlane32_swap(__float_as_uint(mx), __float_as_uint(mx), false, false);
            mx = fmaxf(__uint_as_float(sw[0]), __uint_as_float(sw[1]));
        }
        const float cand = mx * c;
        const bool upd = cand > st.m + FA_THR;
        if (__ballot(upd)) {
            const float mn = upd ? cand : st.m, alpha = __builtin_amdgcn_exp2f(st.m - mn);
            st.m = mn; st.l *= alpha;
#pragma unroll
            for (int i = 0; i < 16; ++i) { st.o0[i] *= alpha; st.o1[i] *= alpha; }
        }
        const float nb = (MODE == 1 && !rowok) ? -INFINITY : -st.m;
        float ps0 = 0.f, ps1 = 0.f;
#pragma unroll
        for (int i = 0; i < 16; i += 2) {
            acc[i] = __builtin_amdgcn_exp2f(__builtin_fmaf(acc[i], c, nb));
            acc[i + 1] = __builtin_amdgcn_exp2f(__builtin_fmaf(acc[i + 1], c, nb));
            ps0 += acc[i]; ps1 += acc[i + 1];
        }
        st.l += ps0 + ps1;
#pragma unroll
        for (int s2 = 0; s2 < 2; ++s2) {
            const bf16x8 pk = cvt8((f32x8){acc[8 * s2], acc[8 * s2 + 1], acc[8 * s2 + 2], acc[8 * s2 + 3], acc[8 * s2 + 4], acc[8 * s2 + 5], acc[8 * s2 + 6], acc[8 * s2 + 7]});
            st.o0 = MFMA32(vf[2 * s2], pk, st.o0);
            st.o1 = MFMA32(vf[2 * s2 + 1], pk, st.o1);
        }
    }
}
DI void fa_issue(const bf16_t* gK, const bf16_t* gV, LAS unsigned char* buf, int tid) {
    __builtin_amdgcn_global_load_lds((const unsigned*)(gK + tid * 8), (LAS unsigned*)(buf + tid * 16), 16, 0, 0);
    __builtin_amdgcn_global_load_lds((const unsigned*)(gK + (tid + 256) * 8), (LAS unsigned*)(buf + (tid + 256) * 16), 16, 0, 0);
    __builtin_amdgcn_global_load_lds((const unsigned*)(gV + tid * 8), (LAS unsigned*)(buf + 8192 + tid * 16), 16, 0, 0);
    __builtin_amdgcn_global_load_lds((const unsigned*)(gV + (tid + 256) * 8), (LAS unsigned*)(buf + 8192 + (tid + 256) * 16), 16, 0, 0);
}
DI void fa_wait(int j, int n) {
    const int rem = n - 1 - j;
    if (rem >= 2) asm volatile("s_waitcnt vmcnt(8)" ::: "memory");
    else if (rem == 1) asm volatile("s_waitcnt vmcnt(4)" ::: "memory");
    else asm volatile("s_waitcnt vmcnt(0)" ::: "memory");
    __builtin_amdgcn_s_barrier();
    asm volatile("" ::: "memory");
}

constexpr int NSA_LDS_IMP = 65536;
constexpr int NSA_LDS_SCS = NSA_LDS_IMP + 8192;
constexpr int NSA_LDS_MSK = NSA_LDS_SCS + 1024;
DI void phase_nsa(const Params& P, unsigned char* smem) {
    unsigned char* ws = P.ws;
    const int tid = threadIdx.x, lane = tid & 63, wave = tid >> 6, r = lane & 31, h = lane >> 5;
    const float c = 0.125f * 1.4426950408889634f;
    LAS unsigned char* lds = (LAS unsigned char*)smem;
    float* impw = (float*)(smem + NSA_LDS_IMP) + wave * 512;
    float* scs = (float*)(smem + NSA_LDS_SCS) + wave * 64;
    unsigned long long* mskw = (unsigned long long*)(smem + NSA_LDS_MSK) + wave * 8;
    for (int it = blockIdx.x; it < 2048; it += gridDim.x) {
        const int qt = 127 - (it >> 4), bg = it & 15, b = bg >> 1, g = bg & 1, t0 = qt * 32, qblk = t0 >> 6;
        const int ql = r >> 2, z = r & 3, s = t0 + wave * 8 + ql, t = b * 4096 + s;
        const bf16_t* Qg = (const bf16_t*)(ws + XP_Q0) + (size_t)t * 512 + (g * 4 + z) * 64;
        bf16x8 qf[4];
#pragma unroll
        for (int ks = 0; ks < 4; ++ks) qf[ks] = *(const bf16x8*)(Qg + ks * 16 + 8 * h);
        const float* gt = (const float*)(ws + XP_GATES) + (size_t)t * 24 + (g * 4 + z) * 3;
        const float g_c = gt[0], g_s = gt[1], g_w = gt[2];
        const bf16_t* Kc = (const bf16_t*)(ws + WS_KCMP) + (size_t)bg * 256 * 64;
        const bf16_t* Vc = (const bf16_t*)(ws + WS_VCMP) + (size_t)bg * 256 * 64;
        const bf16_t* Ks = (const bf16_t*)(ws + XP_KC + 2 * KVSZ) + (size_t)bg * 4096 * 64;
        const bf16_t* Vs = (const bf16_t*)(ws + XP_KC + 3 * KVSZ) + (size_t)bg * 4096 * 64;
        const bf16_t* Kw = (const bf16_t*)(ws + XP_KC + 4 * KVSZ) + (size_t)bg * 4096 * 64;
        const bf16_t* Vw = (const bf16_t*)(ws + XP_KC + 5 * KVSZ) + (size_t)bg * 4096 * 64;
        const int nct = ((t0 >> 4) + 1 + 63) >> 6;
        const int w0 = (t0 - 255) < 0 ? 0 : (t0 - 255) >> 6;
        const int e1 = nct, e2 = 2 * nct, e3 = e2 + qblk + 1, e4 = e3 + (qblk - w0 + 1);
        const int nc = s >= 31 ? ((s - 31) >> 4) + 1 : 0;
        const int s_lo = t0 + wave * 8, s_hi = s_lo + 7, nc_min = s_lo >= 31 ? ((s_lo - 31) >> 4) + 1 : 0;
        for (int i = lane; i < 512; i += 64) impw[i] = 0.f;
        auto tile_ptrs = [&](int i, const bf16_t*& gk, const bf16_t*& gv) {
            if (i < e1) { gk = Kc + (size_t)i * 4096; gv = Vc + (size_t)i * 4096; }
            else if (i < e2) { gk = Kc + (size_t)(i - e1) * 4096; gv = Vc + (size_t)(i - e1) * 4096; }
            else if (i < e3) { gk = Ks + (size_t)(i - e2) * 4096; gv = Vs + (size_t)(i - e2) * 4096; }
            else { gk = Kw + (size_t)(w0 + i - e3) * 4096; gv = Vw + (size_t)(w0 + i - e3) * 4096; }
        };
        FA st; fa_init(st);
        f32x16 out0, out1;
#pragma unroll
        for (int i = 0; i < 16; ++i) { out0[i] = 0.f; out1[i] = 0.f; }
        float m_c = -1e30f, il_c = 0.f;
        unsigned long long mymask = 0ull;
        asm volatile("s_waitcnt vmcnt(0)" ::: "memory");
        __builtin_amdgcn_s_barrier();
#pragma unroll
        for (int i = 0; i < 3; ++i) if (i < e4) { const bf16_t *gk, *gv; tile_ptrs(i, gk, gv); fa_issue(gk, gv, lds + i * 16384, tid); }
        for (int i = 0; i < e4; ++i) {
            fa_wait(i, e4);
            if (i + 3 < e4) { const bf16_t *gk, *gv; tile_ptrs(i + 3, gk, gv); fa_issue(gk, gv, lds + ((i + 3) & 3) * 16384, tid); }
            const LAS bf16_t* cur = (const LAS bf16_t*)(lds + (i & 3) * 16384);
            if (i < e1) {
                const int nb = i * 64;
                { if (nb + 63 < nc_min) fa_tile<0>(st, qf, cur, cur + 4096, r, h, c, true, [=](int) { return true; }); else fa_tile<2>(st, qf, cur, cur + 4096, r, h, c, true, [=](int koff) { return nb + koff < nc; }); }
                if (i == e1 - 1) {
                    const float l = st.l + __shfl_xor(st.l, 32);
                    il_c = 1.f / fmaxf(l, 1e-30f); m_c = st.m;
                    const float f = g_c * il_c;
#pragma unroll
                    for (int k = 0; k < 16; ++k) { out0[k] = st.o0[k] * f; out1[k] = st.o1[k] * f; }
                    fa_init(st);
                }
            } else if (i < e2) {
                const int nb = (i - e1) * 64;
#pragma unroll
                for (int sub = 0; sub < 2; ++sub) {
                    f32x16 acc;
#pragma unroll
                    for (int k = 0; k < 16; ++k) acc[k] = 0.f;
#pragma unroll
                    for (int ks = 0; ks < 4; ++ks) acc = MFMA32(*(const LAS bf16x8*)(cur + ((sub * 4 + ks) * 32 + r) * 16 + 8 * h), qf[ks], acc);
#pragma unroll
                    for (int q4 = 0; q4 < 4; ++q4) {
                        float p[4];
#pragma unroll
                        for (int k = 0; k < 4; ++k) {
                            const int n = nb + sub * 32 + 8 * q4 + 4 * h + k;
                            p[k] = (n < nc) ? __builtin_amdgcn_exp2f(acc[4 * q4 + k] * c - m_c) * il_c : 0.f;
                        }
                        float a = (p[0] + p[1]) + (p[2] + 0.5f * p[3]), cn = 0.5f * p[3];
                        a += __shfl_xor(a, 1); a += __shfl_xor(a, 2);
                        cn += __shfl_xor(cn, 1); cn += __shfl_xor(cn, 2);
                        const int jb = ((nb + sub * 32) >> 2) + 2 * q4 + h;
                        if (z == 0) { atomicAdd(&impw[ql * 64 + jb], a); if (jb + 1 < 64) atomicAdd(&impw[ql * 64 + jb + 1], cn); }
                    }
                }
                if (i == e2 - 1) {
                    __builtin_amdgcn_wave_barrier();
#pragma unroll 1
                    for (int qq = 0; qq < 8; ++qq) {
                        const int j = lane;
                        const float imp = impw[qq * 64 + j];
                        const float score = (j > qblk) ? -1.f : ((j == 0 || j == qblk || j == qblk - 1) ? 1e3f : imp);
                        scs[j] = score;
                        __builtin_amdgcn_wave_barrier();
                        int rank = 0;
#pragma unroll 8
                        for (int jj = 0; jj < 64; ++jj) { const float o = scs[jj]; rank += (o > score || (o == score && jj < j)) ? 1 : 0; }
                        const unsigned long long mk = __ballot(rank < 8 && score >= 0.f);
                        if (lane == 0) mskw[qq] = mk;
                        __builtin_amdgcn_wave_barrier();
                    }
                    mymask = mskw[ql];
                }
            } else if (i < e3) {
                const int j = i - e2;
                const bool sel = (mymask >> j) & 1ull;
                if (__ballot(sel)) {
                    if (j < qblk) fa_tile<1>(st, qf, cur, cur + 4096, r, h, c, sel, [=](int) { return true; });
                    else { const int kb = j * 64; fa_tile<2>(st, qf, cur, cur + 4096, r, h, c, true, [=](int koff) { return sel && (kb + koff <= s); }); }
                }
                if (i == e3 - 1) {
                    const float l = st.l + __shfl_xor(st.l, 32);
                    const float f = g_s / fmaxf(l, 1e-30f);
#pragma unroll
                    for (int k = 0; k < 16; ++k) { out0[k] += st.o0[k] * f; out1[k] += st.o1[k] * f; }
                    fa_init(st);
                }
            } else {
                const int kb = (w0 + i - e3) * 64;
                { if (kb >= s_hi - 255 && kb + 63 <= s_lo) fa_tile<0>(st, qf, cur, cur + 4096, r, h, c, true, [=](int) { return true; }); else fa_tile<2>(st, qf, cur, cur + 4096, r, h, c, true, [=](int koff) { const int key = kb + koff; return key <= s && key >= s - 255; }); }
            }
        }
        {
            const float l = st.l + __shfl_xor(st.l, 32);
            const float f = g_w / fmaxf(l, 1e-30f);
#pragma unroll
            for (int k = 0; k < 16; ++k) { out0[k] += st.o0[k] * f; out1[k] += st.o1[k] * f; }
        }
        bf16_t* o = (bf16_t*)(ws + WS_MIX) + (size_t)t * 1024 + (g * 4 + z) * 64;
#pragma unroll
        for (int g4 = 0; g4 < 4; ++g4) {
            *(u32x2*)(o + 8 * g4 + 4 * h) = cvt4((f32x4){out0[4 * g4], out0[4 * g4 + 1], out0[4 * g4 + 2], out0[4 * g4 + 3]});
            *(u32x2*)(o + 32 + 8 * g4 + 4 * h) = cvt4((f32x4){out1[4 * g4], out1[4 * g4 + 1], out1[4 * g4 + 2], out1[4 * g4 + 3]});
        }
    }
}

DI void phase_glu(const Params& P, unsigned char* smem) {
    unsigned char* ws = P.ws;
    const bf16_t* G5 = (const bf16_t*)(ws + XP_G5);
    const float* gb = P.in[17];
    bool pre = false;
    for (int it = vblock(); it < (NT / 128) * 4; it += gridDim.x) {
        int mt, nt; tile_mn(it, 4, mt, nt);
        const int m0 = mt * 128;
        const bool hn = it + (int)gridDim.x < (NT / 128) * 4;
        int mtn = 0, ntn = 0; if (hn) tile_mn(it + gridDim.x, 4, mtn, ntn);
        auto nextrow = [=](int r) { return G5 + (size_t)(mtn * 128 + r) * 512; };
        auto rowptr = [=](int r) { return G5 + (size_t)(m0 + r) * 512; };
        auto epi = [=](f32x4 (&acc)[4][4], int wr, int wc, int ln) {
            const int fr = ln & 15, fq = ln >> 4;
#pragma unroll
            for (int m = 0; m < 4; ++m) {
                const int row = m0 + wr * 64 + m * 16 + fr;
#pragma unroll
                for (int n = 0; n < 4; ++n) {
                    const int col = nt * 128 + wc * 64 + n * 16 + fq * 4;
                    const f32x4 gv = bf4_to_f(*(const u32x2*)(G5 + (size_t)row * 512 + col)), bb = *(const f32x4*)(gb + col), z = acc[m][n] + bb;
                    *(u32x2*)((bf16_t*)(ws + WS_MIX) + (size_t)row * 1024 + 512 + col) = cvt4((f32x4){gv.x * sigmoidf_(z.x), gv.y * sigmoidf_(z.y), gv.z * sigmoidf_(z.z), gv.w * sigmoidf_(z.w)});
                }
            }
        };
        gemm128s(rowptr, (const bf16_t*)(ws + WS_WGLU) + (size_t)nt * 128 * 512, 512, 512, smem, epi, pre, hn, nextrow, (const bf16_t*)(ws + WS_WGLU) + (size_t)ntn * 128 * 512);
        pre = hn;
    }
}

template <bool RB>
DI void phase_outproj(const Params& P, unsigned char* smem, const float* xres, const bf16_t* xresb, size_t wt_off) {
    unsigned char* ws = P.ws;
    const bf16_t* A = (const bf16_t*)(ws + WS_MIX);
    bf16_t* preb = (bf16_t*)(ws + XP_PRE);
    bool pre = false;
    for (int it = vblock(); it < (NT / 128) * 8; it += gridDim.x) {
        int mt, nt; tile_mn(it, 8, mt, nt);
        const int m0 = mt * 128;
        const bool hn = it + (int)gridDim.x < (NT / 128) * 8;
        int mtn = 0, ntn = 0; if (hn) tile_mn(it + gridDim.x, 8, mtn, ntn);
        auto nextrow = [=](int r) { return A + (size_t)(mtn * 128 + r) * 1024; };
        auto rowptr = [=](int r) { return A + (size_t)(m0 + r) * 1024; };
        auto epi = [=](f32x4 (&acc)[4][4], int wr, int wc, int ln) {
            const int fr = ln & 15, fq = ln >> 4;
#pragma unroll
            for (int m = 0; m < 4; ++m) {
                const size_t base = (size_t)(m0 + wr * 64 + m * 16 + fr) * 1024 + nt * 128 + wc * 64 + fq * 4;
                f32x4 xr[4];
#pragma unroll
                for (int n = 0; n < 4; ++n) xr[n] = RB ? bf4_to_f(*(const u32x2*)(xresb + base + n * 16)) : *(const f32x4*)(xres + base + n * 16);
#pragma unroll
                for (int n = 0; n < 4; ++n) *(u32x2*)(preb + base + n * 16) = cvt4(xr[n] * ALPHA + acc[m][n]);
            }
        };
        gemm128s(rowptr, (const bf16_t*)(ws + wt_off) + (size_t)nt * 128 * 1024, 1024, 1024, smem, epi, pre, hn, nextrow, (const bf16_t*)(ws + wt_off) + (size_t)ntn * 128 * 1024);
        pre = hn;
    }
}

DI void ln_row(float (&v)[16], const float* __restrict__ g, const float* __restrict__ bta, int lane) {
    float s = 0.f;
#pragma unroll
    for (int i = 0; i < 16; ++i) s += v[i];
    const float mu = wave_sum(s) * (1.f / 1024.f);
    float q = 0.f;
#pragma unroll
    for (int i = 0; i < 16; ++i) { v[i] -= mu; q += v[i] * v[i]; }
    const float rstd = rsqrtf(wave_sum(q) * (1.f / 1024.f) + LN_EPS);
#pragma unroll
    for (int j = 0; j < 4; ++j) {
        const float4 gg = *(const float4*)(g + 4 * lane + 256 * j), bb = *(const float4*)(bta + 4 * lane + 256 * j);
        v[4 * j + 0] = v[4 * j + 0] * rstd * gg.x + bb.x; v[4 * j + 1] = v[4 * j + 1] * rstd * gg.y + bb.y;
        v[4 * j + 2] = v[4 * j + 2] * rstd * gg.z + bb.z; v[4 * j + 3] = v[4 * j + 3] * rstd * gg.w + bb.w;
    }
}

DI void phase_ln_router(const Params& P, int layer) {
    unsigned char* ws = P.ws;
    const int lane = threadIdx.x & 63, wave = threadIdx.x >> 6;
    const float* g = P.in[21] + layer * 1024; const float* bta = P.in[22] + layer * 1024;
    const float* wc = (const float*)(ws + WS_RTRW) + (size_t)layer * 36864; const float* bc = P.in[26] + layer * 4;
    const float* wf = wc + 4096; const float* bfn = P.in[28] + layer * 32;
    int* cnt = (int*)(ws + WS_CTL) + layer * 2048;
    int* list = (int*)(ws + WS_LIST2);
    float* wgt = (float*)(ws + WS_WGT);
    bf16_t* xb = (bf16_t*)(ws + WS_ACTB);
    for (int task = blockIdx.x * 4 + wave; task < NT / 16; task += gridDim.x * 4) {
        int my_e = 0; float my_w = 0.f;
        f32x4 wcr[16];
#pragma unroll
        for (int q = 0; q < 16; ++q) wcr[q] = *(const f32x4*)(wc + (q * 64 + lane) * 4);
        const bf16_t* pre = (const bf16_t*)(ws + XP_PRE);
        u32x2 nxb[4];
#pragma unroll
        for (int j = 0; j < 4; ++j) nxb[j] = __builtin_nontemporal_load((const u32x2*)(pre + (size_t)(task * 16) * 1024 + 4 * lane + 256 * j));
#pragma unroll 1
        for (int i = 0; i < 16; ++i) {
            const int t = task * 16 + i;
            float v[16];
#pragma unroll
            for (int j = 0; j < 4; ++j) { const f32x4 nx = bf4_to_f(nxb[j]); v[4 * j] = nx.x; v[4 * j + 1] = nx.y; v[4 * j + 2] = nx.z; v[4 * j + 3] = nx.w; }
            if (i + 1 < 16) {
#pragma unroll
                for (int j = 0; j < 4; ++j) nxb[j] = __builtin_nontemporal_load((const u32x2*)(pre + (size_t)(t + 1) * 1024 + 4 * lane + 256 * j));
            }
            ln_row(v, g, bta, lane);
#pragma unroll
            for (int j = 0; j < 4; ++j) {
                *(u32x2*)(xb + (size_t)t * 1024 + 4 * lane + 256 * j) = cvt4((f32x4){v[4 * j], v[4 * j + 1], v[4 * j + 2], v[4 * j + 3]});
            }
            float lc[4] = {0.f, 0.f, 0.f, 0.f};
#pragma unroll
            for (int j = 0; j < 4; ++j)
#pragma unroll
                for (int k = 0; k < 4; ++k) {
                    const f32x4 w = wcr[j * 4 + k];
                    const float x = v[4 * j + k];
                    lc[0] += x * w.x; lc[1] += x * w.y; lc[2] += x * w.z; lc[3] += x * w.w;
                }
#pragma unroll
            for (int c = 0; c < 4; ++c) lc[c] = wave_sum(lc[c]) + bc[c];
            int gi = 0; float lm = lc[0];
#pragma unroll
            for (int c = 1; c < 4; ++c) if (lc[c] > lm) { lm = lc[c]; gi = c; }
            gi = __builtin_amdgcn_readfirstlane(gi);
            float den = 0.f;
#pragma unroll
            for (int c = 0; c < 4; ++c) den += expf(lc[c] - lm);
            const float gv = 1.f / den;
            float lf[8] = {0.f, 0.f, 0.f, 0.f, 0.f, 0.f, 0.f, 0.f};
            const float* wfg = wf + (size_t)gi * 8192;
#pragma unroll
            for (int j = 0; j < 4; ++j)
#pragma unroll
                for (int k = 0; k < 4; ++k) {
                    const f32x4 w0 = *(const f32x4*)(wfg + (((j * 4 + k) * 2 + 0) * 64 + lane) * 4), w1 = *(const f32x4*)(wfg + (((j * 4 + k) * 2 + 1) * 64 + lane) * 4);
                    const float x = v[4 * j + k];
                    lf[0] += x * w0.x; lf[1] += x * w0.y; lf[2] += x * w0.z; lf[3] += x * w0.w;
                    lf[4] += x * w1.x; lf[5] += x * w1.y; lf[6] += x * w1.z; lf[7] += x * w1.w;
                }
#pragma unroll
            for (int e = 0; e < 8; ++e) lf[e] = wave_sum(lf[e]) + bfn[gi * 8 + e];
            int e1 = 0; float l1 = lf[0];
#pragma unroll
            for (int e = 1; e < 8; ++e) if (lf[e] > l1) { l1 = lf[e]; e1 = e; }
            int e2 = 0; float l2 = -INFINITY;
#pragma unroll
            for (int e = 0; e < 8; ++e) if (e != e1 && lf[e] > l2) { l2 = lf[e]; e2 = e; }
            const float r = expf(l2 - l1);
            if (lane == i) { my_e = gi * 8 + e1; my_w = gv / (1.f + r); }
            if (lane == 16 + i) { my_e = gi * 8 + e2; my_w = gv * r / (1.f + r); }
        }
        if (lane < 32) {
            const int t = task * 16 + (lane & 15), k = lane >> 4, slot = (task & 63) * 32 + my_e;
            const int pos = atomicAdd(&cnt[slot], 1);
            list[(slot << 10) + pos] = t * 2 + k;
            wgt[t * 2 + k] = my_w;
        }
    }
}

constexpr int MOE_LDS_TAB = 65536;
constexpr int MOE_LDS_ROW = 65536 + 8448;
DI void moe_tables(const int* cnt, unsigned char* smem) {
    int* tab = (int*)(smem + MOE_LDS_TAB);
    if (threadIdx.x < 32) { const int e = threadIdx.x; int run = 0; for (int s = 0; s < 64; ++s) { tab[e * 65 + s] = run; run += cnt[s * 32 + e]; } tab[e * 65 + 64] = run; }
    __syncthreads();
}
DI bool moe_tile(const int* tab, int tile, int& e, int& mt, int& off, int& ce) {
    int acc_t = 0, acc_r = 0;
    for (int i = 0; i < 32; ++i) {
        const int c = tab[i * 65 + 64], nt = (c + 127) >> 7;
        if (tile < acc_t + nt) { e = i; mt = tile - acc_t; off = acc_r; ce = c; return true; }
        acc_t += nt; acc_r += c;
    }
    return false;
}
DI int moe_ntiles(const int* tab) { int a = 0; for (int i = 0; i < 32; ++i) a += (tab[i * 65 + 64] + 127) >> 7; return a; }
DI void moe_rows(const int* tab, const int* list, int e, int mt, int ce, int* rowidx) {
    if (threadIdx.x < 128) {
        const int pos = mt * 128 + threadIdx.x;
        int idx = -1;
        if (pos < ce) {
            int lo = 0, hi = 64;
            while (hi - lo > 1) { const int mid = (lo + hi) >> 1; if (tab[e * 65 + mid] <= pos) lo = mid; else hi = mid; }
            idx = list[((lo * 32 + e) << 10) + pos - tab[e * 65 + lo]];
        }
        rowidx[threadIdx.x] = idx;
    }
    __syncthreads();
}

DI void phase_moe_gu(const Params& P, unsigned char* smem, int layer) {
    unsigned char* ws = P.ws;
    const int* cnt = (const int*)(ws + WS_CTL) + layer * 2048;
    const int* list = (const int*)(ws + WS_LIST2);
    const float* wgt = (const float*)(ws + WS_WGT);
    const bf16_t* xb = (const bf16_t*)(ws + WS_ACTB);
    bf16_t* H = (bf16_t*)(ws + XP_H);
    const int* tab = (const int*)(smem + MOE_LDS_TAB);
    int* rowidx = (int*)(smem + MOE_LDS_ROW);
    moe_tables(cnt, smem);
    const int ntile = moe_ntiles(tab);
    for (int it = vblock(); it < ntile * 2; it += gridDim.x) {
        int e, mt, off, ce; moe_tile(tab, it >> 1, e, mt, off, ce);
        const int nt = it & 1;
        moe_rows(tab, list, e, mt, ce, rowidx);
        auto rowptr = [=](int r) { int idx = rowidx[r]; idx = idx < 0 ? rowidx[0] : idx; return xb + (size_t)(idx >> 1) * 1024; };
        auto epi = [=](f32x4 (&acc)[4][4], int wr, int wc, int ln) {
            const int fr = ln & 15, fq = ln >> 4;
#pragma unroll
            for (int m = 0; m < 4; ++m) {
                const int rl = wr * 64 + m * 16 + fr, idx = rowidx[rl];
                if (idx >= 0) {
                    const float w = wgt[idx];
#pragma unroll
                    for (int n = 0; n < 2; ++n) {
                        const f32x4 gte = acc[m][n], up = acc[m][n + 2];
                        *(u32x2*)(H + (size_t)(off + mt * 128 + rl) * 128 + (nt * 2 + wc) * 32 + n * 16 + fq * 4) =
                            cvt4((f32x4){gte.x * sigmoidf_(gte.x) * up.x * w, gte.y * sigmoidf_(gte.y) * up.y * w, gte.z * sigmoidf_(gte.z) * up.z * w, gte.w * sigmoidf_(gte.w) * up.w * w});
                    }
                }
            }
        };
        gemm128(rowptr, (const bf16_t*)(ws + WS_WGU) + ((size_t)(layer * 32 + e) * 256 + nt * 128) * 1024, 1024, 1024, smem, epi);
        __syncthreads();
    }
}
DI void phase_moe_down(const Params& P, unsigned char* smem, int layer) {
    unsigned char* ws = P.ws;
    const int* cnt = (const int*)(ws + WS_CTL) + layer * 2048;
    const int* list = (const int*)(ws + WS_LIST2);
    const bf16_t* H = (const bf16_t*)(ws + XP_H);
    bf16_t* YB = (bf16_t*)(ws + XP_YB);
    const int* tab = (const int*)(smem + MOE_LDS_TAB);
    int* rowidx = (int*)(smem + MOE_LDS_ROW);
    moe_tables(cnt, smem);
    const int ntile = moe_ntiles(tab);
    for (int it = vblock(); it < ntile * 8; it += gridDim.x) {
        int e, mt, off, ce; moe_tile(tab, it >> 3, e, mt, off, ce);
        const int nt = it & 7;
        moe_rows(tab, list, e, mt, ce, rowidx);
        auto rowptr = [=](int r) { int pos = mt * 128 + r; pos = pos < ce ? pos : 0; return H + (size_t)(off + pos) * 128; };
        auto epi = [=](f32x4 (&acc)[4][4], int wr, int wc, int ln) {
            const int fr = ln & 15, fq = ln >> 4;
#pragma unroll
            for (int m = 0; m < 4; ++m) {
                const int idx = rowidx[wr * 64 + m * 16 + fr];
                if (idx >= 0) {
                    bf16_t* dst = YB + (size_t)idx * 1024 + nt * 128 + wc * 64 + fq * 4;
#pragma unroll
                    for (int n = 0; n < 4; ++n) *(u32x2*)(dst + n * 16) = cvt4(acc[m][n]);
                }
            }
        };
        gemm128(rowptr, (const bf16_t*)(ws + WS_WDN) + ((size_t)(layer * 32 + e) * 1024 + nt * 128) * 128, 128, 128, smem, epi);
        __syncthreads();
    }
}
DI void phase_ln_ffn(const Params& P, int layer) {
    unsigned char* ws = P.ws;
    const int lane = threadIdx.x & 63, wave = threadIdx.x >> 6;
    const float* g = P.in[23] + layer * 1024; const float* bta = P.in[24] + layer * 1024;
    const bf16_t* YB = (const bf16_t*)(ws + XP_YB);
    bf16_t* xb = (bf16_t*)(ws + WS_ACTB);
    for (int task = blockIdx.x * 4 + wave; task < NT / 16; task += gridDim.x * 4) {
        u32x2 nxm[4], ny0[4], ny1[4];
        auto fetch = [&](int t) {
#pragma unroll
            for (int j = 0; j < 4; ++j) {
                nxm[j] = __builtin_nontemporal_load((const u32x2*)(xb + (size_t)t * 1024 + 4 * lane + 256 * j));
                ny0[j] = __builtin_nontemporal_load((const u32x2*)(YB + (size_t)(2 * t) * 1024 + 4 * lane + 256 * j));
                ny1[j] = __builtin_nontemporal_load((const u32x2*)(YB + (size_t)(2 * t + 1) * 1024 + 4 * lane + 256 * j));
            }
        };
        fetch(task * 16);
#pragma unroll 1
        for (int i = 0; i < 16; ++i) {
            const int t = task * 16 + i;
            float v[16];
#pragma unroll
            for (int j = 0; j < 4; ++j) {
                const f32x4 a = bf4_to_f(nxm[j]), y0 = bf4_to_f(ny0[j]), y1 = bf4_to_f(ny1[j]);
                v[4 * j + 0] = ALPHA * a.x + (y0.x + y1.x); v[4 * j + 1] = ALPHA * a.y + (y0.y + y1.y);
                v[4 * j + 2] = ALPHA * a.z + (y0.z + y1.z); v[4 * j + 3] = ALPHA * a.w + (y0.w + y1.w);
            }
            if (i + 1 < 16) fetch(t + 1);
            ln_row(v, g, bta, lane);
            float* row = P.out + (size_t)t * 1024;
#pragma unroll
            for (int j = 0; j < 4; ++j) {
                if (layer == 0) *(u32x2*)((bf16_t*)P.out + (size_t)t * 1024 + 4 * lane + 256 * j) = cvt4((f32x4){v[4 * j], v[4 * j + 1], v[4 * j + 2], v[4 * j + 3]});
                else *(f32x4*)(row + 4 * lane + 256 * j) = (f32x4){v[4 * j], v[4 * j + 1], v[4 * j + 2], v[4 * j + 3]};
            }
        }
    }
}

DI void phase_inproj1(const Params& P, unsigned char* smem) {
    unsigned char* ws = P.ws;
    const bf16_t* A = (const bf16_t*)P.out;
    const float* cosT = (const float*)(ws + WS_ROPE);
    const float* sinT = cosT + 4096 * 32;
    bool pre = false;
    for (int it = vblock(); it < (NT / 128) * 24; it += gridDim.x) {
        int mt, nt; tile_mn(it, 24, mt, nt);
        const int m0 = mt * 128;
        auto rowptr = [=](int r) { return A + (size_t)(m0 + r) * 1024; };
        const bf16_t* Bt = (const bf16_t*)(ws + WS_WIN1) + (size_t)nt * 128 * 1024;
        const bool hn = it + (int)gridDim.x < (NT / 128) * 24;
        int mtn = 0, ntn = 0; if (hn) tile_mn(it + gridDim.x, 24, mtn, ntn);
        auto nextrow = [=](int r) { return A + (size_t)(mtn * 128 + r) * 1024; };
        const bf16_t* nBt = (const bf16_t*)(ws + WS_WIN1) + (size_t)ntn * 128 * 1024;
        if (nt >= 16) {
            auto epi = [=](f32x4 (&acc)[4][4], int wr, int wc, int lane) {
                const int head = (nt * 2 + wc) & 15, fr = lane & 15, fq = lane >> 4;
#pragma unroll
                for (int m = 0; m < 4; ++m) {
                    const int t = m0 + wr * 64 + m * 16 + fq * 4, s = t & 4095, b = t >> 12;
                    bf16_t* base = (bf16_t*)(ws + XP_Q1 + (size_t)2 * 64 * MiB) + (size_t)(b * 16 + head) * 4096 * 64;
#pragma unroll
                    for (int n = 0; n < 4; ++n) *(u32x2*)(base + vp_off(s, n * 16 + fr)) = cvt4(acc[m][n]);
                }
            };
            gemm128s<false>(rowptr, Bt, 1024, 1024, smem, epi, pre, hn, nextrow, nBt);
            pre = hn;
            continue;
        }
        auto epi = [=](f32x4 (&acc)[4][4], int wr, int wc, int lane) {
            const int u64 = nt * 2 + wc, kind = u64 >> 4, head = u64 & 15, fr = lane & 15, fq = lane >> 4;
            f32x4 cs[2][2];
#pragma unroll
            for (int n2 = 0; n2 < 2; ++n2) { cs[n2][0] = (f32x4){0.f, 0.f, 0.f, 0.f}; cs[n2][1] = cs[n2][0]; }
#pragma unroll
            for (int m = 0; m < 4; ++m) {
                const int t = m0 + wr * 64 + m * 16 + fr, s = t & 4095, b = t >> 12;
                bf16_t* base = (bf16_t*)(ws + XP_Q1 + (size_t)kind * 64 * MiB) + (size_t)(b * 16 + head) * 4096 * 64;
#pragma unroll
                for (int n2 = 0; n2 < 2; ++n2) {
                    const int i = n2 * 16 + fq * 4;
                    const f32x4 c = *(const f32x4*)(cosT + s * 32 + i), sn = *(const f32x4*)(sinT + s * 32 + i);
                    const f32x4 x1 = acc[m][2 * n2], x2 = acc[m][2 * n2 + 1];
                    const f32x4 r1 = x1 * c - x2 * sn, r2 = x1 * sn + x2 * c;
                    const u32x2 o1 = cvt4(r1), o2 = cvt4(r2);
                    if (kind == 0) { *(u32x2*)(base + (size_t)s * 64 + i) = o1; *(u32x2*)(base + (size_t)s * 64 + i + 32) = o2; }
                    else { *(u32x2*)(base + kp_off(s, i)) = o1; *(u32x2*)(base + kp_off(s, i + 32)) = o2; cs[n2][0] += r1; cs[n2][1] += r2; }
                }
            }
            if (kind == 1) {
                const int t0 = m0 + wr * 64, bh = (t0 >> 12) * 16 + head, seg = (t0 & 4095) >> 6;
                float* dst = (float*)(ws + WS_KMP) + ((size_t)bh * 64 + seg) * 64;
#pragma unroll
                for (int n2 = 0; n2 < 2; ++n2)
#pragma unroll
                    for (int hf = 0; hf < 2; ++hf) {
                        f32x4 v = cs[n2][hf];
#pragma unroll
                        for (int k = 0; k < 4; ++k) { float x = v[k]; x += dpp_f<0xB1>(x); x += dpp_f<0x4E>(x); x += dpp_f<0x141>(x); x += dpp_f<0x140>(x); v[k] = x; }
                        if (fr == 0) *(f32x4*)(dst + n2 * 16 + fq * 4 + hf * 32) = v;
                    }
            }
        };
        gemm128s(rowptr, Bt, 1024, 1024, smem, epi, pre, hn, nextrow, nBt);
        pre = hn;
    }
}
DI void moba_kmeans_slab(const Params& P, bf16_t* kml, int bh, int tid) {
    const float* kp = (const float*)(P.ws + WS_KMP) + (size_t)bh * 64 * 64;
    for (int e = tid; e < 2048; e += 256) {
        const int d = e & 63, n = e >> 6;
        float a = 0.f;
        if (n < 16) a = ((kp[(4 * n) * 64 + d] + kp[(4 * n + 1) * 64 + d]) + (kp[(4 * n + 2) * 64 + d] + kp[(4 * n + 3) * 64 + d])) * (1.f / 256.f);
        kml[((d >> 4) * 32 + n) * 16 + (d & 15)] = f2bf(a);
    }
}
DI unsigned moba_gate_rows(const bf16_t* km, const bf16x8 (&qf)[4], int own, int r, int h) {
    f32x16 g;
#pragma unroll
    for (int i = 0; i < 16; ++i) g[i] = 0.f;
#pragma unroll
    for (int ks = 0; ks < 4; ++ks) g = MFMA32(*(const bf16x8*)(km + (ks * 32 + r) * 16 + 8 * h), qf[ks], g);
    float mine[8], oth[8];
#pragma unroll
    for (int i = 0; i < 8; ++i) { const int n = (i & 3) + 8 * (i >> 2) + 4 * h; mine[i] = n < own ? g[i] : -INFINITY; oth[i] = __shfl_xor(mine[i], 32); }
    unsigned selmask = 0;
#pragma unroll
    for (int i = 0; i < 8; ++i) {
        const int n = (i & 3) + 8 * (i >> 2) + 4 * h;
        int rank = 0;
#pragma unroll
        for (int k = 0; k < 8; ++k) {
            const int nk = (k & 3) + 8 * (k >> 2) + 4 * h, no = (k & 3) + 8 * (k >> 2) + 4 * (1 - h);
            rank += (mine[k] > mine[i] || (mine[k] == mine[i] && nk < n)) ? 1 : 0;
            rank += (oth[k] > mine[i] || (oth[k] == mine[i] && no < n)) ? 1 : 0;
        }
        if (n < own && rank < 3) selmask |= 1u << n;
    }
    return selmask | __shfl_xor(selmask, 32);
}
DI void phase_moba_gate(const Params& P, unsigned char* smem) {
    unsigned char* ws = P.ws;
    const int tid = threadIdx.x, lane = tid & 63, wave = tid >> 6, r = lane & 31, h = lane >> 5;
    bf16_t* kml = (bf16_t*)smem;
    unsigned short* smask = (unsigned short*)(smem + 4096);
    unsigned short* selm = (unsigned short*)(ws + WS_SELM);
    unsigned short* mcnt = (unsigned short*)(ws + WS_MCNT);
    unsigned char* mlist = ws + WS_MLIST;
    int km_bh = -1;
    for (int it = blockIdx.x; it < 2048; it += gridDim.x) {
        const int bh = it & 127, qb = it >> 7;
        if (bh != km_bh) { km_bh = bh; __syncthreads(); moba_kmeans_slab(P, kml, bh, tid); }
        __syncthreads();
#pragma unroll 1
        for (int g2 = 0; g2 < 2; ++g2) {
            const int rl = wave * 64 + g2 * 32 + r, q = qb * 256 + rl;
            const bf16_t* Qg = (const bf16_t*)(ws + XP_Q1) + ((size_t)bh * 4096 + q) * 64;
            bf16x8 qf[4];
#pragma unroll
            for (int ks = 0; ks < 4; ++ks) qf[ks] = *(const bf16x8*)(Qg + ks * 16 + 8 * h);
            const unsigned sm = qb > 0 ? moba_gate_rows(kml, qf, qb, r, h) : 0u;
            if (h == 0) { selm[(size_t)bh * 4096 + q] = (unsigned short)sm; smask[rl] = (unsigned short)sm; }
        }
        __syncthreads();
        for (int n = wave; n < qb; n += 4) {
            unsigned char* lp = mlist + ((size_t)(bh * 16 + qb) * 16 + n) * 256;
            int base = 0;
#pragma unroll
            for (int c4 = 0; c4 < 4; ++c4) {
                const int row = c4 * 64 + lane;
                const bool bit = (smask[row] >> n) & 1;
                const unsigned long long bal = __ballot(bit);
                if (bit) lp[base + __builtin_popcountll(bal & ((1ull << lane) - 1ull))] = (unsigned char)row;
                base += __builtin_popcountll(bal);
            }
            if (lane == 0) mcnt[(bh * 16 + qb) * 16 + n] = (unsigned short)base;
        }
    }
}
DI bf16_t* moba_po(const Params& P, int slot) { return (bf16_t*)(P.ws + (slot == 0 ? WS_MIX : slot == 1 ? WS_ACTB : WS_PO2)); }
DI void phase_moba_kv(const Params& P, unsigned char* smem) {
    unsigned char* ws = P.ws;
    const int tid = threadIdx.x, lane = tid & 63, wave = tid >> 6, r = lane & 31, h = lane >> 5;
    const float c = 0.125f * 1.4426950408889634f;
    LAS unsigned char* lds = (LAS unsigned char*)smem;
    const unsigned short* selm = (const unsigned short*)(ws + WS_SELM);
    const unsigned short* mcnt = (const unsigned short*)(ws + WS_MCNT);
    const unsigned char* mlist = ws + WS_MLIST;
    float* pml = (float*)(ws + WS_PML);
    const bool bal = (gridDim.x == 512);
    const int nit = bal ? ((blockIdx.x >> 7) == 3 ? 3 : 4) : (1920 + (int)gridDim.x - 1 - (int)blockIdx.x) / (int)gridDim.x;
    for (int iti = 0; iti < nit; ++iti) {
        int bh, n;
        if (bal) { const int gq = blockIdx.x >> 7; bh = blockIdx.x & 127; const int tab = gq == 0 ? 0x0DA90 : gq == 1 ? 0x0CB61 : gq == 2 ? 0x0E852 : 0x00743; n = (tab >> (4 * iti)) & 15; }
        else { const int it = blockIdx.x + iti * gridDim.x; n = it >> 7; bh = it & 127; }
        const bf16_t* Kg = (const bf16_t*)(ws + XP_Q1 + 64 * MiB) + (size_t)bh * 4096 * 64 + (size_t)n * 4 * 4096;
        const bf16_t* Vg = (const bf16_t*)(ws + XP_Q1 + 128 * MiB) + (size_t)bh * 4096 * 64 + (size_t)n * 4 * 4096;
        asm volatile("s_waitcnt vmcnt(0)" ::: "memory");
        __builtin_amdgcn_s_barrier();
#pragma unroll
        for (int j = 0; j < 4; ++j) fa_issue(Kg + (size_t)j * 4096, Vg + (size_t)j * 4096, lds + j * 16384, tid);
        const int cntv = (lane < 16 && lane > n) ? (int)mcnt[(bh * 16 + lane) * 16 + n] : 0;
        asm volatile("s_waitcnt vmcnt(0)" ::: "memory");
        __builtin_amdgcn_s_barrier();
        asm volatile("" ::: "memory");
        int prefv = 0, total = 0;
#pragma unroll 1
        for (int qb = 0; qb < 16; ++qb) { if (lane == qb) prefv = total; total += __builtin_amdgcn_readlane(cntv, qb); }
#pragma unroll 1
        for (int v0 = wave * 32; v0 < total; v0 += 128) {
            const int v = v0 + r;
            const bool valid = v < total;
            const int vv = valid ? v : v0;
            int qb = n + 1;
#pragma unroll 1
            for (int l = n + 2; l < 16; ++l) if (vv >= __builtin_amdgcn_readlane(prefv, l)) qb = l;
            const int idx = vv - __shfl(prefv, qb);
            const int q = qb * 256 + (int)mlist[((size_t)(bh * 16 + qb) * 16 + n) * 256 + idx];
            const bf16_t* Qg = (const bf16_t*)(ws + XP_Q1) + ((size_t)bh * 4096 + q) * 64;
            bf16x8 qf[4];
#pragma unroll
            for (int ks = 0; ks < 4; ++ks) qf[ks] = *(const bf16x8*)(Qg + ks * 16 + 8 * h);
            FA st; fa_init(st);
#pragma unroll 1
            for (int j = 0; j < 4; ++j) {
                const LAS bf16_t* cur = (const LAS bf16_t*)(lds + j * 16384);
                fa_tile<0>(st, qf, cur, cur + 4096, r, h, c, true, [=](int) { return true; });
            }
            const float l = st.l + __shfl_xor(st.l, 32);
            const float inv = 1.f / fmaxf(l, 1e-30f);
            if (valid) {
                const int slot = __builtin_popcount((unsigned)selm[(size_t)bh * 4096 + q] & ((1u << n) - 1u));
                bf16_t* o = moba_po(P, slot) + ((size_t)(bh >> 4) * 4096 + q) * 1024 + (bh & 15) * 64;
#pragma unroll
                for (int g4 = 0; g4 < 4; ++g4) {
                    *(u32x2*)(o + 8 * g4 + 4 * h) = cvt4((f32x4){st.o0[4 * g4] * inv, st.o0[4 * g4 + 1] * inv, st.o0[4 * g4 + 2] * inv, st.o0[4 * g4 + 3] * inv});
                    *(u32x2*)(o + 32 + 8 * g4 + 4 * h) = cvt4((f32x4){st.o1[4 * g4] * inv, st.o1[4 * g4 + 1] * inv, st.o1[4 * g4 + 2] * inv, st.o1[4 * g4 + 3] * inv});
                }
                if (h == 0) { float* pm = pml + (((size_t)bh * 4096 + q) * 3 + slot) * 2; pm[0] = st.m; pm[1] = l; }
            }
        }
    }
}
DI void phase_moba_own(const Params& P, unsigned char* smem) {
    unsigned char* ws = P.ws;
    const int tid = threadIdx.x, lane = tid & 63, wave = tid >> 6, r = lane & 31, h = lane >> 5;
    const float c = 0.125f * 1.4426950408889634f;
    LAS unsigned char* lds = (LAS unsigned char*)smem;
    const unsigned short* selm = (const unsigned short*)(ws + WS_SELM);
    const float* pml = (const float*)(ws + WS_PML);
    for (int it = blockIdx.x; it < 2048; it += gridDim.x) {
        const int own = 15 - (it >> 7), bh = it & 127, t0 = own * 256;
        const bf16_t* Kg = (const bf16_t*)(ws + XP_Q1 + 64 * MiB) + (size_t)bh * 4096 * 64 + (size_t)own * 4 * 4096;
        const bf16_t* Vg = (const bf16_t*)(ws + XP_Q1 + 128 * MiB) + (size_t)bh * 4096 * 64 + (size_t)own * 4 * 4096;
        asm volatile("s_waitcnt vmcnt(0)" ::: "memory");
        __builtin_amdgcn_s_barrier();
#pragma unroll
        for (int j = 0; j < 4; ++j) fa_issue(Kg + (size_t)j * 4096, Vg + (size_t)j * 4096, lds + j * 16384, tid);
        asm volatile("s_waitcnt vmcnt(0)" ::: "memory");
        __builtin_amdgcn_s_barrier();
        asm volatile("" ::: "memory");
#pragma unroll 1
        for (int g2 = 0; g2 < 2; ++g2) {
            const int row0 = t0 + g2 * 128 + wave * 32, q = row0 + r;
            const bf16_t* Qg = (const bf16_t*)(ws + XP_Q1) + ((size_t)bh * 4096 + q) * 64;
            bf16x8 qf[4];
#pragma unroll
            for (int ks = 0; ks < 4; ++ks) qf[ks] = *(const bf16x8*)(Qg + ks * 16 + 8 * h);
            const int nsel = __builtin_popcount((unsigned)selm[(size_t)bh * 4096 + q]);
            const size_t orow = ((size_t)(bh >> 4) * 4096 + q) * 1024 + (bh & 15) * 64;
            const float* pm = pml + ((size_t)bh * 4096 + q) * 6;
            float mi[3], li[3];
            u32x2 pa[3][8];
#pragma unroll
            for (int i = 0; i < 3; ++i) {
                mi[i] = i < nsel ? pm[2 * i] : -INFINITY; li[i] = i < nsel ? pm[2 * i + 1] : 0.f;
                const bf16_t* po = moba_po(P, i) + orow;
#pragma unroll
                for (int g4 = 0; g4 < 4; ++g4) {
                    pa[i][2 * g4] = i < nsel ? *(const u32x2*)(po + 8 * g4 + 4 * h) : (u32x2){0u, 0u};
                    pa[i][2 * g4 + 1] = i < nsel ? *(const u32x2*)(po + 32 + 8 * g4 + 4 * h) : (u32x2){0u, 0u};
                }
            }
            FA st; fa_init(st);
            const int jmax = (row0 + 31 - t0) >> 6;
#pragma unroll 1
            for (int j = 0; j <= jmax; ++j) {
                const LAS bf16_t* cur = (const LAS bf16_t*)(lds + j * 16384);
                const int kbase = t0 + j * 64;
                if (kbase + 63 <= row0) fa_tile<0>(st, qf, cur, cur + 4096, r, h, c, true, [=](int) { return true; });
                else fa_tile<2>(st, qf, cur, cur + 4096, r, h, c, true, [=](int koff) { return kbase + koff <= q; });
            }
            const float l_own = st.l + __shfl_xor(st.l, 32);
            const float M = fmaxf(fmaxf(st.m, mi[0]), fmaxf(mi[1], mi[2]));
            const float wo = __builtin_amdgcn_exp2f(st.m - M);
            float L = l_own * wo;
#pragma unroll
            for (int k = 0; k < 16; ++k) { st.o0[k] *= wo; st.o1[k] *= wo; }
#pragma unroll
            for (int i = 0; i < 3; ++i) {
                const float wi = li[i] * __builtin_amdgcn_exp2f(mi[i] - M);
                L += wi;
#pragma unroll
                for (int g4 = 0; g4 < 4; ++g4) {
                    const f32x4 a = bf4_to_f(pa[i][2 * g4]), b2 = bf4_to_f(pa[i][2 * g4 + 1]);
                    st.o0[4 * g4] += wi * a.x; st.o0[4 * g4 + 1] += wi * a.y; st.o0[4 * g4 + 2] += wi * a.z; st.o0[4 * g4 + 3] += wi * a.w;
                    st.o1[4 * g4] += wi * b2.x; st.o1[4 * g4 + 1] += wi * b2.y; st.o1[4 * g4 + 2] += wi * b2.z; st.o1[4 * g4 + 3] += wi * b2.w;
                }
            }
            const float inv = 1.f / fmaxf(L, 1e-30f);
            bf16_t* o = (bf16_t*)(ws + WS_MIX) + orow;
#pragma unroll
            for (int g4 = 0; g4 < 4; ++g4) {
                *(u32x2*)(o + 8 * g4 + 4 * h) = cvt4((f32x4){st.o0[4 * g4] * inv, st.o0[4 * g4 + 1] * inv, st.o0[4 * g4 + 2] * inv, st.o0[4 * g4 + 3] * inv});
                *(u32x2*)(o + 32 + 8 * g4 + 4 * h) = cvt4((f32x4){st.o1[4 * g4] * inv, st.o1[4 * g4 + 1] * inv, st.o1[4 * g4 + 2] * inv, st.o1[4 * g4 + 3] * inv});
            }
        }
    }
}

constexpr int SMEM_BYTES = 65536 + 8192 + 1024 + 512;
static_assert(SMEM_BYTES >= 128 * 129 * 4 && SMEM_BYTES >= MOE_LDS_ROW + 512 && SMEM_BYTES >= NSA_LDS_MSK + 256, "LDS map");
constexpr int SMEM_OLD = 128 * 129 * 4;
typedef __attribute__((address_space(1))) unsigned gu32;
#define XB_TMO      128
#define XB_XCNT(j)  (256  + 64 * (j))
#define XB_XSUB(j)  (1280 + 64 * (j))
#define XB_XGEN(j)  (2304 + 64 * (j))
#define XB_TOP      3328
#define XB_TOPGEN   3392
#define XCD_BAR_WORDS 3456
#define XB_SPIN_CAP (1u << 18)

__device__ __forceinline__ unsigned xb_ld(unsigned* p)              { return __hip_atomic_load(p, __ATOMIC_RELAXED, __HIP_MEMORY_SCOPE_AGENT); }
__device__ __forceinline__ unsigned xb_add(unsigned* p, unsigned v) { return __hip_atomic_fetch_add(p, v, __ATOMIC_RELAXED, __HIP_MEMORY_SCOPE_AGENT); }
__device__ __forceinline__ unsigned xb_xcc_id() { return (unsigned)__builtin_amdgcn_s_getreg((3 << 11) | 20) & 0xFu; }
#define XB_SPIN(cond, bar) do { unsigned _sp = 0; while (cond) { __builtin_amdgcn_s_sleep(1); \
    if ((++_sp & 255u) == 0u) { if (xb_ld(&(bar)[XB_TMO])) break; if (_sp > XB_SPIN_CAP) { atomicAdd(&(bar)[XB_TMO], 1u); break; } } } } while (0)

struct XcdBarrier {
    unsigned* bar; unsigned x;
    volatile LAS unsigned* st;
};

__device__ __forceinline__ XcdBarrier xcd_barrier_post(unsigned* bar, volatile LAS unsigned* st) {
    XcdBarrier b; b.bar = bar; b.x = xb_xcc_id(); b.st = st;
    if (threadIdx.x == 0) (void)xb_add(&bar[XB_XCNT(b.x)], 1u);
    return b;
}
__device__ __forceinline__ void xcd_barrier_complete(unsigned* bar, unsigned x, unsigned& nloc, unsigned& nx) {
    const unsigned G = gridDim.x * gridDim.y * gridDim.z;
    unsigned sum, cnt, mine, sp = 0u;
    for (;;) {
        sum = 0u; cnt = 0u; mine = 0u;
#pragma unroll
        for (unsigned j = 0; j < 16; ++j) { const unsigned c = xb_ld(&bar[XB_XCNT(j)]); sum += c; cnt += (c > 0u) ? 1u : 0u; mine = (j == x) ? c : mine; }
        if (sum == G) break;
        __builtin_amdgcn_s_sleep(1);
        if ((++sp & 255u) == 0u) { if (xb_ld(&bar[XB_TMO])) break; if (sp > XB_SPIN_CAP) { atomicAdd(&bar[XB_TMO], 1u); break; } }
    }
    nloc = mine > 0u ? mine : 1u; nx = cnt > 0u ? cnt : 1u;
}

__device__ __forceinline__ void xcd_barrier(const XcdBarrier& b) {
    asm volatile("s_waitcnt vmcnt(0)" ::: "memory");
    __syncthreads();
    if (threadIdx.x == 0) {
        unsigned* bar = b.bar;
        __builtin_amdgcn_s_waitcnt(0);
        unsigned nloc = b.st[0], nx = b.st[1];
        if (nloc == 0u) { xcd_barrier_complete(bar, b.x, nloc, nx); b.st[0] = nloc; b.st[1] = nx; }
        const unsigned old = xb_add(&bar[XB_XSUB(b.x)], 1u);
        const unsigned gen = old / nloc;
        if (old + 1u == (gen + 1u) * nloc) {
            __builtin_amdgcn_fence(__ATOMIC_RELEASE, "agent");
            asm volatile("s_waitcnt vmcnt(0)" ::: "memory");
            const unsigned og = xb_add(&bar[XB_TOP], 1u);
            const unsigned tg = og / nx;
            if (og + 1u == (tg + 1u) * nx) xb_add(&bar[XB_TOPGEN], 1u);
            else XB_SPIN(xb_ld(&bar[XB_TOPGEN]) == tg, bar);
            __builtin_amdgcn_fence(__ATOMIC_ACQUIRE, "agent");
            xb_add(&bar[XB_XGEN(b.x)], 1u);
            asm volatile("s_waitcnt vmcnt(0)" ::: "memory");
        } else {
            XB_SPIN(xb_ld(&bar[XB_XGEN(b.x)]) == gen, bar);
            __builtin_amdgcn_fence(__ATOMIC_ACQUIRE, "agent");
            asm volatile("s_waitcnt vmcnt(0)" ::: "memory");
        }
    }
    __syncthreads();
}

constexpr size_t CTL_BAR = 16384;
constexpr size_t CTL_BYTES = 32768;

#define PHASE(k, call) if (P.ph_lo <= (k) && (k) < P.ph_hi) { call; if ((k) + 1 < P.ph_hi) xcd_barrier(xb); }
__global__ void __launch_bounds__(256, 2) mega(Params P) {
    __shared__ __attribute__((aligned(16))) unsigned char smem[SMEM_BYTES + 16];
    unsigned* xbst = (unsigned*)(smem + SMEM_BYTES);
    cg::grid_group grid = cg::this_grid();
    if (threadIdx.x < 4) xbst[threadIdx.x] = 0u;
    __syncthreads();
    if (P.ph_lo < 0) grid.sync();
    XcdBarrier xb = xcd_barrier_post((unsigned*)(P.ws + WS_CTL + CTL_BAR), (volatile LAS unsigned*)xbst);
    PHASE(0, phase0(P, smem))
    PHASE(1, phase_inproj0(P, smem))
    PHASE(2, phase_cmp_s5e(P, smem))
    PHASE(3, phase_glu(P, smem); phase_nsa(P, smem))
    PHASE(6, phase_outproj<false>(P, smem, P.in[0], nullptr, WS_WOUT0))
    PHASE(7, phase_ln_router(P, 0))
    PHASE(8, phase_moe_gu(P, smem, 0))
    PHASE(9, phase_moe_down(P, smem, 0))
    PHASE(10, phase_ln_ffn(P, 0))
    PHASE(11, phase_inproj1(P, smem))
    PHASE(12, phase_moba_gate(P, smem))
    PHASE(13, phase_moba_kv(P, smem))
    PHASE(14, phase_moba_own(P, smem))
    PHASE(15, phase_outproj<true>(P, smem, nullptr, (const bf16_t*)P.out, WS_WOUT1))
    PHASE(16, phase_ln_router(P, 1))
    PHASE(17, phase_moe_gu(P, smem, 1))
    PHASE(18, phase_moe_down(P, smem, 1))
    PHASE(20, phase_ln_ffn(P, 1))
}

extern "C" void kernel_launch(void* const* d_in, const int* in_sizes, int n_in, void* d_out, int out_size, void* d_ws, size_t ws_size, hipStream_t stream) {
    static int grid = 0;
    if (grid == 0) {
        if (n_in != 32 || out_size != NT * DM || ws_size < WS_END) { fprintf(stderr, "kernel_launch: unexpected shapes (n_in %d, out %d, ws %zu)\n", n_in, out_size, ws_size); grid = -1; return; }
        int dev = 0, cus = 0, per_cu = 0;
        (void)hipGetDevice(&dev);
        (void)hipDeviceGetAttribute(&cus, hipDeviceAttributeMultiprocessorCount, dev);
        (void)hipOccupancyMaxActiveBlocksPerMultiprocessor(&per_cu, mega, 256, 0);
        if (per_cu < 1) per_cu = 1;
        if (per_cu > 2) per_cu = 2;
        grid = cus * per_cu;
    }
    if (grid < 0) return;
    (void)hipMemsetAsync((char*)d_ws + WS_CTL, 0, CTL_BYTES, stream);
    Params p{};
    for (int i = 0; i < 32; ++i) p.in[i] = (const float*)d_in[i];
    p.out = (float*)d_out; p.ws = (unsigned char*)d_ws;
    p.ph_lo = 0; p.ph_hi = NPH;
    void* args[] = {&p};
    hipError_t e = hipLaunchCooperativeKernel((void*)mega, dim3(grid), dim3(256), args, 0, stream);
    if (e != hipSuccess) fprintf(stderr, "cooperative launch failed: %s (grid %d)\n", hipGetErrorString(e), grid);
}
```

```cpp
#include <hip/hip_runtime.h>
#include <hip/hip_cooperative_groups.h>
#include <cstdio>
#include <cstdint>
namespace cg = cooperative_groups;

typedef unsigned short bf16_t;
typedef short bf16x8 __attribute__((ext_vector_type(8)));
typedef float f32x4 __attribute__((ext_vector_type(4)));
typedef unsigned u32x4 __attribute__((ext_vector_type(4)));
typedef unsigned u32x2 __attribute__((ext_vector_type(2)));
#define DI __device__ __forceinline__
#define LAS __attribute__((address_space(3)))
typedef float f32x16 __attribute__((ext_vector_type(16)));
typedef float f32x8 __attribute__((ext_vector_type(8)));
typedef __bf16 bf16x8v __attribute__((ext_vector_type(8)));
typedef __bf16 bf16x4v __attribute__((ext_vector_type(4)));
#define MFMA32(a, b, c) __builtin_amdgcn_mfma_f32_32x32x16_bf16((a), (b), (c), 0, 0, 0)

constexpr int NB = 8, SEQ = 4096, DM = 1024, NT = NB * SEQ;
constexpr float ALPHA = 1.41421356237f;
constexpr float LN_EPS = 1e-5f;
constexpr int NIN0 = 1920;
constexpr int NPH = 21;

constexpr size_t MiB = 1u << 20;
constexpr size_t WS_CTL = 0;
constexpr size_t WS_ROPE = 1 * MiB;
constexpr size_t WS_WIN0 = 2 * MiB;
constexpr size_t WS_WOUT0 = 6 * MiB;
constexpr size_t WS_WIN1 = 8 * MiB;
constexpr size_t WS_WOUT1 = 14 * MiB;
constexpr size_t WS_WGLU = 16 * MiB;
constexpr size_t WS_WCK1 = 16 * MiB + 512 * 1024;
constexpr size_t WS_WCV1 = 17 * MiB;
constexpr size_t WS_WCK2 = 17 * MiB + 512 * 1024;
constexpr size_t WS_WCV2 = WS_WCK2 + 16384;
constexpr size_t WS_CBIAS = WS_WCV2 + 16384;
constexpr size_t WS_S5AL = WS_CBIAS + 4096;
constexpr size_t WS_RTRW = 17 * MiB + 640 * 1024;
constexpr size_t WS_BTE = 18 * MiB;
constexpr size_t WS_BTY = 22 * MiB;
constexpr size_t WS_WGU = 42 * MiB;
constexpr size_t WS_WDN = 74 * MiB;
constexpr size_t WS_KMP = 90 * MiB;
constexpr size_t WS_WGT = 94 * MiB;
constexpr size_t WS_KMEAN = 94 * MiB + 512 * 1024;
constexpr size_t WS_KCMP = 95 * MiB;
constexpr size_t WS_VCMP = 95 * MiB + 512 * 1024;
constexpr size_t WS_ACTB = 96 * MiB;
constexpr size_t WS_MIX = 160 * MiB;
constexpr size_t WS_XP = 224 * MiB;
constexpr size_t WS_LIST2 = 416 * MiB;
constexpr size_t WS_SELM = 92 * MiB;
constexpr size_t WS_MCNT = 93 * MiB;
constexpr size_t WS_MLIST = WS_LIST2;
constexpr size_t WS_PO2 = 424 * MiB;
constexpr size_t WS_PML = 488 * MiB;
constexpr size_t WS_END = 504 * MiB;
constexpr size_t XP_Q0 = WS_XP;
constexpr size_t XP_KC = WS_XP + 32 * MiB;
constexpr size_t KVSZ = 8 * MiB;
constexpr size_t XP_GATES = WS_XP + 80 * MiB;
constexpr size_t XP_AEXT = WS_XP + 84 * MiB;
constexpr size_t XP_G5 = WS_XP + 124 * MiB;
constexpr size_t XP_PRE = WS_XP;
constexpr size_t XP_YB = WS_XP;
constexpr size_t XP_H = WS_XP + 128 * MiB;
constexpr size_t XP_Q1 = WS_XP;

struct Params {
    const float* in[32];
    float* out;
    unsigned char* ws;
    int ph_lo, ph_hi;
};

DI bf16_t f2bf(float f) { unsigned u = __float_as_uint(f); return (bf16_t)((u + 0x7fffu + ((u >> 16) & 1u)) >> 16); }
DI float bf2f(bf16_t h) { return __uint_as_float(((unsigned)h) << 16); }
DI unsigned pk2(float lo, float hi) { return (unsigned)f2bf(lo) | ((unsigned)f2bf(hi) << 16); }
DI bf16x8 cvt8(f32x8 v) { return __builtin_bit_cast(bf16x8, __builtin_convertvector(v, bf16x8v)); }
DI u32x2 cvt4(f32x4 v) { return __builtin_bit_cast(u32x2, __builtin_convertvector(v, bf16x4v)); }
DI size_t kp_off(int key, int d) { return ((size_t)((key >> 5) * 4 + (d >> 4)) * 32 + (key & 31)) * 16 + (d & 15); }
DI int vp_pos(int ko) { return 8 * ((ko >> 2) & 1) + 4 * (ko >> 3) + (ko & 3); }
DI size_t vp_off(int key, int d) { return ((size_t)(key >> 4) * 64 + d) * 16 + vp_pos(key & 15); }
DI bf16_t ld_bf(const bf16_t* p) { return *p; }
DI f32x4 bf4_to_f(u32x2 w) { return (f32x4){__uint_as_float(w.x << 16), __uint_as_float(w.x & 0xffff0000u), __uint_as_float(w.y << 16), __uint_as_float(w.y & 0xffff0000u)}; }
template <int CTRL> DI float dpp_f(float v) { return __builtin_bit_cast(float, __builtin_amdgcn_update_dpp(0, __builtin_bit_cast(int, v), CTRL, 0xF, 0xF, true)); }
DI float wave_sum(float v) {
    v += dpp_f<0xB1>(v);
    v += dpp_f<0x4E>(v);
    v += dpp_f<0x141>(v);
    v += dpp_f<0x140>(v);
    { const auto s = __builtin_amdgcn_permlane16_swap(__float_as_uint(v), __float_as_uint(v), false, false); v = __uint_as_float(s[0]) + __uint_as_float(s[1]); }
    { const auto s = __builtin_amdgcn_permlane32_swap(__float_as_uint(v), __float_as_uint(v), false, false); v = __uint_as_float(s[0]) + __uint_as_float(s[1]); }
    return v;
}
DI float wave_max(float v) {
#pragma unroll
    for (int o = 32; o > 0; o >>= 1) v = fmaxf(v, __shfl_xor(v, o));
    return v;
}
DI float sigmoidf_(float x) { return __builtin_amdgcn_rcpf(1.f + __expf(-x)); }
DI float gelu_tanh(float x) { const float z = 0.7978845608028654f * (x + 0.044715f * x * x * x); return x * sigmoidf_(2.f * z); }

template <bool TRANS, bool PIN = true>
DI void gemm_kstep(const LAS unsigned char* cur, int aoff, int boff, int fq, int swz, f32x4 (&acc)[4][4]) {
    if (!PIN) {
#pragma unroll
        for (int ks = 0; ks < 2; ++ks) {
            bf16x8 af[4], bfr[4];
            const int co = ((ks * 4 + fq) ^ swz) * 16;
#pragma unroll
            for (int m = 0; m < 4; ++m) af[m] = *(const LAS bf16x8*)(cur + aoff + m * 2048 + co);
#pragma unroll
            for (int n = 0; n < 4; ++n) bfr[n] = *(const LAS bf16x8*)(cur + boff + n * 2048 + co);
#pragma unroll
            for (int m = 0; m < 4; ++m)
#pragma unroll
                for (int n = 0; n < 4; ++n) acc[m][n] = TRANS ? __builtin_amdgcn_mfma_f32_16x16x32_bf16(bfr[n], af[m], acc[m][n], 0, 0, 0) : __builtin_amdgcn_mfma_f32_16x16x32_bf16(af[m], bfr[n], acc[m][n], 0, 0, 0);
        }
        return;
    }
    bf16x8 af[2][4], bfr[2][4];
    const int co0 = (fq ^ swz) * 16, co1 = ((4 + fq) ^ swz) * 16;
    af[0][0] = *(const LAS bf16x8*)(cur + aoff + co0);
#pragma unroll
    for (int n = 0; n < 4; ++n) bfr[0][n] = *(const LAS bf16x8*)(cur + boff + n * 2048 + co0);
#pragma unroll
    for (int m = 1; m < 4; ++m) af[0][m] = *(const LAS bf16x8*)(cur + aoff + m * 2048 + co0);
    __builtin_amdgcn_sched_barrier(0);
#pragma unroll
    for (int n = 0; n < 4; ++n) acc[0][n] = TRANS ? __builtin_amdgcn_mfma_f32_16x16x32_bf16(bfr[0][n], af[0][0], acc[0][n], 0, 0, 0) : __builtin_amdgcn_mfma_f32_16x16x32_bf16(af[0][0], bfr[0][n], acc[0][n], 0, 0, 0);
    __builtin_amdgcn_sched_barrier(0);
    af[1][0] = *(const LAS bf16x8*)(cur + aoff + co1);
#pragma unroll
    for (int n = 0; n < 4; ++n) bfr[1][n] = *(const LAS bf16x8*)(cur + boff + n * 2048 + co1);
#pragma unroll
    for (int m = 1; m < 4; ++m) af[1][m] = *(const LAS bf16x8*)(cur + aoff + m * 2048 + co1);
    __builtin_amdgcn_sched_barrier(0);
#pragma unroll
    for (int m = 1; m < 4; ++m)
#pragma unroll
        for (int n = 0; n < 4; ++n) acc[m][n] = TRANS ? __builtin_amdgcn_mfma_f32_16x16x32_bf16(bfr[0][n], af[0][m], acc[m][n], 0, 0, 0) : __builtin_amdgcn_mfma_f32_16x16x32_bf16(af[0][m], bfr[0][n], acc[m][n], 0, 0, 0);
#pragma unroll
    for (int m = 0; m < 4; ++m)
#pragma unroll
        for (int n = 0; n < 4; ++n) acc[m][n] = TRANS ? __builtin_amdgcn_mfma_f32_16x16x32_bf16(bfr[1][n], af[1][m], acc[m][n], 0, 0, 0) : __builtin_amdgcn_mfma_f32_16x16x32_bf16(af[1][m], bfr[1][n], acc[m][n], 0, 0, 0);
}
constexpr int GEMM_LDS = 65536;
template <bool TRANS = true, bool PIN = true, class RowPtr, class Epi>
DI void gemm128(RowPtr rowptr, const bf16_t* __restrict__ Bt, int ldb, int K, unsigned char* smem, Epi epi, int kskip_lo = 0, int kskip_hi = 0) {
    LAS unsigned char* lds = (LAS unsigned char*)smem;
    const int tid = threadIdx.x, lane = tid & 63, wave = tid >> 6, wr = wave >> 1, wc = wave & 1, fr = lane & 15, fq = lane >> 4;
    const int schunk = ((tid & 7) ^ ((tid >> 4) & 7)) * 8;
    const bf16_t* ga[4];
#pragma unroll
    for (int i = 0; i < 4; ++i) ga[i] = rowptr(i * 32 + (tid >> 3)) + schunk;
    const bf16_t* gb = Bt + (size_t)(tid >> 3) * ldb + schunk;
    const size_t gbs = (size_t)32 * ldb;
    auto stage = [&](int kt, int s) {
#pragma unroll
        for (int i = 0; i < 4; ++i) {
            __builtin_amdgcn_global_load_lds((const unsigned*)(ga[i] + kt * 64), (LAS unsigned*)(lds + s * 32768 + (i * 256 + tid) * 16), 16, 0, 0);
            __builtin_amdgcn_global_load_lds((const unsigned*)(gb + i * gbs + kt * 64), (LAS unsigned*)(lds + s * 32768 + 16384 + (i * 256 + tid) * 16), 16, 0, 0);
        }
    };
    f32x4 acc[4][4];
#pragma unroll
    for (int m = 0; m < 4; ++m)
#pragma unroll
        for (int n = 0; n < 4; ++n) acc[m][n] = (f32x4){0.f, 0.f, 0.f, 0.f};
    const int nskip = kskip_hi - kskip_lo, nk = (K >> 6) - nskip;
    const int swz = (fr >> 1) & 7;
    const int aoff = (wr * 64 + fr) * 128, boff = 16384 + (wc * 64 + fr) * 128;
    stage(kskip_lo == 0 ? nskip : 0, 0);
#pragma unroll 1
    for (int kt = 0; kt < nk; ++kt) {
        asm volatile("s_waitcnt vmcnt(0)" ::: "memory");
        __syncthreads();
        if (kt + 1 < nk) stage(kt + 1 < kskip_lo ? kt + 1 : kt + 1 + nskip, (kt + 1) & 1);
        const LAS unsigned char* cur = lds + (kt & 1) * 32768;
        gemm_kstep<TRANS, PIN>(cur, aoff, boff, fq, swz, acc);
    }
    __syncthreads();
    epi(acc, wr, wc, lane);
}

template <bool TRANS = true, class RowPtr, class Epi, class NextRow>
DI void gemm128s(RowPtr rowptr, const bf16_t* __restrict__ Bt, int ldb, int K, unsigned char* smem, Epi epi, bool prefetched, bool has_next, NextRow nextrow, const bf16_t* __restrict__ nextBt) {
    LAS unsigned char* lds = (LAS unsigned char*)smem;
    const int tid = threadIdx.x, lane = tid & 63, wave = tid >> 6, wr = wave >> 1, wc = wave & 1, fr = lane & 15, fq = lane >> 4;
    const int schunk = ((tid & 7) ^ ((tid >> 4) & 7)) * 8;
    const bf16_t* ga[4];
#pragma unroll
    for (int i = 0; i < 4; ++i) ga[i] = rowptr(i * 32 + (tid >> 3)) + schunk;
    const bf16_t* gb = Bt + (size_t)(tid >> 3) * ldb + schunk;
    const size_t gbs = (size_t)32 * ldb;
    auto stage = [&](int kt, int s) {
#pragma unroll
        for (int i = 0; i < 4; ++i) {
            __builtin_amdgcn_global_load_lds((const unsigned*)(ga[i] + kt * 64), (LAS unsigned*)(lds + s * 32768 + (i * 256 + tid) * 16), 16, 0, 0);
            __builtin_amdgcn_global_load_lds((const unsigned*)(gb + i * gbs + kt * 64), (LAS unsigned*)(lds + s * 32768 + 16384 + (i * 256 + tid) * 16), 16, 0, 0);
        }
    };
    f32x4 acc[4][4];
#pragma unroll
    for (int m = 0; m < 4; ++m)
#pragma unroll
        for (int n = 0; n < 4; ++n) acc[m][n] = (f32x4){0.f, 0.f, 0.f, 0.f};
    const int nk = K >> 6;
    const int swz = (fr >> 1) & 7;
    const int aoff = (wr * 64 + fr) * 128, boff = 16384 + (wc * 64 + fr) * 128;
    if (!prefetched) stage(0, 0);
#pragma unroll 1
    for (int kt = 0; kt < nk; ++kt) {
        asm volatile("s_waitcnt vmcnt(0)" ::: "memory");
        __syncthreads();
        if (kt + 1 < nk) stage(kt + 1, (kt + 1) & 1);
        else if (has_next) {
#pragma unroll
            for (int i = 0; i < 4; ++i) {
                __builtin_amdgcn_global_load_lds((const unsigned*)(nextrow(i * 32 + (tid >> 3)) + schunk), (LAS unsigned*)(lds + (i * 256 + tid) * 16), 16, 0, 0);
                __builtin_amdgcn_global_load_lds((const unsigned*)(nextBt + (size_t)(tid >> 3) * ldb + schunk + i * gbs), (LAS unsigned*)(lds + 16384 + (i * 256 + tid) * 16), 16, 0, 0);
            }
        }
        const LAS unsigned char* cur = lds + (kt & 1) * 32768;
        gemm_kstep<TRANS>(cur, aoff, boff, fq, swz, acc);
    }
    epi(acc, wr, wc, lane);
}

DI int vblock() { const int G = gridDim.x; return (G & 7) == 0 ? (int)(blockIdx.x & 7) * (G >> 3) + (int)(blockIdx.x >> 3) : (int)blockIdx.x; }
DI void tile_mn(int it, int nN, int& mt, int& nt) { const int per = 8 * nN, grp = it / per, idx = it - grp * per; nt = idx >> 3; mt = grp * 8 + (idx & 7); }

DI int rope_pos(int l) { return (l & ~63) + ((2 * ((l & 31) >> 4) + ((l >> 5) & 1)) << 4) + (l & 15); }
DI int rowmap(int kind, int n) {
    if (kind == 1) {
        if (n < 512 || (n >= 512 && n < 640) || (n >= 768 && n < 896) || (n >= 1024 && n < 1152)) return rope_pos(n);
        return n < 1304 ? n : n + 104;
    }
    if (kind == 4) return n < 2048 ? rope_pos(n) : n;
    if (kind == 2) return ((n >> 5) << 6) + (n & 31);
    if (kind == 3) return ((n >> 5) << 6) + 32 + (n & 31);
    return n;
}
DI void tr_tile(const float* __restrict__ src, int K, int N, bf16_t* __restrict__ dst, int kind, int kt, int nt, float* s) {
    const int tid = threadIdx.x, k0 = kt * 64, n0 = nt * 64;
    {
        const int nn = tid & 63, kq = tid >> 6, n = n0 + nn;
#pragma unroll
        for (int i = 0; i < 16; ++i) { const int kk = kq + 4 * i; s[kk * 65 + nn] = (n < N) ? src[(size_t)(k0 + kk) * N + n] : 0.f; }
    }
    __syncthreads();
    {
        const int rn = tid >> 2, kseg = (tid & 3) * 16, n = n0 + rn;
        if (n < N) {
            unsigned w[8];
#pragma unroll
            for (int i = 0; i < 8; ++i) w[i] = pk2(s[(kseg + 2 * i) * 65 + rn], s[(kseg + 2 * i + 1) * 65 + rn]);
            bf16_t* d = dst + (size_t)rowmap(kind, n) * K + k0 + kseg;
            *(uint4*)d = make_uint4(w[0], w[1], w[2], w[3]);
            *(uint4*)(d + 8) = make_uint4(w[4], w[5], w[6], w[7]);
        }
    }
    __syncthreads();
}
struct CF { float re, im; };
DI CF cmul(CF a, CF b) { return {a.re * b.re - a.im * b.im, a.re * b.im + a.im * b.re}; }
DI CF s5_apow(const Params& P, int g, int p, float tau) {
    const float step = expf(P.in[10][g]);
    const float lr = P.in[8][g * 64 + p], li = P.in[9][g * 64 + p];
    const float mag = expf(lr * step * tau);
    float sn, cs; sincosf(li * step * tau, &sn, &cs);
    return {mag * cs, mag * sn};
}
DI CF s5_f(const Params& P, int g, int p) {
    const CF a = s5_apow(P, g, p, 1.f);
    const float lr = P.in[8][g * 64 + p], li = P.in[9][g * 64 + p];
    const float den = lr * lr + li * li;
    return {((a.re - 1.f) * lr + a.im * li) / den, (a.im * lr - (a.re - 1.f) * li) / den};
}
DI void phase0(const Params& P, unsigned char* smem) {
    const int tid = threadIdx.x;
    unsigned char* ws = P.ws;
    float* sf = (float*)smem;
    constexpr int N_TR0 = 16 * 29, N_TR1 = 256, N_TR2 = 16 * 48, N_TR3 = 256, N_TR4 = 64, N_TR5 = 64, N_TR6 = 64, N_TR7 = 2, N_TR8 = 2;
    constexpr int N_TRG = 64 * 32, N_TRU = 64 * 32, N_TRD = 64 * 32;
    constexpr int N_X = NT * DM / 8192, N_ROPE = 512, N_CB = 16, N_AL = 8, N_BTE = 256, N_BTYM = 32 * 63, N_BTYQ = 4096, N_ZP = 13;
    constexpr int N_RW = 2 * 36864 / 256;
    constexpr int TOTAL = N_RW + N_TR0 + N_TR1 + N_TR4 + N_TR5 + N_TR6 + N_TR7 + N_TR8 + N_X + N_ROPE + N_CB + N_AL + N_BTE + N_BTYM + N_BTYQ + N_ZP;
    for (int it0 = blockIdx.x; it0 < TOTAL; it0 += gridDim.x) {
        int it = it0;
        if (it < N_RW) {
            const int e = it * 256 + tid, layer = e / 36864, r = e % 36864;
            float* dst = (float*)(ws + WS_RTRW) + (size_t)layer * 36864;
            if (r < 4096) { const int o = r & 3, l = (r >> 2) & 63, jk = r >> 8, d = 4 * l + 256 * (jk >> 2) + (jk & 3); dst[r] = P.in[25][((size_t)layer * 1024 + d) * 4 + o]; }
            else { const int q = r - 4096, o = q & 3, l = (q >> 2) & 63, hf = (q >> 8) & 1, jk = (q >> 9) & 15, g = q >> 13, d = 4 * l + 256 * (jk >> 2) + (jk & 3);
                   dst[r] = P.in[27][(((size_t)layer * 4 + g) * 1024 + d) * 8 + hf * 4 + o]; }
            continue;
        } it -= N_RW;
        if (it < N_TR0) { tr_tile(P.in[1], 1024, 1816, (bf16_t*)(ws + WS_WIN0), 1, it / 29, it % 29, sf); continue; } it -= N_TR0;
        if (it < N_TR1) { tr_tile(P.in[18], 1024, 1024, (bf16_t*)(ws + WS_WOUT0), 0, it / 16, it % 16, sf); continue; } it -= N_TR1;
        if (it < N_TR4) { tr_tile(P.in[16], 512, 512, (bf16_t*)(ws + WS_WGLU), 0, it / 8, it % 8, sf); continue; } it -= N_TR4;
        if (it < N_TR5) { tr_tile(P.in[4], 2048, 128, (bf16_t*)(ws + WS_WCK1), 0, it / 2, it % 2, sf); continue; } it -= N_TR5;
        if (it < N_TR6) { tr_tile(P.in[6], 2048, 128, (bf16_t*)(ws + WS_WCV1), 0, it / 2, it % 2, sf); continue; } it -= N_TR6;
        if (it < N_TR7) { tr_tile(P.in[5], 128, 64, (bf16_t*)(ws + WS_WCK2), 0, it, 0, sf); continue; } it -= N_TR7;
        if (it < N_TR8) { tr_tile(P.in[7], 128, 64, (bf16_t*)(ws + WS_WCV2), 0, it, 0, sf); continue; } it -= N_TR8;
        if (it < N_X) {
            const float* x = P.in[0]; bf16_t* xb = (bf16_t*)(ws + WS_ACTB);
#pragma unroll
            for (int i = 0; i < 4; ++i) {
                const size_t idx = (size_t)it * 8192 + i * 2048 + tid * 8;
                const f32x4 a = __builtin_nontemporal_load((const f32x4*)(x + idx)), b = __builtin_nontemporal_load((const f32x4*)(x + idx + 4));
                *(uint4*)(xb + idx) = make_uint4(pk2(a.x, a.y), pk2(a.z, a.w), pk2(b.x, b.y), pk2(b.z, b.w));
            }
            continue;
        } it -= N_X;
        if (it < N_ROPE) {
            const int e = it * 256 + tid, pos = e >> 5, i = e & 31;
            const float inv = 1.0f / powf(10000.0f, (float)(2 * i) / 64.0f);
            const float ang = (float)pos * inv;
            ((float*)(ws + WS_ROPE))[e] = (float)cos((double)ang);
            ((float*)(ws + WS_ROPE))[4096 * 32 + e] = (float)sin((double)ang);
            continue;
        } it -= N_ROPE;
        if (it < N_CB) {
            const int kv = it >> 3, j0 = (it & 7) * 16, j = j0 + (tid & 15), sl = tid >> 4;
            const float* pe = P.in[kv ? 3 : 2]; const float* w1 = P.in[kv ? 6 : 4];
            float a = 0.f;
            for (int i = sl * 128; i < sl * 128 + 128; ++i) a += pe[i] * w1[(size_t)i * 128 + j];
            sf[tid] = a; __syncthreads();
            if (tid < 16) { float t = 0.f; for (int q = 0; q < 16; ++q) t += sf[q * 16 + tid]; ((float*)(ws + WS_CBIAS))[kv * 128 + j0 + tid] = t; }
            __syncthreads();
            continue;
        } it -= N_CB;
        if (it < N_AL) {
            const int e = it * 256 + tid, g = e >> 6, p = e & 63;
            const CF a = s5_apow(P, g, p, 32.f);
            ((float*)(ws + WS_S5AL))[e * 2] = a.re; ((float*)(ws + WS_S5AL))[e * 2 + 1] = a.im;
            continue;
        } it -= N_AL;
        if (it < N_BTE) {
            const int e = it * 256 + tid, g = e >> 11, p = (e >> 5) & 63, r = e & 31;
            const CF w = cmul(s5_apow(P, g, p, (float)(31 - r)), s5_f(P, g, p));
            bf16_t* d = (bf16_t*)(ws + WS_BTE) + (size_t)g * 128 * 512;
#pragma unroll
            for (int c = 0; c < 16; ++c) {
                const CF bb = {P.in[11][(g * 64 + p) * 16 + c], P.in[12][(g * 64 + p) * 16 + c]};
                const CF v = cmul(w, bb);
                d[(size_t)p * 512 + r * 16 + c] = f2bf(v.re);
                d[(size_t)(64 + p) * 512 + r * 16 + c] = f2bf(v.im);
            }
            continue;
        } it -= N_BTE;
        if (it < N_BTYM) {
            const int g = it / 63, dd = it % 63 - 31, ch = tid >> 4, c = tid & 15;
            float val = 0.f;
            if (dd >= 0) {
                float* sw = sf; float* sb = sf + 128; float* sc = sf + 128 + 2048;
                if (tid < 64) { const CF w = cmul(s5_apow(P, g, tid, (float)dd), s5_f(P, g, tid)); sw[2 * tid] = w.re; sw[2 * tid + 1] = w.im; }
#pragma unroll
                for (int i = 0; i < 4; ++i) {
                    const int e = tid + 256 * i;
                    sb[2 * e] = P.in[11][(size_t)g * 1024 + e]; sb[2 * e + 1] = P.in[12][(size_t)g * 1024 + e];
                    sc[2 * e] = P.in[13][(size_t)g * 1024 + e]; sc[2 * e + 1] = P.in[14][(size_t)g * 1024 + e];
                }
                __syncthreads();
#pragma unroll 8
                for (int p = 0; p < 64; ++p) {
                    const CF bb = {sb[2 * (p * 16 + c)], sb[2 * (p * 16 + c) + 1]};
                    const CF cc = {sc[2 * (ch * 64 + p)], sc[2 * (ch * 64 + p) + 1]};
                    const CF w = {sw[2 * p], sw[2 * p + 1]};
                    val += cmul(cc, cmul(w, bb)).re;
                }
                __syncthreads();
            }
            bf16_t* d = (bf16_t*)(ws + WS_BTY) + (size_t)g * 512 * 640;
            const bf16_t hv = f2bf(val);
            for (int r = 0; r < 32; ++r) { const int s = r + dd; if (s >= 0 && s < 32) d[(size_t)(s * 16 + ch) * 640 + r * 16 + c] = hv; }
            continue;
        } it -= N_BTYM;
        if (it < N_BTYQ) {
            const int e = it * 256 + tid, g = e >> 15, s = (e >> 10) & 31, ch = (e >> 6) & 15, p = e & 63;
            const CF cc = {P.in[13][(g * 16 + ch) * 64 + p], P.in[14][(g * 16 + ch) * 64 + p]};
            const CF w = cmul(cc, s5_apow(P, g, p, (float)(s + 1)));
            bf16_t* d = (bf16_t*)(ws + WS_BTY) + ((size_t)g * 512 + s * 16 + ch) * 640 + 512;
            d[p] = f2bf(w.re); d[64 + p] = f2bf(-w.im);
            continue;
        } it -= N_BTYQ;
        {
            uint4* d = (uint4*)((bf16_t*)(ws + WS_WIN0) + (size_t)(1304 + it * 8) * 1024);
#pragma unroll
            for (int i = 0; i < 4; ++i) d[i * 256 + tid] = make_uint4(0, 0, 0, 0);
        }
    }
}

DI void phase_inproj0(const Params& P, unsigned char* smem) {
    unsigned char* ws = P.ws;
    const bf16_t* A = (const bf16_t*)(ws + WS_ACTB);
    const float* cosT = (const float*)(ws + WS_ROPE);
    const float* sinT = cosT + 4096 * 32;
    constexpr int NTN = NIN0 / 128;
    bool pre = false;
    for (int it = vblock(); it < (NT / 128) * NTN; it += gridDim.x) {
        int mt, nt; tile_mn(it, NTN, mt, nt);
        const int m0 = mt * 128;
        auto rowptr = [=](int r) { return A + (size_t)(m0 + r) * 1024; };
        const bf16_t* Bt = (const bf16_t*)(ws + WS_WIN0) + (size_t)nt * 128 * 1024;
        const bool hn = it + (int)gridDim.x < (NT / 128) * NTN;
        int mtn = 0, ntn = 0; if (hn) tile_mn(it + gridDim.x, NTN, mtn, ntn);
        auto nextrow = [=](int r) { return A + (size_t)(mtn * 128 + r) * 1024; };
        const bf16_t* nBt = (const bf16_t*)(ws + WS_WIN0) + (size_t)ntn * 128 * 1024;
        if (nt == 7 || nt == 9) {
            auto epi = [=](f32x4 (&acc)[4][4], int wr, int wc, int lane) {
                const int fr = lane & 15, fq = lane >> 4, which = nt == 7 ? 3 : 5, g = wc;
#pragma unroll
                for (int m = 0; m < 4; ++m) {
                    const int t = m0 + wr * 64 + m * 16 + fq * 4, s = t & 4095, b = t >> 12;
                    bf16_t* dst = (bf16_t*)(ws + XP_KC + (size_t)which * KVSZ) + (size_t)(b * 2 + g) * 4096 * 64;
#pragma unroll
                    for (int n = 0; n < 4; ++n) *(u32x2*)(dst + vp_off(s, n * 16 + fr)) = cvt4(acc[m][n]);
                }
            };
            gemm128s<false>(rowptr, Bt, 1024, 1024, smem, epi, pre, hn, nextrow, nBt);
            pre = hn;
            continue;
        }
        auto epi = [=](f32x4 (&acc)[4][4], int wr, int wc, int lane) {
            const int u64 = nt * 2 + wc, fr = lane & 15, fq = lane >> 4;
#pragma unroll
            for (int m = 0; m < 4; ++m) {
                const int t = m0 + wr * 64 + m * 16 + fr, s = t & 4095, b = t >> 12;
                if (u64 < 20) {
                    const bool isq = u64 < 8;
                    const int which = (u64 - 8) >> 1, g = (u64 - 8) & 1;
                    if (isq || ((which & 1) == 0)) {
#pragma unroll
                        for (int n2 = 0; n2 < 2; ++n2) {
                            const int i = n2 * 16 + fq * 4;
                            const f32x4 c = *(const f32x4*)(cosT + s * 32 + i), sn = *(const f32x4*)(sinT + s * 32 + i);
                            const f32x4 x1 = acc[m][2 * n2], x2 = acc[m][2 * n2 + 1];
                            const u32x2 o1 = cvt4(x1 * c - x2 * sn), o2 = cvt4(x1 * sn + x2 * c);
                            if (isq) { bf16_t* dst = (bf16_t*)(ws + XP_Q0) + (size_t)t * 512 + u64 * 64; *(u32x2*)(dst + i) = o1; *(u32x2*)(dst + i + 32) = o2; }
                            else {
                                bf16_t* dst = (bf16_t*)(ws + XP_KC + (size_t)which * KVSZ) + (size_t)(b * 2 + g) * 4096 * 64;
                                if (which == 0) { *(u32x2*)(dst + (size_t)s * 64 + i) = o1; *(u32x2*)(dst + (size_t)s * 64 + i + 32) = o2; }
                                else { *(u32x2*)(dst + kp_off(s, i)) = o1; *(u32x2*)(dst + kp_off(s, i + 32)) = o2; }
                            }
                        }
                    } else {
                        bf16_t* dst = (bf16_t*)(ws + XP_KC + (size_t)which * KVSZ) + ((size_t)(b * 2 + g) * 4096 + s) * 64;
#pragma unroll
                        for (int n = 0; n < 4; ++n) *(u32x2*)(dst + n * 16 + fq * 4) = cvt4(acc[m][n]);
                    }
                } else if (u64 == 20) {
#pragma unroll
                    for (int n = 0; n < 2; ++n) {
                        const int c0 = n * 16 + fq * 4;
                        if (c0 < 24) { f32x4 o; o.x = sigmoidf_(acc[m][n].x); o.y = sigmoidf_(acc[m][n].y); o.z = sigmoidf_(acc[m][n].z); o.w = sigmoidf_(acc[m][n].w); *(f32x4*)((float*)(ws + XP_GATES) + (size_t)t * 24 + c0) = o; }
                    }
                } else if (u64 >= 22) {
#pragma unroll
                    for (int n = 0; n < 4; ++n) {
                        const int g5 = (u64 - 22) * 4 + n;
                        *(u32x2*)((bf16_t*)(ws + XP_AEXT) + ((size_t)g5 * 1024 + (t >> 5)) * 640 + (t & 31) * 16 + fq * 4) = cvt4(acc[m][n]);
                    }
                }
            }
        };
        gemm128s(rowptr, Bt, 1024, 1024, smem, epi, pre, hn, nextrow, nBt);
        pre = hn;
    }
}

constexpr int N_LATE = 16 * 48 + 256 + 3 * 64 * 32;
DI void late_weights(const Params& P, unsigned char* smem, int it) {
    unsigned char* ws = P.ws;
    float* sf = (float*)smem;
    constexpr int N_TR2 = 16 * 48, N_TR3 = 256, N_TRG = 64 * 32, N_TRU = 64 * 32;
    if (it < N_TR2) { tr_tile(P.in[19], 1024, 3072, (bf16_t*)(ws + WS_WIN1), 4, it / 48, it % 48, sf); return; } it -= N_TR2;
    if (it < N_TR3) { tr_tile(P.in[20], 1024, 1024, (bf16_t*)(ws + WS_WOUT1), 0, it / 16, it % 16, sf); return; } it -= N_TR3;
    if (it < N_TRG) { const int mat = it >> 5, r = it & 31; tr_tile(P.in[29] + (size_t)mat * 1024 * 128, 1024, 128, (bf16_t*)(ws + WS_WGU) + (size_t)mat * 256 * 1024, 2, r >> 1, r & 1, sf); return; } it -= N_TRG;
    if (it < N_TRU) { const int mat = it >> 5, r = it & 31; tr_tile(P.in[30] + (size_t)mat * 1024 * 128, 1024, 128, (bf16_t*)(ws + WS_WGU) + (size_t)mat * 256 * 1024, 3, r >> 1, r & 1, sf); return; } it -= N_TRU;
    { const int mat = it >> 5, r = it & 31; tr_tile(P.in[31] + (size_t)mat * 128 * 1024, 128, 1024, (bf16_t*)(ws + WS_WDN) + (size_t)mat * 1024 * 128, 0, r >> 4, r & 15, sf); }
}

DI void s5y_tile(const Params& P, unsigned char* smem, int g, int mt, int nt);
DI void phase_cmp_s5e(const Params& P, unsigned char* smem) {
    unsigned char* ws = P.ws;
    const int tid = threadIdx.x, lane = tid & 63, wave = tid >> 6;
    const int G = gridDim.x, bid = blockIdx.x;
    const bool split = G >= 384;
    const int nmine = !split ? (320 + N_LATE + G - 1 - bid) / G : (bid < 320 ? 1 : (N_LATE + (G - 320) - 1 - (bid - 320)) / (G - 320));
    for (int k = 0; k < nmine; ++k) {
        const int it = !split ? bid + k * G : (bid < 320 ? bid : 320 + (bid - 320) + k * (G - 320));
        if (it >= 64 + 256) { late_weights(P, smem, it - 320); continue; }
        if (it < 64) {
            const int kv = it >> 5, bg = (it >> 1) & 15, mt = it & 1;
            const bf16_t* src = (const bf16_t*)(ws + XP_KC + (size_t)kv * KVSZ) + (size_t)bg * 4096 * 64;
            const float* cb = (const float*)(ws + WS_CBIAS) + kv * 128;
            bf16_t* sH = (bf16_t*)smem;
            auto rowptr = [=](int r) { int rr = mt * 128 + r; rr = rr > 254 ? 254 : rr; return src + (size_t)rr * 1024; };
            auto epi = [=](f32x4 (&acc)[4][4], int wr, int wc, int ln) {
                const int fr = ln & 15, fq = ln >> 4;
#pragma unroll
                for (int m = 0; m < 4; ++m)
#pragma unroll
                    for (int n = 0; n < 4; ++n)
#pragma unroll
                        for (int j = 0; j < 4; ++j) {
                            const int r = wr * 64 + m * 16 + fr, c = wc * 64 + n * 16 + fq * 4 + j;
                            sH[r * 136 + c] = f2bf(gelu_tanh(acc[m][n][j] + cb[c]));
                        }
            };
            gemm128(rowptr, (const bf16_t*)(ws + (kv ? WS_WCV1 : WS_WCK1)), 2048, 2048, smem, epi);
            __syncthreads();
            const bf16_t* W2 = (const bf16_t*)(ws + (kv ? WS_WCV2 : WS_WCK2));
            f32x4 a2[2][4];
#pragma unroll
            for (int m = 0; m < 2; ++m)
#pragma unroll
                for (int n = 0; n < 4; ++n) a2[m][n] = (f32x4){0.f, 0.f, 0.f, 0.f};
#pragma unroll
            for (int ks = 0; ks < 4; ++ks) {
                bf16x8 af[2], bfr[4];
#pragma unroll
                for (int m = 0; m < 2; ++m) af[m] = *(const bf16x8*)(sH + (wave * 32 + m * 16 + (lane & 15)) * 136 + ks * 32 + (lane >> 4) * 8);
#pragma unroll
                for (int n = 0; n < 4; ++n) bfr[n] = *(const bf16x8*)(W2 + (n * 16 + (lane & 15)) * 128 + ks * 32 + (lane >> 4) * 8);
#pragma unroll
                for (int m = 0; m < 2; ++m)
#pragma unroll
                    for (int n = 0; n < 4; ++n) a2[m][n] = __builtin_amdgcn_mfma_f32_16x16x32_bf16(af[m], bfr[n], a2[m][n], 0, 0, 0);
            }
            bf16_t* dst = (bf16_t*)(ws + (kv ? WS_VCMP : WS_KCMP)) + (size_t)bg * 256 * 64;
#pragma unroll
            for (int m = 0; m < 2; ++m)
#pragma unroll
                for (int n = 0; n < 4; ++n)
#pragma unroll
                    for (int j = 0; j < 4; ++j) {
                        const int row = mt * 128 + wave * 32 + m * 16 + (lane >> 4) * 4 + j, col = n * 16 + (lane & 15);
                        dst[kv ? vp_off(row, col) : kp_off(row, col)] = row < 255 ? f2bf(a2[m][n][j]) : (bf16_t)0;
                    }
            __syncthreads();
        } else {
            const int it2 = it - 64, g = it2 >> 3, b = it2 & 7;
            bf16_t* aext = (bf16_t*)(ws + XP_AEXT) + ((size_t)g * 1024 + b * 128) * 640;
            float* sE = (float*)smem;
            auto rowptr = [=](int r) { return (const bf16_t*)aext + (size_t)r * 640; };
            auto epi = [=](f32x4 (&acc)[4][4], int wr, int wc, int ln) {
                const int fr = ln & 15, fq = ln >> 4;
#pragma unroll
                for (int m = 0; m < 4; ++m)
#pragma unroll
                    for (int n = 0; n < 4; ++n)
#pragma unroll
                        for (int j = 0; j < 4; ++j) sE[(wr * 64 + m * 16 + fr) * 129 + wc * 64 + n * 16 + fq * 4 + j] = acc[m][n][j];
            };
            gemm128<true, false>(rowptr, (const bf16_t*)(ws + WS_BTE) + (size_t)g * 128 * 512, 512, 512, smem, epi);
            __syncthreads();
            {
                const int p = tid & 63, c0 = wave * 32;
                const float ar = ((const float*)(ws + WS_S5AL))[(g * 64 + p) * 2], ai = ((const float*)(ws + WS_S5AL))[(g * 64 + p) * 2 + 1];
                float* send = (float*)(smem + 128 * 129 * 4);
                float xr = 0.f, xi = 0.f;
                for (int c = c0; c < c0 + 32; ++c) {
                    const float er = sE[c * 129 + p], ei = sE[c * 129 + 64 + p];
                    const float nr = ar * xr - ai * xi + er, ni = ar * xi + ai * xr + ei;
                    xr = nr; xi = ni;
                }
                send[(wave * 64 + p) * 2] = xr; send[(wave * 64 + p) * 2 + 1] = xi;
                float qr = ar, qi = ai;
#pragma unroll
                for (int k = 0; k < 5; ++k) { const float tr = qr * qr - qi * qi, ti = 2.f * qr * qi; qr = tr; qi = ti; }
                __syncthreads();
                xr = 0.f; xi = 0.f;
                for (int k = 0; k < wave; ++k) {
                    const float er = send[(k * 64 + p) * 2], ei = send[(k * 64 + p) * 2 + 1];
                    const float nr = qr * xr - qi * xi + er, ni = qr * xi + qi * xr + ei;
                    xr = nr; xi = ni;
                }
                for (int c = c0; c < c0 + 32; ++c) {
                    aext[(size_t)c * 640 + 512 + p] = f2bf(xr);
                    aext[(size_t)c * 640 + 576 + p] = f2bf(xi);
                    const float er = sE[c * 129 + p], ei = sE[c * 129 + 64 + p];
                    const float nr = ar * xr - ai * xi + er, ni = ar * xi + ai * xr + ei;
                    xr = nr; xi = ni;
                }
            }
            asm volatile("s_waitcnt vmcnt(0)" ::: "memory");
            __syncthreads();
#pragma unroll 1
            for (int nt = 0; nt < 4; ++nt) s5y_tile(P, smem, g, b, nt);
        }
    }
}

DI void s5y_tile(const Params& P, unsigned char* smem, int g, int mt, int nt) {
    unsigned char* ws = P.ws;
    const bf16_t* aext = (const bf16_t*)(ws + XP_AEXT) + (size_t)g * 1024 * 640;
    const float* dsk = P.in[15];
    auto rowptr = [=](int r) { return aext + (size_t)(mt * 128 + r) * 640; };
    auto epi = [=](f32x4 (&acc)[4][4], int wr, int wc, int ln) {
        const int fr = ln & 15, fq = ln >> 4;
        const f32x4 dk = *(const f32x4*)(dsk + g * 16 + fq * 4);
#pragma unroll
        for (int m = 0; m < 4; ++m) {
            const int cr = mt * 128 + wr * 64 + m * 16 + fr;
#pragma unroll
            for (int n = 0; n < 4; ++n) {
                const int sp = nt * 8 + wc * 4 + n, t = cr * 32 + sp;
                const f32x4 u = bf4_to_f(*(const u32x2*)(aext + (size_t)cr * 640 + sp * 16 + fq * 4));
                const f32x4 y = acc[m][n] + dk * u;
                *(u32x2*)((bf16_t*)(ws + XP_G5) + (size_t)t * 512 + g * 16 + fq * 4) = cvt4((f32x4){gelu_tanh(y.x), gelu_tanh(y.y), gelu_tanh(y.z), gelu_tanh(y.w)});
            }
        }
    };
    gemm128<true, false>(rowptr, (const bf16_t*)(ws + WS_BTY) + ((size_t)g * 512 + nt * 128) * 640, 640, 640, smem, epi, 2 * nt + 2, 8);
}
struct FA { f32x16 o0, o1; float m, l; };
DI void fa_init(FA& st) {
#pragma unroll
    for (int i = 0; i < 16; ++i) { st.o0[i] = 0.f; st.o1[i] = 0.f; }
    st.m = -1e30f; st.l = 0.f;
}
constexpr float FA_THR = 8.f;
template <int MODE, class Valid>
DI void fa_tile(FA& st, const bf16x8 (&qf)[4], const LAS bf16_t* Kt, const LAS bf16_t* Vt, int r, int h, float c, bool rowok, Valid valid) {
    const LAS bf16_t* kb = Kt + r * 16 + 8 * h;
    const LAS bf16_t* vb = Vt + r * 16 + 8 * h;
    bf16x8 kf[4], vf[4];
#pragma unroll
    for (int ks = 0; ks < 4; ++ks) kf[ks] = *(const LAS bf16x8*)(kb + ks * 512);
#pragma unroll
    for (int sub = 0; sub < 2; ++sub) {
        f32x16 acc;
#pragma unroll
        for (int i = 0; i < 16; ++i) acc[i] = 0.f;
#pragma unroll
        for (int ks = 0; ks < 4; ++ks) acc = MFMA32(kf[ks], qf[ks], acc);
#pragma unroll
        for (int s2 = 0; s2 < 2; ++s2) { vf[2 * s2] = *(const LAS bf16x8*)(vb + ((sub * 2 + s2) * 64) * 16); vf[2 * s2 + 1] = *(const LAS bf16x8*)(vb + ((sub * 2 + s2) * 64 + 32) * 16); }
        if (sub == 0) {
#pragma unroll
            for (int ks = 0; ks < 4; ++ks) kf[ks] = *(const LAS bf16x8*)(kb + (4 + ks) * 512);
        }
        __builtin_amdgcn_sched_barrier(0);
        float mx = -INFINITY;
#pragma unroll
        for (int i = 0; i < 16; ++i) {
            if (MODE == 2) { const int koff = sub * 32 + (i & 3) + 8 * (i >> 2) + 4 * h; acc[i] = valid(koff) ? acc[i] : -INFINITY; }
            mx = fmaxf(mx, acc[i]);
        }
        {
            const auto sw = __builtin_amdgcn_permlane32_swap(__float_as_uint(mx), __float_as_uint(mx), false, false);
            mx = fmaxf(__uint_as_float(sw[0]), __uint_as_float(sw[1]));
        }
        const float cand = mx * c;
        const bool upd = cand > st.m + FA_THR;
        if (__ballot(upd)) {
            const float mn = upd ? cand : st.m, alpha = __builtin_amdgcn_exp2f(st.m - mn);
            st.m = mn; st.l *= alpha;
#pragma unroll
            for (int i = 0; i < 16; ++i) { st.o0[i] *= alpha; st.o1[i] *= alpha; }
        }
        const float nb = (MODE == 1 && !rowok) ? -INFINITY : -st.m;
        float ps0 = 0.f, ps1 = 0.f;
#pragma unroll
        for (int i = 0; i < 16; i += 2) {
            acc[i] = __builtin_amdgcn_exp2f(__builtin_fmaf(acc[i], c, nb));
            acc[i + 1] = __builtin_amdgcn_exp2f(__builtin_fmaf(acc[i + 1], c, nb));
            ps0 += acc[i]; ps1 += acc[i + 1];
        }
        st.l += ps0 + ps1;
#pragma unroll
        for (int s2 = 0; s2 < 2; ++s2) {
            const bf16x8 pk = cvt8((f32x8){acc[8 * s2], acc[8 * s2 + 1], acc[8 * s2 + 2], acc[8 * s2 + 3], acc[8 * s2 + 4], acc[8 * s2 + 5], acc[8 * s2 + 6], acc[8 * s2 + 7]});
            st.o0 = MFMA32(vf[2 * s2], pk, st.o0);
            st.o1 = MFMA32(vf[2 * s2 + 1], pk, st.o1);
        }
    }
}
DI void fa_issue(const bf16_t* gK, const bf16_t* gV, LAS unsigned char* buf, int tid) {
    __builtin_amdgcn_global_load_lds((const unsigned*)(gK + tid * 8), (LAS unsigned*)(buf + tid * 16), 16, 0, 0);
    __builtin_amdgcn_global_load_lds((const unsigned*)(gK + (tid + 256) * 8), (LAS unsigned*)(buf + (tid + 256) * 16), 16, 0, 0);
    __builtin_amdgcn_global_load_lds((const unsigned*)(gV + tid * 8), (LAS unsigned*)(buf + 8192 + tid * 16), 16, 0, 0);
    __builtin_amdgcn_global_load_lds((const unsigned*)(gV + (tid + 256) * 8), (LAS unsigned*)(buf + 8192 + (tid + 256) * 16), 16, 0, 0);
}
DI void fa_wait(int j, int n) {
    const int rem = n - 1 - j;
    if (rem >= 2) asm volatile("s_waitcnt vmcnt(8)" ::: "memory");
    else if (rem == 1) asm volatile("s_waitcnt vmcnt(4)" ::: "memory");
    else asm volatile("s_waitcnt vmcnt(0)" ::: "memory");
    __builtin_amdgcn_s_barrier();
    asm volatile("" ::: "memory");
}

constexpr int NSA_LDS_IMP = 65536;
constexpr int NSA_LDS_SCS = NSA_LDS_IMP + 8192;
constexpr int NSA_LDS_MSK = NSA_LDS_SCS + 1024;
DI void phase_nsa(const Params& P, unsigned char* smem) {
    unsigned char* ws = P.ws;
    const int tid = threadIdx.x, lane = tid & 63, wave = tid >> 6, r = lane & 31, h = lane >> 5;
    const float c = 0.125f * 1.4426950408889634f;
    LAS unsigned char* lds = (LAS unsigned char*)smem;
    float* impw = (float*)(smem + NSA_LDS_IMP) + wave * 512;
    float* scs = (float*)(smem + NSA_LDS_SCS) + wave * 64;
    unsigned long long* mskw = (unsigned long long*)(smem + NSA_LDS_MSK) + wave * 8;
    for (int it = blockIdx.x; it < 2048; it += gridDim.x) {
        const int qt = 127 - (it >> 4), bg = it & 15, b = bg >> 1, g = bg & 1, t0 = qt * 32, qblk = t0 >> 6;
        const int ql = r >> 2, z = r & 3, s = t0 + wave * 8 + ql, t = b * 4096 + s;
        const bf16_t* Qg = (const bf16_t*)(ws + XP_Q0) + (size_t)t * 512 + (g * 4 + z) * 64;
        bf16x8 qf[4];
#pragma unroll
        for (int ks = 0; ks < 4; ++ks) qf[ks] = *(const bf16x8*)(Qg + ks * 16 + 8 * h);
        const float* gt = (const float*)(ws + XP_GATES) + (size_t)t * 24 + (g * 4 + z) * 3;
        const float g_c = gt[0], g_s = gt[1], g_w = gt[2];
        const bf16_t* Kc = (const bf16_t*)(ws + WS_KCMP) + (size_t)bg * 256 * 64;
        const bf16_t* Vc = (const bf16_t*)(ws + WS_VCMP) + (size_t)bg * 256 * 64;
        const bf16_t* Ks = (const bf16_t*)(ws + XP_KC + 2 * KVSZ) + (size_t)bg * 4096 * 64;
        const bf16_t* Vs = (const bf16_t*)(ws + XP_KC + 3 * KVSZ) + (size_t)bg * 4096 * 64;
        const bf16_t* Kw = (const bf16_t*)(ws + XP_KC + 4 * KVSZ) + (size_t)bg * 4096 * 64;
        const bf16_t* Vw = (const bf16_t*)(ws + XP_KC + 5 * KVSZ) + (size_t)bg * 4096 * 64;
        const int nct = ((t0 >> 4) + 1 + 63) >> 6;
        const int w0 = (t0 - 255) < 0 ? 0 : (t0 - 255) >> 6;
        const int e1 = nct, e2 = 2 * nct, e3 = e2 + qblk + 1, e4 = e3 + (qblk - w0 + 1);
        const int nc = s >= 31 ? ((s - 31) >> 4) + 1 : 0;
        const int s_lo = t0 + wave * 8, s_hi = s_lo + 7, nc_min = s_lo >= 31 ? ((s_lo - 31) >> 4) + 1 : 0;
        for (int i = lane; i < 512; i += 64) impw[i] = 0.f;
        auto tile_ptrs = [&](int i, const bf16_t*& gk, const bf16_t*& gv) {
            if (i < e1) { gk = Kc + (size_t)i * 4096; gv = Vc + (size_t)i * 4096; }
            else if (i < e2) { gk = Kc + (size_t)(i - e1) * 4096; gv = Vc + (size_t)(i - e1) * 4096; }
            else if (i < e3) { gk = Ks + (size_t)(i - e2) * 4096; gv = Vs + (size_t)(i - e2) * 4096; }
            else { gk = Kw + (size_t)(w0 + i - e3) * 4096; gv = Vw + (size_t)(w0 + i - e3) * 4096; }
        };
        FA st; fa_init(st);
        f32x16 out0, out1;
#pragma unroll
        for (int i = 0; i < 16; ++i) { out0[i] = 0.f; out1[i] = 0.f; }
        float m_c = -1e30f, il_c = 0.f;
        unsigned long long mymask = 0ull;
        asm volatile("s_waitcnt vmcnt(0)" ::: "memory");
        __builtin_amdgcn_s_barrier();
#pragma unroll
        for (int i = 0; i < 3; ++i) if (i < e4) { const bf16_t *gk, *gv; tile_ptrs(i, gk, gv); fa_issue(gk, gv, lds + i * 16384, tid); }
        auto step = [&](int i) -> const LAS bf16_t* {
            fa_wait(i, e4);
            if (i + 3 < e4) { const bf16_t *gk, *gv; tile_ptrs(i + 3, gk, gv); fa_issue(gk, gv, lds + ((i + 3) & 3) * 16384, tid); }
            return (const LAS bf16_t*)(lds + (i & 3) * 16384);
        };
        int i = 0;
        for (; i < e1; ++i) {
            const LAS bf16_t* cur = step(i);
            const int nb = i * 64;
            if (nb + 63 < nc_min) fa_tile<0>(st, qf, cur, cur + 4096, r, h, c, true, [=](int) { return true; }); else fa_tile<2>(st, qf, cur, cur + 4096, r, h, c, true, [=](int koff) { return nb + koff < nc; });
        }
        {
            const float l = st.l + __shfl_xor(st.l, 32);
            il_c = 1.f / fmaxf(l, 1e-30f); m_c = st.m;
            const float f = g_c * il_c;
#pragma unroll
            for (int k = 0; k < 16; ++k) { out0[k] = st.o0[k] * f; out1[k] = st.o1[k] * f; }
            fa_init(st);
        }
        for (; i < e2; ++i) {
            const LAS bf16_t* cur = step(i);
            const int nb = (i - e1) * 64;
#pragma unroll
            for (int sub = 0; sub < 2; ++sub) {
                f32x16 acc;
#pragma unroll
                for (int k = 0; k < 16; ++k) acc[k] = 0.f;
#pragma unroll
                for (int ks = 0; ks < 4; ++ks) acc = MFMA32(*(const LAS bf16x8*)(cur + ((sub * 4 + ks) * 32 + r) * 16 + 8 * h), qf[ks], acc);
#pragma unroll
                for (int q4 = 0; q4 < 4; ++q4) {
                    float p[4];
#pragma unroll
                    for (int k = 0; k < 4; ++k) {
                        const int n = nb + sub * 32 + 8 * q4 + 4 * h + k;
                        p[k] = (n < nc) ? __builtin_amdgcn_exp2f(acc[4 * q4 + k] * c - m_c) * il_c : 0.f;
                    }
                    float a = (p[0] + p[1]) + (p[2] + 0.5f * p[3]), cn = 0.5f * p[3];
                    a += __shfl_xor(a, 1); a += __shfl_xor(a, 2);
                    cn += __shfl_xor(cn, 1); cn += __shfl_xor(cn, 2);
                    const int jb = ((nb + sub * 32) >> 2) + 2 * q4 + h;
                    if (z == 0) { atomicAdd(&impw[ql * 64 + jb], a); if (jb + 1 < 64) atomicAdd(&impw[ql * 64 + jb + 1], cn); }
                }
            }
        }
        {
            __builtin_amdgcn_wave_barrier();
#pragma unroll 1
            for (int qq = 0; qq < 8; ++qq) {
                const int j = lane;
                const float imp = impw[qq * 64 + j];
                const float score = (j > qblk) ? -1.f : ((j == 0 || j == qblk || j == qblk - 1) ? 1e3f : imp);
                scs[j] = score;
                __builtin_amdgcn_wave_barrier();
                int rank = 0;
#pragma unroll 8
                for (int jj = 0; jj < 64; ++jj) { const float o = scs[jj]; rank += (o > score || (o == score && jj < j)) ? 1 : 0; }
                const unsigned long long mk = __ballot(rank < 8 && score >= 0.f);
                if (lane == 0) mskw[qq] = mk;
                __builtin_amdgcn_wave_barrier();
            }
            mymask = mskw[ql];
        }
        for (; i < e3 - 1; ++i) {
            const LAS bf16_t* cur = step(i);
            const bool sel = (mymask >> (i - e2)) & 1ull;
            if (__ballot(sel)) fa_tile<1>(st, qf, cur, cur + 4096, r, h, c, sel, [=](int) { return true; });
        }
        {
            const LAS bf16_t* cur = step(i);
            const int kb = qblk * 64;
            fa_tile<2>(st, qf, cur, cur + 4096, r, h, c, true, [=](int koff) { return kb + koff <= s; });
            ++i;
            const float l = st.l + __shfl_xor(st.l, 32);
            const float f = g_s / fmaxf(l, 1e-30f);
#pragma unroll
            for (int k = 0; k < 16; ++k) { out0[k] += st.o0[k] * f; out1[k] += st.o1[k] * f; }
            fa_init(st);
        }
        for (; i < e4; ++i) {
            const LAS bf16_t* cur = step(i);
            const int kb = (w0 + i - e3) * 64;
            if (kb >= s_hi - 255 && kb + 63 <= s_lo) fa_tile<0>(st, qf, cur, cur + 4096, r, h, c, true, [=](int) { return true; }); else fa_tile<2>(st, qf, cur, cur + 4096, r, h, c, true, [=](int koff) { const int key = kb + koff; return key <= s && key >= s - 255; });
        }
        {
            const float l = st.l + __shfl_xor(st.l, 32);
            const float f = g_w / fmaxf(l, 1e-30f);
#pragma unroll
            for (int k = 0; k < 16; ++k) { out0[k] += st.o0[k] * f; out1[k] += st.o1[k] * f; }
        }
        bf16_t* o = (bf16_t*)(ws + WS_MIX) + (size_t)t * 1024 + (g * 4 + z) * 64;
#pragma unroll
        for (int g4 = 0; g4 < 4; ++g4) {
            *(u32x2*)(o + 8 * g4 + 4 * h) = cvt4((f32x4){out0[4 * g4], out0[4 * g4 + 1], out0[4 * g4 + 2], out0[4 * g4 + 3]});
            *(u32x2*)(o + 32 + 8 * g4 + 4 * h) = cvt4((f32x4){out1[4 * g4], out1[4 * g4 + 1], out1[4 * g4 + 2], out1[4 * g4 + 3]});
        }
    }
}

DI void phase_glu(const Params& P, unsigned char* smem) {
    unsigned char* ws = P.ws;
    const bf16_t* G5 = (const bf16_t*)(ws + XP_G5);
    const float* gb = P.in[17];
    bool pre = false;
    for (int it = vblock(); it < (NT / 128) * 4; it += gridDim.x) {
        int mt, nt; tile_mn(it, 4, mt, nt);
        const int m0 = mt * 128;
        const bool hn = it + (int)gridDim.x < (NT / 128) * 4;
        int mtn = 0, ntn = 0; if (hn) tile_mn(it + gridDim.x, 4, mtn, ntn);
        auto nextrow = [=](int r) { return G5 + (size_t)(mtn * 128 + r) * 512; };
        auto rowptr = [=](int r) { return G5 + (size_t)(m0 + r) * 512; };
        auto epi = [=](f32x4 (&acc)[4][4], int wr, int wc, int ln) {
            const int fr = ln & 15, fq = ln >> 4;
#pragma unroll
            for (int m = 0; m < 4; ++m) {
                const int row = m0 + wr * 64 + m * 16 + fr;
#pragma unroll
                for (int n = 0; n < 4; ++n) {
                    const int col = nt * 128 + wc * 64 + n * 16 + fq * 4;
                    const f32x4 gv = bf4_to_f(*(const u32x2*)(G5 + (size_t)row * 512 + col)), bb = *(const f32x4*)(gb + col), z = acc[m][n] + bb;
                    *(u32x2*)((bf16_t*)(ws + WS_MIX) + (size_t)row * 1024 + 512 + col) = cvt4((f32x4){gv.x * sigmoidf_(z.x), gv.y * sigmoidf_(z.y), gv.z * sigmoidf_(z.z), gv.w * sigmoidf_(z.w)});
                }
            }
        };
        gemm128s(rowptr, (const bf16_t*)(ws + WS_WGLU) + (size_t)nt * 128 * 512, 512, 512, smem, epi, pre, hn, nextrow, (const bf16_t*)(ws + WS_WGLU) + (size_t)ntn * 128 * 512);
        pre = hn;
    }
}

template <bool RB>
DI void phase_outproj(const Params& P, unsigned char* smem, const float* xres, const bf16_t* xresb, size_t wt_off) {
    unsigned char* ws = P.ws;
    const bf16_t* A = (const bf16_t*)(ws + WS_MIX);
    bf16_t* preb = (bf16_t*)(ws + XP_PRE);
    bool pre = false;
    for (int it = vblock(); it < (NT / 128) * 8; it += gridDim.x) {
        int mt, nt; tile_mn(it, 8, mt, nt);
        const int m0 = mt * 128;
        const bool hn = it + (int)gridDim.x < (NT / 128) * 8;
        int mtn = 0, ntn = 0; if (hn) tile_mn(it + gridDim.x, 8, mtn, ntn);
        auto nextrow = [=](int r) { return A + (size_t)(mtn * 128 + r) * 1024; };
        auto rowptr = [=](int r) { return A + (size_t)(m0 + r) * 1024; };
        auto epi = [=](f32x4 (&acc)[4][4], int wr, int wc, int ln) {
            const int fr = ln & 15, fq = ln >> 4;
#pragma unroll
            for (int m = 0; m < 4; ++m) {
                const size_t base = (size_t)(m0 + wr * 64 + m * 16 + fr) * 1024 + nt * 128 + wc * 64 + fq * 4;
                f32x4 xr[4];
#pragma unroll
                for (int n = 0; n < 4; ++n) xr[n] = RB ? bf4_to_f(*(const u32x2*)(xresb + base + n * 16)) : *(const f32x4*)(xres + base + n * 16);
#pragma unroll
                for (int n = 0; n < 4; ++n) *(u32x2*)(preb + base + n * 16) = cvt4(xr[n] * ALPHA + acc[m][n]);
            }
        };
        gemm128s(rowptr, (const bf16_t*)(ws + wt_off) + (size_t)nt * 128 * 1024, 1024, 1024, smem, epi, pre, hn, nextrow, (const bf16_t*)(ws + wt_off) + (size_t)ntn * 128 * 1024);
        pre = hn;
    }
}

DI void ln_row(float (&v)[16], const float* __restrict__ g, const float* __restrict__ bta, int lane) {
    float s = 0.f;
#pragma unroll
    for (int i = 0; i < 16; ++i) s += v[i];
    const float mu = wave_sum(s) * (1.f / 1024.f);
    float q = 0.f;
#pragma unroll
    for (int i = 0; i < 16; ++i) { v[i] -= mu; q += v[i] * v[i]; }
    const float rstd = rsqrtf(wave_sum(q) * (1.f / 1024.f) + LN_EPS);
#pragma unroll
    for (int j = 0; j < 4; ++j) {
        const float4 gg = *(const float4*)(g + 4 * lane + 256 * j), bb = *(const float4*)(bta + 4 * lane + 256 * j);
        v[4 * j + 0] = v[4 * j + 0] * rstd * gg.x + bb.x; v[4 * j + 1] = v[4 * j + 1] * rstd * gg.y + bb.y;
        v[4 * j + 2] = v[4 * j + 2] * rstd * gg.z + bb.z; v[4 * j + 3] = v[4 * j + 3] * rstd * gg.w + bb.w;
    }
}

DI void phase_ln_router(const Params& P, int layer) {
    unsigned char* ws = P.ws;
    const int lane = threadIdx.x & 63, wave = threadIdx.x >> 6;
    const float* g = P.in[21] + layer * 1024; const float* bta = P.in[22] + layer * 1024;
    const float* wc = (const float*)(ws + WS_RTRW) + (size_t)layer * 36864; const float* bc = P.in[26] + layer * 4;
    const float* wf = wc + 4096; const float* bfn = P.in[28] + layer * 32;
    int* cnt = (int*)(ws + WS_CTL) + layer * 2048;
    int* list = (int*)(ws + WS_LIST2);
    float* wgt = (float*)(ws + WS_WGT);
    bf16_t* xb = (bf16_t*)(ws + WS_ACTB);
    for (int task = blockIdx.x * 4 + wave; task < NT / 16; task += gridDim.x * 4) {
        int my_e = 0; float my_w = 0.f;
        f32x4 wcr[16];
#pragma unroll
        for (int q = 0; q < 16; ++q) wcr[q] = *(const f32x4*)(wc + (q * 64 + lane) * 4);
        const bf16_t* pre = (const bf16_t*)(ws + XP_PRE);
        u32x2 nxb[4];
#pragma unroll
        for (int j = 0; j < 4; ++j) nxb[j] = __builtin_nontemporal_load((const u32x2*)(pre + (size_t)(task * 16) * 1024 + 4 * lane + 256 * j));
#pragma unroll 1
        for (int i = 0; i < 16; ++i) {
            const int t = task * 16 + i;
            float v[16];
#pragma unroll
            for (int j = 0; j < 4; ++j) { const f32x4 nx = bf4_to_f(nxb[j]); v[4 * j] = nx.x; v[4 * j + 1] = nx.y; v[4 * j + 2] = nx.z; v[4 * j + 3] = nx.w; }
            if (i + 1 < 16) {
#pragma unroll
                for (int j = 0; j < 4; ++j) nxb[j] = __builtin_nontemporal_load((const u32x2*)(pre + (size_t)(t + 1) * 1024 + 4 * lane + 256 * j));
            }
            ln_row(v, g, bta, lane);
#pragma unroll
            for (int j = 0; j < 4; ++j) {
                *(u32x2*)(xb + (size_t)t * 1024 + 4 * lane + 256 * j) = cvt4((f32x4){v[4 * j], v[4 * j + 1], v[4 * j + 2], v[4 * j + 3]});
            }
            float lc[4] = {0.f, 0.f, 0.f, 0.f};
#pragma unroll
            for (int j = 0; j < 4; ++j)
#pragma unroll
                for (int k = 0; k < 4; ++k) {
                    const f32x4 w = wcr[j * 4 + k];
                    const float x = v[4 * j + k];
                    lc[0] += x * w.x; lc[1] += x * w.y; lc[2] += x * w.z; lc[3] += x * w.w;
                }
#pragma unroll
            for (int c = 0; c < 4; ++c) lc[c] = wave_sum(lc[c]) + bc[c];
            int gi = 0; float lm = lc[0];
#pragma unroll
            for (int c = 1; c < 4; ++c) if (lc[c] > lm) { lm = lc[c]; gi = c; }
            gi = __builtin_amdgcn_readfirstlane(gi);
            float den = 0.f;
#pragma unroll
            for (int c = 0; c < 4; ++c) den += expf(lc[c] - lm);
            const float gv = 1.f / den;
            float lf[8] = {0.f, 0.f, 0.f, 0.f, 0.f, 0.f, 0.f, 0.f};
            const float* wfg = wf + (size_t)gi * 8192;
#pragma unroll
            for (int j = 0; j < 4; ++j)
#pragma unroll
                for (int k = 0; k < 4; ++k) {
                    const f32x4 w0 = *(const f32x4*)(wfg + (((j * 4 + k) * 2 + 0) * 64 + lane) * 4), w1 = *(const f32x4*)(wfg + (((j * 4 + k) * 2 + 1) * 64 + lane) * 4);
                    const float x = v[4 * j + k];
                    lf[0] += x * w0.x; lf[1] += x * w0.y; lf[2] += x * w0.z; lf[3] += x * w0.w;
                    lf[4] += x * w1.x; lf[5] += x * w1.y; lf[6] += x * w1.z; lf[7] += x * w1.w;
                }
#pragma unroll
            for (int e = 0; e < 8; ++e) lf[e] = wave_sum(lf[e]) + bfn[gi * 8 + e];
            int e1 = 0; float l1 = lf[0];
#pragma unroll
            for (int e = 1; e < 8; ++e) if (lf[e] > l1) { l1 = lf[e]; e1 = e; }
            int e2 = 0; float l2 = -INFINITY;
#pragma unroll
            for (int e = 0; e < 8; ++e) if (e != e1 && lf[e] > l2) { l2 = lf[e]; e2 = e; }
            const float r = expf(l2 - l1);
            if (lane == i) { my_e = gi * 8 + e1; my_w = gv / (1.f + r); }
            if (lane == 16 + i) { my_e = gi * 8 + e2; my_w = gv * r / (1.f + r); }
        }
        if (lane < 32) {
            const int t = task * 16 + (lane & 15), k = lane >> 4, slot = (task & 63) * 32 + my_e;
            const int pos = atomicAdd(&cnt[slot], 1);
            list[(slot << 10) + pos] = t * 2 + k;
            wgt[t * 2 + k] = my_w;
        }
    }
}

constexpr int MOE_LDS_TAB = 65536;
constexpr int MOE_LDS_ROW = 65536 + 8448;
DI void moe_tables(const int* cnt, unsigned char* smem) {
    int* tab = (int*)(smem + MOE_LDS_TAB);
    if (threadIdx.x < 32) { const int e = threadIdx.x; int run = 0; for (int s = 0; s < 64; ++s) { tab[e * 65 + s] = run; run += cnt[s * 32 + e]; } tab[e * 65 + 64] = run; }
    __syncthreads();
}
DI bool moe_tile(const int* tab, int tile, int& e, int& mt, int& off, int& ce) {
    int acc_t = 0, acc_r = 0;
    for (int i = 0; i < 32; ++i) {
        const int c = tab[i * 65 + 64], nt = (c + 127) >> 7;
        if (tile < acc_t + nt) { e = i; mt = tile - acc_t; off = acc_r; ce = c; return true; }
        acc_t += nt; acc_r += c;
    }
    return false;
}
DI int moe_ntiles(const int* tab) { int a = 0; for (int i = 0; i < 32; ++i) a += (tab[i * 65 + 64] + 127) >> 7; return a; }
DI void moe_rows(const int* tab, const int* list, int e, int mt, int ce, int* rowidx) {
    if (threadIdx.x < 128) {
        const int pos = mt * 128 + threadIdx.x;
        int idx = -1;
        if (pos < ce) {
            int lo = 0, hi = 64;
            while (hi - lo > 1) { const int mid = (lo + hi) >> 1; if (tab[e * 65 + mid] <= pos) lo = mid; else hi = mid; }
            idx = list[((lo * 32 + e) << 10) + pos - tab[e * 65 + lo]];
        }
        rowidx[threadIdx.x] = idx;
    }
    __syncthreads();
}

DI void phase_moe_gu(const Params& P, unsigned char* smem, int layer) {
    unsigned char* ws = P.ws;
    const int* cnt = (const int*)(ws + WS_CTL) + layer * 2048;
    const int* list = (const int*)(ws + WS_LIST2);
    const float* wgt = (const float*)(ws + WS_WGT);
    const bf16_t* xb = (const bf16_t*)(ws + WS_ACTB);
    bf16_t* H = (bf16_t*)(ws + XP_H);
    const int* tab = (const int*)(smem + MOE_LDS_TAB);
    int* rowidx = (int*)(smem + MOE_LDS_ROW);
    moe_tables(cnt, smem);
    const int ntile = moe_ntiles(tab);
    for (int it = vblock(); it < ntile * 2; it += gridDim.x) {
        int e, mt, off, ce; moe_tile(tab, it >> 1, e, mt, off, ce);
        const int nt = it & 1;
        moe_rows(tab, list, e, mt, ce, rowidx);
        auto rowptr = [=](int r) { int idx = rowidx[r]; idx = idx < 0 ? rowidx[0] : idx; return xb + (size_t)(idx >> 1) * 1024; };
        auto epi = [=](f32x4 (&acc)[4][4], int wr, int wc, int ln) {
            const int fr = ln & 15, fq = ln >> 4;
#pragma unroll
            for (int m = 0; m < 4; ++m) {
                const int rl = wr * 64 + m * 16 + fr, idx = rowidx[rl];
                if (idx >= 0) {
                    const float w = wgt[idx];
#pragma unroll
                    for (int n = 0; n < 2; ++n) {
                        const f32x4 gte = acc[m][n], up = acc[m][n + 2];
                        *(u32x2*)(H + (size_t)(off + mt * 128 + rl) * 128 + (nt * 2 + wc) * 32 + n * 16 + fq * 4) =
                            cvt4((f32x4){gte.x * sigmoidf_(gte.x) * up.x * w, gte.y * sigmoidf_(gte.y) * up.y * w, gte.z * sigmoidf_(gte.z) * up.z * w, gte.w * sigmoidf_(gte.w) * up.w * w});
                    }
                }
            }
        };
        gemm128(rowptr, (const bf16_t*)(ws + WS_WGU) + ((size_t)(layer * 32 + e) * 256 + nt * 128) * 1024, 1024, 1024, smem, epi);
        __syncthreads();
    }
}
DI void phase_moe_down(const Params& P, unsigned char* smem, int layer) {
    unsigned char* ws = P.ws;
    const int* cnt = (const int*)(ws + WS_CTL) + layer * 2048;
    const int* list = (const int*)(ws + WS_LIST2);
    const bf16_t* H = (const bf16_t*)(ws + XP_H);
    bf16_t* YB = (bf16_t*)(ws + XP_YB);
    const int* tab = (const int*)(smem + MOE_LDS_TAB);
    int* rowidx = (int*)(smem + MOE_LDS_ROW);
    moe_tables(cnt, smem);
    const int ntile = moe_ntiles(tab);
    for (int it = vblock(); it < ntile * 8; it += gridDim.x) {
        int e, mt, off, ce; moe_tile(tab, it >> 3, e, mt, off, ce);
        const int nt = it & 7;
        moe_rows(tab, list, e, mt, ce, rowidx);
        auto rowptr = [=](int r) { int pos = mt * 128 + r; pos = pos < ce ? pos : 0; return H + (size_t)(off + pos) * 128; };
        auto epi = [=](f32x4 (&acc)[4][4], int wr, int wc, int ln) {
            const int fr = ln & 15, fq = ln >> 4;
#pragma unroll
            for (int m = 0; m < 4; ++m) {
                const int idx = rowidx[wr * 64 + m * 16 + fr];
                if (idx >= 0) {
                    bf16_t* dst = YB + (size_t)idx * 1024 + nt * 128 + wc * 64 + fq * 4;
#pragma unroll
                    for (int n = 0; n < 4; ++n) *(u32x2*)(dst + n * 16) = cvt4(acc[m][n]);
                }
            }
        };
        gemm128(rowptr, (const bf16_t*)(ws + WS_WDN) + ((size_t)(layer * 32 + e) * 1024 + nt * 128) * 128, 128, 128, smem, epi);
        __syncthreads();
    }
}
DI void phase_ln_ffn(const Params& P, int layer) {
    unsigned char* ws = P.ws;
    const int lane = threadIdx.x & 63, wave = threadIdx.x >> 6;
    const float* g = P.in[23] + layer * 1024; const float* bta = P.in[24] + layer * 1024;
    const bf16_t* YB = (const bf16_t*)(ws + XP_YB);
    bf16_t* xb = (bf16_t*)(ws + WS_ACTB);
    for (int task = blockIdx.x * 4 + wave; task < NT / 16; task += gridDim.x * 4) {
        u32x2 nxm[4], ny0[4], ny1[4];
        auto fetch = [&](int t) {
#pragma unroll
            for (int j = 0; j < 4; ++j) {
                nxm[j] = __builtin_nontemporal_load((const u32x2*)(xb + (size_t)t * 1024 + 4 * lane + 256 * j));
                ny0[j] = __builtin_nontemporal_load((const u32x2*)(YB + (size_t)(2 * t) * 1024 + 4 * lane + 256 * j));
                ny1[j] = __builtin_nontemporal_load((const u32x2*)(YB + (size_t)(2 * t + 1) * 1024 + 4 * lane + 256 * j));
            }
        };
        fetch(task * 16);
#pragma unroll 1
        for (int i = 0; i < 16; ++i) {
            const int t = task * 16 + i;
            float v[16];
#pragma unroll
            for (int j = 0; j < 4; ++j) {
                const f32x4 a = bf4_to_f(nxm[j]), y0 = bf4_to_f(ny0[j]), y1 = bf4_to_f(ny1[j]);
                v[4 * j + 0] = ALPHA * a.x + (y0.x + y1.x); v[4 * j + 1] = ALPHA * a.y + (y0.y + y1.y);
                v[4 * j + 2] = ALPHA * a.z + (y0.z + y1.z); v[4 * j + 3] = ALPHA * a.w + (y0.w + y1.w);
            }
            if (i + 1 < 16) fetch(t + 1);
            ln_row(v, g, bta, lane);
            float* row = P.out + (size_t)t * 1024;
#pragma unroll
            for (int j = 0; j < 4; ++j) {
                if (layer == 0) *(u32x2*)((bf16_t*)P.out + (size_t)t * 1024 + 4 * lane + 256 * j) = cvt4((f32x4){v[4 * j], v[4 * j + 1], v[4 * j + 2], v[4 * j + 3]});
                else *(f32x4*)(row + 4 * lane + 256 * j) = (f32x4){v[4 * j], v[4 * j + 1], v[4 * j + 2], v[4 * j + 3]};
            }
        }
    }
}

DI void phase_inproj1(const Params& P, unsigned char* smem) {
    unsigned char* ws = P.ws;
    const bf16_t* A = (const bf16_t*)P.out;
    const float* cosT = (const float*)(ws + WS_ROPE);
    const float* sinT = cosT + 4096 * 32;
    bool pre = false;
    for (int it = vblock(); it < (NT / 128) * 24; it += gridDim.x) {
        int mt, nt; tile_mn(it, 24, mt, nt);
        const int m0 = mt * 128;
        auto rowptr = [=](int r) { return A + (size_t)(m0 + r) * 1024; };
        const bf16_t* Bt = (const bf16_t*)(ws + WS_WIN1) + (size_t)nt * 128 * 1024;
        const bool hn = it + (int)gridDim.x < (NT / 128) * 24;
        int mtn = 0, ntn = 0; if (hn) tile_mn(it + gridDim.x, 24, mtn, ntn);
        auto nextrow = [=](int r) { return A + (size_t)(mtn * 128 + r) * 1024; };
        const bf16_t* nBt = (const bf16_t*)(ws + WS_WIN1) + (size_t)ntn * 128 * 1024;
        if (nt >= 16) {
            auto epi = [=](f32x4 (&acc)[4][4], int wr, int wc, int lane) {
                const int head = (nt * 2 + wc) & 15, fr = lane & 15, fq = lane >> 4;
#pragma unroll
                for (int m = 0; m < 4; ++m) {
                    const int t = m0 + wr * 64 + m * 16 + fq * 4, s = t & 4095, b = t >> 12;
                    bf16_t* base = (bf16_t*)(ws + XP_Q1 + (size_t)2 * 64 * MiB) + (size_t)(b * 16 + head) * 4096 * 64;
#pragma unroll
                    for (int n = 0; n < 4; ++n) *(u32x2*)(base + vp_off(s, n * 16 + fr)) = cvt4(acc[m][n]);
                }
            };
            gemm128s<false>(rowptr, Bt, 1024, 1024, smem, epi, pre, hn, nextrow, nBt);
            pre = hn;
            continue;
        }
        auto epi = [=](f32x4 (&acc)[4][4], int wr, int wc, int lane) {
            const int u64 = nt * 2 + wc, kind = u64 >> 4, head = u64 & 15, fr = lane & 15, fq = lane >> 4;
            f32x4 cs[2][2];
#pragma unroll
            for (int n2 = 0; n2 < 2; ++n2) { cs[n2][0] = (f32x4){0.f, 0.f, 0.f, 0.f}; cs[n2][1] = cs[n2][0]; }
#pragma unroll
            for (int m = 0; m < 4; ++m) {
                const int t = m0 + wr * 64 + m * 16 + fr, s = t & 4095, b = t >> 12;
                bf16_t* base = (bf16_t*)(ws + XP_Q1 + (size_t)kind * 64 * MiB) + (size_t)(b * 16 + head) * 4096 * 64;
#pragma unroll
                for (int n2 = 0; n2 < 2; ++n2) {
                    const int i = n2 * 16 + fq * 4;
                    const f32x4 c = *(const f32x4*)(cosT + s * 32 + i), sn = *(const f32x4*)(sinT + s * 32 + i);
                    const f32x4 x1 = acc[m][2 * n2], x2 = acc[m][2 * n2 + 1];
                    const f32x4 r1 = x1 * c - x2 * sn, r2 = x1 * sn + x2 * c;
                    const u32x2 o1 = cvt4(r1), o2 = cvt4(r2);
                    if (kind == 0) { *(u32x2*)(base + (size_t)s * 64 + i) = o1; *(u32x2*)(base + (size_t)s * 64 + i + 32) = o2; }
                    else { *(u32x2*)(base + kp_off(s, i)) = o1; *(u32x2*)(base + kp_off(s, i + 32)) = o2; cs[n2][0] += r1; cs[n2][1] += r2; }
                }
            }
            if (kind == 1) {
                const int t0 = m0 + wr * 64, bh = (t0 >> 12) * 16 + head, seg = (t0 & 4095) >> 6;
                float* dst = (float*)(ws + WS_KMP) + ((size_t)bh * 64 + seg) * 64;
#pragma unroll
                for (int n2 = 0; n2 < 2; ++n2)
#pragma unroll
                    for (int hf = 0; hf < 2; ++hf) {
                        f32x4 v = cs[n2][hf];
#pragma unroll
                        for (int k = 0; k < 4; ++k) { float x = v[k]; x += dpp_f<0xB1>(x); x += dpp_f<0x4E>(x); x += dpp_f<0x141>(x); x += dpp_f<0x140>(x); v[k] = x; }
                        if (fr == 0) *(f32x4*)(dst + n2 * 16 + fq * 4 + hf * 32) = v;
                    }
            }
        };
        gemm128s(rowptr, Bt, 1024, 1024, smem, epi, pre, hn, nextrow, nBt);
        pre = hn;
    }
}
DI void moba_kmeans_slab(const Params& P, bf16_t* kml, int bh, int tid) {
    const float* kp = (const float*)(P.ws + WS_KMP) + (size_t)bh * 64 * 64;
    for (int e = tid; e < 2048; e += 256) {
        const int d = e & 63, n = e >> 6;
        float a = 0.f;
        if (n < 16) a = ((kp[(4 * n) * 64 + d] + kp[(4 * n + 1) * 64 + d]) + (kp[(4 * n + 2) * 64 + d] + kp[(4 * n + 3) * 64 + d])) * (1.f / 256.f);
        kml[((d >> 4) * 32 + n) * 16 + (d & 15)] = f2bf(a);
    }
}
DI unsigned moba_gate_rows(const bf16_t* km, const bf16x8 (&qf)[4], int own, int r, int h) {
    f32x16 g;
#pragma unroll
    for (int i = 0; i < 16; ++i) g[i] = 0.f;
#pragma unroll
    for (int ks = 0; ks < 4; ++ks) g = MFMA32(*(const bf16x8*)(km + (ks * 32 + r) * 16 + 8 * h), qf[ks], g);
    float mine[8], oth[8];
#pragma unroll
    for (int i = 0; i < 8; ++i) { const int n = (i & 3) + 8 * (i >> 2) + 4 * h; mine[i] = n < own ? g[i] : -INFINITY; oth[i] = __shfl_xor(mine[i], 32); }
    unsigned selmask = 0;
#pragma unroll
    for (int i = 0; i < 8; ++i) {
        const int n = (i & 3) + 8 * (i >> 2) + 4 * h;
        int rank = 0;
#pragma unroll
        for (int k = 0; k < 8; ++k) {
            const int nk = (k & 3) + 8 * (k >> 2) + 4 * h, no = (k & 3) + 8 * (k >> 2) + 4 * (1 - h);
            rank += (mine[k] > mine[i] || (mine[k] == mine[i] && nk < n)) ? 1 : 0;
            rank += (oth[k] > mine[i] || (oth[k] == mine[i] && no < n)) ? 1 : 0;
        }
        if (n < own && rank < 3) selmask |= 1u << n;
    }
    return selmask | __shfl_xor(selmask, 32);
}
DI void phase_moba_gate(const Params& P, unsigned char* smem) {
    unsigned char* ws = P.ws;
    const int tid = threadIdx.x, lane = tid & 63, wave = tid >> 6, r = lane & 31, h = lane >> 5;
    bf16_t* kml = (bf16_t*)smem;
    unsigned short* smask = (unsigned short*)(smem + 4096);
    unsigned short* selm = (unsigned short*)(ws + WS_SELM);
    unsigned short* mcnt = (unsigned short*)(ws + WS_MCNT);
    unsigned char* mlist = ws + WS_MLIST;
    int km_bh = -1;
    for (int it = blockIdx.x; it < 2048; it += gridDim.x) {
        const int bh = it & 127, qb = it >> 7;
        if (bh != km_bh) { km_bh = bh; __syncthreads(); moba_kmeans_slab(P, kml, bh, tid); }
        __syncthreads();
#pragma unroll 1
        for (int g2 = 0; g2 < 2; ++g2) {
            const int rl = wave * 64 + g2 * 32 + r, q = qb * 256 + rl;
            const bf16_t* Qg = (const bf16_t*)(ws + XP_Q1) + ((size_t)bh * 4096 + q) * 64;
            bf16x8 qf[4];
#pragma unroll
            for (int ks = 0; ks < 4; ++ks) qf[ks] = *(const bf16x8*)(Qg + ks * 16 + 8 * h);
            const unsigned sm = qb > 0 ? moba_gate_rows(kml, qf, qb, r, h) : 0u;
            if (h == 0) { selm[(size_t)bh * 4096 + q] = (unsigned short)sm; smask[rl] = (unsigned short)sm; }
        }
        __syncthreads();
        for (int n = wave; n < qb; n += 4) {
            unsigned char* lp = mlist + ((size_t)(bh * 16 + qb) * 16 + n) * 256;
            int base = 0;
#pragma unroll
            for (int c4 = 0; c4 < 4; ++c4) {
                const int row = c4 * 64 + lane;
                const bool bit = (smask[row] >> n) & 1;
                const unsigned long long bal = __ballot(bit);
                if (bit) lp[base + __builtin_popcountll(bal & ((1ull << lane) - 1ull))] = (unsigned char)row;
                base += __builtin_popcountll(bal);
            }
            if (lane == 0) mcnt[(bh * 16 + qb) * 16 + n] = (unsigned short)base;
        }
    }
}
DI bf16_t* moba_po(const Params& P, int slot) { return (bf16_t*)(P.ws + (slot == 0 ? WS_MIX : slot == 1 ? WS_ACTB : WS_PO2)); }
DI void phase_moba_kv(const Params& P, unsigned char* smem) {
    unsigned char* ws = P.ws;
    const int tid = threadIdx.x, lane = tid & 63, wave = tid >> 6, r = lane & 31, h = lane >> 5;
    const float c = 0.125f * 1.4426950408889634f;
    LAS unsigned char* lds = (LAS unsigned char*)smem;
    const unsigned short* selm = (const unsigned short*)(ws + WS_SELM);
    const unsigned short* mcnt = (const unsigned short*)(ws + WS_MCNT);
    const unsigned char* mlist = ws + WS_MLIST;
    float* pml = (float*)(ws + WS_PML);
    const bool bal = (gridDim.x == 512);
    const int nit = bal ? ((blockIdx.x >> 7) == 3 ? 3 : 4) : (1920 + (int)gridDim.x - 1 - (int)blockIdx.x) / (int)gridDim.x;
    for (int iti = 0; iti < nit; ++iti) {
        int bh, n;
        if (bal) { const int gq = blockIdx.x >> 7; bh = blockIdx.x & 127; const int tab = gq == 0 ? 0x0DA90 : gq == 1 ? 0x0CB61 : gq == 2 ? 0x0E852 : 0x00743; n = (tab >> (4 * iti)) & 15; }
        else { const int it = blockIdx.x + iti * gridDim.x; n = it >> 7; bh = it & 127; }
        const bf16_t* Kg = (const bf16_t*)(ws + XP_Q1 + 64 * MiB) + (size_t)bh * 4096 * 64 + (size_t)n * 4 * 4096;
        const bf16_t* Vg = (const bf16_t*)(ws + XP_Q1 + 128 * MiB) + (size_t)bh * 4096 * 64 + (size_t)n * 4 * 4096;
        asm volatile("s_waitcnt vmcnt(0)" ::: "memory");
        __builtin_amdgcn_s_barrier();
#pragma unroll
        for (int j = 0; j < 4; ++j) fa_issue(Kg + (size_t)j * 4096, Vg + (size_t)j * 4096, lds + j * 16384, tid);
        const int cntv = (lane < 16 && lane > n) ? (int)mcnt[(bh * 16 + lane) * 16 + n] : 0;
        asm volatile("s_waitcnt vmcnt(0)" ::: "memory");
        __builtin_amdgcn_s_barrier();
        asm volatile("" ::: "memory");
        int prefv = 0, total = 0;
#pragma unroll 1
        for (int qb = 0; qb < 16; ++qb) { if (lane == qb) prefv = total; total += __builtin_amdgcn_readlane(cntv, qb); }
#pragma unroll 1
        for (int v0 = wave * 32; v0 < total; v0 += 128) {
            const int v = v0 + r;
            const bool valid = v < total;
            const int vv = valid ? v : v0;
            int qb = n + 1;
#pragma unroll 1
            for (int l = n + 2; l < 16; ++l) if (vv >= __builtin_amdgcn_readlane(prefv, l)) qb = l;
            const int idx = vv - __shfl(prefv, qb);
            const int q = qb * 256 + (int)mlist[((size_t)(bh * 16 + qb) * 16 + n) * 256 + idx];
            const bf16_t* Qg = (const bf16_t*)(ws + XP_Q1) + ((size_t)bh * 4096 + q) * 64;
            bf16x8 qf[4];
#pragma unroll
            for (int ks = 0; ks < 4; ++ks) qf[ks] = *(const bf16x8*)(Qg + ks * 16 + 8 * h);
            FA st; fa_init(st);
#pragma unroll 1
            for (int j = 0; j < 4; ++j) {
                const LAS bf16_t* cur = (const LAS bf16_t*)(lds + j * 16384);
                fa_tile<0>(st, qf, cur, cur + 4096, r, h, c, true, [=](int) { return true; });
            }
            const float l = st.l + __shfl_xor(st.l, 32);
            const float inv = 1.f / fmaxf(l, 1e-30f);
            if (valid) {
                const int slot = __builtin_popcount((unsigned)selm[(size_t)bh * 4096 + q] & ((1u << n) - 1u));
                bf16_t* o = moba_po(P, slot) + ((size_t)(bh >> 4) * 4096 + q) * 1024 + (bh & 15) * 64;
#pragma unroll
                for (int g4 = 0; g4 < 4; ++g4) {
                    *(u32x2*)(o + 8 * g4 + 4 * h) = cvt4((f32x4){st.o0[4 * g4] * inv, st.o0[4 * g4 + 1] * inv, st.o0[4 * g4 + 2] * inv, st.o0[4 * g4 + 3] * inv});
                    *(u32x2*)(o + 32 + 8 * g4 + 4 * h) = cvt4((f32x4){st.o1[4 * g4] * inv, st.o1[4 * g4 + 1] * inv, st.o1[4 * g4 + 2] * inv, st.o1[4 * g4 + 3] * inv});
                }
                if (h == 0) { float* pm = pml + (((size_t)bh * 4096 + q) * 3 + slot) * 2; pm[0] = st.m; pm[1] = l; }
            }
        }
    }
}
DI void phase_moba_own(const Params& P, unsigned char* smem) {
    unsigned char* ws = P.ws;
    const int tid = threadIdx.x, lane = tid & 63, wave = tid >> 6, r = lane & 31, h = lane >> 5;
    const float c = 0.125f * 1.4426950408889634f;
    LAS unsigned char* lds = (LAS unsigned char*)smem;
    const unsigned short* selm = (const unsigned short*)(ws + WS_SELM);
    const float* pml = (const float*)(ws + WS_PML);
    for (int it = blockIdx.x; it < 2048; it += gridDim.x) {
        const int own = 15 - (it >> 7), bh = it & 127, t0 = own * 256;
        const bf16_t* Kg = (const bf16_t*)(ws + XP_Q1 + 64 * MiB) + (size_t)bh * 4096 * 64 + (size_t)own * 4 * 4096;
        const bf16_t* Vg = (const bf16_t*)(ws + XP_Q1 + 128 * MiB) + (size_t)bh * 4096 * 64 + (size_t)own * 4 * 4096;
        asm volatile("s_waitcnt vmcnt(0)" ::: "memory");
        __builtin_amdgcn_s_barrier();
#pragma unroll
        for (int j = 0; j < 4; ++j) fa_issue(Kg + (size_t)j * 4096, Vg + (size_t)j * 4096, lds + j * 16384, tid);
        asm volatile("s_waitcnt vmcnt(0)" ::: "memory");
        __builtin_amdgcn_s_barrier();
        asm volatile("" ::: "memory");
#pragma unroll 1
        for (int g2 = 0; g2 < 2; ++g2) {
            const int row0 = t0 + g2 * 128 + wave * 32, q = row0 + r;
            const bf16_t* Qg = (const bf16_t*)(ws + XP_Q1) + ((size_t)bh * 4096 + q) * 64;
            bf16x8 qf[4];
#pragma unroll
            for (int ks = 0; ks < 4; ++ks) qf[ks] = *(const bf16x8*)(Qg + ks * 16 + 8 * h);
            const int nsel = __builtin_popcount((unsigned)selm[(size_t)bh * 4096 + q]);
            const size_t orow = ((size_t)(bh >> 4) * 4096 + q) * 1024 + (bh & 15) * 64;
            const float* pm = pml + ((size_t)bh * 4096 + q) * 6;
            float mi[3], li[3];
            u32x2 pa[3][8];
#pragma unroll
            for (int i = 0; i < 3; ++i) {
                mi[i] = i < nsel ? pm[2 * i] : -INFINITY; li[i] = i < nsel ? pm[2 * i + 1] : 0.f;
                const bf16_t* po = moba_po(P, i) + orow;
#pragma unroll
                for (int g4 = 0; g4 < 4; ++g4) {
                    pa[i][2 * g4] = i < nsel ? *(const u32x2*)(po + 8 * g4 + 4 * h) : (u32x2){0u, 0u};
                    pa[i][2 * g4 + 1] = i < nsel ? *(const u32x2*)(po + 32 + 8 * g4 + 4 * h) : (u32x2){0u, 0u};
                }
            }
            FA st; fa_init(st);
            const int jmax = (row0 + 31 - t0) >> 6;
#pragma unroll 1
            for (int j = 0; j <= jmax; ++j) {
                const LAS bf16_t* cur = (const LAS bf16_t*)(lds + j * 16384);
                const int kbase = t0 + j * 64;
                if (kbase + 63 <= row0) fa_tile<0>(st, qf, cur, cur + 4096, r, h, c, true, [=](int) { return true; });
                else fa_tile<2>(st, qf, cur, cur + 4096, r, h, c, true, [=](int koff) { return kbase + koff <= q; });
            }
            const float l_own = st.l + __shfl_xor(st.l, 32);
            const float M = fmaxf(fmaxf(st.m, mi[0]), fmaxf(mi[1], mi[2]));
            const float wo = __builtin_amdgcn_exp2f(st.m - M);
            float L = l_own * wo;
#pragma unroll
            for (int k = 0; k < 16; ++k) { st.o0[k] *= wo; st.o1[k] *= wo; }
#pragma unroll
            for (int i = 0; i < 3; ++i) {
                const float wi = li[i] * __builtin_amdgcn_exp2f(mi[i] - M);
                L += wi;
#pragma unroll
                for (int g4 = 0; g4 < 4; ++g4) {
                    const f32x4 a = bf4_to_f(pa[i][2 * g4]), b2 = bf4_to_f(pa[i][2 * g4 + 1]);
                    st.o0[4 * g4] += wi * a.x; st.o0[4 * g4 + 1] += wi * a.y; st.o0[4 * g4 + 2] += wi * a.z; st.o0[4 * g4 + 3] += wi * a.w;
                    st.o1[4 * g4] += wi * b2.x; st.o1[4 * g4 + 1] += wi * b2.y; st.o1[4 * g4 + 2] += wi * b2.z; st.o1[4 * g4 + 3] += wi * b2.w;
                }
            }
            const float inv = 1.f / fmaxf(L, 1e-30f);
            bf16_t* o = (bf16_t*)(ws + WS_MIX) + orow;
#pragma unroll
            for (int g4 = 0; g4 < 4; ++g4) {
                *(u32x2*)(o + 8 * g4 + 4 * h) = cvt4((f32x4){st.o0[4 * g4] * inv, st.o0[4 * g4 + 1] * inv, st.o0[4 * g4 + 2] * inv, st.o0[4 * g4 + 3] * inv});
                *(u32x2*)(o + 32 + 8 * g4 + 4 * h) = cvt4((f32x4){st.o1[4 * g4] * inv, st.o1[4 * g4 + 1] * inv, st.o1[4 * g4 + 2] * inv, st.o1[4 * g4 + 3] * inv});
            }
        }
    }
}

constexpr int SMEM_BYTES = 65536 + 8192 + 1024 + 512;
static_assert(SMEM_BYTES >= 128 * 129 * 4 && SMEM_BYTES >= MOE_LDS_ROW + 512 && SMEM_BYTES >= NSA_LDS_MSK + 256, "LDS map");
constexpr int SMEM_OLD = 128 * 129 * 4;
typedef __attribute__((address_space(1))) unsigned gu32;
#define XB_TMO      128
#define XB_XCNT(j)  (256  + 64 * (j))
#define XB_XSUB(j)  (1280 + 64 * (j))
#define XB_XGEN(j)  (2304 + 64 * (j))
#define XB_TOP      3328
#define XB_TOPGEN   3392
#define XCD_BAR_WORDS 3456
#define XB_SPIN_CAP (1u << 18)

__device__ __forceinline__ unsigned xb_ld(unsigned* p)              { return __hip_atomic_load(p, __ATOMIC_RELAXED, __HIP_MEMORY_SCOPE_AGENT); }
__device__ __forceinline__ unsigned xb_add(unsigned* p, unsigned v) { return __hip_atomic_fetch_add(p, v, __ATOMIC_RELAXED, __HIP_MEMORY_SCOPE_AGENT); }
__device__ __forceinline__ unsigned xb_xcc_id() { return (unsigned)__builtin_amdgcn_s_getreg((3 << 11) | 20) & 0xFu; }
#define XB_SPIN(cond, bar) do { unsigned _sp = 0; while (cond) { __builtin_amdgcn_s_sleep(1); \
    if ((++_sp & 255u) == 0u) { if (xb_ld(&(bar)[XB_TMO])) break; if (_sp > XB_SPIN_CAP) { atomicAdd(&(bar)[XB_TMO], 1u); break; } } } } while (0)

struct XcdBarrier {
    unsigned* bar; unsigned x;
    volatile LAS unsigned* st;
};

__device__ __forceinline__ XcdBarrier xcd_barrier_post(unsigned* bar, volatile LAS unsigned* st) {
    XcdBarrier b; b.bar = bar; b.x = xb_xcc_id(); b.st = st;
    if (threadIdx.x == 0) (void)xb_add(&bar[XB_XCNT(b.x)], 1u);
    return b;
}
__device__ __forceinline__ void xcd_barrier_complete(unsigned* bar, unsigned x, unsigned& nloc, unsigned& nx) {
    const unsigned G = gridDim.x * gridDim.y * gridDim.z;
    unsigned sum, cnt, mine, sp = 0u;
    for (;;) {
        sum = 0u; cnt = 0u; mine = 0u;
#pragma unroll
        for (unsigned j = 0; j < 16; ++j) { const unsigned c = xb_ld(&bar[XB_XCNT(j)]); sum += c; cnt += (c > 0u) ? 1u : 0u; mine = (j == x) ? c : mine; }
        if (sum == G) break;
        __builtin_amdgcn_s_sleep(1);
        if ((++sp & 255u) == 0u) { if (xb_ld(&bar[XB_TMO])) break; if (sp > XB_SPIN_CAP) { atomicAdd(&bar[XB_TMO], 1u); break; } }
    }
    nloc = mine > 0u ? mine : 1u; nx = cnt > 0u ? cnt : 1u;
}

__device__ __forceinline__ void xcd_barrier(const XcdBarrier& b) {
    asm volatile("s_waitcnt vmcnt(0)" ::: "memory");
    __syncthreads();
    if (threadIdx.x == 0) {
        unsigned* bar = b.bar;
        __builtin_amdgcn_s_waitcnt(0);
        unsigned nloc = b.st[0], nx = b.st[1];
        if (nloc == 0u) { xcd_barrier_complete(bar, b.x, nloc, nx); b.st[0] = nloc; b.st[1] = nx; }
        const unsigned old = xb_add(&bar[XB_XSUB(b.x)], 1u);
        const unsigned gen = old / nloc;
        if (old + 1u == (gen + 1u) * nloc) {
            __builtin_amdgcn_fence(__ATOMIC_RELEASE, "agent");
            asm volatile("s_waitcnt vmcnt(0)" ::: "memory");
            const unsigned og = xb_add(&bar[XB_TOP], 1u);
            const unsigned tg = og / nx;
            if (og + 1u == (tg + 1u) * nx) xb_add(&bar[XB_TOPGEN], 1u);
            else XB_SPIN(xb_ld(&bar[XB_TOPGEN]) == tg, bar);
            __builtin_amdgcn_fence(__ATOMIC_ACQUIRE, "agent");
            xb_add(&bar[XB_XGEN(b.x)], 1u);
            asm volatile("s_waitcnt vmcnt(0)" ::: "memory");
        } else {
            XB_SPIN(xb_ld(&bar[XB_XGEN(b.x)]) == gen, bar);
            __builtin_amdgcn_fence(__ATOMIC_ACQUIRE, "agent");
            asm volatile("s_waitcnt vmcnt(0)" ::: "memory");
        }
    }
    __syncthreads();
}

constexpr size_t CTL_BAR = 16384;
constexpr size_t CTL_BYTES = 32768;

#define PHASE(k, call) if (P.ph_lo <= (k) && (k) < P.ph_hi) { call; if ((k) + 1 < P.ph_hi) xcd_barrier(xb); }
__global__ void __launch_bounds__(256, 2) mega(Params P) {
    __shared__ __attribute__((aligned(16))) unsigned char smem[SMEM_BYTES + 16];
    unsigned* xbst = (unsigned*)(smem + SMEM_BYTES);
    cg::grid_group grid = cg::this_grid();
    if (threadIdx.x < 4) xbst[threadIdx.x] = 0u;
    __syncthreads();
    if (P.ph_lo < 0) grid.sync();
    XcdBarrier xb = xcd_barrier_post((unsigned*)(P.ws + WS_CTL + CTL_BAR), (volatile LAS unsigned*)xbst);
    PHASE(0, phase0(P, smem))
    PHASE(1, phase_inproj0(P, smem))
    PHASE(2, phase_cmp_s5e(P, smem))
    PHASE(3, phase_glu(P, smem); phase_nsa(P, smem))
    PHASE(6, phase_outproj<false>(P, smem, P.in[0], nullptr, WS_WOUT0))
    PHASE(7, phase_ln_router(P, 0))
    PHASE(8, phase_moe_gu(P, smem, 0))
    PHASE(9, phase_moe_down(P, smem, 0))
    PHASE(10, phase_ln_ffn(P, 0))
    PHASE(11, phase_inproj1(P, smem))
    PHASE(12, phase_moba_gate(P, smem))
    PHASE(13, phase_moba_kv(P, smem))
    PHASE(14, phase_moba_own(P, smem))
    PHASE(15, phase_outproj<true>(P, smem, nullptr, (const bf16_t*)P.out, WS_WOUT1))
    PHASE(16, phase_ln_router(P, 1))
    PHASE(17, phase_moe_gu(P, smem, 1))
    PHASE(18, phase_moe_down(P, smem, 1))
    PHASE(20, phase_ln_ffn(P, 1))
}

extern "C" void kernel_launch(void* const* d_in, const int* in_sizes, int n_in, void* d_out, int out_size, void* d_ws, size_t ws_size, hipStream_t stream) {
    static int grid = 0;
    if (grid == 0) {
        if (n_in != 32 || out_size != NT * DM || ws_size < WS_END) { fprintf(stderr, "kernel_launch: unexpected shapes (n_in %d, out %d, ws %zu)\n", n_in, out_size, ws_size); grid = -1; return; }
        int dev = 0, cus = 0, per_cu = 0;
        (void)hipGetDevice(&dev);
        (void)hipDeviceGetAttribute(&cus, hipDeviceAttributeMultiprocessorCount, dev);
        (void)hipOccupancyMaxActiveBlocksPerMultiprocessor(&per_cu, mega, 256, 0);
        if (per_cu < 1) per_cu = 1;
        if (per_cu > 2) per_cu = 2;
        grid = cus * per_cu;
    }
    if (grid < 0) return;
    (void)hipMemsetAsync((char*)d_ws + WS_CTL, 0, CTL_BYTES, stream);
    Params p{};
    for (int i = 0; i < 32; ++i) p.in[i] = (const float*)d_in[i];
    p.out = (float*)d_out; p.ws = (unsigned char*)d_ws;
    p.ph_lo = 0; p.ph_hi = NPH;
    void* args[] = {&p};
    hipError_t e = hipLaunchCooperativeKernel((void*)mega, dim3(grid), dim3(256), args, 0, stream);
    if (e != hipSuccess) fprintf(stderr, "cooperative launch failed: %s (grid %d)\n", hipGetErrorString(e), grid);
}
```

```cpp
#include <hip/hip_runtime.h>
#include <hip/hip_cooperative_groups.h>
#include <cstdio>
#include <cstdint>
namespace cg = cooperative_groups;

typedef unsigned short bf16_t;
typedef short bf16x8 __attribute__((ext_vector_type(8)));
typedef float f32x4 __attribute__((ext_vector_type(4)));
typedef unsigned u32x4 __attribute__((ext_vector_type(4)));
typedef unsigned u32x2 __attribute__((ext_vector_type(2)));
#define DI __device__ __forceinline__
#define LAS __attribute__((address_space(3)))
typedef float f32x16 __attribute__((ext_vector_type(16)));
typedef float f32x8 __attribute__((ext_vector_type(8)));
typedef __bf16 bf16x8v __attribute__((ext_vector_type(8)));
typedef __bf16 bf16x4v __attribute__((ext_vector_type(4)));
#define MFMA32(a, b, c) __builtin_amdgcn_mfma_f32_32x32x16_bf16((a), (b), (c), 0, 0, 0)

constexpr int NB = 8, SEQ = 4096, DM = 1024, NT = NB * SEQ;
constexpr float ALPHA = 1.41421356237f;
constexpr float LN_EPS = 1e-5f;
constexpr int NIN0 = 1920;
constexpr int NPH = 21;

constexpr size_t MiB = 1u << 20;
constexpr size_t WS_CTL = 0;
constexpr size_t WS_ROPE = 1 * MiB;
constexpr size_t WS_WIN0 = 2 * MiB;
constexpr size_t WS_WOUT0 = 6 * MiB;
constexpr size_t WS_WIN1 = 8 * MiB;
constexpr size_t WS_WOUT1 = 14 * MiB;
constexpr size_t WS_WGLU = 16 * MiB;
constexpr size_t WS_WCK1 = 16 * MiB + 512 * 1024;
constexpr size_t WS_WCV1 = 17 * MiB;
constexpr size_t WS_WCK2 = 17 * MiB + 512 * 1024;
constexpr size_t WS_WCV2 = WS_WCK2 + 16384;
constexpr size_t WS_CBIAS = WS_WCV2 + 16384;
constexpr size_t WS_S5AL = WS_CBIAS + 4096;
constexpr size_t WS_RTRW = 17 * MiB + 640 * 1024;
constexpr size_t WS_BTE = 18 * MiB;
constexpr size_t WS_BTY = 22 * MiB;
constexpr size_t WS_WGU = 42 * MiB;
constexpr size_t WS_WDN = 74 * MiB;
constexpr size_t WS_KMP = 90 * MiB;
constexpr size_t WS_WGT = 94 * MiB;
constexpr size_t WS_KMEAN = 94 * MiB + 512 * 1024;
constexpr size_t WS_KCMP = 95 * MiB;
constexpr size_t WS_VCMP = 95 * MiB + 512 * 1024;
constexpr size_t WS_ACTB = 96 * MiB;
constexpr size_t WS_MIX = 160 * MiB;
constexpr size_t WS_XP = 224 * MiB;
constexpr size_t WS_LIST2 = 416 * MiB;
constexpr size_t WS_SELM = 92 * MiB;
constexpr size_t WS_MCNT = 93 * MiB;
constexpr size_t WS_MLIST = WS_LIST2;
constexpr size_t WS_PO2 = 424 * MiB;
constexpr size_t WS_PML = 488 * MiB;
constexpr size_t WS_END = 504 * MiB;
constexpr size_t XP_Q0 = WS_XP;
constexpr size_t XP_KC = WS_XP + 32 * MiB;
constexpr size_t KVSZ = 8 * MiB;
constexpr size_t XP_GATES = WS_XP + 80 * MiB;
constexpr size_t XP_AEXT = WS_XP + 84 * MiB;
constexpr size_t XP_G5 = WS_XP + 124 * MiB;
constexpr size_t XP_PRE = WS_XP;
constexpr size_t XP_YB = WS_XP;
constexpr size_t XP_H = WS_XP + 128 * MiB;
constexpr size_t XP_Q1 = WS_XP;

struct Params {
    const float* in[32];
    float* out;
    unsigned char* ws;
    int ph_lo, ph_hi;
};

DI bf16_t f2bf(float f) { unsigned u = __float_as_uint(f); return (bf16_t)((u + 0x7fffu + ((u >> 16) & 1u)) >> 16); }
DI float bf2f(bf16_t h) { return __uint_as_float(((unsigned)h) << 16); }
DI unsigned pk2(float lo, float hi) { return (unsigned)f2bf(lo) | ((unsigned)f2bf(hi) << 16); }
DI bf16x8 cvt8(f32x8 v) { return __builtin_bit_cast(bf16x8, __builtin_convertvector(v, bf16x8v)); }
DI u32x2 cvt4(f32x4 v) { return __builtin_bit_cast(u32x2, __builtin_convertvector(v, bf16x4v)); }
DI int natdim(int p) { const int hh = p >> 5, i = p & 31; return ((i >> 4) << 5) + 8 * ((i & 15) >> 2) + 4 * hh + (i & 3); }
DI u32x4 cvt8u(f32x16 v, int k, float s) { return __builtin_bit_cast(u32x4, cvt8((f32x8){v[8 * k] * s, v[8 * k + 1] * s, v[8 * k + 2] * s, v[8 * k + 3] * s, v[8 * k + 4] * s, v[8 * k + 5] * s, v[8 * k + 6] * s, v[8 * k + 7] * s})); }
DI void nat_store(bf16_t* o, int h, const f32x16& o0, const f32x16& o1, float s) {
    u32x4* d = (u32x4*)(o + 32 * h);
    d[0] = cvt8u(o0, 0, s); d[1] = cvt8u(o0, 1, s); d[2] = cvt8u(o1, 0, s); d[3] = cvt8u(o1, 1, s);
}
DI size_t kp_off(int key, int d) { return ((size_t)((key >> 5) * 4 + (d >> 4)) * 32 + (key & 31)) * 16 + (d & 15); }
DI int vp_pos(int ko) { return 8 * ((ko >> 2) & 1) + 4 * (ko >> 3) + (ko & 3); }
DI size_t vp_off(int key, int d) { return ((size_t)(key >> 4) * 64 + d) * 16 + vp_pos(key & 15); }
DI bf16_t ld_bf(const bf16_t* p) { return *p; }
DI f32x4 bf4_to_f(u32x2 w) { return (f32x4){__uint_as_float(w.x << 16), __uint_as_float(w.x & 0xffff0000u), __uint_as_float(w.y << 16), __uint_as_float(w.y & 0xffff0000u)}; }
template <int CTRL> DI float dpp_f(float v) { return __builtin_bit_cast(float, __builtin_amdgcn_update_dpp(0, __builtin_bit_cast(int, v), CTRL, 0xF, 0xF, true)); }
DI float wave_sum(float v) {
    v += dpp_f<0xB1>(v);
    v += dpp_f<0x4E>(v);
    v += dpp_f<0x141>(v);
    v += dpp_f<0x140>(v);
    { const auto s = __builtin_amdgcn_permlane16_swap(__float_as_uint(v), __float_as_uint(v), false, false); v = __uint_as_float(s[0]) + __uint_as_float(s[1]); }
    { const auto s = __builtin_amdgcn_permlane32_swap(__float_as_uint(v), __float_as_uint(v), false, false); v = __uint_as_float(s[0]) + __uint_as_float(s[1]); }
    return v;
}
DI float wave_max(float v) {
#pragma unroll
    for (int o = 32; o > 0; o >>= 1) v = fmaxf(v, __shfl_xor(v, o));
    return v;
}
DI float sigmoidf_(float x) { return __builtin_amdgcn_rcpf(1.f + __expf(-x)); }
DI float gelu_tanh(float x) { const float z = 0.7978845608028654f * (x + 0.044715f * x * x * x); return x * sigmoidf_(2.f * z); }

template <bool TRANS, bool PIN = true>
DI void gemm_kstep(const LAS unsigned char* cur, int aoff, int boff, int fq, int swz, f32x4 (&acc)[4][4]) {
    if (!PIN) {
#pragma unroll
        for (int ks = 0; ks < 2; ++ks) {
            bf16x8 af[4], bfr[4];
            const int co = ((ks * 4 + fq) ^ swz) * 16;
#pragma unroll
            for (int m = 0; m < 4; ++m) af[m] = *(const LAS bf16x8*)(cur + aoff + m * 2048 + co);
#pragma unroll
            for (int n = 0; n < 4; ++n) bfr[n] = *(const LAS bf16x8*)(cur + boff + n * 2048 + co);
#pragma unroll
            for (int m = 0; m < 4; ++m)
#pragma unroll
                for (int n = 0; n < 4; ++n) acc[m][n] = TRANS ? __builtin_amdgcn_mfma_f32_16x16x32_bf16(bfr[n], af[m], acc[m][n], 0, 0, 0) : __builtin_amdgcn_mfma_f32_16x16x32_bf16(af[m], bfr[n], acc[m][n], 0, 0, 0);
        }
        return;
    }
    bf16x8 af[2][4], bfr[2][4];
    const int co0 = (fq ^ swz) * 16, co1 = ((4 + fq) ^ swz) * 16;
    af[0][0] = *(const LAS bf16x8*)(cur + aoff + co0);
#pragma unroll
    for (int n = 0; n < 4; ++n) bfr[0][n] = *(const LAS bf16x8*)(cur + boff + n * 2048 + co0);
#pragma unroll
    for (int m = 1; m < 4; ++m) af[0][m] = *(const LAS bf16x8*)(cur + aoff + m * 2048 + co0);
    __builtin_amdgcn_sched_barrier(0);
#pragma unroll
    for (int n = 0; n < 4; ++n) acc[0][n] = TRANS ? __builtin_amdgcn_mfma_f32_16x16x32_bf16(bfr[0][n], af[0][0], acc[0][n], 0, 0, 0) : __builtin_amdgcn_mfma_f32_16x16x32_bf16(af[0][0], bfr[0][n], acc[0][n], 0, 0, 0);
    __builtin_amdgcn_sched_barrier(0);
    af[1][0] = *(const LAS bf16x8*)(cur + aoff + co1);
#pragma unroll
    for (int n = 0; n < 4; ++n) bfr[1][n] = *(const LAS bf16x8*)(cur + boff + n * 2048 + co1);
#pragma unroll
    for (int m = 1; m < 4; ++m) af[1][m] = *(const LAS bf16x8*)(cur + aoff + m * 2048 + co1);
    __builtin_amdgcn_sched_barrier(0);
#pragma unroll
    for (int m = 1; m < 4; ++m)
#pragma unroll
        for (int n = 0; n < 4; ++n) acc[m][n] = TRANS ? __builtin_amdgcn_mfma_f32_16x16x32_bf16(bfr[0][n], af[0][m], acc[m][n], 0, 0, 0) : __builtin_amdgcn_mfma_f32_16x16x32_bf16(af[0][m], bfr[0][n], acc[m][n], 0, 0, 0);
#pragma unroll
    for (int m = 0; m < 4; ++m)
#pragma unroll
        for (int n = 0; n < 4; ++n) acc[m][n] = TRANS ? __builtin_amdgcn_mfma_f32_16x16x32_bf16(bfr[1][n], af[1][m], acc[m][n], 0, 0, 0) : __builtin_amdgcn_mfma_f32_16x16x32_bf16(af[1][m], bfr[1][n], acc[m][n], 0, 0, 0);
}
constexpr int GEMM_LDS = 65536;
template <bool TRANS = true, bool PIN = true, class RowPtr, class Epi>
DI void gemm128(RowPtr rowptr, const bf16_t* __restrict__ Bt, int ldb, int K, unsigned char* smem, Epi epi, int kskip_lo = 0, int kskip_hi = 0) {
    LAS unsigned char* lds = (LAS unsigned char*)smem;
    const int tid = threadIdx.x, lane = tid & 63, wave = tid >> 6, wr = wave >> 1, wc = wave & 1, fr = lane & 15, fq = lane >> 4;
    const int schunk = ((tid & 7) ^ ((tid >> 4) & 7)) * 8;
    const bf16_t* ga[4];
#pragma unroll
    for (int i = 0; i < 4; ++i) ga[i] = rowptr(i * 32 + (tid >> 3)) + schunk;
    const bf16_t* gb = Bt + (size_t)(tid >> 3) * ldb + schunk;
    const size_t gbs = (size_t)32 * ldb;
    auto stage = [&](int kt, int s) {
#pragma unroll
        for (int i = 0; i < 4; ++i) {
            __builtin_amdgcn_global_load_lds((const unsigned*)(ga[i] + kt * 64), (LAS unsigned*)(lds + s * 32768 + (i * 256 + tid) * 16), 16, 0, 0);
            __builtin_amdgcn_global_load_lds((const unsigned*)(gb + i * gbs + kt * 64), (LAS unsigned*)(lds + s * 32768 + 16384 + (i * 256 + tid) * 16), 16, 0, 0);
        }
    };
    f32x4 acc[4][4];
#pragma unroll
    for (int m = 0; m < 4; ++m)
#pragma unroll
        for (int n = 0; n < 4; ++n) acc[m][n] = (f32x4){0.f, 0.f, 0.f, 0.f};
    const int nskip = kskip_hi - kskip_lo, nk = (K >> 6) - nskip;
    const int swz = (fr >> 1) & 7;
    const int aoff = (wr * 64 + fr) * 128, boff = 16384 + (wc * 64 + fr) * 128;
    stage(kskip_lo == 0 ? nskip : 0, 0);
#pragma unroll 1
    for (int kt = 0; kt < nk; ++kt) {
        asm volatile("s_waitcnt vmcnt(0)" ::: "memory");
        __syncthreads();
        if (kt + 1 < nk) stage(kt + 1 < kskip_lo ? kt + 1 : kt + 1 + nskip, (kt + 1) & 1);
        const LAS unsigned char* cur = lds + (kt & 1) * 32768;
        gemm_kstep<TRANS, PIN>(cur, aoff, boff, fq, swz, acc);
    }
    __syncthreads();
    epi(acc, wr, wc, lane);
}

template <bool TRANS = true, class RowPtr, class Epi, class NextRow>
DI void gemm128s(RowPtr rowptr, const bf16_t* __restrict__ Bt, int ldb, int K, unsigned char* smem, Epi epi, bool prefetched, bool has_next, NextRow nextrow, const bf16_t* __restrict__ nextBt) {
    LAS unsigned char* lds = (LAS unsigned char*)smem;
    const int tid = threadIdx.x, lane = tid & 63, wave = tid >> 6, wr = wave >> 1, wc = wave & 1, fr = lane & 15, fq = lane >> 4;
    const int schunk = ((tid & 7) ^ ((tid >> 4) & 7)) * 8;
    const bf16_t* ga[4];
#pragma unroll
    for (int i = 0; i < 4; ++i) ga[i] = rowptr(i * 32 + (tid >> 3)) + schunk;
    const bf16_t* gb = Bt + (size_t)(tid >> 3) * ldb + schunk;
    const size_t gbs = (size_t)32 * ldb;
    auto stage = [&](int kt, int s) {
#pragma unroll
        for (int i = 0; i < 4; ++i) {
            __builtin_amdgcn_global_load_lds((const unsigned*)(ga[i] + kt * 64), (LAS unsigned*)(lds + s * 32768 + (i * 256 + tid) * 16), 16, 0, 0);
            __builtin_amdgcn_global_load_lds((const unsigned*)(gb + i * gbs + kt * 64), (LAS unsigned*)(lds + s * 32768 + 16384 + (i * 256 + tid) * 16), 16, 0, 0);
        }
    };
    f32x4 acc[4][4];
#pragma unroll
    for (int m = 0; m < 4; ++m)
#pragma unroll
        for (int n = 0; n < 4; ++n) acc[m][n] = (f32x4){0.f, 0.f, 0.f, 0.f};
    const int nk = K >> 6;
    const int swz = (fr >> 1) & 7;
    const int aoff = (wr * 64 + fr) * 128, boff = 16384 + (wc * 64 + fr) * 128;
    if (!prefetched) stage(0, 0);
#pragma unroll 1
    for (int kt = 0; kt < nk; ++kt) {
        asm volatile("s_waitcnt vmcnt(0)" ::: "memory");
        __syncthreads();
        if (kt + 1 < nk) stage(kt + 1, (kt + 1) & 1);
        else if (has_next) {
#pragma unroll
            for (int i = 0; i < 4; ++i) {
                __builtin_amdgcn_global_load_lds((const unsigned*)(nextrow(i * 32 + (tid >> 3)) + schunk), (LAS unsigned*)(lds + (i * 256 + tid) * 16), 16, 0, 0);
                __builtin_amdgcn_global_load_lds((const unsigned*)(nextBt + (size_t)(tid >> 3) * ldb + schunk + i * gbs), (LAS unsigned*)(lds + 16384 + (i * 256 + tid) * 16), 16, 0, 0);
            }
        }
        const LAS unsigned char* cur = lds + (kt & 1) * 32768;
        gemm_kstep<TRANS>(cur, aoff, boff, fq, swz, acc);
    }
    epi(acc, wr, wc, lane);
}

DI int vblock() { const int G = gridDim.x; return (G & 7) == 0 ? (int)(blockIdx.x & 7) * (G >> 3) + (int)(blockIdx.x >> 3) : (int)blockIdx.x; }
DI void tile_mn(int it, int nN, int& mt, int& nt) { const int per = 8 * nN, grp = it / per, idx = it - grp * per; nt = idx >> 3; mt = grp * 8 + (idx & 7); }

DI int rope_pos(int l) { return (l & ~63) + ((2 * ((l & 31) >> 4) + ((l >> 5) & 1)) << 4) + (l & 15); }
DI int rowmap(int kind, int n) {
    if (kind == 1) {
        if (n < 512 || (n >= 512 && n < 640) || (n >= 768 && n < 896) || (n >= 1024 && n < 1152)) return rope_pos(n);
        return n < 1304 ? n : n + 104;
    }
    if (kind == 4) return n < 2048 ? rope_pos(n) : n;
    if (kind == 2) return ((n >> 5) << 6) + (n & 31);
    if (kind == 3) return ((n >> 5) << 6) + 32 + (n & 31);
    return n;
}
template <bool KNAT = false>
DI void tr_tile(const float* __restrict__ src, int K, int N, bf16_t* __restrict__ dst, int kind, int kt, int nt, float* s) {
    const int tid = threadIdx.x, k0 = kt * 64, n0 = nt * 64;
    {
        const int nn = tid & 63, kq = tid >> 6, n = n0 + nn;
#pragma unroll
        for (int i = 0; i < 16; ++i) { const int kk = kq + 4 * i; s[kk * 65 + nn] = (n < N) ? src[(size_t)(k0 + kk) * N + n] : 0.f; }
    }
    __syncthreads();
    {
        const int rn = tid >> 2, kseg = (tid & 3) * 16, n = n0 + rn;
        if (n < N) {
            unsigned w[8];
#pragma unroll
            for (int i = 0; i < 8; ++i) w[i] = KNAT ? pk2(s[natdim(kseg + 2 * i) * 65 + rn], s[natdim(kseg + 2 * i + 1) * 65 + rn]) : pk2(s[(kseg + 2 * i) * 65 + rn], s[(kseg + 2 * i + 1) * 65 + rn]);
            bf16_t* d = dst + (size_t)rowmap(kind, n) * K + k0 + kseg;
            *(uint4*)d = make_uint4(w[0], w[1], w[2], w[3]);
            *(uint4*)(d + 8) = make_uint4(w[4], w[5], w[6], w[7]);
        }
    }
    __syncthreads();
}
struct CF { float re, im; };
DI CF cmul(CF a, CF b) { return {a.re * b.re - a.im * b.im, a.re * b.im + a.im * b.re}; }
DI CF s5_apow(const Params& P, int g, int p, float tau) {
    const float step = expf(P.in[10][g]);
    const float lr = P.in[8][g * 64 + p], li = P.in[9][g * 64 + p];
    const float mag = expf(lr * step * tau);
    float sn, cs; sincosf(li * step * tau, &sn, &cs);
    return {mag * cs, mag * sn};
}
DI CF s5_f(const Params& P, int g, int p) {
    const CF a = s5_apow(P, g, p, 1.f);
    const float lr = P.in[8][g * 64 + p], li = P.in[9][g * 64 + p];
    const float den = lr * lr + li * li;
    return {((a.re - 1.f) * lr + a.im * li) / den, (a.im * lr - (a.re - 1.f) * li) / den};
}
DI void phase0(const Params& P, unsigned char* smem) {
    const int tid = threadIdx.x;
    unsigned char* ws = P.ws;
    float* sf = (float*)smem;
    constexpr int N_TR0 = 16 * 29, N_TR1 = 256, N_TR2 = 16 * 48, N_TR3 = 256, N_TR4 = 64, N_TR5 = 64, N_TR6 = 64, N_TR7 = 2, N_TR8 = 2;
    constexpr int N_TRG = 64 * 32, N_TRU = 64 * 32, N_TRD = 64 * 32;
    constexpr int N_X = NT * DM / 8192, N_ROPE = 512, N_CB = 16, N_AL = 8, N_BTE = 256, N_BTYM = 32 * 63, N_BTYQ = 4096, N_ZP = 13;
    constexpr int N_RW = 2 * 36864 / 256;
    constexpr int TOTAL = N_RW + N_TR0 + N_TR1 + N_TR4 + N_TR5 + N_TR6 + N_TR7 + N_TR8 + N_X + N_ROPE + N_CB + N_AL + N_BTE + N_BTYM + N_BTYQ + N_ZP;
    for (int it0 = blockIdx.x; it0 < TOTAL; it0 += gridDim.x) {
        int it = it0;
        if (it < N_RW) {
            const int e = it * 256 + tid, layer = e / 36864, r = e % 36864;
            float* dst = (float*)(ws + WS_RTRW) + (size_t)layer * 36864;
            if (r < 4096) { const int o = r & 3, l = (r >> 2) & 63, jk = r >> 8, d = 4 * l + 256 * (jk >> 2) + (jk & 3); dst[r] = P.in[25][((size_t)layer * 1024 + d) * 4 + o]; }
            else { const int q = r - 4096, o = q & 3, l = (q >> 2) & 63, hf = (q >> 8) & 1, jk = (q >> 9) & 15, g = q >> 13, d = 4 * l + 256 * (jk >> 2) + (jk & 3);
                   dst[r] = P.in[27][(((size_t)layer * 4 + g) * 1024 + d) * 8 + hf * 4 + o]; }
            continue;
        } it -= N_RW;
        if (it < N_TR0) { tr_tile(P.in[1], 1024, 1816, (bf16_t*)(ws + WS_WIN0), 1, it / 29, it % 29, sf); continue; } it -= N_TR0;
        if (it < N_TR1) { tr_tile(P.in[18], 1024, 1024, (bf16_t*)(ws + WS_WOUT0), 0, it / 16, it % 16, sf); continue; } it -= N_TR1;
        if (it < N_TR4) { tr_tile(P.in[16], 512, 512, (bf16_t*)(ws + WS_WGLU), 0, it / 8, it % 8, sf); continue; } it -= N_TR4;
        if (it < N_TR5) { tr_tile(P.in[4], 2048, 128, (bf16_t*)(ws + WS_WCK1), 0, it / 2, it % 2, sf); continue; } it -= N_TR5;
        if (it < N_TR6) { tr_tile(P.in[6], 2048, 128, (bf16_t*)(ws + WS_WCV1), 0, it / 2, it % 2, sf); continue; } it -= N_TR6;
        if (it < N_TR7) { tr_tile(P.in[5], 128, 64, (bf16_t*)(ws + WS_WCK2), 0, it, 0, sf); continue; } it -= N_TR7;
        if (it < N_TR8) { tr_tile(P.in[7], 128, 64, (bf16_t*)(ws + WS_WCV2), 0, it, 0, sf); continue; } it -= N_TR8;
        if (it < N_X) {
            const float* x = P.in[0]; bf16_t* xb = (bf16_t*)(ws + WS_ACTB);
#pragma unroll
            for (int i = 0; i < 4; ++i) {
                const size_t idx = (size_t)it * 8192 + i * 2048 + tid * 8;
                const f32x4 a = __builtin_nontemporal_load((const f32x4*)(x + idx)), b = __builtin_nontemporal_load((const f32x4*)(x + idx + 4));
                *(uint4*)(xb + idx) = make_uint4(pk2(a.x, a.y), pk2(a.z, a.w), pk2(b.x, b.y), pk2(b.z, b.w));
            }
            continue;
        } it -= N_X;
        if (it < N_ROPE) {
            const int e = it * 256 + tid, pos = e >> 5, i = e & 31;
            const float inv = 1.0f / powf(10000.0f, (float)(2 * i) / 64.0f);
            const float ang = (float)pos * inv;
            ((float*)(ws + WS_ROPE))[e] = (float)cos((double)ang);
            ((float*)(ws + WS_ROPE))[4096 * 32 + e] = (float)sin((double)ang);
            continue;
        } it -= N_ROPE;
        if (it < N_CB) {
            const int kv = it >> 3, j0 = (it & 7) * 16, j = j0 + (tid & 15), sl = tid >> 4;
            const float* pe = P.in[kv ? 3 : 2]; const float* w1 = P.in[kv ? 6 : 4];
            float a = 0.f;
            for (int i = sl * 128; i < sl * 128 + 128; ++i) a += pe[i] * w1[(size_t)i * 128 + j];
            sf[tid] = a; __syncthreads();
            if (tid < 16) { float t = 0.f; for (int q = 0; q < 16; ++q) t += sf[q * 16 + tid]; ((float*)(ws + WS_CBIAS))[kv * 128 + j0 + tid] = t; }
            __syncthreads();
            continue;
        } it -= N_CB;
        if (it < N_AL) {
            const int e = it * 256 + tid, g = e >> 6, p = e & 63;
            const CF a = s5_apow(P, g, p, 32.f);
            ((float*)(ws + WS_S5AL))[e * 2] = a.re; ((float*)(ws + WS_S5AL))[e * 2 + 1] = a.im;
            continue;
        } it -= N_AL;
        if (it < N_BTE) {
            const int e = it * 256 + tid, g = e >> 11, p = (e >> 5) & 63, r = e & 31;
            const CF w = cmul(s5_apow(P, g, p, (float)(31 - r)), s5_f(P, g, p));
            bf16_t* d = (bf16_t*)(ws + WS_BTE) + (size_t)g * 128 * 512;
#pragma unroll
            for (int c = 0; c < 16; ++c) {
                const CF bb = {P.in[11][(g * 64 + p) * 16 + c], P.in[12][(g * 64 + p) * 16 + c]};
                const CF v = cmul(w, bb);
                d[(size_t)p * 512 + r * 16 + c] = f2bf(v.re);
                d[(size_t)(64 + p) * 512 + r * 16 + c] = f2bf(v.im);
            }
            continue;
        } it -= N_BTE;
        if (it < N_BTYM) {
            const int g = it / 63, dd = it % 63 - 31, ch = tid >> 4, c = tid & 15;
            float val = 0.f;
            if (dd >= 0) {
                float* sw = sf; float* sb = sf + 128; float* sc = sf + 128 + 2048;
                if (tid < 64) { const CF w = cmul(s5_apow(P, g, tid, (float)dd), s5_f(P, g, tid)); sw[2 * tid] = w.re; sw[2 * tid + 1] = w.im; }
#pragma unroll
                for (int i = 0; i < 4; ++i) {
                    const int e = tid + 256 * i;
                    sb[2 * e] = P.in[11][(size_t)g * 1024 + e]; sb[2 * e + 1] = P.in[12][(size_t)g * 1024 + e];
                    sc[2 * e] = P.in[13][(size_t)g * 1024 + e]; sc[2 * e + 1] = P.in[14][(size_t)g * 1024 + e];
                }
                __syncthreads();
#pragma unroll 8
                for (int p = 0; p < 64; ++p) {
                    const CF bb = {sb[2 * (p * 16 + c)], sb[2 * (p * 16 + c) + 1]};
                    const CF cc = {sc[2 * (ch * 64 + p)], sc[2 * (ch * 64 + p) + 1]};
                    const CF w = {sw[2 * p], sw[2 * p + 1]};
                    val += cmul(cc, cmul(w, bb)).re;
                }
                __syncthreads();
            }
            bf16_t* d = (bf16_t*)(ws + WS_BTY) + (size_t)g * 512 * 640;
            const bf16_t hv = f2bf(val);
            for (int r = 0; r < 32; ++r) { const int s = r + dd; if (s >= 0 && s < 32) d[(size_t)(s * 16 + ch) * 640 + r * 16 + c] = hv; }
            continue;
        } it -= N_BTYM;
        if (it < N_BTYQ) {
            const int e = it * 256 + tid, g = e >> 15, s = (e >> 10) & 31, ch = (e >> 6) & 15, p = e & 63;
            const CF cc = {P.in[13][(g * 16 + ch) * 64 + p], P.in[14][(g * 16 + ch) * 64 + p]};
            const CF w = cmul(cc, s5_apow(P, g, p, (float)(s + 1)));
            bf16_t* d = (bf16_t*)(ws + WS_BTY) + ((size_t)g * 512 + s * 16 + ch) * 640 + 512;
            d[p] = f2bf(w.re); d[64 + p] = f2bf(-w.im);
            continue;
        } it -= N_BTYQ;
        {
            uint4* d = (uint4*)((bf16_t*)(ws + WS_WIN0) + (size_t)(1304 + it * 8) * 1024);
#pragma unroll
            for (int i = 0; i < 4; ++i) d[i * 256 + tid] = make_uint4(0, 0, 0, 0);
        }
    }
}

DI void phase_inproj0(const Params& P, unsigned char* smem) {
    unsigned char* ws = P.ws;
    const bf16_t* A = (const bf16_t*)(ws + WS_ACTB);
    const float* cosT = (const float*)(ws + WS_ROPE);
    const float* sinT = cosT + 4096 * 32;
    constexpr int NTN = NIN0 / 128;
    bool pre = false;
    for (int it = vblock(); it < (NT / 128) * NTN; it += gridDim.x) {
        int mt, nt; tile_mn(it, NTN, mt, nt);
        const int m0 = mt * 128;
        auto rowptr = [=](int r) { return A + (size_t)(m0 + r) * 1024; };
        const bf16_t* Bt = (const bf16_t*)(ws + WS_WIN0) + (size_t)nt * 128 * 1024;
        const bool hn = it + (int)gridDim.x < (NT / 128) * NTN;
        int mtn = 0, ntn = 0; if (hn) tile_mn(it + gridDim.x, NTN, mtn, ntn);
        auto nextrow = [=](int r) { return A + (size_t)(mtn * 128 + r) * 1024; };
        const bf16_t* nBt = (const bf16_t*)(ws + WS_WIN0) + (size_t)ntn * 128 * 1024;
        if (nt == 7 || nt == 9) {
            auto epi = [=](f32x4 (&acc)[4][4], int wr, int wc, int lane) {
                const int fr = lane & 15, fq = lane >> 4, which = nt == 7 ? 3 : 5, g = wc;
#pragma unroll
                for (int m = 0; m < 4; ++m) {
                    const int t = m0 + wr * 64 + m * 16 + fq * 4, s = t & 4095, b = t >> 12;
                    bf16_t* dst = (bf16_t*)(ws + XP_KC + (size_t)which * KVSZ) + (size_t)(b * 2 + g) * 4096 * 64;
#pragma unroll
                    for (int n = 0; n < 4; ++n) *(u32x2*)(dst + vp_off(s, n * 16 + fr)) = cvt4(acc[m][n]);
                }
            };
            gemm128s<false>(rowptr, Bt, 1024, 1024, smem, epi, pre, hn, nextrow, nBt);
            pre = hn;
            continue;
        }
        auto epi = [=](f32x4 (&acc)[4][4], int wr, int wc, int lane) {
            const int u64 = nt * 2 + wc, fr = lane & 15, fq = lane >> 4;
#pragma unroll
            for (int m = 0; m < 4; ++m) {
                const int t = m0 + wr * 64 + m * 16 + fr, s = t & 4095, b = t >> 12;
                if (u64 < 20) {
                    const bool isq = u64 < 8;
                    const int which = (u64 - 8) >> 1, g = (u64 - 8) & 1;
                    if (isq || ((which & 1) == 0)) {
#pragma unroll
                        for (int n2 = 0; n2 < 2; ++n2) {
                            const int i = n2 * 16 + fq * 4;
                            const f32x4 c = *(const f32x4*)(cosT + s * 32 + i), sn = *(const f32x4*)(sinT + s * 32 + i);
                            const f32x4 x1 = acc[m][2 * n2], x2 = acc[m][2 * n2 + 1];
                            const u32x2 o1 = cvt4(x1 * c - x2 * sn), o2 = cvt4(x1 * sn + x2 * c);
                            if (isq) { bf16_t* dst = (bf16_t*)(ws + XP_Q0) + (size_t)t * 512 + u64 * 64; *(u32x2*)(dst + i) = o1; *(u32x2*)(dst + i + 32) = o2; }
                            else {
                                bf16_t* dst = (bf16_t*)(ws + XP_KC + (size_t)which * KVSZ) + (size_t)(b * 2 + g) * 4096 * 64;
                                if (which == 0) { *(u32x2*)(dst + (size_t)s * 64 + i) = o1; *(u32x2*)(dst + (size_t)s * 64 + i + 32) = o2; }
                                else { *(u32x2*)(dst + kp_off(s, i)) = o1; *(u32x2*)(dst + kp_off(s, i + 32)) = o2; }
                            }
                        }
                    } else {
                        bf16_t* dst = (bf16_t*)(ws + XP_KC + (size_t)which * KVSZ) + ((size_t)(b * 2 + g) * 4096 + s) * 64;
#pragma unroll
                        for (int n = 0; n < 4; ++n) *(u32x2*)(dst + n * 16 + fq * 4) = cvt4(acc[m][n]);
                    }
                } else if (u64 == 20) {
#pragma unroll
                    for (int n = 0; n < 2; ++n) {
                        const int c0 = n * 16 + fq * 4;
                        if (c0 < 24) { f32x4 o; o.x = sigmoidf_(acc[m][n].x); o.y = sigmoidf_(acc[m][n].y); o.z = sigmoidf_(acc[m][n].z); o.w = sigmoidf_(acc[m][n].w); *(f32x4*)((float*)(ws + XP_GATES) + (size_t)t * 24 + c0) = o; }
                    }
                } else if (u64 >= 22) {
#pragma unroll
                    for (int n = 0; n < 4; ++n) {
                        const int g5 = (u64 - 22) * 4 + n;
                        *(u32x2*)((bf16_t*)(ws + XP_AEXT) + ((size_t)g5 * 1024 + (t >> 5)) * 640 + (t & 31) * 16 + fq * 4) = cvt4(acc[m][n]);
                    }
                }
            }
        };
        gemm128s(rowptr, Bt, 1024, 1024, smem, epi, pre, hn, nextrow, nBt);
        pre = hn;
    }
}

constexpr int N_LATE = 16 * 48 + 256 + 3 * 64 * 32;
DI void late_weights(const Params& P, unsigned char* smem, int it) {
    unsigned char* ws = P.ws;
    float* sf = (float*)smem;
    constexpr int N_TR2 = 16 * 48, N_TR3 = 256, N_TRG = 64 * 32, N_TRU = 64 * 32;
    if (it < N_TR2) { tr_tile(P.in[19], 1024, 3072, (bf16_t*)(ws + WS_WIN1), 4, it / 48, it % 48, sf); return; } it -= N_TR2;
    if (it < N_TR3) { tr_tile<true>(P.in[20], 1024, 1024, (bf16_t*)(ws + WS_WOUT1), 0, it / 16, it % 16, sf); return; } it -= N_TR3;
    if (it < N_TRG) { const int mat = it >> 5, r = it & 31; tr_tile(P.in[29] + (size_t)mat * 1024 * 128, 1024, 128, (bf16_t*)(ws + WS_WGU) + (size_t)mat * 256 * 1024, 2, r >> 1, r & 1, sf); return; } it -= N_TRG;
    if (it < N_TRU) { const int mat = it >> 5, r = it & 31; tr_tile(P.in[30] + (size_t)mat * 1024 * 128, 1024, 128, (bf16_t*)(ws + WS_WGU) + (size_t)mat * 256 * 1024, 3, r >> 1, r & 1, sf); return; } it -= N_TRU;
    { const int mat = it >> 5, r = it & 31; tr_tile(P.in[31] + (size_t)mat * 128 * 1024, 128, 1024, (bf16_t*)(ws + WS_WDN) + (size_t)mat * 1024 * 128, 0, r >> 4, r & 15, sf); }
}

DI void s5y_tile(const Params& P, unsigned char* smem, int g, int mt, int nt);
DI void phase_cmp_s5e(const Params& P, unsigned char* smem) {
    unsigned char* ws = P.ws;
    const int tid = threadIdx.x, lane = tid & 63, wave = tid >> 6;
    const int G = gridDim.x, bid = blockIdx.x;
    const bool split = G >= 384;
    const int nmine = !split ? (320 + N_LATE + G - 1 - bid) / G : (bid < 320 ? 1 : (N_LATE + (G - 320) - 1 - (bid - 320)) / (G - 320));
    for (int k = 0; k < nmine; ++k) {
        const int it = !split ? bid + k * G : (bid < 320 ? bid : 320 + (bid - 320) + k * (G - 320));
        if (it >= 64 + 256) { late_weights(P, smem, it - 320); continue; }
        if (it < 64) {
            const int kv = it >> 5, bg = (it >> 1) & 15, mt = it & 1;
            const bf16_t* src = (const bf16_t*)(ws + XP_KC + (size_t)kv * KVSZ) + (size_t)bg * 4096 * 64;
            const float* cb = (const float*)(ws + WS_CBIAS) + kv * 128;
            bf16_t* sH = (bf16_t*)smem;
            auto rowptr = [=](int r) { int rr = mt * 128 + r; rr = rr > 254 ? 254 : rr; return src + (size_t)rr * 1024; };
            auto epi = [=](f32x4 (&acc)[4][4], int wr, int wc, int ln) {
                const int fr = ln & 15, fq = ln >> 4;
#pragma unroll
                for (int m = 0; m < 4; ++m)
#pragma unroll
                    for (int n = 0; n < 4; ++n)
#pragma unroll
                        for (int j = 0; j < 4; ++j) {
                            const int r = wr * 64 + m * 16 + fr, c = wc * 64 + n * 16 + fq * 4 + j;
                            sH[r * 136 + c] = f2bf(gelu_tanh(acc[m][n][j] + cb[c]));
                        }
            };
            gemm128(rowptr, (const bf16_t*)(ws + (kv ? WS_WCV1 : WS_WCK1)), 2048, 2048, smem, epi);
            __syncthreads();
            const bf16_t* W2 = (const bf16_t*)(ws + (kv ? WS_WCV2 : WS_WCK2));
            f32x4 a2[2][4];
#pragma unroll
            for (int m = 0; m < 2; ++m)
#pragma unroll
                for (int n = 0; n < 4; ++n) a2[m][n] = (f32x4){0.f, 0.f, 0.f, 0.f};
#pragma unroll
            for (int ks = 0; ks < 4; ++ks) {
                bf16x8 af[2], bfr[4];
#pragma unroll
                for (int m = 0; m < 2; ++m) af[m] = *(const bf16x8*)(sH + (wave * 32 + m * 16 + (lane & 15)) * 136 + ks * 32 + (lane >> 4) * 8);
#pragma unroll
                for (int n = 0; n < 4; ++n) bfr[n] = *(const bf16x8*)(W2 + (n * 16 + (lane & 15)) * 128 + ks * 32 + (lane >> 4) * 8);
#pragma unroll
                for (int m = 0; m < 2; ++m)
#pragma unroll
                    for (int n = 0; n < 4; ++n) a2[m][n] = __builtin_amdgcn_mfma_f32_16x16x32_bf16(af[m], bfr[n], a2[m][n], 0, 0, 0);
            }
            bf16_t* dst = (bf16_t*)(ws + (kv ? WS_VCMP : WS_KCMP)) + (size_t)bg * 256 * 64;
#pragma unroll
            for (int m = 0; m < 2; ++m)
#pragma unroll
                for (int n = 0; n < 4; ++n)
#pragma unroll
                    for (int j = 0; j < 4; ++j) {
                        const int row = mt * 128 + wave * 32 + m * 16 + (lane >> 4) * 4 + j, col = n * 16 + (lane & 15);
                        dst[kv ? vp_off(row, col) : kp_off(row, col)] = row < 255 ? f2bf(a2[m][n][j]) : (bf16_t)0;
                    }
            __syncthreads();
        } else {
            const int it2 = it - 64, g = it2 >> 3, b = it2 & 7;
            bf16_t* aext = (bf16_t*)(ws + XP_AEXT) + ((size_t)g * 1024 + b * 128) * 640;
            float* sE = (float*)smem;
            auto rowptr = [=](int r) { return (const bf16_t*)aext + (size_t)r * 640; };
            auto epi = [=](f32x4 (&acc)[4][4], int wr, int wc, int ln) {
                const int fr = ln & 15, fq = ln >> 4;
#pragma unroll
                for (int m = 0; m < 4; ++m)
#pragma unroll
                    for (int n = 0; n < 4; ++n)
#pragma unroll
                        for (int j = 0; j < 4; ++j) sE[(wr * 64 + m * 16 + fr) * 129 + wc * 64 + n * 16 + fq * 4 + j] = acc[m][n][j];
            };
            gemm128<true, false>(rowptr, (const bf16_t*)(ws + WS_BTE) + (size_t)g * 128 * 512, 512, 512, smem, epi);
            __syncthreads();
            {
                const int p = tid & 63, c0 = wave * 32;
                const float ar = ((const float*)(ws + WS_S5AL))[(g * 64 + p) * 2], ai = ((const float*)(ws + WS_S5AL))[(g * 64 + p) * 2 + 1];
                float* send = (float*)(smem + 128 * 129 * 4);
                float xr = 0.f, xi = 0.f;
                for (int c = c0; c < c0 + 32; ++c) {
                    const float er = sE[c * 129 + p], ei = sE[c * 129 + 64 + p];
                    const float nr = ar * xr - ai * xi + er, ni = ar * xi + ai * xr + ei;
                    xr = nr; xi = ni;
                }
                send[(wave * 64 + p) * 2] = xr; send[(wave * 64 + p) * 2 + 1] = xi;
                float qr = ar, qi = ai;
#pragma unroll
                for (int k = 0; k < 5; ++k) { const float tr = qr * qr - qi * qi, ti = 2.f * qr * qi; qr = tr; qi = ti; }
                __syncthreads();
                xr = 0.f; xi = 0.f;
                for (int k = 0; k < wave; ++k) {
                    const float er = send[(k * 64 + p) * 2], ei = send[(k * 64 + p) * 2 + 1];
                    const float nr = qr * xr - qi * xi + er, ni = qr * xi + qi * xr + ei;
                    xr = nr; xi = ni;
                }
                for (int c = c0; c < c0 + 32; ++c) {
                    aext[(size_t)c * 640 + 512 + p] = f2bf(xr);
                    aext[(size_t)c * 640 + 576 + p] = f2bf(xi);
                    const float er = sE[c * 129 + p], ei = sE[c * 129 + 64 + p];
                    const float nr = ar * xr - ai * xi + er, ni = ar * xi + ai * xr + ei;
                    xr = nr; xi = ni;
                }
            }
            asm volatile("s_waitcnt vmcnt(0)" ::: "memory");
            __syncthreads();
#pragma unroll 1
            for (int nt = 0; nt < 4; ++nt) s5y_tile(P, smem, g, b, nt);
        }
    }
}

DI void s5y_tile(const Params& P, unsigned char* smem, int g, int mt, int nt) {
    unsigned char* ws = P.ws;
    const bf16_t* aext = (const bf16_t*)(ws + XP_AEXT) + (size_t)g * 1024 * 640;
    const float* dsk = P.in[15];
    auto rowptr = [=](int r) { return aext + (size_t)(mt * 128 + r) * 640; };
    auto epi = [=](f32x4 (&acc)[4][4], int wr, int wc, int ln) {
        const int fr = ln & 15, fq = ln >> 4;
        const f32x4 dk = *(const f32x4*)(dsk + g * 16 + fq * 4);
#pragma unroll
        for (int m = 0; m < 4; ++m) {
            const int cr = mt * 128 + wr * 64 + m * 16 + fr;
#pragma unroll
            for (int n = 0; n < 4; ++n) {
                const int sp = nt * 8 + wc * 4 + n, t = cr * 32 + sp;
                const f32x4 u = bf4_to_f(*(const u32x2*)(aext + (size_t)cr * 640 + sp * 16 + fq * 4));
                const f32x4 y = acc[m][n] + dk * u;
                *(u32x2*)((bf16_t*)(ws + XP_G5) + (size_t)t * 512 + g * 16 + fq * 4) = cvt4((f32x4){gelu_tanh(y.x), gelu_tanh(y.y), gelu_tanh(y.z), gelu_tanh(y.w)});
            }
        }
    };
    gemm128<true, false>(rowptr, (const bf16_t*)(ws + WS_BTY) + ((size_t)g * 512 + nt * 128) * 640, 640, 640, smem, epi, 2 * nt + 2, 8);
}
struct FA { f32x16 o0, o1; float m, l; };
DI void fa_init(FA& st) {
#pragma unroll
    for (int i = 0; i < 16; ++i) { st.o0[i] = 0.f; st.o1[i] = 0.f; }
    st.m = -1e30f; st.l = 0.f;
}
constexpr float FA_THR = 8.f;
template <int MODE, class Valid>
DI void fa_tile(FA& st, const bf16x8 (&qf)[4], const LAS bf16_t* Kt, const LAS bf16_t* Vt, int r, int h, float c, bool rowok, Valid valid) {
    const LAS bf16_t* kb = Kt + r * 16 + 8 * h;
    const LAS bf16_t* vb = Vt + r * 16 + 8 * h;
    bf16x8 kf[4], vf[4];
#pragma unroll
    for (int ks = 0; ks < 4; ++ks) kf[ks] = *(const LAS bf16x8*)(kb + ks * 512);
#pragma unroll
    for (int sub = 0; sub < 2; ++sub) {
        f32x16 acc;
#pragma unroll
        for (int i = 0; i < 16; ++i) acc[i] = 0.f;
#pragma unroll
        for (int ks = 0; ks < 4; ++ks) acc = MFMA32(kf[ks], qf[ks], acc);
#pragma unroll
        for (int s2 = 0; s2 < 2; ++s2) { vf[2 * s2] = *(const LAS bf16x8*)(vb + ((sub * 2 + s2) * 64) * 16); vf[2 * s2 + 1] = *(const LAS bf16x8*)(vb + ((sub * 2 + s2) * 64 + 32) * 16); }
        if (sub == 0) {
#pragma unroll
            for (int ks = 0; ks < 4; ++ks) kf[ks] = *(const LAS bf16x8*)(kb + (4 + ks) * 512);
        }
        __builtin_amdgcn_sched_barrier(0);
        float mx = -INFINITY;
#pragma unroll
        for (int i = 0; i < 16; ++i) {
            if (MODE == 2) { const int koff = sub * 32 + (i & 3) + 8 * (i >> 2) + 4 * h; acc[i] = valid(koff) ? acc[i] : -INFINITY; }
            mx = fmaxf(mx, acc[i]);
        }
        {
            const auto sw = __builtin_amdgcn_permlane32_swap(__float_as_uint(mx), __float_as_uint(mx), false, false);
            mx = fmaxf(__uint_as_float(sw[0]), __uint_as_float(sw[1]));
        }
        const float cand = mx * c;
        const bool upd = cand > st.m + FA_THR;
        if (__ballot(upd)) {
            const float mn = upd ? cand : st.m, alpha = __builtin_amdgcn_exp2f(st.m - mn);
            st.m = mn; st.l *= alpha;
#pragma unroll
            for (int i = 0; i < 16; ++i) { st.o0[i] *= alpha; st.o1[i] *= alpha; }
        }
        const float nb = (MODE == 1 && !rowok) ? -INFINITY : -st.m;
        float ps0 = 0.f, ps1 = 0.f;
#pragma unroll
        for (int i = 0; i < 16; i += 2) {
            acc[i] = __builtin_amdgcn_exp2f(__builtin_fmaf(acc[i], c, nb));
            acc[i + 1] = __builtin_amdgcn_exp2f(__builtin_fmaf(acc[i + 1], c, nb));
            ps0 += acc[i]; ps1 += acc[i + 1];
        }
        st.l += ps0 + ps1;
#pragma unroll
        for (int s2 = 0; s2 < 2; ++s2) {
            const bf16x8 pk = cvt8((f32x8){acc[8 * s2], acc[8 * s2 + 1], acc[8 * s2 + 2], acc[8 * s2 + 3], acc[8 * s2 + 4], acc[8 * s2 + 5], acc[8 * s2 + 6], acc[8 * s2 + 7]});
            st.o0 = MFMA32(vf[2 * s2], pk, st.o0);
            st.o1 = MFMA32(vf[2 * s2 + 1], pk, st.o1);
        }
    }
}
DI void fa_issue(const bf16_t* gK, const bf16_t* gV, LAS unsigned char* buf, int tid) {
    __builtin_amdgcn_global_load_lds((const unsigned*)(gK + tid * 8), (LAS unsigned*)(buf + tid * 16), 16, 0, 0);
    __builtin_amdgcn_global_load_lds((const unsigned*)(gK + (tid + 256) * 8), (LAS unsigned*)(buf + (tid + 256) * 16), 16, 0, 0);
    __builtin_amdgcn_global_load_lds((const unsigned*)(gV + tid * 8), (LAS unsigned*)(buf + 8192 + tid * 16), 16, 0, 0);
    __builtin_amdgcn_global_load_lds((const unsigned*)(gV + (tid + 256) * 8), (LAS unsigned*)(buf + 8192 + (tid + 256) * 16), 16, 0, 0);
}
DI void fa_wait(int j, int n) {
    const int rem = n - 1 - j;
    if (rem >= 2) asm volatile("s_waitcnt vmcnt(8)" ::: "memory");
    else if (rem == 1) asm volatile("s_waitcnt vmcnt(4)" ::: "memory");
    else asm volatile("s_waitcnt vmcnt(0)" ::: "memory");
    __builtin_amdgcn_s_barrier();
    asm volatile("" ::: "memory");
}

constexpr int NSA_LDS_IMP = 65536;
constexpr int NSA_LDS_SCS = NSA_LDS_IMP + 8192;
constexpr int NSA_LDS_MSK = NSA_LDS_SCS + 1024;
DI void phase_nsa(const Params& P, unsigned char* smem) {
    unsigned char* ws = P.ws;
    const int tid = threadIdx.x, lane = tid & 63, wave = tid >> 6, r = lane & 31, h = lane >> 5;
    const float c = 0.125f * 1.4426950408889634f;
    LAS unsigned char* lds = (LAS unsigned char*)smem;
    float* impw = (float*)(smem + NSA_LDS_IMP) + wave * 512;
    float* scs = (float*)(smem + NSA_LDS_SCS) + wave * 64;
    unsigned long long* mskw = (unsigned long long*)(smem + NSA_LDS_MSK) + wave * 8;
    for (int it = blockIdx.x; it < 2048; it += gridDim.x) {
        const int qt = 127 - (it >> 4), bg = it & 15, b = bg >> 1, g = bg & 1, t0 = qt * 32, qblk = t0 >> 6;
        const int ql = r >> 2, z = r & 3, s = t0 + wave * 8 + ql, t = b * 4096 + s;
        const bf16_t* Qg = (const bf16_t*)(ws + XP_Q0) + (size_t)t * 512 + (g * 4 + z) * 64;
        bf16x8 qf[4];
#pragma unroll
        for (int ks = 0; ks < 4; ++ks) qf[ks] = *(const bf16x8*)(Qg + ks * 16 + 8 * h);
        const float* gt = (const float*)(ws + XP_GATES) + (size_t)t * 24 + (g * 4 + z) * 3;
        const float g_c = gt[0], g_s = gt[1], g_w = gt[2];
        const bf16_t* Kc = (const bf16_t*)(ws + WS_KCMP) + (size_t)bg * 256 * 64;
        const bf16_t* Vc = (const bf16_t*)(ws + WS_VCMP) + (size_t)bg * 256 * 64;
        const bf16_t* Ks = (const bf16_t*)(ws + XP_KC + 2 * KVSZ) + (size_t)bg * 4096 * 64;
        const bf16_t* Vs = (const bf16_t*)(ws + XP_KC + 3 * KVSZ) + (size_t)bg * 4096 * 64;
        const bf16_t* Kw = (const bf16_t*)(ws + XP_KC + 4 * KVSZ) + (size_t)bg * 4096 * 64;
        const bf16_t* Vw = (const bf16_t*)(ws + XP_KC + 5 * KVSZ) + (size_t)bg * 4096 * 64;
        const int nct = ((t0 >> 4) + 1 + 63) >> 6;
        const int w0 = (t0 - 255) < 0 ? 0 : (t0 - 255) >> 6;
        const int e1 = nct, e2 = 2 * nct, e3 = e2 + qblk + 1, e4 = e3 + (qblk - w0 + 1);
        const int nc = s >= 31 ? ((s - 31) >> 4) + 1 : 0;
        const int s_lo = t0 + wave * 8, s_hi = s_lo + 7, nc_min = s_lo >= 31 ? ((s_lo - 31) >> 4) + 1 : 0;
        for (int i = lane; i < 512; i += 64) impw[i] = 0.f;
        auto tile_ptrs = [&](int i, const bf16_t*& gk, const bf16_t*& gv) {
            if (i < e1) { gk = Kc + (size_t)i * 4096; gv = Vc + (size_t)i * 4096; }
            else if (i < e2) { gk = Kc + (size_t)(i - e1) * 4096; gv = Vc + (size_t)(i - e1) * 4096; }
            else if (i < e3) { gk = Ks + (size_t)(i - e2) * 4096; gv = Vs + (size_t)(i - e2) * 4096; }
            else { gk = Kw + (size_t)(w0 + i - e3) * 4096; gv = Vw + (size_t)(w0 + i - e3) * 4096; }
        };
        FA st; fa_init(st);
        f32x16 out0, out1;
#pragma unroll
        for (int i = 0; i < 16; ++i) { out0[i] = 0.f; out1[i] = 0.f; }
        float m_c = -1e30f, il_c = 0.f;
        unsigned long long mymask = 0ull;
        asm volatile("s_waitcnt vmcnt(0)" ::: "memory");
        __builtin_amdgcn_s_barrier();
#pragma unroll
        for (int i = 0; i < 3; ++i) if (i < e4) { const bf16_t *gk, *gv; tile_ptrs(i, gk, gv); fa_issue(gk, gv, lds + i * 16384, tid); }
        auto step = [&](int i) -> const LAS bf16_t* {
            fa_wait(i, e4);
            if (i + 3 < e4) { const bf16_t *gk, *gv; tile_ptrs(i + 3, gk, gv); fa_issue(gk, gv, lds + ((i + 3) & 3) * 16384, tid); }
            return (const LAS bf16_t*)(lds + (i & 3) * 16384);
        };
        int i = 0;
        for (; i < e1; ++i) {
            const LAS bf16_t* cur = step(i);
            const int nb = i * 64;
            if (nb + 63 < nc_min) fa_tile<0>(st, qf, cur, cur + 4096, r, h, c, true, [=](int) { return true; }); else fa_tile<2>(st, qf, cur, cur + 4096, r, h, c, true, [=](int koff) { return nb + koff < nc; });
        }
        {
            const float l = st.l + __shfl_xor(st.l, 32);
            il_c = 1.f / fmaxf(l, 1e-30f); m_c = st.m;
            const float f = g_c * il_c;
#pragma unroll
            for (int k = 0; k < 16; ++k) { out0[k] = st.o0[k] * f; out1[k] = st.o1[k] * f; }
            fa_init(st);
        }
        for (; i < e2; ++i) {
            const LAS bf16_t* cur = step(i);
            const int nb = (i - e1) * 64;
#pragma unroll
            for (int sub = 0; sub < 2; ++sub) {
                f32x16 acc;
#pragma unroll
                for (int k = 0; k < 16; ++k) acc[k] = 0.f;
#pragma unroll
                for (int ks = 0; ks < 4; ++ks) acc = MFMA32(*(const LAS bf16x8*)(cur + ((sub * 4 + ks) * 32 + r) * 16 + 8 * h), qf[ks], acc);
#pragma unroll
                for (int q4 = 0; q4 < 4; ++q4) {
                    float p[4];
#pragma unroll
                    for (int k = 0; k < 4; ++k) {
                        const int n = nb + sub * 32 + 8 * q4 + 4 * h + k;
                        p[k] = (n < nc) ? __builtin_amdgcn_exp2f(acc[4 * q4 + k] * c - m_c) * il_c : 0.f;
                    }
                    float a = (p[0] + p[1]) + (p[2] + 0.5f * p[3]), cn = 0.5f * p[3];
                    a += __shfl_xor(a, 1); a += __shfl_xor(a, 2);
                    cn += __shfl_xor(cn, 1); cn += __shfl_xor(cn, 2);
                    const int jb = ((nb + sub * 32) >> 2) + 2 * q4 + h;
                    if (z == 0) { atomicAdd(&impw[ql * 64 + jb], a); if (jb + 1 < 64) atomicAdd(&impw[ql * 64 + jb + 1], cn); }
                }
            }
        }
        {
            __builtin_amdgcn_wave_barrier();
#pragma unroll 1
            for (int qq = 0; qq < 8; ++qq) {
                const int j = lane;
                const float imp = impw[qq * 64 + j];
                const float score = (j > qblk) ? -1.f : ((j == 0 || j == qblk || j == qblk - 1) ? 1e3f : imp);
                scs[j] = score;
                __builtin_amdgcn_wave_barrier();
                int rank = 0;
#pragma unroll 8
                for (int jj = 0; jj < 64; ++jj) { const float o = scs[jj]; rank += (o > score || (o == score && jj < j)) ? 1 : 0; }
                const unsigned long long mk = __ballot(rank < 8 && score >= 0.f);
                if (lane == 0) mskw[qq] = mk;
                __builtin_amdgcn_wave_barrier();
            }
            mymask = mskw[ql];
        }
        for (; i < e3 - 1; ++i) {
            const LAS bf16_t* cur = step(i);
            const bool sel = (mymask >> (i - e2)) & 1ull;
            if (__ballot(sel)) fa_tile<1>(st, qf, cur, cur + 4096, r, h, c, sel, [=](int) { return true; });
        }
        {
            const LAS bf16_t* cur = step(i);
            const int kb = qblk * 64;
            fa_tile<2>(st, qf, cur, cur + 4096, r, h, c, true, [=](int koff) { return kb + koff <= s; });
            ++i;
            const float l = st.l + __shfl_xor(st.l, 32);
            const float f = g_s / fmaxf(l, 1e-30f);
#pragma unroll
            for (int k = 0; k < 16; ++k) { out0[k] += st.o0[k] * f; out1[k] += st.o1[k] * f; }
            fa_init(st);
        }
        for (; i < e4; ++i) {
            const LAS bf16_t* cur = step(i);
            const int kb = (w0 + i - e3) * 64;
            if (kb >= s_hi - 255 && kb + 63 <= s_lo) fa_tile<0>(st, qf, cur, cur + 4096, r, h, c, true, [=](int) { return true; }); else fa_tile<2>(st, qf, cur, cur + 4096, r, h, c, true, [=](int koff) { const int key = kb + koff; return key <= s && key >= s - 255; });
        }
        {
            const float l = st.l + __shfl_xor(st.l, 32);
            const float f = g_w / fmaxf(l, 1e-30f);
#pragma unroll
            for (int k = 0; k < 16; ++k) { out0[k] += st.o0[k] * f; out1[k] += st.o1[k] * f; }
        }
        bf16_t* o = (bf16_t*)(ws + WS_MIX) + (size_t)t * 1024 + (g * 4 + z) * 64;
#pragma unroll
        for (int g4 = 0; g4 < 4; ++g4) {
            *(u32x2*)(o + 8 * g4 + 4 * h) = cvt4((f32x4){out0[4 * g4], out0[4 * g4 + 1], out0[4 * g4 + 2], out0[4 * g4 + 3]});
            *(u32x2*)(o + 32 + 8 * g4 + 4 * h) = cvt4((f32x4){out1[4 * g4], out1[4 * g4 + 1], out1[4 * g4 + 2], out1[4 * g4 + 3]});
        }
    }
}

DI void phase_glu(const Params& P, unsigned char* smem) {
    unsigned char* ws = P.ws;
    const bf16_t* G5 = (const bf16_t*)(ws + XP_G5);
    const float* gb = P.in[17];
    bool pre = false;
    for (int it = vblock(); it < (NT / 128) * 4; it += gridDim.x) {
        int mt, nt; tile_mn(it, 4, mt, nt);
        const int m0 = mt * 128;
        const bool hn = it + (int)gridDim.x < (NT / 128) * 4;
        int mtn = 0, ntn = 0; if (hn) tile_mn(it + gridDim.x, 4, mtn, ntn);
        auto nextrow = [=](int r) { return G5 + (size_t)(mtn * 128 + r) * 512; };
        auto rowptr = [=](int r) { return G5 + (size_t)(m0 + r) * 512; };
        auto epi = [=](f32x4 (&acc)[4][4], int wr, int wc, int ln) {
            const int fr = ln & 15, fq = ln >> 4;
#pragma unroll
            for (int m = 0; m < 4; ++m) {
                const int row = m0 + wr * 64 + m * 16 + fr;
#pragma unroll
                for (int n = 0; n < 4; ++n) {
                    const int col = nt * 128 + wc * 64 + n * 16 + fq * 4;
                    const f32x4 gv = bf4_to_f(*(const u32x2*)(G5 + (size_t)row * 512 + col)), bb = *(const f32x4*)(gb + col), z = acc[m][n] + bb;
                    *(u32x2*)((bf16_t*)(ws + WS_MIX) + (size_t)row * 1024 + 512 + col) = cvt4((f32x4){gv.x * sigmoidf_(z.x), gv.y * sigmoidf_(z.y), gv.z * sigmoidf_(z.z), gv.w * sigmoidf_(z.w)});
                }
            }
        };
        gemm128s(rowptr, (const bf16_t*)(ws + WS_WGLU) + (size_t)nt * 128 * 512, 512, 512, smem, epi, pre, hn, nextrow, (const bf16_t*)(ws + WS_WGLU) + (size_t)ntn * 128 * 512);
        pre = hn;
    }
}

template <bool RB>
DI void phase_outproj(const Params& P, unsigned char* smem, const float* xres, const bf16_t* xresb, size_t wt_off) {
    unsigned char* ws = P.ws;
    const bf16_t* A = (const bf16_t*)(ws + WS_MIX);
    bf16_t* preb = (bf16_t*)(ws + XP_PRE);
    bool pre = false;
    for (int it = vblock(); it < (NT / 128) * 8; it += gridDim.x) {
        int mt, nt; tile_mn(it, 8, mt, nt);
        const int m0 = mt * 128;
        const bool hn = it + (int)gridDim.x < (NT / 128) * 8;
        int mtn = 0, ntn = 0; if (hn) tile_mn(it + gridDim.x, 8, mtn, ntn);
        auto nextrow = [=](int r) { return A + (size_t)(mtn * 128 + r) * 1024; };
        auto rowptr = [=](int r) { return A + (size_t)(m0 + r) * 1024; };
        auto epi = [=](f32x4 (&acc)[4][4], int wr, int wc, int ln) {
            const int fr = ln & 15, fq = ln >> 4;
#pragma unroll
            for (int m = 0; m < 4; ++m) {
                const size_t base = (size_t)(m0 + wr * 64 + m * 16 + fr) * 1024 + nt * 128 + wc * 64 + fq * 4;
                f32x4 xr[4];
#pragma unroll
                for (int n = 0; n < 4; ++n) xr[n] = RB ? bf4_to_f(*(const u32x2*)(xresb + base + n * 16)) : *(const f32x4*)(xres + base + n * 16);
#pragma unroll
                for (int n = 0; n < 4; ++n) *(u32x2*)(preb + base + n * 16) = cvt4(xr[n] * ALPHA + acc[m][n]);
            }
        };
        gemm128s(rowptr, (const bf16_t*)(ws + wt_off) + (size_t)nt * 128 * 1024, 1024, 1024, smem, epi, pre, hn, nextrow, (const bf16_t*)(ws + wt_off) + (size_t)ntn * 128 * 1024);
        pre = hn;
    }
}

DI void ln_row(float (&v)[16], const float* __restrict__ g, const float* __restrict__ bta, int lane) {
    float s = 0.f;
#pragma unroll
    for (int i = 0; i < 16; ++i) s += v[i];
    const float mu = wave_sum(s) * (1.f / 1024.f);
    float q = 0.f;
#pragma unroll
    for (int i = 0; i < 16; ++i) { v[i] -= mu; q += v[i] * v[i]; }
    const float rstd = rsqrtf(wave_sum(q) * (1.f / 1024.f) + LN_EPS);
#pragma unroll
    for (int j = 0; j < 4; ++j) {
        const float4 gg = *(const float4*)(g + 4 * lane + 256 * j), bb = *(const float4*)(bta + 4 * lane + 256 * j);
        v[4 * j + 0] = v[4 * j + 0] * rstd * gg.x + bb.x; v[4 * j + 1] = v[4 * j + 1] * rstd * gg.y + bb.y;
        v[4 * j + 2] = v[4 * j + 2] * rstd * gg.z + bb.z; v[4 * j + 3] = v[4 * j + 3] * rstd * gg.w + bb.w;
    }
}

DI void phase_ln_router(const Params& P, int layer) {
    unsigned char* ws = P.ws;
    const int lane = threadIdx.x & 63, wave = threadIdx.x >> 6;
    const float* g = P.in[21] + layer * 1024; const float* bta = P.in[22] + layer * 1024;
    const float* wc = (const float*)(ws + WS_RTRW) + (size_t)layer * 36864; const float* bc = P.in[26] + layer * 4;
    const float* wf = wc + 4096; const float* bfn = P.in[28] + layer * 32;
    int* cnt = (int*)(ws + WS_CTL) + layer * 2048;
    int* list = (int*)(ws + WS_LIST2);
    float* wgt = (float*)(ws + WS_WGT);
    bf16_t* xb = (bf16_t*)(ws + WS_ACTB);
    for (int task = blockIdx.x * 4 + wave; task < NT / 16; task += gridDim.x * 4) {
        int my_e = 0; float my_w = 0.f;
        f32x4 wcr[16];
#pragma unroll
        for (int q = 0; q < 16; ++q) wcr[q] = *(const f32x4*)(wc + (q * 64 + lane) * 4);
        const bf16_t* pre = (const bf16_t*)(ws + XP_PRE);
        u32x2 nxb[4];
#pragma unroll
        for (int j = 0; j < 4; ++j) nxb[j] = __builtin_nontemporal_load((const u32x2*)(pre + (size_t)(task * 16) * 1024 + 4 * lane + 256 * j));
#pragma unroll 1
        for (int i = 0; i < 16; ++i) {
            const int t = task * 16 + i;
            float v[16];
#pragma unroll
            for (int j = 0; j < 4; ++j) { const f32x4 nx = bf4_to_f(nxb[j]); v[4 * j] = nx.x; v[4 * j + 1] = nx.y; v[4 * j + 2] = nx.z; v[4 * j + 3] = nx.w; }
            if (i + 1 < 16) {
#pragma unroll
                for (int j = 0; j < 4; ++j) nxb[j] = __builtin_nontemporal_load((const u32x2*)(pre + (size_t)(t + 1) * 1024 + 4 * lane + 256 * j));
            }
            ln_row(v, g, bta, lane);
#pragma unroll
            for (int j = 0; j < 4; ++j) {
                *(u32x2*)(xb + (size_t)t * 1024 + 4 * lane + 256 * j) = cvt4((f32x4){v[4 * j], v[4 * j + 1], v[4 * j + 2], v[4 * j + 3]});
            }
            float lc[4] = {0.f, 0.f, 0.f, 0.f};
#pragma unroll
            for (int j = 0; j < 4; ++j)
#pragma unroll
                for (int k = 0; k < 4; ++k) {
                    const f32x4 w = wcr[j * 4 + k];
                    const float x = v[4 * j + k];
                    lc[0] += x * w.x; lc[1] += x * w.y; lc[2] += x * w.z; lc[3] += x * w.w;
                }
#pragma unroll
            for (int c = 0; c < 4; ++c) lc[c] = wave_sum(lc[c]) + bc[c];
            int gi = 0; float lm = lc[0];
#pragma unroll
            for (int c = 1; c < 4; ++c) if (lc[c] > lm) { lm = lc[c]; gi = c; }
            gi = __builtin_amdgcn_readfirstlane(gi);
            float den = 0.f;
#pragma unroll
            for (int c = 0; c < 4; ++c) den += expf(lc[c] - lm);
            const float gv = 1.f / den;
            float lf[8] = {0.f, 0.f, 0.f, 0.f, 0.f, 0.f, 0.f, 0.f};
            const float* wfg = wf + (size_t)gi * 8192;
#pragma unroll
            for (int j = 0; j < 4; ++j)
#pragma unroll
                for (int k = 0; k < 4; ++k) {
                    const f32x4 w0 = *(const f32x4*)(wfg + (((j * 4 + k) * 2 + 0) * 64 + lane) * 4), w1 = *(const f32x4*)(wfg + (((j * 4 + k) * 2 + 1) * 64 + lane) * 4);
                    const float x = v[4 * j + k];
                    lf[0] += x * w0.x; lf[1] += x * w0.y; lf[2] += x * w0.z; lf[3] += x * w0.w;
                    lf[4] += x * w1.x; lf[5] += x * w1.y; lf[6] += x * w1.z; lf[7] += x * w1.w;
                }
#pragma unroll
            for (int e = 0; e < 8; ++e) lf[e] = wave_sum(lf[e]) + bfn[gi * 8 + e];
            int e1 = 0; float l1 = lf[0];
#pragma unroll
            for (int e = 1; e < 8; ++e) if (lf[e] > l1) { l1 = lf[e]; e1 = e; }
            int e2 = 0; float l2 = -INFINITY;
#pragma unroll
            for (int e = 0; e < 8; ++e) if (e != e1 && lf[e] > l2) { l2 = lf[e]; e2 = e; }
            const float r = expf(l2 - l1);
            if (lane == i) { my_e = gi * 8 + e1; my_w = gv / (1.f + r); }
            if (lane == 16 + i) { my_e = gi * 8 + e2; my_w = gv * r / (1.f + r); }
        }
        if (lane < 32) {
            const int t = task * 16 + (lane & 15), k = lane >> 4, slot = (task & 63) * 32 + my_e;
            const int pos = atomicAdd(&cnt[slot], 1);
            list[(slot << 10) + pos] = t * 2 + k;
            wgt[t * 2 + k] = my_w;
        }
    }
}

constexpr int MOE_LDS_TAB = 65536;
constexpr int MOE_LDS_ROW = 65536 + 8448;
DI void moe_tables(const int* cnt, unsigned char* smem) {
    int* tab = (int*)(smem + MOE_LDS_TAB);
    if (threadIdx.x < 32) { const int e = threadIdx.x; int run = 0; for (int s = 0; s < 64; ++s) { tab[e * 65 + s] = run; run += cnt[s * 32 + e]; } tab[e * 65 + 64] = run; }
    __syncthreads();
}
DI bool moe_tile(const int* tab, int tile, int& e, int& mt, int& off, int& ce) {
    int acc_t = 0, acc_r = 0;
    for (int i = 0; i < 32; ++i) {
        const int c = tab[i * 65 + 64], nt = (c + 127) >> 7;
        if (tile < acc_t + nt) { e = i; mt = tile - acc_t; off = acc_r; ce = c; return true; }
        acc_t += nt; acc_r += c;
    }
    return false;
}
DI int moe_ntiles(const int* tab) { int a = 0; for (int i = 0; i < 32; ++i) a += (tab[i * 65 + 64] + 127) >> 7; return a; }
DI void moe_rows(const int* tab, const int* list, int e, int mt, int ce, int* rowidx) {
    if (threadIdx.x < 128) {
        const int pos = mt * 128 + threadIdx.x;
        int idx = -1;
        if (pos < ce) {
            int lo = 0, hi = 64;
            while (hi - lo > 1) { const int mid = (lo + hi) >> 1; if (tab[e * 65 + mid] <= pos) lo = mid; else hi = mid; }
            idx = list[((lo * 32 + e) << 10) + pos - tab[e * 65 + lo]];
        }
        rowidx[threadIdx.x] = idx;
    }
    __syncthreads();
}

DI void phase_moe_gu(const Params& P, unsigned char* smem, int layer) {
    unsigned char* ws = P.ws;
    const int* cnt = (const int*)(ws + WS_CTL) + layer * 2048;
    const int* list = (const int*)(ws + WS_LIST2);
    const float* wgt = (const float*)(ws + WS_WGT);
    const bf16_t* xb = (const bf16_t*)(ws + WS_ACTB);
    bf16_t* H = (bf16_t*)(ws + XP_H);
    const int* tab = (const int*)(smem + MOE_LDS_TAB);
    int* rowidx = (int*)(smem + MOE_LDS_ROW);
    moe_tables(cnt, smem);
    const int ntile = moe_ntiles(tab);
    for (int it = vblock(); it < ntile * 2; it += gridDim.x) {
        int e, mt, off, ce; moe_tile(tab, it >> 1, e, mt, off, ce);
        const int nt = it & 1;
        moe_rows(tab, list, e, mt, ce, rowidx);
        auto rowptr = [=](int r) { int idx = rowidx[r]; idx = idx < 0 ? rowidx[0] : idx; return xb + (size_t)(idx >> 1) * 1024; };
        auto epi = [=](f32x4 (&acc)[4][4], int wr, int wc, int ln) {
            const int fr = ln & 15, fq = ln >> 4;
#pragma unroll
            for (int m = 0; m < 4; ++m) {
                const int rl = wr * 64 + m * 16 + fr, idx = rowidx[rl];
                if (idx >= 0) {
                    const float w = wgt[idx];
#pragma unroll
                    for (int n = 0; n < 2; ++n) {
                        const f32x4 gte = acc[m][n], up = acc[m][n + 2];
                        *(u32x2*)(H + (size_t)(off + mt * 128 + rl) * 128 + (nt * 2 + wc) * 32 + n * 16 + fq * 4) =
                            cvt4((f32x4){gte.x * sigmoidf_(gte.x) * up.x * w, gte.y * sigmoidf_(gte.y) * up.y * w, gte.z * sigmoidf_(gte.z) * up.z * w, gte.w * sigmoidf_(gte.w) * up.w * w});
                    }
                }
            }
        };
        gemm128(rowptr, (const bf16_t*)(ws + WS_WGU) + ((size_t)(layer * 32 + e) * 256 + nt * 128) * 1024, 1024, 1024, smem, epi);
        __syncthreads();
    }
}
DI void phase_moe_down(const Params& P, unsigned char* smem, int layer) {
    unsigned char* ws = P.ws;
    const int* cnt = (const int*)(ws + WS_CTL) + layer * 2048;
    const int* list = (const int*)(ws + WS_LIST2);
    const bf16_t* H = (const bf16_t*)(ws + XP_H);
    bf16_t* YB = (bf16_t*)(ws + XP_YB);
    const int* tab = (const int*)(smem + MOE_LDS_TAB);
    int* rowidx = (int*)(smem + MOE_LDS_ROW);
    moe_tables(cnt, smem);
    const int ntile = moe_ntiles(tab);
    for (int it = vblock(); it < ntile * 8; it += gridDim.x) {
        int e, mt, off, ce; moe_tile(tab, it >> 3, e, mt, off, ce);
        const int nt = it & 7;
        moe_rows(tab, list, e, mt, ce, rowidx);
        auto rowptr = [=](int r) { int pos = mt * 128 + r; pos = pos < ce ? pos : 0; return H + (size_t)(off + pos) * 128; };
        auto epi = [=](f32x4 (&acc)[4][4], int wr, int wc, int ln) {
            const int fr = ln & 15, fq = ln >> 4;
#pragma unroll
            for (int m = 0; m < 4; ++m) {
                const int idx = rowidx[wr * 64 + m * 16 + fr];
                if (idx >= 0) {
                    bf16_t* dst = YB + (size_t)idx * 1024 + nt * 128 + wc * 64 + fq * 4;
#pragma unroll
                    for (int n = 0; n < 4; ++n) *(u32x2*)(dst + n * 16) = cvt4(acc[m][n]);
                }
            }
        };
        gemm128(rowptr, (const bf16_t*)(ws + WS_WDN) + ((size_t)(layer * 32 + e) * 1024 + nt * 128) * 128, 128, 128, smem, epi);
        __syncthreads();
    }
}
DI void phase_ln_ffn(const Params& P, int layer) {
    unsigned char* ws = P.ws;
    const int lane = threadIdx.x & 63, wave = threadIdx.x >> 6;
    const float* g = P.in[23] + layer * 1024; const float* bta = P.in[24] + layer * 1024;
    const bf16_t* YB = (const bf16_t*)(ws + XP_YB);
    bf16_t* xb = (bf16_t*)(ws + WS_ACTB);
    for (int task = blockIdx.x * 4 + wave; task < NT / 16; task += gridDim.x * 4) {
        u32x2 nxm[4], ny0[4], ny1[4];
        auto fetch = [&](int t) {
#pragma unroll
            for (int j = 0; j < 4; ++j) {
                nxm[j] = __builtin_nontemporal_load((const u32x2*)(xb + (size_t)t * 1024 + 4 * lane + 256 * j));
                ny0[j] = __builtin_nontemporal_load((const u32x2*)(YB + (size_t)(2 * t) * 1024 + 4 * lane + 256 * j));
                ny1[j] = __builtin_nontemporal_load((const u32x2*)(YB + (size_t)(2 * t + 1) * 1024 + 4 * lane + 256 * j));
            }
        };
        fetch(task * 16);
#pragma unroll 1
        for (int i = 0; i < 16; ++i) {
            const int t = task * 16 + i;
            float v[16];
#pragma unroll
            for (int j = 0; j < 4; ++j) {
                const f32x4 a = bf4_to_f(nxm[j]), y0 = bf4_to_f(ny0[j]), y1 = bf4_to_f(ny1[j]);
                v[4 * j + 0] = ALPHA * a.x + (y0.x + y1.x); v[4 * j + 1] = ALPHA * a.y + (y0.y + y1.y);
                v[4 * j + 2] = ALPHA * a.z + (y0.z + y1.z); v[4 * j + 3] = ALPHA * a.w + (y0.w + y1.w);
            }
            if (i + 1 < 16) fetch(t + 1);
            ln_row(v, g, bta, lane);
            float* row = P.out + (size_t)t * 1024;
#pragma unroll
            for (int j = 0; j < 4; ++j) {
                if (layer == 0) *(u32x2*)((bf16_t*)P.out + (size_t)t * 1024 + 4 * lane + 256 * j) = cvt4((f32x4){v[4 * j], v[4 * j + 1], v[4 * j + 2], v[4 * j + 3]});
                else *(f32x4*)(row + 4 * lane + 256 * j) = (f32x4){v[4 * j], v[4 * j + 1], v[4 * j + 2], v[4 * j + 3]};
            }
        }
    }
}

DI void phase_inproj1(const Params& P, unsigned char* smem) {
    unsigned char* ws = P.ws;
    const bf16_t* A = (const bf16_t*)P.out;
    const float* cosT = (const float*)(ws + WS_ROPE);
    const float* sinT = cosT + 4096 * 32;
    bool pre = false;
    for (int it = vblock(); it < (NT / 128) * 24; it += gridDim.x) {
        int mt, nt; tile_mn(it, 24, mt, nt);
        const int m0 = mt * 128;
        auto rowptr = [=](int r) { return A + (size_t)(m0 + r) * 1024; };
        const bf16_t* Bt = (const bf16_t*)(ws + WS_WIN1) + (size_t)nt * 128 * 1024;
        const bool hn = it + (int)gridDim.x < (NT / 128) * 24;
        int mtn = 0, ntn = 0; if (hn) tile_mn(it + gridDim.x, 24, mtn, ntn);
        auto nextrow = [=](int r) { return A + (size_t)(mtn * 128 + r) * 1024; };
        const bf16_t* nBt = (const bf16_t*)(ws + WS_WIN1) + (size_t)ntn * 128 * 1024;
        if (nt >= 16) {
            auto epi = [=](f32x4 (&acc)[4][4], int wr, int wc, int lane) {
                const int head = (nt * 2 + wc) & 15, fr = lane & 15, fq = lane >> 4;
#pragma unroll
                for (int m = 0; m < 4; ++m) {
                    const int t = m0 + wr * 64 + m * 16 + fq * 4, s = t & 4095, b = t >> 12;
                    bf16_t* base = (bf16_t*)(ws + XP_Q1 + (size_t)2 * 64 * MiB) + (size_t)(b * 16 + head) * 4096 * 64;
#pragma unroll
                    for (int n = 0; n < 4; ++n) *(u32x2*)(base + vp_off(s, n * 16 + fr)) = cvt4(acc[m][n]);
                }
            };
            gemm128s<false>(rowptr, Bt, 1024, 1024, smem, epi, pre, hn, nextrow, nBt);
            pre = hn;
            continue;
        }
        auto epi = [=](f32x4 (&acc)[4][4], int wr, int wc, int lane) {
            const int u64 = nt * 2 + wc, kind = u64 >> 4, head = u64 & 15, fr = lane & 15, fq = lane >> 4;
            f32x4 cs[2][2];
#pragma unroll
            for (int n2 = 0; n2 < 2; ++n2) { cs[n2][0] = (f32x4){0.f, 0.f, 0.f, 0.f}; cs[n2][1] = cs[n2][0]; }
#pragma unroll
            for (int m = 0; m < 4; ++m) {
                const int t = m0 + wr * 64 + m * 16 + fr, s = t & 4095, b = t >> 12;
                bf16_t* base = (bf16_t*)(ws + XP_Q1 + (size_t)kind * 64 * MiB) + (size_t)(b * 16 + head) * 4096 * 64;
#pragma unroll
                for (int n2 = 0; n2 < 2; ++n2) {
                    const int i = n2 * 16 + fq * 4;
                    const f32x4 c = *(const f32x4*)(cosT + s * 32 + i), sn = *(const f32x4*)(sinT + s * 32 + i);
                    const f32x4 x1 = acc[m][2 * n2], x2 = acc[m][2 * n2 + 1];
                    const f32x4 r1 = x1 * c - x2 * sn, r2 = x1 * sn + x2 * c;
                    const u32x2 o1 = cvt4(r1), o2 = cvt4(r2);
                    if (kind == 0) { *(u32x2*)(base + (size_t)s * 64 + i) = o1; *(u32x2*)(base + (size_t)s * 64 + i + 32) = o2; }
                    else { *(u32x2*)(base + kp_off(s, i)) = o1; *(u32x2*)(base + kp_off(s, i + 32)) = o2; cs[n2][0] += r1; cs[n2][1] += r2; }
                }
            }
            if (kind == 1) {
                const int t0 = m0 + wr * 64, bh = (t0 >> 12) * 16 + head, seg = (t0 & 4095) >> 6;
                float* dst = (float*)(ws + WS_KMP) + ((size_t)bh * 64 + seg) * 64;
#pragma unroll
                for (int n2 = 0; n2 < 2; ++n2)
#pragma unroll
                    for (int hf = 0; hf < 2; ++hf) {
                        f32x4 v = cs[n2][hf];
#pragma unroll
                        for (int k = 0; k < 4; ++k) { float x = v[k]; x += dpp_f<0xB1>(x); x += dpp_f<0x4E>(x); x += dpp_f<0x141>(x); x += dpp_f<0x140>(x); v[k] = x; }
                        if (fr == 0) *(f32x4*)(dst + n2 * 16 + fq * 4 + hf * 32) = v;
                    }
            }
        };
        gemm128s(rowptr, Bt, 1024, 1024, smem, epi, pre, hn, nextrow, nBt);
        pre = hn;
    }
}
DI void moba_kmeans_slab(const Params& P, bf16_t* kml, int bh, int tid) {
    const float* kp = (const float*)(P.ws + WS_KMP) + (size_t)bh * 64 * 64;
    for (int e = tid; e < 2048; e += 256) {
        const int d = e & 63, n = e >> 6;
        float a = 0.f;
        if (n < 16) a = ((kp[(4 * n) * 64 + d] + kp[(4 * n + 1) * 64 + d]) + (kp[(4 * n + 2) * 64 + d] + kp[(4 * n + 3) * 64 + d])) * (1.f / 256.f);
        kml[((d >> 4) * 32 + n) * 16 + (d & 15)] = f2bf(a);
    }
}
DI unsigned moba_gate_rows(const bf16_t* km, const bf16x8 (&qf)[4], int own, int r, int h) {
    f32x16 g;
#pragma unroll
    for (int i = 0; i < 16; ++i) g[i] = 0.f;
#pragma unroll
    for (int ks = 0; ks < 4; ++ks) g = MFMA32(*(const bf16x8*)(km + (ks * 32 + r) * 16 + 8 * h), qf[ks], g);
    float mine[8], oth[8];
#pragma unroll
    for (int i = 0; i < 8; ++i) { const int n = (i & 3) + 8 * (i >> 2) + 4 * h; mine[i] = n < own ? g[i] : -INFINITY; oth[i] = __shfl_xor(mine[i], 32); }
    unsigned selmask = 0;
#pragma unroll
    for (int i = 0; i < 8; ++i) {
        const int n = (i & 3) + 8 * (i >> 2) + 4 * h;
        int rank = 0;
#pragma unroll
        for (int k = 0; k < 8; ++k) {
            const int nk = (k & 3) + 8 * (k >> 2) + 4 * h, no = (k & 3) + 8 * (k >> 2) + 4 * (1 - h);
            rank += (mine[k] > mine[i] || (mine[k] == mine[i] && nk < n)) ? 1 : 0;
            rank += (oth[k] > mine[i] || (oth[k] == mine[i] && no < n)) ? 1 : 0;
        }
        if (n < own && rank < 3) selmask |= 1u << n;
    }
    return selmask | __shfl_xor(selmask, 32);
}
DI void phase_moba_gate(const Params& P, unsigned char* smem) {
    unsigned char* ws = P.ws;
    const int tid = threadIdx.x, lane = tid & 63, wave = tid >> 6, r = lane & 31, h = lane >> 5;
    bf16_t* kml = (bf16_t*)smem;
    unsigned short* smask = (unsigned short*)(smem + 4096);
    unsigned short* selm = (unsigned short*)(ws + WS_SELM);
    unsigned short* mcnt = (unsigned short*)(ws + WS_MCNT);
    unsigned char* mlist = ws + WS_MLIST;
    int km_bh = -1;
    for (int it = blockIdx.x; it < 2048; it += gridDim.x) {
        const int bh = it & 127, qb = it >> 7;
        if (bh != km_bh) { km_bh = bh; __syncthreads(); moba_kmeans_slab(P, kml, bh, tid); }
        __syncthreads();
#pragma unroll 1
        for (int g2 = 0; g2 < 2; ++g2) {
            const int rl = wave * 64 + g2 * 32 + r, q = qb * 256 + rl;
            const bf16_t* Qg = (const bf16_t*)(ws + XP_Q1) + ((size_t)bh * 4096 + q) * 64;
            bf16x8 qf[4];
#pragma unroll
            for (int ks = 0; ks < 4; ++ks) qf[ks] = *(const bf16x8*)(Qg + ks * 16 + 8 * h);
            const unsigned sm = qb > 0 ? moba_gate_rows(kml, qf, qb, r, h) : 0u;
            if (h == 0) { selm[(size_t)bh * 4096 + q] = (unsigned short)sm; smask[rl] = (unsigned short)sm; }
        }
        __syncthreads();
        for (int n = wave; n < qb; n += 4) {
            unsigned char* lp = mlist + ((size_t)(bh * 16 + qb) * 16 + n) * 256;
            int base = 0;
#pragma unroll
            for (int c4 = 0; c4 < 4; ++c4) {
                const int row = c4 * 64 + lane;
                const bool bit = (smask[row] >> n) & 1;
                const unsigned long long bal = __ballot(bit);
                if (bit) lp[base + __builtin_popcountll(bal & ((1ull << lane) - 1ull))] = (unsigned char)row;
                base += __builtin_popcountll(bal);
            }
            if (lane == 0) mcnt[(bh * 16 + qb) * 16 + n] = (unsigned short)base;
        }
    }
}
DI bf16_t* moba_po(const Params& P, int slot) { return (bf16_t*)(P.ws + (slot == 0 ? WS_MIX : slot == 1 ? WS_ACTB : WS_PO2)); }
DI void phase_moba_kv(const Params& P, unsigned char* smem) {
    unsigned char* ws = P.ws;
    const int tid = threadIdx.x, lane = tid & 63, wave = tid >> 6, r = lane & 31, h = lane >> 5;
    const float c = 0.125f * 1.4426950408889634f;
    LAS unsigned char* lds = (LAS unsigned char*)smem;
    const unsigned short* selm = (const unsigned short*)(ws + WS_SELM);
    const unsigned short* mcnt = (const unsigned short*)(ws + WS_MCNT);
    const unsigned char* mlist = ws + WS_MLIST;
    float* pml = (float*)(ws + WS_PML);
    const bool bal = (gridDim.x == 512);
    const int nit = bal ? ((blockIdx.x >> 7) == 3 ? 3 : 4) : (1920 + (int)gridDim.x - 1 - (int)blockIdx.x) / (int)gridDim.x;
    for (int iti = 0; iti < nit; ++iti) {
        int bh, n;
        if (bal) { const int gq = blockIdx.x >> 7; bh = blockIdx.x & 127; const int tab = gq == 0 ? 0x0DA90 : gq == 1 ? 0x0CB61 : gq == 2 ? 0x0E852 : 0x00743; n = (tab >> (4 * iti)) & 15; }
        else { const int it = blockIdx.x + iti * gridDim.x; n = it >> 7; bh = it & 127; }
        const bf16_t* Kg = (const bf16_t*)(ws + XP_Q1 + 64 * MiB) + (size_t)bh * 4096 * 64 + (size_t)n * 4 * 4096;
        const bf16_t* Vg = (const bf16_t*)(ws + XP_Q1 + 128 * MiB) + (size_t)bh * 4096 * 64 + (size_t)n * 4 * 4096;
        asm volatile("s_waitcnt vmcnt(0)" ::: "memory");
        __builtin_amdgcn_s_barrier();
#pragma unroll
        for (int j = 0; j < 4; ++j) fa_issue(Kg + (size_t)j * 4096, Vg + (size_t)j * 4096, lds + j * 16384, tid);
        const int cntv = (lane < 16 && lane > n) ? (int)mcnt[(bh * 16 + lane) * 16 + n] : 0;
        asm volatile("s_waitcnt vmcnt(0)" ::: "memory");
        __builtin_amdgcn_s_barrier();
        asm volatile("" ::: "memory");
        int prefv = 0, total = 0;
#pragma unroll 1
        for (int qb = 0; qb < 16; ++qb) { if (lane == qb) prefv = total; total += __builtin_amdgcn_readlane(cntv, qb); }
#pragma unroll 1
        for (int v0 = wave * 32; v0 < total; v0 += 128) {
            const int v = v0 + r;
            const bool valid = v < total;
            const int vv = valid ? v : v0;
            int qb = n + 1;
#pragma unroll 1
            for (int l = n + 2; l < 16; ++l) if (vv >= __builtin_amdgcn_readlane(prefv, l)) qb = l;
            const int idx = vv - __shfl(prefv, qb);
            const int q = qb * 256 + (int)mlist[((size_t)(bh * 16 + qb) * 16 + n) * 256 + idx];
            const bf16_t* Qg = (const bf16_t*)(ws + XP_Q1) + ((size_t)bh * 4096 + q) * 64;
            bf16x8 qf[4];
#pragma unroll
            for (int ks = 0; ks < 4; ++ks) qf[ks] = *(const bf16x8*)(Qg + ks * 16 + 8 * h);
            FA st; fa_init(st);
#pragma unroll 1
            for (int j = 0; j < 4; ++j) {
                const LAS bf16_t* cur = (const LAS bf16_t*)(lds + j * 16384);
                fa_tile<0>(st, qf, cur, cur + 4096, r, h, c, true, [=](int) { return true; });
            }
            const float l = st.l + __shfl_xor(st.l, 32);
            const float inv = 1.f / fmaxf(l, 1e-30f);
            if (valid) {
                const int slot = __builtin_popcount((unsigned)selm[(size_t)bh * 4096 + q] & ((1u << n) - 1u));
                bf16_t* o = moba_po(P, slot) + ((size_t)(bh >> 4) * 4096 + q) * 1024 + (bh & 15) * 64;
                nat_store(o, h, st.o0, st.o1, inv);
                if (h == 0) { float* pm = pml + (((size_t)bh * 4096 + q) * 3 + slot) * 2; pm[0] = st.m; pm[1] = l; }
            }
        }
    }
}
DI void phase_moba_own(const Params& P, unsigned char* smem) {
    unsigned char* ws = P.ws;
    const int tid = threadIdx.x, lane = tid & 63, wave = tid >> 6, r = lane & 31, h = lane >> 5;
    const float c = 0.125f * 1.4426950408889634f;
    LAS unsigned char* lds = (LAS unsigned char*)smem;
    const unsigned short* selm = (const unsigned short*)(ws + WS_SELM);
    const float* pml = (const float*)(ws + WS_PML);
    for (int it = blockIdx.x; it < 2048; it += gridDim.x) {
        const int own = 15 - (it >> 7), bh = it & 127, t0 = own * 256;
        const bf16_t* Kg = (const bf16_t*)(ws + XP_Q1 + 64 * MiB) + (size_t)bh * 4096 * 64 + (size_t)own * 4 * 4096;
        const bf16_t* Vg = (const bf16_t*)(ws + XP_Q1 + 128 * MiB) + (size_t)bh * 4096 * 64 + (size_t)own * 4 * 4096;
        asm volatile("s_waitcnt vmcnt(0)" ::: "memory");
        __builtin_amdgcn_s_barrier();
#pragma unroll
        for (int j = 0; j < 4; ++j) fa_issue(Kg + (size_t)j * 4096, Vg + (size_t)j * 4096, lds + j * 16384, tid);
        asm volatile("s_waitcnt vmcnt(0)" ::: "memory");
        __builtin_amdgcn_s_barrier();
        asm volatile("" ::: "memory");
#pragma unroll 1
        for (int g2 = 0; g2 < 2; ++g2) {
            const int row0 = t0 + g2 * 128 + wave * 32, q = row0 + r;
            const bf16_t* Qg = (const bf16_t*)(ws + XP_Q1) + ((size_t)bh * 4096 + q) * 64;
            bf16x8 qf[4];
#pragma unroll
            for (int ks = 0; ks < 4; ++ks) qf[ks] = *(const bf16x8*)(Qg + ks * 16 + 8 * h);
            const int nsel = __builtin_popcount((unsigned)selm[(size_t)bh * 4096 + q]);
            const size_t orow = ((size_t)(bh >> 4) * 4096 + q) * 1024 + (bh & 15) * 64;
            const float* pm = pml + ((size_t)bh * 4096 + q) * 6;
            float mi[3], li[3];
            u32x4 pa[3][4];
#pragma unroll
            for (int i = 0; i < 3; ++i) {
                mi[i] = i < nsel ? pm[2 * i] : -INFINITY; li[i] = i < nsel ? pm[2 * i + 1] : 0.f;
                const u32x4* po = (const u32x4*)(moba_po(P, i) + orow + 32 * h);
#pragma unroll
                for (int k = 0; k < 4; ++k) pa[i][k] = i < nsel ? po[k] : (u32x4){0u, 0u, 0u, 0u};
            }
            FA st; fa_init(st);
            const int jmax = (row0 + 31 - t0) >> 6;
#pragma unroll 1
            for (int j = 0; j <= jmax; ++j) {
                const LAS bf16_t* cur = (const LAS bf16_t*)(lds + j * 16384);
                const int kbase = t0 + j * 64;
                if (kbase + 63 <= row0) fa_tile<0>(st, qf, cur, cur + 4096, r, h, c, true, [=](int) { return true; });
                else fa_tile<2>(st, qf, cur, cur + 4096, r, h, c, true, [=](int koff) { return kbase + koff <= q; });
            }
            const float l_own = st.l + __shfl_xor(st.l, 32);
            const float M = fmaxf(fmaxf(st.m, mi[0]), fmaxf(mi[1], mi[2]));
            const float wo = __builtin_amdgcn_exp2f(st.m - M);
            float L = l_own * wo;
#pragma unroll
            for (int k = 0; k < 16; ++k) { st.o0[k] *= wo; st.o1[k] *= wo; }
#pragma unroll
            for (int i = 0; i < 3; ++i) {
                const float wi = li[i] * __builtin_amdgcn_exp2f(mi[i] - M);
                L += wi;
#pragma unroll
                for (int k = 0; k < 2; ++k) {
                    const f32x4 a0 = bf4_to_f((u32x2){pa[i][k].x, pa[i][k].y}), a1 = bf4_to_f((u32x2){pa[i][k].z, pa[i][k].w});
                    const f32x4 b0 = bf4_to_f((u32x2){pa[i][2 + k].x, pa[i][2 + k].y}), b1 = bf4_to_f((u32x2){pa[i][2 + k].z, pa[i][2 + k].w});
                    st.o0[8 * k] += wi * a0.x; st.o0[8 * k + 1] += wi * a0.y; st.o0[8 * k + 2] += wi * a0.z; st.o0[8 * k + 3] += wi * a0.w;
                    st.o0[8 * k + 4] += wi * a1.x; st.o0[8 * k + 5] += wi * a1.y; st.o0[8 * k + 6] += wi * a1.z; st.o0[8 * k + 7] += wi * a1.w;
                    st.o1[8 * k] += wi * b0.x; st.o1[8 * k + 1] += wi * b0.y; st.o1[8 * k + 2] += wi * b0.z; st.o1[8 * k + 3] += wi * b0.w;
                    st.o1[8 * k + 4] += wi * b1.x; st.o1[8 * k + 5] += wi * b1.y; st.o1[8 * k + 6] += wi * b1.z; st.o1[8 * k + 7] += wi * b1.w;
                }
            }
            const float inv = 1.f / fmaxf(L, 1e-30f);
            nat_store((bf16_t*)(ws + WS_MIX) + orow, h, st.o0, st.o1, inv);
        }
    }
}

constexpr int SMEM_BYTES = 65536 + 8192 + 1024 + 512;
static_assert(SMEM_BYTES >= 128 * 129 * 4 && SMEM_BYTES >= MOE_LDS_ROW + 512 && SMEM_BYTES >= NSA_LDS_MSK + 256, "LDS map");
constexpr int SMEM_OLD = 128 * 129 * 4;
typedef __attribute__((address_space(1))) unsigned gu32;
#define XB_TMO      128
#define XB_XCNT(j)  (256  + 64 * (j))
#define XB_XSUB(j)  (1280 + 64 * (j))
#define XB_XGEN(j)  (2304 + 64 * (j))
#define XB_TOP      3328
#define XB_TOPGEN   3392
#define XCD_BAR_WORDS 3456
#define XB_SPIN_CAP (1u << 18)

__device__ __forceinline__ unsigned xb_ld(unsigned* p)              { return __hip_atomic_load(p, __ATOMIC_RELAXED, __HIP_MEMORY_SCOPE_AGENT); }
__device__ __forceinline__ unsigned xb_add(unsigned* p, unsigned v) { return __hip_atomic_fetch_add(p, v, __ATOMIC_RELAXED, __HIP_MEMORY_SCOPE_AGENT); }
__device__ __forceinline__ unsigned xb_xcc_id() { return (unsigned)__builtin_amdgcn_s_getreg((3 << 11) | 20) & 0xFu; }
#define XB_SPIN(cond, bar) do { unsigned _sp = 0; while (cond) { __builtin_amdgcn_s_sleep(1); \
    if ((++_sp & 255u) == 0u) { if (xb_ld(&(bar)[XB_TMO])) break; if (_sp > XB_SPIN_CAP) { atomicAdd(&(bar)[XB_TMO], 1u); break; } } } } while (0)

struct XcdBarrier {
    unsigned* bar; unsigned x;
    volatile LAS unsigned* st;
};

__device__ __forceinline__ XcdBarrier xcd_barrier_post(unsigned* bar, volatile LAS unsigned* st) {
    XcdBarrier b; b.bar = bar; b.x = xb_xcc_id(); b.st = st;
    if (threadIdx.x == 0) (void)xb_add(&bar[XB_XCNT(b.x)], 1u);
    return b;
}
__device__ __forceinline__ void xcd_barrier_complete(unsigned* bar, unsigned x, unsigned& nloc, unsigned& nx) {
    const unsigned G = gridDim.x * gridDim.y * gridDim.z;
    unsigned sum, cnt, mine, sp = 0u;
    for (;;) {
        sum = 0u; cnt = 0u; mine = 0u;
#pragma unroll
        for (unsigned j = 0; j < 16; ++j) { const unsigned c = xb_ld(&bar[XB_XCNT(j)]); sum += c; cnt += (c > 0u) ? 1u : 0u; mine = (j == x) ? c : mine; }
        if (sum == G) break;
        __builtin_amdgcn_s_sleep(1);
        if ((++sp & 255u) == 0u) { if (xb_ld(&bar[XB_TMO])) break; if (sp > XB_SPIN_CAP) { atomicAdd(&bar[XB_TMO], 1u); break; } }
    }
    nloc = mine > 0u ? mine : 1u; nx = cnt > 0u ? cnt : 1u;
}

__device__ __forceinline__ void xcd_barrier(const XcdBarrier& b) {
    asm volatile("s_waitcnt vmcnt(0)" ::: "memory");
    __syncthreads();
    if (threadIdx.x == 0) {
        unsigned* bar = b.bar;
        __builtin_amdgcn_s_waitcnt(0);
        unsigned nloc = b.st[0], nx = b.st[1];
        if (nloc == 0u) { xcd_barrier_complete(bar, b.x, nloc, nx); b.st[0] = nloc; b.st[1] = nx; }
        const unsigned old = xb_add(&bar[XB_XSUB(b.x)], 1u);
        const unsigned gen = old / nloc;
        if (old + 1u == (gen + 1u) * nloc) {
            __builtin_amdgcn_fence(__ATOMIC_RELEASE, "agent");
            asm volatile("s_waitcnt vmcnt(0)" ::: "memory");
            const unsigned og = xb_add(&bar[XB_TOP], 1u);
            const unsigned tg = og / nx;
            if (og + 1u == (tg + 1u) * nx) xb_add(&bar[XB_TOPGEN], 1u);
            else XB_SPIN(xb_ld(&bar[XB_TOPGEN]) == tg, bar);
            __builtin_amdgcn_fence(__ATOMIC_ACQUIRE, "agent");
            xb_add(&bar[XB_XGEN(b.x)], 1u);
            asm volatile("s_waitcnt vmcnt(0)" ::: "memory");
        } else {
            XB_SPIN(xb_ld(&bar[XB_XGEN(b.x)]) == gen, bar);
            __builtin_amdgcn_fence(__ATOMIC_ACQUIRE, "agent");
            asm volatile("s_waitcnt vmcnt(0)" ::: "memory");
        }
    }
    __syncthreads();
}

constexpr size_t CTL_BAR = 16384;
constexpr size_t CTL_BYTES = 32768;

#define PHASE(k, call) if (P.ph_lo <= (k) && (k) < P.ph_hi) { call; if ((k) + 1 < P.ph_hi) xcd_barrier(xb); }
__global__ void __launch_bounds__(256, 2) mega(Params P) {
    __shared__ __attribute__((aligned(16))) unsigned char smem[SMEM_BYTES + 16];
    unsigned* xbst = (unsigned*)(smem + SMEM_BYTES);
    cg::grid_group grid = cg::this_grid();
    if (threadIdx.x < 4) xbst[threadIdx.x] = 0u;
    __syncthreads();
    if (P.ph_lo < 0) grid.sync();
    XcdBarrier xb = xcd_barrier_post((unsigned*)(P.ws + WS_CTL + CTL_BAR), (volatile LAS unsigned*)xbst);
    PHASE(0, phase0(P, smem))
    PHASE(1, phase_inproj0(P, smem))
    PHASE(2, phase_cmp_s5e(P, smem))
    PHASE(3, phase_glu(P, smem); phase_nsa(P, smem))
    PHASE(6, phase_outproj<false>(P, smem, P.in[0], nullptr, WS_WOUT0))
    PHASE(7, phase_ln_router(P, 0))
    PHASE(8, phase_moe_gu(P, smem, 0))
    PHASE(9, phase_moe_down(P, smem, 0))
    PHASE(10, phase_ln_ffn(P, 0))
    PHASE(11, phase_inproj1(P, smem))
    PHASE(12, phase_moba_gate(P, smem))
    PHASE(13, phase_moba_kv(P, smem))
    PHASE(14, phase_moba_own(P, smem))
    PHASE(15, phase_outproj<true>(P, smem, nullptr, (const bf16_t*)P.out, WS_WOUT1))
    PHASE(16, phase_ln_router(P, 1))
    PHASE(17, phase_moe_gu(P, smem, 1))
    PHASE(18, phase_moe_down(P, smem, 1))
    PHASE(20, phase_ln_ffn(P, 1))
}

extern "C" void kernel_launch(void* const* d_in, const int* in_sizes, int n_in, void* d_out, int out_size, void* d_ws, size_t ws_size, hipStream_t stream) {
    static int grid = 0;
    if (grid == 0) {
        if (n_in != 32 || out_size != NT * DM || ws_size < WS_END) { fprintf(stderr, "kernel_launch: unexpected shapes (n_in %d, out %d, ws %zu)\n", n_in, out_size, ws_size); grid = -1; return; }
        int dev = 0, cus = 0, per_cu = 0;
        (void)hipGetDevice(&dev);
        (void)hipDeviceGetAttribute(&cus, hipDeviceAttributeMultiprocessorCount, dev);
        (void)hipOccupancyMaxActiveBlocksPerMultiprocessor(&per_cu, mega, 256, 0);
        if (per_cu < 1) per_cu = 1;
        if (per_cu > 2) per_cu = 2;
        grid = cus * per_cu;
    }
    if (grid < 0) return;
    (void)hipMemsetAsync((char*)d_ws + WS_CTL, 0, CTL_BYTES, stream);
    Params p{};
    for (int i = 0; i < 32; ++i) p.in[i] = (const float*)d_in[i];
    p.out = (float*)d_out; p.ws = (unsigned char*)d_ws;
    p.ph_lo = 0; p.ph_hi = NPH;
    void* args[] = {&p};
    hipError_t e = hipLaunchCooperativeKernel((void*)mega, dim3(grid), dim3(256), args, 0, stream);
    if (e != hipSuccess) fprintf(stderr, "cooperative launch failed: %s (grid %d)\n", hipGetErrorString(e), grid);
}
```

```cpp
#include <hip/hip_runtime.h>
#include <hip/hip_cooperative_groups.h>
#include <cstdio>
#include <cstdint>
namespace cg = cooperative_groups;

typedef unsigned short bf16_t;
typedef short bf16x8 __attribute__((ext_vector_type(8)));
typedef float f32x4 __attribute__((ext_vector_type(4)));
typedef unsigned u32x4 __attribute__((ext_vector_type(4)));
typedef unsigned u32x2 __attribute__((ext_vector_type(2)));
#define DI __device__ __forceinline__
#define LAS __attribute__((address_space(3)))
typedef float f32x16 __attribute__((ext_vector_type(16)));
typedef float f32x8 __attribute__((ext_vector_type(8)));
typedef __bf16 bf16x8v __attribute__((ext_vector_type(8)));
typedef __bf16 bf16x4v __attribute__((ext_vector_type(4)));
#define MFMA32(a, b, c) __builtin_amdgcn_mfma_f32_32x32x16_bf16((a), (b), (c), 0, 0, 0)

constexpr int NB = 8, SEQ = 4096, DM = 1024, NT = NB * SEQ;
constexpr float ALPHA = 1.41421356237f;
constexpr float LN_EPS = 1e-5f;
constexpr int NIN0 = 1920;
constexpr int NPH = 21;

constexpr size_t MiB = 1u << 20;
constexpr size_t WS_CTL = 0;
constexpr size_t WS_ROPE = 1 * MiB;
constexpr size_t WS_WIN0 = 2 * MiB;
constexpr size_t WS_WOUT0 = 6 * MiB;
constexpr size_t WS_WIN1 = 8 * MiB;
constexpr size_t WS_WOUT1 = 14 * MiB;
constexpr size_t WS_WGLU = 16 * MiB;
constexpr size_t WS_WCK1 = 16 * MiB + 512 * 1024;
constexpr size_t WS_WCV1 = 17 * MiB;
constexpr size_t WS_WCK2 = 17 * MiB + 512 * 1024;
constexpr size_t WS_WCV2 = WS_WCK2 + 16384;
constexpr size_t WS_CBIAS = WS_WCV2 + 16384;
constexpr size_t WS_S5AL = WS_CBIAS + 4096;
constexpr size_t WS_RTRW = 17 * MiB + 640 * 1024;
constexpr size_t WS_BTE = 18 * MiB;
constexpr size_t WS_BTY = 22 * MiB;
constexpr size_t WS_WGU = 42 * MiB;
constexpr size_t WS_WDN = 74 * MiB;
constexpr size_t WS_KMP = 90 * MiB;
constexpr size_t WS_WGT = 94 * MiB;
constexpr size_t WS_KMEAN = 94 * MiB + 512 * 1024;
constexpr size_t WS_KCMP = 95 * MiB;
constexpr size_t WS_VCMP = 95 * MiB + 512 * 1024;
constexpr size_t WS_ACTB = 96 * MiB;
constexpr size_t WS_MIX = 160 * MiB;
constexpr size_t WS_XP = 224 * MiB;
constexpr size_t WS_LIST2 = 416 * MiB;
constexpr size_t WS_SELM = 92 * MiB;
constexpr size_t WS_MCNT = 93 * MiB;
constexpr size_t WS_MLIST = WS_LIST2;
constexpr size_t WS_PO2 = 424 * MiB;
constexpr size_t WS_PML = 488 * MiB;
constexpr size_t WS_END = 504 * MiB;
constexpr size_t XP_Q0 = WS_XP;
constexpr size_t XP_KC = WS_XP + 32 * MiB;
constexpr size_t KVSZ = 8 * MiB;
constexpr size_t XP_GATES = WS_XP + 80 * MiB;
constexpr size_t XP_AEXT = WS_XP + 84 * MiB;
constexpr size_t XP_G5 = WS_XP + 124 * MiB;
constexpr size_t XP_PRE = WS_XP;
constexpr size_t XP_YB = WS_XP;
constexpr size_t XP_H = WS_XP + 128 * MiB;
constexpr size_t XP_Q1 = WS_XP;

struct Params {
    const float* in[32];
    float* out;
    unsigned char* ws;
    int ph_lo, ph_hi;
};

DI bf16_t f2bf(float f) { unsigned u = __float_as_uint(f); return (bf16_t)((u + 0x7fffu + ((u >> 16) & 1u)) >> 16); }
DI float bf2f(bf16_t h) { return __uint_as_float(((unsigned)h) << 16); }
DI unsigned pk2(float lo, float hi) { return (unsigned)f2bf(lo) | ((unsigned)f2bf(hi) << 16); }
DI bf16x8 cvt8(f32x8 v) { return __builtin_bit_cast(bf16x8, __builtin_convertvector(v, bf16x8v)); }
DI u32x2 cvt4(f32x4 v) { return __builtin_bit_cast(u32x2, __builtin_convertvector(v, bf16x4v)); }
DI int natdim(int p) { const int hh = p >> 5, i = p & 31; return ((i >> 4) << 5) + 8 * ((i & 15) >> 2) + 4 * hh + (i & 3); }
DI u32x4 cvt8u(f32x16 v, int k, float s) { return __builtin_bit_cast(u32x4, cvt8((f32x8){v[8 * k] * s, v[8 * k + 1] * s, v[8 * k + 2] * s, v[8 * k + 3] * s, v[8 * k + 4] * s, v[8 * k + 5] * s, v[8 * k + 6] * s, v[8 * k + 7] * s})); }
DI void nat_store(bf16_t* o, int h, const f32x16& o0, const f32x16& o1, float s) {
    u32x4* d = (u32x4*)(o + 32 * h);
    d[0] = cvt8u(o0, 0, s); d[1] = cvt8u(o0, 1, s); d[2] = cvt8u(o1, 0, s); d[3] = cvt8u(o1, 1, s);
}
DI u32x4 cvt44(f32x4 a, f32x4 b) { const u32x2 lo = cvt4(a), hi = cvt4(b); return (u32x4){lo.x, lo.y, hi.x, hi.y}; }
DI size_t kp_off(int key, int d) { return ((size_t)((key >> 5) * 4 + (d >> 4)) * 32 + (key & 31)) * 16 + (d & 15); }
DI int vp_pos(int ko) { return 8 * ((ko >> 2) & 1) + 4 * (ko >> 3) + (ko & 3); }
DI size_t vp_off(int key, int d) { return ((size_t)(key >> 4) * 64 + d) * 16 + vp_pos(key & 15); }
DI bf16_t ld_bf(const bf16_t* p) { return *p; }
DI f32x4 bf4_to_f(u32x2 w) { return (f32x4){__uint_as_float(w.x << 16), __uint_as_float(w.x & 0xffff0000u), __uint_as_float(w.y << 16), __uint_as_float(w.y & 0xffff0000u)}; }
template <int CTRL> DI float dpp_f(float v) { return __builtin_bit_cast(float, __builtin_amdgcn_update_dpp(0, __builtin_bit_cast(int, v), CTRL, 0xF, 0xF, true)); }
DI float wave_sum(float v) {
    v += dpp_f<0xB1>(v);
    v += dpp_f<0x4E>(v);
    v += dpp_f<0x141>(v);
    v += dpp_f<0x140>(v);
    { const auto s = __builtin_amdgcn_permlane16_swap(__float_as_uint(v), __float_as_uint(v), false, false); v = __uint_as_float(s[0]) + __uint_as_float(s[1]); }
    { const auto s = __builtin_amdgcn_permlane32_swap(__float_as_uint(v), __float_as_uint(v), false, false); v = __uint_as_float(s[0]) + __uint_as_float(s[1]); }
    return v;
}
DI float wave_max(float v) {
#pragma unroll
    for (int o = 32; o > 0; o >>= 1) v = fmaxf(v, __shfl_xor(v, o));
    return v;
}
DI float sigmoidf_(float x) { return __builtin_amdgcn_rcpf(1.f + __expf(-x)); }
DI float gelu_tanh(float x) { const float z = 0.7978845608028654f * (x + 0.044715f * x * x * x); return x * sigmoidf_(2.f * z); }

template <bool TRANS, bool PIN = true>
DI void gemm_kstep(const LAS unsigned char* cur, int aoff, int boff, int fq, int swz, f32x4 (&acc)[4][4]) {
    if (!PIN) {
#pragma unroll
        for (int ks = 0; ks < 2; ++ks) {
            bf16x8 af[4], bfr[4];
            const int co = ((ks * 4 + fq) ^ swz) * 16;
#pragma unroll
            for (int m = 0; m < 4; ++m) af[m] = *(const LAS bf16x8*)(cur + aoff + m * 2048 + co);
#pragma unroll
            for (int n = 0; n < 4; ++n) bfr[n] = *(const LAS bf16x8*)(cur + boff + n * 2048 + co);
#pragma unroll
            for (int m = 0; m < 4; ++m)
#pragma unroll
                for (int n = 0; n < 4; ++n) acc[m][n] = TRANS ? __builtin_amdgcn_mfma_f32_16x16x32_bf16(bfr[n], af[m], acc[m][n], 0, 0, 0) : __builtin_amdgcn_mfma_f32_16x16x32_bf16(af[m], bfr[n], acc[m][n], 0, 0, 0);
        }
        return;
    }
    bf16x8 af[2][4], bfr[2][4];
    const int co0 = (fq ^ swz) * 16, co1 = ((4 + fq) ^ swz) * 16;
    af[0][0] = *(const LAS bf16x8*)(cur + aoff + co0);
#pragma unroll
    for (int n = 0; n < 4; ++n) bfr[0][n] = *(const LAS bf16x8*)(cur + boff + n * 2048 + co0);
#pragma unroll
    for (int m = 1; m < 4; ++m) af[0][m] = *(const LAS bf16x8*)(cur + aoff + m * 2048 + co0);
    __builtin_amdgcn_sched_barrier(0);
#pragma unroll
    for (int n = 0; n < 4; ++n) acc[0][n] = TRANS ? __builtin_amdgcn_mfma_f32_16x16x32_bf16(bfr[0][n], af[0][0], acc[0][n], 0, 0, 0) : __builtin_amdgcn_mfma_f32_16x16x32_bf16(af[0][0], bfr[0][n], acc[0][n], 0, 0, 0);
    __builtin_amdgcn_sched_barrier(0);
    af[1][0] = *(const LAS bf16x8*)(cur + aoff + co1);
#pragma unroll
    for (int n = 0; n < 4; ++n) bfr[1][n] = *(const LAS bf16x8*)(cur + boff + n * 2048 + co1);
#pragma unroll
    for (int m = 1; m < 4; ++m) af[1][m] = *(const LAS bf16x8*)(cur + aoff + m * 2048 + co1);
    __builtin_amdgcn_sched_barrier(0);
#pragma unroll
    for (int m = 1; m < 4; ++m)
#pragma unroll
        for (int n = 0; n < 4; ++n) acc[m][n] = TRANS ? __builtin_amdgcn_mfma_f32_16x16x32_bf16(bfr[0][n], af[0][m], acc[m][n], 0, 0, 0) : __builtin_amdgcn_mfma_f32_16x16x32_bf16(af[0][m], bfr[0][n], acc[m][n], 0, 0, 0);
#pragma unroll
    for (int m = 0; m < 4; ++m)
#pragma unroll
        for (int n = 0; n < 4; ++n) acc[m][n] = TRANS ? __builtin_amdgcn_mfma_f32_16x16x32_bf16(bfr[1][n], af[1][m], acc[m][n], 0, 0, 0) : __builtin_amdgcn_mfma_f32_16x16x32_bf16(af[1][m], bfr[1][n], acc[m][n], 0, 0, 0);
}
constexpr int GEMM_LDS = 65536;
template <bool TRANS = true, bool PIN = true, class RowPtr, class Epi>
DI void gemm128(RowPtr rowptr, const bf16_t* __restrict__ Bt, int ldb, int K, unsigned char* smem, Epi epi, int kskip_lo = 0, int kskip_hi = 0) {
    LAS unsigned char* lds = (LAS unsigned char*)smem;
    const int tid = threadIdx.x, lane = tid & 63, wave = tid >> 6, wr = wave >> 1, wc = wave & 1, fr = lane & 15, fq = lane >> 4;
    const int schunk = ((tid & 7) ^ ((tid >> 4) & 7)) * 8;
    const bf16_t* ga[4];
#pragma unroll
    for (int i = 0; i < 4; ++i) ga[i] = rowptr(i * 32 + (tid >> 3)) + schunk;
    const bf16_t* gb = Bt + (size_t)(tid >> 3) * ldb + schunk;
    const size_t gbs = (size_t)32 * ldb;
    auto stage = [&](int kt, int s) {
#pragma unroll
        for (int i = 0; i < 4; ++i) {
            __builtin_amdgcn_global_load_lds((const unsigned*)(ga[i] + kt * 64), (LAS unsigned*)(lds + s * 32768 + (i * 256 + tid) * 16), 16, 0, 0);
            __builtin_amdgcn_global_load_lds((const unsigned*)(gb + i * gbs + kt * 64), (LAS unsigned*)(lds + s * 32768 + 16384 + (i * 256 + tid) * 16), 16, 0, 0);
        }
    };
    f32x4 acc[4][4];
#pragma unroll
    for (int m = 0; m < 4; ++m)
#pragma unroll
        for (int n = 0; n < 4; ++n) acc[m][n] = (f32x4){0.f, 0.f, 0.f, 0.f};
    const int nskip = kskip_hi - kskip_lo, nk = (K >> 6) - nskip;
    const int swz = (fr >> 1) & 7;
    const int aoff = (wr * 64 + fr) * 128, boff = 16384 + (wc * 64 + fr) * 128;
    stage(kskip_lo == 0 ? nskip : 0, 0);
#pragma unroll 1
    for (int kt = 0; kt < nk; ++kt) {
        asm volatile("s_waitcnt vmcnt(0)" ::: "memory");
        __syncthreads();
        if (kt + 1 < nk) stage(kt + 1 < kskip_lo ? kt + 1 : kt + 1 + nskip, (kt + 1) & 1);
        const LAS unsigned char* cur = lds + (kt & 1) * 32768;
        gemm_kstep<TRANS, PIN>(cur, aoff, boff, fq, swz, acc);
    }
    __syncthreads();
    epi(acc, wr, wc, lane);
}

template <bool TRANS = true, class RowPtr, class Epi, class NextRow>
DI void gemm128s(RowPtr rowptr, const bf16_t* __restrict__ Bt, int ldb, int K, unsigned char* smem, Epi epi, bool prefetched, bool has_next, NextRow nextrow, const bf16_t* __restrict__ nextBt) {
    LAS unsigned char* lds = (LAS unsigned char*)smem;
    const int tid = threadIdx.x, lane = tid & 63, wave = tid >> 6, wr = wave >> 1, wc = wave & 1, fr = lane & 15, fq = lane >> 4;
    const int schunk = ((tid & 7) ^ ((tid >> 4) & 7)) * 8;
    const bf16_t* ga[4];
#pragma unroll
    for (int i = 0; i < 4; ++i) ga[i] = rowptr(i * 32 + (tid >> 3)) + schunk;
    const bf16_t* gb = Bt + (size_t)(tid >> 3) * ldb + schunk;
    const size_t gbs = (size_t)32 * ldb;
    auto stage = [&](int kt, int s) {
#pragma unroll
        for (int i = 0; i < 4; ++i) {
            __builtin_amdgcn_global_load_lds((const unsigned*)(ga[i] + kt * 64), (LAS unsigned*)(lds + s * 32768 + (i * 256 + tid) * 16), 16, 0, 0);
            __builtin_amdgcn_global_load_lds((const unsigned*)(gb + i * gbs + kt * 64), (LAS unsigned*)(lds + s * 32768 + 16384 + (i * 256 + tid) * 16), 16, 0, 0);
        }
    };
    f32x4 acc[4][4];
#pragma unroll
    for (int m = 0; m < 4; ++m)
#pragma unroll
        for (int n = 0; n < 4; ++n) acc[m][n] = (f32x4){0.f, 0.f, 0.f, 0.f};
    const int nk = K >> 6;
    const int swz = (fr >> 1) & 7;
    const int aoff = (wr * 64 + fr) * 128, boff = 16384 + (wc * 64 + fr) * 128;
    if (!prefetched) stage(0, 0);
#pragma unroll 1
    for (int kt = 0; kt < nk; ++kt) {
        asm volatile("s_waitcnt vmcnt(0)" ::: "memory");
        __syncthreads();
        if (kt + 1 < nk) stage(kt + 1, (kt + 1) & 1);
        else if (has_next) {
#pragma unroll
            for (int i = 0; i < 4; ++i) {
                __builtin_amdgcn_global_load_lds((const unsigned*)(nextrow(i * 32 + (tid >> 3)) + schunk), (LAS unsigned*)(lds + (i * 256 + tid) * 16), 16, 0, 0);
                __builtin_amdgcn_global_load_lds((const unsigned*)(nextBt + (size_t)(tid >> 3) * ldb + schunk + i * gbs), (LAS unsigned*)(lds + 16384 + (i * 256 + tid) * 16), 16, 0, 0);
            }
        }
        const LAS unsigned char* cur = lds + (kt & 1) * 32768;
        gemm_kstep<TRANS>(cur, aoff, boff, fq, swz, acc);
    }
    epi(acc, wr, wc, lane);
}

DI int vblock() { const int G = gridDim.x; return (G & 7) == 0 ? (int)(blockIdx.x & 7) * (G >> 3) + (int)(blockIdx.x >> 3) : (int)blockIdx.x; }
DI void tile_mn(int it, int nN, int& mt, int& nt) { const int per = 8 * nN, grp = it / per, idx = it - grp * per; nt = idx >> 3; mt = grp * 8 + (idx & 7); }

DI int rope_pos(int l) { return (l & ~63) + ((2 * ((l & 31) >> 4) + ((l >> 5) & 1)) << 4) + (l & 15); }
DI int rowmap(int kind, int n) {
    if (kind == 1) {
        if (n < 512 || (n >= 512 && n < 640) || (n >= 768 && n < 896) || (n >= 1024 && n < 1152)) return rope_pos(n);
        return n < 1304 ? n : n + 104;
    }
    if (kind == 4) return n < 2048 ? rope_pos(n) : n;
    const int inv32 = 16 * ((n >> 2) & 1) + 4 * ((n & 31) >> 3) + (n & 3);
    if (kind == 2) return ((n >> 5) << 6) + inv32;
    if (kind == 3) return ((n >> 5) << 6) + 32 + inv32;
    if (kind == 5) return (n & ~31) + inv32;
    return n;
}
template <bool KNAT = false>
DI void tr_tile(const float* __restrict__ src, int K, int N, bf16_t* __restrict__ dst, int kind, int kt, int nt, float* s) {
    const int tid = threadIdx.x, k0 = kt * 64, n0 = nt * 64;
    {
        const int nn = tid & 63, kq = tid >> 6, n = n0 + nn;
#pragma unroll
        for (int i = 0; i < 16; ++i) { const int kk = kq + 4 * i; s[kk * 65 + nn] = (n < N) ? src[(size_t)(k0 + kk) * N + n] : 0.f; }
    }
    __syncthreads();
    {
        const int rn = tid >> 2, kseg = (tid & 3) * 16, n = n0 + rn;
        if (n < N) {
            unsigned w[8];
#pragma unroll
            for (int i = 0; i < 8; ++i) w[i] = KNAT ? pk2(s[natdim(kseg + 2 * i) * 65 + rn], s[natdim(kseg + 2 * i + 1) * 65 + rn]) : pk2(s[(kseg + 2 * i) * 65 + rn], s[(kseg + 2 * i + 1) * 65 + rn]);
            bf16_t* d = dst + (size_t)rowmap(kind, n) * K + k0 + kseg;
            *(uint4*)d = make_uint4(w[0], w[1], w[2], w[3]);
            *(uint4*)(d + 8) = make_uint4(w[4], w[5], w[6], w[7]);
        }
    }
    __syncthreads();
}
struct CF { float re, im; };
DI CF cmul(CF a, CF b) { return {a.re * b.re - a.im * b.im, a.re * b.im + a.im * b.re}; }
DI CF s5_apow(const Params& P, int g, int p, float tau) {
    const float step = expf(P.in[10][g]);
    const float lr = P.in[8][g * 64 + p], li = P.in[9][g * 64 + p];
    const float mag = expf(lr * step * tau);
    float sn, cs; sincosf(li * step * tau, &sn, &cs);
    return {mag * cs, mag * sn};
}
DI CF s5_f(const Params& P, int g, int p) {
    const CF a = s5_apow(P, g, p, 1.f);
    const float lr = P.in[8][g * 64 + p], li = P.in[9][g * 64 + p];
    const float den = lr * lr + li * li;
    return {((a.re - 1.f) * lr + a.im * li) / den, (a.im * lr - (a.re - 1.f) * li) / den};
}
DI void phase0(const Params& P, unsigned char* smem) {
    const int tid = threadIdx.x;
    unsigned char* ws = P.ws;
    float* sf = (float*)smem;
    constexpr int N_TR0 = 16 * 29, N_TR1 = 256, N_TR2 = 16 * 48, N_TR3 = 256, N_TR4 = 64, N_TR5 = 64, N_TR6 = 64, N_TR7 = 2, N_TR8 = 2;
    constexpr int N_TRG = 64 * 32, N_TRU = 64 * 32, N_TRD = 64 * 32;
    constexpr int N_X = NT * DM / 8192, N_ROPE = 512, N_CB = 16, N_AL = 8, N_BTE = 256, N_BTYM = 32 * 63, N_BTYQ = 4096, N_ZP = 13;
    constexpr int N_RW = 2 * 36864 / 256;
    constexpr int TOTAL = N_RW + N_TR0 + N_TR1 + N_TR4 + N_TR5 + N_TR6 + N_TR7 + N_TR8 + N_X + N_ROPE + N_CB + N_AL + N_BTE + N_BTYM + N_BTYQ + N_ZP;
    for (int it0 = blockIdx.x; it0 < TOTAL; it0 += gridDim.x) {
        int it = it0;
        if (it < N_RW) {
            const int e = it * 256 + tid, layer = e / 36864, r = e % 36864;
            float* dst = (float*)(ws + WS_RTRW) + (size_t)layer * 36864;
            if (r < 4096) { const int o = r & 3, l = (r >> 2) & 63, jk = r >> 8, d = 4 * l + 256 * (jk >> 2) + (jk & 3); dst[r] = P.in[25][((size_t)layer * 1024 + d) * 4 + o]; }
            else { const int q = r - 4096, o = q & 3, l = (q >> 2) & 63, hf = (q >> 8) & 1, jk = (q >> 9) & 15, g = q >> 13, d = 4 * l + 256 * (jk >> 2) + (jk & 3);
                   dst[r] = P.in[27][(((size_t)layer * 4 + g) * 1024 + d) * 8 + hf * 4 + o]; }
            continue;
        } it -= N_RW;
        if (it < N_TR0) { tr_tile(P.in[1], 1024, 1816, (bf16_t*)(ws + WS_WIN0), 1, it / 29, it % 29, sf); continue; } it -= N_TR0;
        if (it < N_TR1) { if (it / 16 < 8) tr_tile<true>(P.in[18], 1024, 1024, (bf16_t*)(ws + WS_WOUT0), 5, it / 16, it % 16, sf); else tr_tile(P.in[18], 1024, 1024, (bf16_t*)(ws + WS_WOUT0), 5, it / 16, it % 16, sf); continue; } it -= N_TR1;
        if (it < N_TR4) { tr_tile(P.in[16], 512, 512, (bf16_t*)(ws + WS_WGLU), 5, it / 8, it % 8, sf); continue; } it -= N_TR4;
        if (it < N_TR5) { tr_tile(P.in[4], 2048, 128, (bf16_t*)(ws + WS_WCK1), 0, it / 2, it % 2, sf); continue; } it -= N_TR5;
        if (it < N_TR6) { tr_tile(P.in[6], 2048, 128, (bf16_t*)(ws + WS_WCV1), 0, it / 2, it % 2, sf); continue; } it -= N_TR6;
        if (it < N_TR7) { tr_tile(P.in[5], 128, 64, (bf16_t*)(ws + WS_WCK2), 0, it, 0, sf); continue; } it -= N_TR7;
        if (it < N_TR8) { tr_tile(P.in[7], 128, 64, (bf16_t*)(ws + WS_WCV2), 0, it, 0, sf); continue; } it -= N_TR8;
        if (it < N_X) {
            const float* x = P.in[0]; bf16_t* xb = (bf16_t*)(ws + WS_ACTB);
#pragma unroll
            for (int i = 0; i < 4; ++i) {
                const size_t idx = (size_t)it * 8192 + i * 2048 + tid * 8;
                const f32x4 a = __builtin_nontemporal_load((const f32x4*)(x + idx)), b = __builtin_nontemporal_load((const f32x4*)(x + idx + 4));
                *(uint4*)(xb + idx) = make_uint4(pk2(a.x, a.y), pk2(a.z, a.w), pk2(b.x, b.y), pk2(b.z, b.w));
            }
            continue;
        } it -= N_X;
        if (it < N_ROPE) {
            const int e = it * 256 + tid, pos = e >> 5, i = e & 31;
            const float inv = 1.0f / powf(10000.0f, (float)(2 * i) / 64.0f);
            const float ang = (float)pos * inv;
            ((float*)(ws + WS_ROPE))[e] = (float)cos((double)ang);
            ((float*)(ws + WS_ROPE))[4096 * 32 + e] = (float)sin((double)ang);
            continue;
        } it -= N_ROPE;
        if (it < N_CB) {
            const int kv = it >> 3, j0 = (it & 7) * 16, j = j0 + (tid & 15), sl = tid >> 4;
            const float* pe = P.in[kv ? 3 : 2]; const float* w1 = P.in[kv ? 6 : 4];
            float a = 0.f;
            for (int i = sl * 128; i < sl * 128 + 128; ++i) a += pe[i] * w1[(size_t)i * 128 + j];
            sf[tid] = a; __syncthreads();
            if (tid < 16) { float t = 0.f; for (int q = 0; q < 16; ++q) t += sf[q * 16 + tid]; ((float*)(ws + WS_CBIAS))[kv * 128 + j0 + tid] = t; }
            __syncthreads();
            continue;
        } it -= N_CB;
        if (it < N_AL) {
            const int e = it * 256 + tid, g = e >> 6, p = e & 63;
            const CF a = s5_apow(P, g, p, 32.f);
            ((float*)(ws + WS_S5AL))[e * 2] = a.re; ((float*)(ws + WS_S5AL))[e * 2 + 1] = a.im;
            continue;
        } it -= N_AL;
        if (it < N_BTE) {
            const int e = it * 256 + tid, g = e >> 11, p = (e >> 5) & 63, r = e & 31;
            const CF w = cmul(s5_apow(P, g, p, (float)(31 - r)), s5_f(P, g, p));
            bf16_t* d = (bf16_t*)(ws + WS_BTE) + (size_t)g * 128 * 512;
#pragma unroll
            for (int c = 0; c < 16; ++c) {
                const CF bb = {P.in[11][(g * 64 + p) * 16 + c], P.in[12][(g * 64 + p) * 16 + c]};
                const CF v = cmul(w, bb);
                d[(size_t)p * 512 + r * 16 + c] = f2bf(v.re);
                d[(size_t)(64 + p) * 512 + r * 16 + c] = f2bf(v.im);
            }
            continue;
        } it -= N_BTE;
        if (it < N_BTYM) {
            const int g = it / 63, dd = it % 63 - 31, ch = tid >> 4, c = tid & 15;
            float val = 0.f;
            if (dd >= 0) {
                float* sw = sf; float* sb = sf + 128; float* sc = sf + 128 + 2048;
                if (tid < 64) { const CF w = cmul(s5_apow(P, g, tid, (float)dd), s5_f(P, g, tid)); sw[2 * tid] = w.re; sw[2 * tid + 1] = w.im; }
#pragma unroll
                for (int i = 0; i < 4; ++i) {
                    const int e = tid + 256 * i;
                    sb[2 * e] = P.in[11][(size_t)g * 1024 + e]; sb[2 * e + 1] = P.in[12][(size_t)g * 1024 + e];
                    sc[2 * e] = P.in[13][(size_t)g * 1024 + e]; sc[2 * e + 1] = P.in[14][(size_t)g * 1024 + e];
                }
                __syncthreads();
#pragma unroll 8
                for (int p = 0; p < 64; ++p) {
                    const CF bb = {sb[2 * (p * 16 + c)], sb[2 * (p * 16 + c) + 1]};
                    const CF cc = {sc[2 * (ch * 64 + p)], sc[2 * (ch * 64 + p) + 1]};
                    const CF w = {sw[2 * p], sw[2 * p + 1]};
                    val += cmul(cc, cmul(w, bb)).re;
                }
                __syncthreads();
            }
            bf16_t* d = (bf16_t*)(ws + WS_BTY) + (size_t)g * 512 * 640;
            const bf16_t hv = f2bf(val);
            for (int r = 0; r < 32; ++r) { const int s = r + dd; if (s >= 0 && s < 32) d[(size_t)(s * 16 + ch) * 640 + r * 16 + c] = hv; }
            continue;
        } it -= N_BTYM;
        if (it < N_BTYQ) {
            const int e = it * 256 + tid, g = e >> 15, s = (e >> 10) & 31, ch = (e >> 6) & 15, p = e & 63;
            const CF cc = {P.in[13][(g * 16 + ch) * 64 + p], P.in[14][(g * 16 + ch) * 64 + p]};
            const CF w = cmul(cc, s5_apow(P, g, p, (float)(s + 1)));
            bf16_t* d = (bf16_t*)(ws + WS_BTY) + ((size_t)g * 512 + s * 16 + ch) * 640 + 512;
            d[p] = f2bf(w.re); d[64 + p] = f2bf(-w.im);
            continue;
        } it -= N_BTYQ;
        {
            uint4* d = (uint4*)((bf16_t*)(ws + WS_WIN0) + (size_t)(1304 + it * 8) * 1024);
#pragma unroll
            for (int i = 0; i < 4; ++i) d[i * 256 + tid] = make_uint4(0, 0, 0, 0);
        }
    }
}

DI void phase_inproj0(const Params& P, unsigned char* smem) {
    unsigned char* ws = P.ws;
    const bf16_t* A = (const bf16_t*)(ws + WS_ACTB);
    const float* cosT = (const float*)(ws + WS_ROPE);
    const float* sinT = cosT + 4096 * 32;
    constexpr int NTN = NIN0 / 128;
    bool pre = false;
    for (int it = vblock(); it < (NT / 128) * NTN; it += gridDim.x) {
        int mt, nt; tile_mn(it, NTN, mt, nt);
        const int m0 = mt * 128;
        auto rowptr = [=](int r) { return A + (size_t)(m0 + r) * 1024; };
        const bf16_t* Bt = (const bf16_t*)(ws + WS_WIN0) + (size_t)nt * 128 * 1024;
        const bool hn = it + (int)gridDim.x < (NT / 128) * NTN;
        int mtn = 0, ntn = 0; if (hn) tile_mn(it + gridDim.x, NTN, mtn, ntn);
        auto nextrow = [=](int r) { return A + (size_t)(mtn * 128 + r) * 1024; };
        const bf16_t* nBt = (const bf16_t*)(ws + WS_WIN0) + (size_t)ntn * 128 * 1024;
        if (nt == 7 || nt == 9) {
            auto epi = [=](f32x4 (&acc)[4][4], int wr, int wc, int lane) {
                const int fr = lane & 15, fq = lane >> 4, which = nt == 7 ? 3 : 5, g = wc;
#pragma unroll
                for (int m = 0; m < 4; ++m) {
                    const int t = m0 + wr * 64 + m * 16 + fq * 4, s = t & 4095, b = t >> 12;
                    bf16_t* dst = (bf16_t*)(ws + XP_KC + (size_t)which * KVSZ) + (size_t)(b * 2 + g) * 4096 * 64;
#pragma unroll
                    for (int n = 0; n < 4; ++n) *(u32x2*)(dst + vp_off(s, n * 16 + fr)) = cvt4(acc[m][n]);
                }
            };
            gemm128s<false>(rowptr, Bt, 1024, 1024, smem, epi, pre, hn, nextrow, nBt);
            pre = hn;
            continue;
        }
        auto epi = [=](f32x4 (&acc)[4][4], int wr, int wc, int lane) {
            const int u64 = nt * 2 + wc, fr = lane & 15, fq = lane >> 4;
#pragma unroll
            for (int m = 0; m < 4; ++m) {
                const int t = m0 + wr * 64 + m * 16 + fr, s = t & 4095, b = t >> 12;
                if (u64 < 20) {
                    const bool isq = u64 < 8;
                    const int which = (u64 - 8) >> 1, g = (u64 - 8) & 1;
                    if (isq || ((which & 1) == 0)) {
#pragma unroll
                        for (int n2 = 0; n2 < 2; ++n2) {
                            const int i = n2 * 16 + fq * 4;
                            const f32x4 c = *(const f32x4*)(cosT + s * 32 + i), sn = *(const f32x4*)(sinT + s * 32 + i);
                            const f32x4 x1 = acc[m][2 * n2], x2 = acc[m][2 * n2 + 1];
                            const u32x2 o1 = cvt4(x1 * c - x2 * sn), o2 = cvt4(x1 * sn + x2 * c);
                            if (isq) { bf16_t* dst = (bf16_t*)(ws + XP_Q0) + (size_t)t * 512 + u64 * 64; *(u32x2*)(dst + i) = o1; *(u32x2*)(dst + i + 32) = o2; }
                            else {
                                bf16_t* dst = (bf16_t*)(ws + XP_KC + (size_t)which * KVSZ) + (size_t)(b * 2 + g) * 4096 * 64;
                                if (which == 0) { *(u32x2*)(dst + (size_t)s * 64 + i) = o1; *(u32x2*)(dst + (size_t)s * 64 + i + 32) = o2; }
                                else { *(u32x2*)(dst + kp_off(s, i)) = o1; *(u32x2*)(dst + kp_off(s, i + 32)) = o2; }
                            }
                        }
                    } else {
                        bf16_t* dst = (bf16_t*)(ws + XP_KC + (size_t)which * KVSZ) + ((size_t)(b * 2 + g) * 4096 + s) * 64;
#pragma unroll
                        for (int n = 0; n < 4; ++n) *(u32x2*)(dst + n * 16 + fq * 4) = cvt4(acc[m][n]);
                    }
                } else if (u64 == 20) {
#pragma unroll
                    for (int n = 0; n < 2; ++n) {
                        const int c0 = n * 16 + fq * 4;
                        if (c0 < 24) { f32x4 o; o.x = sigmoidf_(acc[m][n].x); o.y = sigmoidf_(acc[m][n].y); o.z = sigmoidf_(acc[m][n].z); o.w = sigmoidf_(acc[m][n].w); *(f32x4*)((float*)(ws + XP_GATES) + (size_t)t * 24 + c0) = o; }
                    }
                } else if (u64 >= 22) {
#pragma unroll
                    for (int n = 0; n < 4; ++n) {
                        const int g5 = (u64 - 22) * 4 + n;
                        *(u32x2*)((bf16_t*)(ws + XP_AEXT) + ((size_t)g5 * 1024 + (t >> 5)) * 640 + (t & 31) * 16 + fq * 4) = cvt4(acc[m][n]);
                    }
                }
            }
        };
        gemm128s(rowptr, Bt, 1024, 1024, smem, epi, pre, hn, nextrow, nBt);
        pre = hn;
    }
}

constexpr int N_LATE = 16 * 48 + 256 + 3 * 64 * 32;
DI void late_weights(const Params& P, unsigned char* smem, int it) {
    unsigned char* ws = P.ws;
    float* sf = (float*)smem;
    constexpr int N_TR2 = 16 * 48, N_TR3 = 256, N_TRG = 64 * 32, N_TRU = 64 * 32;
    if (it < N_TR2) { tr_tile(P.in[19], 1024, 3072, (bf16_t*)(ws + WS_WIN1), 4, it / 48, it % 48, sf); return; } it -= N_TR2;
    if (it < N_TR3) { tr_tile<true>(P.in[20], 1024, 1024, (bf16_t*)(ws + WS_WOUT1), 5, it / 16, it % 16, sf); return; } it -= N_TR3;
    if (it < N_TRG) { const int mat = it >> 5, r = it & 31; tr_tile(P.in[29] + (size_t)mat * 1024 * 128, 1024, 128, (bf16_t*)(ws + WS_WGU) + (size_t)mat * 256 * 1024, 2, r >> 1, r & 1, sf); return; } it -= N_TRG;
    if (it < N_TRU) { const int mat = it >> 5, r = it & 31; tr_tile(P.in[30] + (size_t)mat * 1024 * 128, 1024, 128, (bf16_t*)(ws + WS_WGU) + (size_t)mat * 256 * 1024, 3, r >> 1, r & 1, sf); return; } it -= N_TRU;
    { const int mat = it >> 5, r = it & 31; tr_tile(P.in[31] + (size_t)mat * 128 * 1024, 128, 1024, (bf16_t*)(ws + WS_WDN) + (size_t)mat * 1024 * 128, 5, r >> 4, r & 15, sf); }
}

DI void s5y_tile(const Params& P, unsigned char* smem, int g, int mt, int nt);
DI void phase_cmp_s5e(const Params& P, unsigned char* smem) {
    unsigned char* ws = P.ws;
    const int tid = threadIdx.x, lane = tid & 63, wave = tid >> 6;
    const int G = gridDim.x, bid = blockIdx.x;
    const bool split = G >= 384;
    const int nmine = !split ? (320 + N_LATE + G - 1 - bid) / G : (bid < 320 ? 1 : (N_LATE + (G - 320) - 1 - (bid - 320)) / (G - 320));
    for (int k = 0; k < nmine; ++k) {
        const int it = !split ? bid + k * G : (bid < 320 ? bid : 320 + (bid - 320) + k * (G - 320));
        if (it >= 64 + 256) { late_weights(P, smem, it - 320); continue; }
        if (it < 64) {
            const int kv = it >> 5, bg = (it >> 1) & 15, mt = it & 1;
            const bf16_t* src = (const bf16_t*)(ws + XP_KC + (size_t)kv * KVSZ) + (size_t)bg * 4096 * 64;
            const float* cb = (const float*)(ws + WS_CBIAS) + kv * 128;
            bf16_t* sH = (bf16_t*)smem;
            auto rowptr = [=](int r) { int rr = mt * 128 + r; rr = rr > 254 ? 254 : rr; return src + (size_t)rr * 1024; };
            auto epi = [=](f32x4 (&acc)[4][4], int wr, int wc, int ln) {
                const int fr = ln & 15, fq = ln >> 4;
#pragma unroll
                for (int m = 0; m < 4; ++m)
#pragma unroll
                    for (int n = 0; n < 4; ++n)
#pragma unroll
                        for (int j = 0; j < 4; ++j) {
                            const int r = wr * 64 + m * 16 + fr, c = wc * 64 + n * 16 + fq * 4 + j;
                            sH[r * 136 + c] = f2bf(gelu_tanh(acc[m][n][j] + cb[c]));
                        }
            };
            gemm128(rowptr, (const bf16_t*)(ws + (kv ? WS_WCV1 : WS_WCK1)), 2048, 2048, smem, epi);
            __syncthreads();
            const bf16_t* W2 = (const bf16_t*)(ws + (kv ? WS_WCV2 : WS_WCK2));
            f32x4 a2[2][4];
#pragma unroll
            for (int m = 0; m < 2; ++m)
#pragma unroll
                for (int n = 0; n < 4; ++n) a2[m][n] = (f32x4){0.f, 0.f, 0.f, 0.f};
#pragma unroll
            for (int ks = 0; ks < 4; ++ks) {
                bf16x8 af[2], bfr[4];
#pragma unroll
                for (int m = 0; m < 2; ++m) af[m] = *(const bf16x8*)(sH + (wave * 32 + m * 16 + (lane & 15)) * 136 + ks * 32 + (lane >> 4) * 8);
#pragma unroll
                for (int n = 0; n < 4; ++n) bfr[n] = *(const bf16x8*)(W2 + (n * 16 + (lane & 15)) * 128 + ks * 32 + (lane >> 4) * 8);
#pragma unroll
                for (int m = 0; m < 2; ++m)
#pragma unroll
                    for (int n = 0; n < 4; ++n) a2[m][n] = __builtin_amdgcn_mfma_f32_16x16x32_bf16(af[m], bfr[n], a2[m][n], 0, 0, 0);
            }
            bf16_t* dst = (bf16_t*)(ws + (kv ? WS_VCMP : WS_KCMP)) + (size_t)bg * 256 * 64;
#pragma unroll
            for (int m = 0; m < 2; ++m)
#pragma unroll
                for (int n = 0; n < 4; ++n)
#pragma unroll
                    for (int j = 0; j < 4; ++j) {
                        const int row = mt * 128 + wave * 32 + m * 16 + (lane >> 4) * 4 + j, col = n * 16 + (lane & 15);
                        dst[kv ? vp_off(row, col) : kp_off(row, col)] = row < 255 ? f2bf(a2[m][n][j]) : (bf16_t)0;
                    }
            __syncthreads();
        } else {
            const int it2 = it - 64, g = it2 >> 3, b = it2 & 7;
            bf16_t* aext = (bf16_t*)(ws + XP_AEXT) + ((size_t)g * 1024 + b * 128) * 640;
            float* sE = (float*)smem;
            auto rowptr = [=](int r) { return (const bf16_t*)aext + (size_t)r * 640; };
            auto epi = [=](f32x4 (&acc)[4][4], int wr, int wc, int ln) {
                const int fr = ln & 15, fq = ln >> 4;
#pragma unroll
                for (int m = 0; m < 4; ++m)
#pragma unroll
                    for (int n = 0; n < 4; ++n)
#pragma unroll
                        for (int j = 0; j < 4; ++j) sE[(wr * 64 + m * 16 + fr) * 129 + wc * 64 + n * 16 + fq * 4 + j] = acc[m][n][j];
            };
            gemm128<true, false>(rowptr, (const bf16_t*)(ws + WS_BTE) + (size_t)g * 128 * 512, 512, 512, smem, epi);
            __syncthreads();
            {
                const int p = tid & 63, c0 = wave * 32;
                const float ar = ((const float*)(ws + WS_S5AL))[(g * 64 + p) * 2], ai = ((const float*)(ws + WS_S5AL))[(g * 64 + p) * 2 + 1];
                float* send = (float*)(smem + 128 * 129 * 4);
                float xr = 0.f, xi = 0.f;
                for (int c = c0; c < c0 + 32; ++c) {
                    const float er = sE[c * 129 + p], ei = sE[c * 129 + 64 + p];
                    const float nr = ar * xr - ai * xi + er, ni = ar * xi + ai * xr + ei;
                    xr = nr; xi = ni;
                }
                send[(wave * 64 + p) * 2] = xr; send[(wave * 64 + p) * 2 + 1] = xi;
                float qr = ar, qi = ai;
#pragma unroll
                for (int k = 0; k < 5; ++k) { const float tr = qr * qr - qi * qi, ti = 2.f * qr * qi; qr = tr; qi = ti; }
                __syncthreads();
                xr = 0.f; xi = 0.f;
                for (int k = 0; k < wave; ++k) {
                    const float er = send[(k * 64 + p) * 2], ei = send[(k * 64 + p) * 2 + 1];
                    const float nr = qr * xr - qi * xi + er, ni = qr * xi + qi * xr + ei;
                    xr = nr; xi = ni;
                }
                for (int c = c0; c < c0 + 32; ++c) {
                    aext[(size_t)c * 640 + 512 + p] = f2bf(xr);
                    aext[(size_t)c * 640 + 576 + p] = f2bf(xi);
                    const float er = sE[c * 129 + p], ei = sE[c * 129 + 64 + p];
                    const float nr = ar * xr - ai * xi + er, ni = ar * xi + ai * xr + ei;
                    xr = nr; xi = ni;
                }
            }
            asm volatile("s_waitcnt vmcnt(0)" ::: "memory");
            __syncthreads();
#pragma unroll 1
            for (int nt = 0; nt < 4; ++nt) s5y_tile(P, smem, g, b, nt);
        }
    }
}

DI void s5y_tile(const Params& P, unsigned char* smem, int g, int mt, int nt) {
    unsigned char* ws = P.ws;
    const bf16_t* aext = (const bf16_t*)(ws + XP_AEXT) + (size_t)g * 1024 * 640;
    const float* dsk = P.in[15];
    auto rowptr = [=](int r) { return aext + (size_t)(mt * 128 + r) * 640; };
    auto epi = [=](f32x4 (&acc)[4][4], int wr, int wc, int ln) {
        const int fr = ln & 15, fq = ln >> 4;
        const f32x4 dk = *(const f32x4*)(dsk + g * 16 + fq * 4);
#pragma unroll
        for (int m = 0; m < 4; ++m) {
            const int cr = mt * 128 + wr * 64 + m * 16 + fr;
#pragma unroll
            for (int n = 0; n < 4; ++n) {
                const int sp = nt * 8 + wc * 4 + n, t = cr * 32 + sp;
                const f32x4 u = bf4_to_f(*(const u32x2*)(aext + (size_t)cr * 640 + sp * 16 + fq * 4));
                const f32x4 y = acc[m][n] + dk * u;
                *(u32x2*)((bf16_t*)(ws + XP_G5) + (size_t)t * 512 + g * 16 + fq * 4) = cvt4((f32x4){gelu_tanh(y.x), gelu_tanh(y.y), gelu_tanh(y.z), gelu_tanh(y.w)});
            }
        }
    };
    gemm128<true, false>(rowptr, (const bf16_t*)(ws + WS_BTY) + ((size_t)g * 512 + nt * 128) * 640, 640, 640, smem, epi, 2 * nt + 2, 8);
}
struct FA { f32x16 o0, o1; float m, l; };
DI void fa_init(FA& st) {
#pragma unroll
    for (int i = 0; i < 16; ++i) { st.o0[i] = 0.f; st.o1[i] = 0.f; }
    st.m = -1e30f; st.l = 0.f;
}
constexpr float FA_THR = 8.f;
template <int MODE, class Valid>
DI void fa_tile(FA& st, const bf16x8 (&qf)[4], const LAS bf16_t* Kt, const LAS bf16_t* Vt, int r, int h, float c, bool rowok, Valid valid) {
    const LAS bf16_t* kb = Kt + r * 16 + 8 * h;
    const LAS bf16_t* vb = Vt + r * 16 + 8 * h;
    bf16x8 kf[4], vf[4];
#pragma unroll
    for (int ks = 0; ks < 4; ++ks) kf[ks] = *(const LAS bf16x8*)(kb + ks * 512);
#pragma unroll
    for (int sub = 0; sub < 2; ++sub) {
        f32x16 acc;
#pragma unroll
        for (int i = 0; i < 16; ++i) acc[i] = 0.f;
#pragma unroll
        for (int ks = 0; ks < 4; ++ks) acc = MFMA32(kf[ks], qf[ks], acc);
#pragma unroll
        for (int s2 = 0; s2 < 2; ++s2) { vf[2 * s2] = *(const LAS bf16x8*)(vb + ((sub * 2 + s2) * 64) * 16); vf[2 * s2 + 1] = *(const LAS bf16x8*)(vb + ((sub * 2 + s2) * 64 + 32) * 16); }
        if (sub == 0) {
#pragma unroll
            for (int ks = 0; ks < 4; ++ks) kf[ks] = *(const LAS bf16x8*)(kb + (4 + ks) * 512);
        }
        __builtin_amdgcn_sched_barrier(0);
        float mx = -INFINITY;
#pragma unroll
        for (int i = 0; i < 16; ++i) {
            if (MODE == 2) { const int koff = sub * 32 + (i & 3) + 8 * (i >> 2) + 4 * h; acc[i] = valid(koff) ? acc[i] : -INFINITY; }
            mx = fmaxf(mx, acc[i]);
        }
        {
            const auto sw = __builtin_amdgcn_permlane32_swap(__float_as_uint(mx), __float_as_uint(mx), false, false);
            mx = fmaxf(__uint_as_float(sw[0]), __uint_as_float(sw[1]));
        }
        const float cand = mx * c;
        const bool upd = cand > st.m + FA_THR;
        if (__ballot(upd)) {
            const float mn = upd ? cand : st.m, alpha = __builtin_amdgcn_exp2f(st.m - mn);
            st.m = mn; st.l *= alpha;
#pragma unroll
            for (int i = 0; i < 16; ++i) { st.o0[i] *= alpha; st.o1[i] *= alpha; }
        }
        const float nb = (MODE == 1 && !rowok) ? -INFINITY : -st.m;
        float ps0 = 0.f, ps1 = 0.f;
#pragma unroll
        for (int i = 0; i < 16; i += 2) {
            acc[i] = __builtin_amdgcn_exp2f(__builtin_fmaf(acc[i], c, nb));
            acc[i + 1] = __builtin_amdgcn_exp2f(__builtin_fmaf(acc[i + 1], c, nb));
            ps0 += acc[i]; ps1 += acc[i + 1];
        }
        st.l += ps0 + ps1;
#pragma unroll
        for (int s2 = 0; s2 < 2; ++s2) {
            const bf16x8 pk = cvt8((f32x8){acc[8 * s2], acc[8 * s2 + 1], acc[8 * s2 + 2], acc[8 * s2 + 3], acc[8 * s2 + 4], acc[8 * s2 + 5], acc[8 * s2 + 6], acc[8 * s2 + 7]});
            st.o0 = MFMA32(vf[2 * s2], pk, st.o0);
            st.o1 = MFMA32(vf[2 * s2 + 1], pk, st.o1);
        }
    }
}
DI void fa_issue(const bf16_t* gK, const bf16_t* gV, LAS unsigned char* buf, int tid) {
    __builtin_amdgcn_global_load_lds((const unsigned*)(gK + tid * 8), (LAS unsigned*)(buf + tid * 16), 16, 0, 0);
    __builtin_amdgcn_global_load_lds((const unsigned*)(gK + (tid + 256) * 8), (LAS unsigned*)(buf + (tid + 256) * 16), 16, 0, 0);
    __builtin_amdgcn_global_load_lds((const unsigned*)(gV + tid * 8), (LAS unsigned*)(buf + 8192 + tid * 16), 16, 0, 0);
    __builtin_amdgcn_global_load_lds((const unsigned*)(gV + (tid + 256) * 8), (LAS unsigned*)(buf + 8192 + (tid + 256) * 16), 16, 0, 0);
}
DI void fa_wait(int j, int n) {
    const int rem = n - 1 - j;
    if (rem >= 2) asm volatile("s_waitcnt vmcnt(8)" ::: "memory");
    else if (rem == 1) asm volatile("s_waitcnt vmcnt(4)" ::: "memory");
    else asm volatile("s_waitcnt vmcnt(0)" ::: "memory");
    __builtin_amdgcn_s_barrier();
    asm volatile("" ::: "memory");
}

constexpr int NSA_LDS_IMP = 65536;
constexpr int NSA_LDS_SCS = NSA_LDS_IMP + 8192;
constexpr int NSA_LDS_MSK = NSA_LDS_SCS + 1024;
DI void phase_nsa(const Params& P, unsigned char* smem) {
    unsigned char* ws = P.ws;
    const int tid = threadIdx.x, lane = tid & 63, wave = tid >> 6, r = lane & 31, h = lane >> 5;
    const float c = 0.125f * 1.4426950408889634f;
    LAS unsigned char* lds = (LAS unsigned char*)smem;
    float* impw = (float*)(smem + NSA_LDS_IMP) + wave * 512;
    float* scs = (float*)(smem + NSA_LDS_SCS) + wave * 64;
    unsigned long long* mskw = (unsigned long long*)(smem + NSA_LDS_MSK) + wave * 8;
    for (int it = blockIdx.x; it < 2048; it += gridDim.x) {
        const int qt = 127 - (it >> 4), bg = it & 15, b = bg >> 1, g = bg & 1, t0 = qt * 32, qblk = t0 >> 6;
        const int ql = r >> 2, z = r & 3, s = t0 + wave * 8 + ql, t = b * 4096 + s;
        const bf16_t* Qg = (const bf16_t*)(ws + XP_Q0) + (size_t)t * 512 + (g * 4 + z) * 64;
        bf16x8 qf[4];
#pragma unroll
        for (int ks = 0; ks < 4; ++ks) qf[ks] = *(const bf16x8*)(Qg + ks * 16 + 8 * h);
        const float* gt = (const float*)(ws + XP_GATES) + (size_t)t * 24 + (g * 4 + z) * 3;
        const float g_c = gt[0], g_s = gt[1], g_w = gt[2];
        const bf16_t* Kc = (const bf16_t*)(ws + WS_KCMP) + (size_t)bg * 256 * 64;
        const bf16_t* Vc = (const bf16_t*)(ws + WS_VCMP) + (size_t)bg * 256 * 64;
        const bf16_t* Ks = (const bf16_t*)(ws + XP_KC + 2 * KVSZ) + (size_t)bg * 4096 * 64;
        const bf16_t* Vs = (const bf16_t*)(ws + XP_KC + 3 * KVSZ) + (size_t)bg * 4096 * 64;
        const bf16_t* Kw = (const bf16_t*)(ws + XP_KC + 4 * KVSZ) + (size_t)bg * 4096 * 64;
        const bf16_t* Vw = (const bf16_t*)(ws + XP_KC + 5 * KVSZ) + (size_t)bg * 4096 * 64;
        const int nct = ((t0 >> 4) + 1 + 63) >> 6;
        const int w0 = (t0 - 255) < 0 ? 0 : (t0 - 255) >> 6;
        const int e1 = nct, e2 = 2 * nct, e3 = e2 + qblk + 1, e4 = e3 + (qblk - w0 + 1);
        const int nc = s >= 31 ? ((s - 31) >> 4) + 1 : 0;
        const int s_lo = t0 + wave * 8, s_hi = s_lo + 7, nc_min = s_lo >= 31 ? ((s_lo - 31) >> 4) + 1 : 0;
        for (int i = lane; i < 512; i += 64) impw[i] = 0.f;
        auto tile_ptrs = [&](int i, const bf16_t*& gk, const bf16_t*& gv) {
            if (i < e1) { gk = Kc + (size_t)i * 4096; gv = Vc + (size_t)i * 4096; }
            else if (i < e2) { gk = Kc + (size_t)(i - e1) * 4096; gv = Vc + (size_t)(i - e1) * 4096; }
            else if (i < e3) { gk = Ks + (size_t)(i - e2) * 4096; gv = Vs + (size_t)(i - e2) * 4096; }
            else { gk = Kw + (size_t)(w0 + i - e3) * 4096; gv = Vw + (size_t)(w0 + i - e3) * 4096; }
        };
        FA st; fa_init(st);
        f32x16 out0, out1;
#pragma unroll
        for (int i = 0; i < 16; ++i) { out0[i] = 0.f; out1[i] = 0.f; }
        float m_c = -1e30f, il_c = 0.f;
        unsigned long long mymask = 0ull;
        asm volatile("s_waitcnt vmcnt(0)" ::: "memory");
        __builtin_amdgcn_s_barrier();
#pragma unroll
        for (int i = 0; i < 3; ++i) if (i < e4) { const bf16_t *gk, *gv; tile_ptrs(i, gk, gv); fa_issue(gk, gv, lds + i * 16384, tid); }
        auto step = [&](int i) -> const LAS bf16_t* {
            fa_wait(i, e4);
            if (i + 3 < e4) { const bf16_t *gk, *gv; tile_ptrs(i + 3, gk, gv); fa_issue(gk, gv, lds + ((i + 3) & 3) * 16384, tid); }
            return (const LAS bf16_t*)(lds + (i & 3) * 16384);
        };
        int i = 0;
        for (; i < e1; ++i) {
            const LAS bf16_t* cur = step(i);
            const int nb = i * 64;
            if (nb + 63 < nc_min) fa_tile<0>(st, qf, cur, cur + 4096, r, h, c, true, [=](int) { return true; }); else fa_tile<2>(st, qf, cur, cur + 4096, r, h, c, true, [=](int koff) { return nb + koff < nc; });
        }
        {
            const float l = st.l + __shfl_xor(st.l, 32);
            il_c = 1.f / fmaxf(l, 1e-30f); m_c = st.m;
            const float f = g_c * il_c;
#pragma unroll
            for (int k = 0; k < 16; ++k) { out0[k] = st.o0[k] * f; out1[k] = st.o1[k] * f; }
            fa_init(st);
        }
        for (; i < e2; ++i) {
            const LAS bf16_t* cur = step(i);
            const int nb = (i - e1) * 64;
#pragma unroll
            for (int sub = 0; sub < 2; ++sub) {
                f32x16 acc;
#pragma unroll
                for (int k = 0; k < 16; ++k) acc[k] = 0.f;
#pragma unroll
                for (int ks = 0; ks < 4; ++ks) acc = MFMA32(*(const LAS bf16x8*)(cur + ((sub * 4 + ks) * 32 + r) * 16 + 8 * h), qf[ks], acc);
#pragma unroll
                for (int q4 = 0; q4 < 4; ++q4) {
                    float p[4];
#pragma unroll
                    for (int k = 0; k < 4; ++k) {
                        const int n = nb + sub * 32 + 8 * q4 + 4 * h + k;
                        p[k] = (n < nc) ? __builtin_amdgcn_exp2f(acc[4 * q4 + k] * c - m_c) * il_c : 0.f;
                    }
                    float a = (p[0] + p[1]) + (p[2] + 0.5f * p[3]), cn = 0.5f * p[3];
                    a += __shfl_xor(a, 1); a += __shfl_xor(a, 2);
                    cn += __shfl_xor(cn, 1); cn += __shfl_xor(cn, 2);
                    const int jb = ((nb + sub * 32) >> 2) + 2 * q4 + h;
                    if (z == 0) { atomicAdd(&impw[ql * 64 + jb], a); if (jb + 1 < 64) atomicAdd(&impw[ql * 64 + jb + 1], cn); }
                }
            }
        }
        {
            __builtin_amdgcn_wave_barrier();
#pragma unroll 1
            for (int qq = 0; qq < 8; ++qq) {
                const int j = lane;
                const float imp = impw[qq * 64 + j];
                const float score = (j > qblk) ? -1.f : ((j == 0 || j == qblk || j == qblk - 1) ? 1e3f : imp);
                scs[j] = score;
                __builtin_amdgcn_wave_barrier();
                int rank = 0;
#pragma unroll 8
                for (int jj = 0; jj < 64; ++jj) { const float o = scs[jj]; rank += (o > score || (o == score && jj < j)) ? 1 : 0; }
                const unsigned long long mk = __ballot(rank < 8 && score >= 0.f);
                if (lane == 0) mskw[qq] = mk;
                __builtin_amdgcn_wave_barrier();
            }
            mymask = mskw[ql];
        }
        for (; i < e3 - 1; ++i) {
            const LAS bf16_t* cur = step(i);
            const bool sel = (mymask >> (i - e2)) & 1ull;
            if (__ballot(sel)) fa_tile<1>(st, qf, cur, cur + 4096, r, h, c, sel, [=](int) { return true; });
        }
        {
            const LAS bf16_t* cur = step(i);
            const int kb = qblk * 64;
            fa_tile<2>(st, qf, cur, cur + 4096, r, h, c, true, [=](int koff) { return kb + koff <= s; });
            ++i;
            const float l = st.l + __shfl_xor(st.l, 32);
            const float f = g_s / fmaxf(l, 1e-30f);
#pragma unroll
            for (int k = 0; k < 16; ++k) { out0[k] += st.o0[k] * f; out1[k] += st.o1[k] * f; }
            fa_init(st);
        }
        for (; i < e4; ++i) {
            const LAS bf16_t* cur = step(i);
            const int kb = (w0 + i - e3) * 64;
            if (kb >= s_hi - 255 && kb + 63 <= s_lo) fa_tile<0>(st, qf, cur, cur + 4096, r, h, c, true, [=](int) { return true; }); else fa_tile<2>(st, qf, cur, cur + 4096, r, h, c, true, [=](int koff) { const int key = kb + koff; return key <= s && key >= s - 255; });
        }
        {
            const float l = st.l + __shfl_xor(st.l, 32);
            const float f = g_w / fmaxf(l, 1e-30f);
#pragma unroll
            for (int k = 0; k < 16; ++k) { out0[k] += st.o0[k] * f; out1[k] += st.o1[k] * f; }
        }
        nat_store((bf16_t*)(ws + WS_MIX) + (size_t)t * 1024 + (g * 4 + z) * 64, h, out0, out1, 1.f);
    }
}

DI void phase_glu(const Params& P, unsigned char* smem) {
    unsigned char* ws = P.ws;
    const bf16_t* G5 = (const bf16_t*)(ws + XP_G5);
    const float* gb = P.in[17];
    bool pre = false;
    for (int it = vblock(); it < (NT / 128) * 4; it += gridDim.x) {
        int mt, nt; tile_mn(it, 4, mt, nt);
        const int m0 = mt * 128;
        const bool hn = it + (int)gridDim.x < (NT / 128) * 4;
        int mtn = 0, ntn = 0; if (hn) tile_mn(it + gridDim.x, 4, mtn, ntn);
        auto nextrow = [=](int r) { return G5 + (size_t)(mtn * 128 + r) * 512; };
        auto rowptr = [=](int r) { return G5 + (size_t)(m0 + r) * 512; };
        auto epi = [=](f32x4 (&acc)[4][4], int wr, int wc, int ln) {
            const int fr = ln & 15, fq = ln >> 4;
#pragma unroll
            for (int m = 0; m < 4; ++m) {
                const int row = m0 + wr * 64 + m * 16 + fr;
#pragma unroll
                for (int q = 0; q < 2; ++q) {
                    const int col = nt * 128 + wc * 64 + q * 32 + fq * 8;
                    const u32x4 gw = *(const u32x4*)(G5 + (size_t)row * 512 + col);
                    f32x4 o[2];
#pragma unroll
                    for (int e = 0; e < 2; ++e) {
                        const f32x4 gv = bf4_to_f(e == 0 ? (u32x2){gw.x, gw.y} : (u32x2){gw.z, gw.w}), bb = *(const f32x4*)(gb + col + 4 * e), z = acc[m][2 * q + e] + bb;
                        o[e] = (f32x4){gv.x * sigmoidf_(z.x), gv.y * sigmoidf_(z.y), gv.z * sigmoidf_(z.z), gv.w * sigmoidf_(z.w)};
                    }
                    *(u32x4*)((bf16_t*)(ws + WS_MIX) + (size_t)row * 1024 + 512 + col) = cvt44(o[0], o[1]);
                }
            }
        };
        gemm128s(rowptr, (const bf16_t*)(ws + WS_WGLU) + (size_t)nt * 128 * 512, 512, 512, smem, epi, pre, hn, nextrow, (const bf16_t*)(ws + WS_WGLU) + (size_t)ntn * 128 * 512);
        pre = hn;
    }
}

template <bool RB>
DI void phase_outproj(const Params& P, unsigned char* smem, const float* xres, const bf16_t* xresb, size_t wt_off) {
    unsigned char* ws = P.ws;
    const bf16_t* A = (const bf16_t*)(ws + WS_MIX);
    bf16_t* preb = (bf16_t*)(ws + XP_PRE);
    bool pre = false;
    for (int it = vblock(); it < (NT / 128) * 8; it += gridDim.x) {
        int mt, nt; tile_mn(it, 8, mt, nt);
        const int m0 = mt * 128;
        const bool hn = it + (int)gridDim.x < (NT / 128) * 8;
        int mtn = 0, ntn = 0; if (hn) tile_mn(it + gridDim.x, 8, mtn, ntn);
        auto nextrow = [=](int r) { return A + (size_t)(mtn * 128 + r) * 1024; };
        auto rowptr = [=](int r) { return A + (size_t)(m0 + r) * 1024; };
        auto epi = [=](f32x4 (&acc)[4][4], int wr, int wc, int ln) {
            const int fr = ln & 15, fq = ln >> 4;
#pragma unroll
            for (int m = 0; m < 4; ++m) {
                const size_t base = (size_t)(m0 + wr * 64 + m * 16 + fr) * 1024 + nt * 128 + wc * 64 + fq * 8;
                f32x4 xr[4];
#pragma unroll
                for (int q = 0; q < 2; ++q) {
                    if (RB) { const u32x4 w = *(const u32x4*)(xresb + base + q * 32); xr[2 * q] = bf4_to_f((u32x2){w.x, w.y}); xr[2 * q + 1] = bf4_to_f((u32x2){w.z, w.w}); }
                    else { xr[2 * q] = *(const f32x4*)(xres + base + q * 32); xr[2 * q + 1] = *(const f32x4*)(xres + base + q * 32 + 4); }
                }
#pragma unroll
                for (int q = 0; q < 2; ++q) *(u32x4*)(preb + base + q * 32) = cvt44(xr[2 * q] * ALPHA + acc[m][2 * q], xr[2 * q + 1] * ALPHA + acc[m][2 * q + 1]);
            }
        };
        gemm128s(rowptr, (const bf16_t*)(ws + wt_off) + (size_t)nt * 128 * 1024, 1024, 1024, smem, epi, pre, hn, nextrow, (const bf16_t*)(ws + wt_off) + (size_t)ntn * 128 * 1024);
        pre = hn;
    }
}

DI void ln_row(float (&v)[16], const float* __restrict__ g, const float* __restrict__ bta, int lane) {
    float s = 0.f;
#pragma unroll
    for (int i = 0; i < 16; ++i) s += v[i];
    const float mu = wave_sum(s) * (1.f / 1024.f);
    float q = 0.f;
#pragma unroll
    for (int i = 0; i < 16; ++i) { v[i] -= mu; q += v[i] * v[i]; }
    const float rstd = rsqrtf(wave_sum(q) * (1.f / 1024.f) + LN_EPS);
#pragma unroll
    for (int j = 0; j < 4; ++j) {
        const float4 gg = *(const float4*)(g + 4 * lane + 256 * j), bb = *(const float4*)(bta + 4 * lane + 256 * j);
        v[4 * j + 0] = v[4 * j + 0] * rstd * gg.x + bb.x; v[4 * j + 1] = v[4 * j + 1] * rstd * gg.y + bb.y;
        v[4 * j + 2] = v[4 * j + 2] * rstd * gg.z + bb.z; v[4 * j + 3] = v[4 * j + 3] * rstd * gg.w + bb.w;
    }
}

DI void phase_ln_router(const Params& P, int layer) {
    unsigned char* ws = P.ws;
    const int lane = threadIdx.x & 63, wave = threadIdx.x >> 6;
    const float* g = P.in[21] + layer * 1024; const float* bta = P.in[22] + layer * 1024;
    const float* wc = (const float*)(ws + WS_RTRW) + (size_t)layer * 36864; const float* bc = P.in[26] + layer * 4;
    const float* wf = wc + 4096; const float* bfn = P.in[28] + layer * 32;
    int* cnt = (int*)(ws + WS_CTL) + layer * 2048;
    int* list = (int*)(ws + WS_LIST2);
    float* wgt = (float*)(ws + WS_WGT);
    bf16_t* xb = (bf16_t*)(ws + WS_ACTB);
    for (int task = blockIdx.x * 4 + wave; task < NT / 16; task += gridDim.x * 4) {
        int my_e = 0; float my_w = 0.f;
        f32x4 wcr[16];
#pragma unroll
        for (int q = 0; q < 16; ++q) wcr[q] = *(const f32x4*)(wc + (q * 64 + lane) * 4);
        const bf16_t* pre = (const bf16_t*)(ws + XP_PRE);
        u32x2 nxb[4];
#pragma unroll
        for (int j = 0; j < 4; ++j) nxb[j] = __builtin_nontemporal_load((const u32x2*)(pre + (size_t)(task * 16) * 1024 + 4 * lane + 256 * j));
#pragma unroll 1
        for (int i = 0; i < 16; ++i) {
            const int t = task * 16 + i;
            float v[16];
#pragma unroll
            for (int j = 0; j < 4; ++j) { const f32x4 nx = bf4_to_f(nxb[j]); v[4 * j] = nx.x; v[4 * j + 1] = nx.y; v[4 * j + 2] = nx.z; v[4 * j + 3] = nx.w; }
            if (i + 1 < 16) {
#pragma unroll
                for (int j = 0; j < 4; ++j) nxb[j] = __builtin_nontemporal_load((const u32x2*)(pre + (size_t)(t + 1) * 1024 + 4 * lane + 256 * j));
            }
            ln_row(v, g, bta, lane);
#pragma unroll
            for (int j = 0; j < 4; ++j) {
                *(u32x2*)(xb + (size_t)t * 1024 + 4 * lane + 256 * j) = cvt4((f32x4){v[4 * j], v[4 * j + 1], v[4 * j + 2], v[4 * j + 3]});
            }
            float lc[4] = {0.f, 0.f, 0.f, 0.f};
#pragma unroll
            for (int j = 0; j < 4; ++j)
#pragma unroll
                for (int k = 0; k < 4; ++k) {
                    const f32x4 w = wcr[j * 4 + k];
                    const float x = v[4 * j + k];
                    lc[0] += x * w.x; lc[1] += x * w.y; lc[2] += x * w.z; lc[3] += x * w.w;
                }
#pragma unroll
            for (int c = 0; c < 4; ++c) lc[c] = wave_sum(lc[c]) + bc[c];
            int gi = 0; float lm = lc[0];
#pragma unroll
            for (int c = 1; c < 4; ++c) if (lc[c] > lm) { lm = lc[c]; gi = c; }
            gi = __builtin_amdgcn_readfirstlane(gi);
            float den = 0.f;
#pragma unroll
            for (int c = 0; c < 4; ++c) den += expf(lc[c] - lm);
            const float gv = 1.f / den;
            float lf[8] = {0.f, 0.f, 0.f, 0.f, 0.f, 0.f, 0.f, 0.f};
            const float* wfg = wf + (size_t)gi * 8192;
#pragma unroll
            for (int j = 0; j < 4; ++j)
#pragma unroll
                for (int k = 0; k < 4; ++k) {
                    const f32x4 w0 = *(const f32x4*)(wfg + (((j * 4 + k) * 2 + 0) * 64 + lane) * 4), w1 = *(const f32x4*)(wfg + (((j * 4 + k) * 2 + 1) * 64 + lane) * 4);
                    const float x = v[4 * j + k];
                    lf[0] += x * w0.x; lf[1] += x * w0.y; lf[2] += x * w0.z; lf[3] += x * w0.w;
                    lf[4] += x * w1.x; lf[5] += x * w1.y; lf[6] += x * w1.z; lf[7] += x * w1.w;
                }
#pragma unroll
            for (int e = 0; e < 8; ++e) lf[e] = wave_sum(lf[e]) + bfn[gi * 8 + e];
            int e1 = 0; float l1 = lf[0];
#pragma unroll
            for (int e = 1; e < 8; ++e) if (lf[e] > l1) { l1 = lf[e]; e1 = e; }
            int e2 = 0; float l2 = -INFINITY;
#pragma unroll
            for (int e = 0; e < 8; ++e) if (e != e1 && lf[e] > l2) { l2 = lf[e]; e2 = e; }
            const float r = expf(l2 - l1);
            if (lane == i) { my_e = gi * 8 + e1; my_w = gv / (1.f + r); }
            if (lane == 16 + i) { my_e = gi * 8 + e2; my_w = gv * r / (1.f + r); }
        }
        if (lane < 32) {
            const int t = task * 16 + (lane & 15), k = lane >> 4, slot = (task & 63) * 32 + my_e;
            const int pos = atomicAdd(&cnt[slot], 1);
            list[(slot << 10) + pos] = t * 2 + k;
            wgt[t * 2 + k] = my_w;
        }
    }
}

constexpr int MOE_LDS_TAB = 65536;
constexpr int MOE_LDS_ROW = 65536 + 8448;
DI void moe_tables(const int* cnt, unsigned char* smem) {
    int* tab = (int*)(smem + MOE_LDS_TAB);
    if (threadIdx.x < 32) { const int e = threadIdx.x; int run = 0; for (int s = 0; s < 64; ++s) { tab[e * 65 + s] = run; run += cnt[s * 32 + e]; } tab[e * 65 + 64] = run; }
    __syncthreads();
}
DI bool moe_tile(const int* tab, int tile, int& e, int& mt, int& off, int& ce) {
    int acc_t = 0, acc_r = 0;
    for (int i = 0; i < 32; ++i) {
        const int c = tab[i * 65 + 64], nt = (c + 127) >> 7;
        if (tile < acc_t + nt) { e = i; mt = tile - acc_t; off = acc_r; ce = c; return true; }
        acc_t += nt; acc_r += c;
    }
    return false;
}
DI int moe_ntiles(const int* tab) { int a = 0; for (int i = 0; i < 32; ++i) a += (tab[i * 65 + 64] + 127) >> 7; return a; }
DI void moe_rows(const int* tab, const int* list, int e, int mt, int ce, int* rowidx) {
    if (threadIdx.x < 128) {
        const int pos = mt * 128 + threadIdx.x;
        int idx = -1;
        if (pos < ce) {
            int lo = 0, hi = 64;
            while (hi - lo > 1) { const int mid = (lo + hi) >> 1; if (tab[e * 65 + mid] <= pos) lo = mid; else hi = mid; }
            idx = list[((lo * 32 + e) << 10) + pos - tab[e * 65 + lo]];
        }
        rowidx[threadIdx.x] = idx;
    }
    __syncthreads();
}

DI void phase_moe_gu(const Params& P, unsigned char* smem, int layer) {
    unsigned char* ws = P.ws;
    const int* cnt = (const int*)(ws + WS_CTL) + layer * 2048;
    const int* list = (const int*)(ws + WS_LIST2);
    const float* wgt = (const float*)(ws + WS_WGT);
    const bf16_t* xb = (const bf16_t*)(ws + WS_ACTB);
    bf16_t* H = (bf16_t*)(ws + XP_H);
    const int* tab = (const int*)(smem + MOE_LDS_TAB);
    int* rowidx = (int*)(smem + MOE_LDS_ROW);
    moe_tables(cnt, smem);
    const int ntile = moe_ntiles(tab);
    for (int it = vblock(); it < ntile * 2; it += gridDim.x) {
        int e, mt, off, ce; moe_tile(tab, it >> 1, e, mt, off, ce);
        const int nt = it & 1;
        moe_rows(tab, list, e, mt, ce, rowidx);
        auto rowptr = [=](int r) { int idx = rowidx[r]; idx = idx < 0 ? rowidx[0] : idx; return xb + (size_t)(idx >> 1) * 1024; };
        auto epi = [=](f32x4 (&acc)[4][4], int wr, int wc, int ln) {
            const int fr = ln & 15, fq = ln >> 4;
#pragma unroll
            for (int m = 0; m < 4; ++m) {
                const int rl = wr * 64 + m * 16 + fr, idx = rowidx[rl];
                if (idx >= 0) {
                    const float w = wgt[idx];
                    f32x4 hv[2];
#pragma unroll
                    for (int n = 0; n < 2; ++n) {
                        const f32x4 gte = acc[m][n], up = acc[m][n + 2];
                        hv[n] = (f32x4){gte.x * sigmoidf_(gte.x) * up.x * w, gte.y * sigmoidf_(gte.y) * up.y * w, gte.z * sigmoidf_(gte.z) * up.z * w, gte.w * sigmoidf_(gte.w) * up.w * w};
                    }
                    *(u32x4*)(H + (size_t)(off + mt * 128 + rl) * 128 + (nt * 2 + wc) * 32 + fq * 8) = cvt44(hv[0], hv[1]);
                }
            }
        };
        gemm128(rowptr, (const bf16_t*)(ws + WS_WGU) + ((size_t)(layer * 32 + e) * 256 + nt * 128) * 1024, 1024, 1024, smem, epi);
        __syncthreads();
    }
}
DI void phase_moe_down(const Params& P, unsigned char* smem, int layer) {
    unsigned char* ws = P.ws;
    const int* cnt = (const int*)(ws + WS_CTL) + layer * 2048;
    const int* list = (const int*)(ws + WS_LIST2);
    const bf16_t* H = (const bf16_t*)(ws + XP_H);
    bf16_t* YB = (bf16_t*)(ws + XP_YB);
    const int* tab = (const int*)(smem + MOE_LDS_TAB);
    int* rowidx = (int*)(smem + MOE_LDS_ROW);
    moe_tables(cnt, smem);
    const int ntile = moe_ntiles(tab);
    for (int it = vblock(); it < ntile * 8; it += gridDim.x) {
        int e, mt, off, ce; moe_tile(tab, it >> 3, e, mt, off, ce);
        const int nt = it & 7;
        moe_rows(tab, list, e, mt, ce, rowidx);
        auto rowptr = [=](int r) { int pos = mt * 128 + r; pos = pos < ce ? pos : 0; return H + (size_t)(off + pos) * 128; };
        auto epi = [=](f32x4 (&acc)[4][4], int wr, int wc, int ln) {
            const int fr = ln & 15, fq = ln >> 4;
#pragma unroll
            for (int m = 0; m < 4; ++m) {
                const int idx = rowidx[wr * 64 + m * 16 + fr];
                if (idx >= 0) {
                    bf16_t* dst = YB + (size_t)idx * 1024 + nt * 128 + wc * 64 + fq * 8;
#pragma unroll
                    for (int q = 0; q < 2; ++q) *(u32x4*)(dst + q * 32) = cvt44(acc[m][2 * q], acc[m][2 * q + 1]);
                }
            }
        };
        gemm128(rowptr, (const bf16_t*)(ws + WS_WDN) + ((size_t)(layer * 32 + e) * 1024 + nt * 128) * 128, 128, 128, smem, epi);
        __syncthreads();
    }
}
DI void phase_ln_ffn(const Params& P, int layer) {
    unsigned char* ws = P.ws;
    const int lane = threadIdx.x & 63, wave = threadIdx.x >> 6;
    const float* g = P.in[23] + layer * 1024; const float* bta = P.in[24] + layer * 1024;
    const bf16_t* YB = (const bf16_t*)(ws + XP_YB);
    bf16_t* xb = (bf16_t*)(ws + WS_ACTB);
    for (int task = blockIdx.x * 4 + wave; task < NT / 16; task += gridDim.x * 4) {
        u32x2 nxm[4], ny0[4], ny1[4];
        auto fetch = [&](int t) {
#pragma unroll
            for (int j = 0; j < 4; ++j) {
                nxm[j] = __builtin_nontemporal_load((const u32x2*)(xb + (size_t)t * 1024 + 4 * lane + 256 * j));
                ny0[j] = __builtin_nontemporal_load((const u32x2*)(YB + (size_t)(2 * t) * 1024 + 4 * lane + 256 * j));
                ny1[j] = __builtin_nontemporal_load((const u32x2*)(YB + (size_t)(2 * t + 1) * 1024 + 4 * lane + 256 * j));
            }
        };
        fetch(task * 16);
#pragma unroll 1
        for (int i = 0; i < 16; ++i) {
            const int t = task * 16 + i;
            float v[16];
#pragma unroll
            for (int j = 0; j < 4; ++j) {
                const f32x4 a = bf4_to_f(nxm[j]), y0 = bf4_to_f(ny0[j]), y1 = bf4_to_f(ny1[j]);
                v[4 * j + 0] = ALPHA * a.x + (y0.x + y1.x); v[4 * j + 1] = ALPHA * a.y + (y0.y + y1.y);
                v[4 * j + 2] = ALPHA * a.z + (y0.z + y1.z); v[4 * j + 3] = ALPHA * a.w + (y0.w + y1.w);
            }
            if (i + 1 < 16) fetch(t + 1);
            ln_row(v, g, bta, lane);
            float* row = P.out + (size_t)t * 1024;
#pragma unroll
            for (int j = 0; j < 4; ++j) {
                if (layer == 0) *(u32x2*)((bf16_t*)P.out + (size_t)t * 1024 + 4 * lane + 256 * j) = cvt4((f32x4){v[4 * j], v[4 * j + 1], v[4 * j + 2], v[4 * j + 3]});
                else *(f32x4*)(row + 4 * lane + 256 * j) = (f32x4){v[4 * j], v[4 * j + 1], v[4 * j + 2], v[4 * j + 3]};
            }
        }
    }
}

DI void phase_inproj1(const Params& P, unsigned char* smem) {
    unsigned char* ws = P.ws;
    const bf16_t* A = (const bf16_t*)P.out;
    const float* cosT = (const float*)(ws + WS_ROPE);
    const float* sinT = cosT + 4096 * 32;
    bool pre = false;
    for (int it = vblock(); it < (NT / 128) * 24; it += gridDim.x) {
        int mt, nt; tile_mn(it, 24, mt, nt);
        const int m0 = mt * 128;
        auto rowptr = [=](int r) { return A + (size_t)(m0 + r) * 1024; };
        const bf16_t* Bt = (const bf16_t*)(ws + WS_WIN1) + (size_t)nt * 128 * 1024;
        const bool hn = it + (int)gridDim.x < (NT / 128) * 24;
        int mtn = 0, ntn = 0; if (hn) tile_mn(it + gridDim.x, 24, mtn, ntn);
        auto nextrow = [=](int r) { return A + (size_t)(mtn * 128 + r) * 1024; };
        const bf16_t* nBt = (const bf16_t*)(ws + WS_WIN1) + (size_t)ntn * 128 * 1024;
        if (nt >= 16) {
            auto epi = [=](f32x4 (&acc)[4][4], int wr, int wc, int lane) {
                const int head = (nt * 2 + wc) & 15, fr = lane & 15, fq = lane >> 4;
#pragma unroll
                for (int m = 0; m < 4; ++m) {
                    const int t = m0 + wr * 64 + m * 16 + fq * 4, s = t & 4095, b = t >> 12;
                    bf16_t* base = (bf16_t*)(ws + XP_Q1 + (size_t)2 * 64 * MiB) + (size_t)(b * 16 + head) * 4096 * 64;
#pragma unroll
                    for (int n = 0; n < 4; ++n) *(u32x2*)(base + vp_off(s, n * 16 + fr)) = cvt4(acc[m][n]);
                }
            };
            gemm128s<false>(rowptr, Bt, 1024, 1024, smem, epi, pre, hn, nextrow, nBt);
            pre = hn;
            continue;
        }
        auto epi = [=](f32x4 (&acc)[4][4], int wr, int wc, int lane) {
            const int u64 = nt * 2 + wc, kind = u64 >> 4, head = u64 & 15, fr = lane & 15, fq = lane >> 4;
            f32x4 cs[2][2];
#pragma unroll
            for (int n2 = 0; n2 < 2; ++n2) { cs[n2][0] = (f32x4){0.f, 0.f, 0.f, 0.f}; cs[n2][1] = cs[n2][0]; }
#pragma unroll
            for (int m = 0; m < 4; ++m) {
                const int t = m0 + wr * 64 + m * 16 + fr, s = t & 4095, b = t >> 12;
                bf16_t* base = (bf16_t*)(ws + XP_Q1 + (size_t)kind * 64 * MiB) + (size_t)(b * 16 + head) * 4096 * 64;
#pragma unroll
                for (int n2 = 0; n2 < 2; ++n2) {
                    const int i = n2 * 16 + fq * 4;
                    const f32x4 c = *(const f32x4*)(cosT + s * 32 + i), sn = *(const f32x4*)(sinT + s * 32 + i);
                    const f32x4 x1 = acc[m][2 * n2], x2 = acc[m][2 * n2 + 1];
                    const f32x4 r1 = x1 * c - x2 * sn, r2 = x1 * sn + x2 * c;
                    const u32x2 o1 = cvt4(r1), o2 = cvt4(r2);
                    if (kind == 0) { *(u32x2*)(base + (size_t)s * 64 + i) = o1; *(u32x2*)(base + (size_t)s * 64 + i + 32) = o2; }
                    else { *(u32x2*)(base + kp_off(s, i)) = o1; *(u32x2*)(base + kp_off(s, i + 32)) = o2; cs[n2][0] += r1; cs[n2][1] += r2; }
                }
            }
            if (kind == 1) {
                const int t0 = m0 + wr * 64, bh = (t0 >> 12) * 16 + head, seg = (t0 & 4095) >> 6;
                float* dst = (float*)(ws + WS_KMP) + ((size_t)bh * 64 + seg) * 64;
#pragma unroll
                for (int n2 = 0; n2 < 2; ++n2)
#pragma unroll
                    for (int hf = 0; hf < 2; ++hf) {
                        f32x4 v = cs[n2][hf];
#pragma unroll
                        for (int k = 0; k < 4; ++k) { float x = v[k]; x += dpp_f<0xB1>(x); x += dpp_f<0x4E>(x); x += dpp_f<0x141>(x); x += dpp_f<0x140>(x); v[k] = x; }
                        if (fr == 0) *(f32x4*)(dst + n2 * 16 + fq * 4 + hf * 32) = v;
                    }
            }
        };
        gemm128s(rowptr, Bt, 1024, 1024, smem, epi, pre, hn, nextrow, nBt);
        pre = hn;
    }
}
DI void moba_kmeans_slab(const Params& P, bf16_t* kml, int bh, int tid) {
    const float* kp = (const float*)(P.ws + WS_KMP) + (size_t)bh * 64 * 64;
    for (int e = tid; e < 2048; e += 256) {
        const int d = e & 63, n = e >> 6;
        float a = 0.f;
        if (n < 16) a = ((kp[(4 * n) * 64 + d] + kp[(4 * n + 1) * 64 + d]) + (kp[(4 * n + 2) * 64 + d] + kp[(4 * n + 3) * 64 + d])) * (1.f / 256.f);
        kml[((d >> 4) * 32 + n) * 16 + (d & 15)] = f2bf(a);
    }
}
DI unsigned moba_gate_rows(const bf16_t* km, const bf16x8 (&qf)[4], int own, int r, int h) {
    f32x16 g;
#pragma unroll
    for (int i = 0; i < 16; ++i) g[i] = 0.f;
#pragma unroll
    for (int ks = 0; ks < 4; ++ks) g = MFMA32(*(const bf16x8*)(km + (ks * 32 + r) * 16 + 8 * h), qf[ks], g);
    float mine[8], oth[8];
#pragma unroll
    for (int i = 0; i < 8; ++i) { const int n = (i & 3) + 8 * (i >> 2) + 4 * h; mine[i] = n < own ? g[i] : -INFINITY; oth[i] = __shfl_xor(mine[i], 32); }
    unsigned selmask = 0;
#pragma unroll
    for (int i = 0; i < 8; ++i) {
        const int n = (i & 3) + 8 * (i >> 2) + 4 * h;
        int rank = 0;
#pragma unroll
        for (int k = 0; k < 8; ++k) {
            const int nk = (k & 3) + 8 * (k >> 2) + 4 * h, no = (k & 3) + 8 * (k >> 2) + 4 * (1 - h);
            rank += (mine[k] > mine[i] || (mine[k] == mine[i] && nk < n)) ? 1 : 0;
            rank += (oth[k] > mine[i] || (oth[k] == mine[i] && no < n)) ? 1 : 0;
        }
        if (n < own && rank < 3) selmask |= 1u << n;
    }
    return selmask | __shfl_xor(selmask, 32);
}
DI void phase_moba_gate(const Params& P, unsigned char* smem) {
    unsigned char* ws = P.ws;
    const int tid = threadIdx.x, lane = tid & 63, wave = tid >> 6, r = lane & 31, h = lane >> 5;
    bf16_t* kml = (bf16_t*)smem;
    unsigned short* smask = (unsigned short*)(smem + 4096);
    unsigned short* selm = (unsigned short*)(ws + WS_SELM);
    unsigned short* mcnt = (unsigned short*)(ws + WS_MCNT);
    unsigned char* mlist = ws + WS_MLIST;
    int km_bh = -1;
    for (int it = blockIdx.x; it < 2048; it += gridDim.x) {
        const int bh = it & 127, qb = it >> 7;
        if (bh != km_bh) { km_bh = bh; __syncthreads(); moba_kmeans_slab(P, kml, bh, tid); }
        __syncthreads();
#pragma unroll 1
        for (int g2 = 0; g2 < 2; ++g2) {
            const int rl = wave * 64 + g2 * 32 + r, q = qb * 256 + rl;
            const bf16_t* Qg = (const bf16_t*)(ws + XP_Q1) + ((size_t)bh * 4096 + q) * 64;
            bf16x8 qf[4];
#pragma unroll
            for (int ks = 0; ks < 4; ++ks) qf[ks] = *(const bf16x8*)(Qg + ks * 16 + 8 * h);
            const unsigned sm = qb > 0 ? moba_gate_rows(kml, qf, qb, r, h) : 0u;
            if (h == 0) { selm[(size_t)bh * 4096 + q] = (unsigned short)sm; smask[rl] = (unsigned short)sm; }
        }
        __syncthreads();
        for (int n = wave; n < qb; n += 4) {
            unsigned char* lp = mlist + ((size_t)(bh * 16 + qb) * 16 + n) * 256;
            int base = 0;
#pragma unroll
            for (int c4 = 0; c4 < 4; ++c4) {
                const int row = c4 * 64 + lane;
                const bool bit = (smask[row] >> n) & 1;
                const unsigned long long bal = __ballot(bit);
                if (bit) lp[base + __builtin_popcountll(bal & ((1ull << lane) - 1ull))] = (unsigned char)row;
                base += __builtin_popcountll(bal);
            }
            if (lane == 0) mcnt[(bh * 16 + qb) * 16 + n] = (unsigned short)base;
        }
    }
}
DI bf16_t* moba_po(const Params& P, int slot) { return (bf16_t*)(P.ws + (slot == 0 ? WS_MIX : slot == 1 ? WS_ACTB : WS_PO2)); }
DI void phase_moba_kv(const Params& P, unsigned char* smem) {
    unsigned char* ws = P.ws;
    const int tid = threadIdx.x, lane = tid & 63, wave = tid >> 6, r = lane & 31, h = lane >> 5;
    const float c = 0.125f * 1.4426950408889634f;
    LAS unsigned char* lds = (LAS unsigned char*)smem;
    const unsigned short* selm = (const unsigned short*)(ws + WS_SELM);
    const unsigned short* mcnt = (const unsigned short*)(ws + WS_MCNT);
    const unsigned char* mlist = ws + WS_MLIST;
    float* pml = (float*)(ws + WS_PML);
    const bool bal = (gridDim.x == 512);
    const int nit = bal ? ((blockIdx.x >> 7) == 3 ? 3 : 4) : (1920 + (int)gridDim.x - 1 - (int)blockIdx.x) / (int)gridDim.x;
    for (int iti = 0; iti < nit; ++iti) {
        int bh, n;
        if (bal) { const int gq = blockIdx.x >> 7; bh = blockIdx.x & 127; const int tab = gq == 0 ? 0x0DA90 : gq == 1 ? 0x0CB61 : gq == 2 ? 0x0E852 : 0x00743; n = (tab >> (4 * iti)) & 15; }
        else { const int it = blockIdx.x + iti * gridDim.x; n = it >> 7; bh = it & 127; }
        const bf16_t* Kg = (const bf16_t*)(ws + XP_Q1 + 64 * MiB) + (size_t)bh * 4096 * 64 + (size_t)n * 4 * 4096;
        const bf16_t* Vg = (const bf16_t*)(ws + XP_Q1 + 128 * MiB) + (size_t)bh * 4096 * 64 + (size_t)n * 4 * 4096;
        asm volatile("s_waitcnt vmcnt(0)" ::: "memory");
        __builtin_amdgcn_s_barrier();
#pragma unroll
        for (int j = 0; j < 4; ++j) fa_issue(Kg + (size_t)j * 4096, Vg + (size_t)j * 4096, lds + j * 16384, tid);
        const int cntv = (lane < 16 && lane > n) ? (int)mcnt[(bh * 16 + lane) * 16 + n] : 0;
        asm volatile("s_waitcnt vmcnt(0)" ::: "memory");
        __builtin_amdgcn_s_barrier();
        asm volatile("" ::: "memory");
        int prefv = 0, total = 0;
#pragma unroll 1
        for (int qb = 0; qb < 16; ++qb) { if (lane == qb) prefv = total; total += __builtin_amdgcn_readlane(cntv, qb); }
#pragma unroll 1
        for (int v0 = wave * 32; v0 < total; v0 += 128) {
            const int v = v0 + r;
            const bool valid = v < total;
            const int vv = valid ? v : v0;
            int qb = n + 1;
#pragma unroll 1
            for (int l = n + 2; l < 16; ++l) if (vv >= __builtin_amdgcn_readlane(prefv, l)) qb = l;
            const int idx = vv - __shfl(prefv, qb);
            const int q = qb * 256 + (int)mlist[((size_t)(bh * 16 + qb) * 16 + n) * 256 + idx];
            const bf16_t* Qg = (const bf16_t*)(ws + XP_Q1) + ((size_t)bh * 4096 + q) * 64;
            bf16x8 qf[4];
#pragma unroll
            for (int ks = 0; ks < 4; ++ks) qf[ks] = *(const bf16x8*)(Qg + ks * 16 + 8 * h);
            FA st; fa_init(st);
#pragma unroll 1
            for (int j = 0; j < 4; ++j) {
                const LAS bf16_t* cur = (const LAS bf16_t*)(lds + j * 16384);
                fa_tile<0>(st, qf, cur, cur + 4096, r, h, c, true, [=](int) { return true; });
            }
            const float l = st.l + __shfl_xor(st.l, 32);
            const float inv = 1.f / fmaxf(l, 1e-30f);
            if (valid) {
                const int slot = __builtin_popcount((unsigned)selm[(size_t)bh * 4096 + q] & ((1u << n) - 1u));
                bf16_t* o = moba_po(P, slot) + ((size_t)(bh >> 4) * 4096 + q) * 1024 + (bh & 15) * 64;
                nat_store(o, h, st.o0, st.o1, inv);
                if (h == 0) { float* pm = pml + (((size_t)bh * 4096 + q) * 3 + slot) * 2; pm[0] = st.m; pm[1] = l; }
            }
        }
    }
}
DI void phase_moba_own(const Params& P, unsigned char* smem) {
    unsigned char* ws = P.ws;
    const int tid = threadIdx.x, lane = tid & 63, wave = tid >> 6, r = lane & 31, h = lane >> 5;
    const float c = 0.125f * 1.4426950408889634f;
    LAS unsigned char* lds = (LAS unsigned char*)smem;
    const unsigned short* selm = (const unsigned short*)(ws + WS_SELM);
    const float* pml = (const float*)(ws + WS_PML);
    for (int it = blockIdx.x; it < 2048; it += gridDim.x) {
        const int own = 15 - (it >> 7), bh = it & 127, t0 = own * 256;
        const bf16_t* Kg = (const bf16_t*)(ws + XP_Q1 + 64 * MiB) + (size_t)bh * 4096 * 64 + (size_t)own * 4 * 4096;
        const bf16_t* Vg = (const bf16_t*)(ws + XP_Q1 + 128 * MiB) + (size_t)bh * 4096 * 64 + (size_t)own * 4 * 4096;
        asm volatile("s_waitcnt vmcnt(0)" ::: "memory");
        __builtin_amdgcn_s_barrier();
#pragma unroll
        for (int j = 0; j < 4; ++j) fa_issue(Kg + (size_t)j * 4096, Vg + (size_t)j * 4096, lds + j * 16384, tid);
        asm volatile("s_waitcnt vmcnt(0)" ::: "memory");
        __builtin_amdgcn_s_barrier();
        asm volatile("" ::: "memory");
#pragma unroll 1
        for (int g2 = 0; g2 < 2; ++g2) {
            const int row0 = t0 + g2 * 128 + wave * 32, q = row0 + r;
            const bf16_t* Qg = (const bf16_t*)(ws + XP_Q1) + ((size_t)bh * 4096 + q) * 64;
            bf16x8 qf[4];
#pragma unroll
            for (int ks = 0; ks < 4; ++ks) qf[ks] = *(const bf16x8*)(Qg + ks * 16 + 8 * h);
            const int nsel = __builtin_popcount((unsigned)selm[(size_t)bh * 4096 + q]);
            const size_t orow = ((size_t)(bh >> 4) * 4096 + q) * 1024 + (bh & 15) * 64;
            const float* pm = pml + ((size_t)bh * 4096 + q) * 6;
            float mi[3], li[3];
            u32x4 pa[3][4];
#pragma unroll
            for (int i = 0; i < 3; ++i) {
                mi[i] = i < nsel ? pm[2 * i] : -INFINITY; li[i] = i < nsel ? pm[2 * i + 1] : 0.f;
                const u32x4* po = (const u32x4*)(moba_po(P, i) + orow + 32 * h);
#pragma unroll
                for (int k = 0; k < 4; ++k) pa[i][k] = i < nsel ? po[k] : (u32x4){0u, 0u, 0u, 0u};
            }
            FA st; fa_init(st);
            const int jmax = (row0 + 31 - t0) >> 6;
#pragma unroll 1
            for (int j = 0; j <= jmax; ++j) {
                const LAS bf16_t* cur = (const LAS bf16_t*)(lds + j * 16384);
                const int kbase = t0 + j * 64;
                if (kbase + 63 <= row0) fa_tile<0>(st, qf, cur, cur + 4096, r, h, c, true, [=](int) { return true; });
                else fa_tile<2>(st, qf, cur, cur + 4096, r, h, c, true, [=](int koff) { return kbase + koff <= q; });
            }
            const float l_own = st.l + __shfl_xor(st.l, 32);
            const float M = fmaxf(fmaxf(st.m, mi[0]), fmaxf(mi[1], mi[2]));
            const float wo = __builtin_amdgcn_exp2f(st.m - M);
            float L = l_own * wo;
#pragma unroll
            for (int k = 0; k < 16; ++k) { st.o0[k] *= wo; st.o1[k] *= wo; }
#pragma unroll
            for (int i = 0; i < 3; ++i) {
                const float wi = li[i] * __builtin_amdgcn_exp2f(mi[i] - M);
                L += wi;
#pragma unroll
                for (int k = 0; k < 2; ++k) {
                    const f32x4 a0 = bf4_to_f((u32x2){pa[i][k].x, pa[i][k].y}), a1 = bf4_to_f((u32x2){pa[i][k].z, pa[i][k].w});
                    const f32x4 b0 = bf4_to_f((u32x2){pa[i][2 + k].x, pa[i][2 + k].y}), b1 = bf4_to_f((u32x2){pa[i][2 + k].z, pa[i][2 + k].w});
                    st.o0[8 * k] += wi * a0.x; st.o0[8 * k + 1] += wi * a0.y; st.o0[8 * k + 2] += wi * a0.z; st.o0[8 * k + 3] += wi * a0.w;
                    st.o0[8 * k + 4] += wi * a1.x; st.o0[8 * k + 5] += wi * a1.y; st.o0[8 * k + 6] += wi * a1.z; st.o0[8 * k + 7] += wi * a1.w;
                    st.o1[8 * k] += wi * b0.x; st.o1[8 * k + 1] += wi * b0.y; st.o1[8 * k + 2] += wi * b0.z; st.o1[8 * k + 3] += wi * b0.w;
                    st.o1[8 * k + 4] += wi * b1.x; st.o1[8 * k + 5] += wi * b1.y; st.o1[8 * k + 6] += wi * b1.z; st.o1[8 * k + 7] += wi * b1.w;
                }
            }
            const float inv = 1.f / fmaxf(L, 1e-30f);
            nat_store((bf16_t*)(ws + WS_MIX) + orow, h, st.o0, st.o1, inv);
        }
    }
}

constexpr int SMEM_BYTES = 65536 + 8192 + 1024 + 512;
static_assert(SMEM_BYTES >= 128 * 129 * 4 && SMEM_BYTES >= MOE_LDS_ROW + 512 && SMEM_BYTES >= NSA_LDS_MSK + 256, "LDS map");
constexpr int SMEM_OLD = 128 * 129 * 4;
typedef __attribute__((address_space(1))) unsigned gu32;
#define XB_TMO      128
#define XB_XCNT(j)  (256  + 64 * (j))
#define XB_XSUB(j)  (1280 + 64 * (j))
#define XB_XGEN(j)  (2304 + 64 * (j))
#define XB_TOP      3328
#define XB_TOPGEN   3392
#define XCD_BAR_WORDS 3456
#define XB_SPIN_CAP (1u << 18)

__device__ __forceinline__ unsigned xb_ld(unsigned* p)              { return __hip_atomic_load(p, __ATOMIC_RELAXED, __HIP_MEMORY_SCOPE_AGENT); }
__device__ __forceinline__ unsigned xb_add(unsigned* p, unsigned v) { return __hip_atomic_fetch_add(p, v, __ATOMIC_RELAXED, __HIP_MEMORY_SCOPE_AGENT); }
__device__ __forceinline__ unsigned xb_xcc_id() { return (unsigned)__builtin_amdgcn_s_getreg((3 << 11) | 20) & 0xFu; }
#define XB_SPIN(cond, bar) do { unsigned _sp = 0; while (cond) { __builtin_amdgcn_s_sleep(1); \
    if ((++_sp & 255u) == 0u) { if (xb_ld(&(bar)[XB_TMO])) break; if (_sp > XB_SPIN_CAP) { atomicAdd(&(bar)[XB_TMO], 1u); break; } } } } while (0)

struct XcdBarrier {
    unsigned* bar; unsigned x;
    volatile LAS unsigned* st;
};

__device__ __forceinline__ XcdBarrier xcd_barrier_post(unsigned* bar, volatile LAS unsigned* st) {
    XcdBarrier b; b.bar = bar; b.x = xb_xcc_id(); b.st = st;
    if (threadIdx.x == 0) (void)xb_add(&bar[XB_XCNT(b.x)], 1u);
    return b;
}
__device__ __forceinline__ void xcd_barrier_complete(unsigned* bar, unsigned x, unsigned& nloc, unsigned& nx) {
    const unsigned G = gridDim.x * gridDim.y * gridDim.z;
    unsigned sum, cnt, mine, sp = 0u;
    for (;;) {
        sum = 0u; cnt = 0u; mine = 0u;
#pragma unroll
        for (unsigned j = 0; j < 16; ++j) { const unsigned c = xb_ld(&bar[XB_XCNT(j)]); sum += c; cnt += (c > 0u) ? 1u : 0u; mine = (j == x) ? c : mine; }
        if (sum == G) break;
        __builtin_amdgcn_s_sleep(1);
        if ((++sp & 255u) == 0u) { if (xb_ld(&bar[XB_TMO])) break; if (sp > XB_SPIN_CAP) { atomicAdd(&bar[XB_TMO], 1u); break; } }
    }
    nloc = mine > 0u ? mine : 1u; nx = cnt > 0u ? cnt : 1u;
}

__device__ __forceinline__ void xcd_barrier(const XcdBarrier& b) {
    asm volatile("s_waitcnt vmcnt(0)" ::: "memory");
    __syncthreads();
    if (threadIdx.x == 0) {
        unsigned* bar = b.bar;
        __builtin_amdgcn_s_waitcnt(0);
        unsigned nloc = b.st[0], nx = b.st[1];
        if (nloc == 0u) { xcd_barrier_complete(bar, b.x, nloc, nx); b.st[0] = nloc; b.st[1] = nx; }
        const unsigned old = xb_add(&bar[XB_XSUB(b.x)], 1u);
        const unsigned gen = old / nloc;
        if (old + 1u == (gen + 1u) * nloc) {
            __builtin_amdgcn_fence(__ATOMIC_RELEASE, "agent");
            asm volatile("s_waitcnt vmcnt(0)" ::: "memory");
            const unsigned og = xb_add(&bar[XB_TOP], 1u);
            const unsigned tg = og / nx;
            if (og + 1u == (tg + 1u) * nx) xb_add(&bar[XB_TOPGEN], 1u);
            else XB_SPIN(xb_ld(&bar[XB_TOPGEN]) == tg, bar);
            __builtin_amdgcn_fence(__ATOMIC_ACQUIRE, "agent");
            xb_add(&bar[XB_XGEN(b.x)], 1u);
            asm volatile("s_waitcnt vmcnt(0)" ::: "memory");
        } else {
            XB_SPIN(xb_ld(&bar[XB_XGEN(b.x)]) == gen, bar);
            __builtin_amdgcn_fence(__ATOMIC_ACQUIRE, "agent");
            asm volatile("s_waitcnt vmcnt(0)" ::: "memory");
        }
    }
    __syncthreads();
}

constexpr size_t CTL_BAR = 16384;
constexpr size_t CTL_BYTES = 32768;

#define PHASE(k, call) if (P.ph_lo <= (k) && (k) < P.ph_hi) { call; if ((k) + 1 < P.ph_hi) xcd_barrier(xb); }
__global__ void __launch_bounds__(256, 2) mega(Params P) {
    __shared__ __attribute__((aligned(16))) unsigned char smem[SMEM_BYTES + 16];
    unsigned* xbst = (unsigned*)(smem + SMEM_BYTES);
    cg::grid_group grid = cg::this_grid();
    if (threadIdx.x < 4) xbst[threadIdx.x] = 0u;
    __syncthreads();
    if (P.ph_lo < 0) grid.sync();
    XcdBarrier xb = xcd_barrier_post((unsigned*)(P.ws + WS_CTL + CTL_BAR), (volatile LAS unsigned*)xbst);
    PHASE(0, phase0(P, smem))
    PHASE(1, phase_inproj0(P, smem))
    PHASE(2, phase_cmp_s5e(P, smem))
    PHASE(3, phase_glu(P, smem); phase_nsa(P, smem))
    PHASE(6, phase_outproj<false>(P, smem, P.in[0], nullptr, WS_WOUT0))
    PHASE(7, phase_ln_router(P, 0))
    PHASE(8, phase_moe_gu(P, smem, 0))
    PHASE(9, phase_moe_down(P, smem, 0))
    PHASE(10, phase_ln_ffn(P, 0))
    PHASE(11, phase_inproj1(P, smem))
    PHASE(12, phase_moba_gate(P, smem))
    PHASE(13, phase_moba_kv(P, smem))
    PHASE(14, phase_moba_own(P, smem))
    PHASE(15, phase_outproj<true>(P, smem, nullptr, (const bf16_t*)P.out, WS_WOUT1))
    PHASE(16, phase_ln_router(P, 1))
    PHASE(17, phase_moe_gu(P, smem, 1))
    PHASE(18, phase_moe_down(P, smem, 1))
    PHASE(20, phase_ln_ffn(P, 1))
}

extern "C" void kernel_launch(void* const* d_in, const int* in_sizes, int n_in, void* d_out, int out_size, void* d_ws, size_t ws_size, hipStream_t stream) {
    static int grid = 0;
    if (grid == 0) {
        if (n_in != 32 || out_size != NT * DM || ws_size < WS_END) { fprintf(stderr, "kernel_launch: unexpected shapes (n_in %d, out %d, ws %zu)\n", n_in, out_size, ws_size); grid = -1; return; }
        int dev = 0, cus = 0, per_cu = 0;
        (void)hipGetDevice(&dev);
        (void)hipDeviceGetAttribute(&cus, hipDeviceAttributeMultiprocessorCount, dev);
        (void)hipOccupancyMaxActiveBlocksPerMultiprocessor(&per_cu, mega, 256, 0);
        if (per_cu < 1) per_cu = 1;
        if (per_cu > 2) per_cu = 2;
        grid = cus * per_cu;
    }
    if (grid < 0) return;
    (void)hipMemsetAsync((char*)d_ws + WS_CTL, 0, CTL_BYTES, stream);
    Params p{};
    for (int i = 0; i < 32; ++i) p.in[i] = (const float*)d_in[i];
    p.out = (float*)d_out; p.ws = (unsigned char*)d_ws;
    p.ph_lo = 0; p.ph_hi = NPH;
    void* args[] = {&p};
    hipError_t e = hipLaunchCooperativeKernel((void*)mega, dim3(grid), dim3(256), args, 0, stream);
    if (e != hipSuccess) fprintf(stderr, "cooperative launch failed: %s (grid %d)\n", hipGetErrorString(e), grid);
}
```

```cpp
#include <hip/hip_runtime.h>
#include <hip/hip_cooperative_groups.h>
#include <cstdio>
#include <cstdint>
namespace cg = cooperative_groups;

typedef unsigned short bf16_t;
typedef short bf16x8 __attribute__((ext_vector_type(8)));
typedef float f32x4 __attribute__((ext_vector_type(4)));
typedef unsigned u32x4 __attribute__((ext_vector_type(4)));
typedef unsigned u32x2 __attribute__((ext_vector_type(2)));
#define DI __device__ __forceinline__
#define LAS __attribute__((address_space(3)))
typedef float f32x16 __attribute__((ext_vector_type(16)));
typedef float f32x8 __attribute__((ext_vector_type(8)));
typedef __bf16 bf16x8v __attribute__((ext_vector_type(8)));
typedef __bf16 bf16x4v __attribute__((ext_vector_type(4)));
#define MFMA32(a, b, c) __builtin_amdgcn_mfma_f32_32x32x16_bf16((a), (b), (c), 0, 0, 0)

constexpr int NB = 8, SEQ = 4096, DM = 1024, NT = NB * SEQ;
constexpr float ALPHA = 1.41421356237f;
constexpr float LN_EPS = 1e-5f;
constexpr int NIN0 = 1920;
constexpr int NPH = 21;

constexpr size_t MiB = 1u << 20;
constexpr size_t WS_CTL = 0;
constexpr size_t WS_ROPE = 1 * MiB;
constexpr size_t WS_WIN0 = 2 * MiB;
constexpr size_t WS_WOUT0 = 6 * MiB;
constexpr size_t WS_WIN1 = 8 * MiB;
constexpr size_t WS_WOUT1 = 14 * MiB;
constexpr size_t WS_WGLU = 16 * MiB;
constexpr size_t WS_WCK1 = 16 * MiB + 512 * 1024;
constexpr size_t WS_WCV1 = 17 * MiB;
constexpr size_t WS_WCK2 = 17 * MiB + 512 * 1024;
constexpr size_t WS_WCV2 = WS_WCK2 + 16384;
constexpr size_t WS_CBIAS = WS_WCV2 + 16384;
constexpr size_t WS_S5AL = WS_CBIAS + 4096;
constexpr size_t WS_RTRW = 17 * MiB + 640 * 1024;
constexpr size_t WS_BTE = 18 * MiB;
constexpr size_t WS_BTY = 22 * MiB;
constexpr size_t WS_WGU = 42 * MiB;
constexpr size_t WS_WDN = 74 * MiB;
constexpr size_t WS_KMP = 90 * MiB;
constexpr size_t WS_WGT = 94 * MiB;
constexpr size_t WS_KMEAN = 94 * MiB + 512 * 1024;
constexpr size_t WS_KCMP = 95 * MiB;
constexpr size_t WS_VCMP = 95 * MiB + 512 * 1024;
constexpr size_t WS_ACTB = 96 * MiB;
constexpr size_t WS_MIX = 160 * MiB;
constexpr size_t WS_XP = 224 * MiB;
constexpr size_t WS_LIST2 = 416 * MiB;
constexpr size_t WS_SELM = 92 * MiB;
constexpr size_t WS_MCNT = 93 * MiB;
constexpr size_t WS_MLIST = WS_LIST2;
constexpr size_t WS_PO2 = 424 * MiB;
constexpr size_t WS_PML = 488 * MiB;
constexpr size_t WS_END = 504 * MiB;
constexpr size_t XP_Q0 = WS_XP;
constexpr size_t XP_KC = WS_XP + 32 * MiB;
constexpr size_t KVSZ = 8 * MiB;
constexpr size_t XP_GATES = WS_XP + 80 * MiB;
constexpr size_t XP_AEXT = WS_XP + 84 * MiB;
constexpr size_t XP_G5 = WS_XP + 124 * MiB;
constexpr size_t XP_PRE = WS_XP;
constexpr size_t XP_YB = WS_XP;
constexpr size_t XP_H = WS_XP + 128 * MiB;
constexpr size_t XP_Q1 = WS_XP;

struct Params {
    const float* in[32];
    float* out;
    unsigned char* ws;
    int ph_lo, ph_hi;
};

DI bf16_t f2bf(float f) { unsigned u = __float_as_uint(f); return (bf16_t)((u + 0x7fffu + ((u >> 16) & 1u)) >> 16); }
DI float bf2f(bf16_t h) { return __uint_as_float(((unsigned)h) << 16); }
DI unsigned pk2(float lo, float hi) { return (unsigned)f2bf(lo) | ((unsigned)f2bf(hi) << 16); }
DI bf16x8 cvt8(f32x8 v) { return __builtin_bit_cast(bf16x8, __builtin_convertvector(v, bf16x8v)); }
DI u32x2 cvt4(f32x4 v) { return __builtin_bit_cast(u32x2, __builtin_convertvector(v, bf16x4v)); }
DI int natdim(int p) { const int hh = p >> 5, i = p & 31; return ((i >> 4) << 5) + 8 * ((i & 15) >> 2) + 4 * hh + (i & 3); }
DI u32x4 cvt8u(f32x16 v, int k, float s) { return __builtin_bit_cast(u32x4, cvt8((f32x8){v[8 * k] * s, v[8 * k + 1] * s, v[8 * k + 2] * s, v[8 * k + 3] * s, v[8 * k + 4] * s, v[8 * k + 5] * s, v[8 * k + 6] * s, v[8 * k + 7] * s})); }
DI void nat_store(bf16_t* o, int h, const f32x16& o0, const f32x16& o1, float s) {
    u32x4* d = (u32x4*)(o + 32 * h);
    d[0] = cvt8u(o0, 0, s); d[1] = cvt8u(o0, 1, s); d[2] = cvt8u(o1, 0, s); d[3] = cvt8u(o1, 1, s);
}
DI u32x4 cvt44(f32x4 a, f32x4 b) { const u32x2 lo = cvt4(a), hi = cvt4(b); return (u32x4){lo.x, lo.y, hi.x, hi.y}; }
DI size_t kp_off(int key, int d) { return ((size_t)((key >> 5) * 4 + (d >> 4)) * 32 + (key & 31)) * 16 + (d & 15); }
DI int vp_pos(int ko) { return 8 * ((ko >> 2) & 1) + 4 * (ko >> 3) + (ko & 3); }
DI size_t vp_off(int key, int d) { return ((size_t)(key >> 4) * 64 + d) * 16 + vp_pos(key & 15); }
DI bf16_t ld_bf(const bf16_t* p) { return *p; }
DI f32x4 bf4_to_f(u32x2 w) { return (f32x4){__uint_as_float(w.x << 16), __uint_as_float(w.x & 0xffff0000u), __uint_as_float(w.y << 16), __uint_as_float(w.y & 0xffff0000u)}; }
template <int CTRL> DI float dpp_f(float v) { return __builtin_bit_cast(float, __builtin_amdgcn_update_dpp(0, __builtin_bit_cast(int, v), CTRL, 0xF, 0xF, true)); }
DI float wave_sum(float v) {
    v += dpp_f<0xB1>(v);
    v += dpp_f<0x4E>(v);
    v += dpp_f<0x141>(v);
    v += dpp_f<0x140>(v);
    { const auto s = __builtin_amdgcn_permlane16_swap(__float_as_uint(v), __float_as_uint(v), false, false); v = __uint_as_float(s[0]) + __uint_as_float(s[1]); }
    { const auto s = __builtin_amdgcn_permlane32_swap(__float_as_uint(v), __float_as_uint(v), false, false); v = __uint_as_float(s[0]) + __uint_as_float(s[1]); }
    return v;
}
DI float wave_max(float v) {
#pragma unroll
    for (int o = 32; o > 0; o >>= 1) v = fmaxf(v, __shfl_xor(v, o));
    return v;
}
DI float sigmoidf_(float x) { return __builtin_amdgcn_rcpf(1.f + __expf(-x)); }
DI float gelu_tanh(float x) { const float z = 0.7978845608028654f * (x + 0.044715f * x * x * x); return x * sigmoidf_(2.f * z); }

template <bool TRANS, bool PIN = true>
DI void gemm_kstep(const LAS unsigned char* cur, int aoff, int boff, int fq, int swz, f32x4 (&acc)[4][4]) {
    if (!PIN) {
#pragma unroll
        for (int ks = 0; ks < 2; ++ks) {
            bf16x8 af[4], bfr[4];
            const int co = ((ks * 4 + fq) ^ swz) * 16;
#pragma unroll
            for (int m = 0; m < 4; ++m) af[m] = *(const LAS bf16x8*)(cur + aoff + m * 2048 + co);
#pragma unroll
            for (int n = 0; n < 4; ++n) bfr[n] = *(const LAS bf16x8*)(cur + boff + n * 2048 + co);
#pragma unroll
            for (int m = 0; m < 4; ++m)
#pragma unroll
                for (int n = 0; n < 4; ++n) acc[m][n] = TRANS ? __builtin_amdgcn_mfma_f32_16x16x32_bf16(bfr[n], af[m], acc[m][n], 0, 0, 0) : __builtin_amdgcn_mfma_f32_16x16x32_bf16(af[m], bfr[n], acc[m][n], 0, 0, 0);
        }
        return;
    }
    bf16x8 af[2][4], bfr[2][4];
    const int co0 = (fq ^ swz) * 16, co1 = ((4 + fq) ^ swz) * 16;
    af[0][0] = *(const LAS bf16x8*)(cur + aoff + co0);
#pragma unroll
    for (int n = 0; n < 4; ++n) bfr[0][n] = *(const LAS bf16x8*)(cur + boff + n * 2048 + co0);
#pragma unroll
    for (int m = 1; m < 4; ++m) af[0][m] = *(const LAS bf16x8*)(cur + aoff + m * 2048 + co0);
    __builtin_amdgcn_sched_barrier(0);
#pragma unroll
    for (int n = 0; n < 4; ++n) acc[0][n] = TRANS ? __builtin_amdgcn_mfma_f32_16x16x32_bf16(bfr[0][n], af[0][0], acc[0][n], 0, 0, 0) : __builtin_amdgcn_mfma_f32_16x16x32_bf16(af[0][0], bfr[0][n], acc[0][n], 0, 0, 0);
    __builtin_amdgcn_sched_barrier(0);
    af[1][0] = *(const LAS bf16x8*)(cur + aoff + co1);
#pragma unroll
    for (int n = 0; n < 4; ++n) bfr[1][n] = *(const LAS bf16x8*)(cur + boff + n * 2048 + co1);
#pragma unroll
    for (int m = 1; m < 4; ++m) af[1][m] = *(const LAS bf16x8*)(cur + aoff + m * 2048 + co1);
    __builtin_amdgcn_sched_barrier(0);
#pragma unroll
    for (int m = 1; m < 4; ++m)
#pragma unroll
        for (int n = 0; n < 4; ++n) acc[m][n] = TRANS ? __builtin_amdgcn_mfma_f32_16x16x32_bf16(bfr[0][n], af[0][m], acc[m][n], 0, 0, 0) : __builtin_amdgcn_mfma_f32_16x16x32_bf16(af[0][m], bfr[0][n], acc[m][n], 0, 0, 0);
#pragma unroll
    for (int m = 0; m < 4; ++m)
#pragma unroll
        for (int n = 0; n < 4; ++n) acc[m][n] = TRANS ? __builtin_amdgcn_mfma_f32_16x16x32_bf16(bfr[1][n], af[1][m], acc[m][n], 0, 0, 0) : __builtin_amdgcn_mfma_f32_16x16x32_bf16(af[1][m], bfr[1][n], acc[m][n], 0, 0, 0);
}
constexpr int GEMM_LDS = 65536;
template <bool TRANS = true, bool PIN = true, class RowPtr, class Epi>
DI void gemm128(RowPtr rowptr, const bf16_t* __restrict__ Bt, int ldb, int K, unsigned char* smem, Epi epi, int kskip_lo = 0, int kskip_hi = 0) {
    LAS unsigned char* lds = (LAS unsigned char*)smem;
    const int tid = threadIdx.x, lane = tid & 63, wave = tid >> 6, wr = wave >> 1, wc = wave & 1, fr = lane & 15, fq = lane >> 4;
    const int schunk = ((tid & 7) ^ ((tid >> 4) & 7)) * 8;
    const bf16_t* ga[4];
#pragma unroll
    for (int i = 0; i < 4; ++i) ga[i] = rowptr(i * 32 + (tid >> 3)) + schunk;
    const bf16_t* gb = Bt + (size_t)(tid >> 3) * ldb + schunk;
    const size_t gbs = (size_t)32 * ldb;
    auto stage = [&](int kt, int s) {
#pragma unroll
        for (int i = 0; i < 4; ++i) {
            __builtin_amdgcn_global_load_lds((const unsigned*)(ga[i] + kt * 64), (LAS unsigned*)(lds + s * 32768 + (i * 256 + tid) * 16), 16, 0, 0);
            __builtin_amdgcn_global_load_lds((const unsigned*)(gb + i * gbs + kt * 64), (LAS unsigned*)(lds + s * 32768 + 16384 + (i * 256 + tid) * 16), 16, 0, 0);
        }
    };
    f32x4 acc[4][4];
#pragma unroll
    for (int m = 0; m < 4; ++m)
#pragma unroll
        for (int n = 0; n < 4; ++n) acc[m][n] = (f32x4){0.f, 0.f, 0.f, 0.f};
    const int nskip = kskip_hi - kskip_lo, nk = (K >> 6) - nskip;
    const int swz = (fr >> 1) & 7;
    const int aoff = (wr * 64 + fr) * 128, boff = 16384 + (wc * 64 + fr) * 128;
    stage(kskip_lo == 0 ? nskip : 0, 0);
#pragma unroll 1
    for (int kt = 0; kt < nk; ++kt) {
        asm volatile("s_waitcnt vmcnt(0)" ::: "memory");
        __syncthreads();
        if (kt + 1 < nk) stage(kt + 1 < kskip_lo ? kt + 1 : kt + 1 + nskip, (kt + 1) & 1);
        const LAS unsigned char* cur = lds + (kt & 1) * 32768;
        gemm_kstep<TRANS, PIN>(cur, aoff, boff, fq, swz, acc);
    }
    __syncthreads();
    epi(acc, wr, wc, lane);
}

template <bool TRANS = true, class RowPtr, class Epi, class NextRow>
DI void gemm128s(RowPtr rowptr, const bf16_t* __restrict__ Bt, int ldb, int K, unsigned char* smem, Epi epi, bool prefetched, bool has_next, NextRow nextrow, const bf16_t* __restrict__ nextBt) {
    LAS unsigned char* lds = (LAS unsigned char*)smem;
    const int tid = threadIdx.x, lane = tid & 63, wave = tid >> 6, wr = wave >> 1, wc = wave & 1, fr = lane & 15, fq = lane >> 4;
    const int schunk = ((tid & 7) ^ ((tid >> 4) & 7)) * 8;
    const bf16_t* ga[4];
#pragma unroll
    for (int i = 0; i < 4; ++i) ga[i] = rowptr(i * 32 + (tid >> 3)) + schunk;
    const bf16_t* gb = Bt + (size_t)(tid >> 3) * ldb + schunk;
    const size_t gbs = (size_t)32 * ldb;
    auto stage = [&](int kt, int s) {
#pragma unroll
        for (int i = 0; i < 4; ++i) {
            __builtin_amdgcn_global_load_lds((const unsigned*)(ga[i] + kt * 64), (LAS unsigned*)(lds + s * 32768 + (i * 256 + tid) * 16), 16, 0, 0);
            __builtin_amdgcn_global_load_lds((const unsigned*)(gb + i * gbs + kt * 64), (LAS unsigned*)(lds + s * 32768 + 16384 + (i * 256 + tid) * 16), 16, 0, 0);
        }
    };
    f32x4 acc[4][4];
#pragma unroll
    for (int m = 0; m < 4; ++m)
#pragma unroll
        for (int n = 0; n < 4; ++n) acc[m][n] = (f32x4){0.f, 0.f, 0.f, 0.f};
    const int nk = K >> 6;
    const int swz = (fr >> 1) & 7;
    const int aoff = (wr * 64 + fr) * 128, boff = 16384 + (wc * 64 + fr) * 128;
    if (!prefetched) stage(0, 0);
#pragma unroll 1
    for (int kt = 0; kt < nk; ++kt) {
        asm volatile("s_waitcnt vmcnt(0)" ::: "memory");
        __syncthreads();
        if (kt + 1 < nk) stage(kt + 1, (kt + 1) & 1);
        else if (has_next) {
#pragma unroll
            for (int i = 0; i < 4; ++i) {
                __builtin_amdgcn_global_load_lds((const unsigned*)(nextrow(i * 32 + (tid >> 3)) + schunk), (LAS unsigned*)(lds + (i * 256 + tid) * 16), 16, 0, 0);
                __builtin_amdgcn_global_load_lds((const unsigned*)(nextBt + (size_t)(tid >> 3) * ldb + schunk + i * gbs), (LAS unsigned*)(lds + 16384 + (i * 256 + tid) * 16), 16, 0, 0);
            }
        }
        const LAS unsigned char* cur = lds + (kt & 1) * 32768;
        gemm_kstep<TRANS>(cur, aoff, boff, fq, swz, acc);
    }
    epi(acc, wr, wc, lane);
}

DI int vblock() { const int G = gridDim.x; return (G & 7) == 0 ? (int)(blockIdx.x & 7) * (G >> 3) + (int)(blockIdx.x >> 3) : (int)blockIdx.x; }
DI void tile_mn(int it, int nN, int& mt, int& nt) { const int per = 8 * nN, grp = it / per, idx = it - grp * per; nt = idx >> 3; mt = grp * 8 + (idx & 7); }

DI int rope_pos(int l) { return (l & ~63) + 16 * (2 * ((l >> 2) & 1) + ((l >> 5) & 1)) + 4 * ((l >> 3) & 3) + (l & 3); }
DI int rowmap(int kind, int n) {
    if (kind == 1) {
        if (n < 512 || (n >= 512 && n < 640) || (n >= 768 && n < 896) || (n >= 1024 && n < 1152)) return rope_pos(n);
        return n < 1304 ? n : n + 104;
    }
    if (kind == 4) return n < 2048 ? rope_pos(n) : n;
    const int inv32 = 16 * ((n >> 2) & 1) + 4 * ((n & 31) >> 3) + (n & 3);
    if (kind == 2) return ((n >> 5) << 6) + inv32;
    if (kind == 3) return ((n >> 5) << 6) + 32 + inv32;
    if (kind == 5) return (n & ~31) + inv32;
    return n;
}
template <bool KNAT = false>
DI void tr_tile(const float* __restrict__ src, int K, int N, bf16_t* __restrict__ dst, int kind, int kt, int nt, float* s) {
    const int tid = threadIdx.x, k0 = kt * 64, n0 = nt * 64;
    {
        const int nn = tid & 63, kq = tid >> 6, n = n0 + nn;
#pragma unroll
        for (int i = 0; i < 16; ++i) { const int kk = kq + 4 * i; s[kk * 65 + nn] = (n < N) ? src[(size_t)(k0 + kk) * N + n] : 0.f; }
    }
    __syncthreads();
    {
        const int rn = tid >> 2, kseg = (tid & 3) * 16, n = n0 + rn;
        if (n < N) {
            unsigned w[8];
#pragma unroll
            for (int i = 0; i < 8; ++i) w[i] = KNAT ? pk2(s[natdim(kseg + 2 * i) * 65 + rn], s[natdim(kseg + 2 * i + 1) * 65 + rn]) : pk2(s[(kseg + 2 * i) * 65 + rn], s[(kseg + 2 * i + 1) * 65 + rn]);
            bf16_t* d = dst + (size_t)rowmap(kind, n) * K + k0 + kseg;
            *(uint4*)d = make_uint4(w[0], w[1], w[2], w[3]);
            *(uint4*)(d + 8) = make_uint4(w[4], w[5], w[6], w[7]);
        }
    }
    __syncthreads();
}
struct CF { float re, im; };
DI CF cmul(CF a, CF b) { return {a.re * b.re - a.im * b.im, a.re * b.im + a.im * b.re}; }
DI CF s5_apow(const Params& P, int g, int p, float tau) {
    const float step = expf(P.in[10][g]);
    const float lr = P.in[8][g * 64 + p], li = P.in[9][g * 64 + p];
    const float mag = expf(lr * step * tau);
    float sn, cs; sincosf(li * step * tau, &sn, &cs);
    return {mag * cs, mag * sn};
}
DI CF s5_f(const Params& P, int g, int p) {
    const CF a = s5_apow(P, g, p, 1.f);
    const float lr = P.in[8][g * 64 + p], li = P.in[9][g * 64 + p];
    const float den = lr * lr + li * li;
    return {((a.re - 1.f) * lr + a.im * li) / den, (a.im * lr - (a.re - 1.f) * li) / den};
}
DI void phase0(const Params& P, unsigned char* smem) {
    const int tid = threadIdx.x;
    unsigned char* ws = P.ws;
    float* sf = (float*)smem;
    constexpr int N_TR0 = 16 * 29, N_TR1 = 256, N_TR2 = 16 * 48, N_TR3 = 256, N_TR4 = 64, N_TR5 = 64, N_TR6 = 64, N_TR7 = 2, N_TR8 = 2;
    constexpr int N_TRG = 64 * 32, N_TRU = 64 * 32, N_TRD = 64 * 32;
    constexpr int N_X = NT * DM / 8192, N_ROPE = 512, N_CB = 16, N_AL = 8, N_BTE = 256, N_BTYM = 32 * 63, N_BTYQ = 4096, N_ZP = 13;
    constexpr int N_RW = 2 * 36864 / 256;
    constexpr int TOTAL = N_RW + N_TR0 + N_TR1 + N_TR4 + N_TR5 + N_TR6 + N_TR7 + N_TR8 + N_X + N_ROPE + N_CB + N_AL + N_BTE + N_BTYM + N_BTYQ + N_ZP;
    for (int it0 = blockIdx.x; it0 < TOTAL; it0 += gridDim.x) {
        int it = it0;
        if (it < N_RW) {
            const int e = it * 256 + tid, layer = e / 36864, r = e % 36864;
            float* dst = (float*)(ws + WS_RTRW) + (size_t)layer * 36864;
            if (r < 4096) { const int o = r & 3, l = (r >> 2) & 63, jk = r >> 8, d = 4 * l + 256 * (jk >> 2) + (jk & 3); dst[r] = P.in[25][((size_t)layer * 1024 + d) * 4 + o]; }
            else { const int q = r - 4096, o = q & 3, l = (q >> 2) & 63, hf = (q >> 8) & 1, jk = (q >> 9) & 15, g = q >> 13, d = 4 * l + 256 * (jk >> 2) + (jk & 3);
                   dst[r] = P.in[27][(((size_t)layer * 4 + g) * 1024 + d) * 8 + hf * 4 + o]; }
            continue;
        } it -= N_RW;
        if (it < N_TR0) { tr_tile(P.in[1], 1024, 1816, (bf16_t*)(ws + WS_WIN0), 1, it / 29, it % 29, sf); continue; } it -= N_TR0;
        if (it < N_TR1) { if (it / 16 < 8) tr_tile<true>(P.in[18], 1024, 1024, (bf16_t*)(ws + WS_WOUT0), 5, it / 16, it % 16, sf); else tr_tile(P.in[18], 1024, 1024, (bf16_t*)(ws + WS_WOUT0), 5, it / 16, it % 16, sf); continue; } it -= N_TR1;
        if (it < N_TR4) { tr_tile(P.in[16], 512, 512, (bf16_t*)(ws + WS_WGLU), 5, it / 8, it % 8, sf); continue; } it -= N_TR4;
        if (it < N_TR5) { tr_tile(P.in[4], 2048, 128, (bf16_t*)(ws + WS_WCK1), 0, it / 2, it % 2, sf); continue; } it -= N_TR5;
        if (it < N_TR6) { tr_tile(P.in[6], 2048, 128, (bf16_t*)(ws + WS_WCV1), 0, it / 2, it % 2, sf); continue; } it -= N_TR6;
        if (it < N_TR7) { tr_tile(P.in[5], 128, 64, (bf16_t*)(ws + WS_WCK2), 0, it, 0, sf); continue; } it -= N_TR7;
        if (it < N_TR8) { tr_tile(P.in[7], 128, 64, (bf16_t*)(ws + WS_WCV2), 0, it, 0, sf); continue; } it -= N_TR8;
        if (it < N_X) {
            const float* x = P.in[0]; bf16_t* xb = (bf16_t*)(ws + WS_ACTB);
#pragma unroll
            for (int i = 0; i < 4; ++i) {
                const size_t idx = (size_t)it * 8192 + i * 2048 + tid * 8;
                const f32x4 a = __builtin_nontemporal_load((const f32x4*)(x + idx)), b = __builtin_nontemporal_load((const f32x4*)(x + idx + 4));
                *(uint4*)(xb + idx) = make_uint4(pk2(a.x, a.y), pk2(a.z, a.w), pk2(b.x, b.y), pk2(b.z, b.w));
            }
            continue;
        } it -= N_X;
        if (it < N_ROPE) {
            const int e = it * 256 + tid, pos = e >> 5, i = e & 31;
            const float inv = 1.0f / powf(10000.0f, (float)(2 * i) / 64.0f);
            const float ang = (float)pos * inv;
            ((float*)(ws + WS_ROPE))[e] = (float)cos((double)ang);
            ((float*)(ws + WS_ROPE))[4096 * 32 + e] = (float)sin((double)ang);
            continue;
        } it -= N_ROPE;
        if (it < N_CB) {
            const int kv = it >> 3, j0 = (it & 7) * 16, j = j0 + (tid & 15), sl = tid >> 4;
            const float* pe = P.in[kv ? 3 : 2]; const float* w1 = P.in[kv ? 6 : 4];
            float a = 0.f;
            for (int i = sl * 128; i < sl * 128 + 128; ++i) a += pe[i] * w1[(size_t)i * 128 + j];
            sf[tid] = a; __syncthreads();
            if (tid < 16) { float t = 0.f; for (int q = 0; q < 16; ++q) t += sf[q * 16 + tid]; ((float*)(ws + WS_CBIAS))[kv * 128 + j0 + tid] = t; }
            __syncthreads();
            continue;
        } it -= N_CB;
        if (it < N_AL) {
            const int e = it * 256 + tid, g = e >> 6, p = e & 63;
            const CF a = s5_apow(P, g, p, 32.f);
            ((float*)(ws + WS_S5AL))[e * 2] = a.re; ((float*)(ws + WS_S5AL))[e * 2 + 1] = a.im;
            continue;
        } it -= N_AL;
        if (it < N_BTE) {
            const int e = it * 256 + tid, g = e >> 11, p = (e >> 5) & 63, r = e & 31;
            const CF w = cmul(s5_apow(P, g, p, (float)(31 - r)), s5_f(P, g, p));
            bf16_t* d = (bf16_t*)(ws + WS_BTE) + (size_t)g * 128 * 512;
#pragma unroll
            for (int c = 0; c < 16; ++c) {
                const CF bb = {P.in[11][(g * 64 + p) * 16 + c], P.in[12][(g * 64 + p) * 16 + c]};
                const CF v = cmul(w, bb);
                d[(size_t)p * 512 + r * 16 + c] = f2bf(v.re);
                d[(size_t)(64 + p) * 512 + r * 16 + c] = f2bf(v.im);
            }
            continue;
        } it -= N_BTE;
        if (it < N_BTYM) {
            const int g = it / 63, dd = it % 63 - 31, ch = tid >> 4, c = tid & 15;
            float val = 0.f;
            if (dd >= 0) {
                float* sw = sf; float* sb = sf + 128; float* sc = sf + 128 + 2048;
                if (tid < 64) { const CF w = cmul(s5_apow(P, g, tid, (float)dd), s5_f(P, g, tid)); sw[2 * tid] = w.re; sw[2 * tid + 1] = w.im; }
#pragma unroll
                for (int i = 0; i < 4; ++i) {
                    const int e = tid + 256 * i;
                    sb[2 * e] = P.in[11][(size_t)g * 1024 + e]; sb[2 * e + 1] = P.in[12][(size_t)g * 1024 + e];
                    sc[2 * e] = P.in[13][(size_t)g * 1024 + e]; sc[2 * e + 1] = P.in[14][(size_t)g * 1024 + e];
                }
                __syncthreads();
#pragma unroll 8
                for (int p = 0; p < 64; ++p) {
                    const CF bb = {sb[2 * (p * 16 + c)], sb[2 * (p * 16 + c) + 1]};
                    const CF cc = {sc[2 * (ch * 64 + p)], sc[2 * (ch * 64 + p) + 1]};
                    const CF w = {sw[2 * p], sw[2 * p + 1]};
                    val += cmul(cc, cmul(w, bb)).re;
                }
                __syncthreads();
            }
            bf16_t* d = (bf16_t*)(ws + WS_BTY) + (size_t)g * 512 * 640;
            const bf16_t hv = f2bf(val);
            for (int r = 0; r < 32; ++r) { const int s = r + dd; if (s >= 0 && s < 32) d[(size_t)(s * 16 + ch) * 640 + r * 16 + c] = hv; }
            continue;
        } it -= N_BTYM;
        if (it < N_BTYQ) {
            const int e = it * 256 + tid, g = e >> 15, s = (e >> 10) & 31, ch = (e >> 6) & 15, p = e & 63;
            const CF cc = {P.in[13][(g * 16 + ch) * 64 + p], P.in[14][(g * 16 + ch) * 64 + p]};
            const CF w = cmul(cc, s5_apow(P, g, p, (float)(s + 1)));
            bf16_t* d = (bf16_t*)(ws + WS_BTY) + ((size_t)g * 512 + s * 16 + ch) * 640 + 512;
            d[p] = f2bf(w.re); d[64 + p] = f2bf(-w.im);
            continue;
        } it -= N_BTYQ;
        {
            uint4* d = (uint4*)((bf16_t*)(ws + WS_WIN0) + (size_t)(1304 + it * 8) * 1024);
#pragma unroll
            for (int i = 0; i < 4; ++i) d[i * 256 + tid] = make_uint4(0, 0, 0, 0);
        }
    }
}

DI void phase_inproj0(const Params& P, unsigned char* smem) {
    unsigned char* ws = P.ws;
    const bf16_t* A = (const bf16_t*)(ws + WS_ACTB);
    const float* cosT = (const float*)(ws + WS_ROPE);
    const float* sinT = cosT + 4096 * 32;
    constexpr int NTN = NIN0 / 128;
    bool pre = false;
    for (int it = vblock(); it < (NT / 128) * NTN; it += gridDim.x) {
        int mt, nt; tile_mn(it, NTN, mt, nt);
        const int m0 = mt * 128;
        auto rowptr = [=](int r) { return A + (size_t)(m0 + r) * 1024; };
        const bf16_t* Bt = (const bf16_t*)(ws + WS_WIN0) + (size_t)nt * 128 * 1024;
        const bool hn = it + (int)gridDim.x < (NT / 128) * NTN;
        int mtn = 0, ntn = 0; if (hn) tile_mn(it + gridDim.x, NTN, mtn, ntn);
        auto nextrow = [=](int r) { return A + (size_t)(mtn * 128 + r) * 1024; };
        const bf16_t* nBt = (const bf16_t*)(ws + WS_WIN0) + (size_t)ntn * 128 * 1024;
        if (nt == 7 || nt == 9) {
            auto epi = [=](f32x4 (&acc)[4][4], int wr, int wc, int lane) {
                const int fr = lane & 15, fq = lane >> 4, which = nt == 7 ? 3 : 5, g = wc;
#pragma unroll
                for (int m = 0; m < 4; ++m) {
                    const int t = m0 + wr * 64 + m * 16 + fq * 4, s = t & 4095, b = t >> 12;
                    bf16_t* dst = (bf16_t*)(ws + XP_KC + (size_t)which * KVSZ) + (size_t)(b * 2 + g) * 4096 * 64;
#pragma unroll
                    for (int n = 0; n < 4; ++n) *(u32x2*)(dst + vp_off(s, n * 16 + fr)) = cvt4(acc[m][n]);
                }
            };
            gemm128s<false>(rowptr, Bt, 1024, 1024, smem, epi, pre, hn, nextrow, nBt);
            pre = hn;
            continue;
        }
        auto epi = [=](f32x4 (&acc)[4][4], int wr, int wc, int lane) {
            const int u64 = nt * 2 + wc, fr = lane & 15, fq = lane >> 4;
#pragma unroll
            for (int m = 0; m < 4; ++m) {
                const int t = m0 + wr * 64 + m * 16 + fr, s = t & 4095, b = t >> 12;
                if (u64 < 20) {
                    const bool isq = u64 < 8;
                    const int which = (u64 - 8) >> 1, g = (u64 - 8) & 1;
                    if (isq || ((which & 1) == 0)) {
                        f32x4 r1[2], r2[2];
#pragma unroll
                        for (int n2 = 0; n2 < 2; ++n2) {
                            const int i = 8 * fq + 4 * n2;
                            const f32x4 c = *(const f32x4*)(cosT + s * 32 + i), sn = *(const f32x4*)(sinT + s * 32 + i);
                            const f32x4 x1 = acc[m][2 * n2], x2 = acc[m][2 * n2 + 1];
                            r1[n2] = x1 * c - x2 * sn; r2[n2] = x1 * sn + x2 * c;
                        }
                        const u32x4 o1 = cvt44(r1[0], r1[1]), o2 = cvt44(r2[0], r2[1]);
                        if (isq) { bf16_t* dst = (bf16_t*)(ws + XP_Q0) + (size_t)t * 512 + u64 * 64; *(u32x4*)(dst + 8 * fq) = o1; *(u32x4*)(dst + 8 * fq + 32) = o2; }
                        else {
                            bf16_t* dst = (bf16_t*)(ws + XP_KC + (size_t)which * KVSZ) + (size_t)(b * 2 + g) * 4096 * 64;
                            if (which == 0) { *(u32x4*)(dst + (size_t)s * 64 + 8 * fq) = o1; *(u32x4*)(dst + (size_t)s * 64 + 8 * fq + 32) = o2; }
                            else { *(u32x4*)(dst + kp_off(s, 8 * fq)) = o1; *(u32x4*)(dst + kp_off(s, 8 * fq + 32)) = o2; }
                        }
                    } else {
                        bf16_t* dst = (bf16_t*)(ws + XP_KC + (size_t)which * KVSZ) + ((size_t)(b * 2 + g) * 4096 + s) * 64;
#pragma unroll
                        for (int n = 0; n < 4; ++n) *(u32x2*)(dst + n * 16 + fq * 4) = cvt4(acc[m][n]);
                    }
                } else if (u64 == 20) {
#pragma unroll
                    for (int n = 0; n < 2; ++n) {
                        const int c0 = n * 16 + fq * 4;
                        if (c0 < 24) { f32x4 o; o.x = sigmoidf_(acc[m][n].x); o.y = sigmoidf_(acc[m][n].y); o.z = sigmoidf_(acc[m][n].z); o.w = sigmoidf_(acc[m][n].w); *(f32x4*)((float*)(ws + XP_GATES) + (size_t)t * 24 + c0) = o; }
                    }
                } else if (u64 >= 22) {
#pragma unroll
                    for (int n = 0; n < 4; ++n) {
                        const int g5 = (u64 - 22) * 4 + n;
                        *(u32x2*)((bf16_t*)(ws + XP_AEXT) + ((size_t)g5 * 1024 + (t >> 5)) * 640 + (t & 31) * 16 + fq * 4) = cvt4(acc[m][n]);
                    }
                }
            }
        };
        gemm128s(rowptr, Bt, 1024, 1024, smem, epi, pre, hn, nextrow, nBt);
        pre = hn;
    }
}

constexpr int N_LATE = 16 * 48 + 256 + 3 * 64 * 32;
DI void late_weights(const Params& P, unsigned char* smem, int it) {
    unsigned char* ws = P.ws;
    float* sf = (float*)smem;
    constexpr int N_TR2 = 16 * 48, N_TR3 = 256, N_TRG = 64 * 32, N_TRU = 64 * 32;
    if (it < N_TR2) { tr_tile(P.in[19], 1024, 3072, (bf16_t*)(ws + WS_WIN1), 4, it / 48, it % 48, sf); return; } it -= N_TR2;
    if (it < N_TR3) { tr_tile<true>(P.in[20], 1024, 1024, (bf16_t*)(ws + WS_WOUT1), 5, it / 16, it % 16, sf); return; } it -= N_TR3;
    if (it < N_TRG) { const int mat = it >> 5, r = it & 31; tr_tile(P.in[29] + (size_t)mat * 1024 * 128, 1024, 128, (bf16_t*)(ws + WS_WGU) + (size_t)mat * 256 * 1024, 2, r >> 1, r & 1, sf); return; } it -= N_TRG;
    if (it < N_TRU) { const int mat = it >> 5, r = it & 31; tr_tile(P.in[30] + (size_t)mat * 1024 * 128, 1024, 128, (bf16_t*)(ws + WS_WGU) + (size_t)mat * 256 * 1024, 3, r >> 1, r & 1, sf); return; } it -= N_TRU;
    { const int mat = it >> 5, r = it & 31; tr_tile(P.in[31] + (size_t)mat * 128 * 1024, 128, 1024, (bf16_t*)(ws + WS_WDN) + (size_t)mat * 1024 * 128, 5, r >> 4, r & 15, sf); }
}

DI void s5y_tile(const Params& P, unsigned char* smem, int g, int mt, int nt);
DI void phase_cmp_s5e(const Params& P, unsigned char* smem) {
    unsigned char* ws = P.ws;
    const int tid = threadIdx.x, lane = tid & 63, wave = tid >> 6;
    const int G = gridDim.x, bid = blockIdx.x;
    const bool split = G >= 384;
    const int nmine = !split ? (320 + N_LATE + G - 1 - bid) / G : (bid < 320 ? 1 : (N_LATE + (G - 320) - 1 - (bid - 320)) / (G - 320));
    for (int k = 0; k < nmine; ++k) {
        const int it = !split ? bid + k * G : (bid < 320 ? bid : 320 + (bid - 320) + k * (G - 320));
        if (it >= 64 + 256) { late_weights(P, smem, it - 320); continue; }
        if (it < 64) {
            const int kv = it >> 5, bg = (it >> 1) & 15, mt = it & 1;
            const bf16_t* src = (const bf16_t*)(ws + XP_KC + (size_t)kv * KVSZ) + (size_t)bg * 4096 * 64;
            const float* cb = (const float*)(ws + WS_CBIAS) + kv * 128;
            bf16_t* sH = (bf16_t*)smem;
            auto rowptr = [=](int r) { int rr = mt * 128 + r; rr = rr > 254 ? 254 : rr; return src + (size_t)rr * 1024; };
            auto epi = [=](f32x4 (&acc)[4][4], int wr, int wc, int ln) {
                const int fr = ln & 15, fq = ln >> 4;
#pragma unroll
                for (int m = 0; m < 4; ++m)
#pragma unroll
                    for (int n = 0; n < 4; ++n)
#pragma unroll
                        for (int j = 0; j < 4; ++j) {
                            const int r = wr * 64 + m * 16 + fr, c = wc * 64 + n * 16 + fq * 4 + j;
                            sH[r * 136 + c] = f2bf(gelu_tanh(acc[m][n][j] + cb[c]));
                        }
            };
            gemm128(rowptr, (const bf16_t*)(ws + (kv ? WS_WCV1 : WS_WCK1)), 2048, 2048, smem, epi);
            __syncthreads();
            const bf16_t* W2 = (const bf16_t*)(ws + (kv ? WS_WCV2 : WS_WCK2));
            f32x4 a2[2][4];
#pragma unroll
            for (int m = 0; m < 2; ++m)
#pragma unroll
                for (int n = 0; n < 4; ++n) a2[m][n] = (f32x4){0.f, 0.f, 0.f, 0.f};
#pragma unroll
            for (int ks = 0; ks < 4; ++ks) {
                bf16x8 af[2], bfr[4];
#pragma unroll
                for (int m = 0; m < 2; ++m) af[m] = *(const bf16x8*)(sH + (wave * 32 + m * 16 + (lane & 15)) * 136 + ks * 32 + (lane >> 4) * 8);
#pragma unroll
                for (int n = 0; n < 4; ++n) bfr[n] = *(const bf16x8*)(W2 + (n * 16 + (lane & 15)) * 128 + ks * 32 + (lane >> 4) * 8);
#pragma unroll
                for (int m = 0; m < 2; ++m)
#pragma unroll
                    for (int n = 0; n < 4; ++n) a2[m][n] = __builtin_amdgcn_mfma_f32_16x16x32_bf16(af[m], bfr[n], a2[m][n], 0, 0, 0);
            }
            bf16_t* dst = (bf16_t*)(ws + (kv ? WS_VCMP : WS_KCMP)) + (size_t)bg * 256 * 64;
#pragma unroll
            for (int m = 0; m < 2; ++m)
#pragma unroll
                for (int n = 0; n < 4; ++n)
#pragma unroll
                    for (int j = 0; j < 4; ++j) {
                        const int row = mt * 128 + wave * 32 + m * 16 + (lane >> 4) * 4 + j, col = n * 16 + (lane & 15);
                        dst[kv ? vp_off(row, col) : kp_off(row, col)] = row < 255 ? f2bf(a2[m][n][j]) : (bf16_t)0;
                    }
            __syncthreads();
        } else {
            const int it2 = it - 64, g = it2 >> 3, b = it2 & 7;
            bf16_t* aext = (bf16_t*)(ws + XP_AEXT) + ((size_t)g * 1024 + b * 128) * 640;
            float* sE = (float*)smem;
            auto rowptr = [=](int r) { return (const bf16_t*)aext + (size_t)r * 640; };
            auto epi = [=](f32x4 (&acc)[4][4], int wr, int wc, int ln) {
                const int fr = ln & 15, fq = ln >> 4;
#pragma unroll
                for (int m = 0; m < 4; ++m)
#pragma unroll
                    for (int n = 0; n < 4; ++n)
#pragma unroll
                        for (int j = 0; j < 4; ++j) sE[(wr * 64 + m * 16 + fr) * 129 + wc * 64 + n * 16 + fq * 4 + j] = acc[m][n][j];
            };
            gemm128<true, false>(rowptr, (const bf16_t*)(ws + WS_BTE) + (size_t)g * 128 * 512, 512, 512, smem, epi);
            __syncthreads();
            {
                const int p = tid & 63, c0 = wave * 32;
                const float ar = ((const float*)(ws + WS_S5AL))[(g * 64 + p) * 2], ai = ((const float*)(ws + WS_S5AL))[(g * 64 + p) * 2 + 1];
                float* send = (float*)(smem + 128 * 129 * 4);
                float xr = 0.f, xi = 0.f;
                for (int c = c0; c < c0 + 32; ++c) {
                    const float er = sE[c * 129 + p], ei = sE[c * 129 + 64 + p];
                    const float nr = ar * xr - ai * xi + er, ni = ar * xi + ai * xr + ei;
                    xr = nr; xi = ni;
                }
                send[(wave * 64 + p) * 2] = xr; send[(wave * 64 + p) * 2 + 1] = xi;
                float qr = ar, qi = ai;
#pragma unroll
                for (int k = 0; k < 5; ++k) { const float tr = qr * qr - qi * qi, ti = 2.f * qr * qi; qr = tr; qi = ti; }
                __syncthreads();
                xr = 0.f; xi = 0.f;
                for (int k = 0; k < wave; ++k) {
                    const float er = send[(k * 64 + p) * 2], ei = send[(k * 64 + p) * 2 + 1];
                    const float nr = qr * xr - qi * xi + er, ni = qr * xi + qi * xr + ei;
                    xr = nr; xi = ni;
                }
                for (int c = c0; c < c0 + 32; ++c) {
                    aext[(size_t)c * 640 + 512 + p] = f2bf(xr);
                    aext[(size_t)c * 640 + 576 + p] = f2bf(xi);
                    const float er = sE[c * 129 + p], ei = sE[c * 129 + 64 + p];
                    const float nr = ar * xr - ai * xi + er, ni = ar * xi + ai * xr + ei;
                    xr = nr; xi = ni;
                }
            }
            asm volatile("s_waitcnt vmcnt(0)" ::: "memory");
            __syncthreads();
#pragma unroll 1
            for (int nt = 0; nt < 4; ++nt) s5y_tile(P, smem, g, b, nt);
        }
    }
}

DI void s5y_tile(const Params& P, unsigned char* smem, int g, int mt, int nt) {
    unsigned char* ws = P.ws;
    const bf16_t* aext = (const bf16_t*)(ws + XP_AEXT) + (size_t)g * 1024 * 640;
    const float* dsk = P.in[15];
    auto rowptr = [=](int r) { return aext + (size_t)(mt * 128 + r) * 640; };
    auto epi = [=](f32x4 (&acc)[4][4], int wr, int wc, int ln) {
        const int fr = ln & 15, fq = ln >> 4;
        const f32x4 dk = *(const f32x4*)(dsk + g * 16 + fq * 4);
#pragma unroll
        for (int m = 0; m < 4; ++m) {
            const int cr = mt * 128 + wr * 64 + m * 16 + fr;
#pragma unroll
            for (int n = 0; n < 4; ++n) {
                const int sp = nt * 8 + wc * 4 + n, t = cr * 32 + sp;
                const f32x4 u = bf4_to_f(*(const u32x2*)(aext + (size_t)cr * 640 + sp * 16 + fq * 4));
                const f32x4 y = acc[m][n] + dk * u;
                *(u32x2*)((bf16_t*)(ws + XP_G5) + (size_t)t * 512 + g * 16 + fq * 4) = cvt4((f32x4){gelu_tanh(y.x), gelu_tanh(y.y), gelu_tanh(y.z), gelu_tanh(y.w)});
            }
        }
    };
    gemm128<true, false>(rowptr, (const bf16_t*)(ws + WS_BTY) + ((size_t)g * 512 + nt * 128) * 640, 640, 640, smem, epi, 2 * nt + 2, 8);
}
struct FA { f32x16 o0, o1; float m, l; };
DI void fa_init(FA& st) {
#pragma unroll
    for (int i = 0; i < 16; ++i) { st.o0[i] = 0.f; st.o1[i] = 0.f; }
    st.m = -1e30f; st.l = 0.f;
}
constexpr float FA_THR = 8.f;
template <int MODE, class Valid>
DI void fa_tile(FA& st, const bf16x8 (&qf)[4], const LAS bf16_t* Kt, const LAS bf16_t* Vt, int r, int h, float c, bool rowok, Valid valid) {
    const LAS bf16_t* kb = Kt + r * 16 + 8 * h;
    const LAS bf16_t* vb = Vt + r * 16 + 8 * h;
    bf16x8 kf[4], vf[4];
#pragma unroll
    for (int ks = 0; ks < 4; ++ks) kf[ks] = *(const LAS bf16x8*)(kb + ks * 512);
#pragma unroll
    for (int sub = 0; sub < 2; ++sub) {
        f32x16 acc;
#pragma unroll
        for (int i = 0; i < 16; ++i) acc[i] = 0.f;
#pragma unroll
        for (int ks = 0; ks < 4; ++ks) acc = MFMA32(kf[ks], qf[ks], acc);
#pragma unroll
        for (int s2 = 0; s2 < 2; ++s2) { vf[2 * s2] = *(const LAS bf16x8*)(vb + ((sub * 2 + s2) * 64) * 16); vf[2 * s2 + 1] = *(const LAS bf16x8*)(vb + ((sub * 2 + s2) * 64 + 32) * 16); }
        if (sub == 0) {
#pragma unroll
            for (int ks = 0; ks < 4; ++ks) kf[ks] = *(const LAS bf16x8*)(kb + (4 + ks) * 512);
        }
        __builtin_amdgcn_sched_barrier(0);
        float mx = -INFINITY;
#pragma unroll
        for (int i = 0; i < 16; ++i) {
            if (MODE == 2) { const int koff = sub * 32 + (i & 3) + 8 * (i >> 2) + 4 * h; acc[i] = valid(koff) ? acc[i] : -INFINITY; }
            mx = fmaxf(mx, acc[i]);
        }
        {
            const auto sw = __builtin_amdgcn_permlane32_swap(__float_as_uint(mx), __float_as_uint(mx), false, false);
            mx = fmaxf(__uint_as_float(sw[0]), __uint_as_float(sw[1]));
        }
        const float cand = mx * c;
        const bool upd = cand > st.m + FA_THR;
        if (__ballot(upd)) {
            const float mn = upd ? cand : st.m, alpha = __builtin_amdgcn_exp2f(st.m - mn);
            st.m = mn; st.l *= alpha;
#pragma unroll
            for (int i = 0; i < 16; ++i) { st.o0[i] *= alpha; st.o1[i] *= alpha; }
        }
        const float nb = (MODE == 1 && !rowok) ? -INFINITY : -st.m;
        float ps0 = 0.f, ps1 = 0.f;
#pragma unroll
        for (int i = 0; i < 16; i += 2) {
            acc[i] = __builtin_amdgcn_exp2f(__builtin_fmaf(acc[i], c, nb));
            acc[i + 1] = __builtin_amdgcn_exp2f(__builtin_fmaf(acc[i + 1], c, nb));
            ps0 += acc[i]; ps1 += acc[i + 1];
        }
        st.l += ps0 + ps1;
#pragma unroll
        for (int s2 = 0; s2 < 2; ++s2) {
            const bf16x8 pk = cvt8((f32x8){acc[8 * s2], acc[8 * s2 + 1], acc[8 * s2 + 2], acc[8 * s2 + 3], acc[8 * s2 + 4], acc[8 * s2 + 5], acc[8 * s2 + 6], acc[8 * s2 + 7]});
            st.o0 = MFMA32(vf[2 * s2], pk, st.o0);
            st.o1 = MFMA32(vf[2 * s2 + 1], pk, st.o1);
        }
    }
}
DI void fa_issue(const bf16_t* gK, const bf16_t* gV, LAS unsigned char* buf, int tid) {
    __builtin_amdgcn_global_load_lds((const unsigned*)(gK + tid * 8), (LAS unsigned*)(buf + tid * 16), 16, 0, 0);
    __builtin_amdgcn_global_load_lds((const unsigned*)(gK + (tid + 256) * 8), (LAS unsigned*)(buf + (tid + 256) * 16), 16, 0, 0);
    __builtin_amdgcn_global_load_lds((const unsigned*)(gV + tid * 8), (LAS unsigned*)(buf + 8192 + tid * 16), 16, 0, 0);
    __builtin_amdgcn_global_load_lds((const unsigned*)(gV + (tid + 256) * 8), (LAS unsigned*)(buf + 8192 + (tid + 256) * 16), 16, 0, 0);
}
DI void fa_wait(int j, int n) {
    const int rem = n - 1 - j;
    if (rem >= 2) asm volatile("s_waitcnt vmcnt(8)" ::: "memory");
    else if (rem == 1) asm volatile("s_waitcnt vmcnt(4)" ::: "memory");
    else asm volatile("s_waitcnt vmcnt(0)" ::: "memory");
    __builtin_amdgcn_s_barrier();
    asm volatile("" ::: "memory");
}

constexpr int NSA_LDS_IMP = 65536;
constexpr int NSA_LDS_SCS = NSA_LDS_IMP + 8192;
constexpr int NSA_LDS_MSK = NSA_LDS_SCS + 1024;
DI void phase_nsa(const Params& P, unsigned char* smem) {
    unsigned char* ws = P.ws;
    const int tid = threadIdx.x, lane = tid & 63, wave = tid >> 6, r = lane & 31, h = lane >> 5;
    const float c = 0.125f * 1.4426950408889634f;
    LAS unsigned char* lds = (LAS unsigned char*)smem;
    float* impw = (float*)(smem + NSA_LDS_IMP) + wave * 512;
    float* scs = (float*)(smem + NSA_LDS_SCS) + wave * 64;
    unsigned long long* mskw = (unsigned long long*)(smem + NSA_LDS_MSK) + wave * 8;
    for (int it = blockIdx.x; it < 2048; it += gridDim.x) {
        const int qt = 127 - (it >> 4), bg = it & 15, b = bg >> 1, g = bg & 1, t0 = qt * 32, qblk = t0 >> 6;
        const int ql = r >> 2, z = r & 3, s = t0 + wave * 8 + ql, t = b * 4096 + s;
        const bf16_t* Qg = (const bf16_t*)(ws + XP_Q0) + (size_t)t * 512 + (g * 4 + z) * 64;
        bf16x8 qf[4];
#pragma unroll
        for (int ks = 0; ks < 4; ++ks) qf[ks] = *(const bf16x8*)(Qg + ks * 16 + 8 * h);
        const float* gt = (const float*)(ws + XP_GATES) + (size_t)t * 24 + (g * 4 + z) * 3;
        const float g_c = gt[0], g_s = gt[1], g_w = gt[2];
        const bf16_t* Kc = (const bf16_t*)(ws + WS_KCMP) + (size_t)bg * 256 * 64;
        const bf16_t* Vc = (const bf16_t*)(ws + WS_VCMP) + (size_t)bg * 256 * 64;
        const bf16_t* Ks = (const bf16_t*)(ws + XP_KC + 2 * KVSZ) + (size_t)bg * 4096 * 64;
        const bf16_t* Vs = (const bf16_t*)(ws + XP_KC + 3 * KVSZ) + (size_t)bg * 4096 * 64;
        const bf16_t* Kw = (const bf16_t*)(ws + XP_KC + 4 * KVSZ) + (size_t)bg * 4096 * 64;
        const bf16_t* Vw = (const bf16_t*)(ws + XP_KC + 5 * KVSZ) + (size_t)bg * 4096 * 64;
        const int nct = ((t0 >> 4) + 1 + 63) >> 6;
        const int w0 = (t0 - 255) < 0 ? 0 : (t0 - 255) >> 6;
        const int e1 = nct, e2 = 2 * nct, e3 = e2 + qblk + 1, e4 = e3 + (qblk - w0 + 1);
        const int nc = s >= 31 ? ((s - 31) >> 4) + 1 : 0;
        const int s_lo = t0 + wave * 8, s_hi = s_lo + 7, nc_min = s_lo >= 31 ? ((s_lo - 31) >> 4) + 1 : 0;
        for (int i = lane; i < 512; i += 64) impw[i] = 0.f;
        auto tile_ptrs = [&](int i, const bf16_t*& gk, const bf16_t*& gv) {
            if (i < e1) { gk = Kc + (size_t)i * 4096; gv = Vc + (size_t)i * 4096; }
            else if (i < e2) { gk = Kc + (size_t)(i - e1) * 4096; gv = Vc + (size_t)(i - e1) * 4096; }
            else if (i < e3) { gk = Ks + (size_t)(i - e2) * 4096; gv = Vs + (size_t)(i - e2) * 4096; }
            else { gk = Kw + (size_t)(w0 + i - e3) * 4096; gv = Vw + (size_t)(w0 + i - e3) * 4096; }
        };
        FA st; fa_init(st);
        f32x16 out0, out1;
#pragma unroll
        for (int i = 0; i < 16; ++i) { out0[i] = 0.f; out1[i] = 0.f; }
        float m_c = -1e30f, il_c = 0.f;
        unsigned long long mymask = 0ull;
        asm volatile("s_waitcnt vmcnt(0)" ::: "memory");
        __builtin_amdgcn_s_barrier();
#pragma unroll
        for (int i = 0; i < 3; ++i) if (i < e4) { const bf16_t *gk, *gv; tile_ptrs(i, gk, gv); fa_issue(gk, gv, lds + i * 16384, tid); }
        auto step = [&](int i) -> const LAS bf16_t* {
            fa_wait(i, e4);
            if (i + 3 < e4) { const bf16_t *gk, *gv; tile_ptrs(i + 3, gk, gv); fa_issue(gk, gv, lds + ((i + 3) & 3) * 16384, tid); }
            return (const LAS bf16_t*)(lds + (i & 3) * 16384);
        };
        int i = 0;
        for (; i < e1; ++i) {
            const LAS bf16_t* cur = step(i);
            const int nb = i * 64;
            if (nb + 63 < nc_min) fa_tile<0>(st, qf, cur, cur + 4096, r, h, c, true, [=](int) { return true; }); else fa_tile<2>(st, qf, cur, cur + 4096, r, h, c, true, [=](int koff) { return nb + koff < nc; });
        }
        {
            const float l = st.l + __shfl_xor(st.l, 32);
            il_c = 1.f / fmaxf(l, 1e-30f); m_c = st.m;
            const float f = g_c * il_c;
#pragma unroll
            for (int k = 0; k < 16; ++k) { out0[k] = st.o0[k] * f; out1[k] = st.o1[k] * f; }
            fa_init(st);
        }
        for (; i < e2; ++i) {
            const LAS bf16_t* cur = step(i);
            const int nb = (i - e1) * 64;
#pragma unroll
            for (int sub = 0; sub < 2; ++sub) {
                f32x16 acc;
#pragma unroll
                for (int k = 0; k < 16; ++k) acc[k] = 0.f;
#pragma unroll
                for (int ks = 0; ks < 4; ++ks) acc = MFMA32(*(const LAS bf16x8*)(cur + ((sub * 4 + ks) * 32 + r) * 16 + 8 * h), qf[ks], acc);
#pragma unroll
                for (int q4 = 0; q4 < 4; ++q4) {
                    float p[4];
#pragma unroll
                    for (int k = 0; k < 4; ++k) {
                        const int n = nb + sub * 32 + 8 * q4 + 4 * h + k;
                        p[k] = (n < nc) ? __builtin_amdgcn_exp2f(acc[4 * q4 + k] * c - m_c) * il_c : 0.f;
                    }
                    float a = (p[0] + p[1]) + (p[2] + 0.5f * p[3]), cn = 0.5f * p[3];
                    a += __shfl_xor(a, 1); a += __shfl_xor(a, 2);
                    cn += __shfl_xor(cn, 1); cn += __shfl_xor(cn, 2);
                    const int jb = ((nb + sub * 32) >> 2) + 2 * q4 + h;
                    if (z == 0) { atomicAdd(&impw[ql * 64 + jb], a); if (jb + 1 < 64) atomicAdd(&impw[ql * 64 + jb + 1], cn); }
                }
            }
        }
        {
            __builtin_amdgcn_wave_barrier();
#pragma unroll 1
            for (int qq = 0; qq < 8; ++qq) {
                const int j = lane;
                const float imp = impw[qq * 64 + j];
                const float score = (j > qblk) ? -1.f : ((j == 0 || j == qblk || j == qblk - 1) ? 1e3f : imp);
                scs[j] = score;
                __builtin_amdgcn_wave_barrier();
                int rank = 0;
#pragma unroll 8
                for (int jj = 0; jj < 64; ++jj) { const float o = scs[jj]; rank += (o > score || (o == score && jj < j)) ? 1 : 0; }
                const unsigned long long mk = __ballot(rank < 8 && score >= 0.f);
                if (lane == 0) mskw[qq] = mk;
                __builtin_amdgcn_wave_barrier();
            }
            mymask = mskw[ql];
        }
        for (; i < e3 - 1; ++i) {
            const LAS bf16_t* cur = step(i);
            const bool sel = (mymask >> (i - e2)) & 1ull;
            if (__ballot(sel)) fa_tile<1>(st, qf, cur, cur + 4096, r, h, c, sel, [=](int) { return true; });
        }
        {
            const LAS bf16_t* cur = step(i);
            const int kb = qblk * 64;
            fa_tile<2>(st, qf, cur, cur + 4096, r, h, c, true, [=](int koff) { return kb + koff <= s; });
            ++i;
            const float l = st.l + __shfl_xor(st.l, 32);
            const float f = g_s / fmaxf(l, 1e-30f);
#pragma unroll
            for (int k = 0; k < 16; ++k) { out0[k] += st.o0[k] * f; out1[k] += st.o1[k] * f; }
            fa_init(st);
        }
        for (; i < e4; ++i) {
            const LAS bf16_t* cur = step(i);
            const int kb = (w0 + i - e3) * 64;
            if (kb >= s_hi - 255 && kb + 63 <= s_lo) fa_tile<0>(st, qf, cur, cur + 4096, r, h, c, true, [=](int) { return true; }); else fa_tile<2>(st, qf, cur, cur + 4096, r, h, c, true, [=](int koff) { const int key = kb + koff; return key <= s && key >= s - 255; });
        }
        {
            const float l = st.l + __shfl_xor(st.l, 32);
            const float f = g_w / fmaxf(l, 1e-30f);
#pragma unroll
            for (int k = 0; k < 16; ++k) { out0[k] += st.o0[k] * f; out1[k] += st.o1[k] * f; }
        }
        nat_store((bf16_t*)(ws + WS_MIX) + (size_t)t * 1024 + (g * 4 + z) * 64, h, out0, out1, 1.f);
    }
}

DI void phase_glu(const Params& P, unsigned char* smem) {
    unsigned char* ws = P.ws;
    const bf16_t* G5 = (const bf16_t*)(ws + XP_G5);
    const float* gb = P.in[17];
    bool pre = false;
    for (int it = vblock(); it < (NT / 128) * 4; it += gridDim.x) {
        int mt, nt; tile_mn(it, 4, mt, nt);
        const int m0 = mt * 128;
        const bool hn = it + (int)gridDim.x < (NT / 128) * 4;
        int mtn = 0, ntn = 0; if (hn) tile_mn(it + gridDim.x, 4, mtn, ntn);
        auto nextrow = [=](int r) { return G5 + (size_t)(mtn * 128 + r) * 512; };
        auto rowptr = [=](int r) { return G5 + (size_t)(m0 + r) * 512; };
        auto epi = [=](f32x4 (&acc)[4][4], int wr, int wc, int ln) {
            const int fr = ln & 15, fq = ln >> 4;
#pragma unroll
            for (int m = 0; m < 4; ++m) {
                const int row = m0 + wr * 64 + m * 16 + fr;
#pragma unroll
                for (int q = 0; q < 2; ++q) {
                    const int col = nt * 128 + wc * 64 + q * 32 + fq * 8;
                    const u32x4 gw = *(const u32x4*)(G5 + (size_t)row * 512 + col);
                    f32x4 o[2];
#pragma unroll
                    for (int e = 0; e < 2; ++e) {
                        const f32x4 gv = bf4_to_f(e == 0 ? (u32x2){gw.x, gw.y} : (u32x2){gw.z, gw.w}), bb = *(const f32x4*)(gb + col + 4 * e), z = acc[m][2 * q + e] + bb;
                        o[e] = (f32x4){gv.x * sigmoidf_(z.x), gv.y * sigmoidf_(z.y), gv.z * sigmoidf_(z.z), gv.w * sigmoidf_(z.w)};
                    }
                    *(u32x4*)((bf16_t*)(ws + WS_MIX) + (size_t)row * 1024 + 512 + col) = cvt44(o[0], o[1]);
                }
            }
        };
        gemm128s(rowptr, (const bf16_t*)(ws + WS_WGLU) + (size_t)nt * 128 * 512, 512, 512, smem, epi, pre, hn, nextrow, (const bf16_t*)(ws + WS_WGLU) + (size_t)ntn * 128 * 512);
        pre = hn;
    }
}

template <bool RB>
DI void phase_outproj(const Params& P, unsigned char* smem, const float* xres, const bf16_t* xresb, size_t wt_off) {
    unsigned char* ws = P.ws;
    const bf16_t* A = (const bf16_t*)(ws + WS_MIX);
    bf16_t* preb = (bf16_t*)(ws + XP_PRE);
    bool pre = false;
    for (int it = vblock(); it < (NT / 128) * 8; it += gridDim.x) {
        int mt, nt; tile_mn(it, 8, mt, nt);
        const int m0 = mt * 128;
        const bool hn = it + (int)gridDim.x < (NT / 128) * 8;
        int mtn = 0, ntn = 0; if (hn) tile_mn(it + gridDim.x, 8, mtn, ntn);
        auto nextrow = [=](int r) { return A + (size_t)(mtn * 128 + r) * 1024; };
        auto rowptr = [=](int r) { return A + (size_t)(m0 + r) * 1024; };
        auto epi = [=](f32x4 (&acc)[4][4], int wr, int wc, int ln) {
            const int fr = ln & 15, fq = ln >> 4;
#pragma unroll
            for (int m = 0; m < 4; ++m) {
                const size_t base = (size_t)(m0 + wr * 64 + m * 16 + fr) * 1024 + nt * 128 + wc * 64 + fq * 8;
                f32x4 xr[4];
#pragma unroll
                for (int q = 0; q < 2; ++q) {
                    if (RB) { const u32x4 w = *(const u32x4*)(xresb + base + q * 32); xr[2 * q] = bf4_to_f((u32x2){w.x, w.y}); xr[2 * q + 1] = bf4_to_f((u32x2){w.z, w.w}); }
                    else { xr[2 * q] = *(const f32x4*)(xres + base + q * 32); xr[2 * q + 1] = *(const f32x4*)(xres + base + q * 32 + 4); }
                }
#pragma unroll
                for (int q = 0; q < 2; ++q) *(u32x4*)(preb + base + q * 32) = cvt44(xr[2 * q] * ALPHA + acc[m][2 * q], xr[2 * q + 1] * ALPHA + acc[m][2 * q + 1]);
            }
        };
        gemm128s(rowptr, (const bf16_t*)(ws + wt_off) + (size_t)nt * 128 * 1024, 1024, 1024, smem, epi, pre, hn, nextrow, (const bf16_t*)(ws + wt_off) + (size_t)ntn * 128 * 1024);
        pre = hn;
    }
}

DI void ln_row(float (&v)[16], const float* __restrict__ g, const float* __restrict__ bta, int lane) {
    float s = 0.f;
#pragma unroll
    for (int i = 0; i < 16; ++i) s += v[i];
    const float mu = wave_sum(s) * (1.f / 1024.f);
    float q = 0.f;
#pragma unroll
    for (int i = 0; i < 16; ++i) { v[i] -= mu; q += v[i] * v[i]; }
    const float rstd = rsqrtf(wave_sum(q) * (1.f / 1024.f) + LN_EPS);
#pragma unroll
    for (int j = 0; j < 4; ++j) {
        const float4 gg = *(const float4*)(g + 4 * lane + 256 * j), bb = *(const float4*)(bta + 4 * lane + 256 * j);
        v[4 * j + 0] = v[4 * j + 0] * rstd * gg.x + bb.x; v[4 * j + 1] = v[4 * j + 1] * rstd * gg.y + bb.y;
        v[4 * j + 2] = v[4 * j + 2] * rstd * gg.z + bb.z; v[4 * j + 3] = v[4 * j + 3] * rstd * gg.w + bb.w;
    }
}

DI void phase_ln_router(const Params& P, int layer) {
    unsigned char* ws = P.ws;
    const int lane = threadIdx.x & 63, wave = threadIdx.x >> 6;
    const float* g = P.in[21] + layer * 1024; const float* bta = P.in[22] + layer * 1024;
    const float* wc = (const float*)(ws + WS_RTRW) + (size_t)layer * 36864; const float* bc = P.in[26] + layer * 4;
    const float* wf = wc + 4096; const float* bfn = P.in[28] + layer * 32;
    int* cnt = (int*)(ws + WS_CTL) + layer * 2048;
    int* list = (int*)(ws + WS_LIST2);
    float* wgt = (float*)(ws + WS_WGT);
    bf16_t* xb = (bf16_t*)(ws + WS_ACTB);
    for (int task = blockIdx.x * 4 + wave; task < NT / 16; task += gridDim.x * 4) {
        int my_e = 0; float my_w = 0.f;
        f32x4 wcr[16];
#pragma unroll
        for (int q = 0; q < 16; ++q) wcr[q] = *(const f32x4*)(wc + (q * 64 + lane) * 4);
        const bf16_t* pre = (const bf16_t*)(ws + XP_PRE);
        u32x2 nxb[4];
#pragma unroll
        for (int j = 0; j < 4; ++j) nxb[j] = __builtin_nontemporal_load((const u32x2*)(pre + (size_t)(task * 16) * 1024 + 4 * lane + 256 * j));
#pragma unroll 1
        for (int i = 0; i < 16; ++i) {
            const int t = task * 16 + i;
            float v[16];
#pragma unroll
            for (int j = 0; j < 4; ++j) { const f32x4 nx = bf4_to_f(nxb[j]); v[4 * j] = nx.x; v[4 * j + 1] = nx.y; v[4 * j + 2] = nx.z; v[4 * j + 3] = nx.w; }
            if (i + 1 < 16) {
#pragma unroll
                for (int j = 0; j < 4; ++j) nxb[j] = __builtin_nontemporal_load((const u32x2*)(pre + (size_t)(t + 1) * 1024 + 4 * lane + 256 * j));
            }
            ln_row(v, g, bta, lane);
#pragma unroll
            for (int j = 0; j < 4; ++j) {
                *(u32x2*)(xb + (size_t)t * 1024 + 4 * lane + 256 * j) = cvt4((f32x4){v[4 * j], v[4 * j + 1], v[4 * j + 2], v[4 * j + 3]});
            }
            float lc[4] = {0.f, 0.f, 0.f, 0.f};
#pragma unroll
            for (int j = 0; j < 4; ++j)
#pragma unroll
                for (int k = 0; k < 4; ++k) {
                    const f32x4 w = wcr[j * 4 + k];
                    const float x = v[4 * j + k];
                    lc[0] += x * w.x; lc[1] += x * w.y; lc[2] += x * w.z; lc[3] += x * w.w;
                }
#pragma unroll
            for (int c = 0; c < 4; ++c) lc[c] = wave_sum(lc[c]) + bc[c];
            int gi = 0; float lm = lc[0];
#pragma unroll
            for (int c = 1; c < 4; ++c) if (lc[c] > lm) { lm = lc[c]; gi = c; }
            gi = __builtin_amdgcn_readfirstlane(gi);
            float den = 0.f;
#pragma unroll
            for (int c = 0; c < 4; ++c) den += expf(lc[c] - lm);
            const float gv = 1.f / den;
            float lf[8] = {0.f, 0.f, 0.f, 0.f, 0.f, 0.f, 0.f, 0.f};
            const float* wfg = wf + (size_t)gi * 8192;
#pragma unroll
            for (int j = 0; j < 4; ++j)
#pragma unroll
                for (int k = 0; k < 4; ++k) {
                    const f32x4 w0 = *(const f32x4*)(wfg + (((j * 4 + k) * 2 + 0) * 64 + lane) * 4), w1 = *(const f32x4*)(wfg + (((j * 4 + k) * 2 + 1) * 64 + lane) * 4);
                    const float x = v[4 * j + k];
                    lf[0] += x * w0.x; lf[1] += x * w0.y; lf[2] += x * w0.z; lf[3] += x * w0.w;
                    lf[4] += x * w1.x; lf[5] += x * w1.y; lf[6] += x * w1.z; lf[7] += x * w1.w;
                }
#pragma unroll
            for (int e = 0; e < 8; ++e) lf[e] = wave_sum(lf[e]) + bfn[gi * 8 + e];
            int e1 = 0; float l1 = lf[0];
#pragma unroll
            for (int e = 1; e < 8; ++e) if (lf[e] > l1) { l1 = lf[e]; e1 = e; }
            int e2 = 0; float l2 = -INFINITY;
#pragma unroll
            for (int e = 0; e < 8; ++e) if (e != e1 && lf[e] > l2) { l2 = lf[e]; e2 = e; }
            const float r = expf(l2 - l1);
            if (lane == i) { my_e = gi * 8 + e1; my_w = gv / (1.f + r); }
            if (lane == 16 + i) { my_e = gi * 8 + e2; my_w = gv * r / (1.f + r); }
        }
        if (lane < 32) {
            const int t = task * 16 + (lane & 15), k = lane >> 4, slot = (task & 63) * 32 + my_e;
            const int pos = atomicAdd(&cnt[slot], 1);
            list[(slot << 10) + pos] = t * 2 + k;
            wgt[t * 2 + k] = my_w;
        }
    }
}

constexpr int MOE_LDS_TAB = 65536;
constexpr int MOE_LDS_ROW = 65536 + 8448;
DI void moe_tables(const int* cnt, unsigned char* smem) {
    int* tab = (int*)(smem + MOE_LDS_TAB);
    if (threadIdx.x < 32) { const int e = threadIdx.x; int run = 0; for (int s = 0; s < 64; ++s) { tab[e * 65 + s] = run; run += cnt[s * 32 + e]; } tab[e * 65 + 64] = run; }
    __syncthreads();
}
DI bool moe_tile(const int* tab, int tile, int& e, int& mt, int& off, int& ce) {
    int acc_t = 0, acc_r = 0;
    for (int i = 0; i < 32; ++i) {
        const int c = tab[i * 65 + 64], nt = (c + 127) >> 7;
        if (tile < acc_t + nt) { e = i; mt = tile - acc_t; off = acc_r; ce = c; return true; }
        acc_t += nt; acc_r += c;
    }
    return false;
}
DI int moe_ntiles(const int* tab) { int a = 0; for (int i = 0; i < 32; ++i) a += (tab[i * 65 + 64] + 127) >> 7; return a; }
DI void moe_rows(const int* tab, const int* list, int e, int mt, int ce, int* rowidx) {
    if (threadIdx.x < 128) {
        const int pos = mt * 128 + threadIdx.x;
        int idx = -1;
        if (pos < ce) {
            int lo = 0, hi = 64;
            while (hi - lo > 1) { const int mid = (lo + hi) >> 1; if (tab[e * 65 + mid] <= pos) lo = mid; else hi = mid; }
            idx = list[((lo * 32 + e) << 10) + pos - tab[e * 65 + lo]];
        }
        rowidx[threadIdx.x] = idx;
    }
    __syncthreads();
}

DI void phase_moe_gu(const Params& P, unsigned char* smem, int layer) {
    unsigned char* ws = P.ws;
    const int* cnt = (const int*)(ws + WS_CTL) + layer * 2048;
    const int* list = (const int*)(ws + WS_LIST2);
    const float* wgt = (const float*)(ws + WS_WGT);
    const bf16_t* xb = (const bf16_t*)(ws + WS_ACTB);
    bf16_t* H = (bf16_t*)(ws + XP_H);
    const int* tab = (const int*)(smem + MOE_LDS_TAB);
    int* rowidx = (int*)(smem + MOE_LDS_ROW);
    moe_tables(cnt, smem);
    const int ntile = moe_ntiles(tab);
    for (int it = vblock(); it < ntile * 2; it += gridDim.x) {
        int e, mt, off, ce; moe_tile(tab, it >> 1, e, mt, off, ce);
        const int nt = it & 1;
        moe_rows(tab, list, e, mt, ce, rowidx);
        auto rowptr = [=](int r) { int idx = rowidx[r]; idx = idx < 0 ? rowidx[0] : idx; return xb + (size_t)(idx >> 1) * 1024; };
        auto epi = [=](f32x4 (&acc)[4][4], int wr, int wc, int ln) {
            const int fr = ln & 15, fq = ln >> 4;
#pragma unroll
            for (int m = 0; m < 4; ++m) {
                const int rl = wr * 64 + m * 16 + fr, idx = rowidx[rl];
                if (idx >= 0) {
                    const float w = wgt[idx];
                    f32x4 hv[2];
#pragma unroll
                    for (int n = 0; n < 2; ++n) {
                        const f32x4 gte = acc[m][n], up = acc[m][n + 2];
                        hv[n] = (f32x4){gte.x * sigmoidf_(gte.x) * up.x * w, gte.y * sigmoidf_(gte.y) * up.y * w, gte.z * sigmoidf_(gte.z) * up.z * w, gte.w * sigmoidf_(gte.w) * up.w * w};
                    }
                    *(u32x4*)(H + (size_t)(off + mt * 128 + rl) * 128 + (nt * 2 + wc) * 32 + fq * 8) = cvt44(hv[0], hv[1]);
                }
            }
        };
        gemm128(rowptr, (const bf16_t*)(ws + WS_WGU) + ((size_t)(layer * 32 + e) * 256 + nt * 128) * 1024, 1024, 1024, smem, epi);
        __syncthreads();
    }
}
DI void phase_moe_down(const Params& P, unsigned char* smem, int layer) {
    unsigned char* ws = P.ws;
    const int* cnt = (const int*)(ws + WS_CTL) + layer * 2048;
    const int* list = (const int*)(ws + WS_LIST2);
    const bf16_t* H = (const bf16_t*)(ws + XP_H);
    bf16_t* YB = (bf16_t*)(ws + XP_YB);
    const int* tab = (const int*)(smem + MOE_LDS_TAB);
    int* rowidx = (int*)(smem + MOE_LDS_ROW);
    moe_tables(cnt, smem);
    const int ntile = moe_ntiles(tab);
    for (int it = vblock(); it < ntile * 8; it += gridDim.x) {
        int e, mt, off, ce; moe_tile(tab, it >> 3, e, mt, off, ce);
        const int nt = it & 7;
        moe_rows(tab, list, e, mt, ce, rowidx);
        auto rowptr = [=](int r) { int pos = mt * 128 + r; pos = pos < ce ? pos : 0; return H + (size_t)(off + pos) * 128; };
        auto epi = [=](f32x4 (&acc)[4][4], int wr, int wc, int ln) {
            const int fr = ln & 15, fq = ln >> 4;
#pragma unroll
            for (int m = 0; m < 4; ++m) {
                const int idx = rowidx[wr * 64 + m * 16 + fr];
                if (idx >= 0) {
                    bf16_t* dst = YB + (size_t)idx * 1024 + nt * 128 + wc * 64 + fq * 8;
#pragma unroll
                    for (int q = 0; q < 2; ++q) *(u32x4*)(dst + q * 32) = cvt44(acc[m][2 * q], acc[m][2 * q + 1]);
                }
            }
        };
        gemm128(rowptr, (const bf16_t*)(ws + WS_WDN) + ((size_t)(layer * 32 + e) * 1024 + nt * 128) * 128, 128, 128, smem, epi);
        __syncthreads();
    }
}
DI void phase_ln_ffn(const Params& P, int layer) {
    unsigned char* ws = P.ws;
    const int lane = threadIdx.x & 63, wave = threadIdx.x >> 6;
    const float* g = P.in[23] + layer * 1024; const float* bta = P.in[24] + layer * 1024;
    const bf16_t* YB = (const bf16_t*)(ws + XP_YB);
    bf16_t* xb = (bf16_t*)(ws + WS_ACTB);
    for (int task = blockIdx.x * 4 + wave; task < NT / 16; task += gridDim.x * 4) {
        u32x2 nxm[4], ny0[4], ny1[4];
        auto fetch = [&](int t) {
#pragma unroll
            for (int j = 0; j < 4; ++j) {
                nxm[j] = __builtin_nontemporal_load((const u32x2*)(xb + (size_t)t * 1024 + 4 * lane + 256 * j));
                ny0[j] = __builtin_nontemporal_load((const u32x2*)(YB + (size_t)(2 * t) * 1024 + 4 * lane + 256 * j));
                ny1[j] = __builtin_nontemporal_load((const u32x2*)(YB + (size_t)(2 * t + 1) * 1024 + 4 * lane + 256 * j));
            }
        };
        fetch(task * 16);
#pragma unroll 1
        for (int i = 0; i < 16; ++i) {
            const int t = task * 16 + i;
            float v[16];
#pragma unroll
            for (int j = 0; j < 4; ++j) {
                const f32x4 a = bf4_to_f(nxm[j]), y0 = bf4_to_f(ny0[j]), y1 = bf4_to_f(ny1[j]);
                v[4 * j + 0] = ALPHA * a.x + (y0.x + y1.x); v[4 * j + 1] = ALPHA * a.y + (y0.y + y1.y);
                v[4 * j + 2] = ALPHA * a.z + (y0.z + y1.z); v[4 * j + 3] = ALPHA * a.w + (y0.w + y1.w);
            }
            if (i + 1 < 16) fetch(t + 1);
            ln_row(v, g, bta, lane);
            float* row = P.out + (size_t)t * 1024;
#pragma unroll
            for (int j = 0; j < 4; ++j) {
                if (layer == 0) *(u32x2*)((bf16_t*)P.out + (size_t)t * 1024 + 4 * lane + 256 * j) = cvt4((f32x4){v[4 * j], v[4 * j + 1], v[4 * j + 2], v[4 * j + 3]});
                else *(f32x4*)(row + 4 * lane + 256 * j) = (f32x4){v[4 * j], v[4 * j + 1], v[4 * j + 2], v[4 * j + 3]};
            }
        }
    }
}

DI void phase_inproj1(const Params& P, unsigned char* smem) {
    unsigned char* ws = P.ws;
    const bf16_t* A = (const bf16_t*)P.out;
    const float* cosT = (const float*)(ws + WS_ROPE);
    const float* sinT = cosT + 4096 * 32;
    bool pre = false;
    for (int it = vblock(); it < (NT / 128) * 24; it += gridDim.x) {
        int mt, nt; tile_mn(it, 24, mt, nt);
        const int m0 = mt * 128;
        auto rowptr = [=](int r) { return A + (size_t)(m0 + r) * 1024; };
        const bf16_t* Bt = (const bf16_t*)(ws + WS_WIN1) + (size_t)nt * 128 * 1024;
        const bool hn = it + (int)gridDim.x < (NT / 128) * 24;
        int mtn = 0, ntn = 0; if (hn) tile_mn(it + gridDim.x, 24, mtn, ntn);
        auto nextrow = [=](int r) { return A + (size_t)(mtn * 128 + r) * 1024; };
        const bf16_t* nBt = (const bf16_t*)(ws + WS_WIN1) + (size_t)ntn * 128 * 1024;
        if (nt >= 16) {
            auto epi = [=](f32x4 (&acc)[4][4], int wr, int wc, int lane) {
                const int head = (nt * 2 + wc) & 15, fr = lane & 15, fq = lane >> 4;
#pragma unroll
                for (int m = 0; m < 4; ++m) {
                    const int t = m0 + wr * 64 + m * 16 + fq * 4, s = t & 4095, b = t >> 12;
                    bf16_t* base = (bf16_t*)(ws + XP_Q1 + (size_t)2 * 64 * MiB) + (size_t)(b * 16 + head) * 4096 * 64;
#pragma unroll
                    for (int n = 0; n < 4; ++n) *(u32x2*)(base + vp_off(s, n * 16 + fr)) = cvt4(acc[m][n]);
                }
            };
            gemm128s<false>(rowptr, Bt, 1024, 1024, smem, epi, pre, hn, nextrow, nBt);
            pre = hn;
            continue;
        }
        auto epi = [=](f32x4 (&acc)[4][4], int wr, int wc, int lane) {
            const int u64 = nt * 2 + wc, kind = u64 >> 4, head = u64 & 15, fr = lane & 15, fq = lane >> 4;
            f32x4 cs[2][2];
#pragma unroll
            for (int n2 = 0; n2 < 2; ++n2) { cs[n2][0] = (f32x4){0.f, 0.f, 0.f, 0.f}; cs[n2][1] = cs[n2][0]; }
#pragma unroll
            for (int m = 0; m < 4; ++m) {
                const int t = m0 + wr * 64 + m * 16 + fr, s = t & 4095, b = t >> 12;
                bf16_t* base = (bf16_t*)(ws + XP_Q1 + (size_t)kind * 64 * MiB) + (size_t)(b * 16 + head) * 4096 * 64;
                f32x4 r1[2], r2[2];
#pragma unroll
                for (int n2 = 0; n2 < 2; ++n2) {
                    const int i = 8 * fq + 4 * n2;
                    const f32x4 c = *(const f32x4*)(cosT + s * 32 + i), sn = *(const f32x4*)(sinT + s * 32 + i);
                    const f32x4 x1 = acc[m][2 * n2], x2 = acc[m][2 * n2 + 1];
                    r1[n2] = x1 * c - x2 * sn; r2[n2] = x1 * sn + x2 * c;
                    if (kind != 0) { cs[n2][0] += r1[n2]; cs[n2][1] += r2[n2]; }
                }
                const u32x4 o1 = cvt44(r1[0], r1[1]), o2 = cvt44(r2[0], r2[1]);
                if (kind == 0) { *(u32x4*)(base + (size_t)s * 64 + 8 * fq) = o1; *(u32x4*)(base + (size_t)s * 64 + 8 * fq + 32) = o2; }
                else { *(u32x4*)(base + kp_off(s, 8 * fq)) = o1; *(u32x4*)(base + kp_off(s, 8 * fq + 32)) = o2; }
            }
            if (kind == 1) {
                const int t0 = m0 + wr * 64, bh = (t0 >> 12) * 16 + head, seg = (t0 & 4095) >> 6;
                float* dst = (float*)(ws + WS_KMP) + ((size_t)bh * 64 + seg) * 64;
#pragma unroll
                for (int n2 = 0; n2 < 2; ++n2)
#pragma unroll
                    for (int hf = 0; hf < 2; ++hf) {
                        f32x4 v = cs[n2][hf];
#pragma unroll
                        for (int k = 0; k < 4; ++k) { float x = v[k]; x += dpp_f<0xB1>(x); x += dpp_f<0x4E>(x); x += dpp_f<0x141>(x); x += dpp_f<0x140>(x); v[k] = x; }
                        if (fr == 0) *(f32x4*)(dst + 8 * fq + 4 * n2 + hf * 32) = v;
                    }
            }
        };
        gemm128s(rowptr, Bt, 1024, 1024, smem, epi, pre, hn, nextrow, nBt);
        pre = hn;
    }
}
DI void moba_kmeans_slab(const Params& P, bf16_t* kml, int bh, int tid) {
    const float* kp = (const float*)(P.ws + WS_KMP) + (size_t)bh * 64 * 64;
    for (int e = tid; e < 2048; e += 256) {
        const int d = e & 63, n = e >> 6;
        float a = 0.f;
        if (n < 16) a = ((kp[(4 * n) * 64 + d] + kp[(4 * n + 1) * 64 + d]) + (kp[(4 * n + 2) * 64 + d] + kp[(4 * n + 3) * 64 + d])) * (1.f / 256.f);
        kml[((d >> 4) * 32 + n) * 16 + (d & 15)] = f2bf(a);
    }
}
DI unsigned moba_gate_rows(const bf16_t* km, const bf16x8 (&qf)[4], int own, int r, int h) {
    f32x16 g;
#pragma unroll
    for (int i = 0; i < 16; ++i) g[i] = 0.f;
#pragma unroll
    for (int ks = 0; ks < 4; ++ks) g = MFMA32(*(const bf16x8*)(km + (ks * 32 + r) * 16 + 8 * h), qf[ks], g);
    float mine[8], oth[8];
#pragma unroll
    for (int i = 0; i < 8; ++i) { const int n = (i & 3) + 8 * (i >> 2) + 4 * h; mine[i] = n < own ? g[i] : -INFINITY; oth[i] = __shfl_xor(mine[i], 32); }
    unsigned selmask = 0;
#pragma unroll
    for (int i = 0; i < 8; ++i) {
        const int n = (i & 3) + 8 * (i >> 2) + 4 * h;
        int rank = 0;
#pragma unroll
        for (int k = 0; k < 8; ++k) {
            const int nk = (k & 3) + 8 * (k >> 2) + 4 * h, no = (k & 3) + 8 * (k >> 2) + 4 * (1 - h);
            rank += (mine[k] > mine[i] || (mine[k] == mine[i] && nk < n)) ? 1 : 0;
            rank += (oth[k] > mine[i] || (oth[k] == mine[i] && no < n)) ? 1 : 0;
        }
        if (n < own && rank < 3) selmask |= 1u << n;
    }
    return selmask | __shfl_xor(selmask, 32);
}
DI void phase_moba_gate(const Params& P, unsigned char* smem) {
    unsigned char* ws = P.ws;
    const int tid = threadIdx.x, lane = tid & 63, wave = tid >> 6, r = lane & 31, h = lane >> 5;
    bf16_t* kml = (bf16_t*)smem;
    unsigned short* smask = (unsigned short*)(smem + 4096);
    unsigned short* selm = (unsigned short*)(ws + WS_SELM);
    unsigned short* mcnt = (unsigned short*)(ws + WS_MCNT);
    unsigned char* mlist = ws + WS_MLIST;
    int km_bh = -1;
    for (int it = blockIdx.x; it < 2048; it += gridDim.x) {
        const int bh = it & 127, qb = it >> 7;
        if (bh != km_bh) { km_bh = bh; __syncthreads(); moba_kmeans_slab(P, kml, bh, tid); }
        __syncthreads();
#pragma unroll 1
        for (int g2 = 0; g2 < 2; ++g2) {
            const int rl = wave * 64 + g2 * 32 + r, q = qb * 256 + rl;
            const bf16_t* Qg = (const bf16_t*)(ws + XP_Q1) + ((size_t)bh * 4096 + q) * 64;
            bf16x8 qf[4];
#pragma unroll
            for (int ks = 0; ks < 4; ++ks) qf[ks] = *(const bf16x8*)(Qg + ks * 16 + 8 * h);
            const unsigned sm = qb > 0 ? moba_gate_rows(kml, qf, qb, r, h) : 0u;
            if (h == 0) { selm[(size_t)bh * 4096 + q] = (unsigned short)sm; smask[rl] = (unsigned short)sm; }
        }
        __syncthreads();
        for (int n = wave; n < qb; n += 4) {
            unsigned char* lp = mlist + ((size_t)(bh * 16 + qb) * 16 + n) * 256;
            int base = 0;
#pragma unroll
            for (int c4 = 0; c4 < 4; ++c4) {
                const int row = c4 * 64 + lane;
                const bool bit = (smask[row] >> n) & 1;
                const unsigned long long bal = __ballot(bit);
                if (bit) lp[base + __builtin_popcountll(bal & ((1ull << lane) - 1ull))] = (unsigned char)row;
                base += __builtin_popcountll(bal);
            }
            if (lane == 0) mcnt[(bh * 16 + qb) * 16 + n] = (unsigned short)base;
        }
    }
}
DI bf16_t* moba_po(const Params& P, int slot) { return (bf16_t*)(P.ws + (slot == 0 ? WS_MIX : slot == 1 ? WS_ACTB : WS_PO2)); }
DI void phase_moba_kv(const Params& P, unsigned char* smem) {
    unsigned char* ws = P.ws;
    const int tid = threadIdx.x, lane = tid & 63, wave = tid >> 6, r = lane & 31, h = lane >> 5;
    const float c = 0.125f * 1.4426950408889634f;
    LAS unsigned char* lds = (LAS unsigned char*)smem;
    const unsigned short* selm = (const unsigned short*)(ws + WS_SELM);
    const unsigned short* mcnt = (const unsigned short*)(ws + WS_MCNT);
    const unsigned char* mlist = ws + WS_MLIST;
    float* pml = (float*)(ws + WS_PML);
    const bool bal = (gridDim.x == 512);
    const int nit = bal ? ((blockIdx.x >> 7) == 3 ? 3 : 4) : (1920 + (int)gridDim.x - 1 - (int)blockIdx.x) / (int)gridDim.x;
    for (int iti = 0; iti < nit; ++iti) {
        int bh, n;
        if (bal) { const int gq = blockIdx.x >> 7; bh = blockIdx.x & 127; const int tab = gq == 0 ? 0x0DA90 : gq == 1 ? 0x0CB61 : gq == 2 ? 0x0E852 : 0x00743; n = (tab >> (4 * iti)) & 15; }
        else { const int it = blockIdx.x + iti * gridDim.x; n = it >> 7; bh = it & 127; }
        const bf16_t* Kg = (const bf16_t*)(ws + XP_Q1 + 64 * MiB) + (size_t)bh * 4096 * 64 + (size_t)n * 4 * 4096;
        const bf16_t* Vg = (const bf16_t*)(ws + XP_Q1 + 128 * MiB) + (size_t)bh * 4096 * 64 + (size_t)n * 4 * 4096;
        asm volatile("s_waitcnt vmcnt(0)" ::: "memory");
        __builtin_amdgcn_s_barrier();
#pragma unroll
        for (int j = 0; j < 4; ++j) fa_issue(Kg + (size_t)j * 4096, Vg + (size_t)j * 4096, lds + j * 16384, tid);
        const int cntv = (lane < 16 && lane > n) ? (int)mcnt[(bh * 16 + lane) * 16 + n] : 0;
        asm volatile("s_waitcnt vmcnt(0)" ::: "memory");
        __builtin_amdgcn_s_barrier();
        asm volatile("" ::: "memory");
        int prefv = 0, total = 0;
#pragma unroll 1
        for (int qb = 0; qb < 16; ++qb) { if (lane == qb) prefv = total; total += __builtin_amdgcn_readlane(cntv, qb); }
#pragma unroll 1
        for (int v0 = wave * 32; v0 < total; v0 += 128) {
            const int v = v0 + r;
            const bool valid = v < total;
            const int vv = valid ? v : v0;
            int qb = n + 1;
#pragma unroll 1
            for (int l = n + 2; l < 16; ++l) if (vv >= __builtin_amdgcn_readlane(prefv, l)) qb = l;
            const int idx = vv - __shfl(prefv, qb);
            const int q = qb * 256 + (int)mlist[((size_t)(bh * 16 + qb) * 16 + n) * 256 + idx];
            const bf16_t* Qg = (const bf16_t*)(ws + XP_Q1) + ((size_t)bh * 4096 + q) * 64;
            bf16x8 qf[4];
#pragma unroll
            for (int ks = 0; ks < 4; ++ks) qf[ks] = *(const bf16x8*)(Qg + ks * 16 + 8 * h);
            FA st; fa_init(st);
#pragma unroll 1
            for (int j = 0; j < 4; ++j) {
                const LAS bf16_t* cur = (const LAS bf16_t*)(lds + j * 16384);
                fa_tile<0>(st, qf, cur, cur + 4096, r, h, c, true, [=](int) { return true; });
            }
            const float l = st.l + __shfl_xor(st.l, 32);
            const float inv = 1.f / fmaxf(l, 1e-30f);
            if (valid) {
                const int slot = __builtin_popcount((unsigned)selm[(size_t)bh * 4096 + q] & ((1u << n) - 1u));
                bf16_t* o = moba_po(P, slot) + ((size_t)(bh >> 4) * 4096 + q) * 1024 + (bh & 15) * 64;
                nat_store(o, h, st.o0, st.o1, inv);
                if (h == 0) { float* pm = pml + (((size_t)bh * 4096 + q) * 3 + slot) * 2; pm[0] = st.m; pm[1] = l; }
            }
        }
    }
}
DI void phase_moba_own(const Params& P, unsigned char* smem) {
    unsigned char* ws = P.ws;
    const int tid = threadIdx.x, lane = tid & 63, wave = tid >> 6, r = lane & 31, h = lane >> 5;
    const float c = 0.125f * 1.4426950408889634f;
    LAS unsigned char* lds = (LAS unsigned char*)smem;
    const unsigned short* selm = (const unsigned short*)(ws + WS_SELM);
    const float* pml = (const float*)(ws + WS_PML);
    for (int it = blockIdx.x; it < 2048; it += gridDim.x) {
        const int own = 15 - (it >> 7), bh = it & 127, t0 = own * 256;
        const bf16_t* Kg = (const bf16_t*)(ws + XP_Q1 + 64 * MiB) + (size_t)bh * 4096 * 64 + (size_t)own * 4 * 4096;
        const bf16_t* Vg = (const bf16_t*)(ws + XP_Q1 + 128 * MiB) + (size_t)bh * 4096 * 64 + (size_t)own * 4 * 4096;
        asm volatile("s_waitcnt vmcnt(0)" ::: "memory");
        __builtin_amdgcn_s_barrier();
#pragma unroll
        for (int j = 0; j < 4; ++j) fa_issue(Kg + (size_t)j * 4096, Vg + (size_t)j * 4096, lds + j * 16384, tid);
        asm volatile("s_waitcnt vmcnt(0)" ::: "memory");
        __builtin_amdgcn_s_barrier();
        asm volatile("" ::: "memory");
#pragma unroll 1
        for (int g2 = 0; g2 < 2; ++g2) {
            const int row0 = t0 + g2 * 128 + wave * 32, q = row0 + r;
            const bf16_t* Qg = (const bf16_t*)(ws + XP_Q1) + ((size_t)bh * 4096 + q) * 64;
            bf16x8 qf[4];
#pragma unroll
            for (int ks = 0; ks < 4; ++ks) qf[ks] = *(const bf16x8*)(Qg + ks * 16 + 8 * h);
            const int nsel = __builtin_popcount((unsigned)selm[(size_t)bh * 4096 + q]);
            const size_t orow = ((size_t)(bh >> 4) * 4096 + q) * 1024 + (bh & 15) * 64;
            const float* pm = pml + ((size_t)bh * 4096 + q) * 6;
            float mi[3], li[3];
            u32x4 pa[3][4];
#pragma unroll
            for (int i = 0; i < 3; ++i) {
                mi[i] = i < nsel ? pm[2 * i] : -INFINITY; li[i] = i < nsel ? pm[2 * i + 1] : 0.f;
                const u32x4* po = (const u32x4*)(moba_po(P, i) + orow + 32 * h);
#pragma unroll
                for (int k = 0; k < 4; ++k) pa[i][k] = i < nsel ? po[k] : (u32x4){0u, 0u, 0u, 0u};
            }
            FA st; fa_init(st);
            const int jmax = (row0 + 31 - t0) >> 6;
#pragma unroll 1
            for (int j = 0; j <= jmax; ++j) {
                const LAS bf16_t* cur = (const LAS bf16_t*)(lds + j * 16384);
                const int kbase = t0 + j * 64;
                if (kbase + 63 <= row0) fa_tile<0>(st, qf, cur, cur + 4096, r, h, c, true, [=](int) { return true; });
                else fa_tile<2>(st, qf, cur, cur + 4096, r, h, c, true, [=](int koff) { return kbase + koff <= q; });
            }
            const float l_own = st.l + __shfl_xor(st.l, 32);
            const float M = fmaxf(fmaxf(st.m, mi[0]), fmaxf(mi[1], mi[2]));
            const float wo = __builtin_amdgcn_exp2f(st.m - M);
            float L = l_own * wo;
#pragma unroll
            for (int k = 0; k < 16; ++k) { st.o0[k] *= wo; st.o1[k] *= wo; }
#pragma unroll
            for (int i = 0; i < 3; ++i) {
                const float wi = li[i] * __builtin_amdgcn_exp2f(mi[i] - M);
                L += wi;
#pragma unroll
                for (int k = 0; k < 2; ++k) {
                    const f32x4 a0 = bf4_to_f((u32x2){pa[i][k].x, pa[i][k].y}), a1 = bf4_to_f((u32x2){pa[i][k].z, pa[i][k].w});
                    const f32x4 b0 = bf4_to_f((u32x2){pa[i][2 + k].x, pa[i][2 + k].y}), b1 = bf4_to_f((u32x2){pa[i][2 + k].z, pa[i][2 + k].w});
                    st.o0[8 * k] += wi * a0.x; st.o0[8 * k + 1] += wi * a0.y; st.o0[8 * k + 2] += wi * a0.z; st.o0[8 * k + 3] += wi * a0.w;
                    st.o0[8 * k + 4] += wi * a1.x; st.o0[8 * k + 5] += wi * a1.y; st.o0[8 * k + 6] += wi * a1.z; st.o0[8 * k + 7] += wi * a1.w;
                    st.o1[8 * k] += wi * b0.x; st.o1[8 * k + 1] += wi * b0.y; st.o1[8 * k + 2] += wi * b0.z; st.o1[8 * k + 3] += wi * b0.w;
                    st.o1[8 * k + 4] += wi * b1.x; st.o1[8 * k + 5] += wi * b1.y; st.o1[8 * k + 6] += wi * b1.z; st.o1[8 * k + 7] += wi * b1.w;
                }
            }
            const float inv = 1.f / fmaxf(L, 1e-30f);
            nat_store((bf16_t*)(ws + WS_MIX) + orow, h, st.o0, st.o1, inv);
        }
    }
}

constexpr int SMEM_BYTES = 65536 + 8192 + 1024 + 512;
static_assert(SMEM_BYTES >= 128 * 129 * 4 && SMEM_BYTES >= MOE_LDS_ROW + 512 && SMEM_BYTES >= NSA_LDS_MSK + 256, "LDS map");
constexpr int SMEM_OLD = 128 * 129 * 4;
typedef __attribute__((address_space(1))) unsigned gu32;
#define XB_TMO      128
#define XB_XCNT(j)  (256  + 64 * (j))
#define XB_XSUB(j)  (1280 + 64 * (j))
#define XB_XGEN(j)  (2304 + 64 * (j))
#define XB_TOP      3328
#define XB_TOPGEN   3392
#define XCD_BAR_WORDS 3456
#define XB_SPIN_CAP (1u << 18)

__device__ __forceinline__ unsigned xb_ld(unsigned* p)              { return __hip_atomic_load(p, __ATOMIC_RELAXED, __HIP_MEMORY_SCOPE_AGENT); }
__device__ __forceinline__ unsigned xb_add(unsigned* p, unsigned v) { return __hip_atomic_fetch_add(p, v, __ATOMIC_RELAXED, __HIP_MEMORY_SCOPE_AGENT); }
__device__ __forceinline__ unsigned xb_xcc_id() { return (unsigned)__builtin_amdgcn_s_getreg((3 << 11) | 20) & 0xFu; }
#define XB_SPIN(cond, bar) do { unsigned _sp = 0; while (cond) { __builtin_amdgcn_s_sleep(1); \
    if ((++_sp & 255u) == 0u) { if (xb_ld(&(bar)[XB_TMO])) break; if (_sp > XB_SPIN_CAP) { atomicAdd(&(bar)[XB_TMO], 1u); break; } } } } while (0)

struct XcdBarrier {
    unsigned* bar; unsigned x;
    volatile LAS unsigned* st;
};

__device__ __forceinline__ XcdBarrier xcd_barrier_post(unsigned* bar, volatile LAS unsigned* st) {
    XcdBarrier b; b.bar = bar; b.x = xb_xcc_id(); b.st = st;
    if (threadIdx.x == 0) (void)xb_add(&bar[XB_XCNT(b.x)], 1u);
    return b;
}
__device__ __forceinline__ void xcd_barrier_complete(unsigned* bar, unsigned x, unsigned& nloc, unsigned& nx) {
    const unsigned G = gridDim.x * gridDim.y * gridDim.z;
    unsigned sum, cnt, mine, sp = 0u;
    for (;;) {
        sum = 0u; cnt = 0u; mine = 0u;
#pragma unroll
        for (unsigned j = 0; j < 16; ++j) { const unsigned c = xb_ld(&bar[XB_XCNT(j)]); sum += c; cnt += (c > 0u) ? 1u : 0u; mine = (j == x) ? c : mine; }
        if (sum == G) break;
        __builtin_amdgcn_s_sleep(1);
        if ((++sp & 255u) == 0u) { if (xb_ld(&bar[XB_TMO])) break; if (sp > XB_SPIN_CAP) { atomicAdd(&bar[XB_TMO], 1u); break; } }
    }
    nloc = mine > 0u ? mine : 1u; nx = cnt > 0u ? cnt : 1u;
}

__device__ __forceinline__ void xcd_barrier(const XcdBarrier& b) {
    asm volatile("s_waitcnt vmcnt(0)" ::: "memory");
    __syncthreads();
    if (threadIdx.x == 0) {
        unsigned* bar = b.bar;
        __builtin_amdgcn_s_waitcnt(0);
        unsigned nloc = b.st[0], nx = b.st[1];
        if (nloc == 0u) { xcd_barrier_complete(bar, b.x, nloc, nx); b.st[0] = nloc; b.st[1] = nx; }
        const unsigned old = xb_add(&bar[XB_XSUB(b.x)], 1u);
        const unsigned gen = old / nloc;
        if (old + 1u == (gen + 1u) * nloc) {
            __builtin_amdgcn_fence(__ATOMIC_RELEASE, "agent");
            asm volatile("s_waitcnt vmcnt(0)" ::: "memory");
            const unsigned og = xb_add(&bar[XB_TOP], 1u);
            const unsigned tg = og / nx;
            if (og + 1u == (tg + 1u) * nx) xb_add(&bar[XB_TOPGEN], 1u);
            else XB_SPIN(xb_ld(&bar[XB_TOPGEN]) == tg, bar);
            __builtin_amdgcn_fence(__ATOMIC_ACQUIRE, "agent");
            xb_add(&bar[XB_XGEN(b.x)], 1u);
            asm volatile("s_waitcnt vmcnt(0)" ::: "memory");
        } else {
            XB_SPIN(xb_ld(&bar[XB_XGEN(b.x)]) == gen, bar);
            __builtin_amdgcn_fence(__ATOMIC_ACQUIRE, "agent");
            asm volatile("s_waitcnt vmcnt(0)" ::: "memory");
        }
    }
    __syncthreads();
}

constexpr size_t CTL_BAR = 16384;
constexpr size_t CTL_BYTES = 32768;

#define PHASE(k, call) if (P.ph_lo <= (k) && (k) < P.ph_hi) { call; if ((k) + 1 < P.ph_hi) xcd_barrier(xb); }
__global__ void __launch_bounds__(256, 2) mega(Params P) {
    __shared__ __attribute__((aligned(16))) unsigned char smem[SMEM_BYTES + 16];
    unsigned* xbst = (unsigned*)(smem + SMEM_BYTES);
    cg::grid_group grid = cg::this_grid();
    if (threadIdx.x < 4) xbst[threadIdx.x] = 0u;
    __syncthreads();
    if (P.ph_lo < 0) grid.sync();
    XcdBarrier xb = xcd_barrier_post((unsigned*)(P.ws + WS_CTL + CTL_BAR), (volatile LAS unsigned*)xbst);
    PHASE(0, phase0(P, smem))
    PHASE(1, phase_inproj0(P, smem))
    PHASE(2, phase_cmp_s5e(P, smem))
    PHASE(3, phase_glu(P, smem); phase_nsa(P, smem))
    PHASE(6, phase_outproj<false>(P, smem, P.in[0], nullptr, WS_WOUT0))
    PHASE(7, phase_ln_router(P, 0))
    PHASE(8, phase_moe_gu(P, smem, 0))
    PHASE(9, phase_moe_down(P, smem, 0))
    PHASE(10, phase_ln_ffn(P, 0))
    PHASE(11, phase_inproj1(P, smem))
    PHASE(12, phase_moba_gate(P, smem))
    PHASE(13, phase_moba_kv(P, smem))
    PHASE(14, phase_moba_own(P, smem))
    PHASE(15, phase_outproj<true>(P, smem, nullptr, (const bf16_t*)P.out, WS_WOUT1))
    PHASE(16, phase_ln_router(P, 1))
    PHASE(17, phase_moe_gu(P, smem, 1))
    PHASE(18, phase_moe_down(P, smem, 1))
    PHASE(20, phase_ln_ffn(P, 1))
}

extern "C" void kernel_launch(void* const* d_in, const int* in_sizes, int n_in, void* d_out, int out_size, void* d_ws, size_t ws_size, hipStream_t stream) {
    static int grid = 0;
    if (grid == 0) {
        if (n_in != 32 || out_size != NT * DM || ws_size < WS_END) { fprintf(stderr, "kernel_launch: unexpected shapes (n_in %d, out %d, ws %zu)\n", n_in, out_size, ws_size); grid = -1; return; }
        int dev = 0, cus = 0, per_cu = 0;
        (void)hipGetDevice(&dev);
        (void)hipDeviceGetAttribute(&cus, hipDeviceAttributeMultiprocessorCount, dev);
        (void)hipOccupancyMaxActiveBlocksPerMultiprocessor(&per_cu, mega, 256, 0);
        if (per_cu < 1) per_cu = 1;
        if (per_cu > 2) per_cu = 2;
        grid = cus * per_cu;
    }
    if (grid < 0) return;
    (void)hipMemsetAsync((char*)d_ws + WS_CTL, 0, CTL_BYTES, stream);
    Params p{};
    for (int i = 0; i < 32; ++i) p.in[i] = (const float*)d_in[i];
    p.out = (float*)d_out; p.ws = (unsigned char*)d_ws;
    p.ph_lo = 0; p.ph_hi = NPH;
    void* args[] = {&p};
    hipError_t e = hipLaunchCooperativeKernel((void*)mega, dim3(grid), dim3(256), args, 0, stream);
    if (e != hipSuccess) fprintf(stderr, "cooperative launch failed: %s (grid %d)\n", hipGetErrorString(e), grid);
}
```

```cpp
#include <hip/hip_runtime.h>
#include <hip/hip_cooperative_groups.h>
#include <cstdio>
#include <cstdint>
namespace cg = cooperative_groups;

typedef unsigned short bf16_t;
typedef short bf16x8 __attribute__((ext_vector_type(8)));
typedef float f32x4 __attribute__((ext_vector_type(4)));
typedef unsigned u32x4 __attribute__((ext_vector_type(4)));
typedef unsigned u32x2 __attribute__((ext_vector_type(2)));
#define DI __device__ __forceinline__
#define LAS __attribute__((address_space(3)))
typedef float f32x16 __attribute__((ext_vector_type(16)));
typedef float f32x8 __attribute__((ext_vector_type(8)));
typedef __bf16 bf16x8v __attribute__((ext_vector_type(8)));
typedef __bf16 bf16x4v __attribute__((ext_vector_type(4)));
#define MFMA32(a, b, c) __builtin_amdgcn_mfma_f32_32x32x16_bf16((a), (b), (c), 0, 0, 0)

constexpr int NB = 8, SEQ = 4096, DM = 1024, NT = NB * SEQ;
constexpr float ALPHA = 1.41421356237f;
constexpr float LN_EPS = 1e-5f;
constexpr int NIN0 = 1920;
constexpr int NPH = 21;

constexpr size_t MiB = 1u << 20;
constexpr size_t WS_CTL = 0;
constexpr size_t WS_ROPE = 1 * MiB;
constexpr size_t WS_WIN0 = 2 * MiB;
constexpr size_t WS_WOUT0 = 6 * MiB;
constexpr size_t WS_WIN1 = 8 * MiB;
constexpr size_t WS_WOUT1 = 14 * MiB;
constexpr size_t WS_WGLU = 16 * MiB;
constexpr size_t WS_WCK1 = 16 * MiB + 512 * 1024;
constexpr size_t WS_WCV1 = 17 * MiB;
constexpr size_t WS_WCK2 = 17 * MiB + 512 * 1024;
constexpr size_t WS_WCV2 = WS_WCK2 + 16384;
constexpr size_t WS_CBIAS = WS_WCV2 + 16384;
constexpr size_t WS_S5AL = WS_CBIAS + 4096;
constexpr size_t WS_RTRW = 17 * MiB + 640 * 1024;
constexpr size_t WS_BTE = 18 * MiB;
constexpr size_t WS_BTY = 22 * MiB;
constexpr size_t WS_WGU = 42 * MiB;
constexpr size_t WS_WDN = 74 * MiB;
constexpr size_t WS_KMP = 90 * MiB;
constexpr size_t WS_WGT = 94 * MiB;
constexpr size_t WS_KMEAN = 94 * MiB + 512 * 1024;
constexpr size_t WS_KCMP = 95 * MiB;
constexpr size_t WS_VCMP = 95 * MiB + 512 * 1024;
constexpr size_t WS_ACTB = 96 * MiB;
constexpr size_t WS_MIX = 160 * MiB;
constexpr size_t WS_XP = 224 * MiB;
constexpr size_t WS_LIST2 = 416 * MiB;
constexpr size_t WS_SELM = 92 * MiB;
constexpr size_t WS_MCNT = 93 * MiB;
constexpr size_t WS_MLIST = WS_LIST2;
constexpr size_t WS_PO2 = 424 * MiB;
constexpr size_t WS_PML = 488 * MiB;
constexpr size_t WS_END = 504 * MiB;
constexpr size_t XP_Q0 = WS_XP;
constexpr size_t XP_KC = WS_XP + 32 * MiB;
constexpr size_t KVSZ = 8 * MiB;
constexpr size_t XP_GATES = WS_XP + 80 * MiB;
constexpr size_t XP_AEXT = WS_XP + 84 * MiB;
constexpr size_t XP_G5 = WS_XP + 124 * MiB;
constexpr size_t XP_PRE = WS_XP;
constexpr size_t XP_YB = WS_XP;
constexpr size_t XP_H = WS_XP + 128 * MiB;
constexpr size_t XP_Q1 = WS_XP;

struct Params {
    const float* in[32];
    float* out;
    unsigned char* ws;
    int ph_lo, ph_hi;
};

DI bf16_t f2bf(float f) { unsigned u = __float_as_uint(f); return (bf16_t)((u + 0x7fffu + ((u >> 16) & 1u)) >> 16); }
DI float bf2f(bf16_t h) { return __uint_as_float(((unsigned)h) << 16); }
DI unsigned pk2(float lo, float hi) { return (unsigned)f2bf(lo) | ((unsigned)f2bf(hi) << 16); }
DI bf16x8 cvt8(f32x8 v) { return __builtin_bit_cast(bf16x8, __builtin_convertvector(v, bf16x8v)); }
DI u32x2 cvt4(f32x4 v) { return __builtin_bit_cast(u32x2, __builtin_convertvector(v, bf16x4v)); }
DI int natdim(int p) { const int hh = p >> 5, i = p & 31; return ((i >> 4) << 5) + 8 * ((i & 15) >> 2) + 4 * hh + (i & 3); }
DI u32x4 cvt8u(f32x16 v, int k, float s) { return __builtin_bit_cast(u32x4, cvt8((f32x8){v[8 * k] * s, v[8 * k + 1] * s, v[8 * k + 2] * s, v[8 * k + 3] * s, v[8 * k + 4] * s, v[8 * k + 5] * s, v[8 * k + 6] * s, v[8 * k + 7] * s})); }
DI void nat_store(bf16_t* o, int h, const f32x16& o0, const f32x16& o1, float s) {
    u32x4* d = (u32x4*)(o + 32 * h);
    d[0] = cvt8u(o0, 0, s); d[1] = cvt8u(o0, 1, s); d[2] = cvt8u(o1, 0, s); d[3] = cvt8u(o1, 1, s);
}
DI u32x4 cvt44(f32x4 a, f32x4 b) { const u32x2 lo = cvt4(a), hi = cvt4(b); return (u32x4){lo.x, lo.y, hi.x, hi.y}; }
DI size_t kp_off(int key, int d) { return ((size_t)((key >> 5) * 4 + (d >> 4)) * 32 + (key & 31)) * 16 + (d & 15); }
DI int vp_pos(int ko) { return 8 * ((ko >> 2) & 1) + 4 * (ko >> 3) + (ko & 3); }
DI size_t vp_off(int key, int d) { return ((size_t)(key >> 4) * 64 + d) * 16 + vp_pos(key & 15); }
DI bf16_t ld_bf(const bf16_t* p) { return *p; }
DI f32x4 bf4_to_f(u32x2 w) { return (f32x4){__uint_as_float(w.x << 16), __uint_as_float(w.x & 0xffff0000u), __uint_as_float(w.y << 16), __uint_as_float(w.y & 0xffff0000u)}; }
template <int CTRL> DI float dpp_f(float v) { return __builtin_bit_cast(float, __builtin_amdgcn_update_dpp(0, __builtin_bit_cast(int, v), CTRL, 0xF, 0xF, true)); }
DI float wave_sum(float v) {
    v += dpp_f<0xB1>(v);
    v += dpp_f<0x4E>(v);
    v += dpp_f<0x141>(v);
    v += dpp_f<0x140>(v);
    { const auto s = __builtin_amdgcn_permlane16_swap(__float_as_uint(v), __float_as_uint(v), false, false); v = __uint_as_float(s[0]) + __uint_as_float(s[1]); }
    { const auto s = __builtin_amdgcn_permlane32_swap(__float_as_uint(v), __float_as_uint(v), false, false); v = __uint_as_float(s[0]) + __uint_as_float(s[1]); }
    return v;
}
DI float wave_max(float v) {
#pragma unroll
    for (int o = 32; o > 0; o >>= 1) v = fmaxf(v, __shfl_xor(v, o));
    return v;
}
DI float sigmoidf_(float x) { return __builtin_amdgcn_rcpf(1.f + __expf(-x)); }
DI float gelu_tanh(float x) { const float z = 0.7978845608028654f * (x + 0.044715f * x * x * x); return x * sigmoidf_(2.f * z); }

template <bool TRANS, bool PIN = true>
DI void gemm_kstep(const LAS unsigned char* cur, int aoff, int boff, int fq, int swz, f32x4 (&acc)[4][4]) {
    if (!PIN) {
#pragma unroll
        for (int ks = 0; ks < 2; ++ks) {
            bf16x8 af[4], bfr[4];
            const int co = ((ks * 4 + fq) ^ swz) * 16;
#pragma unroll
            for (int m = 0; m < 4; ++m) af[m] = *(const LAS bf16x8*)(cur + aoff + m * 2048 + co);
#pragma unroll
            for (int n = 0; n < 4; ++n) bfr[n] = *(const LAS bf16x8*)(cur + boff + n * 2048 + co);
#pragma unroll
            for (int m = 0; m < 4; ++m)
#pragma unroll
                for (int n = 0; n < 4; ++n) acc[m][n] = TRANS ? __builtin_amdgcn_mfma_f32_16x16x32_bf16(bfr[n], af[m], acc[m][n], 0, 0, 0) : __builtin_amdgcn_mfma_f32_16x16x32_bf16(af[m], bfr[n], acc[m][n], 0, 0, 0);
        }
        return;
    }
    bf16x8 af[2][4], bfr[2][4];
    const int co0 = (fq ^ swz) * 16, co1 = ((4 + fq) ^ swz) * 16;
    af[0][0] = *(const LAS bf16x8*)(cur + aoff + co0);
#pragma unroll
    for (int n = 0; n < 4; ++n) bfr[0][n] = *(const LAS bf16x8*)(cur + boff + n * 2048 + co0);
#pragma unroll
    for (int m = 1; m < 4; ++m) af[0][m] = *(const LAS bf16x8*)(cur + aoff + m * 2048 + co0);
    __builtin_amdgcn_sched_barrier(0);
#pragma unroll
    for (int n = 0; n < 4; ++n) acc[0][n] = TRANS ? __builtin_amdgcn_mfma_f32_16x16x32_bf16(bfr[0][n], af[0][0], acc[0][n], 0, 0, 0) : __builtin_amdgcn_mfma_f32_16x16x32_bf16(af[0][0], bfr[0][n], acc[0][n], 0, 0, 0);
    __builtin_amdgcn_sched_barrier(0);
    af[1][0] = *(const LAS bf16x8*)(cur + aoff + co1);
#pragma unroll
    for (int n = 0; n < 4; ++n) bfr[1][n] = *(const LAS bf16x8*)(cur + boff + n * 2048 + co1);
#pragma unroll
    for (int m = 1; m < 4; ++m) af[1][m] = *(const LAS bf16x8*)(cur + aoff + m * 2048 + co1);
    __builtin_amdgcn_sched_barrier(0);
#pragma unroll
    for (int m = 1; m < 4; ++m)
#pragma unroll
        for (int n = 0; n < 4; ++n) acc[m][n] = TRANS ? __builtin_amdgcn_mfma_f32_16x16x32_bf16(bfr[0][n], af[0][m], acc[m][n], 0, 0, 0) : __builtin_amdgcn_mfma_f32_16x16x32_bf16(af[0][m], bfr[0][n], acc[m][n], 0, 0, 0);
#pragma unroll
    for (int m = 0; m < 4; ++m)
#pragma unroll
        for (int n = 0; n < 4; ++n) acc[m][n] = TRANS ? __builtin_amdgcn_mfma_f32_16x16x32_bf16(bfr[1][n], af[1][m], acc[m][n], 0, 0, 0) : __builtin_amdgcn_mfma_f32_16x16x32_bf16(af[1][m], bfr[1][n], acc[m][n], 0, 0, 0);
}
constexpr int GEMM_LDS = 65536;
template <bool TRANS = true, bool PIN = true, class RowPtr, class Epi>
DI void gemm128(RowPtr rowptr, const bf16_t* __restrict__ Bt, int ldb, int K, unsigned char* smem, Epi epi, int kskip_lo = 0, int kskip_hi = 0) {
    LAS unsigned char* lds = (LAS unsigned char*)smem;
    const int tid = threadIdx.x, lane = tid & 63, wave = tid >> 6, wr = wave >> 1, wc = wave & 1, fr = lane & 15, fq = lane >> 4;
    const int schunk = ((tid & 7) ^ ((tid >> 4) & 7)) * 8;
    const bf16_t* ga[4];
#pragma unroll
    for (int i = 0; i < 4; ++i) ga[i] = rowptr(i * 32 + (tid >> 3)) + schunk;
    const bf16_t* gb = Bt + (size_t)(tid >> 3) * ldb + schunk;
    const size_t gbs = (size_t)32 * ldb;
    auto stage = [&](int kt, int s) {
#pragma unroll
        for (int i = 0; i < 4; ++i) {
            __builtin_amdgcn_global_load_lds((const unsigned*)(ga[i] + kt * 64), (LAS unsigned*)(lds + s * 32768 + (i * 256 + tid) * 16), 16, 0, 0);
            __builtin_amdgcn_global_load_lds((const unsigned*)(gb + i * gbs + kt * 64), (LAS unsigned*)(lds + s * 32768 + 16384 + (i * 256 + tid) * 16), 16, 0, 0);
        }
    };
    f32x4 acc[4][4];
#pragma unroll
    for (int m = 0; m < 4; ++m)
#pragma unroll
        for (int n = 0; n < 4; ++n) acc[m][n] = (f32x4){0.f, 0.f, 0.f, 0.f};
    const int nskip = kskip_hi - kskip_lo, nk = (K >> 6) - nskip;
    const int swz = (fr >> 1) & 7;
    const int aoff = (wr * 64 + fr) * 128, boff = 16384 + (wc * 64 + fr) * 128;
    stage(kskip_lo == 0 ? nskip : 0, 0);
#pragma unroll 1
    for (int kt = 0; kt < nk; ++kt) {
        asm volatile("s_waitcnt vmcnt(0)" ::: "memory");
        __syncthreads();
        if (kt + 1 < nk) stage(kt + 1 < kskip_lo ? kt + 1 : kt + 1 + nskip, (kt + 1) & 1);
        const LAS unsigned char* cur = lds + (kt & 1) * 32768;
        gemm_kstep<TRANS, PIN>(cur, aoff, boff, fq, swz, acc);
    }
    __syncthreads();
    epi(acc, wr, wc, lane);
}

template <bool TRANS = true, class RowPtr, class Epi, class NextRow>
DI void gemm128s(RowPtr rowptr, const bf16_t* __restrict__ Bt, int ldb, int K, unsigned char* smem, Epi epi, bool prefetched, bool has_next, NextRow nextrow, const bf16_t* __restrict__ nextBt) {
    LAS unsigned char* lds = (LAS unsigned char*)smem;
    const int tid = threadIdx.x, lane = tid & 63, wave = tid >> 6, wr = wave >> 1, wc = wave & 1, fr = lane & 15, fq = lane >> 4;
    const int schunk = ((tid & 7) ^ ((tid >> 4) & 7)) * 8;
    const bf16_t* ga[4];
#pragma unroll
    for (int i = 0; i < 4; ++i) ga[i] = rowptr(i * 32 + (tid >> 3)) + schunk;
    const bf16_t* gb = Bt + (size_t)(tid >> 3) * ldb + schunk;
    const size_t gbs = (size_t)32 * ldb;
    auto stage = [&](int kt, int s) {
#pragma unroll
        for (int i = 0; i < 4; ++i) {
            __builtin_amdgcn_global_load_lds((const unsigned*)(ga[i] + kt * 64), (LAS unsigned*)(lds + s * 32768 + (i * 256 + tid) * 16), 16, 0, 0);
            __builtin_amdgcn_global_load_lds((const unsigned*)(gb + i * gbs + kt * 64), (LAS unsigned*)(lds + s * 32768 + 16384 + (i * 256 + tid) * 16), 16, 0, 0);
        }
    };
    f32x4 acc[4][4];
#pragma unroll
    for (int m = 0; m < 4; ++m)
#pragma unroll
        for (int n = 0; n < 4; ++n) acc[m][n] = (f32x4){0.f, 0.f, 0.f, 0.f};
    const int nk = K >> 6;
    const int swz = (fr >> 1) & 7;
    const int aoff = (wr * 64 + fr) * 128, boff = 16384 + (wc * 64 + fr) * 128;
    if (!prefetched) stage(0, 0);
#pragma unroll 1
    for (int kt = 0; kt < nk; ++kt) {
        asm volatile("s_waitcnt vmcnt(0)" ::: "memory");
        __syncthreads();
        if (kt + 1 < nk) stage(kt + 1, (kt + 1) & 1);
        else if (has_next) {
#pragma unroll
            for (int i = 0; i < 4; ++i) {
                __builtin_amdgcn_global_load_lds((const unsigned*)(nextrow(i * 32 + (tid >> 3)) + schunk), (LAS unsigned*)(lds + (i * 256 + tid) * 16), 16, 0, 0);
                __builtin_amdgcn_global_load_lds((const unsigned*)(nextBt + (size_t)(tid >> 3) * ldb + schunk + i * gbs), (LAS unsigned*)(lds + 16384 + (i * 256 + tid) * 16), 16, 0, 0);
            }
        }
        const LAS unsigned char* cur = lds + (kt & 1) * 32768;
        gemm_kstep<TRANS>(cur, aoff, boff, fq, swz, acc);
    }
    epi(acc, wr, wc, lane);
}

DI int vblock() { const int G = gridDim.x; return (G & 7) == 0 ? (int)(blockIdx.x & 7) * (G >> 3) + (int)(blockIdx.x >> 3) : (int)blockIdx.x; }
DI void tile_mn(int it, int nN, int& mt, int& nt) { const int per = 8 * nN, grp = it / per, idx = it - grp * per; nt = idx >> 3; mt = grp * 8 + (idx & 7); }

DI int rope_pos(int l) { return (l & ~63) + 16 * (2 * ((l >> 2) & 1) + ((l >> 5) & 1)) + 4 * ((l >> 3) & 3) + (l & 3); }
DI int rowmap(int kind, int n) {
    if (kind == 1) {
        if (n < 512 || (n >= 512 && n < 640) || (n >= 768 && n < 896) || (n >= 1024 && n < 1152)) return rope_pos(n);
        return n < 1304 ? n : n + 104;
    }
    if (kind == 4) return n < 2048 ? rope_pos(n) : n;
    const int inv32 = 16 * ((n >> 2) & 1) + 4 * ((n & 31) >> 3) + (n & 3);
    if (kind == 2) return ((n >> 5) << 6) + inv32;
    if (kind == 3) return ((n >> 5) << 6) + 32 + inv32;
    if (kind == 5) return (n & ~31) + inv32;
    return n;
}
template <bool KNAT = false>
DI void tr_tile(const float* __restrict__ src, int K, int N, bf16_t* __restrict__ dst, int kind, int kt, int nt, float* s) {
    const int tid = threadIdx.x, k0 = kt * 64, n0 = nt * 64;
    {
        const int nn = tid & 63, kq = tid >> 6, n = n0 + nn;
#pragma unroll
        for (int i = 0; i < 16; ++i) { const int kk = kq + 4 * i; s[kk * 65 + nn] = (n < N) ? src[(size_t)(k0 + kk) * N + n] : 0.f; }
    }
    __syncthreads();
    {
        const int rn = tid >> 2, kseg = (tid & 3) * 16, n = n0 + rn;
        if (n < N) {
            unsigned w[8];
#pragma unroll
            for (int i = 0; i < 8; ++i) w[i] = KNAT ? pk2(s[natdim(kseg + 2 * i) * 65 + rn], s[natdim(kseg + 2 * i + 1) * 65 + rn]) : pk2(s[(kseg + 2 * i) * 65 + rn], s[(kseg + 2 * i + 1) * 65 + rn]);
            bf16_t* d = dst + (size_t)rowmap(kind, n) * K + k0 + kseg;
            *(uint4*)d = make_uint4(w[0], w[1], w[2], w[3]);
            *(uint4*)(d + 8) = make_uint4(w[4], w[5], w[6], w[7]);
        }
    }
    __syncthreads();
}
struct CF { float re, im; };
DI CF cmul(CF a, CF b) { return {a.re * b.re - a.im * b.im, a.re * b.im + a.im * b.re}; }
DI CF s5_apow(const Params& P, int g, int p, float tau) {
    const float step = expf(P.in[10][g]);
    const float lr = P.in[8][g * 64 + p], li = P.in[9][g * 64 + p];
    const float mag = expf(lr * step * tau);
    float sn, cs; sincosf(li * step * tau, &sn, &cs);
    return {mag * cs, mag * sn};
}
DI CF s5_f(const Params& P, int g, int p) {
    const CF a = s5_apow(P, g, p, 1.f);
    const float lr = P.in[8][g * 64 + p], li = P.in[9][g * 64 + p];
    const float den = lr * lr + li * li;
    return {((a.re - 1.f) * lr + a.im * li) / den, (a.im * lr - (a.re - 1.f) * li) / den};
}
DI void phase0(const Params& P, unsigned char* smem) {
    const int tid = threadIdx.x;
    unsigned char* ws = P.ws;
    float* sf = (float*)smem;
    constexpr int N_TR0 = 16 * 29, N_TR1 = 256, N_TR2 = 16 * 48, N_TR3 = 256, N_TR4 = 64, N_TR5 = 64, N_TR6 = 64, N_TR7 = 2, N_TR8 = 2;
    constexpr int N_TRG = 64 * 32, N_TRU = 64 * 32, N_TRD = 64 * 32;
    constexpr int N_X = NT * DM / 8192, N_ROPE = 512, N_CB = 16, N_AL = 8, N_BTE = 256, N_BTYM = 32 * 63, N_BTYQ = 4096, N_ZP = 13;
    constexpr int N_RW = 2 * 36864 / 256;
    constexpr int TOTAL = N_RW + N_TR0 + N_TR1 + N_TR4 + N_TR5 + N_TR6 + N_TR7 + N_TR8 + N_X + N_ROPE + N_CB + N_AL + N_BTE + N_BTYM + N_BTYQ + N_ZP;
    for (int it0 = blockIdx.x; it0 < TOTAL; it0 += gridDim.x) {
        int it = it0;
        if (it < N_RW) {
            const int e = it * 256 + tid, layer = e / 36864, r = e % 36864;
            float* dst = (float*)(ws + WS_RTRW) + (size_t)layer * 36864;
            if (r < 4096) { const int o = r & 3, l = (r >> 2) & 63, jk = r >> 8, d = 8 * l + 512 * (jk >> 3) + (jk & 7); dst[r] = P.in[25][((size_t)layer * 1024 + d) * 4 + o]; }
            else { const int q = r - 4096, o = q & 3, l = (q >> 2) & 63, hf = (q >> 8) & 1, jk = (q >> 9) & 15, g = q >> 13, d = 8 * l + 512 * (jk >> 3) + (jk & 7);
                   dst[r] = P.in[27][(((size_t)layer * 4 + g) * 1024 + d) * 8 + hf * 4 + o]; }
            continue;
        } it -= N_RW;
        if (it < N_TR0) { tr_tile(P.in[1], 1024, 1816, (bf16_t*)(ws + WS_WIN0), 1, it / 29, it % 29, sf); continue; } it -= N_TR0;
        if (it < N_TR1) { if (it / 16 < 8) tr_tile<true>(P.in[18], 1024, 1024, (bf16_t*)(ws + WS_WOUT0), 5, it / 16, it % 16, sf); else tr_tile(P.in[18], 1024, 1024, (bf16_t*)(ws + WS_WOUT0), 5, it / 16, it % 16, sf); continue; } it -= N_TR1;
        if (it < N_TR4) { tr_tile(P.in[16], 512, 512, (bf16_t*)(ws + WS_WGLU), 5, it / 8, it % 8, sf); continue; } it -= N_TR4;
        if (it < N_TR5) { tr_tile(P.in[4], 2048, 128, (bf16_t*)(ws + WS_WCK1), 0, it / 2, it % 2, sf); continue; } it -= N_TR5;
        if (it < N_TR6) { tr_tile(P.in[6], 2048, 128, (bf16_t*)(ws + WS_WCV1), 0, it / 2, it % 2, sf); continue; } it -= N_TR6;
        if (it < N_TR7) { tr_tile(P.in[5], 128, 64, (bf16_t*)(ws + WS_WCK2), 0, it, 0, sf); continue; } it -= N_TR7;
        if (it < N_TR8) { tr_tile(P.in[7], 128, 64, (bf16_t*)(ws + WS_WCV2), 0, it, 0, sf); continue; } it -= N_TR8;
        if (it < N_X) {
            const float* x = P.in[0]; bf16_t* xb = (bf16_t*)(ws + WS_ACTB);
#pragma unroll
            for (int i = 0; i < 4; ++i) {
                const size_t idx = (size_t)it * 8192 + i * 2048 + tid * 8;
                const f32x4 a = __builtin_nontemporal_load((const f32x4*)(x + idx)), b = __builtin_nontemporal_load((const f32x4*)(x + idx + 4));
                *(uint4*)(xb + idx) = make_uint4(pk2(a.x, a.y), pk2(a.z, a.w), pk2(b.x, b.y), pk2(b.z, b.w));
            }
            continue;
        } it -= N_X;
        if (it < N_ROPE) {
            const int e = it * 256 + tid, pos = e >> 5, i = e & 31;
            const float inv = 1.0f / powf(10000.0f, (float)(2 * i) / 64.0f);
            const float ang = (float)pos * inv;
            ((float*)(ws + WS_ROPE))[e] = (float)cos((double)ang);
            ((float*)(ws + WS_ROPE))[4096 * 32 + e] = (float)sin((double)ang);
            continue;
        } it -= N_ROPE;
        if (it < N_CB) {
            const int kv = it >> 3, j0 = (it & 7) * 16, j = j0 + (tid & 15), sl = tid >> 4;
            const float* pe = P.in[kv ? 3 : 2]; const float* w1 = P.in[kv ? 6 : 4];
            float a = 0.f;
            for (int i = sl * 128; i < sl * 128 + 128; ++i) a += pe[i] * w1[(size_t)i * 128 + j];
            sf[tid] = a; __syncthreads();
            if (tid < 16) { float t = 0.f; for (int q = 0; q < 16; ++q) t += sf[q * 16 + tid]; ((float*)(ws + WS_CBIAS))[kv * 128 + j0 + tid] = t; }
            __syncthreads();
            continue;
        } it -= N_CB;
        if (it < N_AL) {
            const int e = it * 256 + tid, g = e >> 6, p = e & 63;
            const CF a = s5_apow(P, g, p, 32.f);
            ((float*)(ws + WS_S5AL))[e * 2] = a.re; ((float*)(ws + WS_S5AL))[e * 2 + 1] = a.im;
            continue;
        } it -= N_AL;
        if (it < N_BTE) {
            const int e = it * 256 + tid, g = e >> 11, p = (e >> 5) & 63, r = e & 31;
            const CF w = cmul(s5_apow(P, g, p, (float)(31 - r)), s5_f(P, g, p));
            bf16_t* d = (bf16_t*)(ws + WS_BTE) + (size_t)g * 128 * 512;
#pragma unroll
            for (int c = 0; c < 16; ++c) {
                const CF bb = {P.in[11][(g * 64 + p) * 16 + c], P.in[12][(g * 64 + p) * 16 + c]};
                const CF v = cmul(w, bb);
                d[(size_t)p * 512 + r * 16 + c] = f2bf(v.re);
                d[(size_t)(64 + p) * 512 + r * 16 + c] = f2bf(v.im);
            }
            continue;
        } it -= N_BTE;
        if (it < N_BTYM) {
            const int g = it / 63, dd = it % 63 - 31, ch = tid >> 4, c = tid & 15;
            float val = 0.f;
            if (dd >= 0) {
                float* sw = sf; float* sb = sf + 128; float* sc = sf + 128 + 2048;
                if (tid < 64) { const CF w = cmul(s5_apow(P, g, tid, (float)dd), s5_f(P, g, tid)); sw[2 * tid] = w.re; sw[2 * tid + 1] = w.im; }
#pragma unroll
                for (int i = 0; i < 4; ++i) {
                    const int e = tid + 256 * i;
                    sb[2 * e] = P.in[11][(size_t)g * 1024 + e]; sb[2 * e + 1] = P.in[12][(size_t)g * 1024 + e];
                    sc[2 * e] = P.in[13][(size_t)g * 1024 + e]; sc[2 * e + 1] = P.in[14][(size_t)g * 1024 + e];
                }
                __syncthreads();
#pragma unroll 8
                for (int p = 0; p < 64; ++p) {
                    const CF bb = {sb[2 * (p * 16 + c)], sb[2 * (p * 16 + c) + 1]};
                    const CF cc = {sc[2 * (ch * 64 + p)], sc[2 * (ch * 64 + p) + 1]};
                    const CF w = {sw[2 * p], sw[2 * p + 1]};
                    val += cmul(cc, cmul(w, bb)).re;
                }
                __syncthreads();
            }
            bf16_t* d = (bf16_t*)(ws + WS_BTY) + (size_t)g * 512 * 640;
            const bf16_t hv = f2bf(val);
            for (int r = 0; r < 32; ++r) { const int s = r + dd; if (s >= 0 && s < 32) d[(size_t)(s * 16 + ch) * 640 + r * 16 + c] = hv; }
            continue;
        } it -= N_BTYM;
        if (it < N_BTYQ) {
            const int e = it * 256 + tid, g = e >> 15, s = (e >> 10) & 31, ch = (e >> 6) & 15, p = e & 63;
            const CF cc = {P.in[13][(g * 16 + ch) * 64 + p], P.in[14][(g * 16 + ch) * 64 + p]};
            const CF w = cmul(cc, s5_apow(P, g, p, (float)(s + 1)));
            bf16_t* d = (bf16_t*)(ws + WS_BTY) + ((size_t)g * 512 + s * 16 + ch) * 640 + 512;
            d[p] = f2bf(w.re); d[64 + p] = f2bf(-w.im);
            continue;
        } it -= N_BTYQ;
        {
            uint4* d = (uint4*)((bf16_t*)(ws + WS_WIN0) + (size_t)(1304 + it * 8) * 1024);
#pragma unroll
            for (int i = 0; i < 4; ++i) d[i * 256 + tid] = make_uint4(0, 0, 0, 0);
        }
    }
}

DI void phase_inproj0(const Params& P, unsigned char* smem) {
    unsigned char* ws = P.ws;
    const bf16_t* A = (const bf16_t*)(ws + WS_ACTB);
    const float* cosT = (const float*)(ws + WS_ROPE);
    const float* sinT = cosT + 4096 * 32;
    constexpr int NTN = NIN0 / 128;
    bool pre = false;
    for (int it = vblock(); it < (NT / 128) * NTN; it += gridDim.x) {
        int mt, nt; tile_mn(it, NTN, mt, nt);
        const int m0 = mt * 128;
        auto rowptr = [=](int r) { return A + (size_t)(m0 + r) * 1024; };
        const bf16_t* Bt = (const bf16_t*)(ws + WS_WIN0) + (size_t)nt * 128 * 1024;
        const bool hn = it + (int)gridDim.x < (NT / 128) * NTN;
        int mtn = 0, ntn = 0; if (hn) tile_mn(it + gridDim.x, NTN, mtn, ntn);
        auto nextrow = [=](int r) { return A + (size_t)(mtn * 128 + r) * 1024; };
        const bf16_t* nBt = (const bf16_t*)(ws + WS_WIN0) + (size_t)ntn * 128 * 1024;
        if (nt == 7 || nt == 9) {
            auto epi = [=](f32x4 (&acc)[4][4], int wr, int wc, int lane) {
                const int fr = lane & 15, fq = lane >> 4, which = nt == 7 ? 3 : 5, g = wc;
#pragma unroll
                for (int m = 0; m < 4; ++m) {
                    const int t = m0 + wr * 64 + m * 16 + fq * 4, s = t & 4095, b = t >> 12;
                    bf16_t* dst = (bf16_t*)(ws + XP_KC + (size_t)which * KVSZ) + (size_t)(b * 2 + g) * 4096 * 64;
#pragma unroll
                    for (int n = 0; n < 4; ++n) *(u32x2*)(dst + vp_off(s, n * 16 + fr)) = cvt4(acc[m][n]);
                }
            };
            gemm128s<false>(rowptr, Bt, 1024, 1024, smem, epi, pre, hn, nextrow, nBt);
            pre = hn;
            continue;
        }
        auto epi = [=](f32x4 (&acc)[4][4], int wr, int wc, int lane) {
            const int u64 = nt * 2 + wc, fr = lane & 15, fq = lane >> 4;
#pragma unroll
            for (int m = 0; m < 4; ++m) {
                const int t = m0 + wr * 64 + m * 16 + fr, s = t & 4095, b = t >> 12;
                if (u64 < 20) {
                    const bool isq = u64 < 8;
                    const int which = (u64 - 8) >> 1, g = (u64 - 8) & 1;
                    if (isq || ((which & 1) == 0)) {
                        f32x4 r1[2], r2[2];
#pragma unroll
                        for (int n2 = 0; n2 < 2; ++n2) {
                            const int i = 8 * fq + 4 * n2;
                            const f32x4 c = *(const f32x4*)(cosT + s * 32 + i), sn = *(const f32x4*)(sinT + s * 32 + i);
                            const f32x4 x1 = acc[m][2 * n2], x2 = acc[m][2 * n2 + 1];
                            r1[n2] = x1 * c - x2 * sn; r2[n2] = x1 * sn + x2 * c;
                        }
                        const u32x4 o1 = cvt44(r1[0], r1[1]), o2 = cvt44(r2[0], r2[1]);
                        if (isq) { bf16_t* dst = (bf16_t*)(ws + XP_Q0) + (size_t)t * 512 + u64 * 64; *(u32x4*)(dst + 8 * fq) = o1; *(u32x4*)(dst + 8 * fq + 32) = o2; }
                        else {
                            bf16_t* dst = (bf16_t*)(ws + XP_KC + (size_t)which * KVSZ) + (size_t)(b * 2 + g) * 4096 * 64;
                            if (which == 0) { *(u32x4*)(dst + (size_t)s * 64 + 8 * fq) = o1; *(u32x4*)(dst + (size_t)s * 64 + 8 * fq + 32) = o2; }
                            else { *(u32x4*)(dst + kp_off(s, 8 * fq)) = o1; *(u32x4*)(dst + kp_off(s, 8 * fq + 32)) = o2; }
                        }
                    } else {
                        bf16_t* dst = (bf16_t*)(ws + XP_KC + (size_t)which * KVSZ) + ((size_t)(b * 2 + g) * 4096 + s) * 64;
#pragma unroll
                        for (int n = 0; n < 4; ++n) *(u32x2*)(dst + n * 16 + fq * 4) = cvt4(acc[m][n]);
                    }
                } else if (u64 == 20) {
#pragma unroll
                    for (int n = 0; n < 2; ++n) {
                        const int c0 = n * 16 + fq * 4;
                        if (c0 < 24) { f32x4 o; o.x = sigmoidf_(acc[m][n].x); o.y = sigmoidf_(acc[m][n].y); o.z = sigmoidf_(acc[m][n].z); o.w = sigmoidf_(acc[m][n].w); *(f32x4*)((float*)(ws + XP_GATES) + (size_t)t * 24 + c0) = o; }
                    }
                } else if (u64 >= 22) {
#pragma unroll
                    for (int n = 0; n < 4; ++n) {
                        const int g5 = (u64 - 22) * 4 + n;
                        *(u32x2*)((bf16_t*)(ws + XP_AEXT) + ((size_t)g5 * 1024 + (t >> 5)) * 640 + (t & 31) * 16 + fq * 4) = cvt4(acc[m][n]);
                    }
                }
            }
        };
        gemm128s(rowptr, Bt, 1024, 1024, smem, epi, pre, hn, nextrow, nBt);
        pre = hn;
    }
}

constexpr int N_LATE = 16 * 48 + 256 + 3 * 64 * 32;
DI void late_weights(const Params& P, unsigned char* smem, int it) {
    unsigned char* ws = P.ws;
    float* sf = (float*)smem;
    constexpr int N_TR2 = 16 * 48, N_TR3 = 256, N_TRG = 64 * 32, N_TRU = 64 * 32;
    if (it < N_TR2) { tr_tile(P.in[19], 1024, 3072, (bf16_t*)(ws + WS_WIN1), 4, it / 48, it % 48, sf); return; } it -= N_TR2;
    if (it < N_TR3) { tr_tile<true>(P.in[20], 1024, 1024, (bf16_t*)(ws + WS_WOUT1), 5, it / 16, it % 16, sf); return; } it -= N_TR3;
    if (it < N_TRG) { const int mat = it >> 5, r = it & 31; tr_tile(P.in[29] + (size_t)mat * 1024 * 128, 1024, 128, (bf16_t*)(ws + WS_WGU) + (size_t)mat * 256 * 1024, 2, r >> 1, r & 1, sf); return; } it -= N_TRG;
    if (it < N_TRU) { const int mat = it >> 5, r = it & 31; tr_tile(P.in[30] + (size_t)mat * 1024 * 128, 1024, 128, (bf16_t*)(ws + WS_WGU) + (size_t)mat * 256 * 1024, 3, r >> 1, r & 1, sf); return; } it -= N_TRU;
    { const int mat = it >> 5, r = it & 31; tr_tile(P.in[31] + (size_t)mat * 128 * 1024, 128, 1024, (bf16_t*)(ws + WS_WDN) + (size_t)mat * 1024 * 128, 5, r >> 4, r & 15, sf); }
}

DI void s5y_tile(const Params& P, unsigned char* smem, int g, int mt, int nt);
DI void phase_cmp_s5e(const Params& P, unsigned char* smem) {
    unsigned char* ws = P.ws;
    const int tid = threadIdx.x, lane = tid & 63, wave = tid >> 6;
    const int G = gridDim.x, bid = blockIdx.x;
    const bool split = G >= 384;
    const int nmine = !split ? (320 + N_LATE + G - 1 - bid) / G : (bid < 320 ? 1 : (N_LATE + (G - 320) - 1 - (bid - 320)) / (G - 320));
    for (int k = 0; k < nmine; ++k) {
        const int it = !split ? bid + k * G : (bid < 320 ? bid : 320 + (bid - 320) + k * (G - 320));
        if (it >= 64 + 256) { late_weights(P, smem, it - 320); continue; }
        if (it < 64) {
            const int kv = it >> 5, bg = (it >> 1) & 15, mt = it & 1;
            const bf16_t* src = (const bf16_t*)(ws + XP_KC + (size_t)kv * KVSZ) + (size_t)bg * 4096 * 64;
            const float* cb = (const float*)(ws + WS_CBIAS) + kv * 128;
            bf16_t* sH = (bf16_t*)smem;
            auto rowptr = [=](int r) { int rr = mt * 128 + r; rr = rr > 254 ? 254 : rr; return src + (size_t)rr * 1024; };
            auto epi = [=](f32x4 (&acc)[4][4], int wr, int wc, int ln) {
                const int fr = ln & 15, fq = ln >> 4;
#pragma unroll
                for (int m = 0; m < 4; ++m)
#pragma unroll
                    for (int n = 0; n < 4; ++n)
#pragma unroll
                        for (int j = 0; j < 4; ++j) {
                            const int r = wr * 64 + m * 16 + fr, c = wc * 64 + n * 16 + fq * 4 + j;
                            sH[r * 136 + c] = f2bf(gelu_tanh(acc[m][n][j] + cb[c]));
                        }
            };
            gemm128(rowptr, (const bf16_t*)(ws + (kv ? WS_WCV1 : WS_WCK1)), 2048, 2048, smem, epi);
            __syncthreads();
            const bf16_t* W2 = (const bf16_t*)(ws + (kv ? WS_WCV2 : WS_WCK2));
            f32x4 a2[2][4];
#pragma unroll
            for (int m = 0; m < 2; ++m)
#pragma unroll
                for (int n = 0; n < 4; ++n) a2[m][n] = (f32x4){0.f, 0.f, 0.f, 0.f};
#pragma unroll
            for (int ks = 0; ks < 4; ++ks) {
                bf16x8 af[2], bfr[4];
#pragma unroll
                for (int m = 0; m < 2; ++m) af[m] = *(const bf16x8*)(sH + (wave * 32 + m * 16 + (lane & 15)) * 136 + ks * 32 + (lane >> 4) * 8);
#pragma unroll
                for (int n = 0; n < 4; ++n) bfr[n] = *(const bf16x8*)(W2 + (n * 16 + (lane & 15)) * 128 + ks * 32 + (lane >> 4) * 8);
#pragma unroll
                for (int m = 0; m < 2; ++m)
#pragma unroll
                    for (int n = 0; n < 4; ++n) a2[m][n] = __builtin_amdgcn_mfma_f32_16x16x32_bf16(af[m], bfr[n], a2[m][n], 0, 0, 0);
            }
            bf16_t* dst = (bf16_t*)(ws + (kv ? WS_VCMP : WS_KCMP)) + (size_t)bg * 256 * 64;
#pragma unroll
            for (int m = 0; m < 2; ++m)
#pragma unroll
                for (int n = 0; n < 4; ++n)
#pragma unroll
                    for (int j = 0; j < 4; ++j) {
                        const int row = mt * 128 + wave * 32 + m * 16 + (lane >> 4) * 4 + j, col = n * 16 + (lane & 15);
                        dst[kv ? vp_off(row, col) : kp_off(row, col)] = row < 255 ? f2bf(a2[m][n][j]) : (bf16_t)0;
                    }
            __syncthreads();
        } else {
            const int it2 = it - 64, g = it2 >> 3, b = it2 & 7;
            bf16_t* aext = (bf16_t*)(ws + XP_AEXT) + ((size_t)g * 1024 + b * 128) * 640;
            float* sE = (float*)smem;
            auto rowptr = [=](int r) { return (const bf16_t*)aext + (size_t)r * 640; };
            auto epi = [=](f32x4 (&acc)[4][4], int wr, int wc, int ln) {
                const int fr = ln & 15, fq = ln >> 4;
#pragma unroll
                for (int m = 0; m < 4; ++m)
#pragma unroll
                    for (int n = 0; n < 4; ++n)
#pragma unroll
                        for (int j = 0; j < 4; ++j) sE[(wr * 64 + m * 16 + fr) * 129 + wc * 64 + n * 16 + fq * 4 + j] = acc[m][n][j];
            };
            gemm128<true, false>(rowptr, (const bf16_t*)(ws + WS_BTE) + (size_t)g * 128 * 512, 512, 512, smem, epi);
            __syncthreads();
            {
                const int p = tid & 63, c0 = wave * 32;
                const float ar = ((const float*)(ws + WS_S5AL))[(g * 64 + p) * 2], ai = ((const float*)(ws + WS_S5AL))[(g * 64 + p) * 2 + 1];
                float* send = (float*)(smem + 128 * 129 * 4);
                float xr = 0.f, xi = 0.f;
                for (int c = c0; c < c0 + 32; ++c) {
                    const float er = sE[c * 129 + p], ei = sE[c * 129 + 64 + p];
                    const float nr = ar * xr - ai * xi + er, ni = ar * xi + ai * xr + ei;
                    xr = nr; xi = ni;
                }
                send[(wave * 64 + p) * 2] = xr; send[(wave * 64 + p) * 2 + 1] = xi;
                float qr = ar, qi = ai;
#pragma unroll
                for (int k = 0; k < 5; ++k) { const float tr = qr * qr - qi * qi, ti = 2.f * qr * qi; qr = tr; qi = ti; }
                __syncthreads();
                xr = 0.f; xi = 0.f;
                for (int k = 0; k < wave; ++k) {
                    const float er = send[(k * 64 + p) * 2], ei = send[(k * 64 + p) * 2 + 1];
                    const float nr = qr * xr - qi * xi + er, ni = qr * xi + qi * xr + ei;
                    xr = nr; xi = ni;
                }
                for (int c = c0; c < c0 + 32; ++c) {
                    aext[(size_t)c * 640 + 512 + p] = f2bf(xr);
                    aext[(size_t)c * 640 + 576 + p] = f2bf(xi);
                    const float er = sE[c * 129 + p], ei = sE[c * 129 + 64 + p];
                    const float nr = ar * xr - ai * xi + er, ni = ar * xi + ai * xr + ei;
                    xr = nr; xi = ni;
                }
            }
            asm volatile("s_waitcnt vmcnt(0)" ::: "memory");
            __syncthreads();
#pragma unroll 1
            for (int nt = 0; nt < 4; ++nt) s5y_tile(P, smem, g, b, nt);
        }
    }
}

DI void s5y_tile(const Params& P, unsigned char* smem, int g, int mt, int nt) {
    unsigned char* ws = P.ws;
    const bf16_t* aext = (const bf16_t*)(ws + XP_AEXT) + (size_t)g * 1024 * 640;
    const float* dsk = P.in[15];
    auto rowptr = [=](int r) { return aext + (size_t)(mt * 128 + r) * 640; };
    auto epi = [=](f32x4 (&acc)[4][4], int wr, int wc, int ln) {
        const int fr = ln & 15, fq = ln >> 4;
        const f32x4 dk = *(const f32x4*)(dsk + g * 16 + fq * 4);
#pragma unroll
        for (int m = 0; m < 4; ++m) {
            const int cr = mt * 128 + wr * 64 + m * 16 + fr;
#pragma unroll
            for (int n = 0; n < 4; ++n) {
                const int sp = nt * 8 + wc * 4 + n, t = cr * 32 + sp;
                const f32x4 u = bf4_to_f(*(const u32x2*)(aext + (size_t)cr * 640 + sp * 16 + fq * 4));
                const f32x4 y = acc[m][n] + dk * u;
                *(u32x2*)((bf16_t*)(ws + XP_G5) + (size_t)t * 512 + g * 16 + fq * 4) = cvt4((f32x4){gelu_tanh(y.x), gelu_tanh(y.y), gelu_tanh(y.z), gelu_tanh(y.w)});
            }
        }
    };
    gemm128<true, false>(rowptr, (const bf16_t*)(ws + WS_BTY) + ((size_t)g * 512 + nt * 128) * 640, 640, 640, smem, epi, 2 * nt + 2, 8);
}
struct FA { f32x16 o0, o1; float m, l; };
DI void fa_init(FA& st) {
#pragma unroll
    for (int i = 0; i < 16; ++i) { st.o0[i] = 0.f; st.o1[i] = 0.f; }
    st.m = -1e30f; st.l = 0.f;
}
constexpr float FA_THR = 8.f;
template <int MODE, class Valid>
DI void fa_tile(FA& st, const bf16x8 (&qf)[4], const LAS bf16_t* Kt, const LAS bf16_t* Vt, int r, int h, float c, bool rowok, Valid valid) {
    const LAS bf16_t* kb = Kt + r * 16 + 8 * h;
    const LAS bf16_t* vb = Vt + r * 16 + 8 * h;
    bf16x8 kf[4], vf[4];
#pragma unroll
    for (int ks = 0; ks < 4; ++ks) kf[ks] = *(const LAS bf16x8*)(kb + ks * 512);
#pragma unroll
    for (int sub = 0; sub < 2; ++sub) {
        f32x16 acc;
#pragma unroll
        for (int i = 0; i < 16; ++i) acc[i] = 0.f;
#pragma unroll
        for (int ks = 0; ks < 4; ++ks) acc = MFMA32(kf[ks], qf[ks], acc);
#pragma unroll
        for (int s2 = 0; s2 < 2; ++s2) { vf[2 * s2] = *(const LAS bf16x8*)(vb + ((sub * 2 + s2) * 64) * 16); vf[2 * s2 + 1] = *(const LAS bf16x8*)(vb + ((sub * 2 + s2) * 64 + 32) * 16); }
        if (sub == 0) {
#pragma unroll
            for (int ks = 0; ks < 4; ++ks) kf[ks] = *(const LAS bf16x8*)(kb + (4 + ks) * 512);
        }
        __builtin_amdgcn_sched_barrier(0);
        float mx = -INFINITY;
#pragma unroll
        for (int i = 0; i < 16; ++i) {
            if (MODE == 2) { const int koff = sub * 32 + (i & 3) + 8 * (i >> 2) + 4 * h; acc[i] = valid(koff) ? acc[i] : -INFINITY; }
            mx = fmaxf(mx, acc[i]);
        }
        {
            const auto sw = __builtin_amdgcn_permlane32_swap(__float_as_uint(mx), __float_as_uint(mx), false, false);
            mx = fmaxf(__uint_as_float(sw[0]), __uint_as_float(sw[1]));
        }
        const float cand = mx * c;
        const bool upd = cand > st.m + FA_THR;
        if (__ballot(upd)) {
            const float mn = upd ? cand : st.m, alpha = __builtin_amdgcn_exp2f(st.m - mn);
            st.m = mn; st.l *= alpha;
#pragma unroll
            for (int i = 0; i < 16; ++i) { st.o0[i] *= alpha; st.o1[i] *= alpha; }
        }
        const float nb = (MODE == 1 && !rowok) ? -INFINITY : -st.m;
        float ps0 = 0.f, ps1 = 0.f;
#pragma unroll
        for (int i = 0; i < 16; i += 2) {
            acc[i] = __builtin_amdgcn_exp2f(__builtin_fmaf(acc[i], c, nb));
            acc[i + 1] = __builtin_amdgcn_exp2f(__builtin_fmaf(acc[i + 1], c, nb));
            ps0 += acc[i]; ps1 += acc[i + 1];
        }
        st.l += ps0 + ps1;
#pragma unroll
        for (int s2 = 0; s2 < 2; ++s2) {
            const bf16x8 pk = cvt8((f32x8){acc[8 * s2], acc[8 * s2 + 1], acc[8 * s2 + 2], acc[8 * s2 + 3], acc[8 * s2 + 4], acc[8 * s2 + 5], acc[8 * s2 + 6], acc[8 * s2 + 7]});
            st.o0 = MFMA32(vf[2 * s2], pk, st.o0);
            st.o1 = MFMA32(vf[2 * s2 + 1], pk, st.o1);
        }
    }
}
DI void fa_issue(const bf16_t* gK, const bf16_t* gV, LAS unsigned char* buf, int tid) {
    __builtin_amdgcn_global_load_lds((const unsigned*)(gK + tid * 8), (LAS unsigned*)(buf + tid * 16), 16, 0, 0);
    __builtin_amdgcn_global_load_lds((const unsigned*)(gK + (tid + 256) * 8), (LAS unsigned*)(buf + (tid + 256) * 16), 16, 0, 0);
    __builtin_amdgcn_global_load_lds((const unsigned*)(gV + tid * 8), (LAS unsigned*)(buf + 8192 + tid * 16), 16, 0, 0);
    __builtin_amdgcn_global_load_lds((const unsigned*)(gV + (tid + 256) * 8), (LAS unsigned*)(buf + 8192 + (tid + 256) * 16), 16, 0, 0);
}
DI void fa_wait(int j, int n) {
    const int rem = n - 1 - j;
    if (rem >= 2) asm volatile("s_waitcnt vmcnt(8)" ::: "memory");
    else if (rem == 1) asm volatile("s_waitcnt vmcnt(4)" ::: "memory");
    else asm volatile("s_waitcnt vmcnt(0)" ::: "memory");
    __builtin_amdgcn_s_barrier();
    asm volatile("" ::: "memory");
}

constexpr int NSA_LDS_IMP = 65536;
constexpr int NSA_LDS_SCS = NSA_LDS_IMP + 8192;
constexpr int NSA_LDS_MSK = NSA_LDS_SCS + 1024;
DI void phase_nsa(const Params& P, unsigned char* smem) {
    unsigned char* ws = P.ws;
    const int tid = threadIdx.x, lane = tid & 63, wave = tid >> 6, r = lane & 31, h = lane >> 5;
    const float c = 0.125f * 1.4426950408889634f;
    LAS unsigned char* lds = (LAS unsigned char*)smem;
    float* impw = (float*)(smem + NSA_LDS_IMP) + wave * 512;
    float* scs = (float*)(smem + NSA_LDS_SCS) + wave * 64;
    unsigned long long* mskw = (unsigned long long*)(smem + NSA_LDS_MSK) + wave * 8;
    for (int it = blockIdx.x; it < 2048; it += gridDim.x) {
        const int qt = 127 - (it >> 4), bg = it & 15, b = bg >> 1, g = bg & 1, t0 = qt * 32, qblk = t0 >> 6;
        const int ql = r >> 2, z = r & 3, s = t0 + wave * 8 + ql, t = b * 4096 + s;
        const bf16_t* Qg = (const bf16_t*)(ws + XP_Q0) + (size_t)t * 512 + (g * 4 + z) * 64;
        bf16x8 qf[4];
#pragma unroll
        for (int ks = 0; ks < 4; ++ks) qf[ks] = *(const bf16x8*)(Qg + ks * 16 + 8 * h);
        const float* gt = (const float*)(ws + XP_GATES) + (size_t)t * 24 + (g * 4 + z) * 3;
        const float g_c = gt[0], g_s = gt[1], g_w = gt[2];
        const bf16_t* Kc = (const bf16_t*)(ws + WS_KCMP) + (size_t)bg * 256 * 64;
        const bf16_t* Vc = (const bf16_t*)(ws + WS_VCMP) + (size_t)bg * 256 * 64;
        const bf16_t* Ks = (const bf16_t*)(ws + XP_KC + 2 * KVSZ) + (size_t)bg * 4096 * 64;
        const bf16_t* Vs = (const bf16_t*)(ws + XP_KC + 3 * KVSZ) + (size_t)bg * 4096 * 64;
        const bf16_t* Kw = (const bf16_t*)(ws + XP_KC + 4 * KVSZ) + (size_t)bg * 4096 * 64;
        const bf16_t* Vw = (const bf16_t*)(ws + XP_KC + 5 * KVSZ) + (size_t)bg * 4096 * 64;
        const int nct = ((t0 >> 4) + 1 + 63) >> 6;
        const int w0 = (t0 - 255) < 0 ? 0 : (t0 - 255) >> 6;
        const int e1 = nct, e2 = 2 * nct, e3 = e2 + qblk + 1, e4 = e3 + (qblk - w0 + 1);
        const int nc = s >= 31 ? ((s - 31) >> 4) + 1 : 0;
        const int s_lo = t0 + wave * 8, s_hi = s_lo + 7, nc_min = s_lo >= 31 ? ((s_lo - 31) >> 4) + 1 : 0;
        for (int i = lane; i < 512; i += 64) impw[i] = 0.f;
        auto tile_ptrs = [&](int i, const bf16_t*& gk, const bf16_t*& gv) {
            if (i < e1) { gk = Kc + (size_t)i * 4096; gv = Vc + (size_t)i * 4096; }
            else if (i < e2) { gk = Kc + (size_t)(i - e1) * 4096; gv = Vc + (size_t)(i - e1) * 4096; }
            else if (i < e3) { gk = Ks + (size_t)(i - e2) * 4096; gv = Vs + (size_t)(i - e2) * 4096; }
            else { gk = Kw + (size_t)(w0 + i - e3) * 4096; gv = Vw + (size_t)(w0 + i - e3) * 4096; }
        };
        FA st; fa_init(st);
        f32x16 out0, out1;
#pragma unroll
        for (int i = 0; i < 16; ++i) { out0[i] = 0.f; out1[i] = 0.f; }
        float m_c = -1e30f, il_c = 0.f;
        unsigned long long mymask = 0ull;
        asm volatile("s_waitcnt vmcnt(0)" ::: "memory");
        __builtin_amdgcn_s_barrier();
#pragma unroll
        for (int i = 0; i < 3; ++i) if (i < e4) { const bf16_t *gk, *gv; tile_ptrs(i, gk, gv); fa_issue(gk, gv, lds + i * 16384, tid); }
        auto step = [&](int i) -> const LAS bf16_t* {
            fa_wait(i, e4);
            if (i + 3 < e4) { const bf16_t *gk, *gv; tile_ptrs(i + 3, gk, gv); fa_issue(gk, gv, lds + ((i + 3) & 3) * 16384, tid); }
            return (const LAS bf16_t*)(lds + (i & 3) * 16384);
        };
        int i = 0;
        for (; i < e1; ++i) {
            const LAS bf16_t* cur = step(i);
            const int nb = i * 64;
            if (nb + 63 < nc_min) fa_tile<0>(st, qf, cur, cur + 4096, r, h, c, true, [=](int) { return true; }); else fa_tile<2>(st, qf, cur, cur + 4096, r, h, c, true, [=](int koff) { return nb + koff < nc; });
        }
        {
            const float l = st.l + __shfl_xor(st.l, 32);
            il_c = 1.f / fmaxf(l, 1e-30f); m_c = st.m;
            const float f = g_c * il_c;
#pragma unroll
            for (int k = 0; k < 16; ++k) { out0[k] = st.o0[k] * f; out1[k] = st.o1[k] * f; }
            fa_init(st);
        }
        for (; i < e2; ++i) {
            const LAS bf16_t* cur = step(i);
            const int nb = (i - e1) * 64;
#pragma unroll
            for (int sub = 0; sub < 2; ++sub) {
                f32x16 acc;
#pragma unroll
                for (int k = 0; k < 16; ++k) acc[k] = 0.f;
#pragma unroll
                for (int ks = 0; ks < 4; ++ks) acc = MFMA32(*(const LAS bf16x8*)(cur + ((sub * 4 + ks) * 32 + r) * 16 + 8 * h), qf[ks], acc);
#pragma unroll
                for (int q4 = 0; q4 < 4; ++q4) {
                    float p[4];
#pragma unroll
                    for (int k = 0; k < 4; ++k) {
                        const int n = nb + sub * 32 + 8 * q4 + 4 * h + k;
                        p[k] = (n < nc) ? __builtin_amdgcn_exp2f(acc[4 * q4 + k] * c - m_c) * il_c : 0.f;
                    }
                    float a = (p[0] + p[1]) + (p[2] + 0.5f * p[3]), cn = 0.5f * p[3];
                    a += __shfl_xor(a, 1); a += __shfl_xor(a, 2);
                    cn += __shfl_xor(cn, 1); cn += __shfl_xor(cn, 2);
                    const int jb = ((nb + sub * 32) >> 2) + 2 * q4 + h;
                    if (z == 0) { atomicAdd(&impw[ql * 64 + jb], a); if (jb + 1 < 64) atomicAdd(&impw[ql * 64 + jb + 1], cn); }
                }
            }
        }
        {
            __builtin_amdgcn_wave_barrier();
#pragma unroll 1
            for (int qq = 0; qq < 8; ++qq) {
                const int j = lane;
                const float imp = impw[qq * 64 + j];
                const float score = (j > qblk) ? -1.f : ((j == 0 || j == qblk || j == qblk - 1) ? 1e3f : imp);
                scs[j] = score;
                __builtin_amdgcn_wave_barrier();
                int rank = 0;
#pragma unroll 8
                for (int jj = 0; jj < 64; ++jj) { const float o = scs[jj]; rank += (o > score || (o == score && jj < j)) ? 1 : 0; }
                const unsigned long long mk = __ballot(rank < 8 && score >= 0.f);
                if (lane == 0) mskw[qq] = mk;
                __builtin_amdgcn_wave_barrier();
            }
            mymask = mskw[ql];
        }
        for (; i < e3 - 1; ++i) {
            const LAS bf16_t* cur = step(i);
            const bool sel = (mymask >> (i - e2)) & 1ull;
            if (__ballot(sel)) fa_tile<1>(st, qf, cur, cur + 4096, r, h, c, sel, [=](int) { return true; });
        }
        {
            const LAS bf16_t* cur = step(i);
            const int kb = qblk * 64;
            fa_tile<2>(st, qf, cur, cur + 4096, r, h, c, true, [=](int koff) { return kb + koff <= s; });
            ++i;
            const float l = st.l + __shfl_xor(st.l, 32);
            const float f = g_s / fmaxf(l, 1e-30f);
#pragma unroll
            for (int k = 0; k < 16; ++k) { out0[k] += st.o0[k] * f; out1[k] += st.o1[k] * f; }
            fa_init(st);
        }
        for (; i < e4; ++i) {
            const LAS bf16_t* cur = step(i);
            const int kb = (w0 + i - e3) * 64;
            if (kb >= s_hi - 255 && kb + 63 <= s_lo) fa_tile<0>(st, qf, cur, cur + 4096, r, h, c, true, [=](int) { return true; }); else fa_tile<2>(st, qf, cur, cur + 4096, r, h, c, true, [=](int koff) { const int key = kb + koff; return key <= s && key >= s - 255; });
        }
        {
            const float l = st.l + __shfl_xor(st.l, 32);
            const float f = g_w / fmaxf(l, 1e-30f);
#pragma unroll
            for (int k = 0; k < 16; ++k) { out0[k] += st.o0[k] * f; out1[k] += st.o1[k] * f; }
        }
        nat_store((bf16_t*)(ws + WS_MIX) + (size_t)t * 1024 + (g * 4 + z) * 64, h, out0, out1, 1.f);
    }
}

DI void phase_glu(const Params& P, unsigned char* smem) {
    unsigned char* ws = P.ws;
    const bf16_t* G5 = (const bf16_t*)(ws + XP_G5);
    const float* gb = P.in[17];
    bool pre = false;
    for (int it = vblock(); it < (NT / 128) * 4; it += gridDim.x) {
        int mt, nt; tile_mn(it, 4, mt, nt);
        const int m0 = mt * 128;
        const bool hn = it + (int)gridDim.x < (NT / 128) * 4;
        int mtn = 0, ntn = 0; if (hn) tile_mn(it + gridDim.x, 4, mtn, ntn);
        auto nextrow = [=](int r) { return G5 + (size_t)(mtn * 128 + r) * 512; };
        auto rowptr = [=](int r) { return G5 + (size_t)(m0 + r) * 512; };
        auto epi = [=](f32x4 (&acc)[4][4], int wr, int wc, int ln) {
            const int fr = ln & 15, fq = ln >> 4;
#pragma unroll
            for (int m = 0; m < 4; ++m) {
                const int row = m0 + wr * 64 + m * 16 + fr;
#pragma unroll
                for (int q = 0; q < 2; ++q) {
                    const int col = nt * 128 + wc * 64 + q * 32 + fq * 8;
                    const u32x4 gw = *(const u32x4*)(G5 + (size_t)row * 512 + col);
                    f32x4 o[2];
#pragma unroll
                    for (int e = 0; e < 2; ++e) {
                        const f32x4 gv = bf4_to_f(e == 0 ? (u32x2){gw.x, gw.y} : (u32x2){gw.z, gw.w}), bb = *(const f32x4*)(gb + col + 4 * e), z = acc[m][2 * q + e] + bb;
                        o[e] = (f32x4){gv.x * sigmoidf_(z.x), gv.y * sigmoidf_(z.y), gv.z * sigmoidf_(z.z), gv.w * sigmoidf_(z.w)};
                    }
                    *(u32x4*)((bf16_t*)(ws + WS_MIX) + (size_t)row * 1024 + 512 + col) = cvt44(o[0], o[1]);
                }
            }
        };
        gemm128s(rowptr, (const bf16_t*)(ws + WS_WGLU) + (size_t)nt * 128 * 512, 512, 512, smem, epi, pre, hn, nextrow, (const bf16_t*)(ws + WS_WGLU) + (size_t)ntn * 128 * 512);
        pre = hn;
    }
}

template <bool RB>
DI void phase_outproj(const Params& P, unsigned char* smem, const float* xres, const bf16_t* xresb, size_t wt_off) {
    unsigned char* ws = P.ws;
    const bf16_t* A = (const bf16_t*)(ws + WS_MIX);
    bf16_t* preb = (bf16_t*)(ws + XP_PRE);
    bool pre = false;
    for (int it = vblock(); it < (NT / 128) * 8; it += gridDim.x) {
        int mt, nt; tile_mn(it, 8, mt, nt);
        const int m0 = mt * 128;
        const bool hn = it + (int)gridDim.x < (NT / 128) * 8;
        int mtn = 0, ntn = 0; if (hn) tile_mn(it + gridDim.x, 8, mtn, ntn);
        auto nextrow = [=](int r) { return A + (size_t)(mtn * 128 + r) * 1024; };
        auto rowptr = [=](int r) { return A + (size_t)(m0 + r) * 1024; };
        auto epi = [=](f32x4 (&acc)[4][4], int wr, int wc, int ln) {
            const int fr = ln & 15, fq = ln >> 4;
#pragma unroll
            for (int m = 0; m < 4; ++m) {
                const size_t base = (size_t)(m0 + wr * 64 + m * 16 + fr) * 1024 + nt * 128 + wc * 64 + fq * 8;
                f32x4 xr[4];
#pragma unroll
                for (int q = 0; q < 2; ++q) {
                    if (RB) { const u32x4 w = *(const u32x4*)(xresb + base + q * 32); xr[2 * q] = bf4_to_f((u32x2){w.x, w.y}); xr[2 * q + 1] = bf4_to_f((u32x2){w.z, w.w}); }
                    else { xr[2 * q] = *(const f32x4*)(xres + base + q * 32); xr[2 * q + 1] = *(const f32x4*)(xres + base + q * 32 + 4); }
                }
#pragma unroll
                for (int q = 0; q < 2; ++q) *(u32x4*)(preb + base + q * 32) = cvt44(xr[2 * q] * ALPHA + acc[m][2 * q], xr[2 * q + 1] * ALPHA + acc[m][2 * q + 1]);
            }
        };
        gemm128s(rowptr, (const bf16_t*)(ws + wt_off) + (size_t)nt * 128 * 1024, 1024, 1024, smem, epi, pre, hn, nextrow, (const bf16_t*)(ws + wt_off) + (size_t)ntn * 128 * 1024);
        pre = hn;
    }
}

DI void ln_row(float (&v)[16], const float* __restrict__ g, const float* __restrict__ bta, int lane) {
    float s = 0.f;
#pragma unroll
    for (int i = 0; i < 16; ++i) s += v[i];
    const float mu = wave_sum(s) * (1.f / 1024.f);
    float q = 0.f;
#pragma unroll
    for (int i = 0; i < 16; ++i) { v[i] -= mu; q += v[i] * v[i]; }
    const float rstd = rsqrtf(wave_sum(q) * (1.f / 1024.f) + LN_EPS);
#pragma unroll
    for (int j = 0; j < 4; ++j) {
        const int col = 8 * lane + 512 * (j >> 1) + 4 * (j & 1);
        const float4 gg = *(const float4*)(g + col), bb = *(const float4*)(bta + col);
        v[4 * j + 0] = v[4 * j + 0] * rstd * gg.x + bb.x; v[4 * j + 1] = v[4 * j + 1] * rstd * gg.y + bb.y;
        v[4 * j + 2] = v[4 * j + 2] * rstd * gg.z + bb.z; v[4 * j + 3] = v[4 * j + 3] * rstd * gg.w + bb.w;
    }
}

DI void phase_ln_router(const Params& P, int layer) {
    unsigned char* ws = P.ws;
    const int lane = threadIdx.x & 63, wave = threadIdx.x >> 6;
    const float* g = P.in[21] + layer * 1024; const float* bta = P.in[22] + layer * 1024;
    const float* wc = (const float*)(ws + WS_RTRW) + (size_t)layer * 36864; const float* bc = P.in[26] + layer * 4;
    const float* wf = wc + 4096; const float* bfn = P.in[28] + layer * 32;
    int* cnt = (int*)(ws + WS_CTL) + layer * 2048;
    int* list = (int*)(ws + WS_LIST2);
    float* wgt = (float*)(ws + WS_WGT);
    bf16_t* xb = (bf16_t*)(ws + WS_ACTB);
    for (int task = blockIdx.x * 4 + wave; task < NT / 16; task += gridDim.x * 4) {
        int my_e = 0; float my_w = 0.f;
        f32x4 wcr[16];
#pragma unroll
        for (int q = 0; q < 16; ++q) wcr[q] = *(const f32x4*)(wc + (q * 64 + lane) * 4);
        const bf16_t* pre = (const bf16_t*)(ws + XP_PRE);
        u32x4 nxb[2];
#pragma unroll
        for (int j = 0; j < 2; ++j) nxb[j] = __builtin_nontemporal_load((const u32x4*)(pre + (size_t)(task * 16) * 1024 + 8 * lane + 512 * j));
#pragma unroll 1
        for (int i = 0; i < 16; ++i) {
            const int t = task * 16 + i;
            float v[16];
#pragma unroll
            for (int j = 0; j < 4; ++j) { const u32x4 w = nxb[j >> 1]; const f32x4 nx = bf4_to_f((j & 1) ? (u32x2){w.z, w.w} : (u32x2){w.x, w.y}); v[4 * j] = nx.x; v[4 * j + 1] = nx.y; v[4 * j + 2] = nx.z; v[4 * j + 3] = nx.w; }
            if (i + 1 < 16) {
#pragma unroll
                for (int j = 0; j < 2; ++j) nxb[j] = __builtin_nontemporal_load((const u32x4*)(pre + (size_t)(t + 1) * 1024 + 8 * lane + 512 * j));
            }
            ln_row(v, g, bta, lane);
#pragma unroll
            for (int j = 0; j < 2; ++j) {
                *(u32x4*)(xb + (size_t)t * 1024 + 8 * lane + 512 * j) = cvt44((f32x4){v[8 * j], v[8 * j + 1], v[8 * j + 2], v[8 * j + 3]}, (f32x4){v[8 * j + 4], v[8 * j + 5], v[8 * j + 6], v[8 * j + 7]});
            }
            float lc[4] = {0.f, 0.f, 0.f, 0.f};
#pragma unroll
            for (int j = 0; j < 4; ++j)
#pragma unroll
                for (int k = 0; k < 4; ++k) {
                    const f32x4 w = wcr[j * 4 + k];
                    const float x = v[4 * j + k];
                    lc[0] += x * w.x; lc[1] += x * w.y; lc[2] += x * w.z; lc[3] += x * w.w;
                }
#pragma unroll
            for (int c = 0; c < 4; ++c) lc[c] = wave_sum(lc[c]) + bc[c];
            int gi = 0; float lm = lc[0];
#pragma unroll
            for (int c = 1; c < 4; ++c) if (lc[c] > lm) { lm = lc[c]; gi = c; }
            gi = __builtin_amdgcn_readfirstlane(gi);
            float den = 0.f;
#pragma unroll
            for (int c = 0; c < 4; ++c) den += expf(lc[c] - lm);
            const float gv = 1.f / den;
            float lf[8] = {0.f, 0.f, 0.f, 0.f, 0.f, 0.f, 0.f, 0.f};
            const float* wfg = wf + (size_t)gi * 8192;
#pragma unroll
            for (int j = 0; j < 4; ++j)
#pragma unroll
                for (int k = 0; k < 4; ++k) {
                    const f32x4 w0 = *(const f32x4*)(wfg + (((j * 4 + k) * 2 + 0) * 64 + lane) * 4), w1 = *(const f32x4*)(wfg + (((j * 4 + k) * 2 + 1) * 64 + lane) * 4);
                    const float x = v[4 * j + k];
                    lf[0] += x * w0.x; lf[1] += x * w0.y; lf[2] += x * w0.z; lf[3] += x * w0.w;
                    lf[4] += x * w1.x; lf[5] += x * w1.y; lf[6] += x * w1.z; lf[7] += x * w1.w;
                }
#pragma unroll
            for (int e = 0; e < 8; ++e) lf[e] = wave_sum(lf[e]) + bfn[gi * 8 + e];
            int e1 = 0; float l1 = lf[0];
#pragma unroll
            for (int e = 1; e < 8; ++e) if (lf[e] > l1) { l1 = lf[e]; e1 = e; }
            int e2 = 0; float l2 = -INFINITY;
#pragma unroll
            for (int e = 0; e < 8; ++e) if (e != e1 && lf[e] > l2) { l2 = lf[e]; e2 = e; }
            const float r = expf(l2 - l1);
            if (lane == i) { my_e = gi * 8 + e1; my_w = gv / (1.f + r); }
            if (lane == 16 + i) { my_e = gi * 8 + e2; my_w = gv * r / (1.f + r); }
        }
        if (lane < 32) {
            const int t = task * 16 + (lane & 15), k = lane >> 4, slot = (task & 63) * 32 + my_e;
            const int pos = atomicAdd(&cnt[slot], 1);
            list[(slot << 10) + pos] = t * 2 + k;
            wgt[t * 2 + k] = my_w;
        }
    }
}

constexpr int MOE_LDS_TAB = 65536;
constexpr int MOE_LDS_ROW = 65536 + 8448;
DI void moe_tables(const int* cnt, unsigned char* smem) {
    int* tab = (int*)(smem + MOE_LDS_TAB);
    if (threadIdx.x < 32) { const int e = threadIdx.x; int run = 0; for (int s = 0; s < 64; ++s) { tab[e * 65 + s] = run; run += cnt[s * 32 + e]; } tab[e * 65 + 64] = run; }
    __syncthreads();
}
DI bool moe_tile(const int* tab, int tile, int& e, int& mt, int& off, int& ce) {
    int acc_t = 0, acc_r = 0;
    for (int i = 0; i < 32; ++i) {
        const int c = tab[i * 65 + 64], nt = (c + 127) >> 7;
        if (tile < acc_t + nt) { e = i; mt = tile - acc_t; off = acc_r; ce = c; return true; }
        acc_t += nt; acc_r += c;
    }
    return false;
}
DI int moe_ntiles(const int* tab) { int a = 0; for (int i = 0; i < 32; ++i) a += (tab[i * 65 + 64] + 127) >> 7; return a; }
DI void moe_rows(const int* tab, const int* list, int e, int mt, int ce, int* rowidx) {
    if (threadIdx.x < 128) {
        const int pos = mt * 128 + threadIdx.x;
        int idx = -1;
        if (pos < ce) {
            int lo = 0, hi = 64;
            while (hi - lo > 1) { const int mid = (lo + hi) >> 1; if (tab[e * 65 + mid] <= pos) lo = mid; else hi = mid; }
            idx = list[((lo * 32 + e) << 10) + pos - tab[e * 65 + lo]];
        }
        rowidx[threadIdx.x] = idx;
    }
    __syncthreads();
}

DI void phase_moe_gu(const Params& P, unsigned char* smem, int layer) {
    unsigned char* ws = P.ws;
    const int* cnt = (const int*)(ws + WS_CTL) + layer * 2048;
    const int* list = (const int*)(ws + WS_LIST2);
    const float* wgt = (const float*)(ws + WS_WGT);
    const bf16_t* xb = (const bf16_t*)(ws + WS_ACTB);
    bf16_t* H = (bf16_t*)(ws + XP_H);
    const int* tab = (const int*)(smem + MOE_LDS_TAB);
    int* rowidx = (int*)(smem + MOE_LDS_ROW);
    moe_tables(cnt, smem);
    const int ntile = moe_ntiles(tab);
    for (int it = vblock(); it < ntile * 2; it += gridDim.x) {
        int e, mt, off, ce; moe_tile(tab, it >> 1, e, mt, off, ce);
        const int nt = it & 1;
        moe_rows(tab, list, e, mt, ce, rowidx);
        auto rowptr = [=](int r) { int idx = rowidx[r]; idx = idx < 0 ? rowidx[0] : idx; return xb + (size_t)(idx >> 1) * 1024; };
        auto epi = [=](f32x4 (&acc)[4][4], int wr, int wc, int ln) {
            const int fr = ln & 15, fq = ln >> 4;
#pragma unroll
            for (int m = 0; m < 4; ++m) {
                const int rl = wr * 64 + m * 16 + fr, idx = rowidx[rl];
                if (idx >= 0) {
                    const float w = wgt[idx];
                    f32x4 hv[2];
#pragma unroll
                    for (int n = 0; n < 2; ++n) {
                        const f32x4 gte = acc[m][n], up = acc[m][n + 2];
                        hv[n] = (f32x4){gte.x * sigmoidf_(gte.x) * up.x * w, gte.y * sigmoidf_(gte.y) * up.y * w, gte.z * sigmoidf_(gte.z) * up.z * w, gte.w * sigmoidf_(gte.w) * up.w * w};
                    }
                    *(u32x4*)(H + (size_t)(off + mt * 128 + rl) * 128 + (nt * 2 + wc) * 32 + fq * 8) = cvt44(hv[0], hv[1]);
                }
            }
        };
        gemm128(rowptr, (const bf16_t*)(ws + WS_WGU) + ((size_t)(layer * 32 + e) * 256 + nt * 128) * 1024, 1024, 1024, smem, epi);
        __syncthreads();
    }
}
DI void phase_moe_down(const Params& P, unsigned char* smem, int layer) {
    unsigned char* ws = P.ws;
    const int* cnt = (const int*)(ws + WS_CTL) + layer * 2048;
    const int* list = (const int*)(ws + WS_LIST2);
    const bf16_t* H = (const bf16_t*)(ws + XP_H);
    bf16_t* YB = (bf16_t*)(ws + XP_YB);
    const int* tab = (const int*)(smem + MOE_LDS_TAB);
    int* rowidx = (int*)(smem + MOE_LDS_ROW);
    moe_tables(cnt, smem);
    const int ntile = moe_ntiles(tab);
    for (int it = vblock(); it < ntile * 8; it += gridDim.x) {
        int e, mt, off, ce; moe_tile(tab, it >> 3, e, mt, off, ce);
        const int nt = it & 7;
        moe_rows(tab, list, e, mt, ce, rowidx);
        auto rowptr = [=](int r) { int pos = mt * 128 + r; pos = pos < ce ? pos : 0; return H + (size_t)(off + pos) * 128; };
        auto epi = [=](f32x4 (&acc)[4][4], int wr, int wc, int ln) {
            const int fr = ln & 15, fq = ln >> 4;
#pragma unroll
            for (int m = 0; m < 4; ++m) {
                const int idx = rowidx[wr * 64 + m * 16 + fr];
                if (idx >= 0) {
                    bf16_t* dst = YB + (size_t)idx * 1024 + nt * 128 + wc * 64 + fq * 8;
#pragma unroll
                    for (int q = 0; q < 2; ++q) *(u32x4*)(dst + q * 32) = cvt44(acc[m][2 * q], acc[m][2 * q + 1]);
                }
            }
        };
        gemm128(rowptr, (const bf16_t*)(ws + WS_WDN) + ((size_t)(layer * 32 + e) * 1024 + nt * 128) * 128, 128, 128, smem, epi);
        __syncthreads();
    }
}
DI void phase_ln_ffn(const Params& P, int layer) {
    unsigned char* ws = P.ws;
    const int lane = threadIdx.x & 63, wave = threadIdx.x >> 6;
    const float* g = P.in[23] + layer * 1024; const float* bta = P.in[24] + layer * 1024;
    const bf16_t* YB = (const bf16_t*)(ws + XP_YB);
    bf16_t* xb = (bf16_t*)(ws + WS_ACTB);
    for (int task = blockIdx.x * 4 + wave; task < NT / 16; task += gridDim.x * 4) {
        u32x4 nxm[2], ny0[2], ny1[2];
        auto fetch = [&](int t) {
#pragma unroll
            for (int j = 0; j < 2; ++j) {
                nxm[j] = __builtin_nontemporal_load((const u32x4*)(xb + (size_t)t * 1024 + 8 * lane + 512 * j));
                ny0[j] = __builtin_nontemporal_load((const u32x4*)(YB + (size_t)(2 * t) * 1024 + 8 * lane + 512 * j));
                ny1[j] = __builtin_nontemporal_load((const u32x4*)(YB + (size_t)(2 * t + 1) * 1024 + 8 * lane + 512 * j));
            }
        };
        fetch(task * 16);
#pragma unroll 1
        for (int i = 0; i < 16; ++i) {
            const int t = task * 16 + i;
            float v[16];
#pragma unroll
            for (int j = 0; j < 4; ++j) {
                const u32x4 wa = nxm[j >> 1], w0 = ny0[j >> 1], w1 = ny1[j >> 1];
                const f32x4 a = bf4_to_f((j & 1) ? (u32x2){wa.z, wa.w} : (u32x2){wa.x, wa.y}), y0 = bf4_to_f((j & 1) ? (u32x2){w0.z, w0.w} : (u32x2){w0.x, w0.y}), y1 = bf4_to_f((j & 1) ? (u32x2){w1.z, w1.w} : (u32x2){w1.x, w1.y});
                v[4 * j + 0] = ALPHA * a.x + (y0.x + y1.x); v[4 * j + 1] = ALPHA * a.y + (y0.y + y1.y);
                v[4 * j + 2] = ALPHA * a.z + (y0.z + y1.z); v[4 * j + 3] = ALPHA * a.w + (y0.w + y1.w);
            }
            if (i + 1 < 16) fetch(t + 1);
            ln_row(v, g, bta, lane);
            float* row = P.out + (size_t)t * 1024;
#pragma unroll
            for (int j = 0; j < 2; ++j) {
                const f32x4 lo = (f32x4){v[8 * j], v[8 * j + 1], v[8 * j + 2], v[8 * j + 3]}, hi = (f32x4){v[8 * j + 4], v[8 * j + 5], v[8 * j + 6], v[8 * j + 7]};
                if (layer == 0) *(u32x4*)((bf16_t*)P.out + (size_t)t * 1024 + 8 * lane + 512 * j) = cvt44(lo, hi);
                else { *(f32x4*)(row + 8 * lane + 512 * j) = lo; *(f32x4*)(row + 8 * lane + 512 * j + 4) = hi; }
            }
        }
    }
}

DI void phase_inproj1(const Params& P, unsigned char* smem) {
    unsigned char* ws = P.ws;
    const bf16_t* A = (const bf16_t*)P.out;
    const float* cosT = (const float*)(ws + WS_ROPE);
    const float* sinT = cosT + 4096 * 32;
    bool pre = false;
    for (int it = vblock(); it < (NT / 128) * 24; it += gridDim.x) {
        int mt, nt; tile_mn(it, 24, mt, nt);
        const int m0 = mt * 128;
        auto rowptr = [=](int r) { return A + (size_t)(m0 + r) * 1024; };
        const bf16_t* Bt = (const bf16_t*)(ws + WS_WIN1) + (size_t)nt * 128 * 1024;
        const bool hn = it + (int)gridDim.x < (NT / 128) * 24;
        int mtn = 0, ntn = 0; if (hn) tile_mn(it + gridDim.x, 24, mtn, ntn);
        auto nextrow = [=](int r) { return A + (size_t)(mtn * 128 + r) * 1024; };
        const bf16_t* nBt = (const bf16_t*)(ws + WS_WIN1) + (size_t)ntn * 128 * 1024;
        if (nt >= 16) {
            auto epi = [=](f32x4 (&acc)[4][4], int wr, int wc, int lane) {
                const int head = (nt * 2 + wc) & 15, fr = lane & 15, fq = lane >> 4;
#pragma unroll
                for (int m = 0; m < 4; ++m) {
                    const int t = m0 + wr * 64 + m * 16 + fq * 4, s = t & 4095, b = t >> 12;
                    bf16_t* base = (bf16_t*)(ws + XP_Q1 + (size_t)2 * 64 * MiB) + (size_t)(b * 16 + head) * 4096 * 64;
#pragma unroll
                    for (int n = 0; n < 4; ++n) *(u32x2*)(base + vp_off(s, n * 16 + fr)) = cvt4(acc[m][n]);
                }
            };
            gemm128s<false>(rowptr, Bt, 1024, 1024, smem, epi, pre, hn, nextrow, nBt);
            pre = hn;
            continue;
        }
        auto epi = [=](f32x4 (&acc)[4][4], int wr, int wc, int lane) {
            const int u64 = nt * 2 + wc, kind = u64 >> 4, head = u64 & 15, fr = lane & 15, fq = lane >> 4;
            f32x4 cs[2][2];
#pragma unroll
            for (int n2 = 0; n2 < 2; ++n2) { cs[n2][0] = (f32x4){0.f, 0.f, 0.f, 0.f}; cs[n2][1] = cs[n2][0]; }
#pragma unroll
            for (int m = 0; m < 4; ++m) {
                const int t = m0 + wr * 64 + m * 16 + fr, s = t & 4095, b = t >> 12;
                bf16_t* base = (bf16_t*)(ws + XP_Q1 + (size_t)kind * 64 * MiB) + (size_t)(b * 16 + head) * 4096 * 64;
                f32x4 r1[2], r2[2];
#pragma unroll
                for (int n2 = 0; n2 < 2; ++n2) {
                    const int i = 8 * fq + 4 * n2;
                    const f32x4 c = *(const f32x4*)(cosT + s * 32 + i), sn = *(const f32x4*)(sinT + s * 32 + i);
                    const f32x4 x1 = acc[m][2 * n2], x2 = acc[m][2 * n2 + 1];
                    r1[n2] = x1 * c - x2 * sn; r2[n2] = x1 * sn + x2 * c;
                    if (kind != 0) { cs[n2][0] += r1[n2]; cs[n2][1] += r2[n2]; }
                }
                const u32x4 o1 = cvt44(r1[0], r1[1]), o2 = cvt44(r2[0], r2[1]);
                if (kind == 0) { *(u32x4*)(base + (size_t)s * 64 + 8 * fq) = o1; *(u32x4*)(base + (size_t)s * 64 + 8 * fq + 32) = o2; }
                else { *(u32x4*)(base + kp_off(s, 8 * fq)) = o1; *(u32x4*)(base + kp_off(s, 8 * fq + 32)) = o2; }
            }
            if (kind == 1) {
                const int t0 = m0 + wr * 64, bh = (t0 >> 12) * 16 + head, seg = (t0 & 4095) >> 6;
                float* dst = (float*)(ws + WS_KMP) + ((size_t)bh * 64 + seg) * 64;
#pragma unroll
                for (int n2 = 0; n2 < 2; ++n2)
#pragma unroll
                    for (int hf = 0; hf < 2; ++hf) {
                        f32x4 v = cs[n2][hf];
#pragma unroll
                        for (int k = 0; k < 4; ++k) { float x = v[k]; x += dpp_f<0xB1>(x); x += dpp_f<0x4E>(x); x += dpp_f<0x141>(x); x += dpp_f<0x140>(x); v[k] = x; }
                        if (fr == 0) *(f32x4*)(dst + 8 * fq + 4 * n2 + hf * 32) = v;
                    }
            }
        };
        gemm128s(rowptr, Bt, 1024, 1024, smem, epi, pre, hn, nextrow, nBt);
        pre = hn;
    }
}
DI void moba_kmeans_slab(const Params& P, bf16_t* kml, int bh, int tid) {
    const float* kp = (const float*)(P.ws + WS_KMP) + (size_t)bh * 64 * 64;
    for (int e = tid; e < 2048; e += 256) {
        const int d = e & 63, n = e >> 6;
        float a = 0.f;
        if (n < 16) a = ((kp[(4 * n) * 64 + d] + kp[(4 * n + 1) * 64 + d]) + (kp[(4 * n + 2) * 64 + d] + kp[(4 * n + 3) * 64 + d])) * (1.f / 256.f);
        kml[((d >> 4) * 32 + n) * 16 + (d & 15)] = f2bf(a);
    }
}
DI unsigned moba_gate_rows(const bf16_t* km, const bf16x8 (&qf)[4], int own, int r, int h) {
    f32x16 g;
#pragma unroll
    for (int i = 0; i < 16; ++i) g[i] = 0.f;
#pragma unroll
    for (int ks = 0; ks < 4; ++ks) g = MFMA32(*(const bf16x8*)(km + (ks * 32 + r) * 16 + 8 * h), qf[ks], g);
    float mine[8], oth[8];
#pragma unroll
    for (int i = 0; i < 8; ++i) { const int n = (i & 3) + 8 * (i >> 2) + 4 * h; mine[i] = n < own ? g[i] : -INFINITY; oth[i] = __shfl_xor(mine[i], 32); }
    unsigned selmask = 0;
#pragma unroll
    for (int i = 0; i < 8; ++i) {
        const int n = (i & 3) + 8 * (i >> 2) + 4 * h;
        int rank = 0;
#pragma unroll
        for (int k = 0; k < 8; ++k) {
            const int nk = (k & 3) + 8 * (k >> 2) + 4 * h, no = (k & 3) + 8 * (k >> 2) + 4 * (1 - h);
            rank += (mine[k] > mine[i] || (mine[k] == mine[i] && nk < n)) ? 1 : 0;
            rank += (oth[k] > mine[i] || (oth[k] == mine[i] && no < n)) ? 1 : 0;
        }
        if (n < own && rank < 3) selmask |= 1u << n;
    }
    return selmask | __shfl_xor(selmask, 32);
}
DI void phase_moba_gate(const Params& P, unsigned char* smem) {
    unsigned char* ws = P.ws;
    const int tid = threadIdx.x, lane = tid & 63, wave = tid >> 6, r = lane & 31, h = lane >> 5;
    bf16_t* kml = (bf16_t*)smem;
    unsigned short* smask = (unsigned short*)(smem + 4096);
    unsigned short* selm = (unsigned short*)(ws + WS_SELM);
    unsigned short* mcnt = (unsigned short*)(ws + WS_MCNT);
    unsigned char* mlist = ws + WS_MLIST;
    int km_bh = -1;
    for (int it = blockIdx.x; it < 2048; it += gridDim.x) {
        const int bh = it & 127, qb = it >> 7;
        if (bh != km_bh) { km_bh = bh; __syncthreads(); moba_kmeans_slab(P, kml, bh, tid); }
        __syncthreads();
#pragma unroll 1
        for (int g2 = 0; g2 < 2; ++g2) {
            const int rl = wave * 64 + g2 * 32 + r, q = qb * 256 + rl;
            const bf16_t* Qg = (const bf16_t*)(ws + XP_Q1) + ((size_t)bh * 4096 + q) * 64;
            bf16x8 qf[4];
#pragma unroll
            for (int ks = 0; ks < 4; ++ks) qf[ks] = *(const bf16x8*)(Qg + ks * 16 + 8 * h);
            const unsigned sm = qb > 0 ? moba_gate_rows(kml, qf, qb, r, h) : 0u;
            if (h == 0) { selm[(size_t)bh * 4096 + q] = (unsigned short)sm; smask[rl] = (unsigned short)sm; }
        }
        __syncthreads();
        for (int n = wave; n < qb; n += 4) {
            unsigned char* lp = mlist + ((size_t)(bh * 16 + qb) * 16 + n) * 256;
            int base = 0;
#pragma unroll
            for (int c4 = 0; c4 < 4; ++c4) {
                const int row = c4 * 64 + lane;
                const bool bit = (smask[row] >> n) & 1;
                const unsigned long long bal = __ballot(bit);
                if (bit) lp[base + __builtin_popcountll(bal & ((1ull << lane) - 1ull))] = (unsigned char)row;
                base += __builtin_popcountll(bal);
            }
            if (lane == 0) mcnt[(bh * 16 + qb) * 16 + n] = (unsigned short)base;
        }
    }
}
DI bf16_t* moba_po(const Params& P, int slot) { return (bf16_t*)(P.ws + (slot == 0 ? WS_MIX : slot == 1 ? WS_ACTB : WS_PO2)); }
DI void phase_moba_kv(const Params& P, unsigned char* smem) {
    unsigned char* ws = P.ws;
    const int tid = threadIdx.x, lane = tid & 63, wave = tid >> 6, r = lane & 31, h = lane >> 5;
    const float c = 0.125f * 1.4426950408889634f;
    LAS unsigned char* lds = (LAS unsigned char*)smem;
    const unsigned short* selm = (const unsigned short*)(ws + WS_SELM);
    const unsigned short* mcnt = (const unsigned short*)(ws + WS_MCNT);
    const unsigned char* mlist = ws + WS_MLIST;
    float* pml = (float*)(ws + WS_PML);
    const bool bal = (gridDim.x == 512);
    const int nit = bal ? ((blockIdx.x >> 7) == 3 ? 3 : 4) : (1920 + (int)gridDim.x - 1 - (int)blockIdx.x) / (int)gridDim.x;
    for (int iti = 0; iti < nit; ++iti) {
        int bh, n;
        if (bal) { const int gq = blockIdx.x >> 7; bh = blockIdx.x & 127; const int tab = gq == 0 ? 0x0DA90 : gq == 1 ? 0x0CB61 : gq == 2 ? 0x0E852 : 0x00743; n = (tab >> (4 * iti)) & 15; }
        else { const int it = blockIdx.x + iti * gridDim.x; n = it >> 7; bh = it & 127; }
        const bf16_t* Kg = (const bf16_t*)(ws + XP_Q1 + 64 * MiB) + (size_t)bh * 4096 * 64 + (size_t)n * 4 * 4096;
        const bf16_t* Vg = (const bf16_t*)(ws + XP_Q1 + 128 * MiB) + (size_t)bh * 4096 * 64 + (size_t)n * 4 * 4096;
        asm volatile("s_waitcnt vmcnt(0)" ::: "memory");
        __builtin_amdgcn_s_barrier();
#pragma unroll
        for (int j = 0; j < 4; ++j) fa_issue(Kg + (size_t)j * 4096, Vg + (size_t)j * 4096, lds + j * 16384, tid);
        const int cntv = (lane < 16 && lane > n) ? (int)mcnt[(bh * 16 + lane) * 16 + n] : 0;
        asm volatile("s_waitcnt vmcnt(0)" ::: "memory");
        __builtin_amdgcn_s_barrier();
        asm volatile("" ::: "memory");
        int prefv = 0, total = 0;
#pragma unroll 1
        for (int qb = 0; qb < 16; ++qb) { if (lane == qb) prefv = total; total += __builtin_amdgcn_readlane(cntv, qb); }
#pragma unroll 1
        for (int v0 = wave * 32; v0 < total; v0 += 128) {
            const int v = v0 + r;
            const bool valid = v < total;
            const int vv = valid ? v : v0;
            int qb = n + 1;
#pragma unroll 1
            for (int l = n + 2; l < 16; ++l) if (vv >= __builtin_amdgcn_readlane(prefv, l)) qb = l;
            const int idx = vv - __shfl(prefv, qb);
            const int q = qb * 256 + (int)mlist[((size_t)(bh * 16 + qb) * 16 + n) * 256 + idx];
            const bf16_t* Qg = (const bf16_t*)(ws + XP_Q1) + ((size_t)bh * 4096 + q) * 64;
            bf16x8 qf[4];
#pragma unroll
            for (int ks = 0; ks < 4; ++ks) qf[ks] = *(const bf16x8*)(Qg + ks * 16 + 8 * h);
            FA st; fa_init(st);
#pragma unroll 1
            for (int j = 0; j < 4; ++j) {
                const LAS bf16_t* cur = (const LAS bf16_t*)(lds + j * 16384);
                fa_tile<0>(st, qf, cur, cur + 4096, r, h, c, true, [=](int) { return true; });
            }
            const float l = st.l + __shfl_xor(st.l, 32);
            const float inv = 1.f / fmaxf(l, 1e-30f);
            if (valid) {
                const int slot = __builtin_popcount((unsigned)selm[(size_t)bh * 4096 + q] & ((1u << n) - 1u));
                bf16_t* o = moba_po(P, slot) + ((size_t)(bh >> 4) * 4096 + q) * 1024 + (bh & 15) * 64;
                nat_store(o, h, st.o0, st.o1, inv);
                if (h == 0) { float* pm = pml + (((size_t)bh * 4096 + q) * 3 + slot) * 2; pm[0] = st.m; pm[1] = l; }
            }
        }
    }
}
DI void phase_moba_own(const Params& P, unsigned char* smem) {
    unsigned char* ws = P.ws;
    const int tid = threadIdx.x, lane = tid & 63, wave = tid >> 6, r = lane & 31, h = lane >> 5;
    const float c = 0.125f * 1.4426950408889634f;
    LAS unsigned char* lds = (LAS unsigned char*)smem;
    const unsigned short* selm = (const unsigned short*)(ws + WS_SELM);
    const float* pml = (const float*)(ws + WS_PML);
    for (int it = blockIdx.x; it < 2048; it += gridDim.x) {
        const int own = 15 - (it >> 7), bh = it & 127, t0 = own * 256;
        const bf16_t* Kg = (const bf16_t*)(ws + XP_Q1 + 64 * MiB) + (size_t)bh * 4096 * 64 + (size_t)own * 4 * 4096;
        const bf16_t* Vg = (const bf16_t*)(ws + XP_Q1 + 128 * MiB) + (size_t)bh * 4096 * 64 + (size_t)own * 4 * 4096;
        asm volatile("s_waitcnt vmcnt(0)" ::: "memory");
        __builtin_amdgcn_s_barrier();
#pragma unroll
        for (int j = 0; j < 4; ++j) fa_issue(Kg + (size_t)j * 4096, Vg + (size_t)j * 4096, lds + j * 16384, tid);
        asm volatile("s_waitcnt vmcnt(0)" ::: "memory");
        __builtin_amdgcn_s_barrier();
        asm volatile("" ::: "memory");
#pragma unroll 1
        for (int g2 = 0; g2 < 2; ++g2) {
            const int row0 = t0 + g2 * 128 + wave * 32, q = row0 + r;
            const bf16_t* Qg = (const bf16_t*)(ws + XP_Q1) + ((size_t)bh * 4096 + q) * 64;
            bf16x8 qf[4];
#pragma unroll
            for (int ks = 0; ks < 4; ++ks) qf[ks] = *(const bf16x8*)(Qg + ks * 16 + 8 * h);
            const int nsel = __builtin_popcount((unsigned)selm[(size_t)bh * 4096 + q]);
            const size_t orow = ((size_t)(bh >> 4) * 4096 + q) * 1024 + (bh & 15) * 64;
            const float* pm = pml + ((size_t)bh * 4096 + q) * 6;
            float mi[3], li[3];
            u32x4 pa[3][4];
#pragma unroll
            for (int i = 0; i < 3; ++i) {
                mi[i] = i < nsel ? pm[2 * i] : -INFINITY; li[i] = i < nsel ? pm[2 * i + 1] : 0.f;
                const u32x4* po = (const u32x4*)(moba_po(P, i) + orow + 32 * h);
#pragma unroll
                for (int k = 0; k < 4; ++k) pa[i][k] = i < nsel ? po[k] : (u32x4){0u, 0u, 0u, 0u};
            }
            FA st; fa_init(st);
            const int jmax = (row0 + 31 - t0) >> 6;
#pragma unroll 1
            for (int j = 0; j <= jmax; ++j) {
                const LAS bf16_t* cur = (const LAS bf16_t*)(lds + j * 16384);
                const int kbase = t0 + j * 64;
                if (kbase + 63 <= row0) fa_tile<0>(st, qf, cur, cur + 4096, r, h, c, true, [=](int) { return true; });
                else fa_tile<2>(st, qf, cur, cur + 4096, r, h, c, true, [=](int koff) { return kbase + koff <= q; });
            }
            const float l_own = st.l + __shfl_xor(st.l, 32);
            const float M = fmaxf(fmaxf(st.m, mi[0]), fmaxf(mi[1], mi[2]));
            const float wo = __builtin_amdgcn_exp2f(st.m - M);
            float L = l_own * wo;
#pragma unroll
            for (int k = 0; k < 16; ++k) { st.o0[k] *= wo; st.o1[k] *= wo; }
#pragma unroll
            for (int i = 0; i < 3; ++i) {
                const float wi = li[i] * __builtin_amdgcn_exp2f(mi[i] - M);
                L += wi;
#pragma unroll
                for (int k = 0; k < 2; ++k) {
                    const f32x4 a0 = bf4_to_f((u32x2){pa[i][k].x, pa[i][k].y}), a1 = bf4_to_f((u32x2){pa[i][k].z, pa[i][k].w});
                    const f32x4 b0 = bf4_to_f((u32x2){pa[i][2 + k].x, pa[i][2 + k].y}), b1 = bf4_to_f((u32x2){pa[i][2 + k].z, pa[i][2 + k].w});
                    st.o0[8 * k] += wi * a0.x; st.o0[8 * k + 1] += wi * a0.y; st.o0[8 * k + 2] += wi * a0.z; st.o0[8 * k + 3] += wi * a0.w;
                    st.o0[8 * k + 4] += wi * a1.x; st.o0[8 * k + 5] += wi * a1.y; st.o0[8 * k + 6] += wi * a1.z; st.o0[8 * k + 7] += wi * a1.w;
                    st.o1[8 * k] += wi * b0.x; st.o1[8 * k + 1] += wi * b0.y; st.o1[8 * k + 2] += wi * b0.z; st.o1[8 * k + 3] += wi * b0.w;
                    st.o1[8 * k + 4] += wi * b1.x; st.o1[8 * k + 5] += wi * b1.y; st.o1[8 * k + 6] += wi * b1.z; st.o1[8 * k + 7] += wi * b1.w;
                }
            }
            const float inv = 1.f / fmaxf(L, 1e-30f);
            nat_store((bf16_t*)(ws + WS_MIX) + orow, h, st.o0, st.o1, inv);
        }
    }
}

constexpr int SMEM_BYTES = 65536 + 8192 + 1024 + 512;
static_assert(SMEM_BYTES >= 128 * 129 * 4 && SMEM_BYTES >= MOE_LDS_ROW + 512 && SMEM_BYTES >= NSA_LDS_MSK + 256, "LDS map");
constexpr int SMEM_OLD = 128 * 129 * 4;
typedef __attribute__((address_space(1))) unsigned gu32;
#define XB_TMO      128
#define XB_XCNT(j)  (256  + 64 * (j))
#define XB_XSUB(j)  (1280 + 64 * (j))
#define XB_XGEN(j)  (2304 + 64 * (j))
#define XB_TOP      3328
#define XB_TOPGEN   3392
#define XCD_BAR_WORDS 3456
#define XB_SPIN_CAP (1u << 18)

__device__ __forceinline__ unsigned xb_ld(unsigned* p)              { return __hip_atomic_load(p, __ATOMIC_RELAXED, __HIP_MEMORY_SCOPE_AGENT); }
__device__ __forceinline__ unsigned xb_add(unsigned* p, unsigned v) { return __hip_atomic_fetch_add(p, v, __ATOMIC_RELAXED, __HIP_MEMORY_SCOPE_AGENT); }
__device__ __forceinline__ unsigned xb_xcc_id() { return (unsigned)__builtin_amdgcn_s_getreg((3 << 11) | 20) & 0xFu; }
#define XB_SPIN(cond, bar) do { unsigned _sp = 0; while (cond) { __builtin_amdgcn_s_sleep(1); \
    if ((++_sp & 255u) == 0u) { if (xb_ld(&(bar)[XB_TMO])) break; if (_sp > XB_SPIN_CAP) { atomicAdd(&(bar)[XB_TMO], 1u); break; } } } } while (0)

struct XcdBarrier {
    unsigned* bar; unsigned x;
    volatile LAS unsigned* st;
};

__device__ __forceinline__ XcdBarrier xcd_barrier_post(unsigned* bar, volatile LAS unsigned* st) {
    XcdBarrier b; b.bar = bar; b.x = xb_xcc_id(); b.st = st;
    if (threadIdx.x == 0) (void)xb_add(&bar[XB_XCNT(b.x)], 1u);
    return b;
}
__device__ __forceinline__ void xcd_barrier_complete(unsigned* bar, unsigned x, unsigned& nloc, unsigned& nx) {
    const unsigned G = gridDim.x * gridDim.y * gridDim.z;
    unsigned sum, cnt, mine, sp = 0u;
    for (;;) {
        sum = 0u; cnt = 0u; mine = 0u;
#pragma unroll
        for (unsigned j = 0; j < 16; ++j) { const unsigned c = xb_ld(&bar[XB_XCNT(j)]); sum += c; cnt += (c > 0u) ? 1u : 0u; mine = (j == x) ? c : mine; }
        if (sum == G) break;
        __builtin_amdgcn_s_sleep(1);
        if ((++sp & 255u) == 0u) { if (xb_ld(&bar[XB_TMO])) break; if (sp > XB_SPIN_CAP) { atomicAdd(&bar[XB_TMO], 1u); break; } }
    }
    nloc = mine > 0u ? mine : 1u; nx = cnt > 0u ? cnt : 1u;
}

__device__ __forceinline__ void xcd_barrier(const XcdBarrier& b) {
    asm volatile("s_waitcnt vmcnt(0)" ::: "memory");
    __syncthreads();
    if (threadIdx.x == 0) {
        unsigned* bar = b.bar;
        __builtin_amdgcn_s_waitcnt(0);
        unsigned nloc = b.st[0], nx = b.st[1];
        if (nloc == 0u) { xcd_barrier_complete(bar, b.x, nloc, nx); b.st[0] = nloc; b.st[1] = nx; }
        const unsigned old = xb_add(&bar[XB_XSUB(b.x)], 1u);
        const unsigned gen = old / nloc;
        if (old + 1u == (gen + 1u) * nloc) {
            __builtin_amdgcn_fence(__ATOMIC_RELEASE, "agent");
            asm volatile("s_waitcnt vmcnt(0)" ::: "memory");
            const unsigned og = xb_add(&bar[XB_TOP], 1u);
            const unsigned tg = og / nx;
            if (og + 1u == (tg + 1u) * nx) xb_add(&bar[XB_TOPGEN], 1u);
            else XB_SPIN(xb_ld(&bar[XB_TOPGEN]) == tg, bar);
            __builtin_amdgcn_fence(__ATOMIC_ACQUIRE, "agent");
            xb_add(&bar[XB_XGEN(b.x)], 1u);
            asm volatile("s_waitcnt vmcnt(0)" ::: "memory");
        } else {
            XB_SPIN(xb_ld(&bar[XB_XGEN(b.x)]) == gen, bar);
            __builtin_amdgcn_fence(__ATOMIC_ACQUIRE, "agent");
            asm volatile("s_waitcnt vmcnt(0)" ::: "memory");
        }
    }
    __syncthreads();
}

constexpr size_t CTL_BAR = 16384;
constexpr size_t CTL_BYTES = 32768;

#define PHASE(k, call) if (P.ph_lo <= (k) && (k) < P.ph_hi) { call; if ((k) + 1 < P.ph_hi) xcd_barrier(xb); }
__global__ void __launch_bounds__(256, 2) mega(Params P) {
    __shared__ __attribute__((aligned(16))) unsigned char smem[SMEM_BYTES + 16];
    unsigned* xbst = (unsigned*)(smem + SMEM_BYTES);
    cg::grid_group grid = cg::this_grid();
    if (threadIdx.x < 4) xbst[threadIdx.x] = 0u;
    __syncthreads();
    if (P.ph_lo < 0) grid.sync();
    XcdBarrier xb = xcd_barrier_post((unsigned*)(P.ws + WS_CTL + CTL_BAR), (volatile LAS unsigned*)xbst);
    PHASE(0, phase0(P, smem))
    PHASE(1, phase_inproj0(P, smem))
    PHASE(2, phase_cmp_s5e(P, smem))
    PHASE(3, phase_glu(P, smem); phase_nsa(P, smem))
    PHASE(6, phase_outproj<false>(P, smem, P.in[0], nullptr, WS_WOUT0))
    PHASE(7, phase_ln_router(P, 0))
    PHASE(8, phase_moe_gu(P, smem, 0))
    PHASE(9, phase_moe_down(P, smem, 0))
    PHASE(10, phase_ln_ffn(P, 0))
    PHASE(11, phase_inproj1(P, smem))
    PHASE(12, phase_moba_gate(P, smem))
    PHASE(13, phase_moba_kv(P, smem))
    PHASE(14, phase_moba_own(P, smem))
    PHASE(15, phase_outproj<true>(P, smem, nullptr, (const bf16_t*)P.out, WS_WOUT1))
    PHASE(16, phase_ln_router(P, 1))
    PHASE(17, phase_moe_gu(P, smem, 1))
    PHASE(18, phase_moe_down(P, smem, 1))
    PHASE(20, phase_ln_ffn(P, 1))
}

extern "C" void kernel_launch(void* const* d_in, const int* in_sizes, int n_in, void* d_out, int out_size, void* d_ws, size_t ws_size, hipStream_t stream) {
    static int grid = 0;
    if (grid == 0) {
        if (n_in != 32 || out_size != NT * DM || ws_size < WS_END) { fprintf(stderr, "kernel_launch: unexpected shapes (n_in %d, out %d, ws %zu)\n", n_in, out_size, ws_size); grid = -1; return; }
        int dev = 0, cus = 0, per_cu = 0;
        (void)hipGetDevice(&dev);
        (void)hipDeviceGetAttribute(&cus, hipDeviceAttributeMultiprocessorCount, dev);
        (void)hipOccupancyMaxActiveBlocksPerMultiprocessor(&per_cu, mega, 256, 0);
        if (per_cu < 1) per_cu = 1;
        if (per_cu > 2) per_cu = 2;
        grid = cus * per_cu;
    }
    if (grid < 0) return;
    (void)hipMemsetAsync((char*)d_ws + WS_CTL, 0, CTL_BYTES, stream);
    Params p{};
    for (int i = 0; i < 32; ++i) p.in[i] = (const float*)d_in[i];
    p.out = (float*)d_out; p.ws = (unsigned char*)d_ws;
    p.ph_lo = 0; p.ph_hi = NPH;
    void* args[] = {&p};
    hipError_t e = hipLaunchCooperativeKernel((void*)mega, dim3(grid), dim3(256), args, 0, stream);
    if (e != hipSuccess) fprintf(stderr, "cooperative launch failed: %s (grid %d)\n", hipGetErrorString(e), grid);
}
```
